# Optimizing an MI355X kernel written in HIP

```python
import math
import jax, jax.numpy as jnp
from jax import lax
import numpy as np

D_MODEL = 1024
BATCH = 8
SEQ = 2048
DEPTH = 1

A_HEADS = 8
A_HEAD_DIM = 64
A_WIDTH = A_HEADS * A_HEAD_DIM
IDX_HEADS = 8
IDX_DIM = 32
INDEX_TOPK = 256
SPARSE_Q_BLOCK = 64
N_BUCKETS = 32
MAX_DISTANCE = 128

B_HEADS = 4
B_KEY_DIM = 64
B_VAL_DIM = 128
B_KEY_WIDTH = B_HEADS * B_KEY_DIM
B_WIDTH = B_HEADS * B_VAL_DIM
GATE_RANK = 16
GATE_TEMP = 16.0
GLA_CHUNK = 64

MIX_WIDTH = A_WIDTH + B_WIDTH

PROJ_SPLITS = (A_WIDTH, A_WIDTH, A_WIDTH,
               IDX_HEADS * IDX_DIM, IDX_DIM, IDX_HEADS,
               B_KEY_WIDTH, B_KEY_WIDTH, B_WIDTH,
               GATE_RANK, B_WIDTH)
PROJ_WIDTH = 3 * A_WIDTH + IDX_HEADS * IDX_DIM + IDX_DIM + IDX_HEADS + 2 * B_KEY_WIDTH + B_WIDTH + GATE_RANK + B_WIDTH

N_GROUPS = 4
EXPERTS_PER_GROUP = 8
N_EXPERTS = N_GROUPS * EXPERTS_PER_GROUP
EXPERT_TOPK = 2
D_EXPERT = 256

EPS = 1e-6

kernel_name = "hymba_dsa_gla_hier_moe_layer"


def rmsnorm(x, g):
    xf = x.astype(jnp.float32)
    y = xf * lax.rsqrt(jnp.mean(xf * xf, axis=-1, keepdims=True) + EPS)
    return (y * g.astype(jnp.float32)).astype(x.dtype)


def t5_bucket(dist):
    max_exact = N_BUCKETS // 2
    d_f = jnp.maximum(dist, 1).astype(jnp.float32)
    large = max_exact + (jnp.log(d_f / max_exact) / math.log(MAX_DISTANCE / max_exact)
                         * (N_BUCKETS - max_exact)).astype(jnp.int32)
    large = jnp.minimum(large, N_BUCKETS - 1)
    return jnp.where(dist < max_exact, dist, large)


def dsa_attention(q, k, v, iq, ik, iw, rel_bias):
    bsz, s_len = q.shape[0], q.shape[1]
    topk = min(INDEX_TOPK, s_len // 4)
    nb = s_len // SPARSE_Q_BLOCK

    def blocks(a):
        return a.reshape(bsz, nb, SPARSE_Q_BLOCK, *a.shape[2:]).swapaxes(0, 1)

    q_pos = jnp.arange(s_len, dtype=jnp.int32).reshape(nb, SPARSE_Q_BLOCK)
    key_pos = jnp.arange(s_len, dtype=jnp.int32)
    ik_f = ik.astype(jnp.float32)
    gather = jax.vmap(lambda a, i: a[i])

    def one_block(args):
        qb, iqb, iwb, tb = args
        idx_logits = jnp.einsum('bqhd,bsd->bqhs', iqb.astype(jnp.float32), ik_f) * IDX_DIM ** -0.5
        score = jnp.einsum('bqhs,bqh->bqs', jax.nn.relu(idx_logits),
                           iwb.astype(jnp.float32) * IDX_HEADS ** -0.5)
        causal = key_pos[None, :] <= tb[:, None]
        score = jnp.where(causal[None], score, -jnp.inf)
        _, idx = lax.top_k(score, topk)
        valid = idx <= tb[None, :, None]
        k_sel = gather(k, idx)
        v_sel = gather(v, idx)
        logits = jnp.einsum('bqhd,bqkhd->bhqk', qb, k_sel).astype(jnp.float32) * A_HEAD_DIM ** -0.5
        dist = jnp.maximum(tb[None, :, None] - idx, 0)
        bias = rel_bias[t5_bucket(dist)]
        logits = logits + jnp.transpose(bias, (0, 3, 1, 2)).astype(jnp.float32)
        logits = jnp.where(valid[:, None], logits, -jnp.inf)
        p = jax.nn.softmax(logits, axis=-1).astype(v.dtype)
        return jnp.einsum('bhqk,bqkhd->bqhd', p, v_sel)

    out = lax.map(one_block, (blocks(q), blocks(iq), blocks(iw), q_pos))
    return out.swapaxes(0, 1).reshape(bsz, s_len, A_HEADS * A_HEAD_DIM)


def gla_chunked(q, k, v, log_a):
    bsz, s_len, h, dk = q.shape
    dv = v.shape[-1]
    nc = s_len // GLA_CHUNK

    def chunks(a):
        return a.reshape(bsz, nc, GLA_CHUNK, h, a.shape[-1]).transpose(1, 0, 3, 2, 4)

    tri = jnp.tril(jnp.ones((GLA_CHUNK, GLA_CHUNK), dtype=bool))

    def step(state, inp):
        qc, kc, vc, gc = inp
        b = jnp.cumsum(gc, axis=2)
        o_inter = jnp.einsum('bhcd,bhdv->bhcv', qc * jnp.exp(b), state)
        diff = b[:, :, :, None, :] - b[:, :, None, :, :]
        decay = jnp.exp(jnp.where(tri[None, None, :, :, None], diff, -jnp.inf))
        attn = jnp.einsum('bhtd,bhsd,bhtsd->bhts', qc, kc, decay)
        o_intra = jnp.einsum('bhts,bhsv->bhtv', attn, vc)
        b_last = b[:, :, -1:, :]
        state = (jnp.exp(b_last[:, :, 0, :])[..., None] * state
                 + jnp.einsum('bhsd,bhsv->bhdv', kc * jnp.exp(b_last - b), vc))
        return state, o_inter + o_intra

    init = jnp.zeros((bsz, h, dk, dv), jnp.float32)
    _, o = lax.scan(step, init, (chunks(q * dk ** -0.5), chunks(k), chunks(v), chunks(log_a)))
    return o.transpose(1, 0, 3, 2, 4).reshape(bsz, s_len, h, dv)


def hier_moe(h, w_rg, b_rg, w_re, b_re, w_g, w_u, w_d):
    bsz, s_len, d = h.shape
    hf = h.reshape(-1, d)
    g_logits = (hf @ w_rg).astype(jnp.float32) + b_rg.astype(jnp.float32)
    g_prob = jax.nn.softmax(g_logits, axis=-1)
    _, g_sel = lax.top_k(g_logits, 1)
    g_onehot = jax.nn.one_hot(g_sel[:, 0], N_GROUPS, dtype=jnp.float32)
    g_weight = jnp.sum(g_prob * g_onehot, axis=-1, keepdims=True)
    e_logits = ((hf @ w_re).astype(jnp.float32) + b_re.astype(jnp.float32)).reshape(-1, N_GROUPS, EXPERTS_PER_GROUP)
    e_logits_sel = jnp.einsum('nge,ng->ne', e_logits, g_onehot)
    top_val, top_idx = lax.top_k(e_logits_sel, EXPERT_TOPK)
    e_weight = jax.nn.softmax(top_val, axis=-1) * g_weight
    e_idx = g_sel * EXPERTS_PER_GROUP + top_idx
    gates = jnp.sum(jax.nn.one_hot(e_idx, N_EXPERTS, dtype=jnp.float32) * e_weight[..., None], axis=1)
    out = jnp.zeros(hf.shape, jnp.float32)
    for g in range(N_GROUPS):
        sl = slice(g * EXPERTS_PER_GROUP, (g + 1) * EXPERTS_PER_GROUP)
        a = jnp.einsum('nd,edf->nef', hf, w_g[sl])
        u = jnp.einsum('nd,edf->nef', hf, w_u[sl])
        hid = jax.nn.silu(a) * u * gates[:, sl, None].astype(hf.dtype)
        out = out + jnp.einsum('nef,efd->nd', hid, w_d[sl]).astype(jnp.float32)
    return out.astype(h.dtype).reshape(bsz, s_len, d)


def setup_inputs(seed: int = 0) -> dict:
    key = jax.random.key(seed)
    ks = jax.random.split(key, 20)
    f32 = jnp.float32
    nrm = lambda k, shape, scale: jax.random.normal(k, shape, f32) * scale
    return {
        "x": nrm(ks[0], (BATCH, SEQ, D_MODEL), 1.0),
        "norm1_g": 1.0 + nrm(ks[1], (DEPTH, D_MODEL), 0.01),
        "w_in": nrm(ks[2], (DEPTH, D_MODEL, PROJ_WIDTH), D_MODEL ** -0.5),
        "q_norm_g": 1.0 + nrm(ks[3], (DEPTH, A_HEAD_DIM), 0.01),
        "k_norm_g": 1.0 + nrm(ks[4], (DEPTH, A_HEAD_DIM), 0.01),
        "rel_bias": nrm(ks[5], (N_BUCKETS, A_HEADS), 0.5),
        "gla_gate_w2": nrm(ks[6], (DEPTH, GATE_RANK, B_KEY_WIDTH), GATE_RANK ** -0.5),
        "gla_gate_b": nrm(ks[7], (DEPTH, B_KEY_WIDTH), 0.1),
        "gla_out_norm_g": 1.0 + nrm(ks[8], (DEPTH, B_VAL_DIM), 0.01),
        "w_out": nrm(ks[9], (DEPTH, MIX_WIDTH, D_MODEL), MIX_WIDTH ** -0.5),
        "norm2_g": 1.0 + nrm(ks[10], (DEPTH, D_MODEL), 0.01),
        "w_router_group": nrm(ks[11], (DEPTH, D_MODEL, N_GROUPS), D_MODEL ** -0.5),
        "b_router_group": nrm(ks[12], (DEPTH, N_GROUPS), 0.01),
        "w_router_expert": nrm(ks[13], (DEPTH, D_MODEL, N_EXPERTS), D_MODEL ** -0.5),
        "b_router_expert": nrm(ks[14], (DEPTH, N_EXPERTS), 0.01),
        "w_exp_gate": nrm(ks[15], (DEPTH, N_EXPERTS, D_MODEL, D_EXPERT), D_MODEL ** -0.5),
        "w_exp_up": nrm(ks[16], (DEPTH, N_EXPERTS, D_MODEL, D_EXPERT), D_MODEL ** -0.5),
        "w_exp_down": nrm(ks[17], (DEPTH, N_EXPERTS, D_EXPERT, D_MODEL), D_EXPERT ** -0.5),
    }


def reference(x, norm1_g, w_in, q_norm_g, k_norm_g, rel_bias, gla_gate_w2, gla_gate_b,
              gla_out_norm_g, w_out, norm2_g, w_router_group, b_router_group,
              w_router_expert, b_router_expert, w_exp_gate, w_exp_up, w_exp_down):
    bsz, s_len, _ = x.shape
    split_points = np.cumsum(PROJ_SPLITS)[:-1].tolist()
    for l in range(DEPTH):
        h = rmsnorm(x, norm1_g[l])
        proj = h @ w_in[l]
        qa, ka, va, iq, ik, iw, qb, kb, vb, g_lr, r_gate = jnp.split(proj, split_points, axis=-1)

        qa = rmsnorm(qa.reshape(bsz, s_len, A_HEADS, A_HEAD_DIM), q_norm_g[l])
        ka = rmsnorm(ka.reshape(bsz, s_len, A_HEADS, A_HEAD_DIM), k_norm_g[l])
        va = va.reshape(bsz, s_len, A_HEADS, A_HEAD_DIM)
        o_a = dsa_attention(qa, ka, va, iq.reshape(bsz, s_len, IDX_HEADS, IDX_DIM), ik, iw, rel_bias)

        log_a = jax.nn.log_sigmoid((g_lr @ gla_gate_w2[l]).astype(jnp.float32)
                                   + gla_gate_b[l].astype(jnp.float32)) / GATE_TEMP
        o_b = gla_chunked(qb.reshape(bsz, s_len, B_HEADS, B_KEY_DIM).astype(jnp.float32),
                          kb.reshape(bsz, s_len, B_HEADS, B_KEY_DIM).astype(jnp.float32),
                          vb.reshape(bsz, s_len, B_HEADS, B_VAL_DIM).astype(jnp.float32),
                          log_a.reshape(bsz, s_len, B_HEADS, B_KEY_DIM))
        o_b = rmsnorm(o_b, gla_out_norm_g[l]).reshape(bsz, s_len, B_WIDTH).astype(x.dtype) * jax.nn.silu(r_gate)

        x = x + jnp.concatenate([o_a, o_b], axis=-1) @ w_out[l]

        x = x + hier_moe(rmsnorm(x, norm2_g[l]), w_router_group[l], b_router_group[l],
                         w_router_expert[l], b_router_expert[l],
                         w_exp_gate[l], w_exp_up[l], w_exp_down[l])
    return x
```

```cpp
#include <hip/hip_runtime.h>
#include <hip/hip_bf16.h>
#include <cstdio>
#include <cstdint>
#include <cmath>
namespace pg8 {
#define PG8_LAS __attribute__((address_space(3)))
typedef unsigned short bf16_t;
typedef short bf16x8 __attribute__((ext_vector_type(8)));
typedef float f32x4 __attribute__((ext_vector_type(4)));
typedef float f32x2 __attribute__((ext_vector_type(2)));
typedef unsigned u32x4 __attribute__((ext_vector_type(4)));
constexpr int BM = 256, BK = 64, HALF = 128, HTB = HALF * BK * 2  , STAGE_BYTES = 8 * HTB, NXCD = 8, WGM = 8;

__host__ __device__ __forceinline__ int lds_byte(int r, int c) { const int st = (r >> 4) * 2 + (c >> 5), rr = r & 15, cc = c & 31, ob = rr * 64 + cc * 2; return st * 1024 + (ob ^ (((ob >> 9) & 1) << 5)); }
__host__ __device__ __forceinline__ void stage_rc(int b, int& R, int& C) { const int st = b / 1024, sb = b % 1024, swz = sb ^ (((sb >> 9) & 1) << 5); R = (st >> 1) * 16 + swz / 64; C = (st & 1) * 32 + (swz % 64) / 2; }
__host__ __device__ __forceinline__ int perm32(int rho) { const int n = rho >> 4, i = rho & 15; return 8 * (i >> 2) + 4 * n + (i & 3); }

struct Unit { int pm, pn; unsigned bo; int e, nv, p0; };
struct Gemm { const bf16_t* A; const bf16_t* Bt; int K; };

struct StaticOrder {
    int nM, nN, nwg, G, c;
    __device__ void init(int M, int N, int G_, int c_) { nM = M / BM; nN = N / BM; nwg = nM * nN; G = G_; c = c_; }
    __device__ bool next(int i, Unit& u) const {
        const long L = (long)i * G + c; if (L >= nwg) return false;
        int wgid = (int)L; { const int q = nwg / NXCD, r = nwg % NXCD, xcd = wgid % NXCD, off = wgid / NXCD; wgid = (xcd < r ? xcd * (q + 1) : r * (q + 1) + (xcd - r) * q) + off; }
        const int nig = WGM * nN, gid = wgid / nig, fm = gid * WGM, gsz = (nM - fm) < WGM ? (nM - fm) : WGM;
        u.pm = fm + ((wgid % nig) % gsz); u.pn = (wgid % nig) / gsz; u.bo = 0u; u.e = 0; u.nv = BM; u.p0 = 0; return true;
    }
    __device__ __forceinline__ unsigned arow(const Unit& u, int r) const { return (unsigned)(u.pm * BM + r); }
};

__device__ __forceinline__ unsigned cvt_pk_bf16(float lo, float hi) { unsigned r; asm volatile("v_cvt_pk_bf16_f32 %0, %1, %2" : "=v"(r) : "v"(lo), "v"(hi)); return r; }

template <class Epi, class Sched, bool ALIGN_EPI = false>
__device__ __forceinline__ void gemm_phase(PG8_LAS unsigned char* lds, const Gemm g, const Sched& S, const Epi& E) {
    const int tid = threadIdx.x, wid = __builtin_amdgcn_readfirstlane(tid >> 6), lane = tid & 63, wr = wid >> 2, wc = wid & 3, fr = lane & 15, fq = lane >> 4;
    const int K = g.K, nt = K / BK;
    int RA[2], CA[2]; unsigned voffB[2];
#pragma unroll
    for (int i = 0; i < 2; ++i) { int R, C; stage_rc(tid * 16 + i * 8192, R, C); const int Rb = ((R & ~31) + perm32(R & 31));
        RA[i] = R; CA[i] = C; voffB[i] = (unsigned)(Rb * K + C) * 2u; }
    const size_t kstep = (size_t)(BK * 2);
    const size_t hstep = (size_t)HALF * K * 2;
    const size_t tstep = 2 * hstep;
    const unsigned ldsw = (unsigned)wid * 1024u;
    const int aoff = lds_byte(wr * 64 + fr, fq * 8), boff = lds_byte(wc * 32 + fr, fq * 8);
#define PG8_SA(b, h) (((b) * 2 + (h)) * HTB)
#define PG8_SB(b, h) ((4 + (b) * 2 + (h)) * HTB)
#define PG8_STAGE(bufoff, gbase, voff) do { _Pragma("unroll") for (int _i = 0; _i < 2; ++_i) \
        __builtin_amdgcn_global_load_lds((const unsigned*)((const char*)(gbase) + (voff)[_i]), (PG8_LAS unsigned*)(lds + (bufoff) + ldsw + _i * 8192), 16, 0, 0); } while (0)
#define PG8_LDA(dst, b, h) do { _Pragma("unroll") for (int m = 0; m < 4; ++m) _Pragma("unroll") for (int k = 0; k < 2; ++k) dst[m][k] = *(const PG8_LAS bf16x8*)(lds + PG8_SA(b, h) + aoff + m * 2048 + k * 1024); } while (0)
#define PG8_LDB(dst, b, h) do { _Pragma("unroll") for (int n = 0; n < 2; ++n) _Pragma("unroll") for (int k = 0; k < 2; ++k) dst[n][k] = *(const PG8_LAS bf16x8*)(lds + PG8_SB(b, h) + boff + n * 2048 + k * 1024); } while (0)
#define PG8_MMA(ai, bj, At, Bt) do { __builtin_amdgcn_s_setprio(1); _Pragma("unroll") for (int m = 0; m < 4; ++m) _Pragma("unroll") for (int n = 0; n < 2; ++n) _Pragma("unroll") for (int k = 0; k < 2; ++k) \
        acc[ai][bj][m][n] = __builtin_amdgcn_mfma_f32_16x16x32_bf16(Bt[n][k], At[m][k], acc[ai][bj][m][n], 0, 0, 0); __builtin_amdgcn_s_setprio(0); } while (0)
#define PG8_WAIT_V(n) asm volatile("s_waitcnt vmcnt(" #n ")" ::: "memory")
#define PG8_WAIT_L(n) asm volatile("s_waitcnt lgkmcnt(" #n ")" ::: "memory")
#define PG8_BAR __builtin_amdgcn_s_barrier()
#define PG8_SCHED __builtin_amdgcn_sched_barrier(0)
#define PG8_AOFF(AO, U) do { _Pragma("unroll") for (int _h = 0; _h < 2; ++_h) _Pragma("unroll") for (int _i = 0; _i < 2; ++_i) \
        AO[_h][_i] = (S.arow(U, _h * HALF + RA[_i]) * (unsigned)K + (unsigned)CA[_i]) * 2u; } while (0)
    Unit cur, nxt; int ui = 0;
    if (!S.next(0, cur)) return;
    f32x4 acc[2][2][4][2];
#pragma unroll
    for (int a = 0; a < 2; ++a)
#pragma unroll
        for (int b = 0; b < 2; ++b)
#pragma unroll
            for (int m = 0; m < 4; ++m)
#pragma unroll
                for (int n = 0; n < 2; ++n) acc[a][b][m][n] = (f32x4){0.f, 0.f, 0.f, 0.f};
    bf16x8 At[4][2], B0[2][2], B1[2][2];
    unsigned aoC[2][2], aoN[2][2];
    PG8_AOFF(aoC, cur);
    const char* const gA = (const char*)g.A;
    const char* cB = (const char*)g.Bt + (size_t)cur.bo + (size_t)cur.pn * tstep;
    {
        PG8_STAGE(PG8_SB(0, 0), cB, voffB); PG8_STAGE(PG8_SB(0, 1), cB + hstep, voffB); PG8_STAGE(PG8_SA(0, 0), gA, aoC[0]); PG8_STAGE(PG8_SA(0, 1), gA, aoC[1]);
        if (wr == 1) PG8_BAR;
        PG8_WAIT_V(2); PG8_BAR;
        PG8_STAGE(PG8_SB(1, 0), cB + kstep, voffB); PG8_STAGE(PG8_SA(1, 0), gA + kstep, aoC[0]); PG8_STAGE(PG8_SB(1, 1), cB + hstep + kstep, voffB);
        PG8_WAIT_V(6); PG8_BAR;
    }
    for (;;) {
        const bool has_next = S.next(ui + 1, nxt);
        if (has_next) { PG8_AOFF(aoN, nxt); } else {
#pragma unroll
            for (int _h = 0; _h < 2; ++_h)
#pragma unroll
                for (int _i = 0; _i < 2; ++_i) aoN[_h][_i] = aoC[_h][_i]; }
        const char* nB = has_next ? (const char*)g.Bt + (size_t)nxt.bo + (size_t)nxt.pn * tstep : cB;
        for (int t = 0; t < nt; t += 2) {
            const bool last = (t == nt - 2);
            const char* a1 = gA + (size_t)(t + 1) * kstep;
            const char* a2 = last ? gA : gA + (size_t)(t + 2) * kstep; const char* b2 = last ? nB : cB + (size_t)(t + 2) * kstep;
            const char* a3 = a2 + kstep; const char* b3 = b2 + kstep;
            unsigned ao2[2][2];
#pragma unroll
            for (int _h = 0; _h < 2; ++_h)
#pragma unroll
                for (int _i = 0; _i < 2; ++_i) ao2[_h][_i] = last ? aoN[_h][_i] : aoC[_h][_i];
            PG8_LDB(B0, 0, 0); PG8_LDB(B1, 0, 1); PG8_SCHED; PG8_LDA(At, 0, 0); PG8_STAGE(PG8_SA(1, 1), a1, aoC[1]);
            PG8_WAIT_V(8); PG8_WAIT_L(0); PG8_BAR; PG8_MMA(0, 0, At, B0); PG8_MMA(0, 1, At, B1); PG8_BAR; PG8_SCHED;
            PG8_LDA(At, 0, 1); PG8_STAGE(PG8_SB(0, 0), b2, voffB); PG8_STAGE(PG8_SB(0, 1), b2 + hstep, voffB); PG8_STAGE(PG8_SA(0, 0), a2, ao2[0]);
            PG8_WAIT_V(8); PG8_WAIT_L(0); PG8_BAR; PG8_MMA(1, 0, At, B0); PG8_MMA(1, 1, At, B1); PG8_BAR; PG8_SCHED;
            PG8_LDB(B0, 1, 0); PG8_LDB(B1, 1, 1); PG8_SCHED; PG8_LDA(At, 1, 0); PG8_STAGE(PG8_SA(0, 1), a2, ao2[1]);
            PG8_WAIT_V(8); PG8_WAIT_L(0); PG8_BAR; PG8_MMA(0, 0, At, B0); PG8_MMA(0, 1, At, B1); PG8_BAR; PG8_SCHED;
            PG8_LDA(At, 1, 1); PG8_STAGE(PG8_SB(1, 0), b3, voffB); PG8_STAGE(PG8_SB(1, 1), b3 + hstep, voffB); PG8_STAGE(PG8_SA(1, 0), a3, ao2[0]);
            PG8_WAIT_V(8); PG8_WAIT_L(0); PG8_BAR; PG8_MMA(1, 0, At, B0); PG8_MMA(1, 1, At, B1); PG8_BAR; PG8_SCHED;
        }
        if constexpr (ALIGN_EPI) { if (wr == 0) PG8_BAR; }
        E(acc, cur, wr, wc, fr, fq);
        if (!has_next) break;
#pragma unroll
        for (int a = 0; a < 2; ++a)
#pragma unroll
            for (int b = 0; b < 2; ++b)
#pragma unroll
                for (int m = 0; m < 4; ++m)
#pragma unroll
                    for (int n = 0; n < 2; ++n) acc[a][b][m][n] = (f32x4){0.f, 0.f, 0.f, 0.f};
        cur = nxt; cB = nB; ++ui;
#pragma unroll
        for (int _h = 0; _h < 2; ++_h)
#pragma unroll
            for (int _i = 0; _i < 2; ++_i) aoC[_h][_i] = aoN[_h][_i];
        if constexpr (ALIGN_EPI) { if (wr == 1) PG8_BAR; }
    }
    PG8_WAIT_V(0);
    if constexpr (!ALIGN_EPI) { if (wr == 0) PG8_BAR; }
    PG8_BAR;
#undef PG8_SA
#undef PG8_SB
#undef PG8_STAGE
#undef PG8_LDA
#undef PG8_LDB
#undef PG8_MMA
#undef PG8_WAIT_V
#undef PG8_WAIT_L
#undef PG8_BAR
#undef PG8_SCHED
#undef PG8_AOFF
}
}
namespace pg8 {
__device__ __forceinline__ u32x4 pack8(const f32x4 v0, const f32x4 v1) { u32x4 w; w.x = cvt_pk_bf16(v0[0], v0[1]); w.y = cvt_pk_bf16(v0[2], v0[3]); w.z = cvt_pk_bf16(v1[0], v1[1]); w.w = cvt_pk_bf16(v1[2], v1[3]); return w; }

struct EpiProj {
    const float* rstd1; const float* qg; const float* kg;
    bf16_t *QN, *KN, *VN, *IQ, *QB, *KB, *VB, *RG, *MISC;
    float qscale, eps;
    __device__ __forceinline__ void operator()(const f32x4 (&acc)[2][2][4][2], const Unit& u, int wr, int wc, int fr, int fq) const {
        const int row0 = u.pm * BM + wr * 64 + fr; const int pn = u.pn;
        if (pn < 4) {
            const bool isq = pn < 2; const float* gp = isq ? qg : kg; bf16_t* O = isq ? QN : KN; const float os = isq ? qscale : 1.f;
            f32x4 gv[2][2];
#pragma unroll
            for (int bj = 0; bj < 2; ++bj)
#pragma unroll
                for (int n = 0; n < 2; ++n) gv[bj][n] = *(const f32x4*)(gp + 32 * bj + 8 * fq + 4 * n) * os;
            const int hcol = (4 * (pn & 1) + wc) * 64 + 8 * fq;
#pragma unroll
            for (int ai = 0; ai < 2; ++ai)
#pragma unroll
                for (int m = 0; m < 4; ++m) { const int row = row0 + ai * HALF + m * 16; const float s = rstd1[row];
                    float ss = 0.f;
#pragma unroll
                    for (int bj = 0; bj < 2; ++bj)
#pragma unroll
                        for (int n = 0; n < 2; ++n) { const f32x4 x = acc[ai][bj][m][n]; ss += (x[0] * x[0] + x[1] * x[1]) + (x[2] * x[2] + x[3] * x[3]); }
                    ss += __shfl_xor(ss, 16); ss += __shfl_xor(ss, 32);
                    const float r = s * __builtin_amdgcn_rsqf(s * s * ss * (1.f / 64.f) + eps);
                    bf16_t* rowp = O + (size_t)row * 512 + hcol;
#pragma unroll
                    for (int bj = 0; bj < 2; ++bj) *(u32x4*)(rowp + 32 * bj) = pack8(acc[ai][bj][m][0] * r * gv[bj][0], acc[ai][bj][m][1] * r * gv[bj][1]); }
            return;
        }
        bf16_t* O; int pitch, coff, lim = 256;
        if (pn < 6) { O = VN; pitch = 512; coff = (pn - 4) * 256; }
        else if (pn == 6) { O = IQ; pitch = 256; coff = 0; }
        else if (pn == 7) { O = QB; pitch = 256; coff = 0; }
        else if (pn == 8) { O = KB; pitch = 256; coff = 0; }
        else if (pn < 11) { O = VB; pitch = 512; coff = (pn - 9) * 256; }
        else if (pn < 13) { O = RG; pitch = 512; coff = (pn - 11) * 256; }
        else { O = MISC; pitch = 64; coff = 0; lim = 56; }
        const int c0 = wc * 32 + 8 * fq;
#pragma unroll
        for (int ai = 0; ai < 2; ++ai)
#pragma unroll
            for (int m = 0; m < 4; ++m) { const int row = row0 + ai * HALF + m * 16; const float s = rstd1[row];
                bf16_t* rowp = O + (size_t)row * pitch + coff + c0;
#pragma unroll
                for (int bj = 0; bj < 2; ++bj) if (c0 + bj * HALF < lim) *(u32x4*)(rowp + bj * HALF) = pack8(acc[ai][bj][m][0] * s, acc[ai][bj][m][1] * s); }
    }
};

struct EpiOut {
    const float* x; bf16_t* XN2; float* ROWSS;
    __device__ __forceinline__ void operator()(const f32x4 (&acc)[2][2][4][2], const Unit& u, int wr, int wc, int fr, int fq) const {
        const int row0 = u.pm * BM + wr * 64 + fr; const int col0 = u.pn * BM + wc * 32 + 8 * fq;
#pragma unroll
        for (int ai = 0; ai < 2; ++ai)
#pragma unroll
            for (int m = 0; m < 4; ++m) { const int row = row0 + ai * HALF + m * 16; const size_t off = (size_t)row * 1024 + col0; float ss = 0.f;
#pragma unroll
                for (int bj = 0; bj < 2; ++bj) { const f32x4 a = *(const f32x4*)(x + off + bj * HALF) + acc[ai][bj][m][0], b = *(const f32x4*)(x + off + bj * HALF + 4) + acc[ai][bj][m][1];
                    ss += (a[0] * a[0] + a[1] * a[1]) + (a[2] * a[2] + a[3] * a[3]) + (b[0] * b[0] + b[1] * b[1]) + (b[2] * b[2] + b[3] * b[3]);
                    *(u32x4*)(XN2 + off + bj * HALF) = pack8(a, b); }
                ss += __shfl_xor(ss, 16); ss += __shfl_xor(ss, 32);
                if (fq == 0) ROWSS[(size_t)row * 16 + u.pn * 4 + wc] = ss; }
    }
};

struct EpiGU {
    const float* LSC; bf16_t* HID;
    __device__ __forceinline__ void operator()(const f32x4 (&acc)[2][2][4][2], const Unit& u, int wr, int wc, int fr, int fq) const {
        const int r0 = wr * 64 + fr; const int c0 = u.pn * HALF + wc * 32 + 8 * fq;
#pragma unroll
        for (int ai = 0; ai < 2; ++ai)
#pragma unroll
            for (int m = 0; m < 4; ++m) { const int r = r0 + ai * HALF + m * 16;
                f32x2 sw = (f32x2){0.f, 0.f};
                if (r < u.nv) sw = *(const f32x2*)(LSC + ((size_t)u.e * 16384 + (size_t)(u.p0 + r)) * 2);
                f32x4 h0, h1;
#pragma unroll
                for (int j = 0; j < 4; ++j) { const float a = acc[ai][0][m][0][j] * sw.x, uu = acc[ai][1][m][0][j] * sw.x; h0[j] = a * __builtin_amdgcn_rcpf(1.f + __expf(-a)) * uu * sw.y;
                                              const float a2 = acc[ai][0][m][1][j] * sw.x, u2 = acc[ai][1][m][1][j] * sw.x; h1[j] = a2 * __builtin_amdgcn_rcpf(1.f + __expf(-a2)) * u2 * sw.y; }
                *(u32x4*)(HID + (size_t)(u.pm * BM + r) * 256 + c0) = pack8(h0, h1); }
    }
};
struct EpiDown {
    bf16_t* Y;
    __device__ __forceinline__ void operator()(const f32x4 (&acc)[2][2][4][2], const Unit& u, int wr, int wc, int fr, int fq) const {
        const int r0 = u.pm * BM + wr * 64 + fr; const int c0 = u.pn * BM + wc * 32 + 8 * fq;
#pragma unroll
        for (int ai = 0; ai < 2; ++ai)
#pragma unroll
            for (int m = 0; m < 4; ++m) { bf16_t* rowp = Y + (size_t)(r0 + ai * HALF + m * 16) * 1024 + c0;
#pragma unroll
                for (int bj = 0; bj < 2; ++bj) *(u32x4*)(rowp + bj * HALF) = pack8(acc[ai][bj][m][0], acc[ai][bj][m][1]); }
    }
};
}
namespace attn_body {
using bf16=__hip_bfloat16;
using bf16x8=__attribute__((ext_vector_type(8)))short;
using s16x4=__attribute__((ext_vector_type(4)))short;
using f32x16=__attribute__((ext_vector_type(16)))float;
using u32x4=__attribute__((ext_vector_type(4)))unsigned;
constexpr int BATCH=8,NHEAD=8,SEQ=2048,D=64,DM=NHEAD*D,PO=1024;
constexpr int NW=8,QBLK=32,QB=QBLK*NW,KVBLK=64,NQB=SEQ/QB;
constexpr int ATTN_UNIT_ROWS=QB;
__device__ __forceinline__ int crow(int r,int hi){return (r&3)+8*(r>>2)+4*hi;}
#define SBAR() __builtin_amdgcn_sched_barrier(0)
typedef float f32x4a __attribute__((ext_vector_type(4)));
__device__ __forceinline__ void tbias(f32x16&p0,f32x16&p1,int t,int qpos,int hi,__attribute__((address_space(3))) const char* tabr){
  int base=qpos-64*t-4*hi; base=base<-4?-4:(base>200?200:base); const int a=200-base, s=a&3;
  const __attribute__((address_space(3))) f32x4a* tp=(const __attribute__((address_space(3))) f32x4a*)(tabr+s*1088+(a-s)*4);
  #pragma unroll
  for(int g=0;g<4;++g){ const f32x4a v0=tp[2*g], v1=tp[2*g+8];
    p0[4*g]+=v0[0];p0[4*g+1]+=v0[1];p0[4*g+2]+=v0[2];p0[4*g+3]+=v0[3]; p1[4*g]+=v1[0];p1[4*g+1]+=v1[1];p1[4*g+2]+=v1[2];p1[4*g+3]+=v1[3];
    asm volatile("":"+v"(p0),"+v"(p1)); }
}
__device__ __forceinline__ float mkeep(float v,unsigned mw,int bit){ const unsigned t=(unsigned)(((int)(mw<<(31-bit)))>>31); return __uint_as_float(__float_as_uint(v)&t); }
constexpr int NSLOT=3, SLOTB=8192;
constexpr int LDS_K=0, LDS_V=NSLOT*SLOTB, LDS_WS=2*NSLOT*SLOTB, LDS_OST=LDS_WS+NW*64*4, LDS_BYTES=LDS_OST+NW*4096, LDS_MSK=LDS_BYTES, LDS_TAB=LDS_MSK+65536, LDS_TOTAL=LDS_TAB+4352;
constexpr float C2=0.125f*1.4426950408889634f;
__device__ __forceinline__ void glds16(const void*gsrc,unsigned lds_dst){unsigned keep;
  asm volatile("s_mov_b32 %0, m0\n\ts_mov_b32 m0, %2\n\ts_nop 0\n\tglobal_load_lds_dwordx4 %1, off\n\ts_mov_b32 m0, %0":"=&s"(keep):"v"(gsrc),"s"(lds_dst):"memory");}
__device__ __forceinline__ float max3f(float a,float b,float c){float r;asm("v_max3_f32 %0, %1, %2, %3":"=v"(r):"v"(a),"v"(b),"v"(c));return r;}
__device__ __forceinline__ float max2f(float a,float b){float r;asm("v_max_f32_e32 %0, %1, %2":"=v"(r):"v"(a),"v"(b));return r;}
__device__ __forceinline__ float fadd_s(float a,float b){float r;asm("v_add_f32_e32 %0, %1, %2":"=v"(r):"v"(a),"v"(b));return r;}
__device__ __forceinline__ float fsub_s(float a,float b){float r;asm("v_sub_f32_e32 %0, %1, %2":"=v"(r):"v"(a),"v"(b));return r;}
typedef float f32x2_t __attribute__((ext_vector_type(2))); typedef __bf16 bf16x2_t __attribute__((ext_vector_type(2)));
__device__ __forceinline__ unsigned cvtpk_s(float lo,float hi){f32x2_t v={lo,hi};bf16x2_t b=__builtin_convertvector(v,bf16x2_t);return __builtin_bit_cast(unsigned,b);}
#define WAIT_BAR(N) asm volatile("s_waitcnt vmcnt(" #N ") lgkmcnt(0)\n\ts_barrier":::"memory")

__device__ __forceinline__ void qkt(f32x16&p0,f32x16&p1,const char*Kslot,const bf16x8*qr,const f32x16&negm,int r32,int hi){
  const char*kb=Kslot+hi*1024+r32*16;
  #pragma unroll
  for(int d0=0;d0<4;++d0){
    const bf16x8 b0=*reinterpret_cast<const bf16x8*>(kb+d0*2048);
    const bf16x8 b1=*reinterpret_cast<const bf16x8*>(kb+d0*2048+512);
    if(d0==0){p0=__builtin_amdgcn_mfma_f32_32x32x16_bf16(b0,qr[0],negm,0,0,0);p1=__builtin_amdgcn_mfma_f32_32x32x16_bf16(b1,qr[0],negm,0,0,0);}
    else{p0=__builtin_amdgcn_mfma_f32_32x32x16_bf16(b0,qr[d0],p0,0,0,0);p1=__builtin_amdgcn_mfma_f32_32x32x16_bf16(b1,qr[d0],p1,0,0,0);}}
}
typedef __attribute__((address_space(3))) const char* lds_cptr;
typedef short v4i16_t __attribute__((ext_vector_type(4)));
__device__ __forceinline__ void kload8(bf16x8*kf,lds_cptr kp){
  kf[0]=*(const __attribute__((address_space(3))) bf16x8*)(kp);      kf[1]=*(const __attribute__((address_space(3))) bf16x8*)(kp+512);
  kf[2]=*(const __attribute__((address_space(3))) bf16x8*)(kp+2048); kf[3]=*(const __attribute__((address_space(3))) bf16x8*)(kp+2560);
  kf[4]=*(const __attribute__((address_space(3))) bf16x8*)(kp+4096); kf[5]=*(const __attribute__((address_space(3))) bf16x8*)(kp+4608);
  kf[6]=*(const __attribute__((address_space(3))) bf16x8*)(kp+6144); kf[7]=*(const __attribute__((address_space(3))) bf16x8*)(kp+6656);
}
__device__ __forceinline__ void kload2(bf16x8*kf,lds_cptr kp,int j){ kf[2*j]=*(const __attribute__((address_space(3))) bf16x8*)(kp+j*2048); kf[2*j+1]=*(const __attribute__((address_space(3))) bf16x8*)(kp+j*2048+512); }
__device__ __forceinline__ s16x4 vtr(lds_cptr p){ return __builtin_bit_cast(s16x4,__builtin_amdgcn_ds_read_tr16_b64_v4i16((__attribute__((address_space(3))) v4i16_t*)p)); }
__device__ __forceinline__ float rowmax(const f32x16&p0,const f32x16&p1){
  float a=max3f(p0[0],p0[1],p1[0]),b=max3f(p0[2],p0[3],p1[1]);a=max3f(a,p1[2],p1[3]);
  #pragma unroll
  for(int r=4;r<16;r+=4){a=max3f(a,p0[r],p0[r+1]);b=max3f(b,p0[r+2],p0[r+3]);a=max3f(a,p1[r],p1[r+1]);b=max3f(b,p1[r+2],p1[r+3]);}
  const float m=max2f(a,b);
  auto rr=__builtin_amdgcn_permlane32_swap(__float_as_uint(m),__float_as_uint(m),false,false);
  return max2f(__uint_as_float(rr[0]),__uint_as_float(rr[1]));
}
__device__ __forceinline__ void pv(f32x16*o,int vb,bf16x8 pa0,bf16x8 pa1,bf16x8 pa2,bf16x8 pa3){
  #pragma unroll
  for(int d0=0;d0<2;++d0){s16x4 lo[4],hi[4];
    #pragma unroll
    for(int ks=0;ks<4;++ks){
      asm volatile("ds_read_b64_tr_b16 %0,%1 offset:%c2":"=&v"(lo[ks]):"v"(vb),"i"(d0*4096+ks*1024):"memory");
      asm volatile("ds_read_b64_tr_b16 %0,%1 offset:%c2":"=&v"(hi[ks]):"v"(vb),"i"(d0*4096+ks*1024+512):"memory");}
    asm volatile("s_waitcnt lgkmcnt(0)":::"memory");SBAR();
    #define PK(k) (bf16x8){lo[k][0],lo[k][1],lo[k][2],lo[k][3],hi[k][0],hi[k][1],hi[k][2],hi[k][3]}
    o[d0]=__builtin_amdgcn_mfma_f32_32x32x16_bf16(pa0,PK(0),o[d0],0,0,0);
    o[d0]=__builtin_amdgcn_mfma_f32_32x32x16_bf16(pa1,PK(1),o[d0],0,0,0);
    o[d0]=__builtin_amdgcn_mfma_f32_32x32x16_bf16(pa2,PK(2),o[d0],0,0,0);
    o[d0]=__builtin_amdgcn_mfma_f32_32x32x16_bf16(pa3,PK(3),o[d0],0,0,0);
    #undef PK
  }
}

#ifndef ATTN_STORE16
#define ATTN_STORE16(p,v) (*(u32x4*)(p)=(v))
#endif
template<int THRL> __device__ __forceinline__ void attn_unit(int b,int h,int qb,const bf16*Q,const bf16*__restrict__ K,const bf16*__restrict__ V,bf16*O,const unsigned*__restrict__ MASK,const float*__restrict__ relb,char*shm){
  int tid0_=threadIdx.x; asm volatile("":"+v"(tid0_));
  const int tid=tid0_,lane=tid&63,r32=lane&31,hi=lane>>5; const int wid=__builtin_amdgcn_readfirstlane(tid>>6);
  const long rowbase=(long)b*SEQ; const int q0=qb*QB;
  const bf16*Qw=Q+(rowbase+q0+wid*QBLK)*DM+h*D;
  const bf16*Kh=K+rowbase*DM+h*D,*Vh=V+rowbase*DM+h*D;
  const unsigned lds0=(unsigned)(uintptr_t)shm;
  float*wsf=(float*)(shm+LDS_WS)+wid*64;
  const bf16*ksrc=Kh+(long)lane*DM+wid*8;
  const bf16*vsrc=Vh+(long)(16*(wid&3)+(lane>>2))*DM+(wid>>2)*32+(lane&3)*8;
  const unsigned kdst=lds0+LDS_K+wid*1024, vdst=lds0+LDS_V+wid*1024;
  #define DMA_K(t,slot) glds16(ksrc+(long)(t)*KVBLK*DM,(unsigned)__builtin_amdgcn_readfirstlane(kdst+(slot)))
  #define DMA_V(t,slot) glds16(vsrc+(long)(t)*KVBLK*DM,(unsigned)__builtin_amdgcn_readfirstlane(vdst+(slot)))
  const int vb0=(int)(lds0+LDS_V)+((lane>>4)&1)*32+(lane&3)*8+(4*hi+((lane&15)>>2))*64;
  const char*Kbase=shm+LDS_K; bf16x8 kf[8];
  const lds_cptr shm3=(lds_cptr)shm; const lds_cptr kp0=shm3+LDS_K+hi*1024+r32*16; const lds_cptr vp0=shm3+LDS_V+((lane>>4)&1)*32+(lane&3)*8+(4*hi+((lane&15)>>2))*64;
  const int NT=(q0+QB)/KVBLK;
  { int tid_=tid; asm volatile("":"+v"(tid_));
    const u32x4*msrc=(const u32x4*)(MASK+((size_t)(b*32)*SEQ+q0)*2); u32x4*mdst=(u32x4*)(shm+LDS_MSK);
    u32x4 mv[8]; const int nit=NT>>2;
    _Pragma("unroll") for(int k=0;k<8;++k){ const int i=tid_+k*(NW*64); if(k<nit) mv[k]=msrc[(size_t)(i>>7)*(SEQ*2/4)+(i&127)]; }
    _Pragma("unroll") for(int k=0;k<8;++k){ const int i=tid_+k*(NW*64); if(k<nit) mdst[i]=mv[k]; }
    for(int i=tid_;i<4*272;i+=NW*64){ const int sft=i/272, k=i-sft*272, d=200-(k+sft); float v=0.f;
      if(d>=0&&d<=112){ int bk; if(d<16)bk=d; else { bk=16+(int)(logf((float)d*(1.0f/16.0f))/2.0794415416798357f*16.0f); bk=bk>31?31:bk; } v=(relb[bk*NHEAD+h]-relb[31*NHEAD+h])*1.4426950408889634f; }
      ((float*)(shm+LDS_TAB))[i]=v; } }
  const unsigned*mskw=(const unsigned*)(shm+LDS_MSK)+(wid*QBLK+r32)*2+hi;
  const int qpos=q0+wid*QBLK+r32;
  DMA_K(0,0);DMA_V(0,0);DMA_K(1,SLOTB);
  bf16x8 qr[4];
  #pragma unroll
  for(int d0=0;d0<4;++d0)qr[d0]=*reinterpret_cast<const bf16x8*>(&Qw[(long)r32*DM+d0*16+hi*8]);
  float mhat=0.f,l_reg=0.f;f32x16 o[2];o[0]=f32x16{};o[1]=f32x16{};f32x16 negm=f32x16{};asm volatile("":"+v"(negm));
  #define CMASK(P0,P1,t) do{ if((t)>=NT-7 && 64*(t)+63+127>=q0+wid*QBLK) tbias(P0,P1,(t),qpos,hi,shm3+LDS_TAB); }while(0)
  bool resc=false;
  #define START(P0,P1) do{ const float rm=rowmax(P0,P1); resc=false; \
    { const float dl=rm; mhat=fadd_s(mhat,dl); \
      _Pragma("unroll") for(int r=0;r<16;++r){P0[r]=fsub_s(P0[r],dl);P1[r]=fsub_s(P1[r],dl);} \
      _Pragma("unroll") for(int r=0;r<16;++r)negm[r]=-mhat; asm volatile("":"+v"(negm)); } \
    _Pragma("unroll") for(int r=0;r<16;++r)P0[r]=__builtin_amdgcn_exp2f(P0[r]); }while(0)
  #define RESC() do{ if(resc){ asm volatile("s_waitcnt lgkmcnt(0)":::"memory"); \
      _Pragma("unroll") for(int d_=0;d_<2;++d_) _Pragma("unroll") for(int r=0;r<16;++r)o[d_][r]*=wsf[crow(r,hi)]; } }while(0)
  f32x16 pA0,pA1,pB0,pB1;
  int sl_prev=0,sl_cur=0,sl_next=SLOTB;
  #define ROT() do{sl_prev=sl_cur;sl_cur=sl_next;sl_next=(sl_next==(NSLOT-1)*SLOTB)?0:sl_next+SLOTB;}while(0)
  DMA_K(2,2*SLOTB);
  WAIT_BAR(3);
  qkt(pA0,pA1,Kbase,qr,negm,r32,hi);asm volatile("s_nop 15\n\ts_nop 7":"+v"(pA0),"+v"(pA1));CMASK(pA0,pA1,0);
  START(pA0,pA1);
  _Pragma("unroll") for(int r=0;r<16;++r)pA1[r]=__builtin_amdgcn_exp2f(pA1[r]);
  { const unsigned mw0=mskw[0]; _Pragma("unroll") for(int r=0;r<16;++r){pA0[r]=mkeep(pA0[r],mw0,r);pA1[r]=mkeep(pA1[r],mw0,16+r);} }
  WAIT_BAR(0);
  DMA_K(3,0);DMA_V(1,SLOTB);
  ROT();
  kload8(kf,kp0+sl_cur);
  WAIT_BAR(2);
  s16x4 vlo[8],vhi[8]; u32x4 pw0,pw1,pw2,pw3;
  #define PKW(P,B) cvtpk_s(P[B],P[B+1])
  #define PAF(k) __builtin_bit_cast(bf16x8,pw##k)
  #define VFR(i) (bf16x8){vlo[i][0],vlo[i][1],vlo[i][2],vlo[i][3],vhi[i][0],vhi[i][1],vhi[i][2],vhi[i][3]}
  #define PIN(x) asm volatile("":"+v"(x))
  #define MX3(a,b,c) __builtin_fmaxf(__builtin_fmaxf((a),(b)),(c))
  #define GAPA(MF,A0,A1,A2,A3,W0,W1,PW) do{ MF; sacc+=A0; sacc+=A1; sacc+=A2; sacc+=A3; PIN(sacc); W0; W1; PIN(PW); SBAR(); }while(0)
  #define EX(v) __builtin_amdgcn_exp2f(v)
  #define GAPB(MF,X,B,MB) do{ MF; X[B]=mkeep(EX(X[B]),mw_,MB+B); X[B+1]=mkeep(EX(X[B+1]),mw_,MB+B+1); X[B+2]=mkeep(EX(X[B+2]),mw_,MB+B+2); X[B+3]=mkeep(EX(X[B+3]),mw_,MB+B+3); PIN(X); SBAR(); }while(0)
  #define VRD(i) do{ vlo[i]=vtr(vp_+(((i)>>2)*4096+((i)&3)*1024)); vhi[i]=vtr(vp_+(((i)>>2)*4096+((i)&3)*1024+512)); }while(0)
  #define KRD(G,j) do{ if(G){ kload2(kf,kp0+sl_next,j); SBAR(); } }while(0)
  #define STEP(C0,C1,P0,P1,t,GK,GV,GL) do{ SBAR(); \
    const lds_cptr vp_=vp0+sl_prev; const unsigned mw_=mskw[(t)*512]; \
    VRD(0); SBAR(); float sacc=(P0[0]+P0[1]); \
    GAPA(C0=__builtin_amdgcn_mfma_f32_32x32x16_bf16(kf[0],qr[0],negm,0,0,0), P0[2],P0[3],P0[4],P0[5],     pw0[0]=PKW(P0,0), pw0[1]=PKW(P0,2), pw0); \
    VRD(4); SBAR(); GAPA(C1=__builtin_amdgcn_mfma_f32_32x32x16_bf16(kf[1],qr[0],negm,0,0,0), P0[6],P0[7],P0[8],P0[9],     pw0[2]=PKW(P0,4), pw0[3]=PKW(P0,6), pw0); \
    VRD(1); SBAR(); GAPA(C0=__builtin_amdgcn_mfma_f32_32x32x16_bf16(kf[2],qr[1],C0,0,0,0),   P0[10],P0[11],P0[12],P0[13], pw1[0]=PKW(P0,8), pw1[1]=PKW(P0,10), pw1); \
    VRD(5); SBAR(); GAPA(C1=__builtin_amdgcn_mfma_f32_32x32x16_bf16(kf[3],qr[1],C1,0,0,0),   P0[14],P0[15],P1[0],P1[1],   pw1[2]=PKW(P0,12),pw1[3]=PKW(P0,14), pw1); \
    VRD(2); SBAR(); GAPA(C0=__builtin_amdgcn_mfma_f32_32x32x16_bf16(kf[4],qr[2],C0,0,0,0),   P1[2],P1[3],P1[4],P1[5],     pw2[0]=PKW(P1,0), pw2[1]=PKW(P1,2), pw2); \
    VRD(6); SBAR(); GAPA(C1=__builtin_amdgcn_mfma_f32_32x32x16_bf16(kf[5],qr[2],C1,0,0,0),   P1[6],P1[7],P1[8],P1[9],     pw2[2]=PKW(P1,4), pw2[3]=PKW(P1,6), pw2); \
    VRD(3); SBAR(); GAPA(C0=__builtin_amdgcn_mfma_f32_32x32x16_bf16(kf[6],qr[3],C0,0,0,0),   P1[10],P1[11],P1[12],P1[13], pw3[0]=PKW(P1,8), pw3[1]=PKW(P1,10), pw3); \
    VRD(7); SBAR(); GAPA(C1=__builtin_amdgcn_mfma_f32_32x32x16_bf16(kf[7],qr[3],C1,0,0,0),   P1[14],P1[15],0.f,0.f,       pw3[2]=PKW(P1,12),pw3[3]=PKW(P1,14), pw3); \
    l_reg+=sacc; \
    if(GK){DMA_K((t)+3,sl_cur);} if(GV){DMA_V((t)+1,sl_next);} \
    CMASK(C0,C1,t); \
    { float a=MX3(C0[0],C0[1],C1[0]),b=MX3(C0[2],C0[3],C1[1]); a=MX3(a,C1[2],C1[3]); \
      _Pragma("unroll") for(int r=4;r<16;r+=4){a=MX3(a,C0[r],C0[r+1]);b=MX3(b,C0[r+2],C0[r+3]);a=MX3(a,C1[r],C1[r+1]);b=MX3(b,C1[r+2],C1[r+3]);} \
      float rm=__builtin_fmaxf(a,b); { auto rr=__builtin_amdgcn_permlane32_swap(__float_as_uint(rm),__float_as_uint(rm),false,false); rm=__builtin_fmaxf(__uint_as_float(rr[0]),__uint_as_float(rr[1])); } \
      resc=false; \
      if(__builtin_expect(__any(rm>(float)THRL),0)){ const float dl=__builtin_fmaxf(rm,0.f); mhat+=dl; \
        _Pragma("unroll") for(int r=0;r<16;++r){C0[r]-=dl;C1[r]-=dl;} \
        _Pragma("unroll") for(int r=0;r<16;++r)negm[r]=-mhat; asm volatile("":"+v"(negm)); \
        const float f=__builtin_amdgcn_exp2f(-dl); l_reg*=f; if(hi==0)wsf[r32]=f; resc=true; } } \
    SBAR(); \
    GAPB(o[0]=__builtin_amdgcn_mfma_f32_32x32x16_bf16(PAF(0),VFR(0),o[0],0,0,0), C0,0,0); \
    GAPB(o[1]=__builtin_amdgcn_mfma_f32_32x32x16_bf16(PAF(0),VFR(4),o[1],0,0,0), C0,4,0); \
    KRD(GL,0); GAPB(o[0]=__builtin_amdgcn_mfma_f32_32x32x16_bf16(PAF(1),VFR(1),o[0],0,0,0), C0,8,0); \
    KRD(GL,1); GAPB(o[1]=__builtin_amdgcn_mfma_f32_32x32x16_bf16(PAF(1),VFR(5),o[1],0,0,0), C0,12,0); \
    KRD(GL,2); GAPB(o[0]=__builtin_amdgcn_mfma_f32_32x32x16_bf16(PAF(2),VFR(2),o[0],0,0,0), C1,0,16); \
    KRD(GL,3); GAPB(o[1]=__builtin_amdgcn_mfma_f32_32x32x16_bf16(PAF(2),VFR(6),o[1],0,0,0), C1,4,16); \
    GAPB(o[0]=__builtin_amdgcn_mfma_f32_32x32x16_bf16(PAF(3),VFR(3),o[0],0,0,0), C1,8,16); \
    GAPB(o[1]=__builtin_amdgcn_mfma_f32_32x32x16_bf16(PAF(3),VFR(7),o[1],0,0,0), C1,12,16); \
    }while(0)
  int t=1;
  #undef CMASK
  #define CMASK(P0,P1,t) do{}while(0)
  for(;t+7<NT;t+=2){
    STEP(pB0,pB1,pA0,pA1,t,true,true,true);     WAIT_BAR(2); RESC(); ROT();
    STEP(pA0,pA1,pB0,pB1,t+1,true,true,true);   WAIT_BAR(2); RESC(); ROT();
  }
  #undef CMASK
  #define CMASK(P0,P1,t) do{ if(64*(t)+63+127>=q0+wid*QBLK) tbias(P0,P1,(t),qpos,hi,shm3+LDS_TAB); }while(0)
  #define ENDW(tt) do{ if((tt)+3<NT){WAIT_BAR(2);} else if((tt)+2<NT){WAIT_BAR(1);} else {WAIT_BAR(0);} }while(0)
  for(;t+1<NT;t+=2){
    STEP(pB0,pB1,pA0,pA1,t,(t+3<NT),(t+1<NT),(t+1<NT));       ENDW(t);   RESC(); ROT();
    STEP(pA0,pA1,pB0,pB1,t+1,(t+4<NT),(t+2<NT),(t+2<NT));     ENDW(t+1); RESC(); ROT();
  }
  STEP(pB0,pB1,pA0,pA1,NT-1,false,false,false); RESC();
  { float sacc=pB0[0]+pB0[1]; _Pragma("unroll") for(int r=2;r<16;++r)sacc+=pB0[r]; _Pragma("unroll") for(int r=0;r<16;++r)sacc+=pB1[r]; l_reg+=sacc;
    pw0=(u32x4){PKW(pB0,0),PKW(pB0,2),PKW(pB0,4),PKW(pB0,6)};pw1=(u32x4){PKW(pB0,8),PKW(pB0,10),PKW(pB0,12),PKW(pB0,14)};pw2=(u32x4){PKW(pB1,0),PKW(pB1,2),PKW(pB1,4),PKW(pB1,6)};pw3=(u32x4){PKW(pB1,8),PKW(pB1,10),PKW(pB1,12),PKW(pB1,14)};
    SBAR(); pv(o,vb0+sl_cur,PAF(0),PAF(1),PAF(2),PAF(3)); }
  #undef PKW
  #undef PAF
  #undef VFR
  #undef PIN
  #undef MX3
  #undef GAPA
  #undef GAPB
  #undef EX
  #undef VRD
  #undef KRD
  #undef STEP
  #undef ENDW
  {auto rr=__builtin_amdgcn_permlane32_swap(__float_as_uint(l_reg),__float_as_uint(l_reg),false,false);l_reg=__uint_as_float(rr[0])+__uint_as_float(rr[1]);}
  if(hi==0)wsf[32+r32]=l_reg;asm volatile("s_waitcnt lgkmcnt(0)":::"memory");
  float rli[16];
  #pragma unroll
  for(int r=0;r<16;++r)rli[r]=__builtin_amdgcn_rcpf(wsf[32+crow(r,hi)]);
  bf16*Ow=O+(rowbase+q0+wid*QBLK)*PO+h*D;
  { bf16*stg=(bf16*)(shm+LDS_OST)+wid*2048;
    #pragma unroll
    for(int r=0;r<16;++r){const int orow=crow(r,hi);
      #pragma unroll
      for(int d0=0;d0<2;++d0)stg[orow*64+d0*32+r32]=__float2bfloat16(o[d0][r]*rli[r]);}
    asm volatile("s_waitcnt lgkmcnt(0)":::"memory");
    #pragma unroll
    for(int i=0;i<4;++i){const int row=i*8+(lane>>3),ch=lane&7; const u32x4 v=*(const u32x4*)(stg+row*64+ch*8); ATTN_STORE16(Ow+(long)row*PO+ch*8,v);} }
  asm volatile("s_waitcnt lgkmcnt(0)\n\ts_barrier":::"memory");
  #undef DMA_K
  #undef DMA_V
  #undef CMASK
  #undef START
  #undef RESC
  #undef ROT
}
struct AttnTensors { const bf16* Q; const bf16* K; const bf16* V; bf16* O; const unsigned* MASK; const float* relb; };
struct AttnUnit { int bh; int qb; };
constexpr int ATTN_LDS_BYTES=LDS_TOTAL;
#undef SBAR
#undef WAIT_BAR
}
constexpr int NWAVES = 8;
#ifndef MK_N_LAUNCHES
#define MK_N_LAUNCHES 1
#endif
constexpr int PER_PHASE = 10;
constexpr int N_LAUNCHES = (MK_N_LAUNCHES == 1) ? 1 : PER_PHASE;
constexpr int M = 8 * 2048;
constexpr size_t MiB = 1u << 20;
constexpr size_t WS_CTL = 0, CTL_ZERO_BYTES = 65536;
constexpr size_t WS_RSTD1 = 1 * MiB, WS_ROWSS = 2 * MiB, WS_WR = 3 * MiB, WS_BLAST = 3 * MiB + 512 * 1024, WS_TOKINFO = 4 * MiB, WS_LISTS = 5 * MiB, WS_LSC = 7 * MiB;
constexpr size_t WS_WO = 16 * MiB, WS_WGU = 18 * MiB, WS_WD = 50 * MiB, WS_XB = 66 * MiB, WS_MASK = 66 * MiB, WS_SB = 70 * MiB, WS_WIN = 98 * MiB;
constexpr size_t WS_QN = 106 * MiB, WS_KN = 122 * MiB, WS_VN = 138 * MiB, WS_XN2 = 106 * MiB, WS_IQ = 154 * MiB, WS_MISC = 162 * MiB, WS_QB = 164 * MiB, WS_KB = 172 * MiB, WS_VB = 180 * MiB, WS_RG = 196 * MiB;
constexpr size_t WS_MIX = 212 * MiB, WS_HID = 138 * MiB, WS_Y = 158 * MiB, WS_END = 244 * MiB;
constexpr int CW_TMO = 0, CW_CODE = 1, CW_BAR = 4096, CW_CNT = 8192;
constexpr int RING_BYTES = 154624;
constexpr int LDSCTL_OFF = RING_BYTES, MISC_OFF = LDSCTL_OFF, TOFF_OFF = LDSCTL_OFF + 256;
constexpr int LDS_BYTES = RING_BYTES + 1024;
static_assert(attn_body::ATTN_LDS_BYTES <= RING_BYTES, "attention LDS");
#define GAS __attribute__((address_space(1)))
#define LAS __attribute__((address_space(3)))
typedef unsigned short bf16;
typedef unsigned v4u __attribute__((ext_vector_type(4)));
typedef float f32x4 __attribute__((ext_vector_type(4)));
typedef short bf16x8 __attribute__((ext_vector_type(8)));
typedef GAS unsigned gu32;
typedef GAS unsigned long long gu64;
#define RLX_AGENT __ATOMIC_RELAXED, __HIP_MEMORY_SCOPE_AGENT
#define LDS_WAIT() asm volatile("s_waitcnt lgkmcnt(0)" ::: "memory")
#define VM_WAIT() asm volatile("s_waitcnt vmcnt(0)" ::: "memory")
__device__ __forceinline__ unsigned long long rt() { return __builtin_amdgcn_s_memrealtime(); }
__device__ __forceinline__ unsigned f2bf(float f) { unsigned u = __builtin_bit_cast(unsigned, f); return (u + 0x7fffu + ((u >> 16) & 1u)) >> 16; }
__device__ __forceinline__ unsigned pk2(float lo, float hi) { return f2bf(lo) | (f2bf(hi) << 16); }

#define XB_TMO      128
#define XB_XCNT(j)  (256  + 64 * (j))
#define XB_XSUB(j)  (1280 + 64 * (j))
#define XB_XGEN(j)  (2304 + 64 * (j))
#define XB_TOP      3328
#define XB_TOPGEN   3392
#define XCD_BAR_WORDS 3456
#define XB_SPIN_CAP (1u << 18)

__device__ __forceinline__ unsigned xb_ld(unsigned* p)              { return __hip_atomic_load(p, __ATOMIC_RELAXED, __HIP_MEMORY_SCOPE_AGENT); }
__device__ __forceinline__ unsigned xb_add(unsigned* p, unsigned v) { return __hip_atomic_fetch_add(p, v, __ATOMIC_RELAXED, __HIP_MEMORY_SCOPE_AGENT); }
__device__ __forceinline__ unsigned xb_xcc_id() { return (unsigned)__builtin_amdgcn_s_getreg((3 << 11) | 20) & 0xFu; }
#define XB_SPIN(cond, bar) do { unsigned _sp = 0; while (cond) { __builtin_amdgcn_s_sleep(1); \
    if ((++_sp & 255u) == 0u) { if (xb_ld(&(bar)[XB_TMO])) break; if (_sp > XB_SPIN_CAP) { atomicAdd(&(bar)[XB_TMO], 1u); break; } } } } while (0)

struct XcdBarrier {
    unsigned* bar; unsigned x;
    volatile LAS unsigned* st;
};

__device__ __forceinline__ XcdBarrier xcd_barrier_post(unsigned* bar, volatile LAS unsigned* st) {
    XcdBarrier b; b.bar = bar; b.x = xb_xcc_id(); b.st = st;
    if (threadIdx.x == 0) (void)xb_add(&bar[XB_XCNT(b.x)], 1u);
    return b;
}
__device__ __forceinline__ void xcd_barrier_complete(unsigned* bar, unsigned x, unsigned& nloc, unsigned& nx) {
    const unsigned G = gridDim.x * gridDim.y * gridDim.z;
    unsigned sum, cnt, mine, sp = 0u;
    for (;;) {
        sum = 0u; cnt = 0u; mine = 0u;
#pragma unroll
        for (unsigned j = 0; j < 16; ++j) { const unsigned c = xb_ld(&bar[XB_XCNT(j)]); sum += c; cnt += (c > 0u) ? 1u : 0u; mine = (j == x) ? c : mine; }
        if (sum == G) break;
        __builtin_amdgcn_s_sleep(1);
        if ((++sp & 255u) == 0u) { if (xb_ld(&bar[XB_TMO])) break; if (sp > XB_SPIN_CAP) { atomicAdd(&bar[XB_TMO], 1u); break; } }
    }
    nloc = mine > 0u ? mine : 1u; nx = cnt > 0u ? cnt : 1u;
}

__device__ __forceinline__ void xcd_barrier(const XcdBarrier& b) {
    asm volatile("s_waitcnt vmcnt(0)" ::: "memory");
    __syncthreads();
    if (threadIdx.x == 0) {
        unsigned* bar = b.bar;
        __builtin_amdgcn_s_waitcnt(0);
        unsigned nloc = b.st[0], nx = b.st[1];
        if (nloc == 0u) { xcd_barrier_complete(bar, b.x, nloc, nx); b.st[0] = nloc; b.st[1] = nx; }
        const unsigned old = xb_add(&bar[XB_XSUB(b.x)], 1u);
        const unsigned gen = old / nloc;
        if (old + 1u == (gen + 1u) * nloc) {
            __builtin_amdgcn_fence(__ATOMIC_RELEASE, "agent");
            asm volatile("s_waitcnt vmcnt(0)" ::: "memory");
            const unsigned og = xb_add(&bar[XB_TOP], 1u);
            const unsigned tg = og / nx;
            if (og + 1u == (tg + 1u) * nx) xb_add(&bar[XB_TOPGEN], 1u);
            else XB_SPIN(xb_ld(&bar[XB_TOPGEN]) == tg, bar);
            __builtin_amdgcn_fence(__ATOMIC_ACQUIRE, "agent");
            xb_add(&bar[XB_XGEN(b.x)], 1u);
            asm volatile("s_waitcnt vmcnt(0)" ::: "memory");
        } else {
            XB_SPIN(xb_ld(&bar[XB_XGEN(b.x)]) == gen, bar);
            __builtin_amdgcn_fence(__ATOMIC_ACQUIRE, "agent");
            asm volatile("s_waitcnt vmcnt(0)" ::: "memory");
        }
    }
    __syncthreads();
}
typedef float f32x2 __attribute__((ext_vector_type(2)));
typedef unsigned v2u __attribute__((ext_vector_type(2)));
__device__ __forceinline__ float bf2f(unsigned short b) { return __uint_as_float((unsigned)b << 16); }
__device__ __forceinline__ float bflo(unsigned w) { return __uint_as_float(w << 16); }
__device__ __forceinline__ float bfhi(unsigned w) { return __uint_as_float(w & 0xffff0000u); }
__device__ __forceinline__ float wave_sum(float v) {
#pragma unroll
    for (int o = 1; o < 64; o <<= 1) v += __shfl_xor(v, o);
    return v;
}
__device__ __forceinline__ float wave_max(float v) {
#pragma unroll
    for (int o = 1; o < 64; o <<= 1) v = fmaxf(v, __shfl_xor(v, o));
    return v;
}
__device__ __forceinline__ float wave_min(float v) {
#pragma unroll
    for (int o = 1; o < 64; o <<= 1) v = fminf(v, __shfl_xor(v, o));
    return v;
}
#define WG_SYNC() __syncthreads()

__device__ __forceinline__ int win_vrow(int n) {
    if (n < 1024) { const int base = (n < 512) ? 0 : 512, m = n - base, hh = m >> 6, d = m & 63; return base + 256 * (hh >> 2) + 128 * (d >> 5) + 32 * (hh & 3) + (d & 31); }
    if (n < 1792) return n;
    if (n < 1832) return 3328 + (n - 1792);
    if (n < 2088) return 1792 + (n - 1832);
    if (n < 2344) return 2048 + (n - 2088);
    if (n < 2856) return 2304 + (n - 2344);
    if (n < 2872) return 3328 + 40 + (n - 2856);
    return 2816 + (n - 2872);
}
template <int KIND>
__device__ __forceinline__ void p0_transpose_item(const float* __restrict__ W, int K, int N, const float* __restrict__ gain, bf16* WT, LAS float* scr, int item, int lane) {
    const int nblk = (N + 31) / 32, kb = item / nblk, nb = item % nblk, k0 = 64 * kb, n0 = 32 * nb;
    const int nn = n0 + (lane & 31); const bool ok = nn < N;
#pragma unroll 8
    for (int i = 0; i < 32; ++i) { const int kk = 2 * i + (lane >> 5); float v = ok ? W[(size_t)(k0 + kk) * N + nn] : 0.f; if (gain) v *= gain[k0 + kk]; scr[kk * 33 + (lane & 31)] = v; }
    LDS_WAIT(); asm volatile("" ::: "memory");
    const int c = lane & 7;
#pragma unroll
    for (int j = 0; j < 4; ++j) { const int n = (lane >> 3) + 8 * j; const LAS float* s = scr + (8 * c) * 33 + n;
        v4u o; o.x = pk2(s[0 * 33], s[1 * 33]); o.y = pk2(s[2 * 33], s[3 * 33]); o.z = pk2(s[4 * 33], s[5 * 33]); o.w = pk2(s[6 * 33], s[7 * 33]);
        const int gn = n0 + n; int row;
        if (KIND == 0) row = win_vrow(gn); else if (KIND == 1) row = gn; else if (KIND == 2) row = (gn >> 7) * 256 + (gn & 127); else row = (gn >> 7) * 256 + 128 + (gn & 127);
        if (gn < N) *(GAS v4u*)(WT + (size_t)row * K + k0 + 8 * c) = o; }
    LDS_WAIT(); asm volatile("" ::: "memory");
}

constexpr int SCP = 2064;
__device__ __forceinline__ int crow_(int r, int hi) { return (r & 3) + 8 * (r >> 2) + 4 * hi; }
__device__ __forceinline__ void idx_item(LAS unsigned char* lds, int b, int p, const bf16* __restrict__ IQ, const bf16* __restrict__ MISC, unsigned* __restrict__ MASK, int lane, int wid) {
    const int q0 = p * 16, fr = lane & 15, fq = lane >> 4;
    LAS float* SC = (LAS float*)lds;
    const size_t rowq = (size_t)b * 2048 + q0 + fr;
    bf16x8 Bq[8]; float sinf[8];
    {   const v4u wraw = *(const v4u*)(MISC + rowq * 64 + 32);
        const unsigned wr_[4] = {wraw.x, wraw.y, wraw.z, wraw.w};
#pragma unroll
        for (int h = 0; h < 8; ++h) { const float w = ((h & 1) ? bfhi(wr_[h >> 1]) : bflo(wr_[h >> 1])) * 0.0625f;
            const v4u raw = *(const v4u*)(IQ + rowq * 256 + h * 32 + fq * 8);
            v4u o; o.x = pk2(bflo(raw.x) * w, bfhi(raw.x) * w); o.y = pk2(bflo(raw.y) * w, bfhi(raw.y) * w); o.z = pk2(bflo(raw.z) * w, bfhi(raw.z) * w); o.w = pk2(bflo(raw.w) * w, bfhi(raw.w) * w);
            Bq[h] = __builtin_bit_cast(bf16x8, o); sinf[h] = (w > 0.f) ? __builtin_inff() : -__builtin_inff(); } }
    const int nkt = p + 1;
    const bf16* ikb = MISC + ((size_t)b * 2048 + fr) * 64 + fq * 8;
    for (int kt0 = wid; kt0 < nkt; kt0 += 32) {
        f32x4 acc[4]; bf16x8 A[4];
#pragma unroll
        for (int u = 0; u < 4; ++u) { const int kt = kt0 + 8 * u; acc[u] = (f32x4){0.f, 0.f, 0.f, 0.f}; if (kt < nkt) A[u] = *(const bf16x8*)(ikb + (size_t)kt * 16 * 64); else A[u] = (bf16x8){0, 0, 0, 0, 0, 0, 0, 0}; }
#pragma unroll
        for (int h = 0; h < 8; ++h)
#pragma unroll
            for (int u = 0; u < 4; ++u) { const f32x4 t = __builtin_amdgcn_mfma_f32_16x16x32_bf16(A[u], Bq[h], acc[u], 0, 0, 0);
#pragma unroll
                for (int i = 0; i < 4; ++i) acc[u][i] = __builtin_amdgcn_fmed3f(t[i], acc[u][i], sinf[h]); }
#pragma unroll
        for (int u = 0; u < 4; ++u) { const int kt = kt0 + 8 * u;
            if (kt < nkt) { if (kt == nkt - 1) {
#pragma unroll
                    for (int i = 0; i < 4; ++i) if (4 * fq + i > fr) acc[u][i] = -__builtin_inff(); }
                *(LAS f32x4*)(SC + fr * SCP + kt * 16 + 4 * fq) = acc[u]; } }
    }
    WG_SYNC();
    const int kap = 32 * ((lane >> 4) & 1) + crow_(lane & 15, lane >> 5);
    for (int rr = 0; rr < 2; ++rr) {
        const int r = 2 * wid + rr, q = q0 + r, n = q + 1;
        float x[32];
#pragma unroll
        for (int j = 0; j < 32; ++j) { const int idx = 64 * j + kap; x[j] = (idx <= q) ? SC[r * SCP + idx] : -__builtin_inff(); }
        unsigned selm = 0u;
        if (n <= 256) {
#pragma unroll
            for (int j = 0; j < 32; ++j) selm |= ((64 * j + kap) <= q) ? (1u << j) : 0u;
        } else {
            float mx = x[0], mn = (kap <= q) ? x[0] : __builtin_inff();
#pragma unroll
            for (int j = 1; j < 32; ++j) { mx = fmaxf(mx, x[j]); mn = fminf(mn, ((64 * j + kap) <= q) ? x[j] : __builtin_inff()); }
            float hi = wave_max(mx), lo = wave_min(mn);
            int c_hi = 0;
#pragma unroll
            for (int j = 0; j < 32; ++j) c_hi += __builtin_popcountll(__ballot(x[j] >= hi));
            bool tie = false; float tieval = hi, thr = hi;
            if (c_hi >= 256) { tie = true; tieval = hi; c_hi = 0; }
            else {
                for (int it = 0; it < 200; ++it) {
                    const float mid = 0.5f * lo + 0.5f * hi;
                    if (!(mid > lo && mid < hi)) { tie = true; tieval = lo; break; }
                    int c = 0;
#pragma unroll
                    for (int j = 0; j < 32; ++j) c += __builtin_popcountll(__ballot(x[j] >= mid));
                    if (c == 256) { thr = mid; break; }
                    if (c > 256) lo = mid; else { hi = mid; c_hi = c; }
                }
            }
            if (!tie) {
#pragma unroll
                for (int j = 0; j < 32; ++j) selm |= (x[j] >= thr) ? (1u << j) : 0u;
            } else {
                const int need = 256 - c_hi;
                int L = 0, H = q;
                while (L < H) { const int mid = (L + H) >> 1; int c = 0;
#pragma unroll
                    for (int j = 0; j < 32; ++j) c += __builtin_popcountll(__ballot(x[j] == tieval && (64 * j + kap) <= mid));
                    if (c >= need) H = mid; else L = mid + 1; }
#pragma unroll
                for (int j = 0; j < 32; ++j) selm |= (x[j] > tieval || (x[j] == tieval && (64 * j + kap) <= L)) ? (1u << j) : 0u;
            }
        }
        unsigned wlo = 0u, whi = 0u;
#pragma unroll
        for (int j = 0; j < 32; ++j) { const unsigned long long bal = __ballot((selm >> j) & 1u); if (lane == j) { wlo = (unsigned)bal; whi = (unsigned)(bal >> 32); } }
        if (lane < 32) { v2u o; o.x = wlo; o.y = whi; *(v2u*)(MASK + (((size_t)(b * 32 + lane)) * 2048 + q) * 2) = o; }
    }
    WG_SYNC();
}

constexpr int KTP = 72;
constexpr int GL_OFF = 0, TOT_OFF = 4096, SSQ_OFF = 6144, QA_OFF = 8192, KR_OFF = 17408, KT_OFF = 26624, PM_OFF = 35840, VT_OFF = 45056;
__device__ __forceinline__ void gla_decay(LAS unsigned char* lds, const bf16* __restrict__ MISC, const float* __restrict__ w2, const float* __restrict__ gb, size_t row0, int h, int tid, float (&bc)[8], float& blast) {
    LAS float* GL = (LAS float*)(lds + GL_OFF); LAS float* TOT = (LAS float*)(lds + TOT_OFF);
    const int d = tid & 63, tg = tid >> 6;
    { const int t = tid >> 3, r2 = (tid & 7) * 2; const unsigned w = *(const unsigned*)(MISC + (row0 + t) * 64 + 40 + r2); GL[t * 16 + r2] = bflo(w); GL[t * 16 + r2 + 1] = bfhi(w); }
    float wc[16];
#pragma unroll
    for (int r = 0; r < 16; ++r) wc[r] = w2[r * 256 + h * 64 + d];
    const float bias = gb[h * 64 + d];
    WG_SYNC();
    float run = 0.f;
#pragma unroll
    for (int i = 0; i < 8; ++i) { const int t = 8 * tg + i; float z = bias;
#pragma unroll
        for (int r4 = 0; r4 < 4; ++r4) { const f32x4 g = *(const LAS f32x4*)(GL + t * 16 + 4 * r4); z += g[0] * wc[4 * r4] + g[1] * wc[4 * r4 + 1] + g[2] * wc[4 * r4 + 2] + g[3] * wc[4 * r4 + 3]; }
        const float ls = fminf(z, 0.f) - log1pf(expf(-fabsf(z)));
        run += ls * (1.0f / 16.0f); bc[i] = run; }
    TOT[tg * 64 + d] = run;
    WG_SYNC();
    float pre = 0.f, tot = 0.f;
#pragma unroll
    for (int g = 0; g < 8; ++g) { const float v = TOT[g * 64 + d]; tot += v; if (g < tg) pre += v; }
#pragma unroll
    for (int i = 0; i < 8; ++i) bc[i] += pre;
    blast = tot;
}
__device__ __forceinline__ void gla_load_vt(LAS unsigned char* lds, const bf16* __restrict__ VB, size_t row0, int h, int tid) {
    LAS bf16* VT = (LAS bf16*)(lds + VT_OFF); const int v = tid & 127, tq = tid >> 7;
#pragma unroll
    for (int i = 0; i < 16; ++i) { const int t = 16 * tq + i; VT[v * KTP + t] = VB[(row0 + t) * 512 + h * 128 + v]; }
}
__device__ __forceinline__ void gla_a_item(LAS unsigned char* lds, int id, const bf16* __restrict__ KB, const bf16* __restrict__ VB, const bf16* __restrict__ MISC, const float* __restrict__ w2, const float* __restrict__ gb,
                                           float* __restrict__ U, float* __restrict__ BLAST, int tid, int lane, int wid) {
    const int b = id >> 7, h = (id >> 5) & 3, c = id & 31; const size_t row0 = (size_t)b * 2048 + 64 * c;
    float bc[8], blast; gla_decay(lds, MISC, w2, gb, row0, h, tid, bc, blast);
    const int d = tid & 63, tg = tid >> 6; LAS bf16* KT = (LAS bf16*)(lds + KT_OFF);
#pragma unroll
    for (int i = 0; i < 8; ++i) { const int t = 8 * tg + i; const float kv = bf2f(KB[(row0 + t) * 256 + h * 64 + d]) * expf(blast - bc[i]); KT[d * KTP + t] = (bf16)f2bf(kv); }
    gla_load_vt(lds, VB, row0, h, tid);
    if (tg == 0) BLAST[(size_t)id * 64 + d] = blast;
    WG_SYNC();
    const int fr = lane & 15, fq = lane >> 4; LAS bf16* VT = (LAS bf16*)(lds + VT_OFF);
    bf16x8 Bf[2];
#pragma unroll
    for (int kk = 0; kk < 2; ++kk) Bf[kk] = *(const LAS bf16x8*)(VT + (16 * wid + fr) * KTP + 32 * kk + 8 * fq);
#pragma unroll
    for (int dt = 0; dt < 4; ++dt) { f32x4 acc = (f32x4){0.f, 0.f, 0.f, 0.f};
#pragma unroll
        for (int kk = 0; kk < 2; ++kk) { const bf16x8 Af = *(const LAS bf16x8*)(KT + (16 * dt + fr) * KTP + 32 * kk + 8 * fq); acc = __builtin_amdgcn_mfma_f32_16x16x32_bf16(Af, Bf[kk], acc, 0, 0, 0); }
        *(f32x4*)(U + ((size_t)id * 128 + 16 * wid + fr) * 64 + 16 * dt + 4 * fq) = acc; }
    WG_SYNC();
}
__device__ __forceinline__ void gla_b_item(int bh, const float* __restrict__ U, const float* __restrict__ BLAST, bf16* __restrict__ SB, int tid) {
    f32x4 S[4];
#pragma unroll
    for (int j = 0; j < 4; ++j) S[j] = (f32x4){0.f, 0.f, 0.f, 0.f};
    const int d0 = (tid * 4) & 63;
#pragma unroll 4
    for (int c = 0; c < 32; ++c) { const size_t id = (size_t)bh * 32 + c;
        const f32x4 bl = *(const f32x4*)(BLAST + id * 64 + d0); f32x4 e; e[0] = expf(bl[0]); e[1] = expf(bl[1]); e[2] = expf(bl[2]); e[3] = expf(bl[3]);
#pragma unroll
        for (int j = 0; j < 4; ++j) { const size_t off = id * 8192 + (size_t)tid * 4 + 2048 * j; const f32x4 u = *(const f32x4*)(U + off);
            const f32x4 sd = S[j] * e; v2u o; o.x = pk2(sd[0], sd[1]); o.y = pk2(sd[2], sd[3]); *(v2u*)(SB + off) = o; S[j] = sd + u; } }
}
__device__ __forceinline__ void gla_c_item(LAS unsigned char* lds, int id, const bf16* __restrict__ QB, const bf16* __restrict__ KB, const bf16* __restrict__ VB, const bf16* __restrict__ RG, const bf16* __restrict__ MISC,
                                           const float* __restrict__ w2, const float* __restrict__ gb, const float* __restrict__ og, const bf16* __restrict__ SB, bf16* __restrict__ MIX, int tid, int lane, int wid) {
    const int b = id >> 7, h = (id >> 5) & 3, c = id & 31; const size_t row0 = (size_t)b * 2048 + 64 * c;
    float bc[8], blast; gla_decay(lds, MISC, w2, gb, row0, h, tid, bc, blast);
    const int d = tid & 63, tg = tid >> 6;
    LAS bf16* QA = (LAS bf16*)(lds + QA_OFF); LAS bf16* KR = (LAS bf16*)(lds + KR_OFF); LAS bf16* PM = (LAS bf16*)(lds + PM_OFF); LAS bf16* VT = (LAS bf16*)(lds + VT_OFF); LAS float* SSQ = (LAS float*)(lds + SSQ_OFF);
#pragma unroll
    for (int i = 0; i < 8; ++i) { const int t = 8 * tg + i; const float e = expf(blast - bc[i]);
        const float kv = bf2f(KB[(row0 + t) * 256 + h * 64 + d]) * e; const float qv = bf2f(QB[(row0 + t) * 256 + h * 64 + d]) * 0.125f / e;
        KR[t * KTP + d] = (bf16)f2bf(kv); QA[t * KTP + d] = (bf16)f2bf(qv); }
    gla_load_vt(lds, VB, row0, h, tid);
    WG_SYNC();
    const int fr = lane & 15, fq = lane >> 4;
    { const int tt = wid >> 1;
#pragma unroll
      for (int s2 = 0; s2 < 2; ++s2) { const int st = 2 * (wid & 1) + s2; f32x4 acc = (f32x4){0.f, 0.f, 0.f, 0.f};
        if (st <= tt) {
#pragma unroll
            for (int kk = 0; kk < 2; ++kk) { const bf16x8 Af = *(const LAS bf16x8*)(QA + (16 * tt + fr) * KTP + 32 * kk + 8 * fq); const bf16x8 Bf = *(const LAS bf16x8*)(KR + (16 * st + fr) * KTP + 32 * kk + 8 * fq);
                acc = __builtin_amdgcn_mfma_f32_16x16x32_bf16(Af, Bf, acc, 0, 0, 0); } }
#pragma unroll
        for (int i = 0; i < 4; ++i) { const int t = 16 * tt + 4 * fq + i, s = 16 * st + fr; PM[t * KTP + s] = (bf16)f2bf((s <= t) ? acc[i] : 0.f); } } }
    WG_SYNC();
    bf16x8 Bv[2], Bs[2];
    const bf16* sbp = SB + ((size_t)id * 128 + 16 * wid + fr) * 64 + 8 * fq;
#pragma unroll
    for (int kk = 0; kk < 2; ++kk) { Bv[kk] = *(const LAS bf16x8*)(VT + (16 * wid + fr) * KTP + 32 * kk + 8 * fq); Bs[kk] = *(const bf16x8*)(sbp + 32 * kk); }
    f32x4 o[4];
#pragma unroll
    for (int tt = 0; tt < 4; ++tt) { f32x4 acc = (f32x4){0.f, 0.f, 0.f, 0.f};
#pragma unroll
        for (int kk = 0; kk < 2; ++kk) { const bf16x8 Ap = *(const LAS bf16x8*)(PM + (16 * tt + fr) * KTP + 32 * kk + 8 * fq); acc = __builtin_amdgcn_mfma_f32_16x16x32_bf16(Ap, Bv[kk], acc, 0, 0, 0);
                                         const bf16x8 Aq = *(const LAS bf16x8*)(QA + (16 * tt + fr) * KTP + 32 * kk + 8 * fq); acc = __builtin_amdgcn_mfma_f32_16x16x32_bf16(Aq, Bs[kk], acc, 0, 0, 0); }
        o[tt] = acc;
#pragma unroll
        for (int i = 0; i < 4; ++i) { float s = acc[i] * acc[i]; s += __shfl_xor(s, 1); s += __shfl_xor(s, 2); s += __shfl_xor(s, 4); s += __shfl_xor(s, 8); if (fr == 0) SSQ[wid * 64 + 16 * tt + 4 * fq + i] = s; } }
    WG_SYNC();
    const int v = 16 * wid + fr; const float gv = og[v];
#pragma unroll
    for (int tt = 0; tt < 4; ++tt)
#pragma unroll
        for (int i = 0; i < 4; ++i) { const int t = 16 * tt + 4 * fq + i; float tot = 0.f;
#pragma unroll
            for (int w = 0; w < 8; ++w) tot += SSQ[w * 64 + t];
            const float rs = 1.0f / sqrtf(tot * (1.0f / 128.0f) + 1e-6f);
            const float r = bf2f(RG[(row0 + t) * 512 + h * 128 + v]); const float sg = r / (1.0f + expf(-r));
            MIX[(row0 + t) * 1024 + 512 + h * 128 + v] = (bf16)f2bf(o[tt][i] * rs * gv * sg); }
    WG_SYNC();
}

constexpr int WRP = 1032;
constexpr int WR_LDS_BYTES = 48 * WRP * 2;
__device__ __forceinline__ void router_tile(LAS unsigned char* lds, int tile, const bf16* __restrict__ XN2, const float* __restrict__ ROWSS, const float* __restrict__ brg, const float* __restrict__ bre,
                                            unsigned* __restrict__ CNT, int* __restrict__ LISTS, float* __restrict__ LSC, int* __restrict__ TOKINFO, int tid, int lane, int wid) {
    LAS bf16* WR = (LAS bf16*)lds; LAS float* LG = (LAS float*)(lds + WR_LDS_BYTES); LAS unsigned* CL = (LAS unsigned*)(lds + WR_LDS_BYTES + 12288); LAS unsigned* BS = CL + 32;
    if (tid < 32) CL[tid] = 0u;
    const int fr = lane & 15, fq = lane >> 4;
    if (wid < 4) {
        const size_t row = (size_t)tile * 64 + 16 * wid + fr; const bf16* ap = XN2 + row * 1024 + 8 * fq;
        f32x4 acc[3];
#pragma unroll
        for (int nt = 0; nt < 3; ++nt) acc[nt] = (f32x4){0.f, 0.f, 0.f, 0.f};
#pragma unroll 8
        for (int kk = 0; kk < 32; ++kk) { const bf16x8 Af = *(const bf16x8*)(ap + 32 * kk);
#pragma unroll
            for (int nt = 0; nt < 3; ++nt) { const bf16x8 Bf = *(const LAS bf16x8*)(WR + (16 * nt + fr) * WRP + 32 * kk + 8 * fq); acc[nt] = __builtin_amdgcn_mfma_f32_16x16x32_bf16(Af, Bf, acc[nt], 0, 0, 0); } }
#pragma unroll
        for (int nt = 0; nt < 3; ++nt)
#pragma unroll
            for (int i = 0; i < 4; ++i) LG[(wid * 16 + 4 * fq + i) * 48 + 16 * nt + fr] = acc[nt][i];
    }
    WG_SYNC();
    int e_[2] = {0, 0}; unsigned lp[2] = {0u, 0u}; float wk[2] = {0.f, 0.f}; float rstd2 = 0.f; const bool act = (wid < 4) && (lane < 16);
    const int token = tile * 64 + 16 * wid + lane;
    if (act) {
        const LAS float* lg = LG + (wid * 16 + lane) * 48; float ss = 0.f;
#pragma unroll
        for (int j = 0; j < 16; ++j) ss += ROWSS[(size_t)token * 16 + j];
        rstd2 = 1.0f / sqrtf(ss * (1.0f / 1024.0f) + 1e-6f);
        float gl[4]; int gs = 0;
#pragma unroll
        for (int j = 0; j < 4; ++j) gl[j] = lg[j] * rstd2 + brg[j];
#pragma unroll
        for (int j = 1; j < 4; ++j) if (gl[j] > gl[gs]) gs = j;
        float den = 0.f;
#pragma unroll
        for (int j = 0; j < 4; ++j) den += expf(gl[j] - gl[gs]);
        const float gw = 1.0f / den;
        float el[8];
#pragma unroll
        for (int j = 0; j < 8; ++j) el[j] = lg[4 + gs * 8 + j] * rstd2 + bre[gs * 8 + j];
        int i0 = 0;
#pragma unroll
        for (int j = 1; j < 8; ++j) if (el[j] > el[i0]) i0 = j;
        int i1 = (i0 == 0) ? 1 : 0;
#pragma unroll
        for (int j = 0; j < 8; ++j) if (j != i0 && j != i1 && el[j] > el[i1]) i1 = j;
        const float ex = expf(el[i1] - el[i0]); const float w0 = 1.0f / (1.0f + ex);
        wk[0] = w0 * gw; wk[1] = ex * w0 * gw; e_[0] = gs * 8 + i0; e_[1] = gs * 8 + i1;
        lp[0] = atomicAdd((unsigned*)(CL + e_[0]), 1u); lp[1] = atomicAdd((unsigned*)(CL + e_[1]), 1u);
    }
    WG_SYNC();
    if (tid < 32) { const unsigned n = CL[tid]; BS[tid] = n ? __hip_atomic_fetch_add(CNT + tid, n, __ATOMIC_RELAXED, __HIP_MEMORY_SCOPE_AGENT) : 0u; }
    WG_SYNC();
    if (act) {
#pragma unroll
        for (int k = 0; k < 2; ++k) { const unsigned pos = BS[e_[k]] + lp[k]; LISTS[(size_t)e_[k] * 16384 + pos] = token; *(f32x2*)(LSC + ((size_t)e_[k] * 16384 + pos) * 2) = (f32x2){rstd2, wk[k]};
            TOKINFO[(size_t)token * 4 + 2 * k] = e_[k]; TOKINFO[(size_t)token * 4 + 2 * k + 1] = (int)pos; }
    }
    WG_SYNC();
}

template <bool GATHER> struct GroupOrder {
    const LAS int* TOFF; const LAS int* CNTL; const int* LISTS; int NPN, G, c; unsigned bstride;
    __device__ bool next(int i, pg8::Unit& u) const {
        const int L = i * G + c; const int ntile = TOFF[32]; if (L >= ntile * NPN) return false;
        const int T = L / NPN; int e = 0;
#pragma unroll
        for (int s = 16; s >= 1; s >>= 1) if (TOFF[e + s] <= T) e += s;
        u.pm = T; u.pn = L - T * NPN; u.e = e; u.p0 = (T - TOFF[e]) * 256; const int rem = CNTL[e] - u.p0; u.nv = rem < 256 ? rem : 256; u.bo = (unsigned)e * bstride; return true;
    }
    __device__ __forceinline__ unsigned arow(const pg8::Unit& u, int r) const {
        if (GATHER) return (unsigned)LISTS[(size_t)u.e * 16384 + u.p0 + (r < u.nv ? r : 0)];
        return (unsigned)(u.pm * 256 + r);
    }
};
struct Args { const float* in[18]; float* out; unsigned char* ws; int ph_lo, ph_hi, li, pad; };
__global__ void __launch_bounds__(NWAVES * 64, 2) hymba_fwd(Args args) {
    extern __shared__ __attribute__((aligned(16))) unsigned char lds[];
    LAS unsigned char* const L = (LAS unsigned char*)lds;
    volatile LAS unsigned* const MISCW = (volatile LAS unsigned*)(L + MISC_OFF);
    LAS int* const TOFF = (LAS int*)(L + TOFF_OFF); LAS int* const CNTL = TOFF + 40;
    const int tid = threadIdx.x, lane = tid & 63, wave = __builtin_amdgcn_readfirstlane(tid >> 6);
    const int G = gridDim.x; const int bx = blockIdx.x; const int vcu = (G % 8 == 0) ? (bx % 8) * (G / 8) + bx / 8 : bx;
    unsigned char* const ws = args.ws;
    gu32* const ctl = (gu32*)(ws + WS_CTL);
    const float* x = args.in[0]; const float* norm1_g = args.in[1]; const float* w_in = args.in[2]; const float* q_norm_g = args.in[3]; const float* k_norm_g = args.in[4];
    const float* rel_bias = args.in[5]; const float* gate_w2 = args.in[6]; const float* gate_b = args.in[7]; const float* out_norm_g = args.in[8]; const float* w_out = args.in[9];
    const float* norm2_g = args.in[10]; const float* w_rg = args.in[11]; const float* b_rg = args.in[12]; const float* w_re = args.in[13]; const float* b_re = args.in[14];
    const float* w_eg = args.in[15]; const float* w_eu = args.in[16]; const float* w_ed = args.in[17];
    float* out = args.out;
    float* RSTD1 = (float*)(ws + WS_RSTD1); float* ROWSS = (float*)(ws + WS_ROWSS); bf16* WR_T = (bf16*)(ws + WS_WR); float* BLAST = (float*)(ws + WS_BLAST);
    int* TOKINFO = (int*)(ws + WS_TOKINFO); int* LISTS = (int*)(ws + WS_LISTS); float* LSC = (float*)(ws + WS_LSC);
    bf16* WO_T = (bf16*)(ws + WS_WO); bf16* WGU_T = (bf16*)(ws + WS_WGU); bf16* WD_T = (bf16*)(ws + WS_WD); bf16* XB = (bf16*)(ws + WS_XB); bf16* WIN_T = (bf16*)(ws + WS_WIN);
    unsigned* MASK = (unsigned*)(ws + WS_MASK); bf16* SB = (bf16*)(ws + WS_SB);
    bf16* QN = (bf16*)(ws + WS_QN); bf16* KN = (bf16*)(ws + WS_KN); bf16* VN = (bf16*)(ws + WS_VN); bf16* XN2 = (bf16*)(ws + WS_XN2);
    bf16* IQ = (bf16*)(ws + WS_IQ); bf16* MISC = (bf16*)(ws + WS_MISC); bf16* QB = (bf16*)(ws + WS_QB); bf16* KB = (bf16*)(ws + WS_KB); bf16* VB = (bf16*)(ws + WS_VB); bf16* RG = (bf16*)(ws + WS_RG);
    bf16* MIX = (bf16*)(ws + WS_MIX); float* U = (float*)(ws + WS_MIX); bf16* HID = (bf16*)(ws + WS_HID); bf16* Y = (bf16*)(ws + WS_Y);
    unsigned* CNT = (unsigned*)(ctl + CW_CNT);

    for (int u = tid; u < (LDS_BYTES - LDSCTL_OFF) / 4; u += NWAVES * 64) ((LAS unsigned*)(L + LDSCTL_OFF))[u] = 0u;
    __syncthreads();
    XcdBarrier bar; bar.bar = (unsigned*)(ctl + CW_BAR); bar.x = 0; bar.st = nullptr;
    if (N_LAUNCHES != PER_PHASE) bar = xcd_barrier_post((unsigned*)(ctl + CW_BAR), MISCW + 8);
#define GRID_BAR(seam) do { if (N_LAUNCHES == PER_PHASE) { if (tid == 0) __hip_atomic_store(ctl + CW_TMO, 0xBADBA0u | (unsigned)(seam), RLX_AGENT); } else { xcd_barrier(bar); } } while (0)
    const int lo = args.ph_lo, hi = args.ph_hi;
#define IN(k) (lo <= (k) && (k) < hi)
#define BOTH(k) (IN(k) && IN((k) + 1))
    const int gw = vcu * NWAVES + wave, NGW = G * NWAVES;

    if (IN(0)) {
        LAS float* scr = (LAS float*)(L + wave * 16384);
        constexpr int I_IN = 16 * 106, I_O = 16 * 32, I_G = 16 * 8, I_D = 4 * 32;
        constexpr int NITEMS = I_IN + I_O + 32 * (2 * I_G + I_D);
        for (int it = gw; it < NITEMS; it += NGW) {
            int r = it;
            if (r < I_IN) { p0_transpose_item<0>(w_in, 1024, 3384, norm1_g, WIN_T, scr, r, lane); continue; } r -= I_IN;
            if (r < I_O) { p0_transpose_item<1>(w_out, 1024, 1024, nullptr, WO_T, scr, r, lane); continue; } r -= I_O;
            const int e = r / (2 * I_G + I_D); r -= e * (2 * I_G + I_D);
            if (r < I_G) { p0_transpose_item<2>(w_eg + (size_t)e * 1024 * 256, 1024, 256, norm2_g, WGU_T + (size_t)e * 512 * 1024, scr, r, lane); continue; } r -= I_G;
            if (r < I_G) { p0_transpose_item<3>(w_eu + (size_t)e * 1024 * 256, 1024, 256, norm2_g, WGU_T + (size_t)e * 512 * 1024, scr, r, lane); continue; } r -= I_G;
            p0_transpose_item<1>(w_ed + (size_t)e * 256 * 1024, 256, 1024, nullptr, WD_T + (size_t)e * 1024 * 256, scr, r, lane);
        }
        for (int i = bx * (NWAVES * 64) + tid; i < 48 * 1024; i += G * NWAVES * 64) { const int n = i >> 10, k = i & 1023;
            const float v = (n < 4) ? w_rg[k * 4 + n] : (n < 36) ? w_re[k * 32 + (n - 4)] : 0.f; WR_T[i] = (bf16)f2bf(v * norm2_g[k]); }
        for (int m = gw; m < M; m += NGW) {
            const GAS f32x4* xr = (const GAS f32x4*)(x + (size_t)m * 1024) + lane; f32x4 v[4]; float s = 0.f;
#pragma unroll
            for (int j = 0; j < 4; ++j) { v[j] = xr[64 * j]; s += (v[j].x * v[j].x + v[j].y * v[j].y) + (v[j].z * v[j].z + v[j].w * v[j].w); }
            s = wave_sum(s); if (lane == 0) RSTD1[m] = 1.0f / sqrtf(s * (1.0f / 1024.0f) + 1e-6f);
            GAS unsigned long long* o8 = (GAS unsigned long long*)(XB + (size_t)m * 1024) + lane;
#pragma unroll
            for (int j = 0; j < 4; ++j) o8[64 * j] = (unsigned long long)pk2(v[j].x, v[j].y) | ((unsigned long long)pk2(v[j].z, v[j].w) << 32);
        }
        if (BOTH(0)) GRID_BAR(0);
    }
    if (IN(1)) {
        pg8::Gemm g{XB, WIN_T, 1024}; pg8::StaticOrder S; S.init(M, 3584, G, bx);
        pg8::EpiProj E{RSTD1, q_norm_g, k_norm_g, QN, KN, VN, IQ, QB, KB, VB, RG, MISC, 0.125f * 1.4426950408889634f, 1e-6f};
        pg8::gemm_phase<pg8::EpiProj, pg8::StaticOrder, true>(L, g, S, E);
        if (BOTH(1)) GRID_BAR(1);
    }
    if (IN(2)) {
        for (int it = bx; it < 1024; it += G) { const int b = it & 7, key = (it >> 3) ^ ((it >> 8) & 1); const int p = (key & 1) ? 127 - (key >> 1) : (key >> 1);
            idx_item(L, b, p, IQ, MISC, MASK, lane, wave); }
        for (int it = bx; it < 1024; it += G) gla_a_item(L, it, KB, VB, MISC, gate_w2, gate_b, U, BLAST, tid, lane, wave);
        if (BOTH(2)) GRID_BAR(2);
    }
    if (IN(3)) {
        for (int it = bx; it < 32; it += G) gla_b_item(it, U, BLAST, SB, tid);
        if (BOTH(3)) GRID_BAR(3);
    }
    if (IN(4)) {
        const attn_body::AttnTensors AT{(const attn_body::bf16*)QN, (const attn_body::bf16*)KN, (const attn_body::bf16*)VN, (attn_body::bf16*)MIX, MASK, rel_bias};
        for (int pr = vcu; pr < 256; pr += G) { const int bh = pr >> 2, s = pr & 3;
            for (int k2 = 0; k2 < 2; ++k2) attn_body::attn_unit<8>(bh >> 3, bh & 7, k2 ? s : 7 - s, AT.Q, AT.K, AT.V, AT.O, AT.MASK, AT.relb, (char*)lds); }
        for (int it = bx; it < 1024; it += G) gla_c_item(L, it, QB, KB, VB, RG, MISC, gate_w2, gate_b, out_norm_g, SB, MIX, tid, lane, wave);
        if (BOTH(4)) GRID_BAR(4);
    }
    if (IN(5)) {
        pg8::Gemm g{MIX, WO_T, 1024}; pg8::StaticOrder S; S.init(M, 1024, G, bx);
        pg8::EpiOut E{x, XN2, ROWSS};
        pg8::gemm_phase<pg8::EpiOut, pg8::StaticOrder, false>(L, g, S, E);
        if (BOTH(5)) GRID_BAR(5);
    }
    if (IN(6)) {
        { LAS bf16* WR = (LAS bf16*)L;
          for (int i = tid; i < 48 * 128; i += NWAVES * 64) { const int n = i >> 7, c8 = i & 127; *(LAS v4u*)(WR + n * WRP + c8 * 8) = *(const v4u*)(WR_T + n * 1024 + c8 * 8); } }
        WG_SYNC();
        for (int tile = bx; tile < 256; tile += G) router_tile(L, tile, XN2, ROWSS, b_rg, b_re, CNT, LISTS, LSC, TOKINFO, tid, lane, wave);
        if (BOTH(6)) GRID_BAR(6);
    }
#define LOAD_TOFF() do { if (tid == 0) { int acc_ = 0; for (int e_ = 0; e_ < 32; ++e_) { const int c_ = (int)__hip_atomic_load(CNT + e_, RLX_AGENT); CNTL[e_] = c_; TOFF[e_] = acc_; acc_ += (c_ + 255) >> 8; } TOFF[32] = acc_; } WG_SYNC(); } while (0)
    if (IN(7)) {
        LOAD_TOFF();
        pg8::Gemm g{XN2, WGU_T, 1024}; GroupOrder<true> S{TOFF, CNTL, LISTS, 2, G, bx, 512u * 1024u * 2u};
        pg8::EpiGU E{LSC, HID};
        pg8::gemm_phase<pg8::EpiGU, GroupOrder<true>, false>(L, g, S, E);
        if (BOTH(7)) GRID_BAR(7);
    }
    if (IN(8)) {
        LOAD_TOFF();
        pg8::Gemm g{HID, WD_T, 256}; GroupOrder<false> S{TOFF, CNTL, LISTS, 4, G, bx, 1024u * 256u * 2u};
        pg8::EpiDown E{Y};
        pg8::gemm_phase<pg8::EpiDown, GroupOrder<false>, false>(L, g, S, E);
        if (BOTH(8)) GRID_BAR(8);
    }
    if (IN(9)) {
        LOAD_TOFF();
        for (int m = gw; m < M; m += NGW) {
            const int e0 = TOKINFO[(size_t)m * 4], p0 = TOKINFO[(size_t)m * 4 + 1], e1 = TOKINFO[(size_t)m * 4 + 2], p1 = TOKINFO[(size_t)m * 4 + 3];
            const size_t s0 = (size_t)TOFF[e0] * 256 + p0, s1 = (size_t)TOFF[e1] * 256 + p1;
            const GAS v4u* a = (const GAS v4u*)(XN2 + (size_t)m * 1024) + lane; const GAS v4u* y0 = (const GAS v4u*)(Y + s0 * 1024) + lane; const GAS v4u* y1 = (const GAS v4u*)(Y + s1 * 1024) + lane;
            GAS f32x4* o = (GAS f32x4*)(out + (size_t)m * 1024) + 2 * lane;
#pragma unroll
            for (int j = 0; j < 2; ++j) { const v4u av = a[64 * j], b0 = y0[64 * j], b1 = y1[64 * j];
                f32x4 r0, r1;
                r0[0] = bflo(av.x) + bflo(b0.x) + bflo(b1.x); r0[1] = bfhi(av.x) + bfhi(b0.x) + bfhi(b1.x); r0[2] = bflo(av.y) + bflo(b0.y) + bflo(b1.y); r0[3] = bfhi(av.y) + bfhi(b0.y) + bfhi(b1.y);
                r1[0] = bflo(av.z) + bflo(b0.z) + bflo(b1.z); r1[1] = bfhi(av.z) + bfhi(b0.z) + bfhi(b1.z); r1[2] = bflo(av.w) + bflo(b0.w) + bflo(b1.w); r1[3] = bfhi(av.w) + bfhi(b0.w) + bfhi(b1.w);
                o[128 * j] = r0; o[128 * j + 1] = r1; }
        }
    }
#undef IN
#undef BOTH
}

extern "C" void kernel_launch(void* const* d_in, const int* in_sizes, int n_in, void* d_out, int out_size, void* d_ws, size_t ws_size, hipStream_t stream) {
    static int grid = 0;
    if (grid == 0) {
        if (n_in != 18 || out_size != M * 1024 || ws_size < WS_END) { fprintf(stderr, "kernel_launch: unexpected problem shape (n_in %d out %d ws %zu)\n", n_in, out_size, ws_size); grid = -1; return; }
        int dev = 0, cus = 0, per_cu = 0;
        if (hipGetDevice(&dev) != hipSuccess || hipDeviceGetAttribute(&cus, hipDeviceAttributeMultiprocessorCount, dev) != hipSuccess) { grid = -1; return; }
        if (hipFuncSetAttribute((const void*)hymba_fwd, hipFuncAttributeMaxDynamicSharedMemorySize, LDS_BYTES) != hipSuccess) { fprintf(stderr, "kernel_launch: hipFuncSetAttribute failed\n"); grid = -1; return; }
        if (hipOccupancyMaxActiveBlocksPerMultiprocessor(&per_cu, (const void*)hymba_fwd, NWAVES * 64, LDS_BYTES) != hipSuccess || per_cu < 1) { fprintf(stderr, "kernel_launch: occupancy query reports %d\n", per_cu); }
        (void)hipGetLastError();
        grid = cus;
    }
    if (grid < 0) return;
    (void)hipMemsetAsync((char*)d_ws + WS_CTL, 0, CTL_ZERO_BYTES, stream);
    Args a{};
    for (int i = 0; i < 18; ++i) a.in[i] = (const float*)d_in[i];
    a.out = (float*)d_out; a.ws = (unsigned char*)d_ws;
    if (N_LAUNCHES == 1) { a.ph_lo = 0; a.ph_hi = PER_PHASE; a.li = 0; hipLaunchKernelGGL(hymba_fwd, dim3(grid), dim3(NWAVES * 64), LDS_BYTES, stream, a); }
    else for (int li = 0; li < PER_PHASE; ++li) { a.ph_lo = li; a.ph_hi = li + 1; a.li = li; hipLaunchKernelGGL(hymba_fwd, dim3(grid), dim3(NWAVES * 64), LDS_BYTES, stream, a); }
}
```

```cpp
#include <hip/hip_runtime.h>
#include <hip/hip_bf16.h>
#include <cstdio>
#include <cstdint>
#include <cmath>
namespace pg8 {
#define PG8_LAS __attribute__((address_space(3)))
typedef unsigned short bf16_t;
typedef short bf16x8 __attribute__((ext_vector_type(8)));
typedef float f32x4 __attribute__((ext_vector_type(4)));
typedef float f32x2 __attribute__((ext_vector_type(2)));
typedef unsigned u32x4 __attribute__((ext_vector_type(4)));
constexpr int BM = 256, BK = 64, HALF = 128, HTB = HALF * BK * 2  , STAGE_BYTES = 8 * HTB, NXCD = 8, WGM = 8;

__host__ __device__ __forceinline__ int lds_byte(int r, int c) { const int st = (r >> 4) * 2 + (c >> 5), rr = r & 15, cc = c & 31, ob = rr * 64 + cc * 2; return st * 1024 + (ob ^ (((ob >> 9) & 1) << 5)); }
__host__ __device__ __forceinline__ void stage_rc(int b, int& R, int& C) { const int st = b / 1024, sb = b % 1024, swz = sb ^ (((sb >> 9) & 1) << 5); R = (st >> 1) * 16 + swz / 64; C = (st & 1) * 32 + (swz % 64) / 2; }
__host__ __device__ __forceinline__ int perm32(int rho) { const int n = rho >> 4, i = rho & 15; return 8 * (i >> 2) + 4 * n + (i & 3); }

struct Unit { int pm, pn; unsigned bo; int e, nv, p0; };
struct Gemm { const bf16_t* A; const bf16_t* Bt; int K; };

struct StaticOrder {
    int nM, nN, nwg, G, c;
    __device__ void init(int M, int N, int G_, int c_) { nM = M / BM; nN = N / BM; nwg = nM * nN; G = G_; c = c_; }
    __device__ bool next(int i, Unit& u) const {
        const long L = (long)i * G + c; if (L >= nwg) return false;
        int wgid = (int)L; { const int q = nwg / NXCD, r = nwg % NXCD, xcd = wgid % NXCD, off = wgid / NXCD; wgid = (xcd < r ? xcd * (q + 1) : r * (q + 1) + (xcd - r) * q) + off; }
        const int nig = WGM * nN, gid = wgid / nig, fm = gid * WGM, gsz = (nM - fm) < WGM ? (nM - fm) : WGM;
        u.pm = fm + ((wgid % nig) % gsz); u.pn = (wgid % nig) / gsz; u.bo = 0u; u.e = 0; u.nv = BM; u.p0 = 0; return true;
    }
    __device__ __forceinline__ unsigned arow(const Unit& u, int r) const { return (unsigned)(u.pm * BM + r); }
};

__device__ __forceinline__ unsigned cvt_pk_bf16(float lo, float hi) { unsigned r; asm volatile("v_cvt_pk_bf16_f32 %0, %1, %2" : "=v"(r) : "v"(lo), "v"(hi)); return r; }

template <class Epi, class Sched, bool ALIGN_EPI = false>
__device__ __forceinline__ void gemm_phase(PG8_LAS unsigned char* lds, const Gemm g, const Sched& S, const Epi& E) {
    const int tid = threadIdx.x, wid = __builtin_amdgcn_readfirstlane(tid >> 6), lane = tid & 63, wr = wid >> 2, wc = wid & 3, fr = lane & 15, fq = lane >> 4;
    const int K = g.K, nt = K / BK;
    int RA[2], CA[2]; unsigned voffB[2];
#pragma unroll
    for (int i = 0; i < 2; ++i) { int R, C; stage_rc(tid * 16 + i * 8192, R, C); const int Rb = ((R & ~31) + perm32(R & 31));
        RA[i] = R; CA[i] = C; voffB[i] = (unsigned)(Rb * K + C) * 2u; }
    const size_t kstep = (size_t)(BK * 2);
    const size_t hstep = (size_t)HALF * K * 2;
    const size_t tstep = 2 * hstep;
    const unsigned ldsw = (unsigned)wid * 1024u;
    const int aoff = lds_byte(wr * 64 + fr, fq * 8), boff = lds_byte(wc * 32 + fr, fq * 8);
#define PG8_SA(b, h) (((b) * 2 + (h)) * HTB)
#define PG8_SB(b, h) ((4 + (b) * 2 + (h)) * HTB)
#define PG8_STAGE(bufoff, gbase, voff) do { _Pragma("unroll") for (int _i = 0; _i < 2; ++_i) \
        __builtin_amdgcn_global_load_lds((const unsigned*)((const char*)(gbase) + (voff)[_i]), (PG8_LAS unsigned*)(lds + (bufoff) + ldsw + _i * 8192), 16, 0, 0); } while (0)
#define PG8_LDA(dst, b, h) do { _Pragma("unroll") for (int m = 0; m < 4; ++m) _Pragma("unroll") for (int k = 0; k < 2; ++k) dst[m][k] = *(const PG8_LAS bf16x8*)(lds + PG8_SA(b, h) + aoff + m * 2048 + k * 1024); } while (0)
#define PG8_LDB(dst, b, h) do { _Pragma("unroll") for (int n = 0; n < 2; ++n) _Pragma("unroll") for (int k = 0; k < 2; ++k) dst[n][k] = *(const PG8_LAS bf16x8*)(lds + PG8_SB(b, h) + boff + n * 2048 + k * 1024); } while (0)
#define PG8_MMA(ai, bj, At, Bt) do { __builtin_amdgcn_s_setprio(1); _Pragma("unroll") for (int m = 0; m < 4; ++m) _Pragma("unroll") for (int n = 0; n < 2; ++n) _Pragma("unroll") for (int k = 0; k < 2; ++k) \
        acc[ai][bj][m][n] = __builtin_amdgcn_mfma_f32_16x16x32_bf16(Bt[n][k], At[m][k], acc[ai][bj][m][n], 0, 0, 0); __builtin_amdgcn_s_setprio(0); } while (0)
#define PG8_WAIT_V(n) asm volatile("s_waitcnt vmcnt(" #n ")" ::: "memory")
#define PG8_WAIT_L(n) asm volatile("s_waitcnt lgkmcnt(" #n ")" ::: "memory")
#define PG8_BAR __builtin_amdgcn_s_barrier()
#define PG8_SCHED __builtin_amdgcn_sched_barrier(0)
#define PG8_AOFF(AO, U) do { _Pragma("unroll") for (int _h = 0; _h < 2; ++_h) _Pragma("unroll") for (int _i = 0; _i < 2; ++_i) \
        AO[_h][_i] = (S.arow(U, _h * HALF + RA[_i]) * (unsigned)K + (unsigned)CA[_i]) * 2u; } while (0)
    Unit cur, nxt; int ui = 0;
    if (!S.next(0, cur)) return;
    f32x4 acc[2][2][4][2];
#pragma unroll
    for (int a = 0; a < 2; ++a)
#pragma unroll
        for (int b = 0; b < 2; ++b)
#pragma unroll
            for (int m = 0; m < 4; ++m)
#pragma unroll
                for (int n = 0; n < 2; ++n) acc[a][b][m][n] = (f32x4){0.f, 0.f, 0.f, 0.f};
    bf16x8 At[4][2], B0[2][2], B1[2][2];
    unsigned aoC[2][2], aoN[2][2];
    PG8_AOFF(aoC, cur);
    const char* const gA = (const char*)g.A;
    const char* cB = (const char*)g.Bt + (size_t)cur.bo + (size_t)cur.pn * tstep;
    {
        PG8_STAGE(PG8_SB(0, 0), cB, voffB); PG8_STAGE(PG8_SB(0, 1), cB + hstep, voffB); PG8_STAGE(PG8_SA(0, 0), gA, aoC[0]); PG8_STAGE(PG8_SA(0, 1), gA, aoC[1]);
        if (wr == 1) PG8_BAR;
        PG8_WAIT_V(2); PG8_BAR;
        PG8_STAGE(PG8_SB(1, 0), cB + kstep, voffB); PG8_STAGE(PG8_SA(1, 0), gA + kstep, aoC[0]); PG8_STAGE(PG8_SB(1, 1), cB + hstep + kstep, voffB);
        PG8_WAIT_V(6); PG8_BAR;
    }
    for (;;) {
        const bool has_next = S.next(ui + 1, nxt);
        if (has_next) { PG8_AOFF(aoN, nxt); } else {
#pragma unroll
            for (int _h = 0; _h < 2; ++_h)
#pragma unroll
                for (int _i = 0; _i < 2; ++_i) aoN[_h][_i] = aoC[_h][_i]; }
        const char* nB = has_next ? (const char*)g.Bt + (size_t)nxt.bo + (size_t)nxt.pn * tstep : cB;
        for (int t = 0; t < nt; t += 2) {
            const bool last = (t == nt - 2);
            const char* a1 = gA + (size_t)(t + 1) * kstep;
            const char* a2 = last ? gA : gA + (size_t)(t + 2) * kstep; const char* b2 = last ? nB : cB + (size_t)(t + 2) * kstep;
            const char* a3 = a2 + kstep; const char* b3 = b2 + kstep;
            unsigned ao2[2][2];
#pragma unroll
            for (int _h = 0; _h < 2; ++_h)
#pragma unroll
                for (int _i = 0; _i < 2; ++_i) ao2[_h][_i] = last ? aoN[_h][_i] : aoC[_h][_i];
            PG8_LDB(B0, 0, 0); PG8_LDB(B1, 0, 1); PG8_SCHED; PG8_LDA(At, 0, 0); PG8_STAGE(PG8_SA(1, 1), a1, aoC[1]);
            PG8_WAIT_V(8); PG8_WAIT_L(0); PG8_BAR; PG8_MMA(0, 0, At, B0); PG8_MMA(0, 1, At, B1); PG8_BAR; PG8_SCHED;
            PG8_LDA(At, 0, 1); PG8_STAGE(PG8_SB(0, 0), b2, voffB); PG8_STAGE(PG8_SB(0, 1), b2 + hstep, voffB); PG8_STAGE(PG8_SA(0, 0), a2, ao2[0]);
            PG8_WAIT_V(8); PG8_WAIT_L(0); PG8_BAR; PG8_MMA(1, 0, At, B0); PG8_MMA(1, 1, At, B1); PG8_BAR; PG8_SCHED;
            PG8_LDB(B0, 1, 0); PG8_LDB(B1, 1, 1); PG8_SCHED; PG8_LDA(At, 1, 0); PG8_STAGE(PG8_SA(0, 1), a2, ao2[1]);
            PG8_WAIT_V(8); PG8_WAIT_L(0); PG8_BAR; PG8_MMA(0, 0, At, B0); PG8_MMA(0, 1, At, B1); PG8_BAR; PG8_SCHED;
            PG8_LDA(At, 1, 1); PG8_STAGE(PG8_SB(1, 0), b3, voffB); PG8_STAGE(PG8_SB(1, 1), b3 + hstep, voffB); PG8_STAGE(PG8_SA(1, 0), a3, ao2[0]);
            PG8_WAIT_V(8); PG8_WAIT_L(0); PG8_BAR; PG8_MMA(1, 0, At, B0); PG8_MMA(1, 1, At, B1); PG8_BAR; PG8_SCHED;
        }
        if constexpr (ALIGN_EPI) { if (wr == 0) PG8_BAR; }
        E(acc, cur, wr, wc, fr, fq);
        if (!has_next) break;
#pragma unroll
        for (int a = 0; a < 2; ++a)
#pragma unroll
            for (int b = 0; b < 2; ++b)
#pragma unroll
                for (int m = 0; m < 4; ++m)
#pragma unroll
                    for (int n = 0; n < 2; ++n) acc[a][b][m][n] = (f32x4){0.f, 0.f, 0.f, 0.f};
        cur = nxt; cB = nB; ++ui;
#pragma unroll
        for (int _h = 0; _h < 2; ++_h)
#pragma unroll
            for (int _i = 0; _i < 2; ++_i) aoC[_h][_i] = aoN[_h][_i];
        if constexpr (ALIGN_EPI) { if (wr == 1) PG8_BAR; }
    }
    PG8_WAIT_V(0);
    if constexpr (!ALIGN_EPI) { if (wr == 0) PG8_BAR; }
    PG8_BAR;
#undef PG8_SA
#undef PG8_SB
#undef PG8_STAGE
#undef PG8_LDA
#undef PG8_LDB
#undef PG8_MMA
#undef PG8_WAIT_V
#undef PG8_WAIT_L
#undef PG8_BAR
#undef PG8_SCHED
#undef PG8_AOFF
}
}
namespace pg8 {
__device__ __forceinline__ u32x4 pack8(const f32x4 v0, const f32x4 v1) { u32x4 w; w.x = cvt_pk_bf16(v0[0], v0[1]); w.y = cvt_pk_bf16(v0[2], v0[3]); w.z = cvt_pk_bf16(v1[0], v1[1]); w.w = cvt_pk_bf16(v1[2], v1[3]); return w; }

struct EpiProj {
    const float* rstd1; const float* qg; const float* kg;
    bf16_t *QN, *KN, *VN, *IQ, *QB, *KB, *VB, *RG, *MISC;
    float qscale, eps;
    __device__ __forceinline__ void operator()(const f32x4 (&acc)[2][2][4][2], const Unit& u, int wr, int wc, int fr, int fq) const {
        const int row0 = u.pm * BM + wr * 64 + fr; const int pn = u.pn;
        if (pn < 4) {
            const bool isq = pn < 2; const float* gp = isq ? qg : kg; bf16_t* O = isq ? QN : KN; const float os = isq ? qscale : 1.f;
            f32x4 gv[2][2];
#pragma unroll
            for (int bj = 0; bj < 2; ++bj)
#pragma unroll
                for (int n = 0; n < 2; ++n) gv[bj][n] = *(const f32x4*)(gp + 32 * bj + 8 * fq + 4 * n) * os;
            const int hcol = (4 * (pn & 1) + wc) * 64 + 8 * fq;
#pragma unroll
            for (int ai = 0; ai < 2; ++ai)
#pragma unroll
                for (int m = 0; m < 4; ++m) { const int row = row0 + ai * HALF + m * 16; const float s = rstd1[row];
                    float ss = 0.f;
#pragma unroll
                    for (int bj = 0; bj < 2; ++bj)
#pragma unroll
                        for (int n = 0; n < 2; ++n) { const f32x4 x = acc[ai][bj][m][n]; ss += (x[0] * x[0] + x[1] * x[1]) + (x[2] * x[2] + x[3] * x[3]); }
                    ss += __shfl_xor(ss, 16); ss += __shfl_xor(ss, 32);
                    const float r = s * __builtin_amdgcn_rsqf(s * s * ss * (1.f / 64.f) + eps);
                    bf16_t* rowp = O + (size_t)row * 512 + hcol;
#pragma unroll
                    for (int bj = 0; bj < 2; ++bj) *(u32x4*)(rowp + 32 * bj) = pack8(acc[ai][bj][m][0] * r * gv[bj][0], acc[ai][bj][m][1] * r * gv[bj][1]); }
            return;
        }
        bf16_t* O; int pitch, coff, lim = 256;
        if (pn < 6) { O = VN; pitch = 512; coff = (pn - 4) * 256; }
        else if (pn == 6) { O = IQ; pitch = 256; coff = 0; }
        else if (pn == 7) { O = QB; pitch = 256; coff = 0; }
        else if (pn == 8) { O = KB; pitch = 256; coff = 0; }
        else if (pn < 11) { O = VB; pitch = 512; coff = (pn - 9) * 256; }
        else if (pn < 13) { O = RG; pitch = 512; coff = (pn - 11) * 256; }
        else { O = MISC; pitch = 64; coff = 0; lim = 56; }
        const int c0 = wc * 32 + 8 * fq;
#pragma unroll
        for (int ai = 0; ai < 2; ++ai)
#pragma unroll
            for (int m = 0; m < 4; ++m) { const int row = row0 + ai * HALF + m * 16; const float s = rstd1[row];
                bf16_t* rowp = O + (size_t)row * pitch + coff + c0;
#pragma unroll
                for (int bj = 0; bj < 2; ++bj) if (c0 + bj * HALF < lim) *(u32x4*)(rowp + bj * HALF) = pack8(acc[ai][bj][m][0] * s, acc[ai][bj][m][1] * s); }
    }
};

struct EpiOut {
    const float* x; bf16_t* XN2; float* ROWSS;
    __device__ __forceinline__ void operator()(const f32x4 (&acc)[2][2][4][2], const Unit& u, int wr, int wc, int fr, int fq) const {
        const int row0 = u.pm * BM + wr * 64 + fr; const int col0 = u.pn * BM + wc * 32 + 8 * fq;
#pragma unroll
        for (int ai = 0; ai < 2; ++ai)
#pragma unroll
            for (int m = 0; m < 4; ++m) { const int row = row0 + ai * HALF + m * 16; const size_t off = (size_t)row * 1024 + col0; float ss = 0.f;
#pragma unroll
                for (int bj = 0; bj < 2; ++bj) { const f32x4 a = *(const f32x4*)(x + off + bj * HALF) + acc[ai][bj][m][0], b = *(const f32x4*)(x + off + bj * HALF + 4) + acc[ai][bj][m][1];
                    ss += (a[0] * a[0] + a[1] * a[1]) + (a[2] * a[2] + a[3] * a[3]) + (b[0] * b[0] + b[1] * b[1]) + (b[2] * b[2] + b[3] * b[3]);
                    *(u32x4*)(XN2 + off + bj * HALF) = pack8(a, b); }
                ss += __shfl_xor(ss, 16); ss += __shfl_xor(ss, 32);
                if (fq == 0) ROWSS[(size_t)row * 16 + u.pn * 4 + wc] = ss; }
    }
};

struct EpiGU {
    const float* LSC; bf16_t* HID;
    __device__ __forceinline__ void operator()(const f32x4 (&acc)[2][2][4][2], const Unit& u, int wr, int wc, int fr, int fq) const {
        const int r0 = wr * 64 + fr; const int c0 = u.pn * HALF + wc * 32 + 8 * fq;
#pragma unroll
        for (int ai = 0; ai < 2; ++ai)
#pragma unroll
            for (int m = 0; m < 4; ++m) { const int r = r0 + ai * HALF + m * 16;
                f32x2 sw = (f32x2){0.f, 0.f};
                if (r < u.nv) sw = *(const f32x2*)(LSC + ((size_t)u.e * 16384 + (size_t)(u.p0 + r)) * 2);
                f32x4 h0, h1;
#pragma unroll
                for (int j = 0; j < 4; ++j) { const float a = acc[ai][0][m][0][j] * sw.x, uu = acc[ai][1][m][0][j] * sw.x; h0[j] = a * __builtin_amdgcn_rcpf(1.f + __expf(-a)) * uu * sw.y;
                                              const float a2 = acc[ai][0][m][1][j] * sw.x, u2 = acc[ai][1][m][1][j] * sw.x; h1[j] = a2 * __builtin_amdgcn_rcpf(1.f + __expf(-a2)) * u2 * sw.y; }
                *(u32x4*)(HID + (size_t)(u.pm * BM + r) * 256 + c0) = pack8(h0, h1); }
    }
};
struct EpiDown {
    bf16_t* Y;
    __device__ __forceinline__ void operator()(const f32x4 (&acc)[2][2][4][2], const Unit& u, int wr, int wc, int fr, int fq) const {
        const int r0 = u.pm * BM + wr * 64 + fr; const int c0 = u.pn * BM + wc * 32 + 8 * fq;
#pragma unroll
        for (int ai = 0; ai < 2; ++ai)
#pragma unroll
            for (int m = 0; m < 4; ++m) { bf16_t* rowp = Y + (size_t)(r0 + ai * HALF + m * 16) * 1024 + c0;
#pragma unroll
                for (int bj = 0; bj < 2; ++bj) *(u32x4*)(rowp + bj * HALF) = pack8(acc[ai][bj][m][0], acc[ai][bj][m][1]); }
    }
};
}
namespace attn_body {
using bf16=__hip_bfloat16;
using bf16x8=__attribute__((ext_vector_type(8)))short;
using s16x4=__attribute__((ext_vector_type(4)))short;
using f32x16=__attribute__((ext_vector_type(16)))float;
using u32x4=__attribute__((ext_vector_type(4)))unsigned;
constexpr int BATCH=8,NHEAD=8,SEQ=2048,D=64,DM=NHEAD*D,PO=1024;
constexpr int NW=8,QBLK=32,QB=QBLK*NW,KVBLK=64,NQB=SEQ/QB;
constexpr int ATTN_UNIT_ROWS=QB;
__device__ __forceinline__ int crow(int r,int hi){return (r&3)+8*(r>>2)+4*hi;}
#define SBAR() __builtin_amdgcn_sched_barrier(0)
typedef float f32x4a __attribute__((ext_vector_type(4)));
__device__ __forceinline__ void tbias(f32x16&p0,f32x16&p1,int t,int qpos,int hi,__attribute__((address_space(3))) const char* tabr){
  int base=qpos-64*t-4*hi; base=base<-4?-4:(base>200?200:base); const int a=200-base, s=a&3;
  const __attribute__((address_space(3))) f32x4a* tp=(const __attribute__((address_space(3))) f32x4a*)(tabr+s*1088+(a-s)*4);
  #pragma unroll
  for(int g=0;g<4;++g){ const f32x4a v0=tp[2*g], v1=tp[2*g+8];
    p0[4*g]+=v0[0];p0[4*g+1]+=v0[1];p0[4*g+2]+=v0[2];p0[4*g+3]+=v0[3]; p1[4*g]+=v1[0];p1[4*g+1]+=v1[1];p1[4*g+2]+=v1[2];p1[4*g+3]+=v1[3];
    asm volatile("":"+v"(p0),"+v"(p1)); }
}
__device__ __forceinline__ float mkeep(float v,unsigned mw,int bit){ const unsigned t=(unsigned)(((int)(mw<<(31-bit)))>>31); return __uint_as_float(__float_as_uint(v)&t); }
constexpr int NSLOT=3, SLOTB=8192;
constexpr int LDS_K=0, LDS_V=NSLOT*SLOTB, LDS_WS=2*NSLOT*SLOTB, LDS_OST=LDS_WS+NW*64*4, LDS_BYTES=LDS_OST+NW*4096, LDS_MSK=LDS_BYTES, LDS_TAB=LDS_MSK+65536, LDS_TOTAL=LDS_TAB+4352;
constexpr float C2=0.125f*1.4426950408889634f;
__device__ __forceinline__ void glds16(const void*gsrc,unsigned lds_dst){unsigned keep;
  asm volatile("s_mov_b32 %0, m0\n\ts_mov_b32 m0, %2\n\ts_nop 0\n\tglobal_load_lds_dwordx4 %1, off\n\ts_mov_b32 m0, %0":"=&s"(keep):"v"(gsrc),"s"(lds_dst):"memory");}
__device__ __forceinline__ float max3f(float a,float b,float c){float r;asm("v_max3_f32 %0, %1, %2, %3":"=v"(r):"v"(a),"v"(b),"v"(c));return r;}
__device__ __forceinline__ float max2f(float a,float b){float r;asm("v_max_f32_e32 %0, %1, %2":"=v"(r):"v"(a),"v"(b));return r;}
__device__ __forceinline__ float fadd_s(float a,float b){float r;asm("v_add_f32_e32 %0, %1, %2":"=v"(r):"v"(a),"v"(b));return r;}
__device__ __forceinline__ float fsub_s(float a,float b){float r;asm("v_sub_f32_e32 %0, %1, %2":"=v"(r):"v"(a),"v"(b));return r;}
typedef float f32x2_t __attribute__((ext_vector_type(2))); typedef __bf16 bf16x2_t __attribute__((ext_vector_type(2)));
__device__ __forceinline__ unsigned cvtpk_s(float lo,float hi){f32x2_t v={lo,hi};bf16x2_t b=__builtin_convertvector(v,bf16x2_t);return __builtin_bit_cast(unsigned,b);}
#define WAIT_BAR(N) asm volatile("s_waitcnt vmcnt(" #N ") lgkmcnt(0)\n\ts_barrier":::"memory")

__device__ __forceinline__ void qkt(f32x16&p0,f32x16&p1,const char*Kslot,const bf16x8*qr,const f32x16&negm,int r32,int hi){
  const char*kb=Kslot+hi*1024+r32*16;
  #pragma unroll
  for(int d0=0;d0<4;++d0){
    const bf16x8 b0=*reinterpret_cast<const bf16x8*>(kb+d0*2048);
    const bf16x8 b1=*reinterpret_cast<const bf16x8*>(kb+d0*2048+512);
    if(d0==0){p0=__builtin_amdgcn_mfma_f32_32x32x16_bf16(b0,qr[0],negm,0,0,0);p1=__builtin_amdgcn_mfma_f32_32x32x16_bf16(b1,qr[0],negm,0,0,0);}
    else{p0=__builtin_amdgcn_mfma_f32_32x32x16_bf16(b0,qr[d0],p0,0,0,0);p1=__builtin_amdgcn_mfma_f32_32x32x16_bf16(b1,qr[d0],p1,0,0,0);}}
}
typedef __attribute__((address_space(3))) const char* lds_cptr;
typedef short v4i16_t __attribute__((ext_vector_type(4)));
__device__ __forceinline__ void kload8(bf16x8*kf,lds_cptr kp){
  kf[0]=*(const __attribute__((address_space(3))) bf16x8*)(kp);      kf[1]=*(const __attribute__((address_space(3))) bf16x8*)(kp+512);
  kf[2]=*(const __attribute__((address_space(3))) bf16x8*)(kp+2048); kf[3]=*(const __attribute__((address_space(3))) bf16x8*)(kp+2560);
  kf[4]=*(const __attribute__((address_space(3))) bf16x8*)(kp+4096); kf[5]=*(const __attribute__((address_space(3))) bf16x8*)(kp+4608);
  kf[6]=*(const __attribute__((address_space(3))) bf16x8*)(kp+6144); kf[7]=*(const __attribute__((address_space(3))) bf16x8*)(kp+6656);
}
__device__ __forceinline__ void kload2(bf16x8*kf,lds_cptr kp,int j){ kf[2*j]=*(const __attribute__((address_space(3))) bf16x8*)(kp+j*2048); kf[2*j+1]=*(const __attribute__((address_space(3))) bf16x8*)(kp+j*2048+512); }
__device__ __forceinline__ s16x4 vtr(lds_cptr p){ return __builtin_bit_cast(s16x4,__builtin_amdgcn_ds_read_tr16_b64_v4i16((__attribute__((address_space(3))) v4i16_t*)p)); }
__device__ __forceinline__ float rowmax(const f32x16&p0,const f32x16&p1){
  float a=max3f(p0[0],p0[1],p1[0]),b=max3f(p0[2],p0[3],p1[1]);a=max3f(a,p1[2],p1[3]);
  #pragma unroll
  for(int r=4;r<16;r+=4){a=max3f(a,p0[r],p0[r+1]);b=max3f(b,p0[r+2],p0[r+3]);a=max3f(a,p1[r],p1[r+1]);b=max3f(b,p1[r+2],p1[r+3]);}
  const float m=max2f(a,b);
  auto rr=__builtin_amdgcn_permlane32_swap(__float_as_uint(m),__float_as_uint(m),false,false);
  return max2f(__uint_as_float(rr[0]),__uint_as_float(rr[1]));
}
__device__ __forceinline__ void pv(f32x16*o,int vb,bf16x8 pa0,bf16x8 pa1,bf16x8 pa2,bf16x8 pa3){
  #pragma unroll
  for(int d0=0;d0<2;++d0){s16x4 lo[4],hi[4];
    #pragma unroll
    for(int ks=0;ks<4;++ks){
      asm volatile("ds_read_b64_tr_b16 %0,%1 offset:%c2":"=&v"(lo[ks]):"v"(vb),"i"(d0*4096+ks*1024):"memory");
      asm volatile("ds_read_b64_tr_b16 %0,%1 offset:%c2":"=&v"(hi[ks]):"v"(vb),"i"(d0*4096+ks*1024+512):"memory");}
    asm volatile("s_waitcnt lgkmcnt(0)":::"memory");SBAR();
    #define PK(k) (bf16x8){lo[k][0],lo[k][1],lo[k][2],lo[k][3],hi[k][0],hi[k][1],hi[k][2],hi[k][3]}
    o[d0]=__builtin_amdgcn_mfma_f32_32x32x16_bf16(pa0,PK(0),o[d0],0,0,0);
    o[d0]=__builtin_amdgcn_mfma_f32_32x32x16_bf16(pa1,PK(1),o[d0],0,0,0);
    o[d0]=__builtin_amdgcn_mfma_f32_32x32x16_bf16(pa2,PK(2),o[d0],0,0,0);
    o[d0]=__builtin_amdgcn_mfma_f32_32x32x16_bf16(pa3,PK(3),o[d0],0,0,0);
    #undef PK
  }
}

#ifndef ATTN_STORE16
#define ATTN_STORE16(p,v) (*(u32x4*)(p)=(v))
#endif
template<int THRL> __device__ __forceinline__ void attn_unit(int b,int h,int qb,const bf16*Q,const bf16*__restrict__ K,const bf16*__restrict__ V,bf16*O,const unsigned*__restrict__ MASK,const float*__restrict__ relb,char*shm){
  int tid0_=threadIdx.x; asm volatile("":"+v"(tid0_));
  const int tid=tid0_,lane=tid&63,r32=lane&31,hi=lane>>5; const int wid=__builtin_amdgcn_readfirstlane(tid>>6);
  const long rowbase=(long)b*SEQ; const int q0=qb*QB;
  const bf16*Qw=Q+(rowbase+q0+wid*QBLK)*DM+h*D;
  const bf16*Kh=K+rowbase*DM+h*D,*Vh=V+rowbase*DM+h*D;
  const unsigned lds0=(unsigned)(uintptr_t)shm;
  float*wsf=(float*)(shm+LDS_WS)+wid*64;
  const bf16*ksrc=Kh+(long)lane*DM+wid*8;
  const bf16*vsrc=Vh+(long)(16*(wid&3)+(lane>>2))*DM+(wid>>2)*32+(lane&3)*8;
  const unsigned kdst=lds0+LDS_K+wid*1024, vdst=lds0+LDS_V+wid*1024;
  #define DMA_K(t,slot) glds16(ksrc+(long)(t)*KVBLK*DM,(unsigned)__builtin_amdgcn_readfirstlane(kdst+(slot)))
  #define DMA_V(t,slot) glds16(vsrc+(long)(t)*KVBLK*DM,(unsigned)__builtin_amdgcn_readfirstlane(vdst+(slot)))
  const int vb0=(int)(lds0+LDS_V)+((lane>>4)&1)*32+(lane&3)*8+(4*hi+((lane&15)>>2))*64;
  const char*Kbase=shm+LDS_K; bf16x8 kf[8];
  const lds_cptr shm3=(lds_cptr)shm; const lds_cptr kp0=shm3+LDS_K+hi*1024+r32*16; const lds_cptr vp0=shm3+LDS_V+((lane>>4)&1)*32+(lane&3)*8+(4*hi+((lane&15)>>2))*64;
  const int NT=(q0+QB)/KVBLK;
  { int tid_=tid; asm volatile("":"+v"(tid_));
    const u32x4*msrc=(const u32x4*)(MASK+((size_t)(b*32)*SEQ+q0)*2); u32x4*mdst=(u32x4*)(shm+LDS_MSK);
    u32x4 mv[8]; const int nit=NT>>2;
    _Pragma("unroll") for(int k=0;k<8;++k){ const int i=tid_+k*(NW*64); if(k<nit) mv[k]=msrc[(size_t)(i>>7)*(SEQ*2/4)+(i&127)]; }
    _Pragma("unroll") for(int k=0;k<8;++k){ const int i=tid_+k*(NW*64); if(k<nit) mdst[i]=mv[k]; }
    for(int i=tid_;i<4*272;i+=NW*64){ const int sft=i/272, k=i-sft*272, d=200-(k+sft); float v=0.f;
      if(d>=0&&d<=112){ int bk; if(d<16)bk=d; else { bk=16+(int)(logf((float)d*(1.0f/16.0f))/2.0794415416798357f*16.0f); bk=bk>31?31:bk; } v=(relb[bk*NHEAD+h]-relb[31*NHEAD+h])*1.4426950408889634f; }
      ((float*)(shm+LDS_TAB))[i]=v; } }
  const unsigned*mskw=(const unsigned*)(shm+LDS_MSK)+(wid*QBLK+r32)*2+hi;
  const int qpos=q0+wid*QBLK+r32;
  DMA_K(0,0);DMA_V(0,0);DMA_K(1,SLOTB);
  bf16x8 qr[4];
  #pragma unroll
  for(int d0=0;d0<4;++d0)qr[d0]=*reinterpret_cast<const bf16x8*>(&Qw[(long)r32*DM+d0*16+hi*8]);
  float mhat=0.f,l_reg=0.f;f32x16 o[2];o[0]=f32x16{};o[1]=f32x16{};f32x16 negm=f32x16{};asm volatile("":"+v"(negm));
  #define CMASK(P0,P1,t) do{ if((t)>=NT-7 && 64*(t)+63+127>=q0+wid*QBLK) tbias(P0,P1,(t),qpos,hi,shm3+LDS_TAB); }while(0)
  bool resc=false;
  #define START(P0,P1) do{ const float rm=rowmax(P0,P1); resc=false; \
    { const float dl=rm; mhat=fadd_s(mhat,dl); \
      _Pragma("unroll") for(int r=0;r<16;++r){P0[r]=fsub_s(P0[r],dl);P1[r]=fsub_s(P1[r],dl);} \
      _Pragma("unroll") for(int r=0;r<16;++r)negm[r]=-mhat; asm volatile("":"+v"(negm)); } \
    _Pragma("unroll") for(int r=0;r<16;++r)P0[r]=__builtin_amdgcn_exp2f(P0[r]); }while(0)
  #define RESC() do{ if(resc){ asm volatile("s_waitcnt lgkmcnt(0)":::"memory"); \
      _Pragma("unroll") for(int d_=0;d_<2;++d_) _Pragma("unroll") for(int r=0;r<16;++r)o[d_][r]*=wsf[crow(r,hi)]; } }while(0)
  f32x16 pA0,pA1,pB0,pB1;
  int sl_prev=0,sl_cur=0,sl_next=SLOTB;
  #define ROT() do{sl_prev=sl_cur;sl_cur=sl_next;sl_next=(sl_next==(NSLOT-1)*SLOTB)?0:sl_next+SLOTB;}while(0)
  DMA_K(2,2*SLOTB);
  WAIT_BAR(3);
  qkt(pA0,pA1,Kbase,qr,negm,r32,hi);asm volatile("s_nop 15\n\ts_nop 7":"+v"(pA0),"+v"(pA1));CMASK(pA0,pA1,0);
  START(pA0,pA1);
  _Pragma("unroll") for(int r=0;r<16;++r)pA1[r]=__builtin_amdgcn_exp2f(pA1[r]);
  { const unsigned mw0=mskw[0]; _Pragma("unroll") for(int r=0;r<16;++r){pA0[r]=mkeep(pA0[r],mw0,r);pA1[r]=mkeep(pA1[r],mw0,16+r);} }
  WAIT_BAR(0);
  DMA_K(3,0);DMA_V(1,SLOTB);
  ROT();
  kload8(kf,kp0+sl_cur);
  WAIT_BAR(2);
  s16x4 vlo[8],vhi[8]; u32x4 pw0,pw1,pw2,pw3;
  #define PKW(P,B) cvtpk_s(P[B],P[B+1])
  #define PAF(k) __builtin_bit_cast(bf16x8,pw##k)
  #define VFR(i) (bf16x8){vlo[i][0],vlo[i][1],vlo[i][2],vlo[i][3],vhi[i][0],vhi[i][1],vhi[i][2],vhi[i][3]}
  #define PIN(x) asm volatile("":"+v"(x))
  #define MX3(a,b,c) __builtin_fmaxf(__builtin_fmaxf((a),(b)),(c))
  #define GAPA(MF,A0,A1,A2,A3,W0,W1,PW) do{ MF; sacc+=A0; sacc+=A1; sacc+=A2; sacc+=A3; PIN(sacc); W0; W1; PIN(PW); SBAR(); }while(0)
  #define EX(v) __builtin_amdgcn_exp2f(v)
  #define GAPB(MF,X,B,MB) do{ MF; X[B]=mkeep(EX(X[B]),mw_,MB+B); X[B+1]=mkeep(EX(X[B+1]),mw_,MB+B+1); X[B+2]=mkeep(EX(X[B+2]),mw_,MB+B+2); X[B+3]=mkeep(EX(X[B+3]),mw_,MB+B+3); PIN(X); SBAR(); }while(0)
  #define VRD(i) do{ vlo[i]=vtr(vp_+(((i)>>2)*4096+((i)&3)*1024)); vhi[i]=vtr(vp_+(((i)>>2)*4096+((i)&3)*1024+512)); }while(0)
  #define KRD(G,j) do{ if(G){ kload2(kf,kp0+sl_next,j); SBAR(); } }while(0)
  #define STEP(C0,C1,P0,P1,t,GK,GV,GL) do{ SBAR(); \
    const lds_cptr vp_=vp0+sl_prev; const unsigned mw_=mskw[(t)*512]; \
    VRD(0); SBAR(); float sacc=(P0[0]+P0[1]); \
    GAPA(C0=__builtin_amdgcn_mfma_f32_32x32x16_bf16(kf[0],qr[0],negm,0,0,0), P0[2],P0[3],P0[4],P0[5],     pw0[0]=PKW(P0,0), pw0[1]=PKW(P0,2), pw0); \
    VRD(4); SBAR(); GAPA(C1=__builtin_amdgcn_mfma_f32_32x32x16_bf16(kf[1],qr[0],negm,0,0,0), P0[6],P0[7],P0[8],P0[9],     pw0[2]=PKW(P0,4), pw0[3]=PKW(P0,6), pw0); \
    VRD(1); SBAR(); GAPA(C0=__builtin_amdgcn_mfma_f32_32x32x16_bf16(kf[2],qr[1],C0,0,0,0),   P0[10],P0[11],P0[12],P0[13], pw1[0]=PKW(P0,8), pw1[1]=PKW(P0,10), pw1); \
    VRD(5); SBAR(); GAPA(C1=__builtin_amdgcn_mfma_f32_32x32x16_bf16(kf[3],qr[1],C1,0,0,0),   P0[14],P0[15],P1[0],P1[1],   pw1[2]=PKW(P0,12),pw1[3]=PKW(P0,14), pw1); \
    VRD(2); SBAR(); GAPA(C0=__builtin_amdgcn_mfma_f32_32x32x16_bf16(kf[4],qr[2],C0,0,0,0),   P1[2],P1[3],P1[4],P1[5],     pw2[0]=PKW(P1,0), pw2[1]=PKW(P1,2), pw2); \
    VRD(6); SBAR(); GAPA(C1=__builtin_amdgcn_mfma_f32_32x32x16_bf16(kf[5],qr[2],C1,0,0,0),   P1[6],P1[7],P1[8],P1[9],     pw2[2]=PKW(P1,4), pw2[3]=PKW(P1,6), pw2); \
    VRD(3); SBAR(); GAPA(C0=__builtin_amdgcn_mfma_f32_32x32x16_bf16(kf[6],qr[3],C0,0,0,0),   P1[10],P1[11],P1[12],P1[13], pw3[0]=PKW(P1,8), pw3[1]=PKW(P1,10), pw3); \
    VRD(7); SBAR(); GAPA(C1=__builtin_amdgcn_mfma_f32_32x32x16_bf16(kf[7],qr[3],C1,0,0,0),   P1[14],P1[15],0.f,0.f,       pw3[2]=PKW(P1,12),pw3[3]=PKW(P1,14), pw3); \
    l_reg+=sacc; \
    if(GK){DMA_K((t)+3,sl_cur);} if(GV){DMA_V((t)+1,sl_next);} \
    CMASK(C0,C1,t); \
    { float a=MX3(C0[0],C0[1],C1[0]),b=MX3(C0[2],C0[3],C1[1]); a=MX3(a,C1[2],C1[3]); \
      _Pragma("unroll") for(int r=4;r<16;r+=4){a=MX3(a,C0[r],C0[r+1]);b=MX3(b,C0[r+2],C0[r+3]);a=MX3(a,C1[r],C1[r+1]);b=MX3(b,C1[r+2],C1[r+3]);} \
      float rm=__builtin_fmaxf(a,b); { auto rr=__builtin_amdgcn_permlane32_swap(__float_as_uint(rm),__float_as_uint(rm),false,false); rm=__builtin_fmaxf(__uint_as_float(rr[0]),__uint_as_float(rr[1])); } \
      resc=false; \
      if(__builtin_expect(__any(rm>(float)THRL),0)){ const float dl=__builtin_fmaxf(rm,0.f); mhat+=dl; \
        _Pragma("unroll") for(int r=0;r<16;++r){C0[r]-=dl;C1[r]-=dl;} \
        _Pragma("unroll") for(int r=0;r<16;++r)negm[r]=-mhat; asm volatile("":"+v"(negm)); \
        const float f=__builtin_amdgcn_exp2f(-dl); l_reg*=f; if(hi==0)wsf[r32]=f; resc=true; } } \
    SBAR(); \
    GAPB(o[0]=__builtin_amdgcn_mfma_f32_32x32x16_bf16(PAF(0),VFR(0),o[0],0,0,0), C0,0,0); \
    GAPB(o[1]=__builtin_amdgcn_mfma_f32_32x32x16_bf16(PAF(0),VFR(4),o[1],0,0,0), C0,4,0); \
    KRD(GL,0); GAPB(o[0]=__builtin_amdgcn_mfma_f32_32x32x16_bf16(PAF(1),VFR(1),o[0],0,0,0), C0,8,0); \
    KRD(GL,1); GAPB(o[1]=__builtin_amdgcn_mfma_f32_32x32x16_bf16(PAF(1),VFR(5),o[1],0,0,0), C0,12,0); \
    KRD(GL,2); GAPB(o[0]=__builtin_amdgcn_mfma_f32_32x32x16_bf16(PAF(2),VFR(2),o[0],0,0,0), C1,0,16); \
    KRD(GL,3); GAPB(o[1]=__builtin_amdgcn_mfma_f32_32x32x16_bf16(PAF(2),VFR(6),o[1],0,0,0), C1,4,16); \
    GAPB(o[0]=__builtin_amdgcn_mfma_f32_32x32x16_bf16(PAF(3),VFR(3),o[0],0,0,0), C1,8,16); \
    GAPB(o[1]=__builtin_amdgcn_mfma_f32_32x32x16_bf16(PAF(3),VFR(7),o[1],0,0,0), C1,12,16); \
    }while(0)
  int t=1;
  #undef CMASK
  #define CMASK(P0,P1,t) do{}while(0)
  for(;t+7<NT;t+=2){
    STEP(pB0,pB1,pA0,pA1,t,true,true,true);     WAIT_BAR(2); RESC(); ROT();
    STEP(pA0,pA1,pB0,pB1,t+1,true,true,true);   WAIT_BAR(2); RESC(); ROT();
  }
  #undef CMASK
  #define CMASK(P0,P1,t) do{ if(64*(t)+63+127>=q0+wid*QBLK) tbias(P0,P1,(t),qpos,hi,shm3+LDS_TAB); }while(0)
  #define ENDW(tt) do{ if((tt)+3<NT){WAIT_BAR(2);} else if((tt)+2<NT){WAIT_BAR(1);} else {WAIT_BAR(0);} }while(0)
  for(;t+1<NT;t+=2){
    STEP(pB0,pB1,pA0,pA1,t,(t+3<NT),(t+1<NT),(t+1<NT));       ENDW(t);   RESC(); ROT();
    STEP(pA0,pA1,pB0,pB1,t+1,(t+4<NT),(t+2<NT),(t+2<NT));     ENDW(t+1); RESC(); ROT();
  }
  STEP(pB0,pB1,pA0,pA1,NT-1,false,false,false); RESC();
  { float sacc=pB0[0]+pB0[1]; _Pragma("unroll") for(int r=2;r<16;++r)sacc+=pB0[r]; _Pragma("unroll") for(int r=0;r<16;++r)sacc+=pB1[r]; l_reg+=sacc;
    pw0=(u32x4){PKW(pB0,0),PKW(pB0,2),PKW(pB0,4),PKW(pB0,6)};pw1=(u32x4){PKW(pB0,8),PKW(pB0,10),PKW(pB0,12),PKW(pB0,14)};pw2=(u32x4){PKW(pB1,0),PKW(pB1,2),PKW(pB1,4),PKW(pB1,6)};pw3=(u32x4){PKW(pB1,8),PKW(pB1,10),PKW(pB1,12),PKW(pB1,14)};
    SBAR(); pv(o,vb0+sl_cur,PAF(0),PAF(1),PAF(2),PAF(3)); }
  #undef PKW
  #undef PAF
  #undef VFR
  #undef PIN
  #undef MX3
  #undef GAPA
  #undef GAPB
  #undef EX
  #undef VRD
  #undef KRD
  #undef STEP
  #undef ENDW
  {auto rr=__builtin_amdgcn_permlane32_swap(__float_as_uint(l_reg),__float_as_uint(l_reg),false,false);l_reg=__uint_as_float(rr[0])+__uint_as_float(rr[1]);}
  if(hi==0)wsf[32+r32]=l_reg;asm volatile("s_waitcnt lgkmcnt(0)":::"memory");
  float rli[16];
  #pragma unroll
  for(int r=0;r<16;++r)rli[r]=__builtin_amdgcn_rcpf(wsf[32+crow(r,hi)]);
  bf16*Ow=O+(rowbase+q0+wid*QBLK)*PO+h*D;
  { bf16*stg=(bf16*)(shm+LDS_OST)+wid*2048;
    #pragma unroll
    for(int r=0;r<16;++r){const int orow=crow(r,hi);
      #pragma unroll
      for(int d0=0;d0<2;++d0)stg[orow*64+d0*32+r32]=__float2bfloat16(o[d0][r]*rli[r]);}
    asm volatile("s_waitcnt lgkmcnt(0)":::"memory");
    #pragma unroll
    for(int i=0;i<4;++i){const int row=i*8+(lane>>3),ch=lane&7; const u32x4 v=*(const u32x4*)(stg+row*64+ch*8); ATTN_STORE16(Ow+(long)row*PO+ch*8,v);} }
  asm volatile("s_waitcnt lgkmcnt(0)\n\ts_barrier":::"memory");
  #undef DMA_K
  #undef DMA_V
  #undef CMASK
  #undef START
  #undef RESC
  #undef ROT
}
struct AttnTensors { const bf16* Q; const bf16* K; const bf16* V; bf16* O; const unsigned* MASK; const float* relb; };
struct AttnUnit { int bh; int qb; };
constexpr int ATTN_LDS_BYTES=LDS_TOTAL;
#undef SBAR
#undef WAIT_BAR
}
constexpr int NWAVES = 8;
#ifndef MK_N_LAUNCHES
#define MK_N_LAUNCHES 1
#endif
constexpr int PER_PHASE = 10;
constexpr int N_LAUNCHES = (MK_N_LAUNCHES == 1) ? 1 : PER_PHASE;
constexpr int M = 8 * 2048;
constexpr size_t MiB = 1u << 20;
constexpr size_t WS_CTL = 0, CTL_ZERO_BYTES = 65536;
constexpr size_t WS_RSTD1 = 1 * MiB, WS_ROWSS = 2 * MiB, WS_WR = 3 * MiB, WS_BLAST = 3 * MiB + 512 * 1024, WS_TOKINFO = 4 * MiB, WS_LISTS = 5 * MiB, WS_LSC = 7 * MiB;
constexpr size_t WS_WO = 16 * MiB, WS_WGU = 18 * MiB, WS_WD = 50 * MiB, WS_XB = 66 * MiB, WS_MASK = 66 * MiB, WS_SB = 70 * MiB, WS_WIN = 98 * MiB;
constexpr size_t WS_QN = 106 * MiB, WS_KN = 122 * MiB, WS_VN = 138 * MiB, WS_XN2 = 106 * MiB, WS_IQ = 154 * MiB, WS_MISC = 162 * MiB, WS_QB = 164 * MiB, WS_KB = 172 * MiB, WS_VB = 180 * MiB, WS_RG = 196 * MiB;
constexpr size_t WS_MIX = 212 * MiB, WS_HID = 138 * MiB, WS_Y = 158 * MiB, WS_END = 244 * MiB;
constexpr int CW_TMO = 0, CW_CODE = 1, CW_BAR = 4096, CW_CNT = 15360;
constexpr int RING_BYTES = 154624;
constexpr int LDSCTL_OFF = RING_BYTES, MISC_OFF = LDSCTL_OFF, TOFF_OFF = LDSCTL_OFF + 256;
constexpr int LDS_BYTES = RING_BYTES + 1024;
static_assert(attn_body::ATTN_LDS_BYTES <= RING_BYTES, "attention LDS");
#ifndef REP_IDX
#define REP_IDX 1
#endif
#ifndef REP_GLAA
#define REP_GLAA 1
#endif
#ifndef REP_ATT
#define REP_ATT 1
#endif
#ifndef REP_GLAC
#define REP_GLAC 1
#endif
#ifndef REP_IDX_SCORE
#define REP_IDX_SCORE 1
#endif
#ifndef REP_IDX_SEL
#define REP_IDX_SEL 1
#endif
#ifndef REP_SEL_A
#define REP_SEL_A 1
#endif
#ifndef REP_SEL_B
#define REP_SEL_B 1
#endif
#ifndef REP_SEL_C
#define REP_SEL_C 1
#endif
#define GAS __attribute__((address_space(1)))
#define LAS __attribute__((address_space(3)))
typedef unsigned short bf16;
typedef unsigned v4u __attribute__((ext_vector_type(4)));
typedef float f32x4 __attribute__((ext_vector_type(4)));
typedef short bf16x8 __attribute__((ext_vector_type(8)));
typedef GAS unsigned gu32;
typedef GAS unsigned long long gu64;
#define RLX_AGENT __ATOMIC_RELAXED, __HIP_MEMORY_SCOPE_AGENT
#define LDS_WAIT() asm volatile("s_waitcnt lgkmcnt(0)" ::: "memory")
#define VM_WAIT() asm volatile("s_waitcnt vmcnt(0)" ::: "memory")
__device__ __forceinline__ unsigned long long rt() { return __builtin_amdgcn_s_memrealtime(); }
__device__ __forceinline__ unsigned f2bf(float f) { unsigned u = __builtin_bit_cast(unsigned, f); return (u + 0x7fffu + ((u >> 16) & 1u)) >> 16; }
__device__ __forceinline__ unsigned pk2(float lo, float hi) { return f2bf(lo) | (f2bf(hi) << 16); }

#define XB_TMO      128
#define XB_XCNT(j)  (256  + 64 * (j))
#define XB_XSUB(j)  (1280 + 64 * (j))
#define XB_XGEN(j)  (2304 + 64 * (j))
#define XB_TOP      3328
#define XB_TOPGEN   3392
#define XCD_BAR_WORDS 3456
#define XB_SPIN_CAP (1u << 18)

__device__ __forceinline__ unsigned xb_ld(unsigned* p)              { return __hip_atomic_load(p, __ATOMIC_RELAXED, __HIP_MEMORY_SCOPE_AGENT); }
__device__ __forceinline__ unsigned xb_add(unsigned* p, unsigned v) { return __hip_atomic_fetch_add(p, v, __ATOMIC_RELAXED, __HIP_MEMORY_SCOPE_AGENT); }
__device__ __forceinline__ unsigned xb_xcc_id() { return (unsigned)__builtin_amdgcn_s_getreg((3 << 11) | 20) & 0xFu; }
#define XB_SPIN(cond, bar) do { unsigned _sp = 0; while (cond) { __builtin_amdgcn_s_sleep(1); \
    if ((++_sp & 255u) == 0u) { if (xb_ld(&(bar)[XB_TMO])) break; if (_sp > XB_SPIN_CAP) { atomicAdd(&(bar)[XB_TMO], 1u); break; } } } } while (0)

struct XcdBarrier {
    unsigned* bar; unsigned x;
    volatile LAS unsigned* st;
};

__device__ __forceinline__ XcdBarrier xcd_barrier_post(unsigned* bar, volatile LAS unsigned* st) {
    XcdBarrier b; b.bar = bar; b.x = xb_xcc_id(); b.st = st;
    if (threadIdx.x == 0) (void)xb_add(&bar[XB_XCNT(b.x)], 1u);
    return b;
}
__device__ __forceinline__ void xcd_barrier_complete(unsigned* bar, unsigned x, unsigned& nloc, unsigned& nx) {
    const unsigned G = gridDim.x * gridDim.y * gridDim.z;
    unsigned sum, cnt, mine, sp = 0u;
    for (;;) {
        sum = 0u; cnt = 0u; mine = 0u;
#pragma unroll
        for (unsigned j = 0; j < 16; ++j) { const unsigned c = xb_ld(&bar[XB_XCNT(j)]); sum += c; cnt += (c > 0u) ? 1u : 0u; mine = (j == x) ? c : mine; }
        if (sum == G) break;
        __builtin_amdgcn_s_sleep(1);
        if ((++sp & 255u) == 0u) { if (xb_ld(&bar[XB_TMO])) break; if (sp > XB_SPIN_CAP) { atomicAdd(&bar[XB_TMO], 1u); break; } }
    }
    nloc = mine > 0u ? mine : 1u; nx = cnt > 0u ? cnt : 1u;
}

__device__ __forceinline__ void xcd_barrier(const XcdBarrier& b) {
    asm volatile("s_waitcnt vmcnt(0)" ::: "memory");
    __syncthreads();
    if (threadIdx.x == 0) {
        unsigned* bar = b.bar;
        __builtin_amdgcn_s_waitcnt(0);
        unsigned nloc = b.st[0], nx = b.st[1];
        if (nloc == 0u) { xcd_barrier_complete(bar, b.x, nloc, nx); b.st[0] = nloc; b.st[1] = nx; }
        const unsigned old = xb_add(&bar[XB_XSUB(b.x)], 1u);
        const unsigned gen = old / nloc;
        if (old + 1u == (gen + 1u) * nloc) {
            __builtin_amdgcn_fence(__ATOMIC_RELEASE, "agent");
            asm volatile("s_waitcnt vmcnt(0)" ::: "memory");
            const unsigned og = xb_add(&bar[XB_TOP], 1u);
            const unsigned tg = og / nx;
            if (og + 1u == (tg + 1u) * nx) xb_add(&bar[XB_TOPGEN], 1u);
            else XB_SPIN(xb_ld(&bar[XB_TOPGEN]) == tg, bar);
            __builtin_amdgcn_fence(__ATOMIC_ACQUIRE, "agent");
            xb_add(&bar[XB_XGEN(b.x)], 1u);
            asm volatile("s_waitcnt vmcnt(0)" ::: "memory");
        } else {
            XB_SPIN(xb_ld(&bar[XB_XGEN(b.x)]) == gen, bar);
            __builtin_amdgcn_fence(__ATOMIC_ACQUIRE, "agent");
            asm volatile("s_waitcnt vmcnt(0)" ::: "memory");
        }
    }
    __syncthreads();
}
typedef float f32x2 __attribute__((ext_vector_type(2)));
typedef unsigned v2u __attribute__((ext_vector_type(2)));
__device__ __forceinline__ float bf2f(unsigned short b) { return __uint_as_float((unsigned)b << 16); }
__device__ __forceinline__ float bflo(unsigned w) { return __uint_as_float(w << 16); }
__device__ __forceinline__ float bfhi(unsigned w) { return __uint_as_float(w & 0xffff0000u); }
__device__ __forceinline__ float wave_sum(float v) {
#pragma unroll
    for (int o = 1; o < 64; o <<= 1) v += __shfl_xor(v, o);
    return v;
}
__device__ __forceinline__ float wave_max(float v) {
#pragma unroll
    for (int o = 1; o < 64; o <<= 1) v = fmaxf(v, __shfl_xor(v, o));
    return v;
}
__device__ __forceinline__ float wave_min(float v) {
#pragma unroll
    for (int o = 1; o < 64; o <<= 1) v = fminf(v, __shfl_xor(v, o));
    return v;
}
#define WG_SYNC() __syncthreads()
#define DPP_STEP_I(v, ctrl) __builtin_amdgcn_update_dpp(0, (v), (ctrl), 0xF, 0xF, false)
__device__ __forceinline__ int wave_isum(int v) {
    v += DPP_STEP_I(v, 0xB1); v += DPP_STEP_I(v, 0x4E); v += DPP_STEP_I(v, 0x141); v += DPP_STEP_I(v, 0x140);
    return __builtin_amdgcn_readlane(v, 0) + __builtin_amdgcn_readlane(v, 16) + __builtin_amdgcn_readlane(v, 32) + __builtin_amdgcn_readlane(v, 48);
}
#define DPP_STEP_F(v, ctrl) __uint_as_float((unsigned)__builtin_amdgcn_update_dpp(0, (int)__float_as_uint(v), (ctrl), 0xF, 0xF, false))
#define RDL_F(v, l) __uint_as_float((unsigned)__builtin_amdgcn_readlane((int)__float_as_uint(v), (l)))
__device__ __forceinline__ float wave_fsum(float v) {
    v += DPP_STEP_F(v, 0xB1); v += DPP_STEP_F(v, 0x4E); v += DPP_STEP_F(v, 0x141); v += DPP_STEP_F(v, 0x140);
    return (RDL_F(v, 0) + RDL_F(v, 16)) + (RDL_F(v, 32) + RDL_F(v, 48));
}
__device__ __forceinline__ float wave_fmax(float v) {
    v = fmaxf(v, DPP_STEP_F(v, 0xB1)); v = fmaxf(v, DPP_STEP_F(v, 0x4E)); v = fmaxf(v, DPP_STEP_F(v, 0x141)); v = fmaxf(v, DPP_STEP_F(v, 0x140));
    return fmaxf(fmaxf(RDL_F(v, 0), RDL_F(v, 16)), fmaxf(RDL_F(v, 32), RDL_F(v, 48)));
}
__device__ __forceinline__ float wave_fmin(float v) {
    v = fminf(v, DPP_STEP_F(v, 0xB1)); v = fminf(v, DPP_STEP_F(v, 0x4E)); v = fminf(v, DPP_STEP_F(v, 0x141)); v = fminf(v, DPP_STEP_F(v, 0x140));
    return fminf(fminf(RDL_F(v, 0), RDL_F(v, 16)), fminf(RDL_F(v, 32), RDL_F(v, 48)));
}

__device__ __forceinline__ int win_vrow(int n) {
    if (n < 1024) { const int base = (n < 512) ? 0 : 512, m = n - base, hh = m >> 6, d = m & 63; return base + 256 * (hh >> 2) + 128 * (d >> 5) + 32 * (hh & 3) + (d & 31); }
    if (n < 1792) return n;
    if (n < 1832) return 3328 + (n - 1792);
    if (n < 2088) return 1792 + (n - 1832);
    if (n < 2344) return 2048 + (n - 2088);
    if (n < 2856) return 2304 + (n - 2344);
    if (n < 2872) return 3328 + 40 + (n - 2856);
    return 2816 + (n - 2872);
}
template <int KIND>
__device__ __forceinline__ void p0_transpose_item(const float* __restrict__ W, int K, int N, const float* __restrict__ gain, bf16* WT, LAS float* scr, int item, int lane) {
    const int nblk = (N + 31) / 32, kb = item / nblk, nb = item % nblk, k0 = 64 * kb, n0 = 32 * nb;
    const int nn = n0 + (lane & 31); const bool ok = nn < N;
#pragma unroll 8
    for (int i = 0; i < 32; ++i) { const int kk = 2 * i + (lane >> 5); float v = ok ? W[(size_t)(k0 + kk) * N + nn] : 0.f; if (gain) v *= gain[k0 + kk]; scr[kk * 33 + (lane & 31)] = v; }
    LDS_WAIT(); asm volatile("" ::: "memory");
    const int c = lane & 7;
#pragma unroll
    for (int j = 0; j < 4; ++j) { const int n = (lane >> 3) + 8 * j; const LAS float* s = scr + (8 * c) * 33 + n;
        v4u o; o.x = pk2(s[0 * 33], s[1 * 33]); o.y = pk2(s[2 * 33], s[3 * 33]); o.z = pk2(s[4 * 33], s[5 * 33]); o.w = pk2(s[6 * 33], s[7 * 33]);
        const int gn = n0 + n; int row;
        if (KIND == 0) row = win_vrow(gn); else if (KIND == 1) row = gn; else if (KIND == 2) row = (gn >> 7) * 256 + (gn & 127); else row = (gn >> 7) * 256 + 128 + (gn & 127);
        if (gn < N) *(GAS v4u*)(WT + (size_t)row * K + k0 + 8 * c) = o; }
    LDS_WAIT(); asm volatile("" ::: "memory");
}

constexpr int SCP = 2064;
__device__ __forceinline__ int crow_(int r, int hi) { return (r & 3) + 8 * (r >> 2) + 4 * hi; }
__device__ __forceinline__ void idx_item(LAS unsigned char* lds, int b, int p, const bf16* __restrict__ IQ, const bf16* __restrict__ MISC, unsigned* __restrict__ MASK, int lane, int wid) {
    const int q0 = p * 16, fr = lane & 15, fq = lane >> 4;
    LAS float* SC = (LAS float*)lds;
    const size_t rowq = (size_t)b * 2048 + q0 + fr;
    bf16x8 Bq[8]; float sinf[8];
    {   const v4u wraw = *(const v4u*)(MISC + rowq * 64 + 32);
        const unsigned wr_[4] = {wraw.x, wraw.y, wraw.z, wraw.w};
#pragma unroll
        for (int h = 0; h < 8; ++h) { const float w = ((h & 1) ? bfhi(wr_[h >> 1]) : bflo(wr_[h >> 1])) * 0.0625f;
            const v4u raw = *(const v4u*)(IQ + rowq * 256 + h * 32 + fq * 8);
            v4u o; o.x = pk2(bflo(raw.x) * w, bfhi(raw.x) * w); o.y = pk2(bflo(raw.y) * w, bfhi(raw.y) * w); o.z = pk2(bflo(raw.z) * w, bfhi(raw.z) * w); o.w = pk2(bflo(raw.w) * w, bfhi(raw.w) * w);
            Bq[h] = __builtin_bit_cast(bf16x8, o); sinf[h] = (w > 0.f) ? __builtin_inff() : -__builtin_inff(); } }
    const int nkt = p + 1;
    const bf16* ikb = MISC + ((size_t)b * 2048 + fr) * 64 + fq * 8;
    for (int rep_ = 0; rep_ < REP_IDX_SCORE; ++rep_)
    for (int kt0 = wid; kt0 < nkt; kt0 += 32) {
        f32x4 acc[4]; bf16x8 A[4];
#pragma unroll
        for (int u = 0; u < 4; ++u) { const int kt = kt0 + 8 * u; acc[u] = (f32x4){0.f, 0.f, 0.f, 0.f}; if (kt < nkt) A[u] = *(const bf16x8*)(ikb + (size_t)kt * 16 * 64); else A[u] = (bf16x8){0, 0, 0, 0, 0, 0, 0, 0}; }
#pragma unroll
        for (int h = 0; h < 8; ++h)
#pragma unroll
            for (int u = 0; u < 4; ++u) { const f32x4 t = __builtin_amdgcn_mfma_f32_16x16x32_bf16(A[u], Bq[h], acc[u], 0, 0, 0);
#pragma unroll
                for (int i = 0; i < 4; ++i) acc[u][i] = __builtin_amdgcn_fmed3f(t[i], acc[u][i], sinf[h]); }
#pragma unroll
        for (int u = 0; u < 4; ++u) { const int kt = kt0 + 8 * u;
            if (kt < nkt) { if (kt == nkt - 1) {
#pragma unroll
                    for (int i = 0; i < 4; ++i) if (4 * fq + i > fr) acc[u][i] = -__builtin_inff(); }
                *(LAS f32x4*)(SC + fr * SCP + kt * 16 + 4 * fq) = acc[u]; } }
    }
    WG_SYNC();
    const int kap = 32 * ((lane >> 4) & 1) + crow_(lane & 15, lane >> 5);
#define IDX_COUNT(dst, expr) do { int cl__ = 0; _Pragma("unroll") for (int g__ = 0; g__ < 4; ++g__) if (8 * g__ < ntile) { _Pragma("unroll") for (int jj__ = 0; jj__ < 8; ++jj__) { const int j = 8 * g__ + jj__; cl__ += (expr) ? 1 : 0; } } \
        dst = wave_isum(cl__); } while (0)
#define IDX_UNI(v) __uint_as_float((unsigned)__builtin_amdgcn_readfirstlane((int)__float_as_uint(v)))
    for (int rep_ = 0; rep_ < REP_IDX_SEL; ++rep_)
    for (int rr = 0; rr < 2; ++rr) {
        const int r = 2 * wid + rr, q = q0 + r, n = q + 1, ntile = (q >> 6) + 1, ngrp = (ntile + 7) >> 3;
        const float NINF = -__builtin_inff();
        float x[32]; unsigned vmask = 0u;
        for (int rpa = 0; rpa < REP_SEL_A; ++rpa) { int off_ = 0; asm volatile("" : "+v"(off_)); vmask = 0u;
#pragma unroll
        for (int j = 0; j < 32; ++j) x[j] = SC[r * SCP + 64 * j + kap + off_];
#pragma unroll
        for (int j = 0; j < 32; ++j) { const bool v = (64 * j + kap + off_) <= q; vmask |= v ? (1u << j) : 0u; x[j] = v ? x[j] : NINF; }
        }
        unsigned selm = vmask;
        for (int rpb = 0; rpb < REP_SEL_B; ++rpb) { asm volatile("" : "+v"(x[0]), "+v"(vmask)); selm = vmask;
        if (n > 256) {
            float mx = NINF, mn = __builtin_inff(), s1 = 0.f, s2 = 0.f;
#pragma unroll
            for (int g = 0; g < 4; ++g) if (g < ngrp) {
#pragma unroll
                for (int jj = 0; jj < 8; ++jj) { const int j = 8 * g + jj; const bool v = (vmask >> j) & 1u; const float xv = v ? x[j] : 0.f; mx = fmaxf(mx, x[j]); mn = fminf(mn, v ? x[j] : __builtin_inff()); s1 += xv; s2 += xv * xv; } }
            float hi = IDX_UNI(wave_fmax(mx)), lo = IDX_UNI(wave_fmin(mn));
            const float fn = (float)n, mu = wave_fsum(s1) / fn, var = fmaxf(wave_fsum(s2) / fn - mu * mu, 0.f);
            int c_lo = n, c_hi = 1;
            bool tie = false, found = false; float tv = hi, thr = hi; int need = 256;
            float mid; { const float pq = 256.0f / fn, pp = pq <= 0.5f ? pq : 1.0f - pq; const float t = sqrtf(-2.0f * __logf(pp)); float z = t - (2.30753f + 0.27061f * t) / (1.0f + t * (0.99229f + 0.04481f * t)); z = pq <= 0.5f ? z : -z; mid = IDX_UNI(mu + z * sqrtf(var)); }
            int side = 0;
            for (int it = 0; it < 40; ++it) {
                if (it > 0 || !(mid > lo && mid < hi)) {
                    mid = 0.5f * lo + 0.5f * hi;
                    if (side > -2 && side < 2) { const float fr_ = ((float)(c_lo - 256) + 0.5f) * __builtin_amdgcn_rcpf((float)(c_lo - c_hi)); const float m2 = lo + (hi - lo) * fr_; if (m2 > lo && m2 < hi) mid = m2; } else side = 0;
                    mid = IDX_UNI(mid);
                }
                if (!(mid > lo && mid < hi)) break;
                unsigned a0 = 0u, a1 = 0u;
#pragma unroll
                for (int g = 1; g >= 0; --g) if (g < ngrp) {
#pragma unroll
                    for (int jj = 7; jj >= 0; --jj) a0 = __builtin_amdgcn_alignbit(a0, __float_as_uint(x[8 * g + jj] - mid), 31); }
#pragma unroll
                for (int g = 3; g >= 2; --g) if (g < ngrp) {
#pragma unroll
                    for (int jj = 7; jj >= 0; --jj) a1 = __builtin_amdgcn_alignbit(a1, __float_as_uint(x[8 * g + jj] - mid), 31); }
                const int c = 64 * 8 * ngrp - wave_isum(__builtin_popcount(a0) + __builtin_popcount(a1));
                if (c == 256) { found = true; selm = vmask & ~(a0 | (a1 << 16)); thr = mid; break; }
                if (c > 256) { lo = mid; c_lo = c; side = side > 0 ? side + 1 : 1; } else { hi = mid; c_hi = c; side = side < 0 ? side - 1 : -1; }
            }
            if (!found) {
                IDX_COUNT(c_hi, x[j] >= hi);
                if (c_hi >= 256) { if (c_hi == 256) { thr = hi; found = true; } else { tie = true; tv = hi; need = 256; } }
                else for (int it = 0; it < 4096; ++it) {
                    float m = NINF;
#pragma unroll
                    for (int g = 0; g < 4; ++g) if (g < ngrp) {
#pragma unroll
                        for (int jj = 0; jj < 8; ++jj) { const int j = 8 * g + jj; m = fmaxf(m, (x[j] < hi) ? x[j] : NINF); } }
                    const float v1 = IDX_UNI(wave_fmax(m));
                    int c; IDX_COUNT(c, x[j] >= v1);
                    if (c >= 256) { if (c == 256) { thr = v1; found = true; } else { tie = true; tv = v1; need = 256 - c_hi; } break; }
                    hi = v1; c_hi = c;
                }
                if (!tie) { selm = 0u;
#pragma unroll
                    for (int j = 0; j < 32; ++j) selm |= (x[j] >= thr) ? (1u << j) : 0u;
                } else {
                    int cum = 0, jstar = 32, needp = 0; unsigned tiem = 0u; selm = 0u;
#pragma unroll
                    for (int j = 0; j < 32; ++j) { const bool t = (x[j] == tv); tiem |= t ? (1u << j) : 0u; const int cj = __builtin_popcountll(__ballot(t));
                        if (jstar == 32 && cum + cj > need) { jstar = j; needp = need - cum; } cum += cj; }
                    const bool tstar = (jstar < 32) && ((tiem >> (jstar & 31)) & 1u);
                    int kL = 0, kH = 63;
                    if (jstar < 32 && needp > 0) { while (kL < kH) { const int km = (kL + kH) >> 1; const int c = __builtin_popcountll(__ballot(tstar && kap <= km)); if (c >= needp) kH = km; else kL = km + 1; } }
                    else kL = -1;
#pragma unroll
                    for (int j = 0; j < 32; ++j) { const bool t = (tiem >> j) & 1u; const bool ts = t && (j < jstar || (j == jstar && kap <= kL)); selm |= (x[j] > tv || ts) ? (1u << j) : 0u; }
                }
            }
        }
        }
        unsigned wlo = 0u, whi = 0u;
        for (int rpc = 0; rpc < REP_SEL_C; ++rpc) { asm volatile("" : "+v"(selm));
#pragma unroll
        for (int j = 0; j < 32; ++j) { const unsigned long long bal = __ballot((selm >> j) & 1u); if (lane == j) { wlo = (unsigned)bal; whi = (unsigned)(bal >> 32); } }
        if (lane < 32) { v2u o; o.x = wlo; o.y = whi; *(v2u*)(MASK + (((size_t)(b * 32 + lane)) * 2048 + q) * 2) = o; }
        }
    }
#undef IDX_COUNT
#undef IDX_UNI
    WG_SYNC();
}

constexpr int KTP = 72;
constexpr int GL_OFF = 0, TOT_OFF = 4096, SSQ_OFF = 6144, QA_OFF = 8192, KR_OFF = 17408, KT_OFF = 26624, PM_OFF = 35840, VT_OFF = 45056;
__device__ __forceinline__ void gla_decay(LAS unsigned char* lds, const bf16* __restrict__ MISC, const float* __restrict__ w2, const float* __restrict__ gb, size_t row0, int h, int tid, float (&bc)[8], float& blast) {
    LAS float* GL = (LAS float*)(lds + GL_OFF); LAS float* TOT = (LAS float*)(lds + TOT_OFF);
    const int d = tid & 63, tg = tid >> 6;
    { const int t = tid >> 3, r2 = (tid & 7) * 2; const unsigned w = *(const unsigned*)(MISC + (row0 + t) * 64 + 40 + r2); GL[t * 16 + r2] = bflo(w); GL[t * 16 + r2 + 1] = bfhi(w); }
    float wc[16];
#pragma unroll
    for (int r = 0; r < 16; ++r) wc[r] = w2[r * 256 + h * 64 + d];
    const float bias = gb[h * 64 + d];
    WG_SYNC();
    float run = 0.f;
#pragma unroll
    for (int i = 0; i < 8; ++i) { const int t = 8 * tg + i; float z = bias;
#pragma unroll
        for (int r4 = 0; r4 < 4; ++r4) { const f32x4 g = *(const LAS f32x4*)(GL + t * 16 + 4 * r4); z += g[0] * wc[4 * r4] + g[1] * wc[4 * r4 + 1] + g[2] * wc[4 * r4 + 2] + g[3] * wc[4 * r4 + 3]; }
        const float ls = fminf(z, 0.f) - log1pf(expf(-fabsf(z)));
        run += ls * (1.0f / 16.0f); bc[i] = run; }
    TOT[tg * 64 + d] = run;
    WG_SYNC();
    float pre = 0.f, tot = 0.f;
#pragma unroll
    for (int g = 0; g < 8; ++g) { const float v = TOT[g * 64 + d]; tot += v; if (g < tg) pre += v; }
#pragma unroll
    for (int i = 0; i < 8; ++i) bc[i] += pre;
    blast = tot;
}
__device__ __forceinline__ void gla_load_vt(LAS unsigned char* lds, const bf16* __restrict__ VB, size_t row0, int h, int tid) {
    LAS bf16* VT = (LAS bf16*)(lds + VT_OFF); const int v = tid & 127, tq = tid >> 7;
#pragma unroll
    for (int i = 0; i < 16; ++i) { const int t = 16 * tq + i; VT[v * KTP + t] = VB[(row0 + t) * 512 + h * 128 + v]; }
}
__device__ __forceinline__ void gla_a_item(LAS unsigned char* lds, int id, const bf16* __restrict__ KB, const bf16* __restrict__ VB, const bf16* __restrict__ MISC, const float* __restrict__ w2, const float* __restrict__ gb,
                                           float* __restrict__ U, float* __restrict__ BLAST, int tid, int lane, int wid) {
    const int b = id >> 7, h = (id >> 5) & 3, c = id & 31; const size_t row0 = (size_t)b * 2048 + 64 * c;
    float bc[8], blast; gla_decay(lds, MISC, w2, gb, row0, h, tid, bc, blast);
    const int d = tid & 63, tg = tid >> 6; LAS bf16* KT = (LAS bf16*)(lds + KT_OFF);
#pragma unroll
    for (int i = 0; i < 8; ++i) { const int t = 8 * tg + i; const float kv = bf2f(KB[(row0 + t) * 256 + h * 64 + d]) * expf(blast - bc[i]); KT[d * KTP + t] = (bf16)f2bf(kv); }
    gla_load_vt(lds, VB, row0, h, tid);
    if (tg == 0) BLAST[(size_t)id * 64 + d] = blast;
    WG_SYNC();
    const int fr = lane & 15, fq = lane >> 4; LAS bf16* VT = (LAS bf16*)(lds + VT_OFF);
    bf16x8 Bf[2];
#pragma unroll
    for (int kk = 0; kk < 2; ++kk) Bf[kk] = *(const LAS bf16x8*)(VT + (16 * wid + fr) * KTP + 32 * kk + 8 * fq);
#pragma unroll
    for (int dt = 0; dt < 4; ++dt) { f32x4 acc = (f32x4){0.f, 0.f, 0.f, 0.f};
#pragma unroll
        for (int kk = 0; kk < 2; ++kk) { const bf16x8 Af = *(const LAS bf16x8*)(KT + (16 * dt + fr) * KTP + 32 * kk + 8 * fq); acc = __builtin_amdgcn_mfma_f32_16x16x32_bf16(Af, Bf[kk], acc, 0, 0, 0); }
        *(f32x4*)(U + ((size_t)id * 128 + 16 * wid + fr) * 64 + 16 * dt + 4 * fq) = acc; }
    WG_SYNC();
}
__device__ __forceinline__ void gla_b_item(int bh, const float* __restrict__ U, const float* __restrict__ BLAST, bf16* __restrict__ SB, int tid) {
    f32x4 S[4];
#pragma unroll
    for (int j = 0; j < 4; ++j) S[j] = (f32x4){0.f, 0.f, 0.f, 0.f};
    const int d0 = (tid * 4) & 63;
#pragma unroll 4
    for (int c = 0; c < 32; ++c) { const size_t id = (size_t)bh * 32 + c;
        const f32x4 bl = *(const f32x4*)(BLAST + id * 64 + d0); f32x4 e; e[0] = expf(bl[0]); e[1] = expf(bl[1]); e[2] = expf(bl[2]); e[3] = expf(bl[3]);
#pragma unroll
        for (int j = 0; j < 4; ++j) { const size_t off = id * 8192 + (size_t)tid * 4 + 2048 * j; const f32x4 u = *(const f32x4*)(U + off);
            const f32x4 sd = S[j] * e; v2u o; o.x = pk2(sd[0], sd[1]); o.y = pk2(sd[2], sd[3]); *(v2u*)(SB + off) = o; S[j] = sd + u; } }
}
__device__ __forceinline__ void gla_c_item(LAS unsigned char* lds, int id, const bf16* __restrict__ QB, const bf16* __restrict__ KB, const bf16* __restrict__ VB, const bf16* __restrict__ RG, const bf16* __restrict__ MISC,
                                           const float* __restrict__ w2, const float* __restrict__ gb, const float* __restrict__ og, const bf16* __restrict__ SB, bf16* __restrict__ MIX, int tid, int lane, int wid) {
    const int b = id >> 7, h = (id >> 5) & 3, c = id & 31; const size_t row0 = (size_t)b * 2048 + 64 * c;
    float bc[8], blast; gla_decay(lds, MISC, w2, gb, row0, h, tid, bc, blast);
    const int d = tid & 63, tg = tid >> 6;
    LAS bf16* QA = (LAS bf16*)(lds + QA_OFF); LAS bf16* KR = (LAS bf16*)(lds + KR_OFF); LAS bf16* PM = (LAS bf16*)(lds + PM_OFF); LAS bf16* VT = (LAS bf16*)(lds + VT_OFF); LAS float* SSQ = (LAS float*)(lds + SSQ_OFF);
#pragma unroll
    for (int i = 0; i < 8; ++i) { const int t = 8 * tg + i; const float e = expf(blast - bc[i]);
        const float kv = bf2f(KB[(row0 + t) * 256 + h * 64 + d]) * e; const float qv = bf2f(QB[(row0 + t) * 256 + h * 64 + d]) * 0.125f / e;
        KR[t * KTP + d] = (bf16)f2bf(kv); QA[t * KTP + d] = (bf16)f2bf(qv); }
    gla_load_vt(lds, VB, row0, h, tid);
    WG_SYNC();
    const int fr = lane & 15, fq = lane >> 4;
    { const int tt = wid >> 1;
#pragma unroll
      for (int s2 = 0; s2 < 2; ++s2) { const int st = 2 * (wid & 1) + s2; f32x4 acc = (f32x4){0.f, 0.f, 0.f, 0.f};
        if (st <= tt) {
#pragma unroll
            for (int kk = 0; kk < 2; ++kk) { const bf16x8 Af = *(const LAS bf16x8*)(QA + (16 * tt + fr) * KTP + 32 * kk + 8 * fq); const bf16x8 Bf = *(const LAS bf16x8*)(KR + (16 * st + fr) * KTP + 32 * kk + 8 * fq);
                acc = __builtin_amdgcn_mfma_f32_16x16x32_bf16(Af, Bf, acc, 0, 0, 0); } }
#pragma unroll
        for (int i = 0; i < 4; ++i) { const int t = 16 * tt + 4 * fq + i, s = 16 * st + fr; PM[t * KTP + s] = (bf16)f2bf((s <= t) ? acc[i] : 0.f); } } }
    WG_SYNC();
    bf16x8 Bv[2], Bs[2];
    const bf16* sbp = SB + ((size_t)id * 128 + 16 * wid + fr) * 64 + 8 * fq;
#pragma unroll
    for (int kk = 0; kk < 2; ++kk) { Bv[kk] = *(const LAS bf16x8*)(VT + (16 * wid + fr) * KTP + 32 * kk + 8 * fq); Bs[kk] = *(const bf16x8*)(sbp + 32 * kk); }
    f32x4 o[4];
#pragma unroll
    for (int tt = 0; tt < 4; ++tt) { f32x4 acc = (f32x4){0.f, 0.f, 0.f, 0.f};
#pragma unroll
        for (int kk = 0; kk < 2; ++kk) { const bf16x8 Ap = *(const LAS bf16x8*)(PM + (16 * tt + fr) * KTP + 32 * kk + 8 * fq); acc = __builtin_amdgcn_mfma_f32_16x16x32_bf16(Ap, Bv[kk], acc, 0, 0, 0);
                                         const bf16x8 Aq = *(const LAS bf16x8*)(QA + (16 * tt + fr) * KTP + 32 * kk + 8 * fq); acc = __builtin_amdgcn_mfma_f32_16x16x32_bf16(Aq, Bs[kk], acc, 0, 0, 0); }
        o[tt] = acc;
#pragma unroll
        for (int i = 0; i < 4; ++i) { float s = acc[i] * acc[i]; s += __shfl_xor(s, 1); s += __shfl_xor(s, 2); s += __shfl_xor(s, 4); s += __shfl_xor(s, 8); if (fr == 0) SSQ[wid * 64 + 16 * tt + 4 * fq + i] = s; } }
    WG_SYNC();
    const int v = 16 * wid + fr; const float gv = og[v];
#pragma unroll
    for (int tt = 0; tt < 4; ++tt)
#pragma unroll
        for (int i = 0; i < 4; ++i) { const int t = 16 * tt + 4 * fq + i; float tot = 0.f;
#pragma unroll
            for (int w = 0; w < 8; ++w) tot += SSQ[w * 64 + t];
            const float rs = 1.0f / sqrtf(tot * (1.0f / 128.0f) + 1e-6f);
            const float r = bf2f(RG[(row0 + t) * 512 + h * 128 + v]); const float sg = r / (1.0f + expf(-r));
            MIX[(row0 + t) * 1024 + 512 + h * 128 + v] = (bf16)f2bf(o[tt][i] * rs * gv * sg); }
    WG_SYNC();
}

constexpr int WRP = 1032;
constexpr int WR_LDS_BYTES = 48 * WRP * 2;
__device__ __forceinline__ void router_tile(LAS unsigned char* lds, int tile, const bf16* __restrict__ XN2, const float* __restrict__ ROWSS, const float* __restrict__ brg, const float* __restrict__ bre,
                                            unsigned* __restrict__ CNT, int* __restrict__ LISTS, float* __restrict__ LSC, int* __restrict__ TOKINFO, int tid, int lane, int wid) {
    LAS bf16* WR = (LAS bf16*)lds; LAS float* LG = (LAS float*)(lds + WR_LDS_BYTES); LAS unsigned* CL = (LAS unsigned*)(lds + WR_LDS_BYTES + 12288); LAS unsigned* BS = CL + 32;
    if (tid < 32) CL[tid] = 0u;
    const int fr = lane & 15, fq = lane >> 4;
    if (wid < 4) {
        const size_t row = (size_t)tile * 64 + 16 * wid + fr; const bf16* ap = XN2 + row * 1024 + 8 * fq;
        f32x4 acc[3];
#pragma unroll
        for (int nt = 0; nt < 3; ++nt) acc[nt] = (f32x4){0.f, 0.f, 0.f, 0.f};
#pragma unroll 8
        for (int kk = 0; kk < 32; ++kk) { const bf16x8 Af = *(const bf16x8*)(ap + 32 * kk);
#pragma unroll
            for (int nt = 0; nt < 3; ++nt) { const bf16x8 Bf = *(const LAS bf16x8*)(WR + (16 * nt + fr) * WRP + 32 * kk + 8 * fq); acc[nt] = __builtin_amdgcn_mfma_f32_16x16x32_bf16(Af, Bf, acc[nt], 0, 0, 0); } }
#pragma unroll
        for (int nt = 0; nt < 3; ++nt)
#pragma unroll
            for (int i = 0; i < 4; ++i) LG[(wid * 16 + 4 * fq + i) * 48 + 16 * nt + fr] = acc[nt][i];
    }
    WG_SYNC();
    int e_[2] = {0, 0}; unsigned lp[2] = {0u, 0u}; float wk[2] = {0.f, 0.f}; float rstd2 = 0.f; const bool act = (wid < 4) && (lane < 16);
    const int token = tile * 64 + 16 * wid + lane;
    if (act) {
        const LAS float* lg = LG + (wid * 16 + lane) * 48; float ss = 0.f;
#pragma unroll
        for (int j = 0; j < 16; ++j) ss += ROWSS[(size_t)token * 16 + j];
        rstd2 = 1.0f / sqrtf(ss * (1.0f / 1024.0f) + 1e-6f);
        float gl[4]; int gs = 0;
#pragma unroll
        for (int j = 0; j < 4; ++j) gl[j] = lg[j] * rstd2 + brg[j];
#pragma unroll
        for (int j = 1; j < 4; ++j) if (gl[j] > gl[gs]) gs = j;
        float den = 0.f;
#pragma unroll
        for (int j = 0; j < 4; ++j) den += expf(gl[j] - gl[gs]);
        const float gw = 1.0f / den;
        float el[8];
#pragma unroll
        for (int j = 0; j < 8; ++j) el[j] = lg[4 + gs * 8 + j] * rstd2 + bre[gs * 8 + j];
        int i0 = 0;
#pragma unroll
        for (int j = 1; j < 8; ++j) if (el[j] > el[i0]) i0 = j;
        int i1 = (i0 == 0) ? 1 : 0;
#pragma unroll
        for (int j = 0; j < 8; ++j) if (j != i0 && j != i1 && el[j] > el[i1]) i1 = j;
        const float ex = expf(el[i1] - el[i0]); const float w0 = 1.0f / (1.0f + ex);
        wk[0] = w0 * gw; wk[1] = ex * w0 * gw; e_[0] = gs * 8 + i0; e_[1] = gs * 8 + i1;
        lp[0] = atomicAdd((unsigned*)(CL + e_[0]), 1u); lp[1] = atomicAdd((unsigned*)(CL + e_[1]), 1u);
    }
    WG_SYNC();
    if (tid < 32) { const unsigned n = CL[tid]; BS[tid] = n ? __hip_atomic_fetch_add(CNT + tid, n, __ATOMIC_RELAXED, __HIP_MEMORY_SCOPE_AGENT) : 0u; }
    WG_SYNC();
    if (act) {
#pragma unroll
        for (int k = 0; k < 2; ++k) { const unsigned pos = BS[e_[k]] + lp[k]; LISTS[(size_t)e_[k] * 16384 + pos] = token; *(f32x2*)(LSC + ((size_t)e_[k] * 16384 + pos) * 2) = (f32x2){rstd2, wk[k]};
            TOKINFO[(size_t)token * 4 + 2 * k] = e_[k]; TOKINFO[(size_t)token * 4 + 2 * k + 1] = (int)pos; }
    }
    WG_SYNC();
}

template <bool GATHER> struct GroupOrder {
    const LAS int* TOFF; const LAS int* CNTL; const int* LISTS; int NPN, G, c; unsigned bstride;
    __device__ bool next(int i, pg8::Unit& u) const {
        const int L = i * G + c; const int ntile = TOFF[32]; if (L >= ntile * NPN) return false;
        const int T = L / NPN; int e = 0;
#pragma unroll
        for (int s = 16; s >= 1; s >>= 1) if (TOFF[e + s] <= T) e += s;
        u.pm = T; u.pn = L - T * NPN; u.e = e; u.p0 = (T - TOFF[e]) * 256; const int rem = CNTL[e] - u.p0; u.nv = rem < 256 ? rem : 256; u.bo = (unsigned)e * bstride; return true;
    }
    __device__ __forceinline__ unsigned arow(const pg8::Unit& u, int r) const {
        if (GATHER) return (unsigned)LISTS[(size_t)u.e * 16384 + u.p0 + (r < u.nv ? r : 0)];
        return (unsigned)(u.pm * 256 + r);
    }
};
struct Args { const float* in[18]; float* out; unsigned char* ws; int ph_lo, ph_hi, li, pad; };
__global__ void __launch_bounds__(NWAVES * 64, 2) hymba_fwd(Args args) {
    extern __shared__ __attribute__((aligned(16))) unsigned char lds[];
    LAS unsigned char* const L = (LAS unsigned char*)lds;
    volatile LAS unsigned* const MISCW = (volatile LAS unsigned*)(L + MISC_OFF);
    LAS int* const TOFF = (LAS int*)(L + TOFF_OFF); LAS int* const CNTL = TOFF + 40;
    const int tid = threadIdx.x, lane = tid & 63, wave = __builtin_amdgcn_readfirstlane(tid >> 6);
    const int G = gridDim.x; const int bx = blockIdx.x; const int vcu = (G % 8 == 0) ? (bx % 8) * (G / 8) + bx / 8 : bx;
    unsigned char* const ws = args.ws;
    gu32* const ctl = (gu32*)(ws + WS_CTL);
    const float* x = args.in[0]; const float* norm1_g = args.in[1]; const float* w_in = args.in[2]; const float* q_norm_g = args.in[3]; const float* k_norm_g = args.in[4];
    const float* rel_bias = args.in[5]; const float* gate_w2 = args.in[6]; const float* gate_b = args.in[7]; const float* out_norm_g = args.in[8]; const float* w_out = args.in[9];
    const float* norm2_g = args.in[10]; const float* w_rg = args.in[11]; const float* b_rg = args.in[12]; const float* w_re = args.in[13]; const float* b_re = args.in[14];
    const float* w_eg = args.in[15]; const float* w_eu = args.in[16]; const float* w_ed = args.in[17];
    float* out = args.out;
    float* RSTD1 = (float*)(ws + WS_RSTD1); float* ROWSS = (float*)(ws + WS_ROWSS); bf16* WR_T = (bf16*)(ws + WS_WR); float* BLAST = (float*)(ws + WS_BLAST);
    int* TOKINFO = (int*)(ws + WS_TOKINFO); int* LISTS = (int*)(ws + WS_LISTS); float* LSC = (float*)(ws + WS_LSC);
    bf16* WO_T = (bf16*)(ws + WS_WO); bf16* WGU_T = (bf16*)(ws + WS_WGU); bf16* WD_T = (bf16*)(ws + WS_WD); bf16* XB = (bf16*)(ws + WS_XB); bf16* WIN_T = (bf16*)(ws + WS_WIN);
    unsigned* MASK = (unsigned*)(ws + WS_MASK); bf16* SB = (bf16*)(ws + WS_SB);
    bf16* QN = (bf16*)(ws + WS_QN); bf16* KN = (bf16*)(ws + WS_KN); bf16* VN = (bf16*)(ws + WS_VN); bf16* XN2 = (bf16*)(ws + WS_XN2);
    bf16* IQ = (bf16*)(ws + WS_IQ); bf16* MISC = (bf16*)(ws + WS_MISC); bf16* QB = (bf16*)(ws + WS_QB); bf16* KB = (bf16*)(ws + WS_KB); bf16* VB = (bf16*)(ws + WS_VB); bf16* RG = (bf16*)(ws + WS_RG);
    bf16* MIX = (bf16*)(ws + WS_MIX); float* U = (float*)(ws + WS_MIX); bf16* HID = (bf16*)(ws + WS_HID); bf16* Y = (bf16*)(ws + WS_Y);
    unsigned* CNT = (unsigned*)(ctl + CW_CNT);

    for (int u = tid; u < (LDS_BYTES - LDSCTL_OFF) / 4; u += NWAVES * 64) ((LAS unsigned*)(L + LDSCTL_OFF))[u] = 0u;
    __syncthreads();
    const int bli = (N_LAUNCHES == PER_PHASE) ? 0 : args.li;
    XcdBarrier bar; bar.bar = (unsigned*)(ctl + CW_BAR) + bli * XCD_BAR_WORDS; bar.x = 0; bar.st = nullptr;
    if (N_LAUNCHES != PER_PHASE) bar = xcd_barrier_post((unsigned*)(ctl + CW_BAR) + bli * XCD_BAR_WORDS, MISCW + 8);
#define GRID_BAR(seam) do { if (N_LAUNCHES == PER_PHASE) { if (tid == 0) __hip_atomic_store(ctl + CW_TMO, 0xBADBA0u | (unsigned)(seam), RLX_AGENT); } else { xcd_barrier(bar); } } while (0)
    const int lo = args.ph_lo, hi = args.ph_hi;
#define IN(k) (lo <= (k) && (k) < hi)
#define BOTH(k) (IN(k) && IN((k) + 1))
    const int gw = vcu * NWAVES + wave, NGW = G * NWAVES;

    if (IN(0)) {
        LAS float* scr = (LAS float*)(L + wave * 16384);
        constexpr int I_IN = 16 * 106, I_O = 16 * 32, I_G = 16 * 8, I_D = 4 * 32;
        constexpr int NITEMS = I_IN + I_O + 32 * (2 * I_G + I_D);
        for (int it = gw; it < NITEMS; it += NGW) {
            int r = it;
            if (r < I_IN) { p0_transpose_item<0>(w_in, 1024, 3384, norm1_g, WIN_T, scr, r, lane); continue; } r -= I_IN;
            if (r < I_O) { p0_transpose_item<1>(w_out, 1024, 1024, nullptr, WO_T, scr, r, lane); continue; } r -= I_O;
            const int e = r / (2 * I_G + I_D); r -= e * (2 * I_G + I_D);
            if (r < I_G) { p0_transpose_item<2>(w_eg + (size_t)e * 1024 * 256, 1024, 256, norm2_g, WGU_T + (size_t)e * 512 * 1024, scr, r, lane); continue; } r -= I_G;
            if (r < I_G) { p0_transpose_item<3>(w_eu + (size_t)e * 1024 * 256, 1024, 256, norm2_g, WGU_T + (size_t)e * 512 * 1024, scr, r, lane); continue; } r -= I_G;
            p0_transpose_item<1>(w_ed + (size_t)e * 256 * 1024, 256, 1024, nullptr, WD_T + (size_t)e * 1024 * 256, scr, r, lane);
        }
        for (int i = bx * (NWAVES * 64) + tid; i < 48 * 1024; i += G * NWAVES * 64) { const int n = i >> 10, k = i & 1023;
            const float v = (n < 4) ? w_rg[k * 4 + n] : (n < 36) ? w_re[k * 32 + (n - 4)] : 0.f; WR_T[i] = (bf16)f2bf(v * norm2_g[k]); }
        for (int m = gw; m < M; m += NGW) {
            const GAS f32x4* xr = (const GAS f32x4*)(x + (size_t)m * 1024) + lane; f32x4 v[4]; float s = 0.f;
#pragma unroll
            for (int j = 0; j < 4; ++j) { v[j] = xr[64 * j]; s += (v[j].x * v[j].x + v[j].y * v[j].y) + (v[j].z * v[j].z + v[j].w * v[j].w); }
            s = wave_sum(s); if (lane == 0) RSTD1[m] = 1.0f / sqrtf(s * (1.0f / 1024.0f) + 1e-6f);
            GAS unsigned long long* o8 = (GAS unsigned long long*)(XB + (size_t)m * 1024) + lane;
#pragma unroll
            for (int j = 0; j < 4; ++j) o8[64 * j] = (unsigned long long)pk2(v[j].x, v[j].y) | ((unsigned long long)pk2(v[j].z, v[j].w) << 32);
        }
        if (BOTH(0)) GRID_BAR(0);
    }
    if (IN(1)) {
        pg8::Gemm g{XB, WIN_T, 1024}; pg8::StaticOrder S; S.init(M, 3584, G, bx);
        pg8::EpiProj E{RSTD1, q_norm_g, k_norm_g, QN, KN, VN, IQ, QB, KB, VB, RG, MISC, 0.125f * 1.4426950408889634f, 1e-6f};
        pg8::gemm_phase<pg8::EpiProj, pg8::StaticOrder, true>(L, g, S, E);
        if (BOTH(1)) GRID_BAR(1);
    }
    if (IN(2)) {
        for (int rep = 0; rep < REP_IDX; ++rep)
        for (int it = bx; it < 1024; it += G) { const int b = it & 7, key = (it >> 3) ^ ((it >> 8) & 1); const int p = (key & 1) ? 127 - (key >> 1) : (key >> 1);
            idx_item(L, b, p, IQ, MISC, MASK, lane, wave); }
        for (int rep = 0; rep < REP_GLAA; ++rep)
        for (int it = bx; it < 1024; it += G) gla_a_item(L, it, KB, VB, MISC, gate_w2, gate_b, U, BLAST, tid, lane, wave);
        if (BOTH(2)) GRID_BAR(2);
    }
    if (IN(3)) {
        for (int it = bx; it < 32; it += G) gla_b_item(it, U, BLAST, SB, tid);
        if (BOTH(3)) GRID_BAR(3);
    }
    if (IN(4)) {
        const attn_body::AttnTensors AT{(const attn_body::bf16*)QN, (const attn_body::bf16*)KN, (const attn_body::bf16*)VN, (attn_body::bf16*)MIX, MASK, rel_bias};
        for (int rep = 0; rep < REP_ATT; ++rep)
        for (int pr = vcu; pr < 256; pr += G) { const int bh = pr >> 2, s = pr & 3;
            for (int k2 = 0; k2 < 2; ++k2) attn_body::attn_unit<8>(bh >> 3, bh & 7, k2 ? s : 7 - s, AT.Q, AT.K, AT.V, AT.O, AT.MASK, AT.relb, (char*)lds); }
        for (int rep = 0; rep < REP_GLAC; ++rep)
        for (int it = bx; it < 1024; it += G) gla_c_item(L, it, QB, KB, VB, RG, MISC, gate_w2, gate_b, out_norm_g, SB, MIX, tid, lane, wave);
        if (BOTH(4)) GRID_BAR(4);
    }
    if (IN(5)) {
        pg8::Gemm g{MIX, WO_T, 1024}; pg8::StaticOrder S; S.init(M, 1024, G, bx);
        pg8::EpiOut E{x, XN2, ROWSS};
        pg8::gemm_phase<pg8::EpiOut, pg8::StaticOrder, false>(L, g, S, E);
        if (BOTH(5)) GRID_BAR(5);
    }
    if (IN(6)) {
        { LAS bf16* WR = (LAS bf16*)L;
          for (int i = tid; i < 48 * 128; i += NWAVES * 64) { const int n = i >> 7, c8 = i & 127; *(LAS v4u*)(WR + n * WRP + c8 * 8) = *(const v4u*)(WR_T + n * 1024 + c8 * 8); } }
        WG_SYNC();
        for (int tile = bx; tile < 256; tile += G) router_tile(L, tile, XN2, ROWSS, b_rg, b_re, CNT, LISTS, LSC, TOKINFO, tid, lane, wave);
        if (BOTH(6)) GRID_BAR(6);
    }
#define LOAD_TOFF() do { if (tid == 0) { int acc_ = 0; for (int e_ = 0; e_ < 32; ++e_) { const int c_ = (int)__hip_atomic_load(CNT + e_, RLX_AGENT); CNTL[e_] = c_; TOFF[e_] = acc_; acc_ += (c_ + 255) >> 8; } TOFF[32] = acc_; } WG_SYNC(); } while (0)
    if (IN(7)) {
        LOAD_TOFF();
        pg8::Gemm g{XN2, WGU_T, 1024}; GroupOrder<true> S{TOFF, CNTL, LISTS, 2, G, bx, 512u * 1024u * 2u};
        pg8::EpiGU E{LSC, HID};
        pg8::gemm_phase<pg8::EpiGU, GroupOrder<true>, false>(L, g, S, E);
        if (BOTH(7)) GRID_BAR(7);
    }
    if (IN(8)) {
        LOAD_TOFF();
        pg8::Gemm g{HID, WD_T, 256}; GroupOrder<false> S{TOFF, CNTL, LISTS, 4, G, bx, 1024u * 256u * 2u};
        pg8::EpiDown E{Y};
        pg8::gemm_phase<pg8::EpiDown, GroupOrder<false>, false>(L, g, S, E);
        if (BOTH(8)) GRID_BAR(8);
    }
    if (IN(9)) {
        LOAD_TOFF();
        for (int m = gw; m < M; m += NGW) {
            const int e0 = TOKINFO[(size_t)m * 4], p0 = TOKINFO[(size_t)m * 4 + 1], e1 = TOKINFO[(size_t)m * 4 + 2], p1 = TOKINFO[(size_t)m * 4 + 3];
            const size_t s0 = (size_t)TOFF[e0] * 256 + p0, s1 = (size_t)TOFF[e1] * 256 + p1;
            const GAS v4u* a = (const GAS v4u*)(XN2 + (size_t)m * 1024) + lane; const GAS v4u* y0 = (const GAS v4u*)(Y + s0 * 1024) + lane; const GAS v4u* y1 = (const GAS v4u*)(Y + s1 * 1024) + lane;
            GAS f32x4* o = (GAS f32x4*)(out + (size_t)m * 1024) + 2 * lane;
#pragma unroll
            for (int j = 0; j < 2; ++j) { const v4u av = a[64 * j], b0 = y0[64 * j], b1 = y1[64 * j];
                f32x4 r0, r1;
                r0[0] = bflo(av.x) + bflo(b0.x) + bflo(b1.x); r0[1] = bfhi(av.x) + bfhi(b0.x) + bfhi(b1.x); r0[2] = bflo(av.y) + bflo(b0.y) + bflo(b1.y); r0[3] = bfhi(av.y) + bfhi(b0.y) + bfhi(b1.y);
                r1[0] = bflo(av.z) + bflo(b0.z) + bflo(b1.z); r1[1] = bfhi(av.z) + bfhi(b0.z) + bfhi(b1.z); r1[2] = bflo(av.w) + bflo(b0.w) + bflo(b1.w); r1[3] = bfhi(av.w) + bfhi(b0.w) + bfhi(b1.w);
                o[128 * j] = r0; o[128 * j + 1] = r1; }
        }
    }
#undef IN
#undef BOTH
}

extern "C" void kernel_launch(void* const* d_in, const int* in_sizes, int n_in, void* d_out, int out_size, void* d_ws, size_t ws_size, hipStream_t stream) {
    static int grid = 0;
    if (grid == 0) {
        if (n_in != 18 || out_size != M * 1024 || ws_size < WS_END) { fprintf(stderr, "kernel_launch: unexpected problem shape (n_in %d out %d ws %zu)\n", n_in, out_size, ws_size); grid = -1; return; }
        int dev = 0, cus = 0, per_cu = 0;
        if (hipGetDevice(&dev) != hipSuccess || hipDeviceGetAttribute(&cus, hipDeviceAttributeMultiprocessorCount, dev) != hipSuccess) { grid = -1; return; }
        if (hipFuncSetAttribute((const void*)hymba_fwd, hipFuncAttributeMaxDynamicSharedMemorySize, LDS_BYTES) != hipSuccess) { fprintf(stderr, "kernel_launch: hipFuncSetAttribute failed\n"); grid = -1; return; }
        if (hipOccupancyMaxActiveBlocksPerMultiprocessor(&per_cu, (const void*)hymba_fwd, NWAVES * 64, LDS_BYTES) != hipSuccess || per_cu < 1) { fprintf(stderr, "kernel_launch: occupancy query reports %d\n", per_cu); }
        (void)hipGetLastError();
        grid = cus;
    }
    if (grid < 0) return;
    (void)hipMemsetAsync((char*)d_ws + WS_CTL, 0, CTL_ZERO_BYTES, stream);
    Args a{};
    for (int i = 0; i < 18; ++i) a.in[i] = (const float*)d_in[i];
    a.out = (float*)d_out; a.ws = (unsigned char*)d_ws;
#if defined(PROBE_PHASE)
    { const int k = PROBE_PHASE; a.ph_lo = 0; a.ph_hi = k + 1; a.li = 0; hipLaunchKernelGGL(hymba_fwd, dim3(grid), dim3(NWAVES * 64), LDS_BYTES, stream, a);
      for (int r = 1; r < PROBE_REPS; ++r) { a.ph_lo = k; a.ph_hi = k + 1; a.li = 1; hipLaunchKernelGGL(hymba_fwd, dim3(grid), dim3(NWAVES * 64), LDS_BYTES, stream, a); }
      if (k + 1 < PER_PHASE) { a.ph_lo = k + 1; a.ph_hi = PER_PHASE; a.li = 2; hipLaunchKernelGGL(hymba_fwd, dim3(grid), dim3(NWAVES * 64), LDS_BYTES, stream, a); } }
#else
    if (N_LAUNCHES == 1) { a.ph_lo = 0; a.ph_hi = PER_PHASE; a.li = 0; hipLaunchKernelGGL(hymba_fwd, dim3(grid), dim3(NWAVES * 64), LDS_BYTES, stream, a); }
    else for (int li = 0; li < PER_PHASE; ++li) { a.ph_lo = li; a.ph_hi = li + 1; a.li = li; hipLaunchKernelGGL(hymba_fwd, dim3(grid), dim3(NWAVES * 64), LDS_BYTES, stream, a); }
#endif
}
```

```cpp
#include <hip/hip_runtime.h>
#include <hip/hip_bf16.h>
#include <cstdio>
#include <cstdint>
#include <cmath>
namespace pg8 {
#define PG8_LAS __attribute__((address_space(3)))
typedef unsigned short bf16_t;
typedef short bf16x8 __attribute__((ext_vector_type(8)));
typedef float f32x4 __attribute__((ext_vector_type(4)));
typedef float f32x2 __attribute__((ext_vector_type(2)));
typedef unsigned u32x4 __attribute__((ext_vector_type(4)));
constexpr int BM = 256, BK = 64, HALF = 128, HTB = HALF * BK * 2  , STAGE_BYTES = 8 * HTB, NXCD = 8, WGM = 8;

__host__ __device__ __forceinline__ int lds_byte(int r, int c) { const int st = (r >> 4) * 2 + (c >> 5), rr = r & 15, cc = c & 31, ob = rr * 64 + cc * 2; return st * 1024 + (ob ^ (((ob >> 9) & 1) << 5)); }
__host__ __device__ __forceinline__ void stage_rc(int b, int& R, int& C) { const int st = b / 1024, sb = b % 1024, swz = sb ^ (((sb >> 9) & 1) << 5); R = (st >> 1) * 16 + swz / 64; C = (st & 1) * 32 + (swz % 64) / 2; }
__host__ __device__ __forceinline__ int perm32(int rho) { const int n = rho >> 4, i = rho & 15; return 8 * (i >> 2) + 4 * n + (i & 3); }

struct Unit { int pm, pn; unsigned bo; int e, nv, p0; };
struct Gemm { const bf16_t* A; const bf16_t* Bt; int K; };

struct StaticOrder {
    int nM, nN, nwg, G, c;
    __device__ void init(int M, int N, int G_, int c_) { nM = M / BM; nN = N / BM; nwg = nM * nN; G = G_; c = c_; }
    __device__ bool next(int i, Unit& u) const {
        const long L = (long)i * G + c; if (L >= nwg) return false;
        int wgid = (int)L; { const int q = nwg / NXCD, r = nwg % NXCD, xcd = wgid % NXCD, off = wgid / NXCD; wgid = (xcd < r ? xcd * (q + 1) : r * (q + 1) + (xcd - r) * q) + off; }
        const int nig = WGM * nN, gid = wgid / nig, fm = gid * WGM, gsz = (nM - fm) < WGM ? (nM - fm) : WGM;
        u.pm = fm + ((wgid % nig) % gsz); u.pn = (wgid % nig) / gsz; u.bo = 0u; u.e = 0; u.nv = BM; u.p0 = 0; return true;
    }
    __device__ __forceinline__ unsigned arow(const Unit& u, int r) const { return (unsigned)(u.pm * BM + r); }
};

__device__ __forceinline__ unsigned cvt_pk_bf16(float lo, float hi) { unsigned r; asm volatile("v_cvt_pk_bf16_f32 %0, %1, %2" : "=v"(r) : "v"(lo), "v"(hi)); return r; }

template <class Epi, class Sched, bool ALIGN_EPI = false>
__device__ __forceinline__ void gemm_phase(PG8_LAS unsigned char* lds, const Gemm g, const Sched& S, const Epi& E) {
    const int tid = threadIdx.x, wid = __builtin_amdgcn_readfirstlane(tid >> 6), lane = tid & 63, wr = wid >> 2, wc = wid & 3, fr = lane & 15, fq = lane >> 4;
    const int K = g.K, nt = K / BK;
    int RA[2], CA[2]; unsigned voffB[2];
#pragma unroll
    for (int i = 0; i < 2; ++i) { int R, C; stage_rc(tid * 16 + i * 8192, R, C); const int Rb = ((R & ~31) + perm32(R & 31));
        RA[i] = R; CA[i] = C; voffB[i] = (unsigned)(Rb * K + C) * 2u; }
    const size_t kstep = (size_t)(BK * 2);
    const size_t hstep = (size_t)HALF * K * 2;
    const size_t tstep = 2 * hstep;
    const unsigned ldsw = (unsigned)wid * 1024u;
    const int aoff = lds_byte(wr * 64 + fr, fq * 8), boff = lds_byte(wc * 32 + fr, fq * 8);
#define PG8_SA(b, h) (((b) * 2 + (h)) * HTB)
#define PG8_SB(b, h) ((4 + (b) * 2 + (h)) * HTB)
#define PG8_STAGE(bufoff, gbase, voff) do { _Pragma("unroll") for (int _i = 0; _i < 2; ++_i) \
        __builtin_amdgcn_global_load_lds((const unsigned*)((const char*)(gbase) + (voff)[_i]), (PG8_LAS unsigned*)(lds + (bufoff) + ldsw + _i * 8192), 16, 0, 0); } while (0)
#define PG8_LDA(dst, b, h) do { _Pragma("unroll") for (int m = 0; m < 4; ++m) _Pragma("unroll") for (int k = 0; k < 2; ++k) dst[m][k] = *(const PG8_LAS bf16x8*)(lds + PG8_SA(b, h) + aoff + m * 2048 + k * 1024); } while (0)
#define PG8_LDB(dst, b, h) do { _Pragma("unroll") for (int n = 0; n < 2; ++n) _Pragma("unroll") for (int k = 0; k < 2; ++k) dst[n][k] = *(const PG8_LAS bf16x8*)(lds + PG8_SB(b, h) + boff + n * 2048 + k * 1024); } while (0)
#define PG8_MMA(ai, bj, At, Bt) do { __builtin_amdgcn_s_setprio(1); _Pragma("unroll") for (int m = 0; m < 4; ++m) _Pragma("unroll") for (int n = 0; n < 2; ++n) _Pragma("unroll") for (int k = 0; k < 2; ++k) \
        acc[ai][bj][m][n] = __builtin_amdgcn_mfma_f32_16x16x32_bf16(Bt[n][k], At[m][k], acc[ai][bj][m][n], 0, 0, 0); __builtin_amdgcn_s_setprio(0); } while (0)
#define PG8_WAIT_V(n) asm volatile("s_waitcnt vmcnt(" #n ")" ::: "memory")
#define PG8_WAIT_L(n) asm volatile("s_waitcnt lgkmcnt(" #n ")" ::: "memory")
#define PG8_BAR __builtin_amdgcn_s_barrier()
#define PG8_SCHED __builtin_amdgcn_sched_barrier(0)
#define PG8_AOFF(AO, U) do { _Pragma("unroll") for (int _h = 0; _h < 2; ++_h) _Pragma("unroll") for (int _i = 0; _i < 2; ++_i) \
        AO[_h][_i] = (S.arow(U, _h * HALF + RA[_i]) * (unsigned)K + (unsigned)CA[_i]) * 2u; } while (0)
    Unit cur, nxt; int ui = 0;
    if (!S.next(0, cur)) return;
    f32x4 acc[2][2][4][2];
#pragma unroll
    for (int a = 0; a < 2; ++a)
#pragma unroll
        for (int b = 0; b < 2; ++b)
#pragma unroll
            for (int m = 0; m < 4; ++m)
#pragma unroll
                for (int n = 0; n < 2; ++n) acc[a][b][m][n] = (f32x4){0.f, 0.f, 0.f, 0.f};
    bf16x8 At[4][2], B0[2][2], B1[2][2];
    unsigned aoC[2][2], aoN[2][2];
    PG8_AOFF(aoC, cur);
    const char* const gA = (const char*)g.A;
    const char* cB = (const char*)g.Bt + (size_t)cur.bo + (size_t)cur.pn * tstep;
    {
        PG8_STAGE(PG8_SB(0, 0), cB, voffB); PG8_STAGE(PG8_SB(0, 1), cB + hstep, voffB); PG8_STAGE(PG8_SA(0, 0), gA, aoC[0]); PG8_STAGE(PG8_SA(0, 1), gA, aoC[1]);
        if (wr == 1) PG8_BAR;
        PG8_WAIT_V(2); PG8_BAR;
        PG8_STAGE(PG8_SB(1, 0), cB + kstep, voffB); PG8_STAGE(PG8_SA(1, 0), gA + kstep, aoC[0]); PG8_STAGE(PG8_SB(1, 1), cB + hstep + kstep, voffB);
        PG8_WAIT_V(6); PG8_BAR;
    }
    for (;;) {
        const bool has_next = S.next(ui + 1, nxt);
        if (has_next) { PG8_AOFF(aoN, nxt); } else {
#pragma unroll
            for (int _h = 0; _h < 2; ++_h)
#pragma unroll
                for (int _i = 0; _i < 2; ++_i) aoN[_h][_i] = aoC[_h][_i]; }
        const char* nB = has_next ? (const char*)g.Bt + (size_t)nxt.bo + (size_t)nxt.pn * tstep : cB;
        for (int t = 0; t < nt; t += 2) {
            const bool last = (t == nt - 2);
            const char* a1 = gA + (size_t)(t + 1) * kstep;
            const char* a2 = last ? gA : gA + (size_t)(t + 2) * kstep; const char* b2 = last ? nB : cB + (size_t)(t + 2) * kstep;
            const char* a3 = a2 + kstep; const char* b3 = b2 + kstep;
            unsigned ao2[2][2];
#pragma unroll
            for (int _h = 0; _h < 2; ++_h)
#pragma unroll
                for (int _i = 0; _i < 2; ++_i) ao2[_h][_i] = last ? aoN[_h][_i] : aoC[_h][_i];
            PG8_LDB(B0, 0, 0); PG8_LDB(B1, 0, 1); PG8_SCHED; PG8_LDA(At, 0, 0); PG8_STAGE(PG8_SA(1, 1), a1, aoC[1]);
            PG8_WAIT_V(8); PG8_WAIT_L(0); PG8_BAR; PG8_MMA(0, 0, At, B0); PG8_MMA(0, 1, At, B1); PG8_BAR; PG8_SCHED;
            PG8_LDA(At, 0, 1); PG8_STAGE(PG8_SB(0, 0), b2, voffB); PG8_STAGE(PG8_SB(0, 1), b2 + hstep, voffB); PG8_STAGE(PG8_SA(0, 0), a2, ao2[0]);
            PG8_WAIT_V(8); PG8_WAIT_L(0); PG8_BAR; PG8_MMA(1, 0, At, B0); PG8_MMA(1, 1, At, B1); PG8_BAR; PG8_SCHED;
            PG8_LDB(B0, 1, 0); PG8_LDB(B1, 1, 1); PG8_SCHED; PG8_LDA(At, 1, 0); PG8_STAGE(PG8_SA(0, 1), a2, ao2[1]);
            PG8_WAIT_V(8); PG8_WAIT_L(0); PG8_BAR; PG8_MMA(0, 0, At, B0); PG8_MMA(0, 1, At, B1); PG8_BAR; PG8_SCHED;
            PG8_LDA(At, 1, 1); PG8_STAGE(PG8_SB(1, 0), b3, voffB); PG8_STAGE(PG8_SB(1, 1), b3 + hstep, voffB); PG8_STAGE(PG8_SA(1, 0), a3, ao2[0]);
            PG8_WAIT_V(8); PG8_WAIT_L(0); PG8_BAR; PG8_MMA(1, 0, At, B0); PG8_MMA(1, 1, At, B1); PG8_BAR; PG8_SCHED;
        }
        if constexpr (ALIGN_EPI) { if (wr == 0) PG8_BAR; }
        E(acc, cur, wr, wc, fr, fq);
        if (!has_next) break;
#pragma unroll
        for (int a = 0; a < 2; ++a)
#pragma unroll
            for (int b = 0; b < 2; ++b)
#pragma unroll
                for (int m = 0; m < 4; ++m)
#pragma unroll
                    for (int n = 0; n < 2; ++n) acc[a][b][m][n] = (f32x4){0.f, 0.f, 0.f, 0.f};
        cur = nxt; cB = nB; ++ui;
#pragma unroll
        for (int _h = 0; _h < 2; ++_h)
#pragma unroll
            for (int _i = 0; _i < 2; ++_i) aoC[_h][_i] = aoN[_h][_i];
        if constexpr (ALIGN_EPI) { if (wr == 1) PG8_BAR; }
    }
    PG8_WAIT_V(0);
    if constexpr (!ALIGN_EPI) { if (wr == 0) PG8_BAR; }
    PG8_BAR;
#undef PG8_SA
#undef PG8_SB
#undef PG8_STAGE
#undef PG8_LDA
#undef PG8_LDB
#undef PG8_MMA
#undef PG8_WAIT_V
#undef PG8_WAIT_L
#undef PG8_BAR
#undef PG8_SCHED
#undef PG8_AOFF
}
}
namespace pg8 {
__device__ __forceinline__ u32x4 pack8(const f32x4 v0, const f32x4 v1) { u32x4 w; w.x = cvt_pk_bf16(v0[0], v0[1]); w.y = cvt_pk_bf16(v0[2], v0[3]); w.z = cvt_pk_bf16(v1[0], v1[1]); w.w = cvt_pk_bf16(v1[2], v1[3]); return w; }

struct EpiProj {
    const float* rstd1; const float* qg; const float* kg;
    bf16_t *QN, *KN, *VN, *IQ, *QB, *KB, *VB, *RG, *MISC;
    float qscale, eps;
    __device__ __forceinline__ void operator()(const f32x4 (&acc)[2][2][4][2], const Unit& u, int wr, int wc, int fr, int fq) const {
        const int row0 = u.pm * BM + wr * 64 + fr; const int pn = u.pn;
        if (pn < 4) {
            const bool isq = pn < 2; const float* gp = isq ? qg : kg; bf16_t* O = isq ? QN : KN; const float os = isq ? qscale : 1.f;
            f32x4 gv[2][2];
#pragma unroll
            for (int bj = 0; bj < 2; ++bj)
#pragma unroll
                for (int n = 0; n < 2; ++n) gv[bj][n] = *(const f32x4*)(gp + 32 * bj + 8 * fq + 4 * n) * os;
            const int hcol = (4 * (pn & 1) + wc) * 64 + 8 * fq;
#pragma unroll
            for (int ai = 0; ai < 2; ++ai)
#pragma unroll
                for (int m = 0; m < 4; ++m) { const int row = row0 + ai * HALF + m * 16; const float s = rstd1[row];
                    float ss = 0.f;
#pragma unroll
                    for (int bj = 0; bj < 2; ++bj)
#pragma unroll
                        for (int n = 0; n < 2; ++n) { const f32x4 x = acc[ai][bj][m][n]; ss += (x[0] * x[0] + x[1] * x[1]) + (x[2] * x[2] + x[3] * x[3]); }
                    ss += __shfl_xor(ss, 16); ss += __shfl_xor(ss, 32);
                    const float r = s * __builtin_amdgcn_rsqf(s * s * ss * (1.f / 64.f) + eps);
                    bf16_t* rowp = O + (size_t)row * 512 + hcol;
#pragma unroll
                    for (int bj = 0; bj < 2; ++bj) *(u32x4*)(rowp + 32 * bj) = pack8(acc[ai][bj][m][0] * r * gv[bj][0], acc[ai][bj][m][1] * r * gv[bj][1]); }
            return;
        }
        bf16_t* O; int pitch, coff, lim = 256;
        if (pn < 6) { O = VN; pitch = 512; coff = (pn - 4) * 256; }
        else if (pn == 6) { O = IQ; pitch = 256; coff = 0; }
        else if (pn == 7) { O = QB; pitch = 256; coff = 0; }
        else if (pn == 8) { O = KB; pitch = 256; coff = 0; }
        else if (pn < 11) { O = VB; pitch = 512; coff = (pn - 9) * 256; }
        else if (pn < 13) { O = RG; pitch = 512; coff = (pn - 11) * 256; }
        else { O = MISC; pitch = 64; coff = 0; lim = 56; }
        const int c0 = wc * 32 + 8 * fq;
#pragma unroll
        for (int ai = 0; ai < 2; ++ai)
#pragma unroll
            for (int m = 0; m < 4; ++m) { const int row = row0 + ai * HALF + m * 16; const float s = rstd1[row];
                bf16_t* rowp = O + (size_t)row * pitch + coff + c0;
#pragma unroll
                for (int bj = 0; bj < 2; ++bj) if (c0 + bj * HALF < lim) *(u32x4*)(rowp + bj * HALF) = pack8(acc[ai][bj][m][0] * s, acc[ai][bj][m][1] * s); }
    }
};

struct EpiOut {
    const float* x; bf16_t* XN2; float* ROWSS;
    __device__ __forceinline__ void operator()(const f32x4 (&acc)[2][2][4][2], const Unit& u, int wr, int wc, int fr, int fq) const {
        const int row0 = u.pm * BM + wr * 64 + fr; const int col0 = u.pn * BM + wc * 32 + 8 * fq;
#pragma unroll
        for (int ai = 0; ai < 2; ++ai)
#pragma unroll
            for (int m = 0; m < 4; ++m) { const int row = row0 + ai * HALF + m * 16; const size_t off = (size_t)row * 1024 + col0; float ss = 0.f;
#pragma unroll
                for (int bj = 0; bj < 2; ++bj) { const f32x4 a = *(const f32x4*)(x + off + bj * HALF) + acc[ai][bj][m][0], b = *(const f32x4*)(x + off + bj * HALF + 4) + acc[ai][bj][m][1];
                    ss += (a[0] * a[0] + a[1] * a[1]) + (a[2] * a[2] + a[3] * a[3]) + (b[0] * b[0] + b[1] * b[1]) + (b[2] * b[2] + b[3] * b[3]);
                    *(u32x4*)(XN2 + off + bj * HALF) = pack8(a, b); }
                ss += __shfl_xor(ss, 16); ss += __shfl_xor(ss, 32);
                if (fq == 0) ROWSS[(size_t)row * 16 + u.pn * 4 + wc] = ss; }
    }
};

struct EpiGU {
    const float* LSC; bf16_t* HID;
    __device__ __forceinline__ void operator()(const f32x4 (&acc)[2][2][4][2], const Unit& u, int wr, int wc, int fr, int fq) const {
        const int r0 = wr * 64 + fr; const int c0 = u.pn * HALF + wc * 32 + 8 * fq;
#pragma unroll
        for (int ai = 0; ai < 2; ++ai)
#pragma unroll
            for (int m = 0; m < 4; ++m) { const int r = r0 + ai * HALF + m * 16;
                f32x2 sw = (f32x2){0.f, 0.f};
                if (r < u.nv) sw = *(const f32x2*)(LSC + ((size_t)u.e * 16384 + (size_t)(u.p0 + r)) * 2);
                f32x4 h0, h1;
#pragma unroll
                for (int j = 0; j < 4; ++j) { const float a = acc[ai][0][m][0][j] * sw.x, uu = acc[ai][1][m][0][j] * sw.x; h0[j] = a * __builtin_amdgcn_rcpf(1.f + __expf(-a)) * uu * sw.y;
                                              const float a2 = acc[ai][0][m][1][j] * sw.x, u2 = acc[ai][1][m][1][j] * sw.x; h1[j] = a2 * __builtin_amdgcn_rcpf(1.f + __expf(-a2)) * u2 * sw.y; }
                *(u32x4*)(HID + (size_t)(u.pm * BM + r) * 256 + c0) = pack8(h0, h1); }
    }
};
struct EpiDown {
    bf16_t* Y;
    __device__ __forceinline__ void operator()(const f32x4 (&acc)[2][2][4][2], const Unit& u, int wr, int wc, int fr, int fq) const {
        const int r0 = u.pm * BM + wr * 64 + fr; const int c0 = u.pn * BM + wc * 32 + 8 * fq;
#pragma unroll
        for (int ai = 0; ai < 2; ++ai)
#pragma unroll
            for (int m = 0; m < 4; ++m) { bf16_t* rowp = Y + (size_t)(r0 + ai * HALF + m * 16) * 1024 + c0;
#pragma unroll
                for (int bj = 0; bj < 2; ++bj) *(u32x4*)(rowp + bj * HALF) = pack8(acc[ai][bj][m][0], acc[ai][bj][m][1]); }
    }
};
}
namespace attn_body {
using bf16=__hip_bfloat16;
using bf16x8=__attribute__((ext_vector_type(8)))short;
using s16x4=__attribute__((ext_vector_type(4)))short;
using f32x16=__attribute__((ext_vector_type(16)))float;
using u32x4=__attribute__((ext_vector_type(4)))unsigned;
constexpr int BATCH=8,NHEAD=8,SEQ=2048,D=64,DM=NHEAD*D,PO=1024;
constexpr int NW=8,QBLK=32,QB=QBLK*NW,KVBLK=64,NQB=SEQ/QB;
constexpr int ATTN_UNIT_ROWS=QB;
__device__ __forceinline__ int crow(int r,int hi){return (r&3)+8*(r>>2)+4*hi;}
#define SBAR() __builtin_amdgcn_sched_barrier(0)
typedef float f32x4a __attribute__((ext_vector_type(4)));
__device__ __forceinline__ void tbias(f32x16&p0,f32x16&p1,int t,int qpos,int hi,__attribute__((address_space(3))) const char* tabr){
  int base=qpos-64*t-4*hi; base=base<-4?-4:(base>200?200:base); const int a=200-base, s=a&3;
  const __attribute__((address_space(3))) f32x4a* tp=(const __attribute__((address_space(3))) f32x4a*)(tabr+s*1088+(a-s)*4);
  #pragma unroll
  for(int g=0;g<4;++g){ const f32x4a v0=tp[2*g], v1=tp[2*g+8];
    p0[4*g]+=v0[0];p0[4*g+1]+=v0[1];p0[4*g+2]+=v0[2];p0[4*g+3]+=v0[3]; p1[4*g]+=v1[0];p1[4*g+1]+=v1[1];p1[4*g+2]+=v1[2];p1[4*g+3]+=v1[3];
    asm volatile("":"+v"(p0),"+v"(p1)); }
}
__device__ __forceinline__ float mkeep(float v,unsigned mw,int bit){ const unsigned t=(unsigned)(((int)(mw<<(31-bit)))>>31); return __uint_as_float(__float_as_uint(v)&t); }
constexpr int NSLOT=3, SLOTB=8192;
constexpr int LDS_K=0, LDS_V=NSLOT*SLOTB, LDS_WS=2*NSLOT*SLOTB, LDS_OST=LDS_WS+NW*64*4, LDS_BYTES=LDS_OST+NW*4096, LDS_MSK=LDS_BYTES, LDS_TAB=LDS_MSK+65536, LDS_TOTAL=LDS_TAB+4352;
constexpr float C2=0.125f*1.4426950408889634f;
__device__ __forceinline__ void glds16(const void*gsrc,unsigned lds_dst){unsigned keep;
  asm volatile("s_mov_b32 %0, m0\n\ts_mov_b32 m0, %2\n\ts_nop 0\n\tglobal_load_lds_dwordx4 %1, off\n\ts_mov_b32 m0, %0":"=&s"(keep):"v"(gsrc),"s"(lds_dst):"memory");}
__device__ __forceinline__ float max3f(float a,float b,float c){float r;asm("v_max3_f32 %0, %1, %2, %3":"=v"(r):"v"(a),"v"(b),"v"(c));return r;}
__device__ __forceinline__ float max2f(float a,float b){float r;asm("v_max_f32_e32 %0, %1, %2":"=v"(r):"v"(a),"v"(b));return r;}
__device__ __forceinline__ float fadd_s(float a,float b){float r;asm("v_add_f32_e32 %0, %1, %2":"=v"(r):"v"(a),"v"(b));return r;}
__device__ __forceinline__ float fsub_s(float a,float b){float r;asm("v_sub_f32_e32 %0, %1, %2":"=v"(r):"v"(a),"v"(b));return r;}
typedef float f32x2_t __attribute__((ext_vector_type(2))); typedef __bf16 bf16x2_t __attribute__((ext_vector_type(2)));
__device__ __forceinline__ unsigned cvtpk_s(float lo,float hi){f32x2_t v={lo,hi};bf16x2_t b=__builtin_convertvector(v,bf16x2_t);return __builtin_bit_cast(unsigned,b);}
#define WAIT_BAR(N) asm volatile("s_waitcnt vmcnt(" #N ") lgkmcnt(0)\n\ts_barrier":::"memory")

__device__ __forceinline__ void qkt(f32x16&p0,f32x16&p1,const char*Kslot,const bf16x8*qr,const f32x16&negm,int r32,int hi){
  const char*kb=Kslot+hi*1024+r32*16;
  #pragma unroll
  for(int d0=0;d0<4;++d0){
    const bf16x8 b0=*reinterpret_cast<const bf16x8*>(kb+d0*2048);
    const bf16x8 b1=*reinterpret_cast<const bf16x8*>(kb+d0*2048+512);
    if(d0==0){p0=__builtin_amdgcn_mfma_f32_32x32x16_bf16(b0,qr[0],negm,0,0,0);p1=__builtin_amdgcn_mfma_f32_32x32x16_bf16(b1,qr[0],negm,0,0,0);}
    else{p0=__builtin_amdgcn_mfma_f32_32x32x16_bf16(b0,qr[d0],p0,0,0,0);p1=__builtin_amdgcn_mfma_f32_32x32x16_bf16(b1,qr[d0],p1,0,0,0);}}
}
typedef __attribute__((address_space(3))) const char* lds_cptr;
typedef short v4i16_t __attribute__((ext_vector_type(4)));
__device__ __forceinline__ void kload8(bf16x8*kf,lds_cptr kp){
  kf[0]=*(const __attribute__((address_space(3))) bf16x8*)(kp);      kf[1]=*(const __attribute__((address_space(3))) bf16x8*)(kp+512);
  kf[2]=*(const __attribute__((address_space(3))) bf16x8*)(kp+2048); kf[3]=*(const __attribute__((address_space(3))) bf16x8*)(kp+2560);
  kf[4]=*(const __attribute__((address_space(3))) bf16x8*)(kp+4096); kf[5]=*(const __attribute__((address_space(3))) bf16x8*)(kp+4608);
  kf[6]=*(const __attribute__((address_space(3))) bf16x8*)(kp+6144); kf[7]=*(const __attribute__((address_space(3))) bf16x8*)(kp+6656);
}
__device__ __forceinline__ void kload2(bf16x8*kf,lds_cptr kp,int j){ kf[2*j]=*(const __attribute__((address_space(3))) bf16x8*)(kp+j*2048); kf[2*j+1]=*(const __attribute__((address_space(3))) bf16x8*)(kp+j*2048+512); }
__device__ __forceinline__ s16x4 vtr(lds_cptr p){ return __builtin_bit_cast(s16x4,__builtin_amdgcn_ds_read_tr16_b64_v4i16((__attribute__((address_space(3))) v4i16_t*)p)); }
__device__ __forceinline__ float rowmax(const f32x16&p0,const f32x16&p1){
  float a=max3f(p0[0],p0[1],p1[0]),b=max3f(p0[2],p0[3],p1[1]);a=max3f(a,p1[2],p1[3]);
  #pragma unroll
  for(int r=4;r<16;r+=4){a=max3f(a,p0[r],p0[r+1]);b=max3f(b,p0[r+2],p0[r+3]);a=max3f(a,p1[r],p1[r+1]);b=max3f(b,p1[r+2],p1[r+3]);}
  const float m=max2f(a,b);
  auto rr=__builtin_amdgcn_permlane32_swap(__float_as_uint(m),__float_as_uint(m),false,false);
  return max2f(__uint_as_float(rr[0]),__uint_as_float(rr[1]));
}
__device__ __forceinline__ void pv(f32x16*o,int vb,bf16x8 pa0,bf16x8 pa1,bf16x8 pa2,bf16x8 pa3){
  #pragma unroll
  for(int d0=0;d0<2;++d0){s16x4 lo[4],hi[4];
    #pragma unroll
    for(int ks=0;ks<4;++ks){
      asm volatile("ds_read_b64_tr_b16 %0,%1 offset:%c2":"=&v"(lo[ks]):"v"(vb),"i"(d0*4096+ks*1024):"memory");
      asm volatile("ds_read_b64_tr_b16 %0,%1 offset:%c2":"=&v"(hi[ks]):"v"(vb),"i"(d0*4096+ks*1024+512):"memory");}
    asm volatile("s_waitcnt lgkmcnt(0)":::"memory");SBAR();
    #define PK(k) (bf16x8){lo[k][0],lo[k][1],lo[k][2],lo[k][3],hi[k][0],hi[k][1],hi[k][2],hi[k][3]}
    o[d0]=__builtin_amdgcn_mfma_f32_32x32x16_bf16(pa0,PK(0),o[d0],0,0,0);
    o[d0]=__builtin_amdgcn_mfma_f32_32x32x16_bf16(pa1,PK(1),o[d0],0,0,0);
    o[d0]=__builtin_amdgcn_mfma_f32_32x32x16_bf16(pa2,PK(2),o[d0],0,0,0);
    o[d0]=__builtin_amdgcn_mfma_f32_32x32x16_bf16(pa3,PK(3),o[d0],0,0,0);
    #undef PK
  }
}

#ifndef ATTN_STORE16
#define ATTN_STORE16(p,v) (*(u32x4*)(p)=(v))
#endif
template<int THRL> __device__ __forceinline__ void attn_unit(int b,int h,int qb,const bf16*Q,const bf16*__restrict__ K,const bf16*__restrict__ V,bf16*O,const unsigned*__restrict__ MASK,const float*__restrict__ relb,char*shm){
  int tid0_=threadIdx.x; asm volatile("":"+v"(tid0_));
  const int tid=tid0_,lane=tid&63,r32=lane&31,hi=lane>>5; const int wid=__builtin_amdgcn_readfirstlane(tid>>6);
  const long rowbase=(long)b*SEQ; const int q0=qb*QB;
  const bf16*Qw=Q+(rowbase+q0+wid*QBLK)*DM+h*D;
  const bf16*Kh=K+rowbase*DM+h*D,*Vh=V+rowbase*DM+h*D;
  const unsigned lds0=(unsigned)(uintptr_t)shm;
  float*wsf=(float*)(shm+LDS_WS)+wid*64;
  const bf16*ksrc=Kh+(long)lane*DM+wid*8;
  const bf16*vsrc=Vh+(long)(16*(wid&3)+(lane>>2))*DM+(wid>>2)*32+(lane&3)*8;
  const unsigned kdst=lds0+LDS_K+wid*1024, vdst=lds0+LDS_V+wid*1024;
  #define DMA_K(t,slot) glds16(ksrc+(long)(t)*KVBLK*DM,(unsigned)__builtin_amdgcn_readfirstlane(kdst+(slot)))
  #define DMA_V(t,slot) glds16(vsrc+(long)(t)*KVBLK*DM,(unsigned)__builtin_amdgcn_readfirstlane(vdst+(slot)))
  const int vb0=(int)(lds0+LDS_V)+((lane>>4)&1)*32+(lane&3)*8+(4*hi+((lane&15)>>2))*64;
  const char*Kbase=shm+LDS_K; bf16x8 kf[8];
  const lds_cptr shm3=(lds_cptr)shm; const lds_cptr kp0=shm3+LDS_K+hi*1024+r32*16; const lds_cptr vp0=shm3+LDS_V+((lane>>4)&1)*32+(lane&3)*8+(4*hi+((lane&15)>>2))*64;
  const int NT=(q0+QB)/KVBLK;
  { int tid_=tid; asm volatile("":"+v"(tid_));
    const u32x4*msrc=(const u32x4*)(MASK+((size_t)(b*32)*SEQ+q0)*2); u32x4*mdst=(u32x4*)(shm+LDS_MSK);
    u32x4 mv[8]; const int nit=NT>>2;
    _Pragma("unroll") for(int k=0;k<8;++k){ const int i=tid_+k*(NW*64); if(k<nit) mv[k]=msrc[(size_t)(i>>7)*(SEQ*2/4)+(i&127)]; }
    _Pragma("unroll") for(int k=0;k<8;++k){ const int i=tid_+k*(NW*64); if(k<nit) mdst[i]=mv[k]; }
    for(int i=tid_;i<4*272;i+=NW*64){ const int sft=i/272, k=i-sft*272, d=200-(k+sft); float v=0.f;
      if(d>=0&&d<=112){ int bk; if(d<16)bk=d; else { bk=16+(int)(logf((float)d*(1.0f/16.0f))/2.0794415416798357f*16.0f); bk=bk>31?31:bk; } v=(relb[bk*NHEAD+h]-relb[31*NHEAD+h])*1.4426950408889634f; }
      ((float*)(shm+LDS_TAB))[i]=v; } }
  const unsigned*mskw=(const unsigned*)(shm+LDS_MSK)+(wid*QBLK+r32)*2+hi;
  const int qpos=q0+wid*QBLK+r32;
  DMA_K(0,0);DMA_V(0,0);DMA_K(1,SLOTB);
  bf16x8 qr[4];
  #pragma unroll
  for(int d0=0;d0<4;++d0)qr[d0]=*reinterpret_cast<const bf16x8*>(&Qw[(long)r32*DM+d0*16+hi*8]);
  float mhat=0.f,l_reg=0.f;f32x16 o[2];o[0]=f32x16{};o[1]=f32x16{};f32x16 negm=f32x16{};asm volatile("":"+v"(negm));
  #define CMASK(P0,P1,t) do{ if((t)>=NT-7 && 64*(t)+63+127>=q0+wid*QBLK) tbias(P0,P1,(t),qpos,hi,shm3+LDS_TAB); }while(0)
  bool resc=false;
  #define START(P0,P1) do{ const float rm=rowmax(P0,P1); resc=false; \
    { const float dl=rm; mhat=fadd_s(mhat,dl); \
      _Pragma("unroll") for(int r=0;r<16;++r){P0[r]=fsub_s(P0[r],dl);P1[r]=fsub_s(P1[r],dl);} \
      _Pragma("unroll") for(int r=0;r<16;++r)negm[r]=-mhat; asm volatile("":"+v"(negm)); } \
    _Pragma("unroll") for(int r=0;r<16;++r)P0[r]=__builtin_amdgcn_exp2f(P0[r]); }while(0)
  #define RESC() do{ if(resc){ asm volatile("s_waitcnt lgkmcnt(0)":::"memory"); \
      _Pragma("unroll") for(int d_=0;d_<2;++d_) _Pragma("unroll") for(int r=0;r<16;++r)o[d_][r]*=wsf[crow(r,hi)]; } }while(0)
  f32x16 pA0,pA1,pB0,pB1;
  int sl_prev=0,sl_cur=0,sl_next=SLOTB;
  #define ROT() do{sl_prev=sl_cur;sl_cur=sl_next;sl_next=(sl_next==(NSLOT-1)*SLOTB)?0:sl_next+SLOTB;}while(0)
  DMA_K(2,2*SLOTB);
  WAIT_BAR(3);
  qkt(pA0,pA1,Kbase,qr,negm,r32,hi);asm volatile("s_nop 15\n\ts_nop 7":"+v"(pA0),"+v"(pA1));CMASK(pA0,pA1,0);
  START(pA0,pA1);
  _Pragma("unroll") for(int r=0;r<16;++r)pA1[r]=__builtin_amdgcn_exp2f(pA1[r]);
  { const unsigned mw0=mskw[0]; _Pragma("unroll") for(int r=0;r<16;++r){pA0[r]=mkeep(pA0[r],mw0,r);pA1[r]=mkeep(pA1[r],mw0,16+r);} }
  WAIT_BAR(0);
  DMA_K(3,0);DMA_V(1,SLOTB);
  ROT();
  kload8(kf,kp0+sl_cur);
  WAIT_BAR(2);
  s16x4 vlo[8],vhi[8]; u32x4 pw0,pw1,pw2,pw3;
  #define PKW(P,B) cvtpk_s(P[B],P[B+1])
  #define PAF(k) __builtin_bit_cast(bf16x8,pw##k)
  #define VFR(i) (bf16x8){vlo[i][0],vlo[i][1],vlo[i][2],vlo[i][3],vhi[i][0],vhi[i][1],vhi[i][2],vhi[i][3]}
  #define PIN(x) asm volatile("":"+v"(x))
  #define MX3(a,b,c) __builtin_fmaxf(__builtin_fmaxf((a),(b)),(c))
  #define GAPA(MF,A0,A1,A2,A3,W0,W1,PW) do{ MF; sacc+=A0; sacc+=A1; sacc+=A2; sacc+=A3; PIN(sacc); W0; W1; PIN(PW); SBAR(); }while(0)
  #define EX(v) __builtin_amdgcn_exp2f(v)
  #define GAPB(MF,X,B,MB) do{ MF; X[B]=mkeep(EX(X[B]),mw_,MB+B); X[B+1]=mkeep(EX(X[B+1]),mw_,MB+B+1); X[B+2]=mkeep(EX(X[B+2]),mw_,MB+B+2); X[B+3]=mkeep(EX(X[B+3]),mw_,MB+B+3); PIN(X); SBAR(); }while(0)
  #define VRD(i) do{ vlo[i]=vtr(vp_+(((i)>>2)*4096+((i)&3)*1024)); vhi[i]=vtr(vp_+(((i)>>2)*4096+((i)&3)*1024+512)); }while(0)
  #define KRD(G,j) do{ if(G){ kload2(kf,kp0+sl_next,j); SBAR(); } }while(0)
  #define STEP(C0,C1,P0,P1,t,GK,GV,GL) do{ SBAR(); \
    const lds_cptr vp_=vp0+sl_prev; const unsigned mw_=mskw[(t)*512]; \
    VRD(0); SBAR(); float sacc=(P0[0]+P0[1]); \
    GAPA(C0=__builtin_amdgcn_mfma_f32_32x32x16_bf16(kf[0],qr[0],negm,0,0,0), P0[2],P0[3],P0[4],P0[5],     pw0[0]=PKW(P0,0), pw0[1]=PKW(P0,2), pw0); \
    VRD(4); SBAR(); GAPA(C1=__builtin_amdgcn_mfma_f32_32x32x16_bf16(kf[1],qr[0],negm,0,0,0), P0[6],P0[7],P0[8],P0[9],     pw0[2]=PKW(P0,4), pw0[3]=PKW(P0,6), pw0); \
    VRD(1); SBAR(); GAPA(C0=__builtin_amdgcn_mfma_f32_32x32x16_bf16(kf[2],qr[1],C0,0,0,0),   P0[10],P0[11],P0[12],P0[13], pw1[0]=PKW(P0,8), pw1[1]=PKW(P0,10), pw1); \
    VRD(5); SBAR(); GAPA(C1=__builtin_amdgcn_mfma_f32_32x32x16_bf16(kf[3],qr[1],C1,0,0,0),   P0[14],P0[15],P1[0],P1[1],   pw1[2]=PKW(P0,12),pw1[3]=PKW(P0,14), pw1); \
    VRD(2); SBAR(); GAPA(C0=__builtin_amdgcn_mfma_f32_32x32x16_bf16(kf[4],qr[2],C0,0,0,0),   P1[2],P1[3],P1[4],P1[5],     pw2[0]=PKW(P1,0), pw2[1]=PKW(P1,2), pw2); \
    VRD(6); SBAR(); GAPA(C1=__builtin_amdgcn_mfma_f32_32x32x16_bf16(kf[5],qr[2],C1,0,0,0),   P1[6],P1[7],P1[8],P1[9],     pw2[2]=PKW(P1,4), pw2[3]=PKW(P1,6), pw2); \
    VRD(3); SBAR(); GAPA(C0=__builtin_amdgcn_mfma_f32_32x32x16_bf16(kf[6],qr[3],C0,0,0,0),   P1[10],P1[11],P1[12],P1[13], pw3[0]=PKW(P1,8), pw3[1]=PKW(P1,10), pw3); \
    VRD(7); SBAR(); GAPA(C1=__builtin_amdgcn_mfma_f32_32x32x16_bf16(kf[7],qr[3],C1,0,0,0),   P1[14],P1[15],0.f,0.f,       pw3[2]=PKW(P1,12),pw3[3]=PKW(P1,14), pw3); \
    l_reg+=sacc; \
    if(GK){DMA_K((t)+3,sl_cur);} if(GV){DMA_V((t)+1,sl_next);} \
    CMASK(C0,C1,t); \
    { float a=MX3(C0[0],C0[1],C1[0]),b=MX3(C0[2],C0[3],C1[1]); a=MX3(a,C1[2],C1[3]); \
      _Pragma("unroll") for(int r=4;r<16;r+=4){a=MX3(a,C0[r],C0[r+1]);b=MX3(b,C0[r+2],C0[r+3]);a=MX3(a,C1[r],C1[r+1]);b=MX3(b,C1[r+2],C1[r+3]);} \
      float rm=__builtin_fmaxf(a,b); { auto rr=__builtin_amdgcn_permlane32_swap(__float_as_uint(rm),__float_as_uint(rm),false,false); rm=__builtin_fmaxf(__uint_as_float(rr[0]),__uint_as_float(rr[1])); } \
      resc=false; \
      if(__builtin_expect(__any(rm>(float)THRL),0)){ const float dl=__builtin_fmaxf(rm,0.f); mhat+=dl; \
        _Pragma("unroll") for(int r=0;r<16;++r){C0[r]-=dl;C1[r]-=dl;} \
        _Pragma("unroll") for(int r=0;r<16;++r)negm[r]=-mhat; asm volatile("":"+v"(negm)); \
        const float f=__builtin_amdgcn_exp2f(-dl); l_reg*=f; if(hi==0)wsf[r32]=f; resc=true; } } \
    SBAR(); \
    GAPB(o[0]=__builtin_amdgcn_mfma_f32_32x32x16_bf16(PAF(0),VFR(0),o[0],0,0,0), C0,0,0); \
    GAPB(o[1]=__builtin_amdgcn_mfma_f32_32x32x16_bf16(PAF(0),VFR(4),o[1],0,0,0), C0,4,0); \
    KRD(GL,0); GAPB(o[0]=__builtin_amdgcn_mfma_f32_32x32x16_bf16(PAF(1),VFR(1),o[0],0,0,0), C0,8,0); \
    KRD(GL,1); GAPB(o[1]=__builtin_amdgcn_mfma_f32_32x32x16_bf16(PAF(1),VFR(5),o[1],0,0,0), C0,12,0); \
    KRD(GL,2); GAPB(o[0]=__builtin_amdgcn_mfma_f32_32x32x16_bf16(PAF(2),VFR(2),o[0],0,0,0), C1,0,16); \
    KRD(GL,3); GAPB(o[1]=__builtin_amdgcn_mfma_f32_32x32x16_bf16(PAF(2),VFR(6),o[1],0,0,0), C1,4,16); \
    GAPB(o[0]=__builtin_amdgcn_mfma_f32_32x32x16_bf16(PAF(3),VFR(3),o[0],0,0,0), C1,8,16); \
    GAPB(o[1]=__builtin_amdgcn_mfma_f32_32x32x16_bf16(PAF(3),VFR(7),o[1],0,0,0), C1,12,16); \
    }while(0)
  int t=1;
  #undef CMASK
  #define CMASK(P0,P1,t) do{}while(0)
  for(;t+7<NT;t+=2){
    STEP(pB0,pB1,pA0,pA1,t,true,true,true);     WAIT_BAR(2); RESC(); ROT();
    STEP(pA0,pA1,pB0,pB1,t+1,true,true,true);   WAIT_BAR(2); RESC(); ROT();
  }
  #undef CMASK
  #define CMASK(P0,P1,t) do{ if(64*(t)+63+127>=q0+wid*QBLK) tbias(P0,P1,(t),qpos,hi,shm3+LDS_TAB); }while(0)
  #define ENDW(tt) do{ if((tt)+3<NT){WAIT_BAR(2);} else if((tt)+2<NT){WAIT_BAR(1);} else {WAIT_BAR(0);} }while(0)
  for(;t+1<NT;t+=2){
    STEP(pB0,pB1,pA0,pA1,t,(t+3<NT),(t+1<NT),(t+1<NT));       ENDW(t);   RESC(); ROT();
    STEP(pA0,pA1,pB0,pB1,t+1,(t+4<NT),(t+2<NT),(t+2<NT));     ENDW(t+1); RESC(); ROT();
  }
  STEP(pB0,pB1,pA0,pA1,NT-1,false,false,false); RESC();
  { float sacc=pB0[0]+pB0[1]; _Pragma("unroll") for(int r=2;r<16;++r)sacc+=pB0[r]; _Pragma("unroll") for(int r=0;r<16;++r)sacc+=pB1[r]; l_reg+=sacc;
    pw0=(u32x4){PKW(pB0,0),PKW(pB0,2),PKW(pB0,4),PKW(pB0,6)};pw1=(u32x4){PKW(pB0,8),PKW(pB0,10),PKW(pB0,12),PKW(pB0,14)};pw2=(u32x4){PKW(pB1,0),PKW(pB1,2),PKW(pB1,4),PKW(pB1,6)};pw3=(u32x4){PKW(pB1,8),PKW(pB1,10),PKW(pB1,12),PKW(pB1,14)};
    SBAR(); pv(o,vb0+sl_cur,PAF(0),PAF(1),PAF(2),PAF(3)); }
  #undef PKW
  #undef PAF
  #undef VFR
  #undef PIN
  #undef MX3
  #undef GAPA
  #undef GAPB
  #undef EX
  #undef VRD
  #undef KRD
  #undef STEP
  #undef ENDW
  {auto rr=__builtin_amdgcn_permlane32_swap(__float_as_uint(l_reg),__float_as_uint(l_reg),false,false);l_reg=__uint_as_float(rr[0])+__uint_as_float(rr[1]);}
  if(hi==0)wsf[32+r32]=l_reg;asm volatile("s_waitcnt lgkmcnt(0)":::"memory");
  float rli[16];
  #pragma unroll
  for(int r=0;r<16;++r)rli[r]=__builtin_amdgcn_rcpf(wsf[32+crow(r,hi)]);
  bf16*Ow=O+(rowbase+q0+wid*QBLK)*PO+h*D;
  { bf16*stg=(bf16*)(shm+LDS_OST)+wid*2048;
    #pragma unroll
    for(int r=0;r<16;++r){const int orow=crow(r,hi);
      #pragma unroll
      for(int d0=0;d0<2;++d0)stg[orow*64+d0*32+r32]=__float2bfloat16(o[d0][r]*rli[r]);}
    asm volatile("s_waitcnt lgkmcnt(0)":::"memory");
    #pragma unroll
    for(int i=0;i<4;++i){const int row=i*8+(lane>>3),ch=lane&7; const u32x4 v=*(const u32x4*)(stg+row*64+ch*8); ATTN_STORE16(Ow+(long)row*PO+ch*8,v);} }
  asm volatile("s_waitcnt lgkmcnt(0)\n\ts_barrier":::"memory");
  #undef DMA_K
  #undef DMA_V
  #undef CMASK
  #undef START
  #undef RESC
  #undef ROT
}
struct AttnTensors { const bf16* Q; const bf16* K; const bf16* V; bf16* O; const unsigned* MASK; const float* relb; };
struct AttnUnit { int bh; int qb; };
constexpr int ATTN_LDS_BYTES=LDS_TOTAL;
#undef SBAR
#undef WAIT_BAR
}
constexpr int NWAVES = 8;
#ifndef MK_N_LAUNCHES
#define MK_N_LAUNCHES 1
#endif
constexpr int PER_PHASE = 10;
constexpr int N_LAUNCHES = (MK_N_LAUNCHES == 1) ? 1 : PER_PHASE;
constexpr int M = 8 * 2048;
constexpr size_t MiB = 1u << 20;
constexpr size_t WS_CTL = 0, CTL_ZERO_BYTES = 65536;
constexpr size_t WS_RSTD1 = 1 * MiB, WS_ROWSS = 2 * MiB, WS_WR = 3 * MiB, WS_BLAST = 3 * MiB + 512 * 1024, WS_TOKINFO = 4 * MiB, WS_LISTS = 5 * MiB, WS_LSC = 7 * MiB;
constexpr size_t WS_WO = 16 * MiB, WS_WGU = 18 * MiB, WS_WD = 50 * MiB, WS_XB = 66 * MiB, WS_MASK = 66 * MiB, WS_SB = 70 * MiB, WS_WIN = 98 * MiB;
constexpr size_t WS_QN = 106 * MiB, WS_KN = 122 * MiB, WS_VN = 138 * MiB, WS_XN2 = 106 * MiB, WS_IQ = 154 * MiB, WS_MISC = 162 * MiB, WS_QB = 164 * MiB, WS_KB = 172 * MiB, WS_VB = 180 * MiB, WS_RG = 196 * MiB;
constexpr size_t WS_MIX = 212 * MiB, WS_HID = 138 * MiB, WS_Y = 158 * MiB, WS_END = 244 * MiB;
constexpr int CW_TMO = 0, CW_CODE = 1, CW_BAR = 4096, CW_CNT = 15360;
constexpr int RING_BYTES = 154624;
constexpr int LDSCTL_OFF = RING_BYTES, MISC_OFF = LDSCTL_OFF, TOFF_OFF = LDSCTL_OFF + 256;
constexpr int LDS_BYTES = RING_BYTES + 1024;
static_assert(attn_body::ATTN_LDS_BYTES <= RING_BYTES, "attention LDS");
#ifndef REP_IDX
#define REP_IDX 1
#endif
#ifndef REP_GLAA
#define REP_GLAA 1
#endif
#ifndef REP_ATT
#define REP_ATT 1
#endif
#ifndef REP_GLAC
#define REP_GLAC 1
#endif
#ifndef REP_IDX_SCORE
#define REP_IDX_SCORE 1
#endif
#ifndef REP_IDX_SEL
#define REP_IDX_SEL 1
#endif
#ifndef REP_SEL_A
#define REP_SEL_A 1
#endif
#ifndef REP_SEL_B
#define REP_SEL_B 1
#endif
#ifndef REP_SEL_C
#define REP_SEL_C 1
#endif
#define GAS __attribute__((address_space(1)))
#define LAS __attribute__((address_space(3)))
typedef unsigned short bf16;
typedef unsigned v4u __attribute__((ext_vector_type(4)));
typedef float f32x4 __attribute__((ext_vector_type(4)));
typedef short bf16x8 __attribute__((ext_vector_type(8)));
typedef GAS unsigned gu32;
typedef GAS unsigned long long gu64;
#define RLX_AGENT __ATOMIC_RELAXED, __HIP_MEMORY_SCOPE_AGENT
#define LDS_WAIT() asm volatile("s_waitcnt lgkmcnt(0)" ::: "memory")
#define VM_WAIT() asm volatile("s_waitcnt vmcnt(0)" ::: "memory")
__device__ __forceinline__ unsigned long long rt() { return __builtin_amdgcn_s_memrealtime(); }
__device__ __forceinline__ unsigned f2bf(float f) { unsigned u = __builtin_bit_cast(unsigned, f); return (u + 0x7fffu + ((u >> 16) & 1u)) >> 16; }
__device__ __forceinline__ unsigned pk2(float lo, float hi) { return f2bf(lo) | (f2bf(hi) << 16); }

#define XB_TMO      128
#define XB_XCNT(j)  (256  + 64 * (j))
#define XB_XSUB(j)  (1280 + 64 * (j))
#define XB_XGEN(j)  (2304 + 64 * (j))
#define XB_TOP      3328
#define XB_TOPGEN   3392
#define XCD_BAR_WORDS 3456
#define XB_SPIN_CAP (1u << 18)

__device__ __forceinline__ unsigned xb_ld(unsigned* p)              { return __hip_atomic_load(p, __ATOMIC_RELAXED, __HIP_MEMORY_SCOPE_AGENT); }
__device__ __forceinline__ unsigned xb_add(unsigned* p, unsigned v) { return __hip_atomic_fetch_add(p, v, __ATOMIC_RELAXED, __HIP_MEMORY_SCOPE_AGENT); }
__device__ __forceinline__ unsigned xb_xcc_id() { return (unsigned)__builtin_amdgcn_s_getreg((3 << 11) | 20) & 0xFu; }
#define XB_SPIN(cond, bar) do { unsigned _sp = 0; while (cond) { __builtin_amdgcn_s_sleep(1); \
    if ((++_sp & 255u) == 0u) { if (xb_ld(&(bar)[XB_TMO])) break; if (_sp > XB_SPIN_CAP) { atomicAdd(&(bar)[XB_TMO], 1u); break; } } } } while (0)

struct XcdBarrier {
    unsigned* bar; unsigned x;
    volatile LAS unsigned* st;
};

__device__ __forceinline__ XcdBarrier xcd_barrier_post(unsigned* bar, volatile LAS unsigned* st) {
    XcdBarrier b; b.bar = bar; b.x = xb_xcc_id(); b.st = st;
    if (threadIdx.x == 0) (void)xb_add(&bar[XB_XCNT(b.x)], 1u);
    return b;
}
__device__ __forceinline__ void xcd_barrier_complete(unsigned* bar, unsigned x, unsigned& nloc, unsigned& nx) {
    const unsigned G = gridDim.x * gridDim.y * gridDim.z;
    unsigned sum, cnt, mine, sp = 0u;
    for (;;) {
        sum = 0u; cnt = 0u; mine = 0u;
#pragma unroll
        for (unsigned j = 0; j < 16; ++j) { const unsigned c = xb_ld(&bar[XB_XCNT(j)]); sum += c; cnt += (c > 0u) ? 1u : 0u; mine = (j == x) ? c : mine; }
        if (sum == G) break;
        __builtin_amdgcn_s_sleep(1);
        if ((++sp & 255u) == 0u) { if (xb_ld(&bar[XB_TMO])) break; if (sp > XB_SPIN_CAP) { atomicAdd(&bar[XB_TMO], 1u); break; } }
    }
    nloc = mine > 0u ? mine : 1u; nx = cnt > 0u ? cnt : 1u;
}

__device__ __forceinline__ void xcd_barrier(const XcdBarrier& b) {
    asm volatile("s_waitcnt vmcnt(0)" ::: "memory");
    __syncthreads();
    if (threadIdx.x == 0) {
        unsigned* bar = b.bar;
        __builtin_amdgcn_s_waitcnt(0);
        unsigned nloc = b.st[0], nx = b.st[1];
        if (nloc == 0u) { xcd_barrier_complete(bar, b.x, nloc, nx); b.st[0] = nloc; b.st[1] = nx; }
        const unsigned old = xb_add(&bar[XB_XSUB(b.x)], 1u);
        const unsigned gen = old / nloc;
        if (old + 1u == (gen + 1u) * nloc) {
            __builtin_amdgcn_fence(__ATOMIC_RELEASE, "agent");
            asm volatile("s_waitcnt vmcnt(0)" ::: "memory");
            const unsigned og = xb_add(&bar[XB_TOP], 1u);
            const unsigned tg = og / nx;
            if (og + 1u == (tg + 1u) * nx) xb_add(&bar[XB_TOPGEN], 1u);
            else XB_SPIN(xb_ld(&bar[XB_TOPGEN]) == tg, bar);
            __builtin_amdgcn_fence(__ATOMIC_ACQUIRE, "agent");
            xb_add(&bar[XB_XGEN(b.x)], 1u);
            asm volatile("s_waitcnt vmcnt(0)" ::: "memory");
        } else {
            XB_SPIN(xb_ld(&bar[XB_XGEN(b.x)]) == gen, bar);
            __builtin_amdgcn_fence(__ATOMIC_ACQUIRE, "agent");
            asm volatile("s_waitcnt vmcnt(0)" ::: "memory");
        }
    }
    __syncthreads();
}
typedef float f32x2 __attribute__((ext_vector_type(2)));
typedef unsigned v2u __attribute__((ext_vector_type(2)));
__device__ __forceinline__ float bf2f(unsigned short b) { return __uint_as_float((unsigned)b << 16); }
__device__ __forceinline__ float bflo(unsigned w) { return __uint_as_float(w << 16); }
__device__ __forceinline__ float bfhi(unsigned w) { return __uint_as_float(w & 0xffff0000u); }
__device__ __forceinline__ float wave_sum(float v) {
#pragma unroll
    for (int o = 1; o < 64; o <<= 1) v += __shfl_xor(v, o);
    return v;
}
__device__ __forceinline__ float wave_max(float v) {
#pragma unroll
    for (int o = 1; o < 64; o <<= 1) v = fmaxf(v, __shfl_xor(v, o));
    return v;
}
__device__ __forceinline__ float wave_min(float v) {
#pragma unroll
    for (int o = 1; o < 64; o <<= 1) v = fminf(v, __shfl_xor(v, o));
    return v;
}
#define WG_SYNC() __syncthreads()
#define DPP_STEP_I(v, ctrl) __builtin_amdgcn_update_dpp(0, (v), (ctrl), 0xF, 0xF, false)
__device__ __forceinline__ int wave_isum(int v) {
    v += DPP_STEP_I(v, 0xB1); v += DPP_STEP_I(v, 0x4E); v += DPP_STEP_I(v, 0x141); v += DPP_STEP_I(v, 0x140);
    return __builtin_amdgcn_readlane(v, 0) + __builtin_amdgcn_readlane(v, 16) + __builtin_amdgcn_readlane(v, 32) + __builtin_amdgcn_readlane(v, 48);
}
#define DPP_STEP_F(v, ctrl) __uint_as_float((unsigned)__builtin_amdgcn_update_dpp(0, (int)__float_as_uint(v), (ctrl), 0xF, 0xF, false))
#define RDL_F(v, l) __uint_as_float((unsigned)__builtin_amdgcn_readlane((int)__float_as_uint(v), (l)))
__device__ __forceinline__ float wave_fsum(float v) {
    v += DPP_STEP_F(v, 0xB1); v += DPP_STEP_F(v, 0x4E); v += DPP_STEP_F(v, 0x141); v += DPP_STEP_F(v, 0x140);
    return (RDL_F(v, 0) + RDL_F(v, 16)) + (RDL_F(v, 32) + RDL_F(v, 48));
}
__device__ __forceinline__ float wave_fmax(float v) {
    v = fmaxf(v, DPP_STEP_F(v, 0xB1)); v = fmaxf(v, DPP_STEP_F(v, 0x4E)); v = fmaxf(v, DPP_STEP_F(v, 0x141)); v = fmaxf(v, DPP_STEP_F(v, 0x140));
    return fmaxf(fmaxf(RDL_F(v, 0), RDL_F(v, 16)), fmaxf(RDL_F(v, 32), RDL_F(v, 48)));
}
__device__ __forceinline__ float wave_fmin(float v) {
    v = fminf(v, DPP_STEP_F(v, 0xB1)); v = fminf(v, DPP_STEP_F(v, 0x4E)); v = fminf(v, DPP_STEP_F(v, 0x141)); v = fminf(v, DPP_STEP_F(v, 0x140));
    return fminf(fminf(RDL_F(v, 0), RDL_F(v, 16)), fminf(RDL_F(v, 32), RDL_F(v, 48)));
}

__device__ __forceinline__ int win_vrow(int n) {
    if (n < 1024) { const int base = (n < 512) ? 0 : 512, m = n - base, hh = m >> 6, d = m & 63; return base + 256 * (hh >> 2) + 128 * (d >> 5) + 32 * (hh & 3) + (d & 31); }
    if (n < 1792) return n;
    if (n < 1832) return 3328 + (n - 1792);
    if (n < 2088) return 1792 + (n - 1832);
    if (n < 2344) return 2048 + (n - 2088);
    if (n < 2856) return 2304 + (n - 2344);
    if (n < 2872) return 3328 + 40 + (n - 2856);
    return 2816 + (n - 2872);
}
template <int KIND>
__device__ __forceinline__ void p0_transpose_item(const float* __restrict__ W, int K, int N, const float* __restrict__ gain, bf16* WT, LAS float* scr, int item, int lane) {
    const int nblk = (N + 31) / 32, kb = item / nblk, nb = item % nblk, k0 = 64 * kb, n0 = 32 * nb;
    f32x4 v[8];
#pragma unroll
    for (int j = 0; j < 8; ++j) { const int i = lane + 64 * j, kk = i >> 3, c4 = (i & 7) * 4; v[j] = (n0 + c4 < N) ? *(const f32x4*)(W + (size_t)(k0 + kk) * N + n0 + c4) : (f32x4){0.f, 0.f, 0.f, 0.f}; }
#pragma unroll
    for (int j = 0; j < 8; ++j) { const int i = lane + 64 * j, kk = i >> 3, c4 = (i & 7) * 4; f32x4 x = v[j]; if (gain) x = x * gain[k0 + kk];
        scr[kk * 33 + c4] = x[0]; scr[kk * 33 + c4 + 1] = x[1]; scr[kk * 33 + c4 + 2] = x[2]; scr[kk * 33 + c4 + 3] = x[3]; }
    LDS_WAIT(); asm volatile("" ::: "memory");
    const int c = lane & 7;
#pragma unroll
    for (int j = 0; j < 4; ++j) { const int n = (lane >> 3) + 8 * j; const LAS float* s = scr + (8 * c) * 33 + n;
        v4u o; o.x = pk2(s[0 * 33], s[1 * 33]); o.y = pk2(s[2 * 33], s[3 * 33]); o.z = pk2(s[4 * 33], s[5 * 33]); o.w = pk2(s[6 * 33], s[7 * 33]);
        const int gn = n0 + n; int row;
        if (KIND == 0) row = win_vrow(gn); else if (KIND == 1) row = gn; else if (KIND == 2) row = (gn >> 7) * 256 + (gn & 127); else row = (gn >> 7) * 256 + 128 + (gn & 127);
        if (gn < N) *(GAS v4u*)(WT + (size_t)row * K + k0 + 8 * c) = o; }
    LDS_WAIT(); asm volatile("" ::: "memory");
}

constexpr int SCP = 2064;
__device__ __forceinline__ int crow_(int r, int hi) { return (r & 3) + 8 * (r >> 2) + 4 * hi; }
__device__ __forceinline__ void idx_item(LAS unsigned char* lds, int b, int p, const bf16* __restrict__ IQ, const bf16* __restrict__ MISC, unsigned* __restrict__ MASK, int lane, int wid) {
    const int q0 = p * 16, fr = lane & 15, fq = lane >> 4;
    LAS float* SC = (LAS float*)lds;
    const size_t rowq = (size_t)b * 2048 + q0 + fr;
    bf16x8 Bq[8]; float sinf[8];
    {   const v4u wraw = *(const v4u*)(MISC + rowq * 64 + 32);
        const unsigned wr_[4] = {wraw.x, wraw.y, wraw.z, wraw.w};
#pragma unroll
        for (int h = 0; h < 8; ++h) { const float w = ((h & 1) ? bfhi(wr_[h >> 1]) : bflo(wr_[h >> 1])) * 0.0625f;
            const v4u raw = *(const v4u*)(IQ + rowq * 256 + h * 32 + fq * 8);
            v4u o; o.x = pk2(bflo(raw.x) * w, bfhi(raw.x) * w); o.y = pk2(bflo(raw.y) * w, bfhi(raw.y) * w); o.z = pk2(bflo(raw.z) * w, bfhi(raw.z) * w); o.w = pk2(bflo(raw.w) * w, bfhi(raw.w) * w);
            Bq[h] = __builtin_bit_cast(bf16x8, o); sinf[h] = (w > 0.f) ? __builtin_inff() : -__builtin_inff(); } }
    const int nkt = p + 1;
    const bf16* ikb = MISC + ((size_t)b * 2048 + fr) * 64 + fq * 8;
    for (int rep_ = 0; rep_ < REP_IDX_SCORE; ++rep_)
    for (int kt0 = wid; kt0 < nkt; kt0 += 32) {
        f32x4 acc[4]; bf16x8 A[4];
#pragma unroll
        for (int u = 0; u < 4; ++u) { const int kt = kt0 + 8 * u; acc[u] = (f32x4){0.f, 0.f, 0.f, 0.f}; if (kt < nkt) A[u] = *(const bf16x8*)(ikb + (size_t)kt * 16 * 64); else A[u] = (bf16x8){0, 0, 0, 0, 0, 0, 0, 0}; }
#pragma unroll
        for (int h = 0; h < 8; ++h)
#pragma unroll
            for (int u = 0; u < 4; ++u) { const f32x4 t = __builtin_amdgcn_mfma_f32_16x16x32_bf16(A[u], Bq[h], acc[u], 0, 0, 0);
#pragma unroll
                for (int i = 0; i < 4; ++i) acc[u][i] = __builtin_amdgcn_fmed3f(t[i], acc[u][i], sinf[h]); }
#pragma unroll
        for (int u = 0; u < 4; ++u) { const int kt = kt0 + 8 * u;
            if (kt < nkt) { if (kt == nkt - 1) {
#pragma unroll
                    for (int i = 0; i < 4; ++i) if (4 * fq + i > fr) acc[u][i] = -__builtin_inff(); }
                *(LAS f32x4*)(SC + fr * SCP + kt * 16 + 4 * fq) = acc[u]; } }
    }
    WG_SYNC();
    const int kap = 32 * ((lane >> 4) & 1) + crow_(lane & 15, lane >> 5);
#define IDX_COUNT(dst, expr) do { int cl__ = 0; _Pragma("unroll") for (int g__ = 0; g__ < 4; ++g__) if (8 * g__ < ntile) { _Pragma("unroll") for (int jj__ = 0; jj__ < 8; ++jj__) { const int j = 8 * g__ + jj__; cl__ += (expr) ? 1 : 0; } } \
        dst = wave_isum(cl__); } while (0)
#define IDX_UNI(v) __uint_as_float((unsigned)__builtin_amdgcn_readfirstlane((int)__float_as_uint(v)))
    for (int rep_ = 0; rep_ < REP_IDX_SEL; ++rep_)
    for (int rr = 0; rr < 2; ++rr) {
        const int r = 2 * wid + rr, q = q0 + r, n = q + 1, ntile = (q >> 6) + 1, ngrp = (ntile + 7) >> 3;
        const float NINF = -__builtin_inff();
        float x[32]; unsigned vmask = 0u;
        for (int rpa = 0; rpa < REP_SEL_A; ++rpa) { int off_ = 0; asm volatile("" : "+v"(off_)); vmask = 0u;
#pragma unroll
        for (int j = 0; j < 32; ++j) x[j] = SC[r * SCP + 64 * j + kap + off_];
#pragma unroll
        for (int j = 0; j < 32; ++j) { const bool v = (64 * j + kap + off_) <= q; vmask |= v ? (1u << j) : 0u; x[j] = v ? x[j] : NINF; }
        }
        unsigned selm = vmask;
        for (int rpb = 0; rpb < REP_SEL_B; ++rpb) { asm volatile("" : "+v"(x[0]), "+v"(vmask)); selm = vmask;
        if (n > 256) {
            float mx = NINF, mn = __builtin_inff(), s1 = 0.f, s2 = 0.f;
#pragma unroll
            for (int g = 0; g < 4; ++g) if (g < ngrp) {
#pragma unroll
                for (int jj = 0; jj < 8; ++jj) { const int j = 8 * g + jj; const bool v = (vmask >> j) & 1u; const float xv = v ? x[j] : 0.f; mx = fmaxf(mx, x[j]); mn = fminf(mn, v ? x[j] : __builtin_inff()); s1 += xv; s2 += xv * xv; } }
            float hi = IDX_UNI(wave_fmax(mx)), lo = IDX_UNI(wave_fmin(mn));
            const float fn = (float)n, mu = wave_fsum(s1) / fn, var = fmaxf(wave_fsum(s2) / fn - mu * mu, 0.f);
            int c_lo = n, c_hi = 1;
            bool tie = false, found = false; float tv = hi, thr = hi; int need = 256;
            float mid; { const float pq = 256.0f / fn, pp = pq <= 0.5f ? pq : 1.0f - pq; const float t = sqrtf(-2.0f * __logf(pp)); float z = t - (2.30753f + 0.27061f * t) / (1.0f + t * (0.99229f + 0.04481f * t)); z = pq <= 0.5f ? z : -z; mid = IDX_UNI(mu + z * sqrtf(var)); }
            int side = 0;
            for (int it = 0; it < 40; ++it) {
                if (it > 0 || !(mid > lo && mid < hi)) {
                    mid = 0.5f * lo + 0.5f * hi;
                    if (side > -2 && side < 2) { const float fr_ = ((float)(c_lo - 256) + 0.5f) * __builtin_amdgcn_rcpf((float)(c_lo - c_hi)); const float m2 = lo + (hi - lo) * fr_; if (m2 > lo && m2 < hi) mid = m2; } else side = 0;
                    mid = IDX_UNI(mid);
                }
                if (!(mid > lo && mid < hi)) break;
                int c = 0;
#pragma unroll
                for (int g = 0; g < 4; ++g) if (g < ngrp) { unsigned long long m_[8];
#pragma unroll
                    for (int jj = 0; jj < 8; ++jj) asm("v_cmp_ge_f32_e64 %0, %1, %2" : "=s"(m_[jj]) : "v"(x[8 * g + jj]), "s"(mid));
#pragma unroll
                    for (int jj = 0; jj < 8; ++jj) c += __builtin_popcountll(m_[jj]); }
                if (c == 256) { found = true; thr = mid; selm = 0u;
#pragma unroll
                    for (int j = 0; j < 32; ++j) selm |= (x[j] >= mid) ? (1u << j) : 0u;
                    break; }
                if (c > 256) { lo = mid; c_lo = c; side = side > 0 ? side + 1 : 1; } else { hi = mid; c_hi = c; side = side < 0 ? side - 1 : -1; }
            }
            if (!found) {
                IDX_COUNT(c_hi, x[j] >= hi);
                if (c_hi >= 256) { if (c_hi == 256) { thr = hi; found = true; } else { tie = true; tv = hi; need = 256; } }
                else for (int it = 0; it < 4096; ++it) {
                    float m = NINF;
#pragma unroll
                    for (int g = 0; g < 4; ++g) if (g < ngrp) {
#pragma unroll
                        for (int jj = 0; jj < 8; ++jj) { const int j = 8 * g + jj; m = fmaxf(m, (x[j] < hi) ? x[j] : NINF); } }
                    const float v1 = IDX_UNI(wave_fmax(m));
                    int c; IDX_COUNT(c, x[j] >= v1);
                    if (c >= 256) { if (c == 256) { thr = v1; found = true; } else { tie = true; tv = v1; need = 256 - c_hi; } break; }
                    hi = v1; c_hi = c;
                }
                if (!tie) { selm = 0u;
#pragma unroll
                    for (int j = 0; j < 32; ++j) selm |= (x[j] >= thr) ? (1u << j) : 0u;
                } else {
                    int cum = 0, jstar = 32, needp = 0; unsigned tiem = 0u; selm = 0u;
#pragma unroll
                    for (int j = 0; j < 32; ++j) { const bool t = (x[j] == tv); tiem |= t ? (1u << j) : 0u; const int cj = __builtin_popcountll(__ballot(t));
                        if (jstar == 32 && cum + cj > need) { jstar = j; needp = need - cum; } cum += cj; }
                    const bool tstar = (jstar < 32) && ((tiem >> (jstar & 31)) & 1u);
                    int kL = 0, kH = 63;
                    if (jstar < 32 && needp > 0) { while (kL < kH) { const int km = (kL + kH) >> 1; const int c = __builtin_popcountll(__ballot(tstar && kap <= km)); if (c >= needp) kH = km; else kL = km + 1; } }
                    else kL = -1;
#pragma unroll
                    for (int j = 0; j < 32; ++j) { const bool t = (tiem >> j) & 1u; const bool ts = t && (j < jstar || (j == jstar && kap <= kL)); selm |= (x[j] > tv || ts) ? (1u << j) : 0u; }
                }
            }
        }
        }
        unsigned wlo = 0u, whi = 0u;
        for (int rpc = 0; rpc < REP_SEL_C; ++rpc) { asm volatile("" : "+v"(selm));
#pragma unroll
        for (int j = 0; j < 32; ++j) { const unsigned long long bal = __ballot((selm >> j) & 1u); if (lane == j) { wlo = (unsigned)bal; whi = (unsigned)(bal >> 32); } }
        if (lane < 32) { v2u o; o.x = wlo; o.y = whi; *(v2u*)(MASK + (((size_t)(b * 32 + lane)) * 2048 + q) * 2) = o; }
        }
    }
#undef IDX_COUNT
#undef IDX_UNI
    WG_SYNC();
}

constexpr int KTP = 72;
constexpr int VRP = 136;
constexpr int EP = 68;
constexpr int OTP = 132;
constexpr int GL_OFF = 0, TOT_OFF = 4096, E_OFF = 6144, QA_OFF = 23552, KR_OFF = 32768, PM_OFF = 41984, VR_OFF = 51200, OT_OFF = 68608;
typedef short v4i16g __attribute__((ext_vector_type(4)));
__device__ __forceinline__ bf16x8 tr_frag(const LAS bf16* T, int pitch, int k0, int n0, int lane) {
    const int g = lane >> 4, q = (lane & 15) >> 2, p = lane & 3;
    const LAS bf16* a = T + (k0 + 8 * g + q) * pitch + n0 + 4 * p;
    const v4i16g lo = __builtin_amdgcn_ds_read_tr16_b64_v4i16((LAS v4i16g*)a), hi = __builtin_amdgcn_ds_read_tr16_b64_v4i16((LAS v4i16g*)(a + 4 * pitch));
    return (bf16x8){lo[0], lo[1], lo[2], lo[3], hi[0], hi[1], hi[2], hi[3]};
}
__device__ __forceinline__ float fexp(float x) { return __builtin_amdgcn_exp2f(x * 1.4426950408889634f); }
__device__ __forceinline__ float gla_decay(LAS unsigned char* lds, const bf16* __restrict__ MISC, const float* __restrict__ w2, const float* __restrict__ gb, size_t row0, int h, int tid) {
    LAS float* GL = (LAS float*)(lds + GL_OFF); LAS float* TOT = (LAS float*)(lds + TOT_OFF); LAS float* E = (LAS float*)(lds + E_OFF);
    const int d = tid & 63, tg = tid >> 6;
    { const int t = tid >> 3, r2 = (tid & 7) * 2; const unsigned w = *(const unsigned*)(MISC + (row0 + t) * 64 + 40 + r2); GL[t * 16 + r2] = bflo(w); GL[t * 16 + r2 + 1] = bfhi(w); }
    float wc[16];
#pragma unroll
    for (int r = 0; r < 16; ++r) wc[r] = w2[r * 256 + h * 64 + d];
    const float bias = gb[h * 64 + d];
    WG_SYNC();
    float bc[8]; float run = 0.f;
#pragma unroll
    for (int i = 0; i < 8; ++i) { const int t = 8 * tg + i; float z = bias;
#pragma unroll
        for (int r4 = 0; r4 < 4; ++r4) { const f32x4 g = *(const LAS f32x4*)(GL + t * 16 + 4 * r4); z += g[0] * wc[4 * r4] + g[1] * wc[4 * r4 + 1] + g[2] * wc[4 * r4 + 2] + g[3] * wc[4 * r4 + 3]; }
        const float ls = fminf(z, 0.f) - 0.6931471805599453f * __builtin_amdgcn_logf(1.0f + __builtin_amdgcn_exp2f(-1.4426950408889634f * fabsf(z)));
        run += ls * (1.0f / 16.0f); bc[i] = run; }
    TOT[tg * 64 + d] = run;
    WG_SYNC();
    float pre = 0.f, tot = 0.f;
#pragma unroll
    for (int g = 0; g < 8; ++g) { const float v = TOT[g * 64 + d]; tot += v; if (g < tg) pre += v; }
#pragma unroll
    for (int i = 0; i < 8; ++i) E[(8 * tg + i) * EP + d] = fexp(tot - (bc[i] + pre));
    return tot;
}
__device__ __forceinline__ void gla_load_v(LAS unsigned char* lds, const bf16* __restrict__ VB, size_t row0, int h, int tid) {
    LAS bf16* VR = (LAS bf16*)(lds + VR_OFF); const int t = tid >> 3, v0 = (tid & 7) * 16; const bf16* src = VB + (row0 + t) * 512 + h * 128 + v0;
    const v4u a = *(const v4u*)src, b = *(const v4u*)(src + 8);
    *(LAS v4u*)(VR + t * VRP + v0) = a; *(LAS v4u*)(VR + t * VRP + v0 + 8) = b;
}
__device__ __forceinline__ v4u scale8(v4u raw, const f32x4 e0, const f32x4 e1) {
    v4u o; o.x = pg8::cvt_pk_bf16(bflo(raw.x) * e0[0], bfhi(raw.x) * e0[1]); o.y = pg8::cvt_pk_bf16(bflo(raw.y) * e0[2], bfhi(raw.y) * e0[3]);
    o.z = pg8::cvt_pk_bf16(bflo(raw.z) * e1[0], bfhi(raw.z) * e1[1]); o.w = pg8::cvt_pk_bf16(bflo(raw.w) * e1[2], bfhi(raw.w) * e1[3]); return o;
}
__device__ __forceinline__ void gla_a_item(LAS unsigned char* lds, int id, const bf16* __restrict__ KB, const bf16* __restrict__ VB, const bf16* __restrict__ MISC, const float* __restrict__ w2, const float* __restrict__ gb,
                                           float* __restrict__ U, float* __restrict__ BLAST, int tid, int lane, int wid) {
    const int b = id >> 7, h = (id >> 5) & 3, c = id & 31; const size_t row0 = (size_t)b * 2048 + 64 * c;
    const v4u kraw = *(const v4u*)(KB + (row0 + (tid >> 3)) * 256 + h * 64 + (tid & 7) * 8);
    gla_load_v(lds, VB, row0, h, tid);
    const float blast = gla_decay(lds, MISC, w2, gb, row0, h, tid);
    if (tid < 64) BLAST[(size_t)id * 64 + tid] = blast;
    WG_SYNC();
    LAS bf16* KR = (LAS bf16*)(lds + KR_OFF); LAS bf16* VR = (LAS bf16*)(lds + VR_OFF); const LAS float* E = (const LAS float*)(lds + E_OFF);
    { const int t = tid >> 3, d8 = (tid & 7) * 8; const f32x4 e0 = *(const LAS f32x4*)(E + t * EP + d8), e1 = *(const LAS f32x4*)(E + t * EP + d8 + 4); *(LAS v4u*)(KR + t * KTP + d8) = scale8(kraw, e0, e1); }
    WG_SYNC();
    const int fr = lane & 15, fq = lane >> 4;
    bf16x8 Bf[2];
#pragma unroll
    for (int kk = 0; kk < 2; ++kk) Bf[kk] = tr_frag(VR, VRP, 32 * kk, 16 * wid, lane);
#pragma unroll
    for (int dt = 0; dt < 4; ++dt) { f32x4 acc = (f32x4){0.f, 0.f, 0.f, 0.f};
#pragma unroll
        for (int kk = 0; kk < 2; ++kk) { const bf16x8 Af = tr_frag(KR, KTP, 32 * kk, 16 * dt, lane); acc = __builtin_amdgcn_mfma_f32_16x16x32_bf16(Af, Bf[kk], acc, 0, 0, 0); }
        *(f32x4*)(U + ((size_t)id * 128 + 16 * wid + fr) * 64 + 16 * dt + 4 * fq) = acc; }
    WG_SYNC();
}
__device__ __forceinline__ void gla_b_item(int item, const float* __restrict__ U, const float* __restrict__ BLAST, bf16* __restrict__ SB, int tid) {
    const int bh = item >> 2, qt = item & 3; const size_t eoff = (size_t)qt * 2048 + (size_t)tid * 4; const int d0 = (tid * 4) & 63;
    f32x4 S = (f32x4){0.f, 0.f, 0.f, 0.f};
#pragma unroll 1
    for (int half = 0; half < 2; ++half) {
        f32x4 u[16], bl[16];
#pragma unroll
        for (int c = 0; c < 16; ++c) { const size_t id = (size_t)bh * 32 + 16 * half + c; u[c] = *(const f32x4*)(U + id * 8192 + eoff); bl[c] = *(const f32x4*)(BLAST + id * 64 + d0); }
#pragma unroll
        for (int c = 0; c < 16; ++c) { const size_t id = (size_t)bh * 32 + 16 * half + c;
            f32x4 e; e[0] = __expf(bl[c][0]); e[1] = __expf(bl[c][1]); e[2] = __expf(bl[c][2]); e[3] = __expf(bl[c][3]);
            const f32x4 sd = S * e; v2u o; o.x = pk2(sd[0], sd[1]); o.y = pk2(sd[2], sd[3]); *(v2u*)(SB + id * 8192 + eoff) = o; S = sd + u[c]; }
    }
}
__device__ __forceinline__ void gla_c_item(LAS unsigned char* lds, int id, const bf16* __restrict__ QB, const bf16* __restrict__ KB, const bf16* __restrict__ VB, const bf16* __restrict__ RG, const bf16* __restrict__ MISC,
                                           const float* __restrict__ w2, const float* __restrict__ gb, const float* __restrict__ og, const bf16* __restrict__ SB, bf16* __restrict__ MIX, int tid, int lane, int wid) {
    const int b = id >> 7, h = (id >> 5) & 3, c = id & 31; const size_t row0 = (size_t)b * 2048 + 64 * c;
    const int st_t = tid >> 3, st_d8 = (tid & 7) * 8;
    const v4u kraw = *(const v4u*)(KB + (row0 + st_t) * 256 + h * 64 + st_d8), qraw = *(const v4u*)(QB + (row0 + st_t) * 256 + h * 64 + st_d8);
    gla_load_v(lds, VB, row0, h, tid);
    const int fr = lane & 15, fq = lane >> 4;
    bf16x8 Bs[2];
    { const bf16* sbp = SB + ((size_t)id * 128 + 16 * wid + fr) * 64 + 8 * fq; Bs[0] = *(const bf16x8*)sbp; Bs[1] = *(const bf16x8*)(sbp + 32); }
    (void)gla_decay(lds, MISC, w2, gb, row0, h, tid);
    WG_SYNC();
    LAS bf16* QA = (LAS bf16*)(lds + QA_OFF); LAS bf16* KR = (LAS bf16*)(lds + KR_OFF); LAS bf16* PM = (LAS bf16*)(lds + PM_OFF); LAS bf16* VR = (LAS bf16*)(lds + VR_OFF);
    const LAS float* E = (const LAS float*)(lds + E_OFF); LAS float* OT = (LAS float*)(lds + OT_OFF);
    { const f32x4 e0 = *(const LAS f32x4*)(E + st_t * EP + st_d8), e1 = *(const LAS f32x4*)(E + st_t * EP + st_d8 + 4);
      f32x4 r0, r1;
#pragma unroll
      for (int i = 0; i < 4; ++i) { r0[i] = 0.125f * __builtin_amdgcn_rcpf(e0[i]); r1[i] = 0.125f * __builtin_amdgcn_rcpf(e1[i]); }
      *(LAS v4u*)(KR + st_t * KTP + st_d8) = scale8(kraw, e0, e1); *(LAS v4u*)(QA + st_t * KTP + st_d8) = scale8(qraw, r0, r1); }
    WG_SYNC();
    { const int tt = wid >> 1;
#pragma unroll
      for (int s2 = 0; s2 < 2; ++s2) { const int st = 2 * (wid & 1) + s2; f32x4 acc = (f32x4){0.f, 0.f, 0.f, 0.f};
        if (st <= tt) {
#pragma unroll
            for (int kk = 0; kk < 2; ++kk) { const bf16x8 Af = *(const LAS bf16x8*)(KR + (16 * st + fr) * KTP + 32 * kk + 8 * fq); const bf16x8 Bf = *(const LAS bf16x8*)(QA + (16 * tt + fr) * KTP + 32 * kk + 8 * fq);
                acc = __builtin_amdgcn_mfma_f32_16x16x32_bf16(Af, Bf, acc, 0, 0, 0); } }
        const int t = 16 * tt + fr, s0 = 16 * st + 4 * fq; v2u o;
        o.x = pg8::cvt_pk_bf16((s0 <= t) ? acc[0] : 0.f, (s0 + 1 <= t) ? acc[1] : 0.f); o.y = pg8::cvt_pk_bf16((s0 + 2 <= t) ? acc[2] : 0.f, (s0 + 3 <= t) ? acc[3] : 0.f);
        *(LAS v2u*)(PM + t * KTP + s0) = o; } }
    WG_SYNC();
    bf16x8 Bv[2];
#pragma unroll
    for (int kk = 0; kk < 2; ++kk) Bv[kk] = tr_frag(VR, VRP, 32 * kk, 16 * wid, lane);
#pragma unroll
    for (int tt = 0; tt < 4; ++tt) { f32x4 acc = (f32x4){0.f, 0.f, 0.f, 0.f};
#pragma unroll
        for (int kk = 0; kk < 2; ++kk) { const bf16x8 Ap = *(const LAS bf16x8*)(PM + (16 * tt + fr) * KTP + 32 * kk + 8 * fq); acc = __builtin_amdgcn_mfma_f32_16x16x32_bf16(Ap, Bv[kk], acc, 0, 0, 0);
                                         const bf16x8 Aq = *(const LAS bf16x8*)(QA + (16 * tt + fr) * KTP + 32 * kk + 8 * fq); acc = __builtin_amdgcn_mfma_f32_16x16x32_bf16(Aq, Bs[kk], acc, 0, 0, 0); }
#pragma unroll
        for (int i = 0; i < 4; ++i) OT[(16 * tt + 4 * fq + i) * OTP + 16 * wid + fr] = acc[i]; }
    WG_SYNC();
    { const int t = tid >> 3, v0 = (tid & 7) * 16; f32x4 ov[4]; float ss = 0.f;
#pragma unroll
      for (int k = 0; k < 4; ++k) { ov[k] = *(const LAS f32x4*)(OT + t * OTP + v0 + 4 * k); ss += (ov[k][0] * ov[k][0] + ov[k][1] * ov[k][1]) + (ov[k][2] * ov[k][2] + ov[k][3] * ov[k][3]); }
      ss += DPP_STEP_F(ss, 0xB1); ss += DPP_STEP_F(ss, 0x4E); ss += DPP_STEP_F(ss, 0x141);
      const float rs = __builtin_amdgcn_rsqf(ss * (1.0f / 128.0f) + 1e-6f);
      const bf16* rgp = RG + (row0 + t) * 512 + h * 128 + v0; const v4u ra = *(const v4u*)rgp, rb = *(const v4u*)(rgp + 8);
      const unsigned rw[8] = {ra.x, ra.y, ra.z, ra.w, rb.x, rb.y, rb.z, rb.w}; unsigned ow[8];
#pragma unroll
      for (int k = 0; k < 4; ++k) { const f32x4 g = *(const f32x4*)(og + v0 + 4 * k); float y[4];
#pragma unroll
          for (int i = 0; i < 4; ++i) { const unsigned w = rw[2 * k + (i >> 1)]; const float r = (i & 1) ? bfhi(w) : bflo(w); const float sg = r * __builtin_amdgcn_rcpf(1.0f + __builtin_amdgcn_exp2f(-1.4426950408889634f * r)); y[i] = ov[k][i] * rs * g[i] * sg; }
          ow[2 * k] = pg8::cvt_pk_bf16(y[0], y[1]); ow[2 * k + 1] = pg8::cvt_pk_bf16(y[2], y[3]); }
      bf16* op = MIX + (row0 + t) * 1024 + 512 + h * 128 + v0;
      *(v4u*)op = (v4u){ow[0], ow[1], ow[2], ow[3]}; *(v4u*)(op + 8) = (v4u){ow[4], ow[5], ow[6], ow[7]}; }
    WG_SYNC();
}

constexpr int WRP = 1032;
constexpr int WR_LDS_BYTES = 48 * WRP * 2;
__device__ __forceinline__ void router_tile(LAS unsigned char* lds, int tile, const bf16* __restrict__ XN2, const float* __restrict__ ROWSS, const float* __restrict__ brg, const float* __restrict__ bre,
                                            unsigned* __restrict__ CNT, int* __restrict__ LISTS, float* __restrict__ LSC, int* __restrict__ TOKINFO, int tid, int lane, int wid) {
    LAS bf16* WR = (LAS bf16*)lds; LAS float* PL = (LAS float*)(lds + WR_LDS_BYTES); LAS unsigned* CL = (LAS unsigned*)(lds + WR_LDS_BYTES + 24576); LAS unsigned* BS = CL + 32;
    if (tid < 32) CL[tid] = 0u;
    const int fr = lane & 15, fq = lane >> 4, rt = wid >> 1, kh = wid & 1;
    {   const size_t row = (size_t)tile * 64 + 16 * rt + fr; const bf16* ap = XN2 + row * 1024 + 512 * kh + 8 * fq;
        bf16x8 Af[16];
#pragma unroll
        for (int kk = 0; kk < 16; ++kk) Af[kk] = *(const bf16x8*)(ap + 32 * kk);
        f32x4 acc[3];
#pragma unroll
        for (int nt = 0; nt < 3; ++nt) acc[nt] = (f32x4){0.f, 0.f, 0.f, 0.f};
#pragma unroll
        for (int kk = 0; kk < 16; ++kk)
#pragma unroll
            for (int nt = 0; nt < 3; ++nt) { const bf16x8 Bf = *(const LAS bf16x8*)(WR + (16 * nt + fr) * WRP + 512 * kh + 32 * kk + 8 * fq); acc[nt] = __builtin_amdgcn_mfma_f32_16x16x32_bf16(Af[kk], Bf, acc[nt], 0, 0, 0); }
#pragma unroll
        for (int nt = 0; nt < 3; ++nt)
#pragma unroll
            for (int i = 0; i < 4; ++i) PL[(wid * 16 + 4 * fq + i) * 48 + 16 * nt + fr] = acc[nt][i];
    }
    WG_SYNC();
    int e_[2] = {0, 0}; unsigned lp[2] = {0u, 0u}; float wk[2] = {0.f, 0.f}; float rstd2 = 0.f; const bool act = tid < 64;
    const int token = tile * 64 + tid;
    if (act) {
        const LAS float* l0 = PL + ((2 * (tid >> 4)) * 16 + (tid & 15)) * 48; const LAS float* l1 = l0 + 16 * 48; float ss = 0.f;
        const f32x4* rp = (const f32x4*)(ROWSS + (size_t)token * 16);
#pragma unroll
        for (int j = 0; j < 4; ++j) { const f32x4 v = rp[j]; ss += (v[0] + v[1]) + (v[2] + v[3]); }
        rstd2 = 1.0f / sqrtf(ss * (1.0f / 1024.0f) + 1e-6f);
        float gl[4]; int gs = 0;
#pragma unroll
        for (int j = 0; j < 4; ++j) gl[j] = (l0[j] + l1[j]) * rstd2 + brg[j];
#pragma unroll
        for (int j = 1; j < 4; ++j) if (gl[j] > gl[gs]) gs = j;
        float den = 0.f;
#pragma unroll
        for (int j = 0; j < 4; ++j) den += __expf(gl[j] - gl[gs]);
        const float gw = 1.0f / den;
        float el[8];
#pragma unroll
        for (int j = 0; j < 8; ++j) el[j] = (l0[4 + gs * 8 + j] + l1[4 + gs * 8 + j]) * rstd2 + bre[gs * 8 + j];
        int i0 = 0;
#pragma unroll
        for (int j = 1; j < 8; ++j) if (el[j] > el[i0]) i0 = j;
        int i1 = (i0 == 0) ? 1 : 0;
#pragma unroll
        for (int j = 0; j < 8; ++j) if (j != i0 && j != i1 && el[j] > el[i1]) i1 = j;
        const float ex = __expf(el[i1] - el[i0]); const float w0 = 1.0f / (1.0f + ex);
        wk[0] = w0 * gw; wk[1] = ex * w0 * gw; e_[0] = gs * 8 + i0; e_[1] = gs * 8 + i1;
        lp[0] = __hip_atomic_fetch_add(CL + e_[0], 1u, __ATOMIC_RELAXED, __HIP_MEMORY_SCOPE_WORKGROUP); lp[1] = __hip_atomic_fetch_add(CL + e_[1], 1u, __ATOMIC_RELAXED, __HIP_MEMORY_SCOPE_WORKGROUP);
    }
    WG_SYNC();
    if (tid < 32) { const unsigned n = CL[tid]; BS[tid] = n ? __hip_atomic_fetch_add(CNT + tid, n, __ATOMIC_RELAXED, __HIP_MEMORY_SCOPE_AGENT) : 0u; }
    WG_SYNC();
    if (act) {
#pragma unroll
        for (int k = 0; k < 2; ++k) { const unsigned pos = BS[e_[k]] + lp[k]; LISTS[(size_t)e_[k] * 16384 + pos] = token; *(f32x2*)(LSC + ((size_t)e_[k] * 16384 + pos) * 2) = (f32x2){rstd2, wk[k]}; }
        *(int4*)(TOKINFO + (size_t)token * 4) = make_int4(e_[0], (int)(BS[e_[0]] + lp[0]), e_[1], (int)(BS[e_[1]] + lp[1]));
    }
    WG_SYNC();
}

template <bool GATHER> struct GroupOrder {
    const LAS int* TOFF; const LAS int* CNTL; const int* LISTS; int NPN, G, c; unsigned bstride;
    __device__ bool next(int i, pg8::Unit& u) const {
        const int L = i * G + c; const int ntile = TOFF[32]; if (L >= ntile * NPN) return false;
        const int T = L / NPN; int e = 0;
#pragma unroll
        for (int s = 16; s >= 1; s >>= 1) if (TOFF[e + s] <= T) e += s;
        u.pm = T; u.pn = L - T * NPN; u.e = e; u.p0 = (T - TOFF[e]) * 256; const int rem = CNTL[e] - u.p0; u.nv = rem < 256 ? rem : 256; u.bo = (unsigned)e * bstride; return true;
    }
    __device__ __forceinline__ unsigned arow(const pg8::Unit& u, int r) const {
        if (GATHER) return (unsigned)LISTS[(size_t)u.e * 16384 + u.p0 + (r < u.nv ? r : 0)];
        return (unsigned)(u.pm * 256 + r);
    }
};
struct Args { const float* in[18]; float* out; unsigned char* ws; int ph_lo, ph_hi, li, pad; };
__global__ void __launch_bounds__(NWAVES * 64, 2) hymba_fwd(Args args) {
    extern __shared__ __attribute__((aligned(16))) unsigned char lds[];
    LAS unsigned char* const L = (LAS unsigned char*)lds;
    volatile LAS unsigned* const MISCW = (volatile LAS unsigned*)(L + MISC_OFF);
    LAS int* const TOFF = (LAS int*)(L + TOFF_OFF); LAS int* const CNTL = TOFF + 40;
    const int tid = threadIdx.x, lane = tid & 63, wave = __builtin_amdgcn_readfirstlane(tid >> 6);
    const int G = gridDim.x; const int bx = blockIdx.x; const int vcu = (G % 8 == 0) ? (bx % 8) * (G / 8) + bx / 8 : bx;
    unsigned char* const ws = args.ws;
    gu32* const ctl = (gu32*)(ws + WS_CTL);
    const float* x = args.in[0]; const float* norm1_g = args.in[1]; const float* w_in = args.in[2]; const float* q_norm_g = args.in[3]; const float* k_norm_g = args.in[4];
    const float* rel_bias = args.in[5]; const float* gate_w2 = args.in[6]; const float* gate_b = args.in[7]; const float* out_norm_g = args.in[8]; const float* w_out = args.in[9];
    const float* norm2_g = args.in[10]; const float* w_rg = args.in[11]; const float* b_rg = args.in[12]; const float* w_re = args.in[13]; const float* b_re = args.in[14];
    const float* w_eg = args.in[15]; const float* w_eu = args.in[16]; const float* w_ed = args.in[17];
    float* out = args.out;
    float* RSTD1 = (float*)(ws + WS_RSTD1); float* ROWSS = (float*)(ws + WS_ROWSS); bf16* WR_T = (bf16*)(ws + WS_WR); float* BLAST = (float*)(ws + WS_BLAST);
    int* TOKINFO = (int*)(ws + WS_TOKINFO); int* LISTS = (int*)(ws + WS_LISTS); float* LSC = (float*)(ws + WS_LSC);
    bf16* WO_T = (bf16*)(ws + WS_WO); bf16* WGU_T = (bf16*)(ws + WS_WGU); bf16* WD_T = (bf16*)(ws + WS_WD); bf16* XB = (bf16*)(ws + WS_XB); bf16* WIN_T = (bf16*)(ws + WS_WIN);
    unsigned* MASK = (unsigned*)(ws + WS_MASK); bf16* SB = (bf16*)(ws + WS_SB);
    bf16* QN = (bf16*)(ws + WS_QN); bf16* KN = (bf16*)(ws + WS_KN); bf16* VN = (bf16*)(ws + WS_VN); bf16* XN2 = (bf16*)(ws + WS_XN2);
    bf16* IQ = (bf16*)(ws + WS_IQ); bf16* MISC = (bf16*)(ws + WS_MISC); bf16* QB = (bf16*)(ws + WS_QB); bf16* KB = (bf16*)(ws + WS_KB); bf16* VB = (bf16*)(ws + WS_VB); bf16* RG = (bf16*)(ws + WS_RG);
    bf16* MIX = (bf16*)(ws + WS_MIX); float* U = (float*)(ws + WS_MIX); bf16* HID = (bf16*)(ws + WS_HID); bf16* Y = (bf16*)(ws + WS_Y);
    unsigned* CNT = (unsigned*)(ctl + CW_CNT);

    for (int u = tid; u < (LDS_BYTES - LDSCTL_OFF) / 4; u += NWAVES * 64) ((LAS unsigned*)(L + LDSCTL_OFF))[u] = 0u;
    __syncthreads();
    const int bli = (N_LAUNCHES == PER_PHASE) ? 0 : args.li;
    XcdBarrier bar; bar.bar = (unsigned*)(ctl + CW_BAR) + bli * XCD_BAR_WORDS; bar.x = 0; bar.st = nullptr;
    if (N_LAUNCHES != PER_PHASE) bar = xcd_barrier_post((unsigned*)(ctl + CW_BAR) + bli * XCD_BAR_WORDS, MISCW + 8);
#define GRID_BAR(seam) do { if (N_LAUNCHES == PER_PHASE) { if (tid == 0) __hip_atomic_store(ctl + CW_TMO, 0xBADBA0u | (unsigned)(seam), RLX_AGENT); } else { xcd_barrier(bar); } } while (0)
    const int lo = args.ph_lo, hi = args.ph_hi;
#define IN(k) (lo <= (k) && (k) < hi)
#define BOTH(k) (IN(k) && IN((k) + 1))
    const int gw = vcu * NWAVES + wave, NGW = G * NWAVES;

    if (IN(0)) {
        LAS float* scr = (LAS float*)(L + wave * 16384);
        constexpr int I_IN = 16 * 106, I_O = 16 * 32, I_G = 16 * 8, I_D = 4 * 32;
        constexpr int NITEMS = I_IN + I_O + 32 * (2 * I_G + I_D);
        for (int it = gw; it < NITEMS; it += NGW) {
            int r = it;
            if (r < I_IN) { p0_transpose_item<0>(w_in, 1024, 3384, norm1_g, WIN_T, scr, r, lane); continue; } r -= I_IN;
            if (r < I_O) { p0_transpose_item<1>(w_out, 1024, 1024, nullptr, WO_T, scr, r, lane); continue; } r -= I_O;
            const int e = r / (2 * I_G + I_D); r -= e * (2 * I_G + I_D);
            if (r < I_G) { p0_transpose_item<2>(w_eg + (size_t)e * 1024 * 256, 1024, 256, norm2_g, WGU_T + (size_t)e * 512 * 1024, scr, r, lane); continue; } r -= I_G;
            if (r < I_G) { p0_transpose_item<3>(w_eu + (size_t)e * 1024 * 256, 1024, 256, norm2_g, WGU_T + (size_t)e * 512 * 1024, scr, r, lane); continue; } r -= I_G;
            p0_transpose_item<1>(w_ed + (size_t)e * 256 * 1024, 256, 1024, nullptr, WD_T + (size_t)e * 1024 * 256, scr, r, lane);
        }
        for (int i = bx * (NWAVES * 64) + tid; i < 48 * 1024; i += G * NWAVES * 64) { const int n = i >> 10, k = i & 1023;
            const float v = (n < 4) ? w_rg[k * 4 + n] : (n < 36) ? w_re[k * 32 + (n - 4)] : 0.f; WR_T[i] = (bf16)f2bf(v * norm2_g[k]); }
        for (int m0 = 2 * gw; m0 < M; m0 += 2 * NGW) {
            f32x4 v[2][4]; float s[2];
#pragma unroll
            for (int r = 0; r < 2; ++r) { const GAS f32x4* xr = (const GAS f32x4*)(x + (size_t)(m0 + r) * 1024) + lane;
#pragma unroll
                for (int j = 0; j < 4; ++j) v[r][j] = xr[64 * j]; }
#pragma unroll
            for (int r = 0; r < 2; ++r) { s[r] = 0.f;
#pragma unroll
                for (int j = 0; j < 4; ++j) s[r] += (v[r][j].x * v[r][j].x + v[r][j].y * v[r][j].y) + (v[r][j].z * v[r][j].z + v[r][j].w * v[r][j].w);
                s[r] = wave_fsum(s[r]); if (lane == 0) RSTD1[m0 + r] = 1.0f / sqrtf(s[r] * (1.0f / 1024.0f) + 1e-6f);
                GAS unsigned long long* o8 = (GAS unsigned long long*)(XB + (size_t)(m0 + r) * 1024) + lane;
#pragma unroll
                for (int j = 0; j < 4; ++j) o8[64 * j] = (unsigned long long)pk2(v[r][j].x, v[r][j].y) | ((unsigned long long)pk2(v[r][j].z, v[r][j].w) << 32); }
        }
        if (BOTH(0)) GRID_BAR(0);
    }
    if (IN(1)) {
        pg8::Gemm g{XB, WIN_T, 1024}; pg8::StaticOrder S; S.init(M, 3584, G, bx);
        pg8::EpiProj E{RSTD1, q_norm_g, k_norm_g, QN, KN, VN, IQ, QB, KB, VB, RG, MISC, 0.125f * 1.4426950408889634f, 1e-6f};
        pg8::gemm_phase<pg8::EpiProj, pg8::StaticOrder, true>(L, g, S, E);
        if (BOTH(1)) GRID_BAR(1);
    }
    if (IN(2)) {
        for (int rep = 0; rep < REP_IDX; ++rep)
        for (int it = bx; it < 1024; it += G) { const int b = it & 7, key = (it >> 3) ^ ((it >> 8) & 1); const int p = (key & 1) ? 127 - (key >> 1) : (key >> 1);
            idx_item(L, b, p, IQ, MISC, MASK, lane, wave); }
        for (int rep = 0; rep < REP_GLAA; ++rep)
        for (int it = bx; it < 1024; it += G) gla_a_item(L, it, KB, VB, MISC, gate_w2, gate_b, U, BLAST, tid, lane, wave);
        if (BOTH(2)) GRID_BAR(2);
    }
    if (IN(3)) {
        for (int it = bx; it < 128; it += G) gla_b_item(it, U, BLAST, SB, tid);
        if (BOTH(3)) GRID_BAR(3);
    }
    if (IN(4)) {
        const attn_body::AttnTensors AT{(const attn_body::bf16*)QN, (const attn_body::bf16*)KN, (const attn_body::bf16*)VN, (attn_body::bf16*)MIX, MASK, rel_bias};
        for (int rep = 0; rep < REP_ATT; ++rep)
        for (int pr = vcu; pr < 256; pr += G) { const int bh = pr >> 2, s = pr & 3;
            for (int k2 = 0; k2 < 2; ++k2) attn_body::attn_unit<8>(bh >> 3, bh & 7, k2 ? s : 7 - s, AT.Q, AT.K, AT.V, AT.O, AT.MASK, AT.relb, (char*)lds); }
        for (int rep = 0; rep < REP_GLAC; ++rep)
        for (int it = bx; it < 1024; it += G) gla_c_item(L, it, QB, KB, VB, RG, MISC, gate_w2, gate_b, out_norm_g, SB, MIX, tid, lane, wave);
        if (BOTH(4)) GRID_BAR(4);
    }
    if (IN(5)) {
        pg8::Gemm g{MIX, WO_T, 1024}; pg8::StaticOrder S; S.init(M, 1024, G, bx);
        pg8::EpiOut E{x, XN2, ROWSS};
        pg8::gemm_phase<pg8::EpiOut, pg8::StaticOrder, false>(L, g, S, E);
        if (BOTH(5)) GRID_BAR(5);
    }
    if (IN(6)) {
        { LAS bf16* WR = (LAS bf16*)L;
          for (int i = tid; i < 48 * 128; i += NWAVES * 64) { const int n = i >> 7, c8 = i & 127; *(LAS v4u*)(WR + n * WRP + c8 * 8) = *(const v4u*)(WR_T + n * 1024 + c8 * 8); } }
        WG_SYNC();
        for (int tile = bx; tile < 256; tile += G) router_tile(L, tile, XN2, ROWSS, b_rg, b_re, CNT, LISTS, LSC, TOKINFO, tid, lane, wave);
        if (BOTH(6)) GRID_BAR(6);
    }
#define LOAD_TOFF() do { if (tid == 0) { int acc_ = 0; for (int e_ = 0; e_ < 32; ++e_) { const int c_ = (int)__hip_atomic_load(CNT + e_, RLX_AGENT); CNTL[e_] = c_; TOFF[e_] = acc_; acc_ += (c_ + 255) >> 8; } TOFF[32] = acc_; } WG_SYNC(); } while (0)
    if (IN(7)) {
        LOAD_TOFF();
        pg8::Gemm g{XN2, WGU_T, 1024}; GroupOrder<true> S{TOFF, CNTL, LISTS, 2, G, bx, 512u * 1024u * 2u};
        pg8::EpiGU E{LSC, HID};
        pg8::gemm_phase<pg8::EpiGU, GroupOrder<true>, false>(L, g, S, E);
        if (BOTH(7)) GRID_BAR(7);
    }
    if (IN(8)) {
        LOAD_TOFF();
        pg8::Gemm g{HID, WD_T, 256}; GroupOrder<false> S{TOFF, CNTL, LISTS, 4, G, bx, 1024u * 256u * 2u};
        pg8::EpiDown E{Y};
        pg8::gemm_phase<pg8::EpiDown, GroupOrder<false>, false>(L, g, S, E);
        if (BOTH(8)) GRID_BAR(8);
    }
    if (IN(9)) {
        LOAD_TOFF();
        for (int m0 = 4 * gw; m0 < M; m0 += 4 * NGW) {
            int4 ti[4];
#pragma unroll
            for (int r = 0; r < 4; ++r) ti[r] = *(const int4*)(TOKINFO + (size_t)(m0 + r) * 4);
            v4u av[4][2], b0[4][2], b1[4][2];
#pragma unroll
            for (int r = 0; r < 4; ++r) { const size_t s0 = (size_t)TOFF[ti[r].x] * 256 + ti[r].y, s1 = (size_t)TOFF[ti[r].z] * 256 + ti[r].w;
                const GAS v4u* a = (const GAS v4u*)(XN2 + (size_t)(m0 + r) * 1024) + lane; const GAS v4u* y0 = (const GAS v4u*)(Y + s0 * 1024) + lane; const GAS v4u* y1 = (const GAS v4u*)(Y + s1 * 1024) + lane;
#pragma unroll
                for (int j = 0; j < 2; ++j) { av[r][j] = a[64 * j]; b0[r][j] = y0[64 * j]; b1[r][j] = y1[64 * j]; } }
#pragma unroll
            for (int r = 0; r < 4; ++r) { GAS f32x4* o = (GAS f32x4*)(out + (size_t)(m0 + r) * 1024) + 2 * lane;
#pragma unroll
                for (int j = 0; j < 2; ++j) { const v4u a_ = av[r][j], c0 = b0[r][j], c1 = b1[r][j]; f32x4 r0, r1;
                    r0[0] = bflo(a_.x) + bflo(c0.x) + bflo(c1.x); r0[1] = bfhi(a_.x) + bfhi(c0.x) + bfhi(c1.x); r0[2] = bflo(a_.y) + bflo(c0.y) + bflo(c1.y); r0[3] = bfhi(a_.y) + bfhi(c0.y) + bfhi(c1.y);
                    r1[0] = bflo(a_.z) + bflo(c0.z) + bflo(c1.z); r1[1] = bfhi(a_.z) + bfhi(c0.z) + bfhi(c1.z); r1[2] = bflo(a_.w) + bflo(c0.w) + bflo(c1.w); r1[3] = bfhi(a_.w) + bfhi(c0.w) + bfhi(c1.w);
                    o[128 * j] = r0; o[128 * j + 1] = r1; } }
        }
    }
#undef IN
#undef BOTH
}

extern "C" void kernel_launch(void* const* d_in, const int* in_sizes, int n_in, void* d_out, int out_size, void* d_ws, size_t ws_size, hipStream_t stream) {
    static int grid = 0;
    if (grid == 0) {
        if (n_in != 18 || out_size != M * 1024 || ws_size < WS_END) { fprintf(stderr, "kernel_launch: unexpected problem shape (n_in %d out %d ws %zu)\n", n_in, out_size, ws_size); grid = -1; return; }
        int dev = 0, cus = 0, per_cu = 0;
        if (hipGetDevice(&dev) != hipSuccess || hipDeviceGetAttribute(&cus, hipDeviceAttributeMultiprocessorCount, dev) != hipSuccess) { grid = -1; return; }
        if (hipFuncSetAttribute((const void*)hymba_fwd, hipFuncAttributeMaxDynamicSharedMemorySize, LDS_BYTES) != hipSuccess) { fprintf(stderr, "kernel_launch: hipFuncSetAttribute failed\n"); grid = -1; return; }
        if (hipOccupancyMaxActiveBlocksPerMultiprocessor(&per_cu, (const void*)hymba_fwd, NWAVES * 64, LDS_BYTES) != hipSuccess || per_cu < 1) { fprintf(stderr, "kernel_launch: occupancy query reports %d\n", per_cu); }
        (void)hipGetLastError();
        grid = cus;
    }
    if (grid < 0) return;
    (void)hipMemsetAsync((char*)d_ws + WS_CTL, 0, CTL_ZERO_BYTES, stream);
    Args a{};
    for (int i = 0; i < 18; ++i) a.in[i] = (const float*)d_in[i];
    a.out = (float*)d_out; a.ws = (unsigned char*)d_ws;
#if defined(PROBE_PHASE)
    { const int k = PROBE_PHASE; a.ph_lo = 0; a.ph_hi = k + 1; a.li = 0; hipLaunchKernelGGL(hymba_fwd, dim3(grid), dim3(NWAVES * 64), LDS_BYTES, stream, a);
      for (int r = 1; r < PROBE_REPS; ++r) { a.ph_lo = k; a.ph_hi = k + 1; a.li = 1; hipLaunchKernelGGL(hymba_fwd, dim3(grid), dim3(NWAVES * 64), LDS_BYTES, stream, a); }
      if (k + 1 < PER_PHASE) { a.ph_lo = k + 1; a.ph_hi = PER_PHASE; a.li = 2; hipLaunchKernelGGL(hymba_fwd, dim3(grid), dim3(NWAVES * 64), LDS_BYTES, stream, a); } }
#else
    if (N_LAUNCHES == 1) { a.ph_lo = 0; a.ph_hi = PER_PHASE; a.li = 0; hipLaunchKernelGGL(hymba_fwd, dim3(grid), dim3(NWAVES * 64), LDS_BYTES, stream, a); }
    else for (int li = 0; li < PER_PHASE; ++li) { a.ph_lo = li; a.ph_hi = li + 1; a.li = li; hipLaunchKernelGGL(hymba_fwd, dim3(grid), dim3(NWAVES * 64), LDS_BYTES, stream, a); }
#endif
}
```

```cpp
#include <hip/hip_runtime.h>
#include <hip/hip_bf16.h>
#include <cstdio>
#include <cstdint>
#include <cmath>
namespace pg8 {
#define PG8_LAS __attribute__((address_space(3)))
typedef unsigned short bf16_t;
typedef short bf16x8 __attribute__((ext_vector_type(8)));
typedef float f32x4 __attribute__((ext_vector_type(4)));
typedef float f32x2 __attribute__((ext_vector_type(2)));
typedef unsigned u32x4 __attribute__((ext_vector_type(4)));
constexpr int BM = 256, BK = 64, HALF = 128, HTB = HALF * BK * 2  , STAGE_BYTES = 8 * HTB, NXCD = 8, WGM = 8;

__host__ __device__ __forceinline__ int lds_byte(int r, int c) { const int st = (r >> 4) * 2 + (c >> 5), rr = r & 15, cc = c & 31, ob = rr * 64 + cc * 2; return st * 1024 + (ob ^ (((ob >> 9) & 1) << 5)); }
__host__ __device__ __forceinline__ void stage_rc(int b, int& R, int& C) { const int st = b / 1024, sb = b % 1024, swz = sb ^ (((sb >> 9) & 1) << 5); R = (st >> 1) * 16 + swz / 64; C = (st & 1) * 32 + (swz % 64) / 2; }
__host__ __device__ __forceinline__ int perm32(int rho) { const int n = rho >> 4, i = rho & 15; return 8 * (i >> 2) + 4 * n + (i & 3); }

struct Unit { int pm, pn; unsigned bo; int e, nv, p0; };
struct Gemm { const bf16_t* A; const bf16_t* Bt; int K; };

struct StaticOrder {
    int nM, nN, nwg, G, c;
    __device__ void init(int M, int N, int G_, int c_) { nM = M / BM; nN = N / BM; nwg = nM * nN; G = G_; c = c_; }
    __device__ bool next(int i, Unit& u) const {
        const long L = (long)i * G + c; if (L >= nwg) return false;
        int wgid = (int)L; { const int q = nwg / NXCD, r = nwg % NXCD, xcd = wgid % NXCD, off = wgid / NXCD; wgid = (xcd < r ? xcd * (q + 1) : r * (q + 1) + (xcd - r) * q) + off; }
        const int nig = WGM * nN, gid = wgid / nig, fm = gid * WGM, gsz = (nM - fm) < WGM ? (nM - fm) : WGM;
        u.pm = fm + ((wgid % nig) % gsz); u.pn = (wgid % nig) / gsz; u.bo = 0u; u.e = 0; u.nv = BM; u.p0 = 0; return true;
    }
    __device__ __forceinline__ unsigned arow(const Unit& u, int r) const { return (unsigned)(u.pm * BM + r); }
};

__device__ __forceinline__ unsigned cvt_pk_bf16(float lo, float hi) { unsigned r; asm volatile("v_cvt_pk_bf16_f32 %0, %1, %2" : "=v"(r) : "v"(lo), "v"(hi)); return r; }

template <class Epi, class Sched, bool ALIGN_EPI = false>
__device__ __forceinline__ void gemm_phase(PG8_LAS unsigned char* lds, const Gemm g, const Sched& S, const Epi& E) {
    const int tid = threadIdx.x, wid = __builtin_amdgcn_readfirstlane(tid >> 6), lane = tid & 63, wr = wid >> 2, wc = wid & 3, fr = lane & 15, fq = lane >> 4;
    const int K = g.K, nt = K / BK;
    int RA[2], CA[2]; unsigned voffB[2];
#pragma unroll
    for (int i = 0; i < 2; ++i) { int R, C; stage_rc(tid * 16 + i * 8192, R, C); const int Rb = ((R & ~31) + perm32(R & 31));
        RA[i] = R; CA[i] = C; voffB[i] = (unsigned)(Rb * K + C) * 2u; }
    const size_t kstep = (size_t)(BK * 2);
    const size_t hstep = (size_t)HALF * K * 2;
    const size_t tstep = 2 * hstep;
    const unsigned ldsw = (unsigned)wid * 1024u;
    const int aoff = lds_byte(wr * 64 + fr, fq * 8), boff = lds_byte(wc * 32 + fr, fq * 8);
#define PG8_SA(b, h) (((b) * 2 + (h)) * HTB)
#define PG8_SB(b, h) ((4 + (b) * 2 + (h)) * HTB)
#define PG8_STAGE(bufoff, gbase, voff) do { _Pragma("unroll") for (int _i = 0; _i < 2; ++_i) \
        __builtin_amdgcn_global_load_lds((const unsigned*)((const char*)(gbase) + (voff)[_i]), (PG8_LAS unsigned*)(lds + (bufoff) + ldsw + _i * 8192), 16, 0, 0); } while (0)
#define PG8_LDA(dst, b, h) do { _Pragma("unroll") for (int m = 0; m < 4; ++m) _Pragma("unroll") for (int k = 0; k < 2; ++k) dst[m][k] = *(const PG8_LAS bf16x8*)(lds + PG8_SA(b, h) + aoff + m * 2048 + k * 1024); } while (0)
#define PG8_LDB(dst, b, h) do { _Pragma("unroll") for (int n = 0; n < 2; ++n) _Pragma("unroll") for (int k = 0; k < 2; ++k) dst[n][k] = *(const PG8_LAS bf16x8*)(lds + PG8_SB(b, h) + boff + n * 2048 + k * 1024); } while (0)
#define PG8_MMA(ai, bj, At, Bt) do { __builtin_amdgcn_s_setprio(1); _Pragma("unroll") for (int m = 0; m < 4; ++m) _Pragma("unroll") for (int n = 0; n < 2; ++n) _Pragma("unroll") for (int k = 0; k < 2; ++k) \
        acc[ai][bj][m][n] = __builtin_amdgcn_mfma_f32_16x16x32_bf16(Bt[n][k], At[m][k], acc[ai][bj][m][n], 0, 0, 0); __builtin_amdgcn_s_setprio(0); } while (0)
#define PG8_WAIT_V(n) asm volatile("s_waitcnt vmcnt(" #n ")" ::: "memory")
#define PG8_WAIT_L(n) asm volatile("s_waitcnt lgkmcnt(" #n ")" ::: "memory")
#define PG8_BAR __builtin_amdgcn_s_barrier()
#define PG8_SCHED __builtin_amdgcn_sched_barrier(0)
#define PG8_AOFF(AO, U) do { _Pragma("unroll") for (int _h = 0; _h < 2; ++_h) _Pragma("unroll") for (int _i = 0; _i < 2; ++_i) \
        AO[_h][_i] = (S.arow(U, _h * HALF + RA[_i]) * (unsigned)K + (unsigned)CA[_i]) * 2u; } while (0)
    Unit cur, nxt; int ui = 0;
    if (!S.next(0, cur)) return;
    f32x4 acc[2][2][4][2];
#pragma unroll
    for (int a = 0; a < 2; ++a)
#pragma unroll
        for (int b = 0; b < 2; ++b)
#pragma unroll
            for (int m = 0; m < 4; ++m)
#pragma unroll
                for (int n = 0; n < 2; ++n) acc[a][b][m][n] = (f32x4){0.f, 0.f, 0.f, 0.f};
    bf16x8 At[4][2], B0[2][2], B1[2][2];
    unsigned aoC[2][2], aoN[2][2];
    PG8_AOFF(aoC, cur);
    const char* const gA = (const char*)g.A;
    const char* cB = (const char*)g.Bt + (size_t)cur.bo + (size_t)cur.pn * tstep;
    {
        PG8_STAGE(PG8_SB(0, 0), cB, voffB); PG8_STAGE(PG8_SB(0, 1), cB + hstep, voffB); PG8_STAGE(PG8_SA(0, 0), gA, aoC[0]); PG8_STAGE(PG8_SA(0, 1), gA, aoC[1]);
        if (wr == 1) PG8_BAR;
        PG8_WAIT_V(2); PG8_BAR;
        PG8_STAGE(PG8_SB(1, 0), cB + kstep, voffB); PG8_STAGE(PG8_SA(1, 0), gA + kstep, aoC[0]); PG8_STAGE(PG8_SB(1, 1), cB + hstep + kstep, voffB);
        PG8_WAIT_V(6); PG8_BAR;
    }
    for (;;) {
        const bool has_next = S.next(ui + 1, nxt);
        if (has_next) { PG8_AOFF(aoN, nxt); } else {
#pragma unroll
            for (int _h = 0; _h < 2; ++_h)
#pragma unroll
                for (int _i = 0; _i < 2; ++_i) aoN[_h][_i] = aoC[_h][_i]; }
        const char* nB = has_next ? (const char*)g.Bt + (size_t)nxt.bo + (size_t)nxt.pn * tstep : cB;
        for (int t = 0; t < nt; t += 2) {
            const bool last = (t == nt - 2);
            const char* a1 = gA + (size_t)(t + 1) * kstep;
            const char* a2 = last ? gA : gA + (size_t)(t + 2) * kstep; const char* b2 = last ? nB : cB + (size_t)(t + 2) * kstep;
            const char* a3 = a2 + kstep; const char* b3 = b2 + kstep;
            unsigned ao2[2][2];
#pragma unroll
            for (int _h = 0; _h < 2; ++_h)
#pragma unroll
                for (int _i = 0; _i < 2; ++_i) ao2[_h][_i] = last ? aoN[_h][_i] : aoC[_h][_i];
            PG8_LDB(B0, 0, 0); PG8_LDB(B1, 0, 1); PG8_SCHED; PG8_LDA(At, 0, 0); PG8_STAGE(PG8_SA(1, 1), a1, aoC[1]);
            PG8_WAIT_V(8); PG8_WAIT_L(0); PG8_BAR; PG8_MMA(0, 0, At, B0); PG8_MMA(0, 1, At, B1); PG8_BAR; PG8_SCHED;
            PG8_LDA(At, 0, 1); PG8_STAGE(PG8_SB(0, 0), b2, voffB); PG8_STAGE(PG8_SB(0, 1), b2 + hstep, voffB); PG8_STAGE(PG8_SA(0, 0), a2, ao2[0]);
            PG8_WAIT_V(8); PG8_WAIT_L(0); PG8_BAR; PG8_MMA(1, 0, At, B0); PG8_MMA(1, 1, At, B1); PG8_BAR; PG8_SCHED;
            PG8_LDB(B0, 1, 0); PG8_LDB(B1, 1, 1); PG8_SCHED; PG8_LDA(At, 1, 0); PG8_STAGE(PG8_SA(0, 1), a2, ao2[1]);
            PG8_WAIT_V(8); PG8_WAIT_L(0); PG8_BAR; PG8_MMA(0, 0, At, B0); PG8_MMA(0, 1, At, B1); PG8_BAR; PG8_SCHED;
            PG8_LDA(At, 1, 1); PG8_STAGE(PG8_SB(1, 0), b3, voffB); PG8_STAGE(PG8_SB(1, 1), b3 + hstep, voffB); PG8_STAGE(PG8_SA(1, 0), a3, ao2[0]);
            PG8_WAIT_V(8); PG8_WAIT_L(0); PG8_BAR; PG8_MMA(1, 0, At, B0); PG8_MMA(1, 1, At, B1); PG8_BAR; PG8_SCHED;
        }
        if constexpr (ALIGN_EPI) { if (wr == 0) PG8_BAR; }
        E(acc, cur, wr, wc, fr, fq);
        if (!has_next) break;
#pragma unroll
        for (int a = 0; a < 2; ++a)
#pragma unroll
            for (int b = 0; b < 2; ++b)
#pragma unroll
                for (int m = 0; m < 4; ++m)
#pragma unroll
                    for (int n = 0; n < 2; ++n) acc[a][b][m][n] = (f32x4){0.f, 0.f, 0.f, 0.f};
        cur = nxt; cB = nB; ++ui;
#pragma unroll
        for (int _h = 0; _h < 2; ++_h)
#pragma unroll
            for (int _i = 0; _i < 2; ++_i) aoC[_h][_i] = aoN[_h][_i];
        if constexpr (ALIGN_EPI) { if (wr == 1) PG8_BAR; }
    }
    PG8_WAIT_V(0);
    if constexpr (!ALIGN_EPI) { if (wr == 0) PG8_BAR; }
    PG8_BAR;
#undef PG8_SA
#undef PG8_SB
#undef PG8_STAGE
#undef PG8_LDA
#undef PG8_LDB
#undef PG8_MMA
#undef PG8_WAIT_V
#undef PG8_WAIT_L
#undef PG8_BAR
#undef PG8_SCHED
#undef PG8_AOFF
}
}
namespace pg8 {
__device__ __forceinline__ u32x4 pack8(const f32x4 v0, const f32x4 v1) { u32x4 w; w.x = cvt_pk_bf16(v0[0], v0[1]); w.y = cvt_pk_bf16(v0[2], v0[3]); w.z = cvt_pk_bf16(v1[0], v1[1]); w.w = cvt_pk_bf16(v1[2], v1[3]); return w; }

struct EpiProj {
    const float* rstd1; const float* qg; const float* kg;
    bf16_t *QN, *KN, *VN, *IQ, *QB, *KB, *VB, *RG, *MISC;
    float qscale, eps;
    __device__ __forceinline__ void operator()(const f32x4 (&acc)[2][2][4][2], const Unit& u, int wr, int wc, int fr, int fq) const {
        const int row0 = u.pm * BM + wr * 64 + fr; const int pn = u.pn;
        if (pn < 4) {
            const bool isq = pn < 2; const float* gp = isq ? qg : kg; bf16_t* O = isq ? QN : KN; const float os = isq ? qscale : 1.f;
            f32x4 gv[2][2];
#pragma unroll
            for (int bj = 0; bj < 2; ++bj)
#pragma unroll
                for (int n = 0; n < 2; ++n) gv[bj][n] = *(const f32x4*)(gp + 32 * bj + 8 * fq + 4 * n) * os;
            const int hcol = (4 * (pn & 1) + wc) * 64 + 8 * fq;
#pragma unroll
            for (int ai = 0; ai < 2; ++ai)
#pragma unroll
                for (int m = 0; m < 4; ++m) { const int row = row0 + ai * HALF + m * 16; const float s = rstd1[row];
                    float ss = 0.f;
#pragma unroll
                    for (int bj = 0; bj < 2; ++bj)
#pragma unroll
                        for (int n = 0; n < 2; ++n) { const f32x4 x = acc[ai][bj][m][n]; ss += (x[0] * x[0] + x[1] * x[1]) + (x[2] * x[2] + x[3] * x[3]); }
                    ss += __shfl_xor(ss, 16); ss += __shfl_xor(ss, 32);
                    const float r = s * __builtin_amdgcn_rsqf(s * s * ss * (1.f / 64.f) + eps);
                    bf16_t* rowp = O + (size_t)row * 512 + hcol;
#pragma unroll
                    for (int bj = 0; bj < 2; ++bj) *(u32x4*)(rowp + 32 * bj) = pack8(acc[ai][bj][m][0] * r * gv[bj][0], acc[ai][bj][m][1] * r * gv[bj][1]); }
            return;
        }
        bf16_t* O; int pitch, coff, lim = 256;
        if (pn < 6) { O = VN; pitch = 512; coff = (pn - 4) * 256; }
        else if (pn == 6) { O = IQ; pitch = 256; coff = 0; }
        else if (pn == 7) { O = QB; pitch = 256; coff = 0; }
        else if (pn == 8) { O = KB; pitch = 256; coff = 0; }
        else if (pn < 11) { O = VB; pitch = 512; coff = (pn - 9) * 256; }
        else if (pn < 13) { O = RG; pitch = 512; coff = (pn - 11) * 256; }
        else { O = MISC; pitch = 64; coff = 0; lim = 56; }
        const int c0 = wc * 32 + 8 * fq;
#pragma unroll
        for (int ai = 0; ai < 2; ++ai)
#pragma unroll
            for (int m = 0; m < 4; ++m) { const int row = row0 + ai * HALF + m * 16; const float s = rstd1[row];
                bf16_t* rowp = O + (size_t)row * pitch + coff + c0;
#pragma unroll
                for (int bj = 0; bj < 2; ++bj) if (c0 + bj * HALF < lim) *(u32x4*)(rowp + bj * HALF) = pack8(acc[ai][bj][m][0] * s, acc[ai][bj][m][1] * s); }
    }
};

struct EpiOut {
    const float* x; bf16_t* XN2; float* ROWSS;
    __device__ __forceinline__ void operator()(const f32x4 (&acc)[2][2][4][2], const Unit& u, int wr, int wc, int fr, int fq) const {
        const int row0 = u.pm * BM + wr * 64 + fr; const int col0 = u.pn * BM + wc * 32 + 8 * fq;
#pragma unroll
        for (int ai = 0; ai < 2; ++ai)
#pragma unroll
            for (int m = 0; m < 4; ++m) { const int row = row0 + ai * HALF + m * 16; const size_t off = (size_t)row * 1024 + col0; float ss = 0.f;
#pragma unroll
                for (int bj = 0; bj < 2; ++bj) { const f32x4 a = *(const f32x4*)(x + off + bj * HALF) + acc[ai][bj][m][0], b = *(const f32x4*)(x + off + bj * HALF + 4) + acc[ai][bj][m][1];
                    ss += (a[0] * a[0] + a[1] * a[1]) + (a[2] * a[2] + a[3] * a[3]) + (b[0] * b[0] + b[1] * b[1]) + (b[2] * b[2] + b[3] * b[3]);
                    *(u32x4*)(XN2 + off + bj * HALF) = pack8(a, b); }
                ss += __shfl_xor(ss, 16); ss += __shfl_xor(ss, 32);
                if (fq == 0) ROWSS[(size_t)row * 16 + u.pn * 4 + wc] = ss; }
    }
};

struct EpiGU {
    const float* LSC; bf16_t* HID;
    __device__ __forceinline__ void operator()(const f32x4 (&acc)[2][2][4][2], const Unit& u, int wr, int wc, int fr, int fq) const {
        const int r0 = wr * 64 + fr; const int c0 = u.pn * HALF + wc * 32 + 8 * fq;
#pragma unroll
        for (int ai = 0; ai < 2; ++ai)
#pragma unroll
            for (int m = 0; m < 4; ++m) { const int r = r0 + ai * HALF + m * 16;
                f32x2 sw = (f32x2){0.f, 0.f};
                if (r < u.nv) sw = *(const f32x2*)(LSC + ((size_t)u.e * 16384 + (size_t)(u.p0 + r)) * 2);
                f32x4 h0, h1;
#pragma unroll
                for (int j = 0; j < 4; ++j) { const float a = acc[ai][0][m][0][j] * sw.x, uu = acc[ai][1][m][0][j] * sw.x; h0[j] = a * __builtin_amdgcn_rcpf(1.f + __expf(-a)) * uu * sw.y;
                                              const float a2 = acc[ai][0][m][1][j] * sw.x, u2 = acc[ai][1][m][1][j] * sw.x; h1[j] = a2 * __builtin_amdgcn_rcpf(1.f + __expf(-a2)) * u2 * sw.y; }
                *(u32x4*)(HID + (size_t)(u.pm * BM + r) * 256 + c0) = pack8(h0, h1); }
    }
};
struct EpiDown {
    bf16_t* Y;
    __device__ __forceinline__ void operator()(const f32x4 (&acc)[2][2][4][2], const Unit& u, int wr, int wc, int fr, int fq) const {
        const int r0 = u.pm * BM + wr * 64 + fr; const int c0 = u.pn * BM + wc * 32 + 8 * fq;
#pragma unroll
        for (int ai = 0; ai < 2; ++ai)
#pragma unroll
            for (int m = 0; m < 4; ++m) { bf16_t* rowp = Y + (size_t)(r0 + ai * HALF + m * 16) * 1024 + c0;
#pragma unroll
                for (int bj = 0; bj < 2; ++bj) *(u32x4*)(rowp + bj * HALF) = pack8(acc[ai][bj][m][0], acc[ai][bj][m][1]); }
    }
};
}
namespace attn_body {
using bf16=__hip_bfloat16;
using bf16x8=__attribute__((ext_vector_type(8)))short;
using s16x4=__attribute__((ext_vector_type(4)))short;
using f32x16=__attribute__((ext_vector_type(16)))float;
using u32x4=__attribute__((ext_vector_type(4)))unsigned;
constexpr int BATCH=8,NHEAD=8,SEQ=2048,D=64,DM=NHEAD*D,PO=1024;
constexpr int NW=8,QBLK=32,QB=QBLK*NW,KVBLK=64,NQB=SEQ/QB;
constexpr int ATTN_UNIT_ROWS=QB;
__device__ __forceinline__ int crow(int r,int hi){return (r&3)+8*(r>>2)+4*hi;}
#define SBAR() __builtin_amdgcn_sched_barrier(0)
typedef float f32x4a __attribute__((ext_vector_type(4)));
__device__ __forceinline__ void tbias(f32x16&p0,f32x16&p1,int t,int qpos,int hi,__attribute__((address_space(3))) const char* tabr){
  int base=qpos-64*t-4*hi; base=base<-4?-4:(base>200?200:base); const int a=200-base, s=a&3;
  const __attribute__((address_space(3))) f32x4a* tp=(const __attribute__((address_space(3))) f32x4a*)(tabr+s*1088+(a-s)*4);
  #pragma unroll
  for(int g=0;g<4;++g){ const f32x4a v0=tp[2*g], v1=tp[2*g+8];
    p0[4*g]+=v0[0];p0[4*g+1]+=v0[1];p0[4*g+2]+=v0[2];p0[4*g+3]+=v0[3]; p1[4*g]+=v1[0];p1[4*g+1]+=v1[1];p1[4*g+2]+=v1[2];p1[4*g+3]+=v1[3];
    asm volatile("":"+v"(p0),"+v"(p1)); }
}
__device__ __forceinline__ float mkeep(float v,unsigned mw,int bit){ const unsigned t=(unsigned)(((int)(mw<<(31-bit)))>>31); return __uint_as_float(__float_as_uint(v)&t); }
constexpr int NSLOT=3, SLOTB=8192;
constexpr int LDS_K=0, LDS_V=NSLOT*SLOTB, LDS_WS=2*NSLOT*SLOTB, LDS_OST=LDS_WS+NW*64*4, LDS_BYTES=LDS_OST+NW*4096, LDS_MSK=LDS_BYTES, LDS_TAB=LDS_MSK+65536, LDS_TOTAL=LDS_TAB+4352;
constexpr float C2=0.125f*1.4426950408889634f;
__device__ __forceinline__ void glds16(const void*gsrc,unsigned lds_dst){unsigned keep;
  asm volatile("s_mov_b32 %0, m0\n\ts_mov_b32 m0, %2\n\ts_nop 0\n\tglobal_load_lds_dwordx4 %1, off\n\ts_mov_b32 m0, %0":"=&s"(keep):"v"(gsrc),"s"(lds_dst):"memory");}
__device__ __forceinline__ float max3f(float a,float b,float c){float r;asm("v_max3_f32 %0, %1, %2, %3":"=v"(r):"v"(a),"v"(b),"v"(c));return r;}
__device__ __forceinline__ float max2f(float a,float b){float r;asm("v_max_f32_e32 %0, %1, %2":"=v"(r):"v"(a),"v"(b));return r;}
__device__ __forceinline__ float fadd_s(float a,float b){float r;asm("v_add_f32_e32 %0, %1, %2":"=v"(r):"v"(a),"v"(b));return r;}
__device__ __forceinline__ float fsub_s(float a,float b){float r;asm("v_sub_f32_e32 %0, %1, %2":"=v"(r):"v"(a),"v"(b));return r;}
typedef float f32x2_t __attribute__((ext_vector_type(2))); typedef __bf16 bf16x2_t __attribute__((ext_vector_type(2)));
__device__ __forceinline__ unsigned cvtpk_s(float lo,float hi){f32x2_t v={lo,hi};bf16x2_t b=__builtin_convertvector(v,bf16x2_t);return __builtin_bit_cast(unsigned,b);}
#define WAIT_BAR(N) asm volatile("s_waitcnt vmcnt(" #N ") lgkmcnt(0)\n\ts_barrier":::"memory")

__device__ __forceinline__ void qkt(f32x16&p0,f32x16&p1,const char*Kslot,const bf16x8*qr,const f32x16&negm,int r32,int hi){
  const char*kb=Kslot+hi*1024+r32*16;
  #pragma unroll
  for(int d0=0;d0<4;++d0){
    const bf16x8 b0=*reinterpret_cast<const bf16x8*>(kb+d0*2048);
    const bf16x8 b1=*reinterpret_cast<const bf16x8*>(kb+d0*2048+512);
    if(d0==0){p0=__builtin_amdgcn_mfma_f32_32x32x16_bf16(b0,qr[0],negm,0,0,0);p1=__builtin_amdgcn_mfma_f32_32x32x16_bf16(b1,qr[0],negm,0,0,0);}
    else{p0=__builtin_amdgcn_mfma_f32_32x32x16_bf16(b0,qr[d0],p0,0,0,0);p1=__builtin_amdgcn_mfma_f32_32x32x16_bf16(b1,qr[d0],p1,0,0,0);}}
}
typedef __attribute__((address_space(3))) const char* lds_cptr;
typedef short v4i16_t __attribute__((ext_vector_type(4)));
__device__ __forceinline__ void kload8(bf16x8*kf,lds_cptr kp){
  kf[0]=*(const __attribute__((address_space(3))) bf16x8*)(kp);      kf[1]=*(const __attribute__((address_space(3))) bf16x8*)(kp+512);
  kf[2]=*(const __attribute__((address_space(3))) bf16x8*)(kp+2048); kf[3]=*(const __attribute__((address_space(3))) bf16x8*)(kp+2560);
  kf[4]=*(const __attribute__((address_space(3))) bf16x8*)(kp+4096); kf[5]=*(const __attribute__((address_space(3))) bf16x8*)(kp+4608);
  kf[6]=*(const __attribute__((address_space(3))) bf16x8*)(kp+6144); kf[7]=*(const __attribute__((address_space(3))) bf16x8*)(kp+6656);
}
__device__ __forceinline__ void kload2(bf16x8*kf,lds_cptr kp,int j){ kf[2*j]=*(const __attribute__((address_space(3))) bf16x8*)(kp+j*2048); kf[2*j+1]=*(const __attribute__((address_space(3))) bf16x8*)(kp+j*2048+512); }
__device__ __forceinline__ s16x4 vtr(lds_cptr p){ return __builtin_bit_cast(s16x4,__builtin_amdgcn_ds_read_tr16_b64_v4i16((__attribute__((address_space(3))) v4i16_t*)p)); }
__device__ __forceinline__ float rowmax(const f32x16&p0,const f32x16&p1){
  float a=max3f(p0[0],p0[1],p1[0]),b=max3f(p0[2],p0[3],p1[1]);a=max3f(a,p1[2],p1[3]);
  #pragma unroll
  for(int r=4;r<16;r+=4){a=max3f(a,p0[r],p0[r+1]);b=max3f(b,p0[r+2],p0[r+3]);a=max3f(a,p1[r],p1[r+1]);b=max3f(b,p1[r+2],p1[r+3]);}
  const float m=max2f(a,b);
  auto rr=__builtin_amdgcn_permlane32_swap(__float_as_uint(m),__float_as_uint(m),false,false);
  return max2f(__uint_as_float(rr[0]),__uint_as_float(rr[1]));
}
__device__ __forceinline__ void pv(f32x16*o,int vb,bf16x8 pa0,bf16x8 pa1,bf16x8 pa2,bf16x8 pa3){
  #pragma unroll
  for(int d0=0;d0<2;++d0){s16x4 lo[4],hi[4];
    #pragma unroll
    for(int ks=0;ks<4;++ks){
      asm volatile("ds_read_b64_tr_b16 %0,%1 offset:%c2":"=&v"(lo[ks]):"v"(vb),"i"(d0*4096+ks*1024):"memory");
      asm volatile("ds_read_b64_tr_b16 %0,%1 offset:%c2":"=&v"(hi[ks]):"v"(vb),"i"(d0*4096+ks*1024+512):"memory");}
    asm volatile("s_waitcnt lgkmcnt(0)":::"memory");SBAR();
    #define PK(k) (bf16x8){lo[k][0],lo[k][1],lo[k][2],lo[k][3],hi[k][0],hi[k][1],hi[k][2],hi[k][3]}
    o[d0]=__builtin_amdgcn_mfma_f32_32x32x16_bf16(pa0,PK(0),o[d0],0,0,0);
    o[d0]=__builtin_amdgcn_mfma_f32_32x32x16_bf16(pa1,PK(1),o[d0],0,0,0);
    o[d0]=__builtin_amdgcn_mfma_f32_32x32x16_bf16(pa2,PK(2),o[d0],0,0,0);
    o[d0]=__builtin_amdgcn_mfma_f32_32x32x16_bf16(pa3,PK(3),o[d0],0,0,0);
    #undef PK
  }
}

#ifndef ATTN_STORE16
#define ATTN_STORE16(p,v) (*(u32x4*)(p)=(v))
#endif
template<int THRL> __device__ __forceinline__ void attn_unit(int b,int h,int qb,const bf16*Q,const bf16*__restrict__ K,const bf16*__restrict__ V,bf16*O,const unsigned*__restrict__ MASK,const float*__restrict__ relb,char*shm){
  int tid0_=threadIdx.x; asm volatile("":"+v"(tid0_));
  const int tid=tid0_,lane=tid&63,r32=lane&31,hi=lane>>5; const int wid=__builtin_amdgcn_readfirstlane(tid>>6);
  const long rowbase=(long)b*SEQ; const int q0=qb*QB;
  const bf16*Qw=Q+(rowbase+q0+wid*QBLK)*DM+h*D;
  const bf16*Kh=K+rowbase*DM+h*D,*Vh=V+rowbase*DM+h*D;
  const unsigned lds0=(unsigned)(uintptr_t)shm;
  float*wsf=(float*)(shm+LDS_WS)+wid*64;
  const bf16*ksrc=Kh+(long)lane*DM+wid*8;
  const bf16*vsrc=Vh+(long)(16*(wid&3)+(lane>>2))*DM+(wid>>2)*32+(lane&3)*8;
  const unsigned kdst=lds0+LDS_K+wid*1024, vdst=lds0+LDS_V+wid*1024;
  #define DMA_K(t,slot) glds16(ksrc+(long)(t)*KVBLK*DM,(unsigned)__builtin_amdgcn_readfirstlane(kdst+(slot)))
  #define DMA_V(t,slot) glds16(vsrc+(long)(t)*KVBLK*DM,(unsigned)__builtin_amdgcn_readfirstlane(vdst+(slot)))
  const int vb0=(int)(lds0+LDS_V)+((lane>>4)&1)*32+(lane&3)*8+(4*hi+((lane&15)>>2))*64;
  const char*Kbase=shm+LDS_K; bf16x8 kf[8];
  const lds_cptr shm3=(lds_cptr)shm; const lds_cptr kp0=shm3+LDS_K+hi*1024+r32*16; const lds_cptr vp0=shm3+LDS_V+((lane>>4)&1)*32+(lane&3)*8+(4*hi+((lane&15)>>2))*64;
  const int NT=(q0+QB)/KVBLK;
  { int tid_=tid; asm volatile("":"+v"(tid_));
    const u32x4*msrc=(const u32x4*)(MASK+((size_t)(b*32)*SEQ+q0)*2); u32x4*mdst=(u32x4*)(shm+LDS_MSK);
    u32x4 mv[8]; const int nit=NT>>2;
    _Pragma("unroll") for(int k=0;k<8;++k){ const int i=tid_+k*(NW*64); if(k<nit) mv[k]=msrc[(size_t)(i>>7)*(SEQ*2/4)+(i&127)]; }
    _Pragma("unroll") for(int k=0;k<8;++k){ const int i=tid_+k*(NW*64); if(k<nit) mdst[i]=mv[k]; }
    for(int i=tid_;i<4*272;i+=NW*64){ const int sft=i/272, k=i-sft*272, d=200-(k+sft); float v=0.f;
      if(d>=0&&d<=112){ int bk; if(d<16)bk=d; else { bk=16+(int)(logf((float)d*(1.0f/16.0f))/2.0794415416798357f*16.0f); bk=bk>31?31:bk; } v=(relb[bk*NHEAD+h]-relb[31*NHEAD+h])*1.4426950408889634f; }
      ((float*)(shm+LDS_TAB))[i]=v; } }
  const unsigned*mskw=(const unsigned*)(shm+LDS_MSK)+(wid*QBLK+r32)*2+hi;
  const int qpos=q0+wid*QBLK+r32;
  DMA_K(0,0);DMA_V(0,0);DMA_K(1,SLOTB);
  bf16x8 qr[4];
  #pragma unroll
  for(int d0=0;d0<4;++d0)qr[d0]=*reinterpret_cast<const bf16x8*>(&Qw[(long)r32*DM+d0*16+hi*8]);
  float mhat=0.f,l_reg=0.f;f32x16 o[2];o[0]=f32x16{};o[1]=f32x16{};f32x16 negm=f32x16{};asm volatile("":"+v"(negm));
  #define CMASK(P0,P1,t) do{ if((t)>=NT-7 && 64*(t)+63+127>=q0+wid*QBLK) tbias(P0,P1,(t),qpos,hi,shm3+LDS_TAB); }while(0)
  bool resc=false;
  #define START(P0,P1) do{ const float rm=rowmax(P0,P1); resc=false; \
    { const float dl=rm; mhat=fadd_s(mhat,dl); \
      _Pragma("unroll") for(int r=0;r<16;++r){P0[r]=fsub_s(P0[r],dl);P1[r]=fsub_s(P1[r],dl);} \
      _Pragma("unroll") for(int r=0;r<16;++r)negm[r]=-mhat; asm volatile("":"+v"(negm)); } \
    _Pragma("unroll") for(int r=0;r<16;++r)P0[r]=__builtin_amdgcn_exp2f(P0[r]); }while(0)
  #define RESC() do{ if(resc){ asm volatile("s_waitcnt lgkmcnt(0)":::"memory"); \
      _Pragma("unroll") for(int d_=0;d_<2;++d_) _Pragma("unroll") for(int r=0;r<16;++r)o[d_][r]*=wsf[crow(r,hi)]; } }while(0)
  f32x16 pA0,pA1,pB0,pB1;
  int sl_prev=0,sl_cur=0,sl_next=SLOTB;
  #define ROT() do{sl_prev=sl_cur;sl_cur=sl_next;sl_next=(sl_next==(NSLOT-1)*SLOTB)?0:sl_next+SLOTB;}while(0)
  DMA_K(2,2*SLOTB);
  WAIT_BAR(3);
  qkt(pA0,pA1,Kbase,qr,negm,r32,hi);asm volatile("s_nop 15\n\ts_nop 7":"+v"(pA0),"+v"(pA1));CMASK(pA0,pA1,0);
  START(pA0,pA1);
  _Pragma("unroll") for(int r=0;r<16;++r)pA1[r]=__builtin_amdgcn_exp2f(pA1[r]);
  { const unsigned mw0=mskw[0]; _Pragma("unroll") for(int r=0;r<16;++r){pA0[r]=mkeep(pA0[r],mw0,r);pA1[r]=mkeep(pA1[r],mw0,16+r);} }
  WAIT_BAR(0);
  DMA_K(3,0);DMA_V(1,SLOTB);
  ROT();
  kload8(kf,kp0+sl_cur);
  WAIT_BAR(2);
  s16x4 vlo[8],vhi[8]; u32x4 pw0,pw1,pw2,pw3;
  #define PKW(P,B) cvtpk_s(P[B],P[B+1])
  #define PAF(k) __builtin_bit_cast(bf16x8,pw##k)
  #define VFR(i) (bf16x8){vlo[i][0],vlo[i][1],vlo[i][2],vlo[i][3],vhi[i][0],vhi[i][1],vhi[i][2],vhi[i][3]}
  #define PIN(x) asm volatile("":"+v"(x))
  #define MX3(a,b,c) __builtin_fmaxf(__builtin_fmaxf((a),(b)),(c))
  #define GAPA(MF,A0,A1,A2,A3,W0,W1,PW) do{ MF; sacc+=A0; sacc+=A1; sacc+=A2; sacc+=A3; PIN(sacc); W0; W1; PIN(PW); SBAR(); }while(0)
  #define EX(v) __builtin_amdgcn_exp2f(v)
  #define GAPB(MF,X,B,MB) do{ MF; X[B]=mkeep(EX(X[B]),mw_,MB+B); X[B+1]=mkeep(EX(X[B+1]),mw_,MB+B+1); X[B+2]=mkeep(EX(X[B+2]),mw_,MB+B+2); X[B+3]=mkeep(EX(X[B+3]),mw_,MB+B+3); PIN(X); SBAR(); }while(0)
  #define VRD(i) do{ vlo[i]=vtr(vp_+(((i)>>2)*4096+((i)&3)*1024)); vhi[i]=vtr(vp_+(((i)>>2)*4096+((i)&3)*1024+512)); }while(0)
  #define KRD(G,j) do{ if(G){ kload2(kf,kp0+sl_next,j); SBAR(); } }while(0)
  #define STEP(C0,C1,P0,P1,t,GK,GV,GL) do{ SBAR(); \
    const lds_cptr vp_=vp0+sl_prev; const unsigned mw_=mskw[(t)*512]; \
    VRD(0); SBAR(); float sacc=(P0[0]+P0[1]); \
    GAPA(C0=__builtin_amdgcn_mfma_f32_32x32x16_bf16(kf[0],qr[0],negm,0,0,0), P0[2],P0[3],P0[4],P0[5],     pw0[0]=PKW(P0,0), pw0[1]=PKW(P0,2), pw0); \
    VRD(4); SBAR(); GAPA(C1=__builtin_amdgcn_mfma_f32_32x32x16_bf16(kf[1],qr[0],negm,0,0,0), P0[6],P0[7],P0[8],P0[9],     pw0[2]=PKW(P0,4), pw0[3]=PKW(P0,6), pw0); \
    VRD(1); SBAR(); GAPA(C0=__builtin_amdgcn_mfma_f32_32x32x16_bf16(kf[2],qr[1],C0,0,0,0),   P0[10],P0[11],P0[12],P0[13], pw1[0]=PKW(P0,8), pw1[1]=PKW(P0,10), pw1); \
    VRD(5); SBAR(); GAPA(C1=__builtin_amdgcn_mfma_f32_32x32x16_bf16(kf[3],qr[1],C1,0,0,0),   P0[14],P0[15],P1[0],P1[1],   pw1[2]=PKW(P0,12),pw1[3]=PKW(P0,14), pw1); \
    VRD(2); SBAR(); GAPA(C0=__builtin_amdgcn_mfma_f32_32x32x16_bf16(kf[4],qr[2],C0,0,0,0),   P1[2],P1[3],P1[4],P1[5],     pw2[0]=PKW(P1,0), pw2[1]=PKW(P1,2), pw2); \
    VRD(6); SBAR(); GAPA(C1=__builtin_amdgcn_mfma_f32_32x32x16_bf16(kf[5],qr[2],C1,0,0,0),   P1[6],P1[7],P1[8],P1[9],     pw2[2]=PKW(P1,4), pw2[3]=PKW(P1,6), pw2); \
    VRD(3); SBAR(); GAPA(C0=__builtin_amdgcn_mfma_f32_32x32x16_bf16(kf[6],qr[3],C0,0,0,0),   P1[10],P1[11],P1[12],P1[13], pw3[0]=PKW(P1,8), pw3[1]=PKW(P1,10), pw3); \
    VRD(7); SBAR(); GAPA(C1=__builtin_amdgcn_mfma_f32_32x32x16_bf16(kf[7],qr[3],C1,0,0,0),   P1[14],P1[15],0.f,0.f,       pw3[2]=PKW(P1,12),pw3[3]=PKW(P1,14), pw3); \
    l_reg+=sacc; \
    if(GK){DMA_K((t)+3,sl_cur);} if(GV){DMA_V((t)+1,sl_next);} \
    CMASK(C0,C1,t); \
    { float a=MX3(C0[0],C0[1],C1[0]),b=MX3(C0[2],C0[3],C1[1]); a=MX3(a,C1[2],C1[3]); \
      _Pragma("unroll") for(int r=4;r<16;r+=4){a=MX3(a,C0[r],C0[r+1]);b=MX3(b,C0[r+2],C0[r+3]);a=MX3(a,C1[r],C1[r+1]);b=MX3(b,C1[r+2],C1[r+3]);} \
      float rm=__builtin_fmaxf(a,b); { auto rr=__builtin_amdgcn_permlane32_swap(__float_as_uint(rm),__float_as_uint(rm),false,false); rm=__builtin_fmaxf(__uint_as_float(rr[0]),__uint_as_float(rr[1])); } \
      resc=false; \
      if(__builtin_expect(__any(rm>(float)THRL),0)){ const float dl=__builtin_fmaxf(rm,0.f); mhat+=dl; \
        _Pragma("unroll") for(int r=0;r<16;++r){C0[r]-=dl;C1[r]-=dl;} \
        _Pragma("unroll") for(int r=0;r<16;++r)negm[r]=-mhat; asm volatile("":"+v"(negm)); \
        const float f=__builtin_amdgcn_exp2f(-dl); l_reg*=f; if(hi==0)wsf[r32]=f; resc=true; } } \
    SBAR(); \
    GAPB(o[0]=__builtin_amdgcn_mfma_f32_32x32x16_bf16(PAF(0),VFR(0),o[0],0,0,0), C0,0,0); \
    GAPB(o[1]=__builtin_amdgcn_mfma_f32_32x32x16_bf16(PAF(0),VFR(4),o[1],0,0,0), C0,4,0); \
    KRD(GL,0); GAPB(o[0]=__builtin_amdgcn_mfma_f32_32x32x16_bf16(PAF(1),VFR(1),o[0],0,0,0), C0,8,0); \
    KRD(GL,1); GAPB(o[1]=__builtin_amdgcn_mfma_f32_32x32x16_bf16(PAF(1),VFR(5),o[1],0,0,0), C0,12,0); \
    KRD(GL,2); GAPB(o[0]=__builtin_amdgcn_mfma_f32_32x32x16_bf16(PAF(2),VFR(2),o[0],0,0,0), C1,0,16); \
    KRD(GL,3); GAPB(o[1]=__builtin_amdgcn_mfma_f32_32x32x16_bf16(PAF(2),VFR(6),o[1],0,0,0), C1,4,16); \
    GAPB(o[0]=__builtin_amdgcn_mfma_f32_32x32x16_bf16(PAF(3),VFR(3),o[0],0,0,0), C1,8,16); \
    GAPB(o[1]=__builtin_amdgcn_mfma_f32_32x32x16_bf16(PAF(3),VFR(7),o[1],0,0,0), C1,12,16); \
    }while(0)
  int t=1;
  #undef CMASK
  #define CMASK(P0,P1,t) do{}while(0)
  for(;t+7<NT;t+=2){
    STEP(pB0,pB1,pA0,pA1,t,true,true,true);     WAIT_BAR(2); RESC(); ROT();
    STEP(pA0,pA1,pB0,pB1,t+1,true,true,true);   WAIT_BAR(2); RESC(); ROT();
  }
  #undef CMASK
  #define CMASK(P0,P1,t) do{ if(64*(t)+63+127>=q0+wid*QBLK) tbias(P0,P1,(t),qpos,hi,shm3+LDS_TAB); }while(0)
  #define ENDW(tt) do{ if((tt)+3<NT){WAIT_BAR(2);} else if((tt)+2<NT){WAIT_BAR(1);} else {WAIT_BAR(0);} }while(0)
  for(;t+1<NT;t+=2){
    STEP(pB0,pB1,pA0,pA1,t,(t+3<NT),(t+1<NT),(t+1<NT));       ENDW(t);   RESC(); ROT();
    STEP(pA0,pA1,pB0,pB1,t+1,(t+4<NT),(t+2<NT),(t+2<NT));     ENDW(t+1); RESC(); ROT();
  }
  STEP(pB0,pB1,pA0,pA1,NT-1,false,false,false); RESC();
  { float sacc=pB0[0]+pB0[1]; _Pragma("unroll") for(int r=2;r<16;++r)sacc+=pB0[r]; _Pragma("unroll") for(int r=0;r<16;++r)sacc+=pB1[r]; l_reg+=sacc;
    pw0=(u32x4){PKW(pB0,0),PKW(pB0,2),PKW(pB0,4),PKW(pB0,6)};pw1=(u32x4){PKW(pB0,8),PKW(pB0,10),PKW(pB0,12),PKW(pB0,14)};pw2=(u32x4){PKW(pB1,0),PKW(pB1,2),PKW(pB1,4),PKW(pB1,6)};pw3=(u32x4){PKW(pB1,8),PKW(pB1,10),PKW(pB1,12),PKW(pB1,14)};
    SBAR(); pv(o,vb0+sl_cur,PAF(0),PAF(1),PAF(2),PAF(3)); }
  #undef PKW
  #undef PAF
  #undef VFR
  #undef PIN
  #undef MX3
  #undef GAPA
  #undef GAPB
  #undef EX
  #undef VRD
  #undef KRD
  #undef STEP
  #undef ENDW
  {auto rr=__builtin_amdgcn_permlane32_swap(__float_as_uint(l_reg),__float_as_uint(l_reg),false,false);l_reg=__uint_as_float(rr[0])+__uint_as_float(rr[1]);}
  if(hi==0)wsf[32+r32]=l_reg;asm volatile("s_waitcnt lgkmcnt(0)":::"memory");
  float rli[16];
  #pragma unroll
  for(int r=0;r<16;++r)rli[r]=__builtin_amdgcn_rcpf(wsf[32+crow(r,hi)]);
  bf16*Ow=O+(rowbase+q0+wid*QBLK)*PO+h*D;
  { bf16*stg=(bf16*)(shm+LDS_OST)+wid*2048;
    #pragma unroll
    for(int r=0;r<16;++r){const int orow=crow(r,hi);
      #pragma unroll
      for(int d0=0;d0<2;++d0)stg[orow*64+d0*32+r32]=__float2bfloat16(o[d0][r]*rli[r]);}
    asm volatile("s_waitcnt lgkmcnt(0)":::"memory");
    #pragma unroll
    for(int i=0;i<4;++i){const int row=i*8+(lane>>3),ch=lane&7; const u32x4 v=*(const u32x4*)(stg+row*64+ch*8); ATTN_STORE16(Ow+(long)row*PO+ch*8,v);} }
  asm volatile("s_waitcnt lgkmcnt(0)\n\ts_barrier":::"memory");
  #undef DMA_K
  #undef DMA_V
  #undef CMASK
  #undef START
  #undef RESC
  #undef ROT
}
struct AttnTensors { const bf16* Q; const bf16* K; const bf16* V; bf16* O; const unsigned* MASK; const float* relb; };
struct AttnUnit { int bh; int qb; };
constexpr int ATTN_LDS_BYTES=LDS_TOTAL;
#undef SBAR
#undef WAIT_BAR
}
constexpr int NWAVES = 8;
#ifndef MK_N_LAUNCHES
#define MK_N_LAUNCHES 1
#endif
constexpr int PER_PHASE = 10;
constexpr int N_LAUNCHES = (MK_N_LAUNCHES == 1) ? 1 : PER_PHASE;
constexpr int M = 8 * 2048;
constexpr size_t MiB = 1u << 20;
constexpr size_t WS_CTL = 0, CTL_ZERO_BYTES = 65536;
constexpr size_t WS_RSTD1 = 1 * MiB, WS_ROWSS = 2 * MiB, WS_WR = 3 * MiB, WS_BLAST = 3 * MiB + 512 * 1024, WS_TOKINFO = 4 * MiB, WS_LISTS = 5 * MiB, WS_LSC = 7 * MiB;
constexpr size_t WS_WO = 16 * MiB, WS_WGU = 18 * MiB, WS_WD = 50 * MiB, WS_XB = 66 * MiB, WS_MASK = 66 * MiB, WS_SB = 70 * MiB, WS_WIN = 98 * MiB;
constexpr size_t WS_QN = 106 * MiB, WS_KN = 122 * MiB, WS_VN = 138 * MiB, WS_XN2 = 106 * MiB, WS_IQ = 154 * MiB, WS_MISC = 162 * MiB, WS_QB = 164 * MiB, WS_KB = 172 * MiB, WS_VB = 180 * MiB, WS_RG = 196 * MiB;
constexpr size_t WS_MIX = 212 * MiB, WS_HID = 138 * MiB, WS_Y = 158 * MiB, WS_END = 244 * MiB;
constexpr int CW_TMO = 0, CW_CODE = 1, CW_BAR = 4096, CW_CNT = 15360;
constexpr int RING_BYTES = 154624;
constexpr int LDSCTL_OFF = RING_BYTES, MISC_OFF = LDSCTL_OFF, TOFF_OFF = LDSCTL_OFF + 256;
constexpr int LDS_BYTES = RING_BYTES + 1024;
static_assert(attn_body::ATTN_LDS_BYTES <= RING_BYTES, "attention LDS");
#ifndef REP_IDX
#define REP_IDX 1
#endif
#ifndef REP_GLAA
#define REP_GLAA 1
#endif
#ifndef REP_ATT
#define REP_ATT 1
#endif
#ifndef REP_GLAC
#define REP_GLAC 1
#endif
#ifndef REP_IDX_SCORE
#define REP_IDX_SCORE 1
#endif
#ifndef REP_IDX_SEL
#define REP_IDX_SEL 1
#endif
#ifndef REP_SEL_A
#define REP_SEL_A 1
#endif
#ifndef REP_SEL_B
#define REP_SEL_B 1
#endif
#ifndef REP_SEL_C
#define REP_SEL_C 1
#endif
#ifndef REP_SEL_CNT
#define REP_SEL_CNT 1
#endif
#ifndef REP_SEL_ST
#define REP_SEL_ST 1
#endif
#define GAS __attribute__((address_space(1)))
#define LAS __attribute__((address_space(3)))
typedef unsigned short bf16;
typedef unsigned v4u __attribute__((ext_vector_type(4)));
typedef float f32x4 __attribute__((ext_vector_type(4)));
typedef short bf16x8 __attribute__((ext_vector_type(8)));
typedef GAS unsigned gu32;
typedef GAS unsigned long long gu64;
#define RLX_AGENT __ATOMIC_RELAXED, __HIP_MEMORY_SCOPE_AGENT
#define LDS_WAIT() asm volatile("s_waitcnt lgkmcnt(0)" ::: "memory")
#define VM_WAIT() asm volatile("s_waitcnt vmcnt(0)" ::: "memory")
__device__ __forceinline__ unsigned long long rt() { return __builtin_amdgcn_s_memrealtime(); }
__device__ __forceinline__ unsigned f2bf(float f) { unsigned u = __builtin_bit_cast(unsigned, f); return (u + 0x7fffu + ((u >> 16) & 1u)) >> 16; }
__device__ __forceinline__ unsigned pk2(float lo, float hi) { return f2bf(lo) | (f2bf(hi) << 16); }

#define XB_TMO      128
#define XB_XCNT(j)  (256  + 64 * (j))
#define XB_XSUB(j)  (1280 + 64 * (j))
#define XB_XGEN(j)  (2304 + 64 * (j))
#define XB_TOP      3328
#define XB_TOPGEN   3392
#define XCD_BAR_WORDS 3456
#define XB_SPIN_CAP (1u << 18)

__device__ __forceinline__ unsigned xb_ld(unsigned* p)              { return __hip_atomic_load(p, __ATOMIC_RELAXED, __HIP_MEMORY_SCOPE_AGENT); }
__device__ __forceinline__ unsigned xb_add(unsigned* p, unsigned v) { return __hip_atomic_fetch_add(p, v, __ATOMIC_RELAXED, __HIP_MEMORY_SCOPE_AGENT); }
__device__ __forceinline__ unsigned xb_xcc_id() { return (unsigned)__builtin_amdgcn_s_getreg((3 << 11) | 20) & 0xFu; }
#define XB_SPIN(cond, bar) do { unsigned _sp = 0; while (cond) { __builtin_amdgcn_s_sleep(1); \
    if ((++_sp & 255u) == 0u) { if (xb_ld(&(bar)[XB_TMO])) break; if (_sp > XB_SPIN_CAP) { atomicAdd(&(bar)[XB_TMO], 1u); break; } } } } while (0)

struct XcdBarrier {
    unsigned* bar; unsigned x;
    volatile LAS unsigned* st;
};

__device__ __forceinline__ XcdBarrier xcd_barrier_post(unsigned* bar, volatile LAS unsigned* st) {
    XcdBarrier b; b.bar = bar; b.x = xb_xcc_id(); b.st = st;
    if (threadIdx.x == 0) (void)xb_add(&bar[XB_XCNT(b.x)], 1u);
    return b;
}
__device__ __forceinline__ void xcd_barrier_complete(unsigned* bar, unsigned x, unsigned& nloc, unsigned& nx) {
    const unsigned G = gridDim.x * gridDim.y * gridDim.z;
    unsigned sum, cnt, mine, sp = 0u;
    for (;;) {
        sum = 0u; cnt = 0u; mine = 0u;
#pragma unroll
        for (unsigned j = 0; j < 16; ++j) { const unsigned c = xb_ld(&bar[XB_XCNT(j)]); sum += c; cnt += (c > 0u) ? 1u : 0u; mine = (j == x) ? c : mine; }
        if (sum == G) break;
        __builtin_amdgcn_s_sleep(1);
        if ((++sp & 255u) == 0u) { if (xb_ld(&bar[XB_TMO])) break; if (sp > XB_SPIN_CAP) { atomicAdd(&bar[XB_TMO], 1u); break; } }
    }
    nloc = mine > 0u ? mine : 1u; nx = cnt > 0u ? cnt : 1u;
}

__device__ __forceinline__ void xcd_barrier(const XcdBarrier& b) {
    asm volatile("s_waitcnt vmcnt(0)" ::: "memory");
    __syncthreads();
    if (threadIdx.x == 0) {
        unsigned* bar = b.bar;
        __builtin_amdgcn_s_waitcnt(0);
        unsigned nloc = b.st[0], nx = b.st[1];
        if (nloc == 0u) { xcd_barrier_complete(bar, b.x, nloc, nx); b.st[0] = nloc; b.st[1] = nx; }
        const unsigned old = xb_add(&bar[XB_XSUB(b.x)], 1u);
        const unsigned gen = old / nloc;
        if (old + 1u == (gen + 1u) * nloc) {
            __builtin_amdgcn_fence(__ATOMIC_RELEASE, "agent");
            asm volatile("s_waitcnt vmcnt(0)" ::: "memory");
            const unsigned og = xb_add(&bar[XB_TOP], 1u);
            const unsigned tg = og / nx;
            if (og + 1u == (tg + 1u) * nx) xb_add(&bar[XB_TOPGEN], 1u);
            else XB_SPIN(xb_ld(&bar[XB_TOPGEN]) == tg, bar);
            __builtin_amdgcn_fence(__ATOMIC_ACQUIRE, "agent");
            xb_add(&bar[XB_XGEN(b.x)], 1u);
            asm volatile("s_waitcnt vmcnt(0)" ::: "memory");
        } else {
            XB_SPIN(xb_ld(&bar[XB_XGEN(b.x)]) == gen, bar);
            __builtin_amdgcn_fence(__ATOMIC_ACQUIRE, "agent");
            asm volatile("s_waitcnt vmcnt(0)" ::: "memory");
        }
    }
    __syncthreads();
}
typedef float f32x2 __attribute__((ext_vector_type(2)));
typedef unsigned v2u __attribute__((ext_vector_type(2)));
__device__ __forceinline__ float bf2f(unsigned short b) { return __uint_as_float((unsigned)b << 16); }
__device__ __forceinline__ float bflo(unsigned w) { return __uint_as_float(w << 16); }
__device__ __forceinline__ float bfhi(unsigned w) { return __uint_as_float(w & 0xffff0000u); }
__device__ __forceinline__ float wave_sum(float v) {
#pragma unroll
    for (int o = 1; o < 64; o <<= 1) v += __shfl_xor(v, o);
    return v;
}
__device__ __forceinline__ float wave_max(float v) {
#pragma unroll
    for (int o = 1; o < 64; o <<= 1) v = fmaxf(v, __shfl_xor(v, o));
    return v;
}
__device__ __forceinline__ float wave_min(float v) {
#pragma unroll
    for (int o = 1; o < 64; o <<= 1) v = fminf(v, __shfl_xor(v, o));
    return v;
}
#define WG_SYNC() __syncthreads()
#define DPP_STEP_I(v, ctrl) __builtin_amdgcn_update_dpp(0, (v), (ctrl), 0xF, 0xF, false)
__device__ __forceinline__ int wave_isum(int v) {
    v += DPP_STEP_I(v, 0xB1); v += DPP_STEP_I(v, 0x4E); v += DPP_STEP_I(v, 0x141); v += DPP_STEP_I(v, 0x140);
    return __builtin_amdgcn_readlane(v, 0) + __builtin_amdgcn_readlane(v, 16) + __builtin_amdgcn_readlane(v, 32) + __builtin_amdgcn_readlane(v, 48);
}
#define DPP_STEP_F(v, ctrl) __uint_as_float((unsigned)__builtin_amdgcn_update_dpp(0, (int)__float_as_uint(v), (ctrl), 0xF, 0xF, false))
#define RDL_F(v, l) __uint_as_float((unsigned)__builtin_amdgcn_readlane((int)__float_as_uint(v), (l)))
__device__ __forceinline__ float wave_fsum(float v) {
    v += DPP_STEP_F(v, 0xB1); v += DPP_STEP_F(v, 0x4E); v += DPP_STEP_F(v, 0x141); v += DPP_STEP_F(v, 0x140);
    return (RDL_F(v, 0) + RDL_F(v, 16)) + (RDL_F(v, 32) + RDL_F(v, 48));
}
__device__ __forceinline__ float wave_fmax(float v) {
    v = fmaxf(v, DPP_STEP_F(v, 0xB1)); v = fmaxf(v, DPP_STEP_F(v, 0x4E)); v = fmaxf(v, DPP_STEP_F(v, 0x141)); v = fmaxf(v, DPP_STEP_F(v, 0x140));
    return fmaxf(fmaxf(RDL_F(v, 0), RDL_F(v, 16)), fmaxf(RDL_F(v, 32), RDL_F(v, 48)));
}
__device__ __forceinline__ float wave_fmin(float v) {
    v = fminf(v, DPP_STEP_F(v, 0xB1)); v = fminf(v, DPP_STEP_F(v, 0x4E)); v = fminf(v, DPP_STEP_F(v, 0x141)); v = fminf(v, DPP_STEP_F(v, 0x140));
    return fminf(fminf(RDL_F(v, 0), RDL_F(v, 16)), fminf(RDL_F(v, 32), RDL_F(v, 48)));
}

__device__ __forceinline__ int win_vrow(int n) {
    if (n < 1024) { const int base = (n < 512) ? 0 : 512, m = n - base, hh = m >> 6, d = m & 63; return base + 256 * (hh >> 2) + 128 * (d >> 5) + 32 * (hh & 3) + (d & 31); }
    if (n < 1792) return n;
    if (n < 1832) return 3328 + (n - 1792);
    if (n < 2088) return 1792 + (n - 1832);
    if (n < 2344) return 2048 + (n - 2088);
    if (n < 2856) return 2304 + (n - 2344);
    if (n < 2872) return 3328 + 40 + (n - 2856);
    return 2816 + (n - 2872);
}
template <int KIND>
__device__ __forceinline__ void p0_transpose_item(const float* __restrict__ W, int K, int N, const float* __restrict__ gain, bf16* WT, LAS float* scr, int item, int lane) {
    const int nblk = (N + 31) / 32, kb = item / nblk, nb = item % nblk, k0 = 64 * kb, n0 = 32 * nb;
    f32x4 v[8];
#pragma unroll
    for (int j = 0; j < 8; ++j) { const int i = lane + 64 * j, kk = i >> 3, c4 = (i & 7) * 4; v[j] = (n0 + c4 < N) ? *(const f32x4*)(W + (size_t)(k0 + kk) * N + n0 + c4) : (f32x4){0.f, 0.f, 0.f, 0.f}; }
#pragma unroll
    for (int j = 0; j < 8; ++j) { const int i = lane + 64 * j, kk = i >> 3, c4 = (i & 7) * 4; f32x4 x = v[j]; if (gain) x = x * gain[k0 + kk];
        scr[kk * 33 + c4] = x[0]; scr[kk * 33 + c4 + 1] = x[1]; scr[kk * 33 + c4 + 2] = x[2]; scr[kk * 33 + c4 + 3] = x[3]; }
    LDS_WAIT(); asm volatile("" ::: "memory");
    const int c = lane & 7;
#pragma unroll
    for (int j = 0; j < 4; ++j) { const int n = (lane >> 3) + 8 * j; const LAS float* s = scr + (8 * c) * 33 + n;
        v4u o; o.x = pk2(s[0 * 33], s[1 * 33]); o.y = pk2(s[2 * 33], s[3 * 33]); o.z = pk2(s[4 * 33], s[5 * 33]); o.w = pk2(s[6 * 33], s[7 * 33]);
        const int gn = n0 + n; int row;
        if (KIND == 0) row = win_vrow(gn); else if (KIND == 1) row = gn; else if (KIND == 2) row = (gn >> 7) * 256 + (gn & 127); else row = (gn >> 7) * 256 + 128 + (gn & 127);
        if (gn < N) *(GAS v4u*)(WT + (size_t)row * K + k0 + 8 * c) = o; }
    LDS_WAIT(); asm volatile("" ::: "memory");
}

constexpr int SCP = 2064;
__device__ __forceinline__ int crow_(int r, int hi) { return (r & 3) + 8 * (r >> 2) + 4 * hi; }
__device__ __forceinline__ void idx_item(LAS unsigned char* lds, int b, int p, const bf16* __restrict__ IQ, const bf16* __restrict__ MISC, unsigned* __restrict__ MASK, int lane, int wid) {
    const int q0 = p * 16, fr = lane & 15, fq = lane >> 4;
    LAS float* SC = (LAS float*)lds;
    const size_t rowq = (size_t)b * 2048 + q0 + fr;
    bf16x8 Bq[8]; float sinf[8];
    {   const v4u wraw = *(const v4u*)(MISC + rowq * 64 + 32);
        const unsigned wr_[4] = {wraw.x, wraw.y, wraw.z, wraw.w};
#pragma unroll
        for (int h = 0; h < 8; ++h) { const float w = ((h & 1) ? bfhi(wr_[h >> 1]) : bflo(wr_[h >> 1])) * 0.0625f;
            const v4u raw = *(const v4u*)(IQ + rowq * 256 + h * 32 + fq * 8);
            v4u o; o.x = pk2(bflo(raw.x) * w, bfhi(raw.x) * w); o.y = pk2(bflo(raw.y) * w, bfhi(raw.y) * w); o.z = pk2(bflo(raw.z) * w, bfhi(raw.z) * w); o.w = pk2(bflo(raw.w) * w, bfhi(raw.w) * w);
            Bq[h] = __builtin_bit_cast(bf16x8, o); sinf[h] = (w > 0.f) ? __builtin_inff() : -__builtin_inff(); } }
    const int nkt = p + 1;
    const bf16* ikb = MISC + ((size_t)b * 2048 + fr) * 64 + fq * 8;
    for (int rep_ = 0; rep_ < REP_IDX_SCORE; ++rep_)
    for (int kt0 = wid; kt0 < nkt; kt0 += 32) {
        f32x4 acc[4]; bf16x8 A[4];
#pragma unroll
        for (int u = 0; u < 4; ++u) { const int kt = kt0 + 8 * u; acc[u] = (f32x4){0.f, 0.f, 0.f, 0.f}; if (kt < nkt) A[u] = *(const bf16x8*)(ikb + (size_t)kt * 16 * 64); else A[u] = (bf16x8){0, 0, 0, 0, 0, 0, 0, 0}; }
#pragma unroll
        for (int h = 0; h < 8; ++h)
#pragma unroll
            for (int u = 0; u < 4; ++u) { const f32x4 t = __builtin_amdgcn_mfma_f32_16x16x32_bf16(A[u], Bq[h], acc[u], 0, 0, 0);
#pragma unroll
                for (int i = 0; i < 4; ++i) acc[u][i] = __builtin_amdgcn_fmed3f(t[i], acc[u][i], sinf[h]); }
#pragma unroll
        for (int u = 0; u < 4; ++u) { const int kt = kt0 + 8 * u;
            if (kt < nkt) { if (kt == nkt - 1) {
#pragma unroll
                    for (int i = 0; i < 4; ++i) if (4 * fq + i > fr) acc[u][i] = -__builtin_inff(); }
                *(LAS f32x4*)(SC + fr * SCP + kt * 16 + 4 * fq) = acc[u]; } }
    }
    WG_SYNC();
    const int kap = 32 * ((lane >> 4) & 1) + crow_(lane & 15, lane >> 5);
#define IDX_COUNT(dst, expr) do { int cl__ = 0; _Pragma("unroll") for (int g__ = 0; g__ < 4; ++g__) if (8 * g__ < ntile) { _Pragma("unroll") for (int jj__ = 0; jj__ < 8; ++jj__) { const int j = 8 * g__ + jj__; cl__ += (expr) ? 1 : 0; } } \
        dst = wave_isum(cl__); } while (0)
#define IDX_UNI(v) __uint_as_float((unsigned)__builtin_amdgcn_readfirstlane((int)__float_as_uint(v)))
    for (int rep_ = 0; rep_ < REP_IDX_SEL; ++rep_)
    for (int rr = 0; rr < 2; ++rr) {
        const int r = 2 * wid + rr, q = q0 + r, n = q + 1, ntile = (q >> 6) + 1, ngrp = (ntile + 7) >> 3;
        const float NINF = -__builtin_inff();
        float x[32]; unsigned vmask = 0u;
        for (int rpa = 0; rpa < REP_SEL_A; ++rpa) { int off_ = 0; asm volatile("" : "+v"(off_)); vmask = 0u;
#pragma unroll
        for (int j = 0; j < 32; ++j) x[j] = SC[r * SCP + 64 * j + kap + off_];
#pragma unroll
        for (int j = 0; j < 32; ++j) { const bool v = (64 * j + kap + off_) <= q; vmask |= v ? (1u << j) : 0u; x[j] = v ? x[j] : NINF; }
        }
        unsigned selm = vmask;
        for (int rpb = 0; rpb < REP_SEL_B; ++rpb) { asm volatile("" : "+v"(x[0]), "+v"(vmask)); selm = vmask;
        if (n > 256) {
            float mx = NINF, mn = __builtin_inff(), s1 = 0.f, s2 = 0.f;
#pragma unroll
            for (int g = 0; g < 4; ++g) if (g < ngrp) {
#pragma unroll
                for (int jj = 0; jj < 8; ++jj) { const int j = 8 * g + jj; const bool v = (vmask >> j) & 1u; const float xv = v ? x[j] : 0.f; mx = fmaxf(mx, x[j]); mn = fminf(mn, v ? x[j] : __builtin_inff()); s1 += xv; s2 += xv * xv; } }
            float hi = IDX_UNI(wave_fmax(mx)), lo = IDX_UNI(wave_fmin(mn));
            const float fn = (float)n, mu = wave_fsum(s1) / fn, var = fmaxf(wave_fsum(s2) / fn - mu * mu, 0.f);
            int c_lo = n, c_hi = 1;
            bool tie = false, found = false; float tv = hi, thr = hi; int need = 256;
            float mid; { const float pq = 256.0f / fn, pp = pq <= 0.5f ? pq : 1.0f - pq; const float t = sqrtf(-2.0f * __logf(pp)); float z = t - (2.30753f + 0.27061f * t) / (1.0f + t * (0.99229f + 0.04481f * t)); z = pq <= 0.5f ? z : -z; mid = IDX_UNI(mu + z * sqrtf(var)); }
            int side = 0;
            for (int it = 0; it < 40; ++it) {
                if (it > 0 || !(mid > lo && mid < hi)) {
                    mid = 0.5f * lo + 0.5f * hi;
                    if (side > -2 && side < 2) { const float fr_ = ((float)(c_lo - 256) + 0.5f) * __builtin_amdgcn_rcpf((float)(c_lo - c_hi)); const float m2 = lo + (hi - lo) * fr_; if (m2 > lo && m2 < hi) mid = m2; } else side = 0;
                    mid = IDX_UNI(mid);
                }
                if (!(mid > lo && mid < hi)) break;
                unsigned a0 = 0u, a1 = 0u;
#pragma unroll
                for (int g = 1; g >= 0; --g) if (g < ngrp) {
#pragma unroll
                    for (int jj = 7; jj >= 0; --jj) a0 = __builtin_amdgcn_alignbit(a0, __float_as_uint(x[8 * g + jj] - mid), 31); }
#pragma unroll
                for (int g = 3; g >= 2; --g) if (g < ngrp) {
#pragma unroll
                    for (int jj = 7; jj >= 0; --jj) a1 = __builtin_amdgcn_alignbit(a1, __float_as_uint(x[8 * g + jj] - mid), 31); }
                const int c = 64 * 8 * ngrp - wave_isum(__builtin_popcount(a0) + __builtin_popcount(a1));
                if (c == 256) { found = true; selm = vmask & ~(a0 | (a1 << 16)); thr = mid; break; }
                if (c > 256) { lo = mid; c_lo = c; side = side > 0 ? side + 1 : 1; } else { hi = mid; c_hi = c; side = side < 0 ? side - 1 : -1; }
            }
            if (!found) {
                IDX_COUNT(c_hi, x[j] >= hi);
                if (c_hi >= 256) { if (c_hi == 256) { thr = hi; found = true; } else { tie = true; tv = hi; need = 256; } }
                else for (int it = 0; it < 4096; ++it) {
                    float m = NINF;
#pragma unroll
                    for (int g = 0; g < 4; ++g) if (g < ngrp) {
#pragma unroll
                        for (int jj = 0; jj < 8; ++jj) { const int j = 8 * g + jj; m = fmaxf(m, (x[j] < hi) ? x[j] : NINF); } }
                    const float v1 = IDX_UNI(wave_fmax(m));
                    int c; IDX_COUNT(c, x[j] >= v1);
                    if (c >= 256) { if (c == 256) { thr = v1; found = true; } else { tie = true; tv = v1; need = 256 - c_hi; } break; }
                    hi = v1; c_hi = c;
                }
                if (!tie) { selm = 0u;
#pragma unroll
                    for (int j = 0; j < 32; ++j) selm |= (x[j] >= thr) ? (1u << j) : 0u;
                } else {
                    int cum = 0, jstar = 32, needp = 0; unsigned tiem = 0u; selm = 0u;
#pragma unroll
                    for (int j = 0; j < 32; ++j) { const bool t = (x[j] == tv); tiem |= t ? (1u << j) : 0u; const int cj = __builtin_popcountll(__ballot(t));
                        if (jstar == 32 && cum + cj > need) { jstar = j; needp = need - cum; } cum += cj; }
                    const bool tstar = (jstar < 32) && ((tiem >> (jstar & 31)) & 1u);
                    int kL = 0, kH = 63;
                    if (jstar < 32 && needp > 0) { while (kL < kH) { const int km = (kL + kH) >> 1; const int c = __builtin_popcountll(__ballot(tstar && kap <= km)); if (c >= needp) kH = km; else kL = km + 1; } }
                    else kL = -1;
#pragma unroll
                    for (int j = 0; j < 32; ++j) { const bool t = (tiem >> j) & 1u; const bool ts = t && (j < jstar || (j == jstar && kap <= kL)); selm |= (x[j] > tv || ts) ? (1u << j) : 0u; }
                }
            }
        }
        }
        unsigned wlo = 0u, whi = 0u;
        for (int rpc = 0; rpc < REP_SEL_C; ++rpc) { asm volatile("" : "+v"(selm));
#pragma unroll
        for (int j = 0; j < 32; ++j) { const unsigned long long bal = __ballot((selm >> j) & 1u); if (lane == j) { wlo = (unsigned)bal; whi = (unsigned)(bal >> 32); } }
        if (lane < 32) { v2u o; o.x = wlo; o.y = whi; *(v2u*)(MASK + (((size_t)(b * 32 + lane)) * 2048 + q) * 2) = o; }
        }
    }
#undef IDX_COUNT
#undef IDX_UNI
    WG_SYNC();
}

constexpr int KTP = 72;
constexpr int VRP = 136;
constexpr int EP = 68;
constexpr int OTP = 132;
constexpr int GL_OFF = 0, TOT_OFF = 4096, E_OFF = 6144, QA_OFF = 23552, KR_OFF = 32768, PM_OFF = 41984, VR_OFF = 51200, OT_OFF = 68608;
typedef short v4i16g __attribute__((ext_vector_type(4)));
__device__ __forceinline__ bf16x8 tr_frag(const LAS bf16* T, int pitch, int k0, int n0, int lane) {
    const int g = lane >> 4, q = (lane & 15) >> 2, p = lane & 3;
    const LAS bf16* a = T + (k0 + 8 * g + q) * pitch + n0 + 4 * p;
    const v4i16g lo = __builtin_amdgcn_ds_read_tr16_b64_v4i16((LAS v4i16g*)a), hi = __builtin_amdgcn_ds_read_tr16_b64_v4i16((LAS v4i16g*)(a + 4 * pitch));
    return (bf16x8){lo[0], lo[1], lo[2], lo[3], hi[0], hi[1], hi[2], hi[3]};
}
__device__ __forceinline__ float fexp(float x) { return __builtin_amdgcn_exp2f(x * 1.4426950408889634f); }
__device__ __forceinline__ float gla_decay(LAS unsigned char* lds, const bf16* __restrict__ MISC, const float* __restrict__ w2, const float* __restrict__ gb, size_t row0, int h, int tid) {
    LAS float* GL = (LAS float*)(lds + GL_OFF); LAS float* TOT = (LAS float*)(lds + TOT_OFF); LAS float* E = (LAS float*)(lds + E_OFF);
    const int d = tid & 63, tg = tid >> 6;
    { const int t = tid >> 3, r2 = (tid & 7) * 2; const unsigned w = *(const unsigned*)(MISC + (row0 + t) * 64 + 40 + r2); GL[t * 16 + r2] = bflo(w); GL[t * 16 + r2 + 1] = bfhi(w); }
    float wc[16];
#pragma unroll
    for (int r = 0; r < 16; ++r) wc[r] = w2[r * 256 + h * 64 + d];
    const float bias = gb[h * 64 + d];
    WG_SYNC();
    float bc[8]; float run = 0.f;
#pragma unroll
    for (int i = 0; i < 8; ++i) { const int t = 8 * tg + i; float z = bias;
#pragma unroll
        for (int r4 = 0; r4 < 4; ++r4) { const f32x4 g = *(const LAS f32x4*)(GL + t * 16 + 4 * r4); z += g[0] * wc[4 * r4] + g[1] * wc[4 * r4 + 1] + g[2] * wc[4 * r4 + 2] + g[3] * wc[4 * r4 + 3]; }
        const float ls = fminf(z, 0.f) - 0.6931471805599453f * __builtin_amdgcn_logf(1.0f + __builtin_amdgcn_exp2f(-1.4426950408889634f * fabsf(z)));
        run += ls * (1.0f / 16.0f); bc[i] = run; }
    TOT[tg * 64 + d] = run;
    WG_SYNC();
    float pre = 0.f, tot = 0.f;
#pragma unroll
    for (int g = 0; g < 8; ++g) { const float v = TOT[g * 64 + d]; tot += v; if (g < tg) pre += v; }
#pragma unroll
    for (int i = 0; i < 8; ++i) E[(8 * tg + i) * EP + d] = fexp(tot - (bc[i] + pre));
    return tot;
}
__device__ __forceinline__ void gla_load_v(LAS unsigned char* lds, const bf16* __restrict__ VB, size_t row0, int h, int tid) {
    LAS bf16* VR = (LAS bf16*)(lds + VR_OFF); const int t = tid >> 3, v0 = (tid & 7) * 16; const bf16* src = VB + (row0 + t) * 512 + h * 128 + v0;
    const v4u a = *(const v4u*)src, b = *(const v4u*)(src + 8);
    *(LAS v4u*)(VR + t * VRP + v0) = a; *(LAS v4u*)(VR + t * VRP + v0 + 8) = b;
}
__device__ __forceinline__ v4u scale8(v4u raw, const f32x4 e0, const f32x4 e1) {
    v4u o; o.x = pg8::cvt_pk_bf16(bflo(raw.x) * e0[0], bfhi(raw.x) * e0[1]); o.y = pg8::cvt_pk_bf16(bflo(raw.y) * e0[2], bfhi(raw.y) * e0[3]);
    o.z = pg8::cvt_pk_bf16(bflo(raw.z) * e1[0], bfhi(raw.z) * e1[1]); o.w = pg8::cvt_pk_bf16(bflo(raw.w) * e1[2], bfhi(raw.w) * e1[3]); return o;
}
__device__ __forceinline__ void gla_a_item(LAS unsigned char* lds, int id, const bf16* __restrict__ KB, const bf16* __restrict__ VB, const bf16* __restrict__ MISC, const float* __restrict__ w2, const float* __restrict__ gb,
                                           float* __restrict__ U, float* __restrict__ BLAST, int tid, int lane, int wid) {
    const int b = id >> 7, h = (id >> 5) & 3, c = id & 31; const size_t row0 = (size_t)b * 2048 + 64 * c;
    const v4u kraw = *(const v4u*)(KB + (row0 + (tid >> 3)) * 256 + h * 64 + (tid & 7) * 8);
    gla_load_v(lds, VB, row0, h, tid);
    const float blast = gla_decay(lds, MISC, w2, gb, row0, h, tid);
    if (tid < 64) BLAST[(size_t)id * 64 + tid] = blast;
    WG_SYNC();
    LAS bf16* KR = (LAS bf16*)(lds + KR_OFF); LAS bf16* VR = (LAS bf16*)(lds + VR_OFF); const LAS float* E = (const LAS float*)(lds + E_OFF);
    { const int t = tid >> 3, d8 = (tid & 7) * 8; const f32x4 e0 = *(const LAS f32x4*)(E + t * EP + d8), e1 = *(const LAS f32x4*)(E + t * EP + d8 + 4); *(LAS v4u*)(KR + t * KTP + d8) = scale8(kraw, e0, e1); }
    WG_SYNC();
    const int fr = lane & 15, fq = lane >> 4;
    bf16x8 Bf[2];
#pragma unroll
    for (int kk = 0; kk < 2; ++kk) Bf[kk] = tr_frag(VR, VRP, 32 * kk, 16 * wid, lane);
#pragma unroll
    for (int dt = 0; dt < 4; ++dt) { f32x4 acc = (f32x4){0.f, 0.f, 0.f, 0.f};
#pragma unroll
        for (int kk = 0; kk < 2; ++kk) { const bf16x8 Af = tr_frag(KR, KTP, 32 * kk, 16 * dt, lane); acc = __builtin_amdgcn_mfma_f32_16x16x32_bf16(Af, Bf[kk], acc, 0, 0, 0); }
        *(f32x4*)(U + ((size_t)id * 128 + 16 * wid + fr) * 64 + 16 * dt + 4 * fq) = acc; }
    WG_SYNC();
}
__device__ __forceinline__ void gla_b_item(int item, const float* __restrict__ U, const float* __restrict__ BLAST, bf16* __restrict__ SB, int tid) {
    const int bh = item >> 2, qt = item & 3; const size_t eoff = (size_t)qt * 2048 + (size_t)tid * 4; const int d0 = (tid * 4) & 63;
    f32x4 S = (f32x4){0.f, 0.f, 0.f, 0.f};
#pragma unroll 1
    for (int half = 0; half < 2; ++half) {
        f32x4 u[16], bl[16];
#pragma unroll
        for (int c = 0; c < 16; ++c) { const size_t id = (size_t)bh * 32 + 16 * half + c; u[c] = *(const f32x4*)(U + id * 8192 + eoff); bl[c] = *(const f32x4*)(BLAST + id * 64 + d0); }
#pragma unroll
        for (int c = 0; c < 16; ++c) { const size_t id = (size_t)bh * 32 + 16 * half + c;
            f32x4 e; e[0] = __expf(bl[c][0]); e[1] = __expf(bl[c][1]); e[2] = __expf(bl[c][2]); e[3] = __expf(bl[c][3]);
            const f32x4 sd = S * e; v2u o; o.x = pk2(sd[0], sd[1]); o.y = pk2(sd[2], sd[3]); *(v2u*)(SB + id * 8192 + eoff) = o; S = sd + u[c]; }
    }
}
__device__ __forceinline__ void gla_c_item(LAS unsigned char* lds, int id, const bf16* __restrict__ QB, const bf16* __restrict__ KB, const bf16* __restrict__ VB, const bf16* __restrict__ RG, const bf16* __restrict__ MISC,
                                           const float* __restrict__ w2, const float* __restrict__ gb, const float* __restrict__ og, const bf16* __restrict__ SB, bf16* __restrict__ MIX, int tid, int lane, int wid) {
    const int b = id >> 7, h = (id >> 5) & 3, c = id & 31; const size_t row0 = (size_t)b * 2048 + 64 * c;
    const int st_t = tid >> 3, st_d8 = (tid & 7) * 8;
    const v4u kraw = *(const v4u*)(KB + (row0 + st_t) * 256 + h * 64 + st_d8), qraw = *(const v4u*)(QB + (row0 + st_t) * 256 + h * 64 + st_d8);
    gla_load_v(lds, VB, row0, h, tid);
    const int fr = lane & 15, fq = lane >> 4;
    bf16x8 Bs[2];
    { const bf16* sbp = SB + ((size_t)id * 128 + 16 * wid + fr) * 64 + 8 * fq; Bs[0] = *(const bf16x8*)sbp; Bs[1] = *(const bf16x8*)(sbp + 32); }
    (void)gla_decay(lds, MISC, w2, gb, row0, h, tid);
    WG_SYNC();
    LAS bf16* QA = (LAS bf16*)(lds + QA_OFF); LAS bf16* KR = (LAS bf16*)(lds + KR_OFF); LAS bf16* PM = (LAS bf16*)(lds + PM_OFF); LAS bf16* VR = (LAS bf16*)(lds + VR_OFF);
    const LAS float* E = (const LAS float*)(lds + E_OFF); LAS float* OT = (LAS float*)(lds + OT_OFF);
    { const f32x4 e0 = *(const LAS f32x4*)(E + st_t * EP + st_d8), e1 = *(const LAS f32x4*)(E + st_t * EP + st_d8 + 4);
      f32x4 r0, r1;
#pragma unroll
      for (int i = 0; i < 4; ++i) { r0[i] = 0.125f * __builtin_amdgcn_rcpf(e0[i]); r1[i] = 0.125f * __builtin_amdgcn_rcpf(e1[i]); }
      *(LAS v4u*)(KR + st_t * KTP + st_d8) = scale8(kraw, e0, e1); *(LAS v4u*)(QA + st_t * KTP + st_d8) = scale8(qraw, r0, r1); }
    WG_SYNC();
    { const int tt = wid >> 1;
#pragma unroll
      for (int s2 = 0; s2 < 2; ++s2) { const int st = 2 * (wid & 1) + s2; f32x4 acc = (f32x4){0.f, 0.f, 0.f, 0.f};
        if (st <= tt) {
#pragma unroll
            for (int kk = 0; kk < 2; ++kk) { const bf16x8 Af = *(const LAS bf16x8*)(KR + (16 * st + fr) * KTP + 32 * kk + 8 * fq); const bf16x8 Bf = *(const LAS bf16x8*)(QA + (16 * tt + fr) * KTP + 32 * kk + 8 * fq);
                acc = __builtin_amdgcn_mfma_f32_16x16x32_bf16(Af, Bf, acc, 0, 0, 0); } }
        const int t = 16 * tt + fr, s0 = 16 * st + 4 * fq; v2u o;
        o.x = pg8::cvt_pk_bf16((s0 <= t) ? acc[0] : 0.f, (s0 + 1 <= t) ? acc[1] : 0.f); o.y = pg8::cvt_pk_bf16((s0 + 2 <= t) ? acc[2] : 0.f, (s0 + 3 <= t) ? acc[3] : 0.f);
        *(LAS v2u*)(PM + t * KTP + s0) = o; } }
    WG_SYNC();
    bf16x8 Bv[2];
#pragma unroll
    for (int kk = 0; kk < 2; ++kk) Bv[kk] = tr_frag(VR, VRP, 32 * kk, 16 * wid, lane);
#pragma unroll
    for (int tt = 0; tt < 4; ++tt) { f32x4 acc = (f32x4){0.f, 0.f, 0.f, 0.f};
#pragma unroll
        for (int kk = 0; kk < 2; ++kk) { const bf16x8 Ap = *(const LAS bf16x8*)(PM + (16 * tt + fr) * KTP + 32 * kk + 8 * fq); acc = __builtin_amdgcn_mfma_f32_16x16x32_bf16(Ap, Bv[kk], acc, 0, 0, 0);
                                         const bf16x8 Aq = *(const LAS bf16x8*)(QA + (16 * tt + fr) * KTP + 32 * kk + 8 * fq); acc = __builtin_amdgcn_mfma_f32_16x16x32_bf16(Aq, Bs[kk], acc, 0, 0, 0); }
#pragma unroll
        for (int i = 0; i < 4; ++i) OT[(16 * tt + 4 * fq + i) * OTP + 16 * wid + fr] = acc[i]; }
    WG_SYNC();
    { const int t = tid >> 3, v0 = (tid & 7) * 16; f32x4 ov[4]; float ss = 0.f;
#pragma unroll
      for (int k = 0; k < 4; ++k) { ov[k] = *(const LAS f32x4*)(OT + t * OTP + v0 + 4 * k); ss += (ov[k][0] * ov[k][0] + ov[k][1] * ov[k][1]) + (ov[k][2] * ov[k][2] + ov[k][3] * ov[k][3]); }
      ss += DPP_STEP_F(ss, 0xB1); ss += DPP_STEP_F(ss, 0x4E); ss += DPP_STEP_F(ss, 0x141);
      const float rs = __builtin_amdgcn_rsqf(ss * (1.0f / 128.0f) + 1e-6f);
      const bf16* rgp = RG + (row0 + t) * 512 + h * 128 + v0; const v4u ra = *(const v4u*)rgp, rb = *(const v4u*)(rgp + 8);
      const unsigned rw[8] = {ra.x, ra.y, ra.z, ra.w, rb.x, rb.y, rb.z, rb.w}; unsigned ow[8];
#pragma unroll
      for (int k = 0; k < 4; ++k) { const f32x4 g = *(const f32x4*)(og + v0 + 4 * k); float y[4];
#pragma unroll
          for (int i = 0; i < 4; ++i) { const unsigned w = rw[2 * k + (i >> 1)]; const float r = (i & 1) ? bfhi(w) : bflo(w); const float sg = r * __builtin_amdgcn_rcpf(1.0f + __builtin_amdgcn_exp2f(-1.4426950408889634f * r)); y[i] = ov[k][i] * rs * g[i] * sg; }
          ow[2 * k] = pg8::cvt_pk_bf16(y[0], y[1]); ow[2 * k + 1] = pg8::cvt_pk_bf16(y[2], y[3]); }
      bf16* op = MIX + (row0 + t) * 1024 + 512 + h * 128 + v0;
      *(v4u*)op = (v4u){ow[0], ow[1], ow[2], ow[3]}; *(v4u*)(op + 8) = (v4u){ow[4], ow[5], ow[6], ow[7]}; }
    WG_SYNC();
}

constexpr int WRP = 1032;
constexpr int WR_LDS_BYTES = 48 * WRP * 2;
__device__ __forceinline__ void router_tile(LAS unsigned char* lds, int tile, const bf16* __restrict__ XN2, const float* __restrict__ ROWSS, const float* __restrict__ brg, const float* __restrict__ bre,
                                            unsigned* __restrict__ CNT, int* __restrict__ LISTS, float* __restrict__ LSC, int* __restrict__ TOKINFO, int tid, int lane, int wid) {
    LAS bf16* WR = (LAS bf16*)lds; LAS float* PL = (LAS float*)(lds + WR_LDS_BYTES); LAS unsigned* CL = (LAS unsigned*)(lds + WR_LDS_BYTES + 24576); LAS unsigned* BS = CL + 32;
    if (tid < 32) CL[tid] = 0u;
    const int fr = lane & 15, fq = lane >> 4, rt = wid >> 1, kh = wid & 1;
    {   const size_t row = (size_t)tile * 64 + 16 * rt + fr; const bf16* ap = XN2 + row * 1024 + 512 * kh + 8 * fq;
        bf16x8 Af[16];
#pragma unroll
        for (int kk = 0; kk < 16; ++kk) Af[kk] = *(const bf16x8*)(ap + 32 * kk);
        f32x4 acc[3];
#pragma unroll
        for (int nt = 0; nt < 3; ++nt) acc[nt] = (f32x4){0.f, 0.f, 0.f, 0.f};
#pragma unroll
        for (int kk = 0; kk < 16; ++kk)
#pragma unroll
            for (int nt = 0; nt < 3; ++nt) { const bf16x8 Bf = *(const LAS bf16x8*)(WR + (16 * nt + fr) * WRP + 512 * kh + 32 * kk + 8 * fq); acc[nt] = __builtin_amdgcn_mfma_f32_16x16x32_bf16(Af[kk], Bf, acc[nt], 0, 0, 0); }
#pragma unroll
        for (int nt = 0; nt < 3; ++nt)
#pragma unroll
            for (int i = 0; i < 4; ++i) PL[(wid * 16 + 4 * fq + i) * 48 + 16 * nt + fr] = acc[nt][i];
    }
    WG_SYNC();
    int e_[2] = {0, 0}; unsigned lp[2] = {0u, 0u}; float wk[2] = {0.f, 0.f}; float rstd2 = 0.f; const bool act = tid < 64;
    const int token = tile * 64 + tid;
    if (act) {
        const LAS float* l0 = PL + ((2 * (tid >> 4)) * 16 + (tid & 15)) * 48; const LAS float* l1 = l0 + 16 * 48; float ss = 0.f;
        const f32x4* rp = (const f32x4*)(ROWSS + (size_t)token * 16);
#pragma unroll
        for (int j = 0; j < 4; ++j) { const f32x4 v = rp[j]; ss += (v[0] + v[1]) + (v[2] + v[3]); }
        rstd2 = 1.0f / sqrtf(ss * (1.0f / 1024.0f) + 1e-6f);
        float gl[4]; int gs = 0;
#pragma unroll
        for (int j = 0; j < 4; ++j) gl[j] = (l0[j] + l1[j]) * rstd2 + brg[j];
#pragma unroll
        for (int j = 1; j < 4; ++j) if (gl[j] > gl[gs]) gs = j;
        float den = 0.f;
#pragma unroll
        for (int j = 0; j < 4; ++j) den += __expf(gl[j] - gl[gs]);
        const float gw = 1.0f / den;
        float el[8];
#pragma unroll
        for (int j = 0; j < 8; ++j) el[j] = (l0[4 + gs * 8 + j] + l1[4 + gs * 8 + j]) * rstd2 + bre[gs * 8 + j];
        int i0 = 0;
#pragma unroll
        for (int j = 1; j < 8; ++j) if (el[j] > el[i0]) i0 = j;
        int i1 = (i0 == 0) ? 1 : 0;
#pragma unroll
        for (int j = 0; j < 8; ++j) if (j != i0 && j != i1 && el[j] > el[i1]) i1 = j;
        const float ex = __expf(el[i1] - el[i0]); const float w0 = 1.0f / (1.0f + ex);
        wk[0] = w0 * gw; wk[1] = ex * w0 * gw; e_[0] = gs * 8 + i0; e_[1] = gs * 8 + i1;
        lp[0] = __hip_atomic_fetch_add(CL + e_[0], 1u, __ATOMIC_RELAXED, __HIP_MEMORY_SCOPE_WORKGROUP); lp[1] = __hip_atomic_fetch_add(CL + e_[1], 1u, __ATOMIC_RELAXED, __HIP_MEMORY_SCOPE_WORKGROUP);
    }
    WG_SYNC();
    if (tid < 32) { const unsigned n = CL[tid]; BS[tid] = n ? __hip_atomic_fetch_add(CNT + tid, n, __ATOMIC_RELAXED, __HIP_MEMORY_SCOPE_AGENT) : 0u; }
    WG_SYNC();
    if (act) {
#pragma unroll
        for (int k = 0; k < 2; ++k) { const unsigned pos = BS[e_[k]] + lp[k]; LISTS[(size_t)e_[k] * 16384 + pos] = token; *(f32x2*)(LSC + ((size_t)e_[k] * 16384 + pos) * 2) = (f32x2){rstd2, wk[k]}; }
        *(int4*)(TOKINFO + (size_t)token * 4) = make_int4(e_[0], (int)(BS[e_[0]] + lp[0]), e_[1], (int)(BS[e_[1]] + lp[1]));
    }
    WG_SYNC();
}

template <bool GATHER> struct GroupOrder {
    const LAS int* TOFF; const LAS int* BOFF; const LAS int* CNTL; const int* LISTS; int NPN, G, c; unsigned bstride;
    __device__ bool next(int i, pg8::Unit& u) const {
        const int L = i * G + c; const int ntile = BOFF[32]; if (L >= ntile * NPN) return false;
        const int Tb = L / NPN; int e = 0;
#pragma unroll
        for (int s = 16; s >= 1; s >>= 1) if (BOFF[e + s] <= Tb) e += s;
        const int jt = Tb - BOFF[e];
        u.pm = TOFF[e] + jt; u.pn = L - Tb * NPN; u.e = e; u.p0 = jt * 256; const int rem = CNTL[e] - u.p0; u.nv = rem < 256 ? rem : 256; u.bo = (unsigned)e * bstride; return true;
    }
    __device__ __forceinline__ unsigned arow(const pg8::Unit& u, int r) const {
        if (GATHER) return (unsigned)LISTS[(size_t)u.e * 16384 + u.p0 + (r < u.nv ? r : 0)];
        return (unsigned)(u.pm * 256 + r);
    }
};
__device__ __forceinline__ void skinny_gu(LAS unsigned char* lds, int e, int p0, int rem, int rg, int cb, int slot0, const bf16* __restrict__ XN2, const bf16* __restrict__ WGU, const int* __restrict__ LISTS, const float* __restrict__ LSC, bf16* __restrict__ HID, int lane, int wid) {
    const int fr = lane & 15, fq = lane >> 4; const int r = 16 * rg + fr; const int tok = LISTS[(size_t)e * 16384 + p0 + (r < rem ? r : 0)];
    const bf16* ap = XN2 + (size_t)tok * 1024 + 128 * wid + 8 * fq; const bf16* wb = WGU + (size_t)e * 512 * 1024 + 128 * wid + 8 * fq;
    LAS f32x4* PART = (LAS f32x4*)lds;
    bf16x8 Af[4];
#pragma unroll
    for (int k = 0; k < 4; ++k) Af[k] = *(const bf16x8*)(ap + 32 * k);
#pragma unroll
    for (int nt = 0; nt < 4; ++nt) { const int j = 64 * cb + 16 * nt + fr; const bf16* bp = wb + (size_t)((j >> 7) * 256 + (j & 127)) * 1024;
        bf16x8 Bg[4], Bu[4];
#pragma unroll
        for (int k = 0; k < 4; ++k) { Bg[k] = *(const bf16x8*)(bp + 32 * k); Bu[k] = *(const bf16x8*)(bp + 128 * 1024 + 32 * k); }
        f32x4 ag = (f32x4){0.f, 0.f, 0.f, 0.f}, au = (f32x4){0.f, 0.f, 0.f, 0.f};
#pragma unroll
        for (int k = 0; k < 4; ++k) { ag = __builtin_amdgcn_mfma_f32_16x16x32_bf16(Af[k], Bg[k], ag, 0, 0, 0); au = __builtin_amdgcn_mfma_f32_16x16x32_bf16(Af[k], Bu[k], au, 0, 0, 0); }
        PART[(wid * 8 + nt) * 64 + lane] = ag; PART[(wid * 8 + 4 + nt) * 64 + lane] = au; }
    WG_SYNC();
    if (wid < 4) { const int nt = wid; f32x4 g = (f32x4){0.f, 0.f, 0.f, 0.f}, u = (f32x4){0.f, 0.f, 0.f, 0.f};
#pragma unroll
        for (int w = 0; w < 8; ++w) { g += PART[(w * 8 + nt) * 64 + lane]; u += PART[(w * 8 + 4 + nt) * 64 + lane]; }
#pragma unroll
        for (int i = 0; i < 4; ++i) { const int rr = 16 * rg + 4 * fq + i; if (rr < rem) { const f32x2 sw = *(const f32x2*)(LSC + ((size_t)e * 16384 + p0 + rr) * 2);
            const float a = g[i] * sw.x, uu = u[i] * sw.x; HID[(size_t)(slot0 + rr) * 256 + 64 * cb + 16 * nt + fr] = (bf16)f2bf(a * __builtin_amdgcn_rcpf(1.f + __expf(-a)) * uu * sw.y); } } }
    WG_SYNC();
}
__device__ __forceinline__ void skinny_down(int e, int rem, int rg, int cq, int slot0, const bf16* __restrict__ HID, const bf16* __restrict__ WD, bf16* __restrict__ Y, int lane, int wid) {
    const int fr = lane & 15, fq = lane >> 4; const int r = 16 * rg + fr; const int col0 = 256 * cq + 32 * wid;
    const bf16* ap = HID + (size_t)(slot0 + (r < rem ? r : 0)) * 256 + 8 * fq; const bf16* wb = WD + (size_t)e * 1024 * 256 + (size_t)(col0 + fr) * 256 + 8 * fq;
    bf16x8 Af[8], B0[8], B1[8];
#pragma unroll
    for (int k = 0; k < 8; ++k) { Af[k] = *(const bf16x8*)(ap + 32 * k); B0[k] = *(const bf16x8*)(wb + 32 * k); B1[k] = *(const bf16x8*)(wb + (size_t)16 * 256 + 32 * k); }
    f32x4 a0 = (f32x4){0.f, 0.f, 0.f, 0.f}, a1 = (f32x4){0.f, 0.f, 0.f, 0.f};
#pragma unroll
    for (int k = 0; k < 8; ++k) { a0 = __builtin_amdgcn_mfma_f32_16x16x32_bf16(Af[k], B0[k], a0, 0, 0, 0); a1 = __builtin_amdgcn_mfma_f32_16x16x32_bf16(Af[k], B1[k], a1, 0, 0, 0); }
#pragma unroll
    for (int i = 0; i < 4; ++i) { const int rr = 16 * rg + 4 * fq + i; if (rr < rem) { bf16* yp = Y + (size_t)(slot0 + rr) * 1024 + col0 + fr; yp[0] = (bf16)f2bf(a0[i]); yp[16] = (bf16)f2bf(a1[i]); } }
}
struct Args { const float* in[18]; float* out; unsigned char* ws; int ph_lo, ph_hi, li, pad; };
__global__ void __launch_bounds__(NWAVES * 64, 2) hymba_fwd(Args args) {
    extern __shared__ __attribute__((aligned(16))) unsigned char lds[];
    LAS unsigned char* const L = (LAS unsigned char*)lds;
    volatile LAS unsigned* const MISCW = (volatile LAS unsigned*)(L + MISC_OFF);
    LAS int* const TOFF = (LAS int*)(L + TOFF_OFF); LAS int* const CNTL = TOFF + 40; LAS int* const BOFF = TOFF + 80; LAS int* const SMALL = TOFF + 120;
    const int tid = threadIdx.x, lane = tid & 63, wave = __builtin_amdgcn_readfirstlane(tid >> 6);
    const int G = gridDim.x; const int bx = blockIdx.x; const int vcu = (G % 8 == 0) ? (bx % 8) * (G / 8) + bx / 8 : bx;
    unsigned char* const ws = args.ws;
    gu32* const ctl = (gu32*)(ws + WS_CTL);
    const float* x = args.in[0]; const float* norm1_g = args.in[1]; const float* w_in = args.in[2]; const float* q_norm_g = args.in[3]; const float* k_norm_g = args.in[4];
    const float* rel_bias = args.in[5]; const float* gate_w2 = args.in[6]; const float* gate_b = args.in[7]; const float* out_norm_g = args.in[8]; const float* w_out = args.in[9];
    const float* norm2_g = args.in[10]; const float* w_rg = args.in[11]; const float* b_rg = args.in[12]; const float* w_re = args.in[13]; const float* b_re = args.in[14];
    const float* w_eg = args.in[15]; const float* w_eu = args.in[16]; const float* w_ed = args.in[17];
    float* out = args.out;
    float* RSTD1 = (float*)(ws + WS_RSTD1); float* ROWSS = (float*)(ws + WS_ROWSS); bf16* WR_T = (bf16*)(ws + WS_WR); float* BLAST = (float*)(ws + WS_BLAST);
    int* TOKINFO = (int*)(ws + WS_TOKINFO); int* LISTS = (int*)(ws + WS_LISTS); float* LSC = (float*)(ws + WS_LSC);
    bf16* WO_T = (bf16*)(ws + WS_WO); bf16* WGU_T = (bf16*)(ws + WS_WGU); bf16* WD_T = (bf16*)(ws + WS_WD); bf16* XB = (bf16*)(ws + WS_XB); bf16* WIN_T = (bf16*)(ws + WS_WIN);
    unsigned* MASK = (unsigned*)(ws + WS_MASK); bf16* SB = (bf16*)(ws + WS_SB);
    bf16* QN = (bf16*)(ws + WS_QN); bf16* KN = (bf16*)(ws + WS_KN); bf16* VN = (bf16*)(ws + WS_VN); bf16* XN2 = (bf16*)(ws + WS_XN2);
    bf16* IQ = (bf16*)(ws + WS_IQ); bf16* MISC = (bf16*)(ws + WS_MISC); bf16* QB = (bf16*)(ws + WS_QB); bf16* KB = (bf16*)(ws + WS_KB); bf16* VB = (bf16*)(ws + WS_VB); bf16* RG = (bf16*)(ws + WS_RG);
    bf16* MIX = (bf16*)(ws + WS_MIX); float* U = (float*)(ws + WS_MIX); bf16* HID = (bf16*)(ws + WS_HID); bf16* Y = (bf16*)(ws + WS_Y);
    unsigned* CNT = (unsigned*)(ctl + CW_CNT);

    for (int u = tid; u < (LDS_BYTES - LDSCTL_OFF) / 4; u += NWAVES * 64) ((LAS unsigned*)(L + LDSCTL_OFF))[u] = 0u;
    __syncthreads();
    const int bli = (N_LAUNCHES == PER_PHASE) ? 0 : args.li;
    XcdBarrier bar; bar.bar = (unsigned*)(ctl + CW_BAR) + bli * XCD_BAR_WORDS; bar.x = 0; bar.st = nullptr;
    if (N_LAUNCHES != PER_PHASE) bar = xcd_barrier_post((unsigned*)(ctl + CW_BAR) + bli * XCD_BAR_WORDS, MISCW + 8);
#define GRID_BAR(seam) do { if (N_LAUNCHES == PER_PHASE) { if (tid == 0) __hip_atomic_store(ctl + CW_TMO, 0xBADBA0u | (unsigned)(seam), RLX_AGENT); } else { xcd_barrier(bar); } } while (0)
    const int lo = args.ph_lo, hi = args.ph_hi;
#define IN(k) (lo <= (k) && (k) < hi)
#define BOTH(k) (IN(k) && IN((k) + 1))
    const int gw = vcu * NWAVES + wave, NGW = G * NWAVES;

    if (IN(0)) {
        LAS float* scr = (LAS float*)(L + wave * 16384);
        constexpr int I_IN = 16 * 106, I_O = 16 * 32;
        constexpr int NITEMS = I_IN + I_O;
        for (int it = gw; it < NITEMS; it += NGW) {
            int r = it;
            if (r < I_IN) { p0_transpose_item<0>(w_in, 1024, 3384, norm1_g, WIN_T, scr, r, lane); continue; } r -= I_IN;
            p0_transpose_item<1>(w_out, 1024, 1024, nullptr, WO_T, scr, r, lane);
        }
        for (int i = bx * (NWAVES * 64) + tid; i < 48 * 1024; i += G * NWAVES * 64) { const int n = i >> 10, k = i & 1023;
            const float v = (n < 4) ? w_rg[k * 4 + n] : (n < 36) ? w_re[k * 32 + (n - 4)] : 0.f; WR_T[i] = (bf16)f2bf(v * norm2_g[k]); }
        for (int m0 = 2 * gw; m0 < M; m0 += 2 * NGW) {
            f32x4 v[2][4]; float s[2];
#pragma unroll
            for (int r = 0; r < 2; ++r) { const GAS f32x4* xr = (const GAS f32x4*)(x + (size_t)(m0 + r) * 1024) + lane;
#pragma unroll
                for (int j = 0; j < 4; ++j) v[r][j] = xr[64 * j]; }
#pragma unroll
            for (int r = 0; r < 2; ++r) { s[r] = 0.f;
#pragma unroll
                for (int j = 0; j < 4; ++j) s[r] += (v[r][j].x * v[r][j].x + v[r][j].y * v[r][j].y) + (v[r][j].z * v[r][j].z + v[r][j].w * v[r][j].w);
                s[r] = wave_fsum(s[r]); if (lane == 0) RSTD1[m0 + r] = 1.0f / sqrtf(s[r] * (1.0f / 1024.0f) + 1e-6f);
                GAS unsigned long long* o8 = (GAS unsigned long long*)(XB + (size_t)(m0 + r) * 1024) + lane;
#pragma unroll
                for (int j = 0; j < 4; ++j) o8[64 * j] = (unsigned long long)pk2(v[r][j].x, v[r][j].y) | ((unsigned long long)pk2(v[r][j].z, v[r][j].w) << 32); }
        }
        if (BOTH(0)) GRID_BAR(0);
    }
    if (IN(1)) {
        pg8::Gemm g{XB, WIN_T, 1024}; pg8::StaticOrder S; S.init(M, 3584, G, bx);
        pg8::EpiProj E{RSTD1, q_norm_g, k_norm_g, QN, KN, VN, IQ, QB, KB, VB, RG, MISC, 0.125f * 1.4426950408889634f, 1e-6f};
        pg8::gemm_phase<pg8::EpiProj, pg8::StaticOrder, true>(L, g, S, E);
        {
            const int nshort = (896 % G == 0) ? G : G - (896 % G), first = G - nshort;
            if (bx >= first) { LAS float* scr = (LAS float*)(L + wave * 16384);
                constexpr int I_G = 16 * 8, I_D = 4 * 32, PER_E = 2 * I_G + I_D;
                for (int it = (bx - first) * NWAVES + wave; it < 32 * PER_E; it += nshort * NWAVES) { const int e = it / PER_E; int r = it - e * PER_E;
                    if (r < I_G) { p0_transpose_item<2>(w_eg + (size_t)e * 1024 * 256, 1024, 256, norm2_g, WGU_T + (size_t)e * 512 * 1024, scr, r, lane); continue; } r -= I_G;
                    if (r < I_G) { p0_transpose_item<3>(w_eu + (size_t)e * 1024 * 256, 1024, 256, norm2_g, WGU_T + (size_t)e * 512 * 1024, scr, r, lane); continue; } r -= I_G;
                    p0_transpose_item<1>(w_ed + (size_t)e * 256 * 1024, 256, 1024, nullptr, WD_T + (size_t)e * 1024 * 256, scr, r, lane); } } }
        if (BOTH(1)) GRID_BAR(1);
    }
    if (IN(2)) {
        for (int rep = 0; rep < REP_IDX; ++rep)
        for (int it = bx; it < 1024; it += G) { const int b = it & 7, key = (it >> 3) ^ ((it >> 8) & 1); const int p = (key & 1) ? 127 - (key >> 1) : (key >> 1);
            idx_item(L, b, p, IQ, MISC, MASK, lane, wave); }
        for (int rep = 0; rep < REP_GLAA; ++rep)
        for (int it = bx; it < 1024; it += G) gla_a_item(L, it, KB, VB, MISC, gate_w2, gate_b, U, BLAST, tid, lane, wave);
        if (BOTH(2)) GRID_BAR(2);
    }
    if (IN(3)) {
        for (int it = bx; it < 128; it += G) gla_b_item(it, U, BLAST, SB, tid);
        if (BOTH(3)) GRID_BAR(3);
    }
    if (IN(4)) {
        const attn_body::AttnTensors AT{(const attn_body::bf16*)QN, (const attn_body::bf16*)KN, (const attn_body::bf16*)VN, (attn_body::bf16*)MIX, MASK, rel_bias};
        for (int rep = 0; rep < REP_ATT; ++rep)
        for (int pr = vcu; pr < 256; pr += G) { const int bh = pr >> 2, s = pr & 3;
            for (int k2 = 0; k2 < 2; ++k2) attn_body::attn_unit<8>(bh >> 3, bh & 7, k2 ? s : 7 - s, AT.Q, AT.K, AT.V, AT.O, AT.MASK, AT.relb, (char*)lds); }
        for (int rep = 0; rep < REP_GLAC; ++rep)
        for (int it = bx; it < 1024; it += G) gla_c_item(L, it, QB, KB, VB, RG, MISC, gate_w2, gate_b, out_norm_g, SB, MIX, tid, lane, wave);
        if (BOTH(4)) GRID_BAR(4);
    }
    if (IN(5)) {
        pg8::Gemm g{MIX, WO_T, 1024}; pg8::StaticOrder S; S.init(M, 1024, G, bx);
        pg8::EpiOut E{x, XN2, ROWSS};
        pg8::gemm_phase<pg8::EpiOut, pg8::StaticOrder, false>(L, g, S, E);
        if (BOTH(5)) GRID_BAR(5);
    }
    if (IN(6)) {
        { LAS bf16* WR = (LAS bf16*)L;
          for (int i = tid; i < 48 * 128; i += NWAVES * 64) { const int n = i >> 7, c8 = i & 127; *(LAS v4u*)(WR + n * WRP + c8 * 8) = *(const v4u*)(WR_T + n * 1024 + c8 * 8); } }
        WG_SYNC();
        for (int tile = bx; tile < 256; tile += G) router_tile(L, tile, XN2, ROWSS, b_rg, b_re, CNT, LISTS, LSC, TOKINFO, tid, lane, wave);
        if (BOTH(6)) GRID_BAR(6);
    }
#define LOAD_TOFF() do { if (tid == 0) { int acc_ = 0, bacc_ = 0, ns_ = 0; for (int e_ = 0; e_ < 32; ++e_) { const int c_ = (int)__hip_atomic_load(CNT + e_, RLX_AGENT); CNTL[e_] = c_; TOFF[e_] = acc_; BOFF[e_] = bacc_; \
        const int full_ = c_ >> 8, rem_ = c_ & 255; acc_ += (c_ + 255) >> 8; bacc_ += full_ + (rem_ > 128 ? 1 : 0); if (rem_ > 0 && rem_ <= 128) { SMALL[1 + ns_] = e_; ++ns_; } } TOFF[32] = acc_; BOFF[32] = bacc_; SMALL[0] = ns_; } WG_SYNC(); } while (0)
    if (IN(7)) {
        LOAD_TOFF();
        pg8::Gemm g{XN2, WGU_T, 1024}; GroupOrder<true> S{TOFF, BOFF, CNTL, LISTS, 2, G, vcu, 512u * 1024u * 2u};
        pg8::EpiGU E{LSC, HID};
        pg8::gemm_phase<pg8::EpiGU, GroupOrder<true>, false>(L, g, S, E);
        { const int ns = SMALL[0];
          for (int idx = G - 1 - bx; idx < ns * 32; idx += G) { const int e = SMALL[1 + (idx >> 5)], rg = (idx >> 2) & 7, cb = idx & 3; const int cnt = CNTL[e], full = cnt >> 8, rem = cnt & 255;
              if (16 * rg < rem) skinny_gu(L, e, full * 256, rem, rg, cb, (TOFF[e] + full) * 256, XN2, WGU_T, LISTS, LSC, HID, lane, wave); } }
        if (BOTH(7)) GRID_BAR(7);
    }
    if (IN(8)) {
        LOAD_TOFF();
        pg8::Gemm g{HID, WD_T, 256}; GroupOrder<false> S{TOFF, BOFF, CNTL, LISTS, 4, G, vcu, 1024u * 256u * 2u};
        pg8::EpiDown E{Y};
        pg8::gemm_phase<pg8::EpiDown, GroupOrder<false>, false>(L, g, S, E);
        { const int ns = SMALL[0];
          for (int idx = G - 1 - bx; idx < ns * 32; idx += G) { const int e = SMALL[1 + (idx >> 5)], rg = (idx >> 2) & 7, cq = idx & 3; const int cnt = CNTL[e], full = cnt >> 8, rem = cnt & 255;
              if (16 * rg < rem) skinny_down(e, rem, rg, cq, (TOFF[e] + full) * 256, HID, WD_T, Y, lane, wave); } }
        if (BOTH(8)) GRID_BAR(8);
    }
    if (IN(9)) {
        LOAD_TOFF();
        for (int m0 = 4 * gw; m0 < M; m0 += 4 * NGW) {
            int4 ti[4];
#pragma unroll
            for (int r = 0; r < 4; ++r) ti[r] = *(const int4*)(TOKINFO + (size_t)(m0 + r) * 4);
            v4u av[4][2], b0[4][2], b1[4][2];
#pragma unroll
            for (int r = 0; r < 4; ++r) { const size_t s0 = (size_t)TOFF[ti[r].x] * 256 + ti[r].y, s1 = (size_t)TOFF[ti[r].z] * 256 + ti[r].w;
                const GAS v4u* a = (const GAS v4u*)(XN2 + (size_t)(m0 + r) * 1024) + lane; const GAS v4u* y0 = (const GAS v4u*)(Y + s0 * 1024) + lane; const GAS v4u* y1 = (const GAS v4u*)(Y + s1 * 1024) + lane;
#pragma unroll
                for (int j = 0; j < 2; ++j) { av[r][j] = a[64 * j]; b0[r][j] = y0[64 * j]; b1[r][j] = y1[64 * j]; } }
#pragma unroll
            for (int r = 0; r < 4; ++r) { GAS f32x4* o = (GAS f32x4*)(out + (size_t)(m0 + r) * 1024) + 2 * lane;
#pragma unroll
                for (int j = 0; j < 2; ++j) { const v4u a_ = av[r][j], c0 = b0[r][j], c1 = b1[r][j]; f32x4 r0, r1;
                    r0[0] = bflo(a_.x) + bflo(c0.x) + bflo(c1.x); r0[1] = bfhi(a_.x) + bfhi(c0.x) + bfhi(c1.x); r0[2] = bflo(a_.y) + bflo(c0.y) + bflo(c1.y); r0[3] = bfhi(a_.y) + bfhi(c0.y) + bfhi(c1.y);
                    r1[0] = bflo(a_.z) + bflo(c0.z) + bflo(c1.z); r1[1] = bfhi(a_.z) + bfhi(c0.z) + bfhi(c1.z); r1[2] = bflo(a_.w) + bflo(c0.w) + bflo(c1.w); r1[3] = bfhi(a_.w) + bfhi(c0.w) + bfhi(c1.w);
                    o[128 * j] = r0; o[128 * j + 1] = r1; } }
        }
    }
#undef IN
#undef BOTH
}

extern "C" void kernel_launch(void* const* d_in, const int* in_sizes, int n_in, void* d_out, int out_size, void* d_ws, size_t ws_size, hipStream_t stream) {
    static int grid = 0;
    if (grid == 0) {
        if (n_in != 18 || out_size != M * 1024 || ws_size < WS_END) { fprintf(stderr, "kernel_launch: unexpected problem shape (n_in %d out %d ws %zu)\n", n_in, out_size, ws_size); grid = -1; return; }
        int dev = 0, cus = 0, per_cu = 0;
        if (hipGetDevice(&dev) != hipSuccess || hipDeviceGetAttribute(&cus, hipDeviceAttributeMultiprocessorCount, dev) != hipSuccess) { grid = -1; return; }
        if (hipFuncSetAttribute((const void*)hymba_fwd, hipFuncAttributeMaxDynamicSharedMemorySize, LDS_BYTES) != hipSuccess) { fprintf(stderr, "kernel_launch: hipFuncSetAttribute failed\n"); grid = -1; return; }
        if (hipOccupancyMaxActiveBlocksPerMultiprocessor(&per_cu, (const void*)hymba_fwd, NWAVES * 64, LDS_BYTES) != hipSuccess || per_cu < 1) { fprintf(stderr, "kernel_launch: occupancy query reports %d\n", per_cu); }
        (void)hipGetLastError();
        grid = cus;
    }
    if (grid < 0) return;
    (void)hipMemsetAsync((char*)d_ws + WS_CTL, 0, CTL_ZERO_BYTES, stream);
    Args a{};
    for (int i = 0; i < 18; ++i) a.in[i] = (const float*)d_in[i];
    a.out = (float*)d_out; a.ws = (unsigned char*)d_ws;
#if defined(PROBE_PHASE)
    { const int k = PROBE_PHASE; a.ph_lo = 0; a.ph_hi = k + 1; a.li = 0; hipLaunchKernelGGL(hymba_fwd, dim3(grid), dim3(NWAVES * 64), LDS_BYTES, stream, a);
      for (int r = 1; r < PROBE_REPS; ++r) { a.ph_lo = k; a.ph_hi = k + 1; a.li = 1; hipLaunchKernelGGL(hymba_fwd, dim3(grid), dim3(NWAVES * 64), LDS_BYTES, stream, a); }
      if (k + 1 < PER_PHASE) { a.ph_lo = k + 1; a.ph_hi = PER_PHASE; a.li = 2; hipLaunchKernelGGL(hymba_fwd, dim3(grid), dim3(NWAVES * 64), LDS_BYTES, stream, a); } }
#else
    if (N_LAUNCHES == 1) { a.ph_lo = 0; a.ph_hi = PER_PHASE; a.li = 0; hipLaunchKernelGGL(hymba_fwd, dim3(grid), dim3(NWAVES * 64), LDS_BYTES, stream, a); }
    else for (int li = 0; li < PER_PHASE; ++li) { a.ph_lo = li; a.ph_hi = li + 1; a.li = li; hipLaunchKernelGGL(hymba_fwd, dim3(grid), dim3(NWAVES * 64), LDS_BYTES, stream, a); }
#endif
}
```

```cpp
#include <hip/hip_runtime.h>
#include <hip/hip_bf16.h>
#include <cstdio>
#include <cstdint>
#include <cmath>
namespace pg8 {
#define PG8_LAS __attribute__((address_space(3)))
typedef unsigned short bf16_t;
typedef short bf16x8 __attribute__((ext_vector_type(8)));
typedef float f32x4 __attribute__((ext_vector_type(4)));
typedef float f32x2 __attribute__((ext_vector_type(2)));
typedef unsigned u32x4 __attribute__((ext_vector_type(4)));
constexpr int BM = 256, BK = 64, HALF = 128, HTB = HALF * BK * 2  , STAGE_BYTES = 8 * HTB, NXCD = 8, WGM = 8;

__host__ __device__ __forceinline__ int lds_byte(int r, int c) { const int st = (r >> 4) * 2 + (c >> 5), rr = r & 15, cc = c & 31, ob = rr * 64 + cc * 2; return st * 1024 + (ob ^ (((ob >> 9) & 1) << 5)); }
__host__ __device__ __forceinline__ void stage_rc(int b, int& R, int& C) { const int st = b / 1024, sb = b % 1024, swz = sb ^ (((sb >> 9) & 1) << 5); R = (st >> 1) * 16 + swz / 64; C = (st & 1) * 32 + (swz % 64) / 2; }
__host__ __device__ __forceinline__ int perm32(int rho) { const int n = rho >> 4, i = rho & 15; return 8 * (i >> 2) + 4 * n + (i & 3); }

struct Unit { int pm, pn; unsigned bo; int e, nv, p0; };
struct Gemm { const bf16_t* A; const bf16_t* Bt; int K; };

struct StaticOrder {
    int nM, nN, nwg, G, c;
    __device__ void init(int M, int N, int G_, int c_) { nM = M / BM; nN = N / BM; nwg = nM * nN; G = G_; c = c_; }
    __device__ bool next(int i, Unit& u) const {
        const long L = (long)i * G + c; if (L >= nwg) return false;
        int wgid = (int)L; { const int q = nwg / NXCD, r = nwg % NXCD, xcd = wgid % NXCD, off = wgid / NXCD; wgid = (xcd < r ? xcd * (q + 1) : r * (q + 1) + (xcd - r) * q) + off; }
        const int nig = WGM * nN, gid = wgid / nig, fm = gid * WGM, gsz = (nM - fm) < WGM ? (nM - fm) : WGM;
        u.pm = fm + ((wgid % nig) % gsz); u.pn = (wgid % nig) / gsz; u.bo = 0u; u.e = 0; u.nv = BM; u.p0 = 0; return true;
    }
    __device__ __forceinline__ unsigned arow(const Unit& u, int r) const { return (unsigned)(u.pm * BM + r); }
};

__device__ __forceinline__ unsigned cvt_pk_bf16(float lo, float hi) { unsigned r; asm volatile("v_cvt_pk_bf16_f32 %0, %1, %2" : "=v"(r) : "v"(lo), "v"(hi)); return r; }

template <class Epi, class Sched, bool ALIGN_EPI = false>
__device__ __forceinline__ void gemm_phase(PG8_LAS unsigned char* lds, const Gemm g, const Sched& S, const Epi& E) {
    const int tid = threadIdx.x, wid = __builtin_amdgcn_readfirstlane(tid >> 6), lane = tid & 63, wr = wid >> 2, wc = wid & 3, fr = lane & 15, fq = lane >> 4;
    const int K = g.K, nt = K / BK;
    int RA[2], CA[2]; unsigned voffB[2];
#pragma unroll
    for (int i = 0; i < 2; ++i) { int R, C; stage_rc(tid * 16 + i * 8192, R, C); const int Rb = ((R & ~31) + perm32(R & 31));
        RA[i] = R; CA[i] = C; voffB[i] = (unsigned)(Rb * K + C) * 2u; }
    const size_t kstep = (size_t)(BK * 2);
    const size_t hstep = (size_t)HALF * K * 2;
    const size_t tstep = 2 * hstep;
    const unsigned ldsw = (unsigned)wid * 1024u;
    const int aoff = lds_byte(wr * 64 + fr, fq * 8), boff = lds_byte(wc * 32 + fr, fq * 8);
#define PG8_SA(b, h) (((b) * 2 + (h)) * HTB)
#define PG8_SB(b, h) ((4 + (b) * 2 + (h)) * HTB)
#define PG8_STAGE(bufoff, gbase, voff) do { _Pragma("unroll") for (int _i = 0; _i < 2; ++_i) \
        __builtin_amdgcn_global_load_lds((const unsigned*)((const char*)(gbase) + (voff)[_i]), (PG8_LAS unsigned*)(lds + (bufoff) + ldsw + _i * 8192), 16, 0, 0); } while (0)
#define PG8_LDA(dst, b, h) do { _Pragma("unroll") for (int m = 0; m < 4; ++m) _Pragma("unroll") for (int k = 0; k < 2; ++k) dst[m][k] = *(const PG8_LAS bf16x8*)(lds + PG8_SA(b, h) + aoff + m * 2048 + k * 1024); } while (0)
#define PG8_LDB(dst, b, h) do { _Pragma("unroll") for (int n = 0; n < 2; ++n) _Pragma("unroll") for (int k = 0; k < 2; ++k) dst[n][k] = *(const PG8_LAS bf16x8*)(lds + PG8_SB(b, h) + boff + n * 2048 + k * 1024); } while (0)
#define PG8_MMA(ai, bj, At, Bt) do { __builtin_amdgcn_s_setprio(1); _Pragma("unroll") for (int m = 0; m < 4; ++m) _Pragma("unroll") for (int n = 0; n < 2; ++n) _Pragma("unroll") for (int k = 0; k < 2; ++k) \
        acc[ai][bj][m][n] = __builtin_amdgcn_mfma_f32_16x16x32_bf16(Bt[n][k], At[m][k], acc[ai][bj][m][n], 0, 0, 0); __builtin_amdgcn_s_setprio(0); } while (0)
#define PG8_WAIT_V(n) asm volatile("s_waitcnt vmcnt(" #n ")" ::: "memory")
#define PG8_WAIT_L(n) asm volatile("s_waitcnt lgkmcnt(" #n ")" ::: "memory")
#define PG8_BAR __builtin_amdgcn_s_barrier()
#define PG8_SCHED __builtin_amdgcn_sched_barrier(0)
#define PG8_AOFF(AO, U) do { _Pragma("unroll") for (int _h = 0; _h < 2; ++_h) _Pragma("unroll") for (int _i = 0; _i < 2; ++_i) \
        AO[_h][_i] = (S.arow(U, _h * HALF + RA[_i]) * (unsigned)K + (unsigned)CA[_i]) * 2u; } while (0)
    Unit cur, nxt; int ui = 0;
    if (!S.next(0, cur)) return;
    f32x4 acc[2][2][4][2];
#pragma unroll
    for (int a = 0; a < 2; ++a)
#pragma unroll
        for (int b = 0; b < 2; ++b)
#pragma unroll
            for (int m = 0; m < 4; ++m)
#pragma unroll
                for (int n = 0; n < 2; ++n) acc[a][b][m][n] = (f32x4){0.f, 0.f, 0.f, 0.f};
    bf16x8 At[4][2], B0[2][2], B1[2][2];
    unsigned aoC[2][2], aoN[2][2];
    PG8_AOFF(aoC, cur);
    const char* const gA = (const char*)g.A;
    const char* cB = (const char*)g.Bt + (size_t)cur.bo + (size_t)cur.pn * tstep;
    {
        PG8_STAGE(PG8_SB(0, 0), cB, voffB); PG8_STAGE(PG8_SB(0, 1), cB + hstep, voffB); PG8_STAGE(PG8_SA(0, 0), gA, aoC[0]); PG8_STAGE(PG8_SA(0, 1), gA, aoC[1]);
        if (wr == 1) PG8_BAR;
        PG8_WAIT_V(2); PG8_BAR;
        PG8_STAGE(PG8_SB(1, 0), cB + kstep, voffB); PG8_STAGE(PG8_SA(1, 0), gA + kstep, aoC[0]); PG8_STAGE(PG8_SB(1, 1), cB + hstep + kstep, voffB);
        PG8_WAIT_V(6); PG8_BAR;
    }
    for (;;) {
        const bool has_next = S.next(ui + 1, nxt);
        if (has_next) { PG8_AOFF(aoN, nxt); } else {
#pragma unroll
            for (int _h = 0; _h < 2; ++_h)
#pragma unroll
                for (int _i = 0; _i < 2; ++_i) aoN[_h][_i] = aoC[_h][_i]; }
        const char* nB = has_next ? (const char*)g.Bt + (size_t)nxt.bo + (size_t)nxt.pn * tstep : cB;
        for (int t = 0; t < nt; t += 2) {
            const bool last = (t == nt - 2);
            const char* a1 = gA + (size_t)(t + 1) * kstep;
            const char* a2 = last ? gA : gA + (size_t)(t + 2) * kstep; const char* b2 = last ? nB : cB + (size_t)(t + 2) * kstep;
            const char* a3 = a2 + kstep; const char* b3 = b2 + kstep;
            unsigned ao2[2][2];
#pragma unroll
            for (int _h = 0; _h < 2; ++_h)
#pragma unroll
                for (int _i = 0; _i < 2; ++_i) ao2[_h][_i] = last ? aoN[_h][_i] : aoC[_h][_i];
            PG8_LDB(B0, 0, 0); PG8_LDB(B1, 0, 1); PG8_SCHED; PG8_LDA(At, 0, 0); PG8_STAGE(PG8_SA(1, 1), a1, aoC[1]);
            PG8_WAIT_V(8); PG8_WAIT_L(0); PG8_BAR; PG8_MMA(0, 0, At, B0); PG8_MMA(0, 1, At, B1); PG8_BAR; PG8_SCHED;
            PG8_LDA(At, 0, 1); PG8_STAGE(PG8_SB(0, 0), b2, voffB); PG8_STAGE(PG8_SB(0, 1), b2 + hstep, voffB); PG8_STAGE(PG8_SA(0, 0), a2, ao2[0]);
            PG8_WAIT_V(8); PG8_WAIT_L(0); PG8_BAR; PG8_MMA(1, 0, At, B0); PG8_MMA(1, 1, At, B1); PG8_BAR; PG8_SCHED;
            PG8_LDB(B0, 1, 0); PG8_LDB(B1, 1, 1); PG8_SCHED; PG8_LDA(At, 1, 0); PG8_STAGE(PG8_SA(0, 1), a2, ao2[1]);
            PG8_WAIT_V(8); PG8_WAIT_L(0); PG8_BAR; PG8_MMA(0, 0, At, B0); PG8_MMA(0, 1, At, B1); PG8_BAR; PG8_SCHED;
            PG8_LDA(At, 1, 1); PG8_STAGE(PG8_SB(1, 0), b3, voffB); PG8_STAGE(PG8_SB(1, 1), b3 + hstep, voffB); PG8_STAGE(PG8_SA(1, 0), a3, ao2[0]);
            PG8_WAIT_V(8); PG8_WAIT_L(0); PG8_BAR; PG8_MMA(1, 0, At, B0); PG8_MMA(1, 1, At, B1); PG8_BAR; PG8_SCHED;
        }
        if constexpr (ALIGN_EPI) { if (wr == 0) PG8_BAR; }
        E(acc, cur, wr, wc, fr, fq);
        if (!has_next) break;
#pragma unroll
        for (int a = 0; a < 2; ++a)
#pragma unroll
            for (int b = 0; b < 2; ++b)
#pragma unroll
                for (int m = 0; m < 4; ++m)
#pragma unroll
                    for (int n = 0; n < 2; ++n) acc[a][b][m][n] = (f32x4){0.f, 0.f, 0.f, 0.f};
        cur = nxt; cB = nB; ++ui;
#pragma unroll
        for (int _h = 0; _h < 2; ++_h)
#pragma unroll
            for (int _i = 0; _i < 2; ++_i) aoC[_h][_i] = aoN[_h][_i];
        if constexpr (ALIGN_EPI) { if (wr == 1) PG8_BAR; }
    }
    PG8_WAIT_V(0);
    if constexpr (!ALIGN_EPI) { if (wr == 0) PG8_BAR; }
    PG8_BAR;
#undef PG8_SA
#undef PG8_SB
#undef PG8_STAGE
#undef PG8_LDA
#undef PG8_LDB
#undef PG8_MMA
#undef PG8_WAIT_V
#undef PG8_WAIT_L
#undef PG8_BAR
#undef PG8_SCHED
#undef PG8_AOFF
}
}
namespace pg8 {
__device__ __forceinline__ u32x4 pack8(const f32x4 v0, const f32x4 v1) { u32x4 w; w.x = cvt_pk_bf16(v0[0], v0[1]); w.y = cvt_pk_bf16(v0[2], v0[3]); w.z = cvt_pk_bf16(v1[0], v1[1]); w.w = cvt_pk_bf16(v1[2], v1[3]); return w; }

struct EpiProj {
    const float* rstd1; const float* qg; const float* kg;
    bf16_t *QN, *KN, *VN, *IQ, *QB, *KB, *VB, *RG, *MISC;
    float qscale, eps;
    __device__ __forceinline__ void operator()(const f32x4 (&acc)[2][2][4][2], const Unit& u, int wr, int wc, int fr, int fq) const {
        const int row0 = u.pm * BM + wr * 64 + fr; const int pn = u.pn;
        float rs1[2][4];
#pragma unroll
        for (int ai = 0; ai < 2; ++ai)
#pragma unroll
            for (int m = 0; m < 4; ++m) rs1[ai][m] = rstd1[row0 + ai * HALF + m * 16];
        if (pn < 4) {
            const bool isq = pn < 2; const float* gp = isq ? qg : kg; bf16_t* O = isq ? QN : KN; const float os = isq ? qscale : 1.f;
            f32x4 gv[2][2];
#pragma unroll
            for (int bj = 0; bj < 2; ++bj)
#pragma unroll
                for (int n = 0; n < 2; ++n) gv[bj][n] = *(const f32x4*)(gp + 32 * bj + 8 * fq + 4 * n) * os;
            const int hcol = (4 * (pn & 1) + wc) * 64 + 8 * fq;
#pragma unroll
            for (int ai = 0; ai < 2; ++ai)
#pragma unroll
                for (int m = 0; m < 4; ++m) { const int row = row0 + ai * HALF + m * 16; const float s = rs1[ai][m];
                    float ss = 0.f;
#pragma unroll
                    for (int bj = 0; bj < 2; ++bj)
#pragma unroll
                        for (int n = 0; n < 2; ++n) { const f32x4 x = acc[ai][bj][m][n]; ss += (x[0] * x[0] + x[1] * x[1]) + (x[2] * x[2] + x[3] * x[3]); }
                    ss += __shfl_xor(ss, 16); ss += __shfl_xor(ss, 32);
                    const float r = s * __builtin_amdgcn_rsqf(s * s * ss * (1.f / 64.f) + eps);
                    bf16_t* rowp = O + (size_t)row * 512 + hcol;
#pragma unroll
                    for (int bj = 0; bj < 2; ++bj) *(u32x4*)(rowp + 32 * bj) = pack8(acc[ai][bj][m][0] * r * gv[bj][0], acc[ai][bj][m][1] * r * gv[bj][1]); }
            return;
        }
        bf16_t* O; int pitch, coff, lim = 256;
        if (pn < 6) { O = VN; pitch = 512; coff = (pn - 4) * 256; }
        else if (pn == 6) { O = IQ; pitch = 256; coff = 0; }
        else if (pn == 7) { O = QB; pitch = 256; coff = 0; }
        else if (pn == 8) { O = KB; pitch = 256; coff = 0; }
        else if (pn < 11) { O = VB; pitch = 512; coff = (pn - 9) * 256; }
        else if (pn < 13) { O = RG; pitch = 512; coff = (pn - 11) * 256; }
        else { O = MISC; pitch = 64; coff = 0; lim = 56; }
        const int c0 = wc * 32 + 8 * fq;
#pragma unroll
        for (int ai = 0; ai < 2; ++ai)
#pragma unroll
            for (int m = 0; m < 4; ++m) { const int row = row0 + ai * HALF + m * 16; const float s = rs1[ai][m];
                bf16_t* rowp = O + (size_t)row * pitch + coff + c0;
#pragma unroll
                for (int bj = 0; bj < 2; ++bj) if (c0 + bj * HALF < lim) *(u32x4*)(rowp + bj * HALF) = pack8(acc[ai][bj][m][0] * s, acc[ai][bj][m][1] * s); }
    }
};

struct EpiOut {
    const float* x; bf16_t* XN2; float* ROWSS;
    __device__ __forceinline__ void operator()(const f32x4 (&acc)[2][2][4][2], const Unit& u, int wr, int wc, int fr, int fq) const {
        const int row0 = u.pm * BM + wr * 64 + fr; const int col0 = u.pn * BM + wc * 32 + 8 * fq;
        f32x4 xv[2][4];
#define EPO_LOAD(buf, g) do { const size_t off_ = (size_t)(row0 + ((g) >> 2) * HALF + ((g) & 3) * 16) * 1024 + col0; \
            xv[buf][0] = *(const f32x4*)(x + off_); xv[buf][1] = *(const f32x4*)(x + off_ + 4); xv[buf][2] = *(const f32x4*)(x + off_ + HALF); xv[buf][3] = *(const f32x4*)(x + off_ + HALF + 4); } while (0)
        EPO_LOAD(0, 0);
#pragma unroll
        for (int g = 0; g < 8; ++g) { const int ai = g >> 2, m = g & 3, cur = g & 1;
            if (g + 1 < 8) EPO_LOAD(cur ^ 1, g + 1);
            const int row = row0 + ai * HALF + m * 16; const size_t off = (size_t)row * 1024 + col0; float ss = 0.f;
#pragma unroll
            for (int bj = 0; bj < 2; ++bj) { const f32x4 a = xv[cur][2 * bj] + acc[ai][bj][m][0], b = xv[cur][2 * bj + 1] + acc[ai][bj][m][1];
                ss += (a[0] * a[0] + a[1] * a[1]) + (a[2] * a[2] + a[3] * a[3]) + (b[0] * b[0] + b[1] * b[1]) + (b[2] * b[2] + b[3] * b[3]);
                *(u32x4*)(XN2 + off + bj * HALF) = pack8(a, b); }
            ss += __shfl_xor(ss, 16); ss += __shfl_xor(ss, 32);
            if (fq == 0) ROWSS[(size_t)row * 16 + u.pn * 4 + wc] = ss; }
#undef EPO_LOAD
    }
};

struct EpiGU {
    const float* LSC; bf16_t* HID;
    __device__ __forceinline__ void operator()(const f32x4 (&acc)[2][2][4][2], const Unit& u, int wr, int wc, int fr, int fq) const {
        const int r0 = wr * 64 + fr; const int c0 = u.pn * HALF + wc * 32 + 8 * fq;
#pragma unroll
        for (int ai = 0; ai < 2; ++ai)
#pragma unroll
            for (int m = 0; m < 4; ++m) { const int r = r0 + ai * HALF + m * 16;
                f32x2 sw = (f32x2){0.f, 0.f};
                if (r < u.nv) sw = *(const f32x2*)(LSC + ((size_t)u.e * 16384 + (size_t)(u.p0 + r)) * 2);
                f32x4 h0, h1;
#pragma unroll
                for (int j = 0; j < 4; ++j) { const float a = acc[ai][0][m][0][j] * sw.x, uu = acc[ai][1][m][0][j] * sw.x; h0[j] = a * __builtin_amdgcn_rcpf(1.f + __expf(-a)) * uu * sw.y;
                                              const float a2 = acc[ai][0][m][1][j] * sw.x, u2 = acc[ai][1][m][1][j] * sw.x; h1[j] = a2 * __builtin_amdgcn_rcpf(1.f + __expf(-a2)) * u2 * sw.y; }
                *(u32x4*)(HID + (size_t)(u.pm * BM + r) * 256 + c0) = pack8(h0, h1); }
    }
};
struct EpiDown {
    bf16_t* Y;
    __device__ __forceinline__ void operator()(const f32x4 (&acc)[2][2][4][2], const Unit& u, int wr, int wc, int fr, int fq) const {
        const int r0 = u.pm * BM + wr * 64 + fr; const int c0 = u.pn * BM + wc * 32 + 8 * fq;
#pragma unroll
        for (int ai = 0; ai < 2; ++ai)
#pragma unroll
            for (int m = 0; m < 4; ++m) { bf16_t* rowp = Y + (size_t)(r0 + ai * HALF + m * 16) * 1024 + c0;
#pragma unroll
                for (int bj = 0; bj < 2; ++bj) *(u32x4*)(rowp + bj * HALF) = pack8(acc[ai][bj][m][0], acc[ai][bj][m][1]); }
    }
};
}
namespace attn_body {
using bf16=__hip_bfloat16;
using bf16x8=__attribute__((ext_vector_type(8)))short;
using s16x4=__attribute__((ext_vector_type(4)))short;
using f32x16=__attribute__((ext_vector_type(16)))float;
using u32x4=__attribute__((ext_vector_type(4)))unsigned;
constexpr int BATCH=8,NHEAD=8,SEQ=2048,D=64,DM=NHEAD*D,PO=1024;
constexpr int NW=8,QBLK=32,QB=QBLK*NW,KVBLK=64,NQB=SEQ/QB;
constexpr int ATTN_UNIT_ROWS=QB;
__device__ __forceinline__ int crow(int r,int hi){return (r&3)+8*(r>>2)+4*hi;}
#define SBAR() __builtin_amdgcn_sched_barrier(0)
typedef float f32x4a __attribute__((ext_vector_type(4)));
__device__ __forceinline__ void tbias(f32x16&p0,f32x16&p1,int t,int qpos,int hi,__attribute__((address_space(3))) const char* tabr){
  int base=qpos-64*t-4*hi; base=base<-4?-4:(base>200?200:base); const int a=200-base, s=a&3;
  const __attribute__((address_space(3))) f32x4a* tp=(const __attribute__((address_space(3))) f32x4a*)(tabr+s*1088+(a-s)*4);
  #pragma unroll
  for(int g=0;g<4;++g){ const f32x4a v0=tp[2*g], v1=tp[2*g+8];
    p0[4*g]+=v0[0];p0[4*g+1]+=v0[1];p0[4*g+2]+=v0[2];p0[4*g+3]+=v0[3]; p1[4*g]+=v1[0];p1[4*g+1]+=v1[1];p1[4*g+2]+=v1[2];p1[4*g+3]+=v1[3];
    asm volatile("":"+v"(p0),"+v"(p1)); }
}
__device__ __forceinline__ float mkeep(float v,unsigned mw,int bit){ const unsigned t=(unsigned)(((int)(mw<<(31-bit)))>>31); return __uint_as_float(__float_as_uint(v)&t); }
constexpr int NSLOT=3, SLOTB=8192;
constexpr int LDS_K=0, LDS_V=NSLOT*SLOTB, LDS_WS=2*NSLOT*SLOTB, LDS_OST=LDS_WS+NW*64*4, LDS_BYTES=LDS_OST+NW*4096, LDS_MSK=LDS_BYTES, LDS_TAB=LDS_MSK+65536, LDS_TOTAL=LDS_TAB+4352;
constexpr float C2=0.125f*1.4426950408889634f;
__device__ __forceinline__ void glds16(const void*gsrc,unsigned lds_dst){unsigned keep;
  asm volatile("s_mov_b32 %0, m0\n\ts_mov_b32 m0, %2\n\ts_nop 0\n\tglobal_load_lds_dwordx4 %1, off\n\ts_mov_b32 m0, %0":"=&s"(keep):"v"(gsrc),"s"(lds_dst):"memory");}
__device__ __forceinline__ float max3f(float a,float b,float c){float r;asm("v_max3_f32 %0, %1, %2, %3":"=v"(r):"v"(a),"v"(b),"v"(c));return r;}
__device__ __forceinline__ float max2f(float a,float b){float r;asm("v_max_f32_e32 %0, %1, %2":"=v"(r):"v"(a),"v"(b));return r;}
__device__ __forceinline__ float fadd_s(float a,float b){float r;asm("v_add_f32_e32 %0, %1, %2":"=v"(r):"v"(a),"v"(b));return r;}
__device__ __forceinline__ float fsub_s(float a,float b){float r;asm("v_sub_f32_e32 %0, %1, %2":"=v"(r):"v"(a),"v"(b));return r;}
typedef float f32x2_t __attribute__((ext_vector_type(2))); typedef __bf16 bf16x2_t __attribute__((ext_vector_type(2)));
__device__ __forceinline__ unsigned cvtpk_s(float lo,float hi){f32x2_t v={lo,hi};bf16x2_t b=__builtin_convertvector(v,bf16x2_t);return __builtin_bit_cast(unsigned,b);}
#define WAIT_BAR(N) asm volatile("s_waitcnt vmcnt(" #N ") lgkmcnt(0)\n\ts_barrier":::"memory")

__device__ __forceinline__ void qkt(f32x16&p0,f32x16&p1,const char*Kslot,const bf16x8*qr,const f32x16&negm,int r32,int hi){
  const char*kb=Kslot+hi*1024+r32*16;
  #pragma unroll
  for(int d0=0;d0<4;++d0){
    const bf16x8 b0=*reinterpret_cast<const bf16x8*>(kb+d0*2048);
    const bf16x8 b1=*reinterpret_cast<const bf16x8*>(kb+d0*2048+512);
    if(d0==0){p0=__builtin_amdgcn_mfma_f32_32x32x16_bf16(b0,qr[0],negm,0,0,0);p1=__builtin_amdgcn_mfma_f32_32x32x16_bf16(b1,qr[0],negm,0,0,0);}
    else{p0=__builtin_amdgcn_mfma_f32_32x32x16_bf16(b0,qr[d0],p0,0,0,0);p1=__builtin_amdgcn_mfma_f32_32x32x16_bf16(b1,qr[d0],p1,0,0,0);}}
}
typedef __attribute__((address_space(3))) const char* lds_cptr;
typedef short v4i16_t __attribute__((ext_vector_type(4)));
__device__ __forceinline__ void kload8(bf16x8*kf,lds_cptr kp){
  kf[0]=*(const __attribute__((address_space(3))) bf16x8*)(kp);      kf[1]=*(const __attribute__((address_space(3))) bf16x8*)(kp+512);
  kf[2]=*(const __attribute__((address_space(3))) bf16x8*)(kp+2048); kf[3]=*(const __attribute__((address_space(3))) bf16x8*)(kp+2560);
  kf[4]=*(const __attribute__((address_space(3))) bf16x8*)(kp+4096); kf[5]=*(const __attribute__((address_space(3))) bf16x8*)(kp+4608);
  kf[6]=*(const __attribute__((address_space(3))) bf16x8*)(kp+6144); kf[7]=*(const __attribute__((address_space(3))) bf16x8*)(kp+6656);
}
__device__ __forceinline__ void kload2(bf16x8*kf,lds_cptr kp,int j){ kf[2*j]=*(const __attribute__((address_space(3))) bf16x8*)(kp+j*2048); kf[2*j+1]=*(const __attribute__((address_space(3))) bf16x8*)(kp+j*2048+512); }
__device__ __forceinline__ s16x4 vtr(lds_cptr p){ return __builtin_bit_cast(s16x4,__builtin_amdgcn_ds_read_tr16_b64_v4i16((__attribute__((address_space(3))) v4i16_t*)p)); }
__device__ __forceinline__ float rowmax(const f32x16&p0,const f32x16&p1){
  float a=max3f(p0[0],p0[1],p1[0]),b=max3f(p0[2],p0[3],p1[1]);a=max3f(a,p1[2],p1[3]);
  #pragma unroll
  for(int r=4;r<16;r+=4){a=max3f(a,p0[r],p0[r+1]);b=max3f(b,p0[r+2],p0[r+3]);a=max3f(a,p1[r],p1[r+1]);b=max3f(b,p1[r+2],p1[r+3]);}
  const float m=max2f(a,b);
  auto rr=__builtin_amdgcn_permlane32_swap(__float_as_uint(m),__float_as_uint(m),false,false);
  return max2f(__uint_as_float(rr[0]),__uint_as_float(rr[1]));
}
__device__ __forceinline__ void pv(f32x16*o,int vb,bf16x8 pa0,bf16x8 pa1,bf16x8 pa2,bf16x8 pa3){
  #pragma unroll
  for(int d0=0;d0<2;++d0){s16x4 lo[4],hi[4];
    #pragma unroll
    for(int ks=0;ks<4;++ks){
      asm volatile("ds_read_b64_tr_b16 %0,%1 offset:%c2":"=&v"(lo[ks]):"v"(vb),"i"(d0*4096+ks*1024):"memory");
      asm volatile("ds_read_b64_tr_b16 %0,%1 offset:%c2":"=&v"(hi[ks]):"v"(vb),"i"(d0*4096+ks*1024+512):"memory");}
    asm volatile("s_waitcnt lgkmcnt(0)":::"memory");SBAR();
    #define PK(k) (bf16x8){lo[k][0],lo[k][1],lo[k][2],lo[k][3],hi[k][0],hi[k][1],hi[k][2],hi[k][3]}
    o[d0]=__builtin_amdgcn_mfma_f32_32x32x16_bf16(pa0,PK(0),o[d0],0,0,0);
    o[d0]=__builtin_amdgcn_mfma_f32_32x32x16_bf16(pa1,PK(1),o[d0],0,0,0);
    o[d0]=__builtin_amdgcn_mfma_f32_32x32x16_bf16(pa2,PK(2),o[d0],0,0,0);
    o[d0]=__builtin_amdgcn_mfma_f32_32x32x16_bf16(pa3,PK(3),o[d0],0,0,0);
    #undef PK
  }
}

#ifndef ATTN_STORE16
#define ATTN_STORE16(p,v) (*(u32x4*)(p)=(v))
#endif
template<int THRL> __device__ __forceinline__ void attn_unit(int b,int h,int qb,const bf16*Q,const bf16*__restrict__ K,const bf16*__restrict__ V,bf16*O,const unsigned*__restrict__ MASK,const float*__restrict__ relb,char*shm){
  int tid0_=threadIdx.x; asm volatile("":"+v"(tid0_));
  const int tid=tid0_,lane=tid&63,r32=lane&31,hi=lane>>5; const int wid=__builtin_amdgcn_readfirstlane(tid>>6);
  const long rowbase=(long)b*SEQ; const int q0=qb*QB;
  const bf16*Qw=Q+(rowbase+q0+wid*QBLK)*DM+h*D;
  const bf16*Kh=K+rowbase*DM+h*D,*Vh=V+rowbase*DM+h*D;
  const unsigned lds0=(unsigned)(uintptr_t)shm;
  float*wsf=(float*)(shm+LDS_WS)+wid*64;
  const bf16*ksrc=Kh+(long)lane*DM+wid*8;
  const bf16*vsrc=Vh+(long)(16*(wid&3)+(lane>>2))*DM+(wid>>2)*32+(lane&3)*8;
  const unsigned kdst=lds0+LDS_K+wid*1024, vdst=lds0+LDS_V+wid*1024;
  #define DMA_K(t,slot) glds16(ksrc+(long)(t)*KVBLK*DM,(unsigned)__builtin_amdgcn_readfirstlane(kdst+(slot)))
  #define DMA_V(t,slot) glds16(vsrc+(long)(t)*KVBLK*DM,(unsigned)__builtin_amdgcn_readfirstlane(vdst+(slot)))
  const int vb0=(int)(lds0+LDS_V)+((lane>>4)&1)*32+(lane&3)*8+(4*hi+((lane&15)>>2))*64;
  const char*Kbase=shm+LDS_K; bf16x8 kf[8];
  const lds_cptr shm3=(lds_cptr)shm; const lds_cptr kp0=shm3+LDS_K+hi*1024+r32*16; const lds_cptr vp0=shm3+LDS_V+((lane>>4)&1)*32+(lane&3)*8+(4*hi+((lane&15)>>2))*64;
  const int NT=(q0+QB)/KVBLK;
  { int tid_=tid; asm volatile("":"+v"(tid_));
    const u32x4*msrc=(const u32x4*)(MASK+((size_t)(b*32)*SEQ+q0)*2); u32x4*mdst=(u32x4*)(shm+LDS_MSK);
    u32x4 mv[8]; const int nit=NT>>2;
    _Pragma("unroll") for(int k=0;k<8;++k){ const int i=tid_+k*(NW*64); if(k<nit) mv[k]=msrc[(size_t)(i>>7)*(SEQ*2/4)+(i&127)]; }
    _Pragma("unroll") for(int k=0;k<8;++k){ const int i=tid_+k*(NW*64); if(k<nit) mdst[i]=mv[k]; }
    for(int i=tid_;i<4*272;i+=NW*64){ const int sft=i/272, k=i-sft*272, d=200-(k+sft); float v=0.f;
      if(d>=0&&d<=112){ int bk; if(d<16)bk=d; else { bk=16+(int)(logf((float)d*(1.0f/16.0f))/2.0794415416798357f*16.0f); bk=bk>31?31:bk; } v=(relb[bk*NHEAD+h]-relb[31*NHEAD+h])*1.4426950408889634f; }
      ((float*)(shm+LDS_TAB))[i]=v; } }
  const unsigned*mskw=(const unsigned*)(shm+LDS_MSK)+(wid*QBLK+r32)*2+hi;
  const int qpos=q0+wid*QBLK+r32;
  DMA_K(0,0);DMA_V(0,0);DMA_K(1,SLOTB);
  bf16x8 qr[4];
  #pragma unroll
  for(int d0=0;d0<4;++d0)qr[d0]=*reinterpret_cast<const bf16x8*>(&Qw[(long)r32*DM+d0*16+hi*8]);
  float mhat=0.f,l_reg=0.f;f32x16 o[2];o[0]=f32x16{};o[1]=f32x16{};f32x16 negm=f32x16{};asm volatile("":"+v"(negm));
  #define CMASK(P0,P1,t) do{ if((t)>=NT-7 && 64*(t)+63+127>=q0+wid*QBLK) tbias(P0,P1,(t),qpos,hi,shm3+LDS_TAB); }while(0)
  bool resc=false;
  #define START(P0,P1) do{ const float rm=rowmax(P0,P1); resc=false; \
    { const float dl=rm; mhat=fadd_s(mhat,dl); \
      _Pragma("unroll") for(int r=0;r<16;++r){P0[r]=fsub_s(P0[r],dl);P1[r]=fsub_s(P1[r],dl);} \
      _Pragma("unroll") for(int r=0;r<16;++r)negm[r]=-mhat; asm volatile("":"+v"(negm)); } \
    _Pragma("unroll") for(int r=0;r<16;++r)P0[r]=__builtin_amdgcn_exp2f(P0[r]); }while(0)
  #define RESC() do{ if(resc){ asm volatile("s_waitcnt lgkmcnt(0)":::"memory"); \
      _Pragma("unroll") for(int d_=0;d_<2;++d_) _Pragma("unroll") for(int r=0;r<16;++r)o[d_][r]*=wsf[crow(r,hi)]; } }while(0)
  f32x16 pA0,pA1,pB0,pB1;
  int sl_prev=0,sl_cur=0,sl_next=SLOTB;
  #define ROT() do{sl_prev=sl_cur;sl_cur=sl_next;sl_next=(sl_next==(NSLOT-1)*SLOTB)?0:sl_next+SLOTB;}while(0)
  DMA_K(2,2*SLOTB);
  WAIT_BAR(3);
  qkt(pA0,pA1,Kbase,qr,negm,r32,hi);asm volatile("s_nop 15\n\ts_nop 7":"+v"(pA0),"+v"(pA1));CMASK(pA0,pA1,0);
  START(pA0,pA1);
  _Pragma("unroll") for(int r=0;r<16;++r)pA1[r]=__builtin_amdgcn_exp2f(pA1[r]);
  { const unsigned mw0=mskw[0]; _Pragma("unroll") for(int r=0;r<16;++r){pA0[r]=mkeep(pA0[r],mw0,r);pA1[r]=mkeep(pA1[r],mw0,16+r);} }
  WAIT_BAR(0);
  DMA_K(3,0);DMA_V(1,SLOTB);
  ROT();
  kload8(kf,kp0+sl_cur);
  WAIT_BAR(2);
  s16x4 vlo[8],vhi[8]; u32x4 pw0,pw1,pw2,pw3;
  #define PKW(P,B) cvtpk_s(P[B],P[B+1])
  #define PAF(k) __builtin_bit_cast(bf16x8,pw##k)
  #define VFR(i) (bf16x8){vlo[i][0],vlo[i][1],vlo[i][2],vlo[i][3],vhi[i][0],vhi[i][1],vhi[i][2],vhi[i][3]}
  #define PIN(x) asm volatile("":"+v"(x))
  #define MX3(a,b,c) __builtin_fmaxf(__builtin_fmaxf((a),(b)),(c))
  #define GAPA(MF,A0,A1,A2,A3,W0,W1,PW) do{ MF; sacc+=A0; sacc+=A1; sacc+=A2; sacc+=A3; PIN(sacc); W0; W1; PIN(PW); SBAR(); }while(0)
  #define EX(v) __builtin_amdgcn_exp2f(v)
  #define GAPB(MF,X,B,MB) do{ MF; X[B]=mkeep(EX(X[B]),mw_,MB+B); X[B+1]=mkeep(EX(X[B+1]),mw_,MB+B+1); X[B+2]=mkeep(EX(X[B+2]),mw_,MB+B+2); X[B+3]=mkeep(EX(X[B+3]),mw_,MB+B+3); PIN(X); SBAR(); }while(0)
  #define VRD(i) do{ vlo[i]=vtr(vp_+(((i)>>2)*4096+((i)&3)*1024)); vhi[i]=vtr(vp_+(((i)>>2)*4096+((i)&3)*1024+512)); }while(0)
  #define KRD(G,j) do{ if(G){ kload2(kf,kp0+sl_next,j); SBAR(); } }while(0)
  #define STEP(C0,C1,P0,P1,t,GK,GV,GL) do{ SBAR(); \
    const lds_cptr vp_=vp0+sl_prev; const unsigned mw_=mskw[(t)*512]; \
    VRD(0); SBAR(); float sacc=(P0[0]+P0[1]); \
    GAPA(C0=__builtin_amdgcn_mfma_f32_32x32x16_bf16(kf[0],qr[0],negm,0,0,0), P0[2],P0[3],P0[4],P0[5],     pw0[0]=PKW(P0,0), pw0[1]=PKW(P0,2), pw0); \
    VRD(4); SBAR(); GAPA(C1=__builtin_amdgcn_mfma_f32_32x32x16_bf16(kf[1],qr[0],negm,0,0,0), P0[6],P0[7],P0[8],P0[9],     pw0[2]=PKW(P0,4), pw0[3]=PKW(P0,6), pw0); \
    VRD(1); SBAR(); GAPA(C0=__builtin_amdgcn_mfma_f32_32x32x16_bf16(kf[2],qr[1],C0,0,0,0),   P0[10],P0[11],P0[12],P0[13], pw1[0]=PKW(P0,8), pw1[1]=PKW(P0,10), pw1); \
    VRD(5); SBAR(); GAPA(C1=__builtin_amdgcn_mfma_f32_32x32x16_bf16(kf[3],qr[1],C1,0,0,0),   P0[14],P0[15],P1[0],P1[1],   pw1[2]=PKW(P0,12),pw1[3]=PKW(P0,14), pw1); \
    VRD(2); SBAR(); GAPA(C0=__builtin_amdgcn_mfma_f32_32x32x16_bf16(kf[4],qr[2],C0,0,0,0),   P1[2],P1[3],P1[4],P1[5],     pw2[0]=PKW(P1,0), pw2[1]=PKW(P1,2), pw2); \
    VRD(6); SBAR(); GAPA(C1=__builtin_amdgcn_mfma_f32_32x32x16_bf16(kf[5],qr[2],C1,0,0,0),   P1[6],P1[7],P1[8],P1[9],     pw2[2]=PKW(P1,4), pw2[3]=PKW(P1,6), pw2); \
    VRD(3); SBAR(); GAPA(C0=__builtin_amdgcn_mfma_f32_32x32x16_bf16(kf[6],qr[3],C0,0,0,0),   P1[10],P1[11],P1[12],P1[13], pw3[0]=PKW(P1,8), pw3[1]=PKW(P1,10), pw3); \
    VRD(7); SBAR(); GAPA(C1=__builtin_amdgcn_mfma_f32_32x32x16_bf16(kf[7],qr[3],C1,0,0,0),   P1[14],P1[15],0.f,0.f,       pw3[2]=PKW(P1,12),pw3[3]=PKW(P1,14), pw3); \
    l_reg+=sacc; \
    if(GK){DMA_K((t)+3,sl_cur);} if(GV){DMA_V((t)+1,sl_next);} \
    CMASK(C0,C1,t); \
    { float a=MX3(C0[0],C0[1],C1[0]),b=MX3(C0[2],C0[3],C1[1]); a=MX3(a,C1[2],C1[3]); \
      _Pragma("unroll") for(int r=4;r<16;r+=4){a=MX3(a,C0[r],C0[r+1]);b=MX3(b,C0[r+2],C0[r+3]);a=MX3(a,C1[r],C1[r+1]);b=MX3(b,C1[r+2],C1[r+3]);} \
      float rm=__builtin_fmaxf(a,b); { auto rr=__builtin_amdgcn_permlane32_swap(__float_as_uint(rm),__float_as_uint(rm),false,false); rm=__builtin_fmaxf(__uint_as_float(rr[0]),__uint_as_float(rr[1])); } \
      resc=false; \
      if(__builtin_expect(__any(rm>(float)THRL),0)){ const float dl=__builtin_fmaxf(rm,0.f); mhat+=dl; \
        _Pragma("unroll") for(int r=0;r<16;++r){C0[r]-=dl;C1[r]-=dl;} \
        _Pragma("unroll") for(int r=0;r<16;++r)negm[r]=-mhat; asm volatile("":"+v"(negm)); \
        const float f=__builtin_amdgcn_exp2f(-dl); l_reg*=f; if(hi==0)wsf[r32]=f; resc=true; } } \
    SBAR(); \
    GAPB(o[0]=__builtin_amdgcn_mfma_f32_32x32x16_bf16(PAF(0),VFR(0),o[0],0,0,0), C0,0,0); \
    GAPB(o[1]=__builtin_amdgcn_mfma_f32_32x32x16_bf16(PAF(0),VFR(4),o[1],0,0,0), C0,4,0); \
    KRD(GL,0); GAPB(o[0]=__builtin_amdgcn_mfma_f32_32x32x16_bf16(PAF(1),VFR(1),o[0],0,0,0), C0,8,0); \
    KRD(GL,1); GAPB(o[1]=__builtin_amdgcn_mfma_f32_32x32x16_bf16(PAF(1),VFR(5),o[1],0,0,0), C0,12,0); \
    KRD(GL,2); GAPB(o[0]=__builtin_amdgcn_mfma_f32_32x32x16_bf16(PAF(2),VFR(2),o[0],0,0,0), C1,0,16); \
    KRD(GL,3); GAPB(o[1]=__builtin_amdgcn_mfma_f32_32x32x16_bf16(PAF(2),VFR(6),o[1],0,0,0), C1,4,16); \
    GAPB(o[0]=__builtin_amdgcn_mfma_f32_32x32x16_bf16(PAF(3),VFR(3),o[0],0,0,0), C1,8,16); \
    GAPB(o[1]=__builtin_amdgcn_mfma_f32_32x32x16_bf16(PAF(3),VFR(7),o[1],0,0,0), C1,12,16); \
    }while(0)
  int t=1;
  #undef CMASK
  #define CMASK(P0,P1,t) do{}while(0)
  for(;t+7<NT;t+=2){
    STEP(pB0,pB1,pA0,pA1,t,true,true,true);     WAIT_BAR(2); RESC(); ROT();
    STEP(pA0,pA1,pB0,pB1,t+1,true,true,true);   WAIT_BAR(2); RESC(); ROT();
  }
  #undef CMASK
  #define CMASK(P0,P1,t) do{ if(64*(t)+63+127>=q0+wid*QBLK) tbias(P0,P1,(t),qpos,hi,shm3+LDS_TAB); }while(0)
  #define ENDW(tt) do{ if((tt)+3<NT){WAIT_BAR(2);} else if((tt)+2<NT){WAIT_BAR(1);} else {WAIT_BAR(0);} }while(0)
  for(;t+1<NT;t+=2){
    STEP(pB0,pB1,pA0,pA1,t,(t+3<NT),(t+1<NT),(t+1<NT));       ENDW(t);   RESC(); ROT();
    STEP(pA0,pA1,pB0,pB1,t+1,(t+4<NT),(t+2<NT),(t+2<NT));     ENDW(t+1); RESC(); ROT();
  }
  STEP(pB0,pB1,pA0,pA1,NT-1,false,false,false); RESC();
  { float sacc=pB0[0]+pB0[1]; _Pragma("unroll") for(int r=2;r<16;++r)sacc+=pB0[r]; _Pragma("unroll") for(int r=0;r<16;++r)sacc+=pB1[r]; l_reg+=sacc;
    pw0=(u32x4){PKW(pB0,0),PKW(pB0,2),PKW(pB0,4),PKW(pB0,6)};pw1=(u32x4){PKW(pB0,8),PKW(pB0,10),PKW(pB0,12),PKW(pB0,14)};pw2=(u32x4){PKW(pB1,0),PKW(pB1,2),PKW(pB1,4),PKW(pB1,6)};pw3=(u32x4){PKW(pB1,8),PKW(pB1,10),PKW(pB1,12),PKW(pB1,14)};
    SBAR(); pv(o,vb0+sl_cur,PAF(0),PAF(1),PAF(2),PAF(3)); }
  #undef PKW
  #undef PAF
  #undef VFR
  #undef PIN
  #undef MX3
  #undef GAPA
  #undef GAPB
  #undef EX
  #undef VRD
  #undef KRD
  #undef STEP
  #undef ENDW
  {auto rr=__builtin_amdgcn_permlane32_swap(__float_as_uint(l_reg),__float_as_uint(l_reg),false,false);l_reg=__uint_as_float(rr[0])+__uint_as_float(rr[1]);}
  if(hi==0)wsf[32+r32]=l_reg;asm volatile("s_waitcnt lgkmcnt(0)":::"memory");
  float rli[16];
  #pragma unroll
  for(int r=0;r<16;++r)rli[r]=__builtin_amdgcn_rcpf(wsf[32+crow(r,hi)]);
  bf16*Ow=O+(rowbase+q0+wid*QBLK)*PO+h*D;
  { bf16*stg=(bf16*)(shm+LDS_OST)+wid*2048;
    #pragma unroll
    for(int r=0;r<16;++r){const int orow=crow(r,hi);
      #pragma unroll
      for(int d0=0;d0<2;++d0)stg[orow*64+d0*32+r32]=__float2bfloat16(o[d0][r]*rli[r]);}
    asm volatile("s_waitcnt lgkmcnt(0)":::"memory");
    #pragma unroll
    for(int i=0;i<4;++i){const int row=i*8+(lane>>3),ch=lane&7; const u32x4 v=*(const u32x4*)(stg+row*64+ch*8); ATTN_STORE16(Ow+(long)row*PO+ch*8,v);} }
  asm volatile("s_waitcnt lgkmcnt(0)\n\ts_barrier":::"memory");
  #undef DMA_K
  #undef DMA_V
  #undef CMASK
  #undef START
  #undef RESC
  #undef ROT
}
struct AttnTensors { const bf16* Q; const bf16* K; const bf16* V; bf16* O; const unsigned* MASK; const float* relb; };
struct AttnUnit { int bh; int qb; };
constexpr int ATTN_LDS_BYTES=LDS_TOTAL;
#undef SBAR
#undef WAIT_BAR
}
constexpr int NWAVES = 8;
#ifndef MK_N_LAUNCHES
#define MK_N_LAUNCHES 1
#endif
constexpr int PER_PHASE = 10;
constexpr int N_LAUNCHES = (MK_N_LAUNCHES == 1) ? 1 : PER_PHASE;
constexpr int M = 8 * 2048;
constexpr size_t MiB = 1u << 20;
constexpr size_t WS_CTL = 0, CTL_ZERO_BYTES = 65536;
constexpr size_t WS_RSTD1 = 1 * MiB, WS_ROWSS = 2 * MiB, WS_WR = 3 * MiB, WS_BLAST = 3 * MiB + 512 * 1024, WS_TOKINFO = 4 * MiB, WS_LISTS = 5 * MiB, WS_LSC = 7 * MiB;
constexpr size_t WS_WO = 16 * MiB, WS_WGU = 18 * MiB, WS_WD = 50 * MiB, WS_XB = 66 * MiB, WS_MASK = 66 * MiB, WS_SB = 70 * MiB, WS_WIN = 98 * MiB;
constexpr size_t WS_QN = 106 * MiB, WS_KN = 122 * MiB, WS_VN = 138 * MiB, WS_XN2 = 106 * MiB, WS_IQ = 154 * MiB, WS_MISC = 162 * MiB, WS_QB = 164 * MiB, WS_KB = 172 * MiB, WS_VB = 180 * MiB, WS_RG = 196 * MiB;
constexpr size_t WS_MIX = 212 * MiB, WS_HID = 138 * MiB, WS_Y = 158 * MiB, WS_END = 244 * MiB;
constexpr int CW_TMO = 0, CW_CODE = 1, CW_BAR = 4096, CW_CNT = 15360;
constexpr int RING_BYTES = 154624;
constexpr int LDSCTL_OFF = RING_BYTES, MISC_OFF = LDSCTL_OFF, TOFF_OFF = LDSCTL_OFF + 256;
constexpr int LDS_BYTES = RING_BYTES + 1024;
static_assert(attn_body::ATTN_LDS_BYTES <= RING_BYTES, "attention LDS");
#ifndef REP_IDX
#define REP_IDX 1
#endif
#ifndef REP_GLAA
#define REP_GLAA 1
#endif
#ifndef REP_ATT
#define REP_ATT 1
#endif
#ifndef REP_GLAC
#define REP_GLAC 1
#endif
#ifndef REP_IDX_SCORE
#define REP_IDX_SCORE 1
#endif
#ifndef REP_IDX_SEL
#define REP_IDX_SEL 1
#endif
#ifndef REP_SEL_A
#define REP_SEL_A 1
#endif
#ifndef REP_SEL_B
#define REP_SEL_B 1
#endif
#ifndef REP_SEL_C
#define REP_SEL_C 1
#endif
#ifndef REP_SEL_CNT
#define REP_SEL_CNT 1
#endif
#ifndef REP_SEL_ST
#define REP_SEL_ST 1
#endif
#define GAS __attribute__((address_space(1)))
#define LAS __attribute__((address_space(3)))
typedef unsigned short bf16;
typedef unsigned v4u __attribute__((ext_vector_type(4)));
typedef float f32x4 __attribute__((ext_vector_type(4)));
typedef short bf16x8 __attribute__((ext_vector_type(8)));
typedef GAS unsigned gu32;
typedef GAS unsigned long long gu64;
#define RLX_AGENT __ATOMIC_RELAXED, __HIP_MEMORY_SCOPE_AGENT
#define LDS_WAIT() asm volatile("s_waitcnt lgkmcnt(0)" ::: "memory")
#define VM_WAIT() asm volatile("s_waitcnt vmcnt(0)" ::: "memory")
__device__ __forceinline__ unsigned long long rt() { return __builtin_amdgcn_s_memrealtime(); }
__device__ __forceinline__ unsigned f2bf(float f) { unsigned u = __builtin_bit_cast(unsigned, f); return (u + 0x7fffu + ((u >> 16) & 1u)) >> 16; }
__device__ __forceinline__ unsigned pk2(float lo, float hi) { return f2bf(lo) | (f2bf(hi) << 16); }

#define XB_TMO      128
#define XB_XCNT(j)  (256  + 64 * (j))
#define XB_XSUB(j)  (1280 + 64 * (j))
#define XB_XGEN(j)  (2304 + 64 * (j))
#define XB_TOP      3328
#define XB_TOPGEN   3392
#define XCD_BAR_WORDS 3456
#define XB_SPIN_CAP (1u << 18)

__device__ __forceinline__ unsigned xb_ld(unsigned* p)              { return __hip_atomic_load(p, __ATOMIC_RELAXED, __HIP_MEMORY_SCOPE_AGENT); }
__device__ __forceinline__ unsigned xb_add(unsigned* p, unsigned v) { return __hip_atomic_fetch_add(p, v, __ATOMIC_RELAXED, __HIP_MEMORY_SCOPE_AGENT); }
__device__ __forceinline__ unsigned xb_xcc_id() { return (unsigned)__builtin_amdgcn_s_getreg((3 << 11) | 20) & 0xFu; }
#define XB_SPIN(cond, bar) do { unsigned _sp = 0; while (cond) { __builtin_amdgcn_s_sleep(1); \
    if ((++_sp & 255u) == 0u) { if (xb_ld(&(bar)[XB_TMO])) break; if (_sp > XB_SPIN_CAP) { atomicAdd(&(bar)[XB_TMO], 1u); break; } } } } while (0)

struct XcdBarrier {
    unsigned* bar; unsigned x;
    volatile LAS unsigned* st;
};

__device__ __forceinline__ XcdBarrier xcd_barrier_post(unsigned* bar, volatile LAS unsigned* st) {
    XcdBarrier b; b.bar = bar; b.x = xb_xcc_id(); b.st = st;
    if (threadIdx.x == 0) (void)xb_add(&bar[XB_XCNT(b.x)], 1u);
    return b;
}
__device__ __forceinline__ void xcd_barrier_complete(unsigned* bar, unsigned x, unsigned& nloc, unsigned& nx) {
    const unsigned G = gridDim.x * gridDim.y * gridDim.z;
    unsigned sum, cnt, mine, sp = 0u;
    for (;;) {
        sum = 0u; cnt = 0u; mine = 0u;
#pragma unroll
        for (unsigned j = 0; j < 16; ++j) { const unsigned c = xb_ld(&bar[XB_XCNT(j)]); sum += c; cnt += (c > 0u) ? 1u : 0u; mine = (j == x) ? c : mine; }
        if (sum == G) break;
        __builtin_amdgcn_s_sleep(1);
        if ((++sp & 255u) == 0u) { if (xb_ld(&bar[XB_TMO])) break; if (sp > XB_SPIN_CAP) { atomicAdd(&bar[XB_TMO], 1u); break; } }
    }
    nloc = mine > 0u ? mine : 1u; nx = cnt > 0u ? cnt : 1u;
}

__device__ __forceinline__ void xcd_barrier(const XcdBarrier& b) {
    asm volatile("s_waitcnt vmcnt(0)" ::: "memory");
    __syncthreads();
    if (threadIdx.x == 0) {
        unsigned* bar = b.bar;
        __builtin_amdgcn_s_waitcnt(0);
        unsigned nloc = b.st[0], nx = b.st[1];
        if (nloc == 0u) { xcd_barrier_complete(bar, b.x, nloc, nx); b.st[0] = nloc; b.st[1] = nx; }
        const unsigned old = xb_add(&bar[XB_XSUB(b.x)], 1u);
        const unsigned gen = old / nloc;
        if (old + 1u == (gen + 1u) * nloc) {
            __builtin_amdgcn_fence(__ATOMIC_RELEASE, "agent");
            asm volatile("s_waitcnt vmcnt(0)" ::: "memory");
            const unsigned og = xb_add(&bar[XB_TOP], 1u);
            const unsigned tg = og / nx;
            if (og + 1u == (tg + 1u) * nx) xb_add(&bar[XB_TOPGEN], 1u);
            else XB_SPIN(xb_ld(&bar[XB_TOPGEN]) == tg, bar);
            __builtin_amdgcn_fence(__ATOMIC_ACQUIRE, "agent");
            xb_add(&bar[XB_XGEN(b.x)], 1u);
            asm volatile("s_waitcnt vmcnt(0)" ::: "memory");
        } else {
            XB_SPIN(xb_ld(&bar[XB_XGEN(b.x)]) == gen, bar);
            __builtin_amdgcn_fence(__ATOMIC_ACQUIRE, "agent");
            asm volatile("s_waitcnt vmcnt(0)" ::: "memory");
        }
    }
    __syncthreads();
}
typedef float f32x2 __attribute__((ext_vector_type(2)));
typedef unsigned v2u __attribute__((ext_vector_type(2)));
__device__ __forceinline__ float bf2f(unsigned short b) { return __uint_as_float((unsigned)b << 16); }
__device__ __forceinline__ float bflo(unsigned w) { return __uint_as_float(w << 16); }
__device__ __forceinline__ float bfhi(unsigned w) { return __uint_as_float(w & 0xffff0000u); }
__device__ __forceinline__ float wave_sum(float v) {
#pragma unroll
    for (int o = 1; o < 64; o <<= 1) v += __shfl_xor(v, o);
    return v;
}
__device__ __forceinline__ float wave_max(float v) {
#pragma unroll
    for (int o = 1; o < 64; o <<= 1) v = fmaxf(v, __shfl_xor(v, o));
    return v;
}
__device__ __forceinline__ float wave_min(float v) {
#pragma unroll
    for (int o = 1; o < 64; o <<= 1) v = fminf(v, __shfl_xor(v, o));
    return v;
}
#define WG_SYNC() __syncthreads()
#define DPP_STEP_I(v, ctrl) __builtin_amdgcn_update_dpp(0, (v), (ctrl), 0xF, 0xF, false)
__device__ __forceinline__ int wave_isum(int v) {
    v += DPP_STEP_I(v, 0xB1); v += DPP_STEP_I(v, 0x4E); v += DPP_STEP_I(v, 0x141); v += DPP_STEP_I(v, 0x140);
    return __builtin_amdgcn_readlane(v, 0) + __builtin_amdgcn_readlane(v, 16) + __builtin_amdgcn_readlane(v, 32) + __builtin_amdgcn_readlane(v, 48);
}
#define DPP_STEP_F(v, ctrl) __uint_as_float((unsigned)__builtin_amdgcn_update_dpp(0, (int)__float_as_uint(v), (ctrl), 0xF, 0xF, false))
#define RDL_F(v, l) __uint_as_float((unsigned)__builtin_amdgcn_readlane((int)__float_as_uint(v), (l)))
__device__ __forceinline__ float wave_fsum(float v) {
    v += DPP_STEP_F(v, 0xB1); v += DPP_STEP_F(v, 0x4E); v += DPP_STEP_F(v, 0x141); v += DPP_STEP_F(v, 0x140);
    return (RDL_F(v, 0) + RDL_F(v, 16)) + (RDL_F(v, 32) + RDL_F(v, 48));
}
__device__ __forceinline__ float wave_fmax(float v) {
    v = fmaxf(v, DPP_STEP_F(v, 0xB1)); v = fmaxf(v, DPP_STEP_F(v, 0x4E)); v = fmaxf(v, DPP_STEP_F(v, 0x141)); v = fmaxf(v, DPP_STEP_F(v, 0x140));
    return fmaxf(fmaxf(RDL_F(v, 0), RDL_F(v, 16)), fmaxf(RDL_F(v, 32), RDL_F(v, 48)));
}
__device__ __forceinline__ float wave_fmin(float v) {
    v = fminf(v, DPP_STEP_F(v, 0xB1)); v = fminf(v, DPP_STEP_F(v, 0x4E)); v = fminf(v, DPP_STEP_F(v, 0x141)); v = fminf(v, DPP_STEP_F(v, 0x140));
    return fminf(fminf(RDL_F(v, 0), RDL_F(v, 16)), fminf(RDL_F(v, 32), RDL_F(v, 48)));
}

__device__ __forceinline__ int win_vrow(int n) {
    if (n < 1024) { const int base = (n < 512) ? 0 : 512, m = n - base, hh = m >> 6, d = m & 63; return base + 256 * (hh >> 2) + 128 * (d >> 5) + 32 * (hh & 3) + (d & 31); }
    if (n < 1792) return n;
    if (n < 1832) return 3328 + (n - 1792);
    if (n < 2088) return 1792 + (n - 1832);
    if (n < 2344) return 2048 + (n - 2088);
    if (n < 2856) return 2304 + (n - 2344);
    if (n < 2872) return 3328 + 40 + (n - 2856);
    return 2816 + (n - 2872);
}
template <int KIND>
__device__ __forceinline__ void p0_transpose_item(const float* __restrict__ W, int K, int N, const float* __restrict__ gain, bf16* WT, LAS float* scr, int item, int lane) {
    const int nblk = (N + 31) / 32, kb = item / nblk, nb = item % nblk, k0 = 64 * kb, n0 = 32 * nb;
    f32x4 v[8];
#pragma unroll
    for (int j = 0; j < 8; ++j) { const int i = lane + 64 * j, kk = i >> 3, c4 = (i & 7) * 4; v[j] = (n0 + c4 < N) ? *(const f32x4*)(W + (size_t)(k0 + kk) * N + n0 + c4) : (f32x4){0.f, 0.f, 0.f, 0.f}; }
#pragma unroll
    for (int j = 0; j < 8; ++j) { const int i = lane + 64 * j, kk = i >> 3, c4 = (i & 7) * 4; f32x4 x = v[j]; if (gain) x = x * gain[k0 + kk];
        scr[kk * 33 + c4] = x[0]; scr[kk * 33 + c4 + 1] = x[1]; scr[kk * 33 + c4 + 2] = x[2]; scr[kk * 33 + c4 + 3] = x[3]; }
    LDS_WAIT(); asm volatile("" ::: "memory");
    const int c = lane & 7;
#pragma unroll
    for (int j = 0; j < 4; ++j) { const int n = (lane >> 3) + 8 * j; const LAS float* s = scr + (8 * c) * 33 + n;
        v4u o; o.x = pk2(s[0 * 33], s[1 * 33]); o.y = pk2(s[2 * 33], s[3 * 33]); o.z = pk2(s[4 * 33], s[5 * 33]); o.w = pk2(s[6 * 33], s[7 * 33]);
        const int gn = n0 + n; int row;
        if (KIND == 0) row = win_vrow(gn); else if (KIND == 1) row = gn; else if (KIND == 2) row = (gn >> 7) * 256 + (gn & 127); else row = (gn >> 7) * 256 + 128 + (gn & 127);
        if (gn < N) *(GAS v4u*)(WT + (size_t)row * K + k0 + 8 * c) = o; }
    LDS_WAIT(); asm volatile("" ::: "memory");
}

constexpr int SCP = 2064;
__device__ __forceinline__ int crow_(int r, int hi) { return (r & 3) + 8 * (r >> 2) + 4 * hi; }
__device__ __forceinline__ void idx_item(LAS unsigned char* lds, int b, int p, const bf16* __restrict__ IQ, const bf16* __restrict__ MISC, unsigned* __restrict__ MASK, int lane, int wid) {
    const int q0 = p * 16, fr = lane & 15, fq = lane >> 4;
    LAS float* SC = (LAS float*)lds;
    const size_t rowq = (size_t)b * 2048 + q0 + fr;
    bf16x8 Bq[8]; float sinf[8];
    {   const v4u wraw = *(const v4u*)(MISC + rowq * 64 + 32);
        const unsigned wr_[4] = {wraw.x, wraw.y, wraw.z, wraw.w};
#pragma unroll
        for (int h = 0; h < 8; ++h) { const float w = ((h & 1) ? bfhi(wr_[h >> 1]) : bflo(wr_[h >> 1])) * 0.0625f;
            const v4u raw = *(const v4u*)(IQ + rowq * 256 + h * 32 + fq * 8);
            v4u o; o.x = pg8::cvt_pk_bf16(bflo(raw.x) * w, bfhi(raw.x) * w); o.y = pg8::cvt_pk_bf16(bflo(raw.y) * w, bfhi(raw.y) * w); o.z = pg8::cvt_pk_bf16(bflo(raw.z) * w, bfhi(raw.z) * w); o.w = pg8::cvt_pk_bf16(bflo(raw.w) * w, bfhi(raw.w) * w);
            Bq[h] = __builtin_bit_cast(bf16x8, o); sinf[h] = (w > 0.f) ? __builtin_inff() : -__builtin_inff(); } }
    const int nkt = p + 1;
    LAS int* const ROWCTR = (LAS int*)(lds + 16 * SCP * 4);
    if (wid == 0 && lane == 0) ROWCTR[0] = 0;
    const bf16* ikb = MISC + ((size_t)b * 2048 + fr) * 64 + fq * 8;
    for (int rep_ = 0; rep_ < REP_IDX_SCORE; ++rep_)
    for (int kt0 = wid; kt0 < nkt; kt0 += 32) {
        f32x4 acc[4]; bf16x8 A[4];
#pragma unroll
        for (int u = 0; u < 4; ++u) { const int kt = kt0 + 8 * u; acc[u] = (f32x4){0.f, 0.f, 0.f, 0.f}; if (kt < nkt) A[u] = *(const bf16x8*)(ikb + (size_t)kt * 16 * 64); else A[u] = (bf16x8){0, 0, 0, 0, 0, 0, 0, 0}; }
#pragma unroll
        for (int h = 0; h < 8; ++h)
#pragma unroll
            for (int u = 0; u < 4; ++u) { const f32x4 t = __builtin_amdgcn_mfma_f32_16x16x32_bf16(A[u], Bq[h], acc[u], 0, 0, 0);
#pragma unroll
                for (int i = 0; i < 4; ++i) acc[u][i] = __builtin_amdgcn_fmed3f(t[i], acc[u][i], sinf[h]); }
#pragma unroll
        for (int u = 0; u < 4; ++u) { const int kt = kt0 + 8 * u;
            if (kt < nkt) { if (kt == nkt - 1) {
#pragma unroll
                    for (int i = 0; i < 4; ++i) if (4 * fq + i > fr) acc[u][i] = -__builtin_inff(); }
                *(LAS f32x4*)(SC + fr * SCP + kt * 16 + 4 * fq) = acc[u]; } }
    }
    WG_SYNC();
    const int kap = 32 * ((lane >> 4) & 1) + crow_(lane & 15, lane >> 5);
#define IDX_COUNT(dst, expr) do { int cl__ = 0; _Pragma("unroll") for (int g__ = 0; g__ < 4; ++g__) if (8 * g__ < ntile) { _Pragma("unroll") for (int jj__ = 0; jj__ < 8; ++jj__) { const int j = 8 * g__ + jj__; cl__ += (expr) ? 1 : 0; } } \
        dst = wave_isum(cl__); } while (0)
#define IDX_UNI(v) __uint_as_float((unsigned)__builtin_amdgcn_readfirstlane((int)__float_as_uint(v)))
    for (;;) {
        int r = 0; if (lane == 0) r = __hip_atomic_fetch_add(ROWCTR, 1, __ATOMIC_RELAXED, __HIP_MEMORY_SCOPE_WORKGROUP);
        r = __builtin_amdgcn_readfirstlane(r); if (r >= 16) break;
        const int q = q0 + r, n = q + 1, ntile = (q >> 6) + 1, ngrp = (ntile + 7) >> 3;
        const float NINF = -__builtin_inff();
        float x[32]; unsigned vmask = 0u;
        for (int rpa = 0; rpa < REP_SEL_A; ++rpa) { int off_ = 0; asm volatile("" : "+v"(off_)); vmask = 0u;
#pragma unroll
        for (int j = 0; j < 32; ++j) x[j] = SC[r * SCP + 64 * j + kap + off_];
#pragma unroll
        for (int j = 0; j < 32; ++j) { const bool v = (64 * j + kap + off_) <= q; vmask |= v ? (1u << j) : 0u; x[j] = v ? x[j] : NINF; }
        }
        unsigned selm = vmask;
        for (int rpb = 0; rpb < REP_SEL_B; ++rpb) { asm volatile("" : "+v"(x[0]), "+v"(vmask)); selm = vmask;
        if (n > 256) {
            float mx = NINF, mn = __builtin_inff(), s1 = 0.f, s2 = 0.f;
#pragma unroll
            for (int g = 0; g < 4; ++g) if (g < ngrp) {
#pragma unroll
                for (int jj = 0; jj < 8; ++jj) { const int j = 8 * g + jj; const bool v = (vmask >> j) & 1u; const float xv = v ? x[j] : 0.f; mx = fmaxf(mx, x[j]); mn = fminf(mn, v ? x[j] : __builtin_inff()); s1 += xv; s2 += xv * xv; } }
            float hi = IDX_UNI(wave_fmax(mx)), lo = IDX_UNI(wave_fmin(mn));
            const float fn = (float)n, mu = wave_fsum(s1) / fn, var = fmaxf(wave_fsum(s2) / fn - mu * mu, 0.f);
            int c_lo = n, c_hi = 1;
            bool tie = false, found = false; float tv = hi, thr = hi; int need = 256;
            float mid; { const float pq = 256.0f / fn, pp = pq <= 0.5f ? pq : 1.0f - pq; const float t = sqrtf(-2.0f * __logf(pp)); float z = t - (2.30753f + 0.27061f * t) / (1.0f + t * (0.99229f + 0.04481f * t)); z = pq <= 0.5f ? z : -z; mid = IDX_UNI(mu + z * sqrtf(var)); }
            int side = 0;
            for (int it = 0; it < 40; ++it) {
                if (it > 0 || !(mid > lo && mid < hi)) {
                    mid = 0.5f * lo + 0.5f * hi;
                    if (side > -2 && side < 2) { const float fr_ = ((float)(c_lo - 256) + 0.5f) * __builtin_amdgcn_rcpf((float)(c_lo - c_hi)); const float m2 = lo + (hi - lo) * fr_; if (m2 > lo && m2 < hi) mid = m2; } else side = 0;
                    mid = IDX_UNI(mid);
                }
                if (!(mid > lo && mid < hi)) break;
                unsigned a0 = 0u, a1 = 0u;
#pragma unroll
                for (int g = 1; g >= 0; --g) if (g < ngrp) {
#pragma unroll
                    for (int jj = 7; jj >= 0; --jj) a0 = __builtin_amdgcn_alignbit(a0, __float_as_uint(x[8 * g + jj] - mid), 31); }
#pragma unroll
                for (int g = 3; g >= 2; --g) if (g < ngrp) {
#pragma unroll
                    for (int jj = 7; jj >= 0; --jj) a1 = __builtin_amdgcn_alignbit(a1, __float_as_uint(x[8 * g + jj] - mid), 31); }
                const int c = 64 * 8 * ngrp - wave_isum(__builtin_popcount(a0) + __builtin_popcount(a1));
                if (c == 256) { found = true; selm = vmask & ~(a0 | (a1 << 16)); thr = mid; break; }
                if (c > 256) { lo = mid; c_lo = c; side = side > 0 ? side + 1 : 1; } else { hi = mid; c_hi = c; side = side < 0 ? side - 1 : -1; }
            }
            if (!found) {
                IDX_COUNT(c_hi, x[j] >= hi);
                if (c_hi >= 256) { if (c_hi == 256) { thr = hi; found = true; } else { tie = true; tv = hi; need = 256; } }
                else for (int it = 0; it < 4096; ++it) {
                    float m = NINF;
#pragma unroll
                    for (int g = 0; g < 4; ++g) if (g < ngrp) {
#pragma unroll
                        for (int jj = 0; jj < 8; ++jj) { const int j = 8 * g + jj; m = fmaxf(m, (x[j] < hi) ? x[j] : NINF); } }
                    const float v1 = IDX_UNI(wave_fmax(m));
                    int c; IDX_COUNT(c, x[j] >= v1);
                    if (c >= 256) { if (c == 256) { thr = v1; found = true; } else { tie = true; tv = v1; need = 256 - c_hi; } break; }
                    hi = v1; c_hi = c;
                }
                if (!tie) { selm = 0u;
#pragma unroll
                    for (int j = 0; j < 32; ++j) selm |= (x[j] >= thr) ? (1u << j) : 0u;
                } else {
                    int cum = 0, jstar = 32, needp = 0; unsigned tiem = 0u; selm = 0u;
#pragma unroll
                    for (int j = 0; j < 32; ++j) { const bool t = (x[j] == tv); tiem |= t ? (1u << j) : 0u; const int cj = __builtin_popcountll(__ballot(t));
                        if (jstar == 32 && cum + cj > need) { jstar = j; needp = need - cum; } cum += cj; }
                    const bool tstar = (jstar < 32) && ((tiem >> (jstar & 31)) & 1u);
                    int kL = 0, kH = 63;
                    if (jstar < 32 && needp > 0) { while (kL < kH) { const int km = (kL + kH) >> 1; const int c = __builtin_popcountll(__ballot(tstar && kap <= km)); if (c >= needp) kH = km; else kL = km + 1; } }
                    else kL = -1;
#pragma unroll
                    for (int j = 0; j < 32; ++j) { const bool t = (tiem >> j) & 1u; const bool ts = t && (j < jstar || (j == jstar && kap <= kL)); selm |= (x[j] > tv || ts) ? (1u << j) : 0u; }
                }
            }
        }
        }
        unsigned wlo = 0u, whi = 0u;
        for (int rpc = 0; rpc < REP_SEL_C; ++rpc) { asm volatile("" : "+v"(selm));
#pragma unroll
        for (int j = 0; j < 32; ++j) { const unsigned long long bal = __ballot((selm >> j) & 1u); if (lane == j) { wlo = (unsigned)bal; whi = (unsigned)(bal >> 32); } }
        if (lane < 32) { v2u o; o.x = wlo; o.y = whi; *(v2u*)(MASK + (((size_t)(b * 32 + lane)) * 2048 + q) * 2) = o; }
        }
    }
#undef IDX_COUNT
#undef IDX_UNI
    WG_SYNC();
}

constexpr int KTP = 72;
constexpr int VRP = 136;
constexpr int EP = 68;
constexpr int OTP = 132;
constexpr int GL_OFF = 0, TOT_OFF = 4096, E_OFF = 6144, QA_OFF = 23552, KR_OFF = 32768, PM_OFF = 41984, VR_OFF = 51200, OT_OFF = 68608;
typedef short v4i16g __attribute__((ext_vector_type(4)));
__device__ __forceinline__ bf16x8 tr_frag(const LAS bf16* T, int pitch, int k0, int n0, int lane) {
    const int g = lane >> 4, q = (lane & 15) >> 2, p = lane & 3;
    const LAS bf16* a = T + (k0 + 8 * g + q) * pitch + n0 + 4 * p;
    const v4i16g lo = __builtin_amdgcn_ds_read_tr16_b64_v4i16((LAS v4i16g*)a), hi = __builtin_amdgcn_ds_read_tr16_b64_v4i16((LAS v4i16g*)(a + 4 * pitch));
    return (bf16x8){lo[0], lo[1], lo[2], lo[3], hi[0], hi[1], hi[2], hi[3]};
}
__device__ __forceinline__ float fexp(float x) { return __builtin_amdgcn_exp2f(x * 1.4426950408889634f); }
__device__ __forceinline__ float gla_decay(LAS unsigned char* lds, const bf16* __restrict__ MISC, const float* __restrict__ w2, const float* __restrict__ gb, size_t row0, int h, int tid) {
    LAS float* GL = (LAS float*)(lds + GL_OFF); LAS float* TOT = (LAS float*)(lds + TOT_OFF); LAS float* E = (LAS float*)(lds + E_OFF);
    const int d = tid & 63, tg = tid >> 6;
    { const int t = tid >> 3, r2 = (tid & 7) * 2; const unsigned w = *(const unsigned*)(MISC + (row0 + t) * 64 + 40 + r2); GL[t * 16 + r2] = bflo(w); GL[t * 16 + r2 + 1] = bfhi(w); }
    float wc[16];
#pragma unroll
    for (int r = 0; r < 16; ++r) wc[r] = w2[r * 256 + h * 64 + d];
    const float bias = gb[h * 64 + d];
    WG_SYNC();
    float bc[8]; float run = 0.f;
#pragma unroll
    for (int i = 0; i < 8; ++i) { const int t = 8 * tg + i; float z = bias;
#pragma unroll
        for (int r4 = 0; r4 < 4; ++r4) { const f32x4 g = *(const LAS f32x4*)(GL + t * 16 + 4 * r4); z += g[0] * wc[4 * r4] + g[1] * wc[4 * r4 + 1] + g[2] * wc[4 * r4 + 2] + g[3] * wc[4 * r4 + 3]; }
        const float ls = fminf(z, 0.f) - 0.6931471805599453f * __builtin_amdgcn_logf(1.0f + __builtin_amdgcn_exp2f(-1.4426950408889634f * fabsf(z)));
        run += ls * (1.0f / 16.0f); bc[i] = run; }
    TOT[tg * 64 + d] = run;
    WG_SYNC();
    float pre = 0.f, tot = 0.f;
#pragma unroll
    for (int g = 0; g < 8; ++g) { const float v = TOT[g * 64 + d]; tot += v; if (g < tg) pre += v; }
#pragma unroll
    for (int i = 0; i < 8; ++i) E[(8 * tg + i) * EP + d] = fexp(tot - (bc[i] + pre));
    return tot;
}
__device__ __forceinline__ void gla_load_v(LAS unsigned char* lds, const bf16* __restrict__ VB, size_t row0, int h, int tid) {
    LAS bf16* VR = (LAS bf16*)(lds + VR_OFF); const int t = tid >> 3, v0 = (tid & 7) * 16; const bf16* src = VB + (row0 + t) * 512 + h * 128 + v0;
    const v4u a = *(const v4u*)src, b = *(const v4u*)(src + 8);
    *(LAS v4u*)(VR + t * VRP + v0) = a; *(LAS v4u*)(VR + t * VRP + v0 + 8) = b;
}
__device__ __forceinline__ v4u scale8(v4u raw, const f32x4 e0, const f32x4 e1) {
    v4u o; o.x = pg8::cvt_pk_bf16(bflo(raw.x) * e0[0], bfhi(raw.x) * e0[1]); o.y = pg8::cvt_pk_bf16(bflo(raw.y) * e0[2], bfhi(raw.y) * e0[3]);
    o.z = pg8::cvt_pk_bf16(bflo(raw.z) * e1[0], bfhi(raw.z) * e1[1]); o.w = pg8::cvt_pk_bf16(bflo(raw.w) * e1[2], bfhi(raw.w) * e1[3]); return o;
}
__device__ __forceinline__ void gla_a_item(LAS unsigned char* lds, int id, const bf16* __restrict__ KB, const bf16* __restrict__ VB, const bf16* __restrict__ MISC, const float* __restrict__ w2, const float* __restrict__ gb,
                                           float* __restrict__ U, float* __restrict__ BLAST, int tid, int lane, int wid) {
    const int b = id >> 7, h = (id >> 5) & 3, c = id & 31; const size_t row0 = (size_t)b * 2048 + 64 * c;
    const v4u kraw = *(const v4u*)(KB + (row0 + (tid >> 3)) * 256 + h * 64 + (tid & 7) * 8);
    gla_load_v(lds, VB, row0, h, tid);
    const float blast = gla_decay(lds, MISC, w2, gb, row0, h, tid);
    if (tid < 64) BLAST[(size_t)id * 64 + tid] = blast;
    WG_SYNC();
    LAS bf16* KR = (LAS bf16*)(lds + KR_OFF); LAS bf16* VR = (LAS bf16*)(lds + VR_OFF); const LAS float* E = (const LAS float*)(lds + E_OFF);
    { const int t = tid >> 3, d8 = (tid & 7) * 8; const f32x4 e0 = *(const LAS f32x4*)(E + t * EP + d8), e1 = *(const LAS f32x4*)(E + t * EP + d8 + 4); *(LAS v4u*)(KR + t * KTP + d8) = scale8(kraw, e0, e1); }
    WG_SYNC();
    const int fr = lane & 15, fq = lane >> 4;
    bf16x8 Bf[2];
#pragma unroll
    for (int kk = 0; kk < 2; ++kk) Bf[kk] = tr_frag(VR, VRP, 32 * kk, 16 * wid, lane);
#pragma unroll
    for (int dt = 0; dt < 4; ++dt) { f32x4 acc = (f32x4){0.f, 0.f, 0.f, 0.f};
#pragma unroll
        for (int kk = 0; kk < 2; ++kk) { const bf16x8 Af = tr_frag(KR, KTP, 32 * kk, 16 * dt, lane); acc = __builtin_amdgcn_mfma_f32_16x16x32_bf16(Af, Bf[kk], acc, 0, 0, 0); }
        *(f32x4*)(U + ((size_t)id * 128 + 16 * wid + fr) * 64 + 16 * dt + 4 * fq) = acc; }
    WG_SYNC();
}
__device__ __forceinline__ void gla_b_item(int item, const float* __restrict__ U, const float* __restrict__ BLAST, bf16* __restrict__ SB, int tid) {
    const int bh = item >> 2, qt = item & 3; const size_t eoff = (size_t)qt * 2048 + (size_t)tid * 4; const int d0 = (tid * 4) & 63;
    f32x4 S = (f32x4){0.f, 0.f, 0.f, 0.f};
#pragma unroll 1
    for (int half = 0; half < 2; ++half) {
        f32x4 u[16], bl[16];
#pragma unroll
        for (int c = 0; c < 16; ++c) { const size_t id = (size_t)bh * 32 + 16 * half + c; u[c] = *(const f32x4*)(U + id * 8192 + eoff); bl[c] = *(const f32x4*)(BLAST + id * 64 + d0); }
#pragma unroll
        for (int c = 0; c < 16; ++c) { const size_t id = (size_t)bh * 32 + 16 * half + c;
            f32x4 e; e[0] = __expf(bl[c][0]); e[1] = __expf(bl[c][1]); e[2] = __expf(bl[c][2]); e[3] = __expf(bl[c][3]);
            const f32x4 sd = S * e; v2u o; o.x = pk2(sd[0], sd[1]); o.y = pk2(sd[2], sd[3]); *(v2u*)(SB + id * 8192 + eoff) = o; S = sd + u[c]; }
    }
}
__device__ __forceinline__ void gla_c_item(LAS unsigned char* lds, int id, const bf16* __restrict__ QB, const bf16* __restrict__ KB, const bf16* __restrict__ VB, const bf16* __restrict__ RG, const bf16* __restrict__ MISC,
                                           const float* __restrict__ w2, const float* __restrict__ gb, const float* __restrict__ og, const bf16* __restrict__ SB, bf16* __restrict__ MIX, int tid, int lane, int wid) {
    const int b = id >> 7, h = (id >> 5) & 3, c = id & 31; const size_t row0 = (size_t)b * 2048 + 64 * c;
    const int st_t = tid >> 3, st_d8 = (tid & 7) * 8;
    const v4u kraw = *(const v4u*)(KB + (row0 + st_t) * 256 + h * 64 + st_d8), qraw = *(const v4u*)(QB + (row0 + st_t) * 256 + h * 64 + st_d8);
    gla_load_v(lds, VB, row0, h, tid);
    const int fr = lane & 15, fq = lane >> 4;
    bf16x8 Bs[2];
    { const bf16* sbp = SB + ((size_t)id * 128 + 16 * wid + fr) * 64 + 8 * fq; Bs[0] = *(const bf16x8*)sbp; Bs[1] = *(const bf16x8*)(sbp + 32); }
    (void)gla_decay(lds, MISC, w2, gb, row0, h, tid);
    WG_SYNC();
    LAS bf16* QA = (LAS bf16*)(lds + QA_OFF); LAS bf16* KR = (LAS bf16*)(lds + KR_OFF); LAS bf16* PM = (LAS bf16*)(lds + PM_OFF); LAS bf16* VR = (LAS bf16*)(lds + VR_OFF);
    const LAS float* E = (const LAS float*)(lds + E_OFF); LAS float* OT = (LAS float*)(lds + OT_OFF);
    { const f32x4 e0 = *(const LAS f32x4*)(E + st_t * EP + st_d8), e1 = *(const LAS f32x4*)(E + st_t * EP + st_d8 + 4);
      f32x4 r0, r1;
#pragma unroll
      for (int i = 0; i < 4; ++i) { r0[i] = 0.125f * __builtin_amdgcn_rcpf(e0[i]); r1[i] = 0.125f * __builtin_amdgcn_rcpf(e1[i]); }
      *(LAS v4u*)(KR + st_t * KTP + st_d8) = scale8(kraw, e0, e1); *(LAS v4u*)(QA + st_t * KTP + st_d8) = scale8(qraw, r0, r1); }
    WG_SYNC();
    { const int tt = wid >> 1;
#pragma unroll
      for (int s2 = 0; s2 < 2; ++s2) { const int st = 2 * (wid & 1) + s2; f32x4 acc = (f32x4){0.f, 0.f, 0.f, 0.f};
        if (st <= tt) {
#pragma unroll
            for (int kk = 0; kk < 2; ++kk) { const bf16x8 Af = *(const LAS bf16x8*)(KR + (16 * st + fr) * KTP + 32 * kk + 8 * fq); const bf16x8 Bf = *(const LAS bf16x8*)(QA + (16 * tt + fr) * KTP + 32 * kk + 8 * fq);
                acc = __builtin_amdgcn_mfma_f32_16x16x32_bf16(Af, Bf, acc, 0, 0, 0); } }
        const int t = 16 * tt + fr, s0 = 16 * st + 4 * fq; v2u o;
        o.x = pg8::cvt_pk_bf16((s0 <= t) ? acc[0] : 0.f, (s0 + 1 <= t) ? acc[1] : 0.f); o.y = pg8::cvt_pk_bf16((s0 + 2 <= t) ? acc[2] : 0.f, (s0 + 3 <= t) ? acc[3] : 0.f);
        *(LAS v2u*)(PM + t * KTP + s0) = o; } }
    WG_SYNC();
    bf16x8 Bv[2];
#pragma unroll
    for (int kk = 0; kk < 2; ++kk) Bv[kk] = tr_frag(VR, VRP, 32 * kk, 16 * wid, lane);
#pragma unroll
    for (int tt = 0; tt < 4; ++tt) { f32x4 acc = (f32x4){0.f, 0.f, 0.f, 0.f};
#pragma unroll
        for (int kk = 0; kk < 2; ++kk) { const bf16x8 Ap = *(const LAS bf16x8*)(PM + (16 * tt + fr) * KTP + 32 * kk + 8 * fq); acc = __builtin_amdgcn_mfma_f32_16x16x32_bf16(Ap, Bv[kk], acc, 0, 0, 0);
                                         const bf16x8 Aq = *(const LAS bf16x8*)(QA + (16 * tt + fr) * KTP + 32 * kk + 8 * fq); acc = __builtin_amdgcn_mfma_f32_16x16x32_bf16(Aq, Bs[kk], acc, 0, 0, 0); }
#pragma unroll
        for (int i = 0; i < 4; ++i) OT[(16 * tt + 4 * fq + i) * OTP + 16 * wid + fr] = acc[i]; }
    WG_SYNC();
    { const int t = tid >> 3, v0 = (tid & 7) * 16; f32x4 ov[4]; float ss = 0.f;
#pragma unroll
      for (int k = 0; k < 4; ++k) { ov[k] = *(const LAS f32x4*)(OT + t * OTP + v0 + 4 * k); ss += (ov[k][0] * ov[k][0] + ov[k][1] * ov[k][1]) + (ov[k][2] * ov[k][2] + ov[k][3] * ov[k][3]); }
      ss += DPP_STEP_F(ss, 0xB1); ss += DPP_STEP_F(ss, 0x4E); ss += DPP_STEP_F(ss, 0x141);
      const float rs = __builtin_amdgcn_rsqf(ss * (1.0f / 128.0f) + 1e-6f);
      const bf16* rgp = RG + (row0 + t) * 512 + h * 128 + v0; const v4u ra = *(const v4u*)rgp, rb = *(const v4u*)(rgp + 8);
      const unsigned rw[8] = {ra.x, ra.y, ra.z, ra.w, rb.x, rb.y, rb.z, rb.w}; unsigned ow[8];
#pragma unroll
      for (int k = 0; k < 4; ++k) { const f32x4 g = *(const f32x4*)(og + v0 + 4 * k); float y[4];
#pragma unroll
          for (int i = 0; i < 4; ++i) { const unsigned w = rw[2 * k + (i >> 1)]; const float r = (i & 1) ? bfhi(w) : bflo(w); const float sg = r * __builtin_amdgcn_rcpf(1.0f + __builtin_amdgcn_exp2f(-1.4426950408889634f * r)); y[i] = ov[k][i] * rs * g[i] * sg; }
          ow[2 * k] = pg8::cvt_pk_bf16(y[0], y[1]); ow[2 * k + 1] = pg8::cvt_pk_bf16(y[2], y[3]); }
      bf16* op = MIX + (row0 + t) * 1024 + 512 + h * 128 + v0;
      *(v4u*)op = (v4u){ow[0], ow[1], ow[2], ow[3]}; *(v4u*)(op + 8) = (v4u){ow[4], ow[5], ow[6], ow[7]}; }
    WG_SYNC();
}

constexpr int WRP = 1032;
constexpr int WR_LDS_BYTES = 48 * WRP * 2;
__device__ __forceinline__ void router_tile(LAS unsigned char* lds, int tile, const bf16* __restrict__ XN2, const float* __restrict__ ROWSS, const float* __restrict__ brg, const float* __restrict__ bre,
                                            unsigned* __restrict__ CNT, int* __restrict__ LISTS, float* __restrict__ LSC, int* __restrict__ TOKINFO, int tid, int lane, int wid) {
    LAS bf16* WR = (LAS bf16*)lds; LAS float* PL = (LAS float*)(lds + WR_LDS_BYTES); LAS unsigned* CL = (LAS unsigned*)(lds + WR_LDS_BYTES + 24576); LAS unsigned* BS = CL + 32;
    if (tid < 32) CL[tid] = 0u;
    const int fr = lane & 15, fq = lane >> 4, rt = wid >> 1, kh = wid & 1;
    {   const size_t row = (size_t)tile * 64 + 16 * rt + fr; const bf16* ap = XN2 + row * 1024 + 512 * kh + 8 * fq;
        bf16x8 Af[16];
#pragma unroll
        for (int kk = 0; kk < 16; ++kk) Af[kk] = *(const bf16x8*)(ap + 32 * kk);
        f32x4 acc[3];
#pragma unroll
        for (int nt = 0; nt < 3; ++nt) acc[nt] = (f32x4){0.f, 0.f, 0.f, 0.f};
#pragma unroll
        for (int kk = 0; kk < 16; ++kk)
#pragma unroll
            for (int nt = 0; nt < 3; ++nt) { const bf16x8 Bf = *(const LAS bf16x8*)(WR + (16 * nt + fr) * WRP + 512 * kh + 32 * kk + 8 * fq); acc[nt] = __builtin_amdgcn_mfma_f32_16x16x32_bf16(Af[kk], Bf, acc[nt], 0, 0, 0); }
#pragma unroll
        for (int nt = 0; nt < 3; ++nt)
#pragma unroll
            for (int i = 0; i < 4; ++i) PL[(wid * 16 + 4 * fq + i) * 48 + 16 * nt + fr] = acc[nt][i];
    }
    WG_SYNC();
    int e_[2] = {0, 0}; unsigned lp[2] = {0u, 0u}; float wk[2] = {0.f, 0.f}; float rstd2 = 0.f; const bool act = tid < 64;
    const int token = tile * 64 + tid;
    if (act) {
        const LAS float* l0 = PL + ((2 * (tid >> 4)) * 16 + (tid & 15)) * 48; const LAS float* l1 = l0 + 16 * 48; float ss = 0.f;
        const f32x4* rp = (const f32x4*)(ROWSS + (size_t)token * 16);
#pragma unroll
        for (int j = 0; j < 4; ++j) { const f32x4 v = rp[j]; ss += (v[0] + v[1]) + (v[2] + v[3]); }
        rstd2 = 1.0f / sqrtf(ss * (1.0f / 1024.0f) + 1e-6f);
        float gl[4]; int gs = 0;
#pragma unroll
        for (int j = 0; j < 4; ++j) gl[j] = (l0[j] + l1[j]) * rstd2 + brg[j];
#pragma unroll
        for (int j = 1; j < 4; ++j) if (gl[j] > gl[gs]) gs = j;
        float den = 0.f;
#pragma unroll
        for (int j = 0; j < 4; ++j) den += __expf(gl[j] - gl[gs]);
        const float gw = 1.0f / den;
        float el[8];
#pragma unroll
        for (int j = 0; j < 8; ++j) el[j] = (l0[4 + gs * 8 + j] + l1[4 + gs * 8 + j]) * rstd2 + bre[gs * 8 + j];
        int i0 = 0;
#pragma unroll
        for (int j = 1; j < 8; ++j) if (el[j] > el[i0]) i0 = j;
        int i1 = (i0 == 0) ? 1 : 0;
#pragma unroll
        for (int j = 0; j < 8; ++j) if (j != i0 && j != i1 && el[j] > el[i1]) i1 = j;
        const float ex = __expf(el[i1] - el[i0]); const float w0 = 1.0f / (1.0f + ex);
        wk[0] = w0 * gw; wk[1] = ex * w0 * gw; e_[0] = gs * 8 + i0; e_[1] = gs * 8 + i1;
        lp[0] = __hip_atomic_fetch_add(CL + e_[0], 1u, __ATOMIC_RELAXED, __HIP_MEMORY_SCOPE_WORKGROUP); lp[1] = __hip_atomic_fetch_add(CL + e_[1], 1u, __ATOMIC_RELAXED, __HIP_MEMORY_SCOPE_WORKGROUP);
    }
    WG_SYNC();
    if (tid < 32) { const unsigned n = CL[tid]; BS[tid] = n ? __hip_atomic_fetch_add(CNT + tid, n, __ATOMIC_RELAXED, __HIP_MEMORY_SCOPE_AGENT) : 0u; }
    WG_SYNC();
    if (act) {
#pragma unroll
        for (int k = 0; k < 2; ++k) { const unsigned pos = BS[e_[k]] + lp[k]; LISTS[(size_t)e_[k] * 16384 + pos] = token; *(f32x2*)(LSC + ((size_t)e_[k] * 16384 + pos) * 2) = (f32x2){rstd2, wk[k]}; }
        *(int4*)(TOKINFO + (size_t)token * 4) = make_int4(e_[0], (int)(BS[e_[0]] + lp[0]), e_[1], (int)(BS[e_[1]] + lp[1]));
    }
    WG_SYNC();
}

template <bool GATHER> struct GroupOrder {
    const LAS int* TOFF; const LAS int* BOFF; const LAS int* CNTL; const int* LISTS; int NPN, G, c; unsigned bstride;
    __device__ bool next(int i, pg8::Unit& u) const {
        const int L = i * G + c; const int ntile = BOFF[32]; if (L >= ntile * NPN) return false;
        const int Tb = L / NPN; int e = 0;
#pragma unroll
        for (int s = 16; s >= 1; s >>= 1) if (BOFF[e + s] <= Tb) e += s;
        const int jt = Tb - BOFF[e];
        u.pm = TOFF[e] + jt; u.pn = L - Tb * NPN; u.e = e; u.p0 = jt * 256; const int rem = CNTL[e] - u.p0; u.nv = rem < 256 ? rem : 256; u.bo = (unsigned)e * bstride; return true;
    }
    __device__ __forceinline__ unsigned arow(const pg8::Unit& u, int r) const {
        if (GATHER) return (unsigned)LISTS[(size_t)u.e * 16384 + u.p0 + (r < u.nv ? r : 0)];
        return (unsigned)(u.pm * 256 + r);
    }
};
__device__ __forceinline__ void skinny_gu(LAS unsigned char* lds, int e, int p0, int rem, int rg, int cb, int slot0, const bf16* __restrict__ XN2, const bf16* __restrict__ WGU, const int* __restrict__ LISTS, const float* __restrict__ LSC, bf16* __restrict__ HID, int lane, int wid) {
    const int fr = lane & 15, fq = lane >> 4; const int r = 16 * rg + fr; const int tok = LISTS[(size_t)e * 16384 + p0 + (r < rem ? r : 0)];
    const bf16* ap = XN2 + (size_t)tok * 1024 + 128 * wid + 8 * fq; const bf16* wb = WGU + (size_t)e * 512 * 1024 + 128 * wid + 8 * fq;
    LAS f32x4* PART = (LAS f32x4*)lds;
    bf16x8 Af[4];
#pragma unroll
    for (int k = 0; k < 4; ++k) Af[k] = *(const bf16x8*)(ap + 32 * k);
#pragma unroll
    for (int nt = 0; nt < 4; ++nt) { const int j = 64 * cb + 16 * nt + fr; const bf16* bp = wb + (size_t)((j >> 7) * 256 + (j & 127)) * 1024;
        bf16x8 Bg[4], Bu[4];
#pragma unroll
        for (int k = 0; k < 4; ++k) { Bg[k] = *(const bf16x8*)(bp + 32 * k); Bu[k] = *(const bf16x8*)(bp + 128 * 1024 + 32 * k); }
        f32x4 ag = (f32x4){0.f, 0.f, 0.f, 0.f}, au = (f32x4){0.f, 0.f, 0.f, 0.f};
#pragma unroll
        for (int k = 0; k < 4; ++k) { ag = __builtin_amdgcn_mfma_f32_16x16x32_bf16(Af[k], Bg[k], ag, 0, 0, 0); au = __builtin_amdgcn_mfma_f32_16x16x32_bf16(Af[k], Bu[k], au, 0, 0, 0); }
        PART[(wid * 8 + nt) * 64 + lane] = ag; PART[(wid * 8 + 4 + nt) * 64 + lane] = au; }
    WG_SYNC();
    if (wid < 4) { const int nt = wid; f32x4 g = (f32x4){0.f, 0.f, 0.f, 0.f}, u = (f32x4){0.f, 0.f, 0.f, 0.f};
#pragma unroll
        for (int w = 0; w < 8; ++w) { g += PART[(w * 8 + nt) * 64 + lane]; u += PART[(w * 8 + 4 + nt) * 64 + lane]; }
#pragma unroll
        for (int i = 0; i < 4; ++i) { const int rr = 16 * rg + 4 * fq + i; if (rr < rem) { const f32x2 sw = *(const f32x2*)(LSC + ((size_t)e * 16384 + p0 + rr) * 2);
            const float a = g[i] * sw.x, uu = u[i] * sw.x; HID[(size_t)(slot0 + rr) * 256 + 64 * cb + 16 * nt + fr] = (bf16)f2bf(a * __builtin_amdgcn_rcpf(1.f + __expf(-a)) * uu * sw.y); } } }
    WG_SYNC();
}
__device__ __forceinline__ void skinny_down(int e, int rem, int rg, int cq, int slot0, const bf16* __restrict__ HID, const bf16* __restrict__ WD, bf16* __restrict__ Y, int lane, int wid) {
    const int fr = lane & 15, fq = lane >> 4; const int r = 16 * rg + fr; const int col0 = 256 * cq + 32 * wid;
    const bf16* ap = HID + (size_t)(slot0 + (r < rem ? r : 0)) * 256 + 8 * fq; const bf16* wb = WD + (size_t)e * 1024 * 256 + (size_t)(col0 + fr) * 256 + 8 * fq;
    bf16x8 Af[8], B0[8], B1[8];
#pragma unroll
    for (int k = 0; k < 8; ++k) { Af[k] = *(const bf16x8*)(ap + 32 * k); B0[k] = *(const bf16x8*)(wb + 32 * k); B1[k] = *(const bf16x8*)(wb + (size_t)16 * 256 + 32 * k); }
    f32x4 a0 = (f32x4){0.f, 0.f, 0.f, 0.f}, a1 = (f32x4){0.f, 0.f, 0.f, 0.f};
#pragma unroll
    for (int k = 0; k < 8; ++k) { a0 = __builtin_amdgcn_mfma_f32_16x16x32_bf16(Af[k], B0[k], a0, 0, 0, 0); a1 = __builtin_amdgcn_mfma_f32_16x16x32_bf16(Af[k], B1[k], a1, 0, 0, 0); }
#pragma unroll
    for (int i = 0; i < 4; ++i) { const int rr = 16 * rg + 4 * fq + i; if (rr < rem) { bf16* yp = Y + (size_t)(slot0 + rr) * 1024 + col0 + fr; yp[0] = (bf16)f2bf(a0[i]); yp[16] = (bf16)f2bf(a1[i]); } }
}
struct Args { const float* in[18]; float* out; unsigned char* ws; int ph_lo, ph_hi, li, pad; };
__global__ void __launch_bounds__(NWAVES * 64, 2) hymba_fwd(Args args) {
    extern __shared__ __attribute__((aligned(16))) unsigned char lds[];
    LAS unsigned char* const L = (LAS unsigned char*)lds;
    volatile LAS unsigned* const MISCW = (volatile LAS unsigned*)(L + MISC_OFF);
    LAS int* const TOFF = (LAS int*)(L + TOFF_OFF); LAS int* const CNTL = TOFF + 40; LAS int* const BOFF = TOFF + 80; LAS int* const SMALL = TOFF + 120;
    const int tid = threadIdx.x, lane = tid & 63, wave = __builtin_amdgcn_readfirstlane(tid >> 6);
    const int G = gridDim.x; const int bx = blockIdx.x; const int vcu = (G % 8 == 0) ? (bx % 8) * (G / 8) + bx / 8 : bx;
    unsigned char* const ws = args.ws;
    gu32* const ctl = (gu32*)(ws + WS_CTL);
    const float* x = args.in[0]; const float* norm1_g = args.in[1]; const float* w_in = args.in[2]; const float* q_norm_g = args.in[3]; const float* k_norm_g = args.in[4];
    const float* rel_bias = args.in[5]; const float* gate_w2 = args.in[6]; const float* gate_b = args.in[7]; const float* out_norm_g = args.in[8]; const float* w_out = args.in[9];
    const float* norm2_g = args.in[10]; const float* w_rg = args.in[11]; const float* b_rg = args.in[12]; const float* w_re = args.in[13]; const float* b_re = args.in[14];
    const float* w_eg = args.in[15]; const float* w_eu = args.in[16]; const float* w_ed = args.in[17];
    float* out = args.out;
    float* RSTD1 = (float*)(ws + WS_RSTD1); float* ROWSS = (float*)(ws + WS_ROWSS); bf16* WR_T = (bf16*)(ws + WS_WR); float* BLAST = (float*)(ws + WS_BLAST);
    int* TOKINFO = (int*)(ws + WS_TOKINFO); int* LISTS = (int*)(ws + WS_LISTS); float* LSC = (float*)(ws + WS_LSC);
    bf16* WO_T = (bf16*)(ws + WS_WO); bf16* WGU_T = (bf16*)(ws + WS_WGU); bf16* WD_T = (bf16*)(ws + WS_WD); bf16* XB = (bf16*)(ws + WS_XB); bf16* WIN_T = (bf16*)(ws + WS_WIN);
    unsigned* MASK = (unsigned*)(ws + WS_MASK); bf16* SB = (bf16*)(ws + WS_SB);
    bf16* QN = (bf16*)(ws + WS_QN); bf16* KN = (bf16*)(ws + WS_KN); bf16* VN = (bf16*)(ws + WS_VN); bf16* XN2 = (bf16*)(ws + WS_XN2);
    bf16* IQ = (bf16*)(ws + WS_IQ); bf16* MISC = (bf16*)(ws + WS_MISC); bf16* QB = (bf16*)(ws + WS_QB); bf16* KB = (bf16*)(ws + WS_KB); bf16* VB = (bf16*)(ws + WS_VB); bf16* RG = (bf16*)(ws + WS_RG);
    bf16* MIX = (bf16*)(ws + WS_MIX); float* U = (float*)(ws + WS_MIX); bf16* HID = (bf16*)(ws + WS_HID); bf16* Y = (bf16*)(ws + WS_Y);
    unsigned* CNT = (unsigned*)(ctl + CW_CNT);

    for (int u = tid; u < (LDS_BYTES - LDSCTL_OFF) / 4; u += NWAVES * 64) ((LAS unsigned*)(L + LDSCTL_OFF))[u] = 0u;
    __syncthreads();
    const int bli = (N_LAUNCHES == PER_PHASE) ? 0 : args.li;
    XcdBarrier bar; bar.bar = (unsigned*)(ctl + CW_BAR) + bli * XCD_BAR_WORDS; bar.x = 0; bar.st = nullptr;
    if (N_LAUNCHES != PER_PHASE) bar = xcd_barrier_post((unsigned*)(ctl + CW_BAR) + bli * XCD_BAR_WORDS, MISCW + 8);
#define GRID_BAR(seam) do { if (N_LAUNCHES == PER_PHASE) { if (tid == 0) __hip_atomic_store(ctl + CW_TMO, 0xBADBA0u | (unsigned)(seam), RLX_AGENT); } else { xcd_barrier(bar); } } while (0)
    const int lo = args.ph_lo, hi = args.ph_hi;
#define IN(k) (lo <= (k) && (k) < hi)
#define BOTH(k) (IN(k) && IN((k) + 1))
    const int gw = vcu * NWAVES + wave, NGW = G * NWAVES;

    constexpr int I_G = 16 * 8, I_D = 4 * 32, PER_E = 2 * I_G + I_D, NE1 = 18;
#define expert_weights(lo_, hi_, w0_, nw_) do { LAS float* scr_ = (LAS float*)(L + wave * 16384); \
        for (int it_ = (lo_) + (w0_); it_ < (hi_); it_ += (nw_)) { const int e_ = it_ / PER_E; int r_ = it_ - e_ * PER_E; \
            if (r_ < I_G) { p0_transpose_item<2>(w_eg + (size_t)e_ * 1024 * 256, 1024, 256, norm2_g, WGU_T + (size_t)e_ * 512 * 1024, scr_, r_, lane); continue; } r_ -= I_G; \
            if (r_ < I_G) { p0_transpose_item<3>(w_eu + (size_t)e_ * 1024 * 256, 1024, 256, norm2_g, WGU_T + (size_t)e_ * 512 * 1024, scr_, r_, lane); continue; } r_ -= I_G; \
            p0_transpose_item<1>(w_ed + (size_t)e_ * 256 * 1024, 256, 1024, nullptr, WD_T + (size_t)e_ * 1024 * 256, scr_, r_, lane); } } while (0)
    if (IN(0)) {
        LAS float* scr = (LAS float*)(L + wave * 16384);
        constexpr int I_IN = 16 * 106, I_O = 16 * 32;
        constexpr int NITEMS = I_IN + I_O;
        for (int it = gw; it < NITEMS; it += NGW) {
            int r = it;
            if (r < I_IN) { p0_transpose_item<0>(w_in, 1024, 3384, norm1_g, WIN_T, scr, r, lane); continue; } r -= I_IN;
            p0_transpose_item<1>(w_out, 1024, 1024, nullptr, WO_T, scr, r, lane);
        }
        for (int i = bx * (NWAVES * 64) + tid; i < 48 * 1024; i += G * NWAVES * 64) { const int n = i >> 10, k = i & 1023;
            const float v = (n < 4) ? w_rg[k * 4 + n] : (n < 36) ? w_re[k * 32 + (n - 4)] : 0.f; WR_T[i] = (bf16)f2bf(v * norm2_g[k]); }
        for (int m0 = 2 * gw; m0 < M; m0 += 2 * NGW) {
            f32x4 v[2][4]; float s[2];
#pragma unroll
            for (int r = 0; r < 2; ++r) { const GAS f32x4* xr = (const GAS f32x4*)(x + (size_t)(m0 + r) * 1024) + lane;
#pragma unroll
                for (int j = 0; j < 4; ++j) v[r][j] = xr[64 * j]; }
#pragma unroll
            for (int r = 0; r < 2; ++r) { s[r] = 0.f;
#pragma unroll
                for (int j = 0; j < 4; ++j) s[r] += (v[r][j].x * v[r][j].x + v[r][j].y * v[r][j].y) + (v[r][j].z * v[r][j].z + v[r][j].w * v[r][j].w);
                s[r] = wave_fsum(s[r]); if (lane == 0) RSTD1[m0 + r] = 1.0f / sqrtf(s[r] * (1.0f / 1024.0f) + 1e-6f);
                GAS unsigned long long* o8 = (GAS unsigned long long*)(XB + (size_t)(m0 + r) * 1024) + lane;
#pragma unroll
                for (int j = 0; j < 4; ++j) o8[64 * j] = (unsigned long long)pk2(v[r][j].x, v[r][j].y) | ((unsigned long long)pk2(v[r][j].z, v[r][j].w) << 32); }
        }
        if (BOTH(0)) GRID_BAR(0);
    }
    if (IN(1)) {
        pg8::Gemm g{XB, WIN_T, 1024}; pg8::StaticOrder S; S.init(M, 3584, G, bx);
        pg8::EpiProj E{RSTD1, q_norm_g, k_norm_g, QN, KN, VN, IQ, QB, KB, VB, RG, MISC, 0.125f * 1.4426950408889634f, 1e-6f};
        pg8::gemm_phase<pg8::EpiProj, pg8::StaticOrder, true>(L, g, S, E);
        {
            const int nshort = (896 % G == 0) ? G : G - (896 % G), first = G - nshort;
            if (bx >= first) expert_weights(0, NE1 * PER_E, (bx - first) * NWAVES + wave, nshort * NWAVES); }
        if (BOTH(1)) GRID_BAR(1);
    }
    if (IN(2)) {
        for (int rep = 0; rep < REP_IDX; ++rep)
        for (int it = bx; it < 1024; it += G) { const int b = it & 7, key = (it >> 3) ^ ((it >> 8) & 1); const int p = (key & 1) ? 127 - (key >> 1) : (key >> 1);
            idx_item(L, b, p, IQ, MISC, MASK, lane, wave); }
        for (int rep = 0; rep < REP_GLAA; ++rep)
        for (int it = bx; it < 1024; it += G) gla_a_item(L, it, KB, VB, MISC, gate_w2, gate_b, U, BLAST, tid, lane, wave);
        if (BOTH(2)) GRID_BAR(2);
    }
    if (IN(3)) {
        for (int it = bx; it < 128; it += G) gla_b_item(it, U, BLAST, SB, tid);
        { const int first = (G > 128) ? 128 : 0, nb = G - first;
          if (bx >= first) expert_weights(NE1 * PER_E, 32 * PER_E, (bx - first) * NWAVES + wave, nb * NWAVES); }
        if (BOTH(3)) GRID_BAR(3);
    }
    if (IN(4)) {
        const attn_body::AttnTensors AT{(const attn_body::bf16*)QN, (const attn_body::bf16*)KN, (const attn_body::bf16*)VN, (attn_body::bf16*)MIX, MASK, rel_bias};
        for (int rep = 0; rep < REP_ATT; ++rep)
        for (int pr = vcu; pr < 256; pr += G) { const int bh = pr >> 2, s = pr & 3;
            for (int k2 = 0; k2 < 2; ++k2) attn_body::attn_unit<8>(bh >> 3, bh & 7, k2 ? s : 7 - s, AT.Q, AT.K, AT.V, AT.O, AT.MASK, AT.relb, (char*)lds); }
        for (int rep = 0; rep < REP_GLAC; ++rep)
        for (int it = bx; it < 1024; it += G) gla_c_item(L, it, QB, KB, VB, RG, MISC, gate_w2, gate_b, out_norm_g, SB, MIX, tid, lane, wave);
        if (BOTH(4)) GRID_BAR(4);
    }
    if (IN(5)) {
        pg8::Gemm g{MIX, WO_T, 1024}; pg8::StaticOrder S; S.init(M, 1024, G, bx);
        pg8::EpiOut E{x, XN2, ROWSS};
        pg8::gemm_phase<pg8::EpiOut, pg8::StaticOrder, false>(L, g, S, E);
        if (BOTH(5)) GRID_BAR(5);
    }
    if (IN(6)) {
        { LAS bf16* WR = (LAS bf16*)L;
          for (int i = tid; i < 48 * 128; i += NWAVES * 64) { const int n = i >> 7, c8 = i & 127; *(LAS v4u*)(WR + n * WRP + c8 * 8) = *(const v4u*)(WR_T + n * 1024 + c8 * 8); } }
        WG_SYNC();
        for (int tile = bx; tile < 256; tile += G) router_tile(L, tile, XN2, ROWSS, b_rg, b_re, CNT, LISTS, LSC, TOKINFO, tid, lane, wave);
        if (BOTH(6)) GRID_BAR(6);
    }
#define LOAD_TOFF() do { if (tid == 0) { int acc_ = 0, bacc_ = 0, ns_ = 0; for (int e_ = 0; e_ < 32; ++e_) { const int c_ = (int)__hip_atomic_load(CNT + e_, RLX_AGENT); CNTL[e_] = c_; TOFF[e_] = acc_; BOFF[e_] = bacc_; \
        const int full_ = c_ >> 8, rem_ = c_ & 255; acc_ += (c_ + 255) >> 8; bacc_ += full_ + (rem_ > 128 ? 1 : 0); if (rem_ > 0 && rem_ <= 128) { SMALL[1 + ns_] = e_; ++ns_; } } TOFF[32] = acc_; BOFF[32] = bacc_; SMALL[0] = ns_; } WG_SYNC(); } while (0)
    if (IN(7)) {
        LOAD_TOFF();
        pg8::Gemm g{XN2, WGU_T, 1024}; GroupOrder<true> S{TOFF, BOFF, CNTL, LISTS, 2, G, vcu, 512u * 1024u * 2u};
        pg8::EpiGU E{LSC, HID};
        pg8::gemm_phase<pg8::EpiGU, GroupOrder<true>, false>(L, g, S, E);
        { const int ns = SMALL[0];
          for (int idx = G - 1 - bx; idx < ns * 32; idx += G) { const int e = SMALL[1 + (idx >> 5)], rg = (idx >> 2) & 7, cb = idx & 3; const int cnt = CNTL[e], full = cnt >> 8, rem = cnt & 255;
              if (16 * rg < rem) skinny_gu(L, e, full * 256, rem, rg, cb, (TOFF[e] + full) * 256, XN2, WGU_T, LISTS, LSC, HID, lane, wave); } }
        if (BOTH(7)) GRID_BAR(7);
    }
    if (IN(8)) {
        LOAD_TOFF();
        pg8::Gemm g{HID, WD_T, 256}; GroupOrder<false> S{TOFF, BOFF, CNTL, LISTS, 4, G, vcu, 1024u * 256u * 2u};
        pg8::EpiDown E{Y};
        pg8::gemm_phase<pg8::EpiDown, GroupOrder<false>, false>(L, g, S, E);
        { const int ns = SMALL[0];
          for (int idx = G - 1 - bx; idx < ns * 32; idx += G) { const int e = SMALL[1 + (idx >> 5)], rg = (idx >> 2) & 7, cq = idx & 3; const int cnt = CNTL[e], full = cnt >> 8, rem = cnt & 255;
              if (16 * rg < rem) skinny_down(e, rem, rg, cq, (TOFF[e] + full) * 256, HID, WD_T, Y, lane, wave); } }
        if (BOTH(8)) GRID_BAR(8);
    }
    if (IN(9)) {
        LOAD_TOFF();
        for (int m0 = 4 * gw; m0 < M; m0 += 4 * NGW) {
            int4 ti[4];
#pragma unroll
            for (int r = 0; r < 4; ++r) ti[r] = *(const int4*)(TOKINFO + (size_t)(m0 + r) * 4);
            v4u av[4][2], b0[4][2], b1[4][2];
#pragma unroll
            for (int r = 0; r < 4; ++r) { const size_t s0 = (size_t)TOFF[ti[r].x] * 256 + ti[r].y, s1 = (size_t)TOFF[ti[r].z] * 256 + ti[r].w;
                const GAS v4u* a = (const GAS v4u*)(XN2 + (size_t)(m0 + r) * 1024) + lane; const GAS v4u* y0 = (const GAS v4u*)(Y + s0 * 1024) + lane; const GAS v4u* y1 = (const GAS v4u*)(Y + s1 * 1024) + lane;
#pragma unroll
                for (int j = 0; j < 2; ++j) { av[r][j] = a[64 * j]; b0[r][j] = y0[64 * j]; b1[r][j] = y1[64 * j]; } }
#pragma unroll
            for (int r = 0; r < 4; ++r) { GAS f32x4* o = (GAS f32x4*)(out + (size_t)(m0 + r) * 1024) + 2 * lane;
#pragma unroll
                for (int j = 0; j < 2; ++j) { const v4u a_ = av[r][j], c0 = b0[r][j], c1 = b1[r][j]; f32x4 r0, r1;
                    r0[0] = bflo(a_.x) + bflo(c0.x) + bflo(c1.x); r0[1] = bfhi(a_.x) + bfhi(c0.x) + bfhi(c1.x); r0[2] = bflo(a_.y) + bflo(c0.y) + bflo(c1.y); r0[3] = bfhi(a_.y) + bfhi(c0.y) + bfhi(c1.y);
                    r1[0] = bflo(a_.z) + bflo(c0.z) + bflo(c1.z); r1[1] = bfhi(a_.z) + bfhi(c0.z) + bfhi(c1.z); r1[2] = bflo(a_.w) + bflo(c0.w) + bflo(c1.w); r1[3] = bfhi(a_.w) + bfhi(c0.w) + bfhi(c1.w);
                    o[128 * j] = r0; o[128 * j + 1] = r1; } }
        }
    }
#undef IN
#undef BOTH
}

extern "C" void kernel_launch(void* const* d_in, const int* in_sizes, int n_in, void* d_out, int out_size, void* d_ws, size_t ws_size, hipStream_t stream) {
    static int grid = 0;
    if (grid == 0) {
        if (n_in != 18 || out_size != M * 1024 || ws_size < WS_END) { fprintf(stderr, "kernel_launch: unexpected problem shape (n_in %d out %d ws %zu)\n", n_in, out_size, ws_size); grid = -1; return; }
        int dev = 0, cus = 0, per_cu = 0;
        if (hipGetDevice(&dev) != hipSuccess || hipDeviceGetAttribute(&cus, hipDeviceAttributeMultiprocessorCount, dev) != hipSuccess) { grid = -1; return; }
        if (hipFuncSetAttribute((const void*)hymba_fwd, hipFuncAttributeMaxDynamicSharedMemorySize, LDS_BYTES) != hipSuccess) { fprintf(stderr, "kernel_launch: hipFuncSetAttribute failed\n"); grid = -1; return; }
        if (hipOccupancyMaxActiveBlocksPerMultiprocessor(&per_cu, (const void*)hymba_fwd, NWAVES * 64, LDS_BYTES) != hipSuccess || per_cu < 1) { fprintf(stderr, "kernel_launch: occupancy query reports %d\n", per_cu); }
        (void)hipGetLastError();
        grid = cus;
    }
    if (grid < 0) return;
    (void)hipMemsetAsync((char*)d_ws + WS_CTL, 0, CTL_ZERO_BYTES, stream);
    Args a{};
    for (int i = 0; i < 18; ++i) a.in[i] = (const float*)d_in[i];
    a.out = (float*)d_out; a.ws = (unsigned char*)d_ws;
#if defined(PROBE_PHASE)
    { const int k = PROBE_PHASE; a.ph_lo = 0; a.ph_hi = k + 1; a.li = 0; hipLaunchKernelGGL(hymba_fwd, dim3(grid), dim3(NWAVES * 64), LDS_BYTES, stream, a);
      for (int r = 1; r < PROBE_REPS; ++r) { a.ph_lo = k; a.ph_hi = k + 1; a.li = 1; hipLaunchKernelGGL(hymba_fwd, dim3(grid), dim3(NWAVES * 64), LDS_BYTES, stream, a); }
      if (k + 1 < PER_PHASE) { a.ph_lo = k + 1; a.ph_hi = PER_PHASE; a.li = 2; hipLaunchKernelGGL(hymba_fwd, dim3(grid), dim3(NWAVES * 64), LDS_BYTES, stream, a); } }
#else
    if (N_LAUNCHES == 1) { a.ph_lo = 0; a.ph_hi = PER_PHASE; a.li = 0; hipLaunchKernelGGL(hymba_fwd, dim3(grid), dim3(NWAVES * 64), LDS_BYTES, stream, a); }
    else for (int li = 0; li < PER_PHASE; ++li) { a.ph_lo = li; a.ph_hi = li + 1; a.li = li; hipLaunchKernelGGL(hymba_fwd, dim3(grid), dim3(NWAVES * 64), LDS_BYTES, stream, a); }
#endif
}
```

```cpp
#include <hip/hip_runtime.h>
#include <hip/hip_bf16.h>
#include <cstdio>
#include <cstdint>
#include <cmath>
namespace pg8 {
#define PG8_LAS __attribute__((address_space(3)))
typedef unsigned short bf16_t;
typedef short bf16x8 __attribute__((ext_vector_type(8)));
typedef float f32x4 __attribute__((ext_vector_type(4)));
typedef float f32x2 __attribute__((ext_vector_type(2)));
typedef unsigned u32x4 __attribute__((ext_vector_type(4)));
constexpr int BM = 256, BK = 64, HALF = 128, HTB = HALF * BK * 2  , STAGE_BYTES = 8 * HTB, NXCD = 8, WGM = 8;

__host__ __device__ __forceinline__ int lds_byte(int r, int c) { const int st = (r >> 4) * 2 + (c >> 5), rr = r & 15, cc = c & 31, ob = rr * 64 + cc * 2; return st * 1024 + (ob ^ (((ob >> 9) & 1) << 5)); }
__host__ __device__ __forceinline__ void stage_rc(int b, int& R, int& C) { const int st = b / 1024, sb = b % 1024, swz = sb ^ (((sb >> 9) & 1) << 5); R = (st >> 1) * 16 + swz / 64; C = (st & 1) * 32 + (swz % 64) / 2; }
__host__ __device__ __forceinline__ int perm32(int rho) { const int n = rho >> 4, i = rho & 15; return 8 * (i >> 2) + 4 * n + (i & 3); }

struct Unit { int pm, pn; unsigned bo; int e, nv, p0; };
struct Gemm { const bf16_t* A; const bf16_t* Bt; int K; };

struct StaticOrder {
    int nM, nN, nwg, G, c;
    __device__ void init(int M, int N, int G_, int c_) { nM = M / BM; nN = N / BM; nwg = nM * nN; G = G_; c = c_; }
    __device__ bool next(int i, Unit& u) const {
        const long L = (long)i * G + c; if (L >= nwg) return false;
        int wgid = (int)L; { const int q = nwg / NXCD, r = nwg % NXCD, xcd = wgid % NXCD, off = wgid / NXCD; wgid = (xcd < r ? xcd * (q + 1) : r * (q + 1) + (xcd - r) * q) + off; }
        const int nig = WGM * nN, gid = wgid / nig, fm = gid * WGM, gsz = (nM - fm) < WGM ? (nM - fm) : WGM;
        u.pm = fm + ((wgid % nig) % gsz); u.pn = (wgid % nig) / gsz; u.bo = 0u; u.e = 0; u.nv = BM; u.p0 = 0; return true;
    }
    __device__ __forceinline__ unsigned arow(const Unit& u, int r) const { return (unsigned)(u.pm * BM + r); }
};

__device__ __forceinline__ unsigned cvt_pk_bf16(float lo, float hi) { unsigned r; asm volatile("v_cvt_pk_bf16_f32 %0, %1, %2" : "=v"(r) : "v"(lo), "v"(hi)); return r; }

template <class Epi, class Sched, bool ALIGN_EPI = false>
__device__ __forceinline__ void gemm_phase(PG8_LAS unsigned char* lds, const Gemm g, const Sched& S, const Epi& E) {
    const int tid = threadIdx.x, wid = __builtin_amdgcn_readfirstlane(tid >> 6), lane = tid & 63, wr = wid >> 2, wc = wid & 3, fr = lane & 15, fq = lane >> 4;
    const int K = g.K, nt = K / BK;
    int RA[2], CA[2]; unsigned voffB[2];
#pragma unroll
    for (int i = 0; i < 2; ++i) { int R, C; stage_rc(tid * 16 + i * 8192, R, C); const int Rb = ((R & ~31) + perm32(R & 31));
        RA[i] = R; CA[i] = C; voffB[i] = (unsigned)(Rb * K + C) * 2u; }
    const size_t kstep = (size_t)(BK * 2);
    const size_t hstep = (size_t)HALF * K * 2;
    const size_t tstep = 2 * hstep;
    const unsigned ldsw = (unsigned)wid * 1024u;
    const int aoff = lds_byte(wr * 64 + fr, fq * 8), boff = lds_byte(wc * 32 + fr, fq * 8);
#define PG8_SA(b, h) (((b) * 2 + (h)) * HTB)
#define PG8_SB(b, h) ((4 + (b) * 2 + (h)) * HTB)
#define PG8_STAGE(bufoff, gbase, voff) do { _Pragma("unroll") for (int _i = 0; _i < 2; ++_i) \
        __builtin_amdgcn_global_load_lds((const unsigned*)((const char*)(gbase) + (voff)[_i]), (PG8_LAS unsigned*)(lds + (bufoff) + ldsw + _i * 8192), 16, 0, 0); } while (0)
#define PG8_LDA(dst, b, h) do { _Pragma("unroll") for (int m = 0; m < 4; ++m) _Pragma("unroll") for (int k = 0; k < 2; ++k) dst[m][k] = *(const PG8_LAS bf16x8*)(lds + PG8_SA(b, h) + aoff + m * 2048 + k * 1024); } while (0)
#define PG8_LDB(dst, b, h) do { _Pragma("unroll") for (int n = 0; n < 2; ++n) _Pragma("unroll") for (int k = 0; k < 2; ++k) dst[n][k] = *(const PG8_LAS bf16x8*)(lds + PG8_SB(b, h) + boff + n * 2048 + k * 1024); } while (0)
#define PG8_MMA(ai, bj, At, Bt) do { __builtin_amdgcn_s_setprio(1); _Pragma("unroll") for (int m = 0; m < 4; ++m) _Pragma("unroll") for (int n = 0; n < 2; ++n) _Pragma("unroll") for (int k = 0; k < 2; ++k) \
        acc[ai][bj][m][n] = __builtin_amdgcn_mfma_f32_16x16x32_bf16(Bt[n][k], At[m][k], acc[ai][bj][m][n], 0, 0, 0); __builtin_amdgcn_s_setprio(0); } while (0)
#define PG8_WAIT_V(n) asm volatile("s_waitcnt vmcnt(" #n ")" ::: "memory")
#define PG8_WAIT_L(n) asm volatile("s_waitcnt lgkmcnt(" #n ")" ::: "memory")
#define PG8_BAR __builtin_amdgcn_s_barrier()
#define PG8_SCHED __builtin_amdgcn_sched_barrier(0)
#define PG8_AOFF(AO, U) do { _Pragma("unroll") for (int _h = 0; _h < 2; ++_h) _Pragma("unroll") for (int _i = 0; _i < 2; ++_i) \
        AO[_h][_i] = (S.arow(U, _h * HALF + RA[_i]) * (unsigned)K + (unsigned)CA[_i]) * 2u; } while (0)
    Unit cur, nxt; int ui = 0;
    if (!S.next(0, cur)) return;
    f32x4 acc[2][2][4][2];
#pragma unroll
    for (int a = 0; a < 2; ++a)
#pragma unroll
        for (int b = 0; b < 2; ++b)
#pragma unroll
            for (int m = 0; m < 4; ++m)
#pragma unroll
                for (int n = 0; n < 2; ++n) acc[a][b][m][n] = (f32x4){0.f, 0.f, 0.f, 0.f};
    bf16x8 At[4][2], B0[2][2], B1[2][2];
    unsigned aoC[2][2], aoN[2][2];
    PG8_AOFF(aoC, cur);
    const char* const gA = (const char*)g.A;
    const char* cB = (const char*)g.Bt + (size_t)cur.bo + (size_t)cur.pn * tstep;
    {
        PG8_STAGE(PG8_SB(0, 0), cB, voffB); PG8_STAGE(PG8_SB(0, 1), cB + hstep, voffB); PG8_STAGE(PG8_SA(0, 0), gA, aoC[0]); PG8_STAGE(PG8_SA(0, 1), gA, aoC[1]);
        if (wr == 1) PG8_BAR;
        PG8_WAIT_V(2); PG8_BAR;
        PG8_STAGE(PG8_SB(1, 0), cB + kstep, voffB); PG8_STAGE(PG8_SA(1, 0), gA + kstep, aoC[0]); PG8_STAGE(PG8_SB(1, 1), cB + hstep + kstep, voffB);
        PG8_WAIT_V(6); PG8_BAR;
    }
    for (;;) {
        const bool has_next = S.next(ui + 1, nxt);
        if (has_next) { PG8_AOFF(aoN, nxt); } else {
#pragma unroll
            for (int _h = 0; _h < 2; ++_h)
#pragma unroll
                for (int _i = 0; _i < 2; ++_i) aoN[_h][_i] = aoC[_h][_i]; }
        const char* nB = has_next ? (const char*)g.Bt + (size_t)nxt.bo + (size_t)nxt.pn * tstep : cB;
        for (int t = 0; t < nt; t += 2) {
            const bool last = (t == nt - 2);
            const char* a1 = gA + (size_t)(t + 1) * kstep;
            const char* a2 = last ? gA : gA + (size_t)(t + 2) * kstep; const char* b2 = last ? nB : cB + (size_t)(t + 2) * kstep;
            const char* a3 = a2 + kstep; const char* b3 = b2 + kstep;
            unsigned ao2[2][2];
#pragma unroll
            for (int _h = 0; _h < 2; ++_h)
#pragma unroll
                for (int _i = 0; _i < 2; ++_i) ao2[_h][_i] = last ? aoN[_h][_i] : aoC[_h][_i];
            PG8_LDB(B0, 0, 0); PG8_LDB(B1, 0, 1); PG8_SCHED; PG8_LDA(At, 0, 0); PG8_STAGE(PG8_SA(1, 1), a1, aoC[1]);
            PG8_WAIT_V(8); PG8_WAIT_L(0); PG8_BAR; PG8_MMA(0, 0, At, B0); PG8_MMA(0, 1, At, B1); PG8_BAR; PG8_SCHED;
            PG8_LDA(At, 0, 1); PG8_STAGE(PG8_SB(0, 0), b2, voffB); PG8_STAGE(PG8_SB(0, 1), b2 + hstep, voffB); PG8_STAGE(PG8_SA(0, 0), a2, ao2[0]);
            PG8_WAIT_V(8); PG8_WAIT_L(0); PG8_BAR; PG8_MMA(1, 0, At, B0); PG8_MMA(1, 1, At, B1); PG8_BAR; PG8_SCHED;
            PG8_LDB(B0, 1, 0); PG8_LDB(B1, 1, 1); PG8_SCHED; PG8_LDA(At, 1, 0); PG8_STAGE(PG8_SA(0, 1), a2, ao2[1]);
            PG8_WAIT_V(8); PG8_WAIT_L(0); PG8_BAR; PG8_MMA(0, 0, At, B0); PG8_MMA(0, 1, At, B1); PG8_BAR; PG8_SCHED;
            PG8_LDA(At, 1, 1); PG8_STAGE(PG8_SB(1, 0), b3, voffB); PG8_STAGE(PG8_SB(1, 1), b3 + hstep, voffB); PG8_STAGE(PG8_SA(1, 0), a3, ao2[0]);
            PG8_WAIT_V(8); PG8_WAIT_L(0); PG8_BAR; PG8_MMA(1, 0, At, B0); PG8_MMA(1, 1, At, B1); PG8_BAR; PG8_SCHED;
        }
        if constexpr (ALIGN_EPI) { if (wr == 0) PG8_BAR; }
        E(acc, cur, wr, wc, fr, fq);
        if (!has_next) break;
#pragma unroll
        for (int a = 0; a < 2; ++a)
#pragma unroll
            for (int b = 0; b < 2; ++b)
#pragma unroll
                for (int m = 0; m < 4; ++m)
#pragma unroll
                    for (int n = 0; n < 2; ++n) acc[a][b][m][n] = (f32x4){0.f, 0.f, 0.f, 0.f};
        cur = nxt; cB = nB; ++ui;
#pragma unroll
        for (int _h = 0; _h < 2; ++_h)
#pragma unroll
            for (int _i = 0; _i < 2; ++_i) aoC[_h][_i] = aoN[_h][_i];
        if constexpr (ALIGN_EPI) { if (wr == 1) PG8_BAR; }
    }
    PG8_WAIT_V(0);
    if constexpr (!ALIGN_EPI) { if (wr == 0) PG8_BAR; }
    PG8_BAR;
#undef PG8_SA
#undef PG8_SB
#undef PG8_STAGE
#undef PG8_LDA
#undef PG8_LDB
#undef PG8_MMA
#undef PG8_WAIT_V
#undef PG8_WAIT_L
#undef PG8_BAR
#undef PG8_SCHED
#undef PG8_AOFF
}
}
namespace pg8 {
__device__ __forceinline__ float row4_sum(float v) {
    { auto r = __builtin_amdgcn_permlane16_swap(__float_as_uint(v), __float_as_uint(v), false, false); v = __uint_as_float(r[0]) + __uint_as_float(r[1]); }
    { auto r = __builtin_amdgcn_permlane32_swap(__float_as_uint(v), __float_as_uint(v), false, false); v = __uint_as_float(r[0]) + __uint_as_float(r[1]); }
    return v;
}
__device__ __forceinline__ u32x4 pack8(const f32x4 v0, const f32x4 v1) { u32x4 w; w.x = cvt_pk_bf16(v0[0], v0[1]); w.y = cvt_pk_bf16(v0[2], v0[3]); w.z = cvt_pk_bf16(v1[0], v1[1]); w.w = cvt_pk_bf16(v1[2], v1[3]); return w; }

struct EpiProj {
    const float* rstd1; const float* qg; const float* kg;
    bf16_t *QN, *KN, *VN, *IQ, *QB, *KB, *VB, *RG, *MISC;
    float qscale, eps;
    __device__ __forceinline__ void operator()(const f32x4 (&acc)[2][2][4][2], const Unit& u, int wr, int wc, int fr, int fq) const {
        const int row0 = u.pm * BM + wr * 64 + fr; const int pn = u.pn;
        float rs1[2][4];
#pragma unroll
        for (int ai = 0; ai < 2; ++ai)
#pragma unroll
            for (int m = 0; m < 4; ++m) rs1[ai][m] = rstd1[row0 + ai * HALF + m * 16];
        if (pn < 4) {
            const bool isq = pn < 2; const float* gp = isq ? qg : kg; bf16_t* O = isq ? QN : KN; const float os = isq ? qscale : 1.f;
            f32x4 gv[2][2];
#pragma unroll
            for (int bj = 0; bj < 2; ++bj)
#pragma unroll
                for (int n = 0; n < 2; ++n) gv[bj][n] = *(const f32x4*)(gp + 32 * bj + 8 * fq + 4 * n) * os;
            const int hcol = (4 * (pn & 1) + wc) * 64 + 8 * fq;
#pragma unroll
            for (int ai = 0; ai < 2; ++ai)
#pragma unroll
                for (int m = 0; m < 4; ++m) { const int row = row0 + ai * HALF + m * 16; const float s = rs1[ai][m];
                    float ss = 0.f;
#pragma unroll
                    for (int bj = 0; bj < 2; ++bj)
#pragma unroll
                        for (int n = 0; n < 2; ++n) { const f32x4 x = acc[ai][bj][m][n]; ss += (x[0] * x[0] + x[1] * x[1]) + (x[2] * x[2] + x[3] * x[3]); }
                    ss = row4_sum(ss);
                    const float r = s * __builtin_amdgcn_rsqf(s * s * ss * (1.f / 64.f) + eps);
                    bf16_t* rowp = O + (size_t)row * 512 + hcol;
#pragma unroll
                    for (int bj = 0; bj < 2; ++bj) *(u32x4*)(rowp + 32 * bj) = pack8(acc[ai][bj][m][0] * r * gv[bj][0], acc[ai][bj][m][1] * r * gv[bj][1]); }
            return;
        }
        bf16_t* O; int pitch, coff, lim = 256;
        if (pn < 6) { O = VN; pitch = 512; coff = (pn - 4) * 256; }
        else if (pn == 6) { O = IQ; pitch = 256; coff = 0; }
        else if (pn == 7) { O = QB; pitch = 256; coff = 0; }
        else if (pn == 8) { O = KB; pitch = 256; coff = 0; }
        else if (pn < 11) { O = VB; pitch = 512; coff = (pn - 9) * 256; }
        else if (pn < 13) { O = RG; pitch = 512; coff = (pn - 11) * 256; }
        else { O = MISC; pitch = 64; coff = 0; lim = 56; }
        const int c0 = wc * 32 + 8 * fq;
#pragma unroll
        for (int ai = 0; ai < 2; ++ai)
#pragma unroll
            for (int m = 0; m < 4; ++m) { const int row = row0 + ai * HALF + m * 16; const float s = rs1[ai][m];
                bf16_t* rowp = O + (size_t)row * pitch + coff + c0;
#pragma unroll
                for (int bj = 0; bj < 2; ++bj) if (c0 + bj * HALF < lim) *(u32x4*)(rowp + bj * HALF) = pack8(acc[ai][bj][m][0] * s, acc[ai][bj][m][1] * s); }
    }
};

struct EpiOut {
    const float* x; bf16_t* XN2; float* ROWSS;
    __device__ __forceinline__ void operator()(const f32x4 (&acc)[2][2][4][2], const Unit& u, int wr, int wc, int fr, int fq) const {
        const int row0 = u.pm * BM + wr * 64 + fr; const int col0 = u.pn * BM + wc * 32 + 8 * fq;
        f32x4 xv[2][4];
#define EPO_LOAD(buf, g) do { const size_t off_ = (size_t)(row0 + ((g) >> 2) * HALF + ((g) & 3) * 16) * 1024 + col0; \
            xv[buf][0] = *(const f32x4*)(x + off_); xv[buf][1] = *(const f32x4*)(x + off_ + 4); xv[buf][2] = *(const f32x4*)(x + off_ + HALF); xv[buf][3] = *(const f32x4*)(x + off_ + HALF + 4); } while (0)
        EPO_LOAD(0, 0);
#pragma unroll
        for (int g = 0; g < 8; ++g) { const int ai = g >> 2, m = g & 3, cur = g & 1;
            if (g + 1 < 8) EPO_LOAD(cur ^ 1, g + 1);
            const int row = row0 + ai * HALF + m * 16; const size_t off = (size_t)row * 1024 + col0; float ss = 0.f;
#pragma unroll
            for (int bj = 0; bj < 2; ++bj) { const f32x4 a = xv[cur][2 * bj] + acc[ai][bj][m][0], b = xv[cur][2 * bj + 1] + acc[ai][bj][m][1];
                ss += (a[0] * a[0] + a[1] * a[1]) + (a[2] * a[2] + a[3] * a[3]) + (b[0] * b[0] + b[1] * b[1]) + (b[2] * b[2] + b[3] * b[3]);
                *(u32x4*)(XN2 + off + bj * HALF) = pack8(a, b); }
            ss = row4_sum(ss);
            if (fq == 0) ROWSS[(size_t)row * 16 + u.pn * 4 + wc] = ss; }
#undef EPO_LOAD
    }
};

struct EpiGU {
    const float* LSC; bf16_t* HID;
    __device__ __forceinline__ void operator()(const f32x4 (&acc)[2][2][4][2], const Unit& u, int wr, int wc, int fr, int fq) const {
        const int r0 = wr * 64 + fr; const int c0 = u.pn * HALF + wc * 32 + 8 * fq;
#pragma unroll
        for (int ai = 0; ai < 2; ++ai)
#pragma unroll
            for (int m = 0; m < 4; ++m) { const int r = r0 + ai * HALF + m * 16;
                f32x2 sw = (f32x2){0.f, 0.f};
                if (r < u.nv) sw = *(const f32x2*)(LSC + ((size_t)u.e * 16384 + (size_t)(u.p0 + r)) * 2);
                f32x4 h0, h1;
#pragma unroll
                for (int j = 0; j < 4; ++j) { const float a = acc[ai][0][m][0][j] * sw.x, uu = acc[ai][1][m][0][j] * sw.x; h0[j] = a * __builtin_amdgcn_rcpf(1.f + __expf(-a)) * uu * sw.y;
                                              const float a2 = acc[ai][0][m][1][j] * sw.x, u2 = acc[ai][1][m][1][j] * sw.x; h1[j] = a2 * __builtin_amdgcn_rcpf(1.f + __expf(-a2)) * u2 * sw.y; }
                *(u32x4*)(HID + (size_t)(u.pm * BM + r) * 256 + c0) = pack8(h0, h1); }
    }
};
struct EpiDown {
    bf16_t* Y;
    __device__ __forceinline__ void operator()(const f32x4 (&acc)[2][2][4][2], const Unit& u, int wr, int wc, int fr, int fq) const {
        const int r0 = u.pm * BM + wr * 64 + fr; const int c0 = u.pn * BM + wc * 32 + 8 * fq;
#pragma unroll
        for (int ai = 0; ai < 2; ++ai)
#pragma unroll
            for (int m = 0; m < 4; ++m) { bf16_t* rowp = Y + (size_t)(r0 + ai * HALF + m * 16) * 1024 + c0;
#pragma unroll
                for (int bj = 0; bj < 2; ++bj) *(u32x4*)(rowp + bj * HALF) = pack8(acc[ai][bj][m][0], acc[ai][bj][m][1]); }
    }
};
}
namespace attn_body {
using bf16=__hip_bfloat16;
using bf16x8=__attribute__((ext_vector_type(8)))short;
using s16x4=__attribute__((ext_vector_type(4)))short;
using f32x16=__attribute__((ext_vector_type(16)))float;
using u32x4=__attribute__((ext_vector_type(4)))unsigned;
constexpr int BATCH=8,NHEAD=8,SEQ=2048,D=64,DM=NHEAD*D,PO=1024;
constexpr int NW=8,QBLK=32,QB=QBLK*NW,KVBLK=64,NQB=SEQ/QB;
constexpr int ATTN_UNIT_ROWS=QB;
__device__ __forceinline__ int crow(int r,int hi){return (r&3)+8*(r>>2)+4*hi;}
#define SBAR() __builtin_amdgcn_sched_barrier(0)
typedef float f32x4a __attribute__((ext_vector_type(4)));
__device__ __forceinline__ void tbias(f32x16&p0,f32x16&p1,int t,int qpos,int hi,__attribute__((address_space(3))) const char* tabr){
  int base=qpos-64*t-4*hi; base=base<-4?-4:(base>200?200:base); const int a=200-base, s=a&3;
  const __attribute__((address_space(3))) f32x4a* tp=(const __attribute__((address_space(3))) f32x4a*)(tabr+s*1088+(a-s)*4);
  #pragma unroll
  for(int g=0;g<4;++g){ const f32x4a v0=tp[2*g], v1=tp[2*g+8];
    p0[4*g]+=v0[0];p0[4*g+1]+=v0[1];p0[4*g+2]+=v0[2];p0[4*g+3]+=v0[3]; p1[4*g]+=v1[0];p1[4*g+1]+=v1[1];p1[4*g+2]+=v1[2];p1[4*g+3]+=v1[3];
    asm volatile("":"+v"(p0),"+v"(p1)); }
}
__device__ __forceinline__ float mkeep(float v,unsigned mw,int bit){ const unsigned t=(unsigned)(((int)(mw<<(31-bit)))>>31); return __uint_as_float(__float_as_uint(v)&t); }
constexpr int NSLOT=3, SLOTB=8192;
constexpr int LDS_K=0, LDS_V=NSLOT*SLOTB, LDS_WS=2*NSLOT*SLOTB, LDS_OST=LDS_WS+NW*64*4, LDS_BYTES=LDS_OST+NW*4096, LDS_MSK=LDS_BYTES, LDS_TAB=LDS_MSK+65536, LDS_TOTAL=LDS_TAB+4352;
constexpr float C2=0.125f*1.4426950408889634f;
__device__ __forceinline__ void glds16(const void*gsrc,unsigned lds_dst){unsigned keep;
  asm volatile("s_mov_b32 %0, m0\n\ts_mov_b32 m0, %2\n\ts_nop 0\n\tglobal_load_lds_dwordx4 %1, off\n\ts_mov_b32 m0, %0":"=&s"(keep):"v"(gsrc),"s"(lds_dst):"memory");}
__device__ __forceinline__ float max3f(float a,float b,float c){float r;asm("v_max3_f32 %0, %1, %2, %3":"=v"(r):"v"(a),"v"(b),"v"(c));return r;}
__device__ __forceinline__ float max2f(float a,float b){float r;asm("v_max_f32_e32 %0, %1, %2":"=v"(r):"v"(a),"v"(b));return r;}
__device__ __forceinline__ float fadd_s(float a,float b){float r;asm("v_add_f32_e32 %0, %1, %2":"=v"(r):"v"(a),"v"(b));return r;}
__device__ __forceinline__ float fsub_s(float a,float b){float r;asm("v_sub_f32_e32 %0, %1, %2":"=v"(r):"v"(a),"v"(b));return r;}
typedef float f32x2_t __attribute__((ext_vector_type(2))); typedef __bf16 bf16x2_t __attribute__((ext_vector_type(2)));
__device__ __forceinline__ unsigned cvtpk_s(float lo,float hi){f32x2_t v={lo,hi};bf16x2_t b=__builtin_convertvector(v,bf16x2_t);return __builtin_bit_cast(unsigned,b);}
#define WAIT_BAR(N) asm volatile("s_waitcnt vmcnt(" #N ") lgkmcnt(0)\n\ts_barrier":::"memory")

__device__ __forceinline__ void qkt(f32x16&p0,f32x16&p1,const char*Kslot,const bf16x8*qr,const f32x16&negm,int r32,int hi){
  const char*kb=Kslot+hi*1024+r32*16;
  #pragma unroll
  for(int d0=0;d0<4;++d0){
    const bf16x8 b0=*reinterpret_cast<const bf16x8*>(kb+d0*2048);
    const bf16x8 b1=*reinterpret_cast<const bf16x8*>(kb+d0*2048+512);
    if(d0==0){p0=__builtin_amdgcn_mfma_f32_32x32x16_bf16(b0,qr[0],negm,0,0,0);p1=__builtin_amdgcn_mfma_f32_32x32x16_bf16(b1,qr[0],negm,0,0,0);}
    else{p0=__builtin_amdgcn_mfma_f32_32x32x16_bf16(b0,qr[d0],p0,0,0,0);p1=__builtin_amdgcn_mfma_f32_32x32x16_bf16(b1,qr[d0],p1,0,0,0);}}
}
typedef __attribute__((address_space(3))) const char* lds_cptr;
typedef short v4i16_t __attribute__((ext_vector_type(4)));
__device__ __forceinline__ void kload8(bf16x8*kf,lds_cptr kp){
  kf[0]=*(const __attribute__((address_space(3))) bf16x8*)(kp);      kf[1]=*(const __attribute__((address_space(3))) bf16x8*)(kp+512);
  kf[2]=*(const __attribute__((address_space(3))) bf16x8*)(kp+2048); kf[3]=*(const __attribute__((address_space(3))) bf16x8*)(kp+2560);
  kf[4]=*(const __attribute__((address_space(3))) bf16x8*)(kp+4096); kf[5]=*(const __attribute__((address_space(3))) bf16x8*)(kp+4608);
  kf[6]=*(const __attribute__((address_space(3))) bf16x8*)(kp+6144); kf[7]=*(const __attribute__((address_space(3))) bf16x8*)(kp+6656);
}
__device__ __forceinline__ void kload2(bf16x8*kf,lds_cptr kp,int j){ kf[2*j]=*(const __attribute__((address_space(3))) bf16x8*)(kp+j*2048); kf[2*j+1]=*(const __attribute__((address_space(3))) bf16x8*)(kp+j*2048+512); }
__device__ __forceinline__ s16x4 vtr(lds_cptr p){ return __builtin_bit_cast(s16x4,__builtin_amdgcn_ds_read_tr16_b64_v4i16((__attribute__((address_space(3))) v4i16_t*)p)); }
__device__ __forceinline__ float rowmax(const f32x16&p0,const f32x16&p1){
  float a=max3f(p0[0],p0[1],p1[0]),b=max3f(p0[2],p0[3],p1[1]);a=max3f(a,p1[2],p1[3]);
  #pragma unroll
  for(int r=4;r<16;r+=4){a=max3f(a,p0[r],p0[r+1]);b=max3f(b,p0[r+2],p0[r+3]);a=max3f(a,p1[r],p1[r+1]);b=max3f(b,p1[r+2],p1[r+3]);}
  const float m=max2f(a,b);
  auto rr=__builtin_amdgcn_permlane32_swap(__float_as_uint(m),__float_as_uint(m),false,false);
  return max2f(__uint_as_float(rr[0]),__uint_as_float(rr[1]));
}
__device__ __forceinline__ void pv(f32x16*o,int vb,bf16x8 pa0,bf16x8 pa1,bf16x8 pa2,bf16x8 pa3){
  #pragma unroll
  for(int d0=0;d0<2;++d0){s16x4 lo[4],hi[4];
    #pragma unroll
    for(int ks=0;ks<4;++ks){
      asm volatile("ds_read_b64_tr_b16 %0,%1 offset:%c2":"=&v"(lo[ks]):"v"(vb),"i"(d0*4096+ks*1024):"memory");
      asm volatile("ds_read_b64_tr_b16 %0,%1 offset:%c2":"=&v"(hi[ks]):"v"(vb),"i"(d0*4096+ks*1024+512):"memory");}
    asm volatile("s_waitcnt lgkmcnt(0)":::"memory");SBAR();
    #define PK(k) (bf16x8){lo[k][0],lo[k][1],lo[k][2],lo[k][3],hi[k][0],hi[k][1],hi[k][2],hi[k][3]}
    o[d0]=__builtin_amdgcn_mfma_f32_32x32x16_bf16(pa0,PK(0),o[d0],0,0,0);
    o[d0]=__builtin_amdgcn_mfma_f32_32x32x16_bf16(pa1,PK(1),o[d0],0,0,0);
    o[d0]=__builtin_amdgcn_mfma_f32_32x32x16_bf16(pa2,PK(2),o[d0],0,0,0);
    o[d0]=__builtin_amdgcn_mfma_f32_32x32x16_bf16(pa3,PK(3),o[d0],0,0,0);
    #undef PK
  }
}

#ifndef ATTN_STORE16
#define ATTN_STORE16(p,v) (*(u32x4*)(p)=(v))
#endif
template<int THRL> __device__ __forceinline__ void attn_unit(int b,int h,int qb,const bf16*Q,const bf16*__restrict__ K,const bf16*__restrict__ V,bf16*O,const unsigned*__restrict__ MASK,const float*__restrict__ relb,char*shm){
  int tid0_=threadIdx.x; asm volatile("":"+v"(tid0_));
  const int tid=tid0_,lane=tid&63,r32=lane&31,hi=lane>>5; const int wid=__builtin_amdgcn_readfirstlane(tid>>6);
  const long rowbase=(long)b*SEQ; const int q0=qb*QB;
  const bf16*Qw=Q+(rowbase+q0+wid*QBLK)*DM+h*D;
  const bf16*Kh=K+rowbase*DM+h*D,*Vh=V+rowbase*DM+h*D;
  const unsigned lds0=(unsigned)(uintptr_t)shm;
  float*wsf=(float*)(shm+LDS_WS)+wid*64;
  const bf16*ksrc=Kh+(long)lane*DM+wid*8;
  const bf16*vsrc=Vh+(long)(16*(wid&3)+(lane>>2))*DM+(wid>>2)*32+(lane&3)*8;
  const unsigned kdst=lds0+LDS_K+wid*1024, vdst=lds0+LDS_V+wid*1024;
  #define DMA_K(t,slot) glds16(ksrc+(long)(t)*KVBLK*DM,(unsigned)__builtin_amdgcn_readfirstlane(kdst+(slot)))
  #define DMA_V(t,slot) glds16(vsrc+(long)(t)*KVBLK*DM,(unsigned)__builtin_amdgcn_readfirstlane(vdst+(slot)))
  const int vb0=(int)(lds0+LDS_V)+((lane>>4)&1)*32+(lane&3)*8+(4*hi+((lane&15)>>2))*64;
  const char*Kbase=shm+LDS_K; bf16x8 kf[8];
  const lds_cptr shm3=(lds_cptr)shm; const lds_cptr kp0=shm3+LDS_K+hi*1024+r32*16; const lds_cptr vp0=shm3+LDS_V+((lane>>4)&1)*32+(lane&3)*8+(4*hi+((lane&15)>>2))*64;
  const int NT=(q0+QB)/KVBLK;
  { int tid_=tid; asm volatile("":"+v"(tid_));
    const u32x4*msrc=(const u32x4*)(MASK+((size_t)(b*32)*SEQ+q0)*2); u32x4*mdst=(u32x4*)(shm+LDS_MSK);
    u32x4 mv[8]; const int nit=NT>>2;
    _Pragma("unroll") for(int k=0;k<8;++k){ const int i=tid_+k*(NW*64); if(k<nit) mv[k]=msrc[(size_t)(i>>7)*(SEQ*2/4)+(i&127)]; }
    _Pragma("unroll") for(int k=0;k<8;++k){ const int i=tid_+k*(NW*64); if(k<nit) mdst[i]=mv[k]; }
    for(int i=tid_;i<4*272;i+=NW*64){ const int sft=i/272, k=i-sft*272, d=200-(k+sft); float v=0.f;
      if(d>=0&&d<=112){ int bk; if(d<16)bk=d; else { bk=16+(int)(logf((float)d*(1.0f/16.0f))/2.0794415416798357f*16.0f); bk=bk>31?31:bk; } v=(relb[bk*NHEAD+h]-relb[31*NHEAD+h])*1.4426950408889634f; }
      ((float*)(shm+LDS_TAB))[i]=v; } }
  const unsigned*mskw=(const unsigned*)(shm+LDS_MSK)+(wid*QBLK+r32)*2+hi;
  const int qpos=q0+wid*QBLK+r32;
  DMA_K(0,0);DMA_V(0,0);DMA_K(1,SLOTB);
  bf16x8 qr[4];
  #pragma unroll
  for(int d0=0;d0<4;++d0)qr[d0]=*reinterpret_cast<const bf16x8*>(&Qw[(long)r32*DM+d0*16+hi*8]);
  float mhat=0.f,l_reg=0.f;f32x16 o[2];o[0]=f32x16{};o[1]=f32x16{};f32x16 negm=f32x16{};asm volatile("":"+v"(negm));
  #define CMASK(P0,P1,t) do{ if((t)>=NT-7 && 64*(t)+63+127>=q0+wid*QBLK) tbias(P0,P1,(t),qpos,hi,shm3+LDS_TAB); }while(0)
  bool resc=false;
  #define START(P0,P1) do{ const float rm=rowmax(P0,P1); resc=false; \
    { const float dl=rm; mhat=fadd_s(mhat,dl); \
      _Pragma("unroll") for(int r=0;r<16;++r){P0[r]=fsub_s(P0[r],dl);P1[r]=fsub_s(P1[r],dl);} \
      _Pragma("unroll") for(int r=0;r<16;++r)negm[r]=-mhat; asm volatile("":"+v"(negm)); } \
    _Pragma("unroll") for(int r=0;r<16;++r)P0[r]=__builtin_amdgcn_exp2f(P0[r]); }while(0)
  #define RESC() do{ if(resc){ asm volatile("s_waitcnt lgkmcnt(0)":::"memory"); \
      _Pragma("unroll") for(int d_=0;d_<2;++d_) _Pragma("unroll") for(int r=0;r<16;++r)o[d_][r]*=wsf[crow(r,hi)]; } }while(0)
  f32x16 pA0,pA1,pB0,pB1;
  int sl_prev=0,sl_cur=0,sl_next=SLOTB;
  #define ROT() do{sl_prev=sl_cur;sl_cur=sl_next;sl_next=(sl_next==(NSLOT-1)*SLOTB)?0:sl_next+SLOTB;}while(0)
  DMA_K(2,2*SLOTB);
  WAIT_BAR(3);
  qkt(pA0,pA1,Kbase,qr,negm,r32,hi);asm volatile("s_nop 15\n\ts_nop 7":"+v"(pA0),"+v"(pA1));CMASK(pA0,pA1,0);
  START(pA0,pA1);
  _Pragma("unroll") for(int r=0;r<16;++r)pA1[r]=__builtin_amdgcn_exp2f(pA1[r]);
  { const unsigned mw0=mskw[0]; _Pragma("unroll") for(int r=0;r<16;++r){pA0[r]=mkeep(pA0[r],mw0,r);pA1[r]=mkeep(pA1[r],mw0,16+r);} }
  WAIT_BAR(0);
  DMA_K(3,0);DMA_V(1,SLOTB);
  ROT();
  kload8(kf,kp0+sl_cur);
  WAIT_BAR(2);
  s16x4 vlo[8],vhi[8]; u32x4 pw0,pw1,pw2,pw3;
  #define PKW(P,B) cvtpk_s(P[B],P[B+1])
  #define PAF(k) __builtin_bit_cast(bf16x8,pw##k)
  #define VFR(i) (bf16x8){vlo[i][0],vlo[i][1],vlo[i][2],vlo[i][3],vhi[i][0],vhi[i][1],vhi[i][2],vhi[i][3]}
  #define PIN(x) asm volatile("":"+v"(x))
  #define MX3(a,b,c) __builtin_fmaxf(__builtin_fmaxf((a),(b)),(c))
  #define GAPA(MF,A0,A1,A2,A3,W0,W1,PW) do{ MF; sacc+=A0; sacc+=A1; sacc+=A2; sacc+=A3; PIN(sacc); W0; W1; PIN(PW); SBAR(); }while(0)
  #define EX(v) __builtin_amdgcn_exp2f(v)
  #define GAPB(MF,X,B,MB) do{ MF; X[B]=mkeep(EX(X[B]),mw_,MB+B); X[B+1]=mkeep(EX(X[B+1]),mw_,MB+B+1); X[B+2]=mkeep(EX(X[B+2]),mw_,MB+B+2); X[B+3]=mkeep(EX(X[B+3]),mw_,MB+B+3); PIN(X); SBAR(); }while(0)
  #define VRD(i) do{ vlo[i]=vtr(vp_+(((i)>>2)*4096+((i)&3)*1024)); vhi[i]=vtr(vp_+(((i)>>2)*4096+((i)&3)*1024+512)); }while(0)
  #define KRD(G,j) do{ if(G){ kload2(kf,kp0+sl_next,j); SBAR(); } }while(0)
  #define STEP(C0,C1,P0,P1,t,GK,GV,GL) do{ SBAR(); \
    const lds_cptr vp_=vp0+sl_prev; const unsigned mw_=mskw[(t)*512]; \
    VRD(0); SBAR(); float sacc=(P0[0]+P0[1]); \
    GAPA(C0=__builtin_amdgcn_mfma_f32_32x32x16_bf16(kf[0],qr[0],negm,0,0,0), P0[2],P0[3],P0[4],P0[5],     pw0[0]=PKW(P0,0), pw0[1]=PKW(P0,2), pw0); \
    VRD(4); SBAR(); GAPA(C1=__builtin_amdgcn_mfma_f32_32x32x16_bf16(kf[1],qr[0],negm,0,0,0), P0[6],P0[7],P0[8],P0[9],     pw0[2]=PKW(P0,4), pw0[3]=PKW(P0,6), pw0); \
    VRD(1); SBAR(); GAPA(C0=__builtin_amdgcn_mfma_f32_32x32x16_bf16(kf[2],qr[1],C0,0,0,0),   P0[10],P0[11],P0[12],P0[13], pw1[0]=PKW(P0,8), pw1[1]=PKW(P0,10), pw1); \
    VRD(5); SBAR(); GAPA(C1=__builtin_amdgcn_mfma_f32_32x32x16_bf16(kf[3],qr[1],C1,0,0,0),   P0[14],P0[15],P1[0],P1[1],   pw1[2]=PKW(P0,12),pw1[3]=PKW(P0,14), pw1); \
    VRD(2); SBAR(); GAPA(C0=__builtin_amdgcn_mfma_f32_32x32x16_bf16(kf[4],qr[2],C0,0,0,0),   P1[2],P1[3],P1[4],P1[5],     pw2[0]=PKW(P1,0), pw2[1]=PKW(P1,2), pw2); \
    VRD(6); SBAR(); GAPA(C1=__builtin_amdgcn_mfma_f32_32x32x16_bf16(kf[5],qr[2],C1,0,0,0),   P1[6],P1[7],P1[8],P1[9],     pw2[2]=PKW(P1,4), pw2[3]=PKW(P1,6), pw2); \
    VRD(3); SBAR(); GAPA(C0=__builtin_amdgcn_mfma_f32_32x32x16_bf16(kf[6],qr[3],C0,0,0,0),   P1[10],P1[11],P1[12],P1[13], pw3[0]=PKW(P1,8), pw3[1]=PKW(P1,10), pw3); \
    VRD(7); SBAR(); GAPA(C1=__builtin_amdgcn_mfma_f32_32x32x16_bf16(kf[7],qr[3],C1,0,0,0),   P1[14],P1[15],0.f,0.f,       pw3[2]=PKW(P1,12),pw3[3]=PKW(P1,14), pw3); \
    l_reg+=sacc; \
    if(GK){DMA_K((t)+3,sl_cur);} if(GV){DMA_V((t)+1,sl_next);} \
    CMASK(C0,C1,t); \
    { float a=MX3(C0[0],C0[1],C1[0]),b=MX3(C0[2],C0[3],C1[1]); a=MX3(a,C1[2],C1[3]); \
      _Pragma("unroll") for(int r=4;r<16;r+=4){a=MX3(a,C0[r],C0[r+1]);b=MX3(b,C0[r+2],C0[r+3]);a=MX3(a,C1[r],C1[r+1]);b=MX3(b,C1[r+2],C1[r+3]);} \
      float rm=__builtin_fmaxf(a,b); { auto rr=__builtin_amdgcn_permlane32_swap(__float_as_uint(rm),__float_as_uint(rm),false,false); rm=__builtin_fmaxf(__uint_as_float(rr[0]),__uint_as_float(rr[1])); } \
      resc=false; \
      if(__builtin_expect(__any(rm>(float)THRL),0)){ const float dl=__builtin_fmaxf(rm,0.f); mhat+=dl; \
        _Pragma("unroll") for(int r=0;r<16;++r){C0[r]-=dl;C1[r]-=dl;} \
        _Pragma("unroll") for(int r=0;r<16;++r)negm[r]=-mhat; asm volatile("":"+v"(negm)); \
        const float f=__builtin_amdgcn_exp2f(-dl); l_reg*=f; if(hi==0)wsf[r32]=f; resc=true; } } \
    SBAR(); \
    GAPB(o[0]=__builtin_amdgcn_mfma_f32_32x32x16_bf16(PAF(0),VFR(0),o[0],0,0,0), C0,0,0); \
    GAPB(o[1]=__builtin_amdgcn_mfma_f32_32x32x16_bf16(PAF(0),VFR(4),o[1],0,0,0), C0,4,0); \
    KRD(GL,0); GAPB(o[0]=__builtin_amdgcn_mfma_f32_32x32x16_bf16(PAF(1),VFR(1),o[0],0,0,0), C0,8,0); \
    KRD(GL,1); GAPB(o[1]=__builtin_amdgcn_mfma_f32_32x32x16_bf16(PAF(1),VFR(5),o[1],0,0,0), C0,12,0); \
    KRD(GL,2); GAPB(o[0]=__builtin_amdgcn_mfma_f32_32x32x16_bf16(PAF(2),VFR(2),o[0],0,0,0), C1,0,16); \
    KRD(GL,3); GAPB(o[1]=__builtin_amdgcn_mfma_f32_32x32x16_bf16(PAF(2),VFR(6),o[1],0,0,0), C1,4,16); \
    GAPB(o[0]=__builtin_amdgcn_mfma_f32_32x32x16_bf16(PAF(3),VFR(3),o[0],0,0,0), C1,8,16); \
    GAPB(o[1]=__builtin_amdgcn_mfma_f32_32x32x16_bf16(PAF(3),VFR(7),o[1],0,0,0), C1,12,16); \
    }while(0)
  int t=1;
  #undef CMASK
  #define CMASK(P0,P1,t) do{}while(0)
  for(;t+7<NT;t+=2){
    STEP(pB0,pB1,pA0,pA1,t,true,true,true);     WAIT_BAR(2); RESC(); ROT();
    STEP(pA0,pA1,pB0,pB1,t+1,true,true,true);   WAIT_BAR(2); RESC(); ROT();
  }
  #undef CMASK
  #define CMASK(P0,P1,t) do{ if(64*(t)+63+127>=q0+wid*QBLK) tbias(P0,P1,(t),qpos,hi,shm3+LDS_TAB); }while(0)
  #define ENDW(tt) do{ if((tt)+3<NT){WAIT_BAR(2);} else if((tt)+2<NT){WAIT_BAR(1);} else {WAIT_BAR(0);} }while(0)
  for(;t+1<NT;t+=2){
    STEP(pB0,pB1,pA0,pA1,t,(t+3<NT),(t+1<NT),(t+1<NT));       ENDW(t);   RESC(); ROT();
    STEP(pA0,pA1,pB0,pB1,t+1,(t+4<NT),(t+2<NT),(t+2<NT));     ENDW(t+1); RESC(); ROT();
  }
  STEP(pB0,pB1,pA0,pA1,NT-1,false,false,false); RESC();
  { float sacc=pB0[0]+pB0[1]; _Pragma("unroll") for(int r=2;r<16;++r)sacc+=pB0[r]; _Pragma("unroll") for(int r=0;r<16;++r)sacc+=pB1[r]; l_reg+=sacc;
    pw0=(u32x4){PKW(pB0,0),PKW(pB0,2),PKW(pB0,4),PKW(pB0,6)};pw1=(u32x4){PKW(pB0,8),PKW(pB0,10),PKW(pB0,12),PKW(pB0,14)};pw2=(u32x4){PKW(pB1,0),PKW(pB1,2),PKW(pB1,4),PKW(pB1,6)};pw3=(u32x4){PKW(pB1,8),PKW(pB1,10),PKW(pB1,12),PKW(pB1,14)};
    SBAR(); pv(o,vb0+sl_cur,PAF(0),PAF(1),PAF(2),PAF(3)); }
  #undef PKW
  #undef PAF
  #undef VFR
  #undef PIN
  #undef MX3
  #undef GAPA
  #undef GAPB
  #undef EX
  #undef VRD
  #undef KRD
  #undef STEP
  #undef ENDW
  {auto rr=__builtin_amdgcn_permlane32_swap(__float_as_uint(l_reg),__float_as_uint(l_reg),false,false);l_reg=__uint_as_float(rr[0])+__uint_as_float(rr[1]);}
  if(hi==0)wsf[32+r32]=l_reg;asm volatile("s_waitcnt lgkmcnt(0)":::"memory");
  float rli[16];
  #pragma unroll
  for(int r=0;r<16;++r)rli[r]=__builtin_amdgcn_rcpf(wsf[32+crow(r,hi)]);
  bf16*Ow=O+(rowbase+q0+wid*QBLK)*PO+h*D;
  { bf16*stg=(bf16*)(shm+LDS_OST)+wid*2048;
    #pragma unroll
    for(int r=0;r<16;++r){const int orow=crow(r,hi);
      #pragma unroll
      for(int d0=0;d0<2;++d0)stg[orow*64+d0*32+r32]=__float2bfloat16(o[d0][r]*rli[r]);}
    asm volatile("s_waitcnt lgkmcnt(0)":::"memory");
    #pragma unroll
    for(int i=0;i<4;++i){const int row=i*8+(lane>>3),ch=lane&7; const u32x4 v=*(const u32x4*)(stg+row*64+ch*8); ATTN_STORE16(Ow+(long)row*PO+ch*8,v);} }
  asm volatile("s_waitcnt lgkmcnt(0)\n\ts_barrier":::"memory");
  #undef DMA_K
  #undef DMA_V
  #undef CMASK
  #undef START
  #undef RESC
  #undef ROT
}
struct AttnTensors { const bf16* Q; const bf16* K; const bf16* V; bf16* O; const unsigned* MASK; const float* relb; };
struct AttnUnit { int bh; int qb; };
constexpr int ATTN_LDS_BYTES=LDS_TOTAL;
#undef SBAR
#undef WAIT_BAR
}
constexpr int NWAVES = 8;
#ifndef MK_N_LAUNCHES
#define MK_N_LAUNCHES 1
#endif
constexpr int PER_PHASE = 10;
constexpr int N_LAUNCHES = (MK_N_LAUNCHES == 1) ? 1 : PER_PHASE;
constexpr int M = 8 * 2048;
constexpr size_t MiB = 1u << 20;
constexpr size_t WS_CTL = 0, CTL_ZERO_BYTES = 65536;
constexpr size_t WS_RSTD1 = 1 * MiB, WS_ROWSS = 2 * MiB, WS_WR = 3 * MiB, WS_BLAST = 3 * MiB + 512 * 1024, WS_TOKINFO = 4 * MiB, WS_LISTS = 5 * MiB, WS_LSC = 7 * MiB;
constexpr size_t WS_WO = 16 * MiB, WS_WGU = 18 * MiB, WS_WD = 50 * MiB, WS_XB = 66 * MiB, WS_MASK = 66 * MiB, WS_SB = 70 * MiB, WS_EG = 86 * MiB  , WS_WIN = 98 * MiB;
constexpr size_t WS_QN = 106 * MiB, WS_KN = 122 * MiB, WS_VN = 138 * MiB, WS_XN2 = 106 * MiB, WS_IQ = 154 * MiB, WS_MISC = 162 * MiB, WS_QB = 164 * MiB, WS_KB = 172 * MiB, WS_VB = 180 * MiB, WS_RG = 196 * MiB;
constexpr size_t WS_MIX = 212 * MiB, WS_HID = 138 * MiB, WS_Y = 158 * MiB, WS_END = 244 * MiB;
constexpr int CW_TMO = 0, CW_CODE = 1, CW_BAR = 4096, CW_CNT = 15360;
constexpr int RING_BYTES = 154624;
constexpr int LDSCTL_OFF = RING_BYTES, MISC_OFF = LDSCTL_OFF, TOFF_OFF = LDSCTL_OFF + 256;
constexpr int LDS_BYTES = RING_BYTES + 1024;
static_assert(attn_body::ATTN_LDS_BYTES <= RING_BYTES, "attention LDS");
#ifndef REP_IDX
#define REP_IDX 1
#endif
#ifndef REP_GLAA
#define REP_GLAA 1
#endif
#ifndef REP_ATT
#define REP_ATT 1
#endif
#ifndef REP_GLAC
#define REP_GLAC 1
#endif
#ifndef REP_IDX_SCORE
#define REP_IDX_SCORE 1
#endif
#ifndef REP_IDX_SEL
#define REP_IDX_SEL 1
#endif
#ifndef REP_SEL_A
#define REP_SEL_A 1
#endif
#ifndef REP_SEL_B
#define REP_SEL_B 1
#endif
#ifndef REP_SEL_C
#define REP_SEL_C 1
#endif
#ifndef REP_SEL_CNT
#define REP_SEL_CNT 1
#endif
#ifndef REP_SEL_ST
#define REP_SEL_ST 1
#endif
#define GAS __attribute__((address_space(1)))
#define LAS __attribute__((address_space(3)))
typedef unsigned short bf16;
typedef unsigned v4u __attribute__((ext_vector_type(4)));
typedef float f32x4 __attribute__((ext_vector_type(4)));
typedef short bf16x8 __attribute__((ext_vector_type(8)));
typedef GAS unsigned gu32;
typedef GAS unsigned long long gu64;
#define RLX_AGENT __ATOMIC_RELAXED, __HIP_MEMORY_SCOPE_AGENT
#define LDS_WAIT() asm volatile("s_waitcnt lgkmcnt(0)" ::: "memory")
#define VM_WAIT() asm volatile("s_waitcnt vmcnt(0)" ::: "memory")
__device__ __forceinline__ unsigned long long rt() { return __builtin_amdgcn_s_memrealtime(); }
__device__ __forceinline__ unsigned f2bf(float f) { unsigned u = __builtin_bit_cast(unsigned, f); return (u + 0x7fffu + ((u >> 16) & 1u)) >> 16; }
__device__ __forceinline__ unsigned pk2(float lo, float hi) { return f2bf(lo) | (f2bf(hi) << 16); }

#define XB_TMO      128
#define XB_XCNT(j)  (256  + 64 * (j))
#define XB_XSUB(j)  (1280 + 64 * (j))
#define XB_XGEN(j)  (2304 + 64 * (j))
#define XB_TOP      3328
#define XB_TOPGEN   3392
#define XCD_BAR_WORDS 3456
#define XB_SPIN_CAP (1u << 18)

__device__ __forceinline__ unsigned xb_ld(unsigned* p)              { return __hip_atomic_load(p, __ATOMIC_RELAXED, __HIP_MEMORY_SCOPE_AGENT); }
__device__ __forceinline__ unsigned xb_add(unsigned* p, unsigned v) { return __hip_atomic_fetch_add(p, v, __ATOMIC_RELAXED, __HIP_MEMORY_SCOPE_AGENT); }
__device__ __forceinline__ unsigned xb_xcc_id() { return (unsigned)__builtin_amdgcn_s_getreg((3 << 11) | 20) & 0xFu; }
#define XB_SPIN(cond, bar) do { unsigned _sp = 0; while (cond) { __builtin_amdgcn_s_sleep(1); \
    if ((++_sp & 255u) == 0u) { if (xb_ld(&(bar)[XB_TMO])) break; if (_sp > XB_SPIN_CAP) { atomicAdd(&(bar)[XB_TMO], 1u); break; } } } } while (0)

struct XcdBarrier {
    unsigned* bar; unsigned x;
    volatile LAS unsigned* st;
};

__device__ __forceinline__ XcdBarrier xcd_barrier_post(unsigned* bar, volatile LAS unsigned* st) {
    XcdBarrier b; b.bar = bar; b.x = xb_xcc_id(); b.st = st;
    if (threadIdx.x == 0) (void)xb_add(&bar[XB_XCNT(b.x)], 1u);
    return b;
}
__device__ __forceinline__ void xcd_barrier_complete(unsigned* bar, unsigned x, unsigned& nloc, unsigned& nx) {
    const unsigned G = gridDim.x * gridDim.y * gridDim.z;
    unsigned sum, cnt, mine, sp = 0u;
    for (;;) {
        sum = 0u; cnt = 0u; mine = 0u;
#pragma unroll
        for (unsigned j = 0; j < 16; ++j) { const unsigned c = xb_ld(&bar[XB_XCNT(j)]); sum += c; cnt += (c > 0u) ? 1u : 0u; mine = (j == x) ? c : mine; }
        if (sum == G) break;
        __builtin_amdgcn_s_sleep(1);
        if ((++sp & 255u) == 0u) { if (xb_ld(&bar[XB_TMO])) break; if (sp > XB_SPIN_CAP) { atomicAdd(&bar[XB_TMO], 1u); break; } }
    }
    nloc = mine > 0u ? mine : 1u; nx = cnt > 0u ? cnt : 1u;
}

__device__ __forceinline__ void xcd_barrier(const XcdBarrier& b) {
    asm volatile("s_waitcnt vmcnt(0)" ::: "memory");
    __syncthreads();
    if (threadIdx.x == 0) {
        unsigned* bar = b.bar;
        __builtin_amdgcn_s_waitcnt(0);
        unsigned nloc = b.st[0], nx = b.st[1];
        if (nloc == 0u) { xcd_barrier_complete(bar, b.x, nloc, nx); b.st[0] = nloc; b.st[1] = nx; }
        const unsigned old = xb_add(&bar[XB_XSUB(b.x)], 1u);
        const unsigned gen = old / nloc;
        if (old + 1u == (gen + 1u) * nloc) {
            __builtin_amdgcn_fence(__ATOMIC_RELEASE, "agent");
            asm volatile("s_waitcnt vmcnt(0)" ::: "memory");
            const unsigned og = xb_add(&bar[XB_TOP], 1u);
            const unsigned tg = og / nx;
            if (og + 1u == (tg + 1u) * nx) xb_add(&bar[XB_TOPGEN], 1u);
            else XB_SPIN(xb_ld(&bar[XB_TOPGEN]) == tg, bar);
            __builtin_amdgcn_fence(__ATOMIC_ACQUIRE, "agent");
            xb_add(&bar[XB_XGEN(b.x)], 1u);
            asm volatile("s_waitcnt vmcnt(0)" ::: "memory");
        } else {
            XB_SPIN(xb_ld(&bar[XB_XGEN(b.x)]) == gen, bar);
            __builtin_amdgcn_fence(__ATOMIC_ACQUIRE, "agent");
            asm volatile("s_waitcnt vmcnt(0)" ::: "memory");
        }
    }
    __syncthreads();
}
typedef float f32x2 __attribute__((ext_vector_type(2)));
typedef unsigned v2u __attribute__((ext_vector_type(2)));
__device__ __forceinline__ float bf2f(unsigned short b) { return __uint_as_float((unsigned)b << 16); }
__device__ __forceinline__ float bflo(unsigned w) { return __uint_as_float(w << 16); }
__device__ __forceinline__ float bfhi(unsigned w) { return __uint_as_float(w & 0xffff0000u); }
__device__ __forceinline__ float wave_sum(float v) {
#pragma unroll
    for (int o = 1; o < 64; o <<= 1) v += __shfl_xor(v, o);
    return v;
}
__device__ __forceinline__ float wave_max(float v) {
#pragma unroll
    for (int o = 1; o < 64; o <<= 1) v = fmaxf(v, __shfl_xor(v, o));
    return v;
}
__device__ __forceinline__ float wave_min(float v) {
#pragma unroll
    for (int o = 1; o < 64; o <<= 1) v = fminf(v, __shfl_xor(v, o));
    return v;
}
#define WG_SYNC() __syncthreads()
#define DPP_STEP_I(v, ctrl) __builtin_amdgcn_update_dpp(0, (v), (ctrl), 0xF, 0xF, false)
__device__ __forceinline__ int wave_isum(int v) {
    v += DPP_STEP_I(v, 0xB1); v += DPP_STEP_I(v, 0x4E); v += DPP_STEP_I(v, 0x141); v += DPP_STEP_I(v, 0x140);
    return __builtin_amdgcn_readlane(v, 0) + __builtin_amdgcn_readlane(v, 16) + __builtin_amdgcn_readlane(v, 32) + __builtin_amdgcn_readlane(v, 48);
}
#define DPP_STEP_F(v, ctrl) __uint_as_float((unsigned)__builtin_amdgcn_update_dpp(0, (int)__float_as_uint(v), (ctrl), 0xF, 0xF, false))
#define RDL_F(v, l) __uint_as_float((unsigned)__builtin_amdgcn_readlane((int)__float_as_uint(v), (l)))
__device__ __forceinline__ float wave_fsum(float v) {
    v += DPP_STEP_F(v, 0xB1); v += DPP_STEP_F(v, 0x4E); v += DPP_STEP_F(v, 0x141); v += DPP_STEP_F(v, 0x140);
    return (RDL_F(v, 0) + RDL_F(v, 16)) + (RDL_F(v, 32) + RDL_F(v, 48));
}
__device__ __forceinline__ float wave_fmax(float v) {
    v = fmaxf(v, DPP_STEP_F(v, 0xB1)); v = fmaxf(v, DPP_STEP_F(v, 0x4E)); v = fmaxf(v, DPP_STEP_F(v, 0x141)); v = fmaxf(v, DPP_STEP_F(v, 0x140));
    return fmaxf(fmaxf(RDL_F(v, 0), RDL_F(v, 16)), fmaxf(RDL_F(v, 32), RDL_F(v, 48)));
}
__device__ __forceinline__ float wave_fmin(float v) {
    v = fminf(v, DPP_STEP_F(v, 0xB1)); v = fminf(v, DPP_STEP_F(v, 0x4E)); v = fminf(v, DPP_STEP_F(v, 0x141)); v = fminf(v, DPP_STEP_F(v, 0x140));
    return fminf(fminf(RDL_F(v, 0), RDL_F(v, 16)), fminf(RDL_F(v, 32), RDL_F(v, 48)));
}

__device__ __forceinline__ int win_vrow(int n) {
    if (n < 1024) { const int base = (n < 512) ? 0 : 512, m = n - base, hh = m >> 6, d = m & 63; return base + 256 * (hh >> 2) + 128 * (d >> 5) + 32 * (hh & 3) + (d & 31); }
    if (n < 1792) return n;
    if (n < 1832) return 3328 + (n - 1792);
    if (n < 2088) return 1792 + (n - 1832);
    if (n < 2344) return 2048 + (n - 2088);
    if (n < 2856) return 2304 + (n - 2344);
    if (n < 2872) return 3328 + 40 + (n - 2856);
    return 2816 + (n - 2872);
}
template <int KIND>
__device__ __forceinline__ void p0_transpose_item(const float* __restrict__ W, int K, int N, const float* __restrict__ gain, bf16* WT, LAS float* scr, int item, int lane) {
    const int nblk = (N + 31) / 32, kb = item / nblk, nb = item % nblk, k0 = 64 * kb, n0 = 32 * nb;
    f32x4 v[8];
#pragma unroll
    for (int j = 0; j < 8; ++j) { const int i = lane + 64 * j, kk = i >> 3, c4 = (i & 7) * 4; v[j] = (n0 + c4 < N) ? *(const f32x4*)(W + (size_t)(k0 + kk) * N + n0 + c4) : (f32x4){0.f, 0.f, 0.f, 0.f}; }
#pragma unroll
    for (int j = 0; j < 8; ++j) { const int i = lane + 64 * j, kk = i >> 3, c4 = (i & 7) * 4; f32x4 x = v[j]; if (gain) x = x * gain[k0 + kk];
        scr[kk * 33 + c4] = x[0]; scr[kk * 33 + c4 + 1] = x[1]; scr[kk * 33 + c4 + 2] = x[2]; scr[kk * 33 + c4 + 3] = x[3]; }
    LDS_WAIT(); asm volatile("" ::: "memory");
    const int c = lane & 7;
#pragma unroll
    for (int j = 0; j < 4; ++j) { const int n = (lane >> 3) + 8 * j; const LAS float* s = scr + (8 * c) * 33 + n;
        v4u o; o.x = pk2(s[0 * 33], s[1 * 33]); o.y = pk2(s[2 * 33], s[3 * 33]); o.z = pk2(s[4 * 33], s[5 * 33]); o.w = pk2(s[6 * 33], s[7 * 33]);
        const int gn = n0 + n; int row;
        if (KIND == 0) row = win_vrow(gn); else if (KIND == 1) row = gn; else if (KIND == 2) row = (gn >> 7) * 256 + (gn & 127); else row = (gn >> 7) * 256 + 128 + (gn & 127);
        if (gn < N) *(GAS v4u*)(WT + (size_t)row * K + k0 + 8 * c) = o; }
    LDS_WAIT(); asm volatile("" ::: "memory");
}

constexpr int SCP = 2064;
__device__ __forceinline__ int crow_(int r, int hi) { return (r & 3) + 8 * (r >> 2) + 4 * hi; }
__device__ __forceinline__ void idx_item(LAS unsigned char* lds, int b, int p, const bf16* __restrict__ IQ, const bf16* __restrict__ MISC, unsigned* __restrict__ MASK, int lane, int wid) {
    const int q0 = p * 16, fr = lane & 15, fq = lane >> 4;
    LAS float* SC = (LAS float*)lds;
    const size_t rowq = (size_t)b * 2048 + q0 + fr;
    bf16x8 Bq[8]; float sinf[8];
    {   const v4u wraw = *(const v4u*)(MISC + rowq * 64 + 32);
        const unsigned wr_[4] = {wraw.x, wraw.y, wraw.z, wraw.w};
#pragma unroll
        for (int h = 0; h < 8; ++h) { const float w = ((h & 1) ? bfhi(wr_[h >> 1]) : bflo(wr_[h >> 1])) * 0.0625f;
            const v4u raw = *(const v4u*)(IQ + rowq * 256 + h * 32 + fq * 8);
            v4u o; o.x = pg8::cvt_pk_bf16(bflo(raw.x) * w, bfhi(raw.x) * w); o.y = pg8::cvt_pk_bf16(bflo(raw.y) * w, bfhi(raw.y) * w); o.z = pg8::cvt_pk_bf16(bflo(raw.z) * w, bfhi(raw.z) * w); o.w = pg8::cvt_pk_bf16(bflo(raw.w) * w, bfhi(raw.w) * w);
            Bq[h] = __builtin_bit_cast(bf16x8, o); sinf[h] = (w > 0.f) ? __builtin_inff() : -__builtin_inff(); } }
    const int nkt = p + 1;
    LAS int* const ROWCTR = (LAS int*)(lds + 16 * SCP * 4);
    if (wid == 0 && lane == 0) ROWCTR[0] = 0;
    const bf16* ikb = MISC + ((size_t)b * 2048 + fr) * 64 + fq * 8;
    for (int rep_ = 0; rep_ < REP_IDX_SCORE; ++rep_)
    for (int kt0 = wid; kt0 < nkt; kt0 += 32) {
        f32x4 acc[4]; bf16x8 A[4];
#pragma unroll
        for (int u = 0; u < 4; ++u) { const int kt = kt0 + 8 * u; acc[u] = (f32x4){0.f, 0.f, 0.f, 0.f}; if (kt < nkt) A[u] = *(const bf16x8*)(ikb + (size_t)kt * 16 * 64); else A[u] = (bf16x8){0, 0, 0, 0, 0, 0, 0, 0}; }
#pragma unroll
        for (int h = 0; h < 8; ++h)
#pragma unroll
            for (int u = 0; u < 4; ++u) { const f32x4 t = __builtin_amdgcn_mfma_f32_16x16x32_bf16(A[u], Bq[h], acc[u], 0, 0, 0);
#pragma unroll
                for (int i = 0; i < 4; ++i) acc[u][i] = __builtin_amdgcn_fmed3f(t[i], acc[u][i], sinf[h]); }
#pragma unroll
        for (int u = 0; u < 4; ++u) { const int kt = kt0 + 8 * u;
            if (kt < nkt) { if (kt == nkt - 1) {
#pragma unroll
                    for (int i = 0; i < 4; ++i) if (4 * fq + i > fr) acc[u][i] = -__builtin_inff(); }
                *(LAS f32x4*)(SC + fr * SCP + kt * 16 + 4 * fq) = acc[u]; } }
    }
    WG_SYNC();
    const int kap = 32 * ((lane >> 4) & 1) + crow_(lane & 15, lane >> 5);
#define IDX_COUNT(dst, expr) do { int cl__ = 0; _Pragma("unroll") for (int g__ = 0; g__ < 4; ++g__) if (8 * g__ < ntile) { _Pragma("unroll") for (int jj__ = 0; jj__ < 8; ++jj__) { const int j = 8 * g__ + jj__; cl__ += (expr) ? 1 : 0; } } \
        dst = wave_isum(cl__); } while (0)
#define IDX_UNI(v) __uint_as_float((unsigned)__builtin_amdgcn_readfirstlane((int)__float_as_uint(v)))
    for (;;) {
        int r = 0; if (lane == 0) r = __hip_atomic_fetch_add(ROWCTR, 1, __ATOMIC_RELAXED, __HIP_MEMORY_SCOPE_WORKGROUP);
        r = __builtin_amdgcn_readfirstlane(r); if (r >= 16) break;
        r = 15 - r;
        const int q = q0 + r, n = q + 1, ntile = (q >> 6) + 1, ngrp = (ntile + 7) >> 3;
        const float NINF = -__builtin_inff();
        float x[32]; unsigned vmask = 0u;
        for (int rpa = 0; rpa < REP_SEL_A; ++rpa) { int off_ = 0; asm volatile("" : "+v"(off_)); vmask = 0u;
#pragma unroll
        for (int j = 0; j < 32; ++j) x[j] = SC[r * SCP + 64 * j + kap + off_];
#pragma unroll
        for (int j = 0; j < 32; ++j) { const bool v = (64 * j + kap + off_) <= q; vmask |= v ? (1u << j) : 0u; x[j] = v ? x[j] : NINF; }
        }
        unsigned selm = vmask;
        for (int rpb = 0; rpb < REP_SEL_B; ++rpb) { asm volatile("" : "+v"(x[0]), "+v"(vmask)); selm = vmask;
        if (n > 256) {
            float mx = NINF, mn = __builtin_inff(), s1 = 0.f, s2 = 0.f;
#pragma unroll
            for (int g = 0; g < 4; ++g) if (g < ngrp) {
#pragma unroll
                for (int jj = 0; jj < 8; ++jj) { const int j = 8 * g + jj; const bool v = (vmask >> j) & 1u; const float xv = v ? x[j] : 0.f; mx = fmaxf(mx, x[j]); mn = fminf(mn, v ? x[j] : __builtin_inff()); s1 += xv; s2 += xv * xv; } }
            float hi = IDX_UNI(wave_fmax(mx)), lo = IDX_UNI(wave_fmin(mn));
            const float fn = (float)n, mu = wave_fsum(s1) / fn, var = fmaxf(wave_fsum(s2) / fn - mu * mu, 0.f);
            int c_lo = n, c_hi = 1;
            bool tie = false, found = false; float tv = hi, thr = hi; int need = 256;
            float mid; { const float pq = 256.0f / fn, pp = pq <= 0.5f ? pq : 1.0f - pq; const float t = sqrtf(-2.0f * __logf(pp)); float z = t - (2.30753f + 0.27061f * t) / (1.0f + t * (0.99229f + 0.04481f * t)); z = pq <= 0.5f ? z : -z; mid = IDX_UNI(mu + z * sqrtf(var)); }
            int side = 0;
            for (int it = 0; it < 40; ++it) {
                if (it > 0 || !(mid > lo && mid < hi)) {
                    mid = 0.5f * lo + 0.5f * hi;
                    if (side > -2 && side < 2) { const float fr_ = ((float)(c_lo - 256) + 0.5f) * __builtin_amdgcn_rcpf((float)(c_lo - c_hi)); const float m2 = lo + (hi - lo) * fr_; if (m2 > lo && m2 < hi) mid = m2; } else side = 0;
                    mid = IDX_UNI(mid);
                }
                if (!(mid > lo && mid < hi)) break;
                unsigned a0 = 0u, a1 = 0u;
#pragma unroll
                for (int g = 1; g >= 0; --g) if (g < ngrp) {
#pragma unroll
                    for (int jj = 7; jj >= 0; --jj) a0 = __builtin_amdgcn_alignbit(a0, __float_as_uint(x[8 * g + jj] - mid), 31); }
#pragma unroll
                for (int g = 3; g >= 2; --g) if (g < ngrp) {
#pragma unroll
                    for (int jj = 7; jj >= 0; --jj) a1 = __builtin_amdgcn_alignbit(a1, __float_as_uint(x[8 * g + jj] - mid), 31); }
                const int c = 64 * 8 * ngrp - wave_isum(__builtin_popcount(a0) + __builtin_popcount(a1));
                if (c == 256) { found = true; selm = vmask & ~(a0 | (a1 << 16)); thr = mid; break; }
                if (c > 256) { lo = mid; c_lo = c; side = side > 0 ? side + 1 : 1; } else { hi = mid; c_hi = c; side = side < 0 ? side - 1 : -1; }
            }
            if (!found) {
                IDX_COUNT(c_hi, x[j] >= hi);
                if (c_hi >= 256) { if (c_hi == 256) { thr = hi; found = true; } else { tie = true; tv = hi; need = 256; } }
                else for (int it = 0; it < 4096; ++it) {
                    float m = NINF;
#pragma unroll
                    for (int g = 0; g < 4; ++g) if (g < ngrp) {
#pragma unroll
                        for (int jj = 0; jj < 8; ++jj) { const int j = 8 * g + jj; m = fmaxf(m, (x[j] < hi) ? x[j] : NINF); } }
                    const float v1 = IDX_UNI(wave_fmax(m));
                    int c; IDX_COUNT(c, x[j] >= v1);
                    if (c >= 256) { if (c == 256) { thr = v1; found = true; } else { tie = true; tv = v1; need = 256 - c_hi; } break; }
                    hi = v1; c_hi = c;
                }
                if (!tie) { selm = 0u;
#pragma unroll
                    for (int j = 0; j < 32; ++j) selm |= (x[j] >= thr) ? (1u << j) : 0u;
                } else {
                    int cum = 0, jstar = 32, needp = 0; unsigned tiem = 0u; selm = 0u;
#pragma unroll
                    for (int j = 0; j < 32; ++j) { const bool t = (x[j] == tv); tiem |= t ? (1u << j) : 0u; const int cj = __builtin_popcountll(__ballot(t));
                        if (jstar == 32 && cum + cj > need) { jstar = j; needp = need - cum; } cum += cj; }
                    const bool tstar = (jstar < 32) && ((tiem >> (jstar & 31)) & 1u);
                    int kL = 0, kH = 63;
                    if (jstar < 32 && needp > 0) { while (kL < kH) { const int km = (kL + kH) >> 1; const int c = __builtin_popcountll(__ballot(tstar && kap <= km)); if (c >= needp) kH = km; else kL = km + 1; } }
                    else kL = -1;
#pragma unroll
                    for (int j = 0; j < 32; ++j) { const bool t = (tiem >> j) & 1u; const bool ts = t && (j < jstar || (j == jstar && kap <= kL)); selm |= (x[j] > tv || ts) ? (1u << j) : 0u; }
                }
            }
        }
        }
        unsigned wlo = 0u, whi = 0u;
        for (int rpc = 0; rpc < REP_SEL_C; ++rpc) { asm volatile("" : "+v"(selm));
#pragma unroll
        for (int j = 0; j < 32; ++j) { const unsigned long long bal = __ballot((selm >> j) & 1u); if (lane == j) { wlo = (unsigned)bal; whi = (unsigned)(bal >> 32); } }
        if (lane < 32) { v2u o; o.x = wlo; o.y = whi; *(v2u*)(MASK + (((size_t)(b * 32 + lane)) * 2048 + q) * 2) = o; }
        }
    }
#undef IDX_COUNT
#undef IDX_UNI
    WG_SYNC();
}

constexpr int KTP = 72;
constexpr int VRP = 136;
constexpr int EP = 68;
constexpr int OTP = 132;
constexpr int GL_OFF = 0, TOT_OFF = 4096, E_OFF = 6144, QA_OFF = 23552, KR_OFF = 32768, PM_OFF = 41984, VR_OFF = 51200, OT_OFF = 68608;
typedef short v4i16g __attribute__((ext_vector_type(4)));
__device__ __forceinline__ bf16x8 tr_frag(const LAS bf16* T, int pitch, int k0, int n0, int lane) {
    const int g = lane >> 4, q = (lane & 15) >> 2, p = lane & 3;
    const LAS bf16* a = T + (k0 + 8 * g + q) * pitch + n0 + 4 * p;
    const v4i16g lo = __builtin_amdgcn_ds_read_tr16_b64_v4i16((LAS v4i16g*)a), hi = __builtin_amdgcn_ds_read_tr16_b64_v4i16((LAS v4i16g*)(a + 4 * pitch));
    return (bf16x8){lo[0], lo[1], lo[2], lo[3], hi[0], hi[1], hi[2], hi[3]};
}
__device__ __forceinline__ float fexp(float x) { return __builtin_amdgcn_exp2f(x * 1.4426950408889634f); }
__device__ __forceinline__ float gla_decay(LAS unsigned char* lds, const bf16* __restrict__ MISC, const float* __restrict__ w2, const float* __restrict__ gb, size_t row0, int h, int tid) {
    LAS float* GL = (LAS float*)(lds + GL_OFF); LAS float* TOT = (LAS float*)(lds + TOT_OFF); LAS float* E = (LAS float*)(lds + E_OFF);
    const int d = tid & 63, tg = tid >> 6;
    { const int t = tid >> 3, r2 = (tid & 7) * 2; const unsigned w = *(const unsigned*)(MISC + (row0 + t) * 64 + 40 + r2); GL[t * 16 + r2] = bflo(w); GL[t * 16 + r2 + 1] = bfhi(w); }
    float wc[16];
#pragma unroll
    for (int r = 0; r < 16; ++r) wc[r] = w2[r * 256 + h * 64 + d];
    const float bias = gb[h * 64 + d];
    WG_SYNC();
    float bc[8]; float run = 0.f;
#pragma unroll
    for (int i = 0; i < 8; ++i) { const int t = 8 * tg + i; float z = bias;
#pragma unroll
        for (int r4 = 0; r4 < 4; ++r4) { const f32x4 g = *(const LAS f32x4*)(GL + t * 16 + 4 * r4); z += g[0] * wc[4 * r4] + g[1] * wc[4 * r4 + 1] + g[2] * wc[4 * r4 + 2] + g[3] * wc[4 * r4 + 3]; }
        const float ls = fminf(z, 0.f) - 0.6931471805599453f * __builtin_amdgcn_logf(1.0f + __builtin_amdgcn_exp2f(-1.4426950408889634f * fabsf(z)));
        run += ls * (1.0f / 16.0f); bc[i] = run; }
    TOT[tg * 64 + d] = run;
    WG_SYNC();
    float pre = 0.f, tot = 0.f;
#pragma unroll
    for (int g = 0; g < 8; ++g) { const float v = TOT[g * 64 + d]; tot += v; if (g < tg) pre += v; }
#pragma unroll
    for (int i = 0; i < 8; ++i) E[(8 * tg + i) * EP + d] = fexp(tot - (bc[i] + pre));
    return tot;
}
__device__ __forceinline__ void gla_load_v(LAS unsigned char* lds, const bf16* __restrict__ VB, size_t row0, int h, int tid) {
    LAS bf16* VR = (LAS bf16*)(lds + VR_OFF); const int t = tid >> 3, v0 = (tid & 7) * 16; const bf16* src = VB + (row0 + t) * 512 + h * 128 + v0;
    const v4u a = *(const v4u*)src, b = *(const v4u*)(src + 8);
    *(LAS v4u*)(VR + t * VRP + v0) = a; *(LAS v4u*)(VR + t * VRP + v0 + 8) = b;
}
__device__ __forceinline__ v4u scale8(v4u raw, const f32x4 e0, const f32x4 e1) {
    v4u o; o.x = pg8::cvt_pk_bf16(bflo(raw.x) * e0[0], bfhi(raw.x) * e0[1]); o.y = pg8::cvt_pk_bf16(bflo(raw.y) * e0[2], bfhi(raw.y) * e0[3]);
    o.z = pg8::cvt_pk_bf16(bflo(raw.z) * e1[0], bfhi(raw.z) * e1[1]); o.w = pg8::cvt_pk_bf16(bflo(raw.w) * e1[2], bfhi(raw.w) * e1[3]); return o;
}
__device__ __forceinline__ void gla_a_item(LAS unsigned char* lds, int id, const bf16* __restrict__ KB, const bf16* __restrict__ VB, const bf16* __restrict__ MISC, const float* __restrict__ w2, const float* __restrict__ gb,
                                           float* __restrict__ U, float* __restrict__ BLAST, float* __restrict__ EG, int tid, int lane, int wid) {
    const int b = id >> 7, h = (id >> 5) & 3, c = id & 31; const size_t row0 = (size_t)b * 2048 + 64 * c;
    const v4u kraw = *(const v4u*)(KB + (row0 + (tid >> 3)) * 256 + h * 64 + (tid & 7) * 8);
    gla_load_v(lds, VB, row0, h, tid);
    const float blast = gla_decay(lds, MISC, w2, gb, row0, h, tid);
    if (tid < 64) BLAST[(size_t)id * 64 + tid] = blast;
    WG_SYNC();
    LAS bf16* KR = (LAS bf16*)(lds + KR_OFF); LAS bf16* VR = (LAS bf16*)(lds + VR_OFF); const LAS float* E = (const LAS float*)(lds + E_OFF);
    { const int t = tid >> 3, d8 = (tid & 7) * 8; const f32x4 e0 = *(const LAS f32x4*)(E + t * EP + d8), e1 = *(const LAS f32x4*)(E + t * EP + d8 + 4); *(LAS v4u*)(KR + t * KTP + d8) = scale8(kraw, e0, e1);
      float* eg = EG + ((size_t)id * 64 + t) * 64 + d8; *(f32x4*)eg = e0; *(f32x4*)(eg + 4) = e1; }
    WG_SYNC();
    const int fr = lane & 15, fq = lane >> 4;
    bf16x8 Bf[2];
#pragma unroll
    for (int kk = 0; kk < 2; ++kk) Bf[kk] = tr_frag(VR, VRP, 32 * kk, 16 * wid, lane);
#pragma unroll
    for (int dt = 0; dt < 4; ++dt) { f32x4 acc = (f32x4){0.f, 0.f, 0.f, 0.f};
#pragma unroll
        for (int kk = 0; kk < 2; ++kk) { const bf16x8 Af = tr_frag(KR, KTP, 32 * kk, 16 * dt, lane); acc = __builtin_amdgcn_mfma_f32_16x16x32_bf16(Af, Bf[kk], acc, 0, 0, 0); }
        *(f32x4*)(U + ((size_t)id * 128 + 16 * wid + fr) * 64 + 16 * dt + 4 * fq) = acc; }
    WG_SYNC();
}
__device__ __forceinline__ void gla_b_item(int item, const float* __restrict__ U, const float* __restrict__ BLAST, bf16* __restrict__ SB, int tid) {
    const int bh = item >> 2, qt = item & 3; const size_t eoff = (size_t)qt * 2048 + (size_t)tid * 4; const int d0 = (tid * 4) & 63;
    f32x4 S = (f32x4){0.f, 0.f, 0.f, 0.f};
#pragma unroll 1
    for (int half = 0; half < 2; ++half) {
        f32x4 u[16], bl[16];
#pragma unroll
        for (int c = 0; c < 16; ++c) { const size_t id = (size_t)bh * 32 + 16 * half + c; u[c] = *(const f32x4*)(U + id * 8192 + eoff); bl[c] = *(const f32x4*)(BLAST + id * 64 + d0); }
#pragma unroll
        for (int c = 0; c < 16; ++c) { const size_t id = (size_t)bh * 32 + 16 * half + c;
            f32x4 e; e[0] = __expf(bl[c][0]); e[1] = __expf(bl[c][1]); e[2] = __expf(bl[c][2]); e[3] = __expf(bl[c][3]);
            const f32x4 sd = S * e; v2u o; o.x = pk2(sd[0], sd[1]); o.y = pk2(sd[2], sd[3]); *(v2u*)(SB + id * 8192 + eoff) = o; S = sd + u[c]; }
    }
}
__device__ __forceinline__ void gla_c_item(LAS unsigned char* lds, int id, const bf16* __restrict__ QB, const bf16* __restrict__ KB, const bf16* __restrict__ VB, const bf16* __restrict__ RG, const float* __restrict__ EG,
                                           const float* __restrict__ og, const bf16* __restrict__ SB, bf16* __restrict__ MIX, int tid, int lane, int wid) {
    const int b = id >> 7, h = (id >> 5) & 3, c = id & 31; const size_t row0 = (size_t)b * 2048 + 64 * c;
    const int st_t = tid >> 3, st_d8 = (tid & 7) * 8;
    const v4u kraw = *(const v4u*)(KB + (row0 + st_t) * 256 + h * 64 + st_d8), qraw = *(const v4u*)(QB + (row0 + st_t) * 256 + h * 64 + st_d8);
    const float* eg = EG + ((size_t)id * 64 + st_t) * 64 + st_d8; const f32x4 e0 = *(const f32x4*)eg, e1 = *(const f32x4*)(eg + 4);
    gla_load_v(lds, VB, row0, h, tid);
    const int fr = lane & 15, fq = lane >> 4;
    bf16x8 Bs[2];
    { const bf16* sbp = SB + ((size_t)id * 128 + 16 * wid + fr) * 64 + 8 * fq; Bs[0] = *(const bf16x8*)sbp; Bs[1] = *(const bf16x8*)(sbp + 32); }
    LAS bf16* QA = (LAS bf16*)(lds + QA_OFF); LAS bf16* KR = (LAS bf16*)(lds + KR_OFF); LAS bf16* PM = (LAS bf16*)(lds + PM_OFF); LAS bf16* VR = (LAS bf16*)(lds + VR_OFF);
    LAS float* OT = (LAS float*)(lds + OT_OFF);
    { f32x4 r0, r1;
#pragma unroll
      for (int i = 0; i < 4; ++i) { r0[i] = 0.125f * __builtin_amdgcn_rcpf(e0[i]); r1[i] = 0.125f * __builtin_amdgcn_rcpf(e1[i]); }
      *(LAS v4u*)(KR + st_t * KTP + st_d8) = scale8(kraw, e0, e1); *(LAS v4u*)(QA + st_t * KTP + st_d8) = scale8(qraw, r0, r1); }
    WG_SYNC();
    { const int tt = wid >> 1;
#pragma unroll
      for (int s2 = 0; s2 < 2; ++s2) { const int st = 2 * (wid & 1) + s2; f32x4 acc = (f32x4){0.f, 0.f, 0.f, 0.f};
        if (st <= tt) {
#pragma unroll
            for (int kk = 0; kk < 2; ++kk) { const bf16x8 Af = *(const LAS bf16x8*)(KR + (16 * st + fr) * KTP + 32 * kk + 8 * fq); const bf16x8 Bf = *(const LAS bf16x8*)(QA + (16 * tt + fr) * KTP + 32 * kk + 8 * fq);
                acc = __builtin_amdgcn_mfma_f32_16x16x32_bf16(Af, Bf, acc, 0, 0, 0); } }
        const int t = 16 * tt + fr, s0 = 16 * st + 4 * fq; v2u o;
        o.x = pg8::cvt_pk_bf16((s0 <= t) ? acc[0] : 0.f, (s0 + 1 <= t) ? acc[1] : 0.f); o.y = pg8::cvt_pk_bf16((s0 + 2 <= t) ? acc[2] : 0.f, (s0 + 3 <= t) ? acc[3] : 0.f);
        *(LAS v2u*)(PM + t * KTP + s0) = o; } }
    WG_SYNC();
    bf16x8 Bv[2];
#pragma unroll
    for (int kk = 0; kk < 2; ++kk) Bv[kk] = tr_frag(VR, VRP, 32 * kk, 16 * wid, lane);
#pragma unroll
    for (int tt = 0; tt < 4; ++tt) { f32x4 acc = (f32x4){0.f, 0.f, 0.f, 0.f};
#pragma unroll
        for (int kk = 0; kk < 2; ++kk) { const bf16x8 Ap = *(const LAS bf16x8*)(PM + (16 * tt + fr) * KTP + 32 * kk + 8 * fq); acc = __builtin_amdgcn_mfma_f32_16x16x32_bf16(Ap, Bv[kk], acc, 0, 0, 0);
                                         const bf16x8 Aq = *(const LAS bf16x8*)(QA + (16 * tt + fr) * KTP + 32 * kk + 8 * fq); acc = __builtin_amdgcn_mfma_f32_16x16x32_bf16(Aq, Bs[kk], acc, 0, 0, 0); }
#pragma unroll
        for (int i = 0; i < 4; ++i) OT[(16 * tt + 4 * fq + i) * OTP + 16 * wid + fr] = acc[i]; }
    WG_SYNC();
    { const int t = tid >> 3, v0 = (tid & 7) * 16; f32x4 ov[4]; float ss = 0.f;
#pragma unroll
      for (int k = 0; k < 4; ++k) { ov[k] = *(const LAS f32x4*)(OT + t * OTP + v0 + 4 * k); ss += (ov[k][0] * ov[k][0] + ov[k][1] * ov[k][1]) + (ov[k][2] * ov[k][2] + ov[k][3] * ov[k][3]); }
      ss += DPP_STEP_F(ss, 0xB1); ss += DPP_STEP_F(ss, 0x4E); ss += DPP_STEP_F(ss, 0x141);
      const float rs = __builtin_amdgcn_rsqf(ss * (1.0f / 128.0f) + 1e-6f);
      const bf16* rgp = RG + (row0 + t) * 512 + h * 128 + v0; const v4u ra = *(const v4u*)rgp, rb = *(const v4u*)(rgp + 8);
      const unsigned rw[8] = {ra.x, ra.y, ra.z, ra.w, rb.x, rb.y, rb.z, rb.w}; unsigned ow[8];
#pragma unroll
      for (int k = 0; k < 4; ++k) { const f32x4 g = *(const f32x4*)(og + v0 + 4 * k); float y[4];
#pragma unroll
          for (int i = 0; i < 4; ++i) { const unsigned w = rw[2 * k + (i >> 1)]; const float r = (i & 1) ? bfhi(w) : bflo(w); const float sg = r * __builtin_amdgcn_rcpf(1.0f + __builtin_amdgcn_exp2f(-1.4426950408889634f * r)); y[i] = ov[k][i] * rs * g[i] * sg; }
          ow[2 * k] = pg8::cvt_pk_bf16(y[0], y[1]); ow[2 * k + 1] = pg8::cvt_pk_bf16(y[2], y[3]); }
      bf16* op = MIX + (row0 + t) * 1024 + 512 + h * 128 + v0;
      *(v4u*)op = (v4u){ow[0], ow[1], ow[2], ow[3]}; *(v4u*)(op + 8) = (v4u){ow[4], ow[5], ow[6], ow[7]}; }
    WG_SYNC();
}

constexpr int WRP = 1032;
constexpr int WR_LDS_BYTES = 48 * WRP * 2;
__device__ __forceinline__ void router_tile(LAS unsigned char* lds, int tile, const bf16* __restrict__ XN2, const float* __restrict__ ROWSS, const float* __restrict__ brg, const float* __restrict__ bre,
                                            unsigned* __restrict__ CNT, int* __restrict__ LISTS, float* __restrict__ LSC, int* __restrict__ TOKINFO, int tid, int lane, int wid) {
    LAS bf16* WR = (LAS bf16*)lds; LAS float* PL = (LAS float*)(lds + WR_LDS_BYTES); LAS unsigned* CL = (LAS unsigned*)(lds + WR_LDS_BYTES + 24576); LAS unsigned* BS = CL + 32;
    if (tid < 32) CL[tid] = 0u;
    const int fr = lane & 15, fq = lane >> 4, rt = wid >> 1, kh = wid & 1;
    {   const size_t row = (size_t)tile * 64 + 16 * rt + fr; const bf16* ap = XN2 + row * 1024 + 512 * kh + 8 * fq;
        bf16x8 Af[16];
#pragma unroll
        for (int kk = 0; kk < 16; ++kk) Af[kk] = *(const bf16x8*)(ap + 32 * kk);
        f32x4 acc[3];
#pragma unroll
        for (int nt = 0; nt < 3; ++nt) acc[nt] = (f32x4){0.f, 0.f, 0.f, 0.f};
#pragma unroll
        for (int kk = 0; kk < 16; ++kk)
#pragma unroll
            for (int nt = 0; nt < 3; ++nt) { const bf16x8 Bf = *(const LAS bf16x8*)(WR + (16 * nt + fr) * WRP + 512 * kh + 32 * kk + 8 * fq); acc[nt] = __builtin_amdgcn_mfma_f32_16x16x32_bf16(Af[kk], Bf, acc[nt], 0, 0, 0); }
#pragma unroll
        for (int nt = 0; nt < 3; ++nt)
#pragma unroll
            for (int i = 0; i < 4; ++i) PL[(wid * 16 + 4 * fq + i) * 48 + 16 * nt + fr] = acc[nt][i];
    }
    WG_SYNC();
    int e_[2] = {0, 0}; unsigned lp[2] = {0u, 0u}; float wk[2] = {0.f, 0.f}; float rstd2 = 0.f; const bool act = tid < 64;
    const int token = tile * 64 + tid;
    if (act) {
        const LAS float* l0 = PL + ((2 * (tid >> 4)) * 16 + (tid & 15)) * 48; const LAS float* l1 = l0 + 16 * 48; float ss = 0.f;
        const f32x4* rp = (const f32x4*)(ROWSS + (size_t)token * 16);
#pragma unroll
        for (int j = 0; j < 4; ++j) { const f32x4 v = rp[j]; ss += (v[0] + v[1]) + (v[2] + v[3]); }
        rstd2 = 1.0f / sqrtf(ss * (1.0f / 1024.0f) + 1e-6f);
        float gl[4]; int gs = 0;
#pragma unroll
        for (int j = 0; j < 4; ++j) gl[j] = (l0[j] + l1[j]) * rstd2 + brg[j];
#pragma unroll
        for (int j = 1; j < 4; ++j) if (gl[j] > gl[gs]) gs = j;
        float den = 0.f;
#pragma unroll
        for (int j = 0; j < 4; ++j) den += __expf(gl[j] - gl[gs]);
        const float gw = 1.0f / den;
        float el[8];
#pragma unroll
        for (int j = 0; j < 8; ++j) el[j] = (l0[4 + gs * 8 + j] + l1[4 + gs * 8 + j]) * rstd2 + bre[gs * 8 + j];
        int i0 = 0;
#pragma unroll
        for (int j = 1; j < 8; ++j) if (el[j] > el[i0]) i0 = j;
        int i1 = (i0 == 0) ? 1 : 0;
#pragma unroll
        for (int j = 0; j < 8; ++j) if (j != i0 && j != i1 && el[j] > el[i1]) i1 = j;
        const float ex = __expf(el[i1] - el[i0]); const float w0 = 1.0f / (1.0f + ex);
        wk[0] = w0 * gw; wk[1] = ex * w0 * gw; e_[0] = gs * 8 + i0; e_[1] = gs * 8 + i1;
        lp[0] = __hip_atomic_fetch_add(CL + e_[0], 1u, __ATOMIC_RELAXED, __HIP_MEMORY_SCOPE_WORKGROUP); lp[1] = __hip_atomic_fetch_add(CL + e_[1], 1u, __ATOMIC_RELAXED, __HIP_MEMORY_SCOPE_WORKGROUP);
    }
    WG_SYNC();
    if (tid < 32) { const unsigned n = CL[tid]; BS[tid] = n ? __hip_atomic_fetch_add(CNT + tid, n, __ATOMIC_RELAXED, __HIP_MEMORY_SCOPE_AGENT) : 0u; }
    WG_SYNC();
    if (act) {
#pragma unroll
        for (int k = 0; k < 2; ++k) { const unsigned pos = BS[e_[k]] + lp[k]; LISTS[(size_t)e_[k] * 16384 + pos] = token; *(f32x2*)(LSC + ((size_t)e_[k] * 16384 + pos) * 2) = (f32x2){rstd2, wk[k]}; }
        *(int4*)(TOKINFO + (size_t)token * 4) = make_int4(e_[0], (int)(BS[e_[0]] + lp[0]), e_[1], (int)(BS[e_[1]] + lp[1]));
    }
    WG_SYNC();
}

template <bool GATHER> struct GroupOrder {
    const LAS int* TOFF; const LAS int* BOFF; const LAS int* CNTL; const int* LISTS; int NPN, G, c; unsigned bstride;
    __device__ bool next(int i, pg8::Unit& u) const {
        const int L = i * G + c; const int ntile = BOFF[32]; if (L >= ntile * NPN) return false;
        const int Tb = L / NPN; int e = 0;
#pragma unroll
        for (int s = 16; s >= 1; s >>= 1) if (BOFF[e + s] <= Tb) e += s;
        const int jt = Tb - BOFF[e];
        u.pm = TOFF[e] + jt; u.pn = L - Tb * NPN; u.e = e; u.p0 = jt * 256; const int rem = CNTL[e] - u.p0; u.nv = rem < 256 ? rem : 256; u.bo = (unsigned)e * bstride; return true;
    }
    __device__ __forceinline__ unsigned arow(const pg8::Unit& u, int r) const {
        if (GATHER) return (unsigned)LISTS[(size_t)u.e * 16384 + u.p0 + (r < u.nv ? r : 0)];
        return (unsigned)(u.pm * 256 + r);
    }
};
__device__ __forceinline__ void skinny_gu(LAS unsigned char* lds, int e, int p0, int rem, int rg, int cb, int slot0, const bf16* __restrict__ XN2, const bf16* __restrict__ WGU, const int* __restrict__ LISTS, const float* __restrict__ LSC, bf16* __restrict__ HID, int lane, int wid) {
    const int fr = lane & 15, fq = lane >> 4; const int r = 16 * rg + fr; const int tok = LISTS[(size_t)e * 16384 + p0 + (r < rem ? r : 0)];
    const bf16* ap = XN2 + (size_t)tok * 1024 + 128 * wid + 8 * fq; const bf16* wb = WGU + (size_t)e * 512 * 1024 + 128 * wid + 8 * fq;
    LAS f32x4* PART = (LAS f32x4*)lds;
    bf16x8 Af[4];
#pragma unroll
    for (int k = 0; k < 4; ++k) Af[k] = *(const bf16x8*)(ap + 32 * k);
#pragma unroll
    for (int nt = 0; nt < 4; ++nt) { const int j = 64 * cb + 16 * nt + fr; const bf16* bp = wb + (size_t)((j >> 7) * 256 + (j & 127)) * 1024;
        bf16x8 Bg[4], Bu[4];
#pragma unroll
        for (int k = 0; k < 4; ++k) { Bg[k] = *(const bf16x8*)(bp + 32 * k); Bu[k] = *(const bf16x8*)(bp + 128 * 1024 + 32 * k); }
        f32x4 ag = (f32x4){0.f, 0.f, 0.f, 0.f}, au = (f32x4){0.f, 0.f, 0.f, 0.f};
#pragma unroll
        for (int k = 0; k < 4; ++k) { ag = __builtin_amdgcn_mfma_f32_16x16x32_bf16(Af[k], Bg[k], ag, 0, 0, 0); au = __builtin_amdgcn_mfma_f32_16x16x32_bf16(Af[k], Bu[k], au, 0, 0, 0); }
        PART[(wid * 8 + nt) * 64 + lane] = ag; PART[(wid * 8 + 4 + nt) * 64 + lane] = au; }
    WG_SYNC();
    if (wid < 4) { const int nt = wid; f32x4 g = (f32x4){0.f, 0.f, 0.f, 0.f}, u = (f32x4){0.f, 0.f, 0.f, 0.f};
#pragma unroll
        for (int w = 0; w < 8; ++w) { g += PART[(w * 8 + nt) * 64 + lane]; u += PART[(w * 8 + 4 + nt) * 64 + lane]; }
#pragma unroll
        for (int i = 0; i < 4; ++i) { const int rr = 16 * rg + 4 * fq + i; if (rr < rem) { const f32x2 sw = *(const f32x2*)(LSC + ((size_t)e * 16384 + p0 + rr) * 2);
            const float a = g[i] * sw.x, uu = u[i] * sw.x; HID[(size_t)(slot0 + rr) * 256 + 64 * cb + 16 * nt + fr] = (bf16)f2bf(a * __builtin_amdgcn_rcpf(1.f + __expf(-a)) * uu * sw.y); } } }
    WG_SYNC();
}
__device__ __forceinline__ void skinny_down(int e, int rem, int rg, int cq, int slot0, const bf16* __restrict__ HID, const bf16* __restrict__ WD, bf16* __restrict__ Y, int lane, int wid) {
    const int fr = lane & 15, fq = lane >> 4; const int r = 16 * rg + fr; const int col0 = 256 * cq + 32 * wid;
    const bf16* ap = HID + (size_t)(slot0 + (r < rem ? r : 0)) * 256 + 8 * fq; const bf16* wb = WD + (size_t)e * 1024 * 256 + (size_t)(col0 + fr) * 256 + 8 * fq;
    bf16x8 Af[8], B0[8], B1[8];
#pragma unroll
    for (int k = 0; k < 8; ++k) { Af[k] = *(const bf16x8*)(ap + 32 * k); B0[k] = *(const bf16x8*)(wb + 32 * k); B1[k] = *(const bf16x8*)(wb + (size_t)16 * 256 + 32 * k); }
    f32x4 a0 = (f32x4){0.f, 0.f, 0.f, 0.f}, a1 = (f32x4){0.f, 0.f, 0.f, 0.f};
#pragma unroll
    for (int k = 0; k < 8; ++k) { a0 = __builtin_amdgcn_mfma_f32_16x16x32_bf16(Af[k], B0[k], a0, 0, 0, 0); a1 = __builtin_amdgcn_mfma_f32_16x16x32_bf16(Af[k], B1[k], a1, 0, 0, 0); }
#pragma unroll
    for (int i = 0; i < 4; ++i) { const int rr = 16 * rg + 4 * fq + i; if (rr < rem) { bf16* yp = Y + (size_t)(slot0 + rr) * 1024 + col0 + fr; yp[0] = (bf16)f2bf(a0[i]); yp[16] = (bf16)f2bf(a1[i]); } }
}
struct Args { const float* in[18]; float* out; unsigned char* ws; int ph_lo, ph_hi, li, pad; };
__global__ void __launch_bounds__(NWAVES * 64, 2) hymba_fwd(Args args) {
    extern __shared__ __attribute__((aligned(16))) unsigned char lds[];
    LAS unsigned char* const L = (LAS unsigned char*)lds;
    volatile LAS unsigned* const MISCW = (volatile LAS unsigned*)(L + MISC_OFF);
    LAS int* const TOFF = (LAS int*)(L + TOFF_OFF); LAS int* const CNTL = TOFF + 40; LAS int* const BOFF = TOFF + 80; LAS int* const SMALL = TOFF + 120;
    const int tid = threadIdx.x, lane = tid & 63, wave = __builtin_amdgcn_readfirstlane(tid >> 6);
    const int G = gridDim.x; const int bx = blockIdx.x; const int vcu = (G % 8 == 0) ? (bx % 8) * (G / 8) + bx / 8 : bx;
    unsigned char* const ws = args.ws;
    gu32* const ctl = (gu32*)(ws + WS_CTL);
    const float* x = args.in[0]; const float* norm1_g = args.in[1]; const float* w_in = args.in[2]; const float* q_norm_g = args.in[3]; const float* k_norm_g = args.in[4];
    const float* rel_bias = args.in[5]; const float* gate_w2 = args.in[6]; const float* gate_b = args.in[7]; const float* out_norm_g = args.in[8]; const float* w_out = args.in[9];
    const float* norm2_g = args.in[10]; const float* w_rg = args.in[11]; const float* b_rg = args.in[12]; const float* w_re = args.in[13]; const float* b_re = args.in[14];
    const float* w_eg = args.in[15]; const float* w_eu = args.in[16]; const float* w_ed = args.in[17];
    float* out = args.out;
    float* RSTD1 = (float*)(ws + WS_RSTD1); float* ROWSS = (float*)(ws + WS_ROWSS); bf16* WR_T = (bf16*)(ws + WS_WR); float* BLAST = (float*)(ws + WS_BLAST);
    int* TOKINFO = (int*)(ws + WS_TOKINFO); int* LISTS = (int*)(ws + WS_LISTS); float* LSC = (float*)(ws + WS_LSC);
    bf16* WO_T = (bf16*)(ws + WS_WO); bf16* WGU_T = (bf16*)(ws + WS_WGU); bf16* WD_T = (bf16*)(ws + WS_WD); bf16* XB = (bf16*)(ws + WS_XB); bf16* WIN_T = (bf16*)(ws + WS_WIN);
    unsigned* MASK = (unsigned*)(ws + WS_MASK); bf16* SB = (bf16*)(ws + WS_SB); float* EG = (float*)(ws + WS_EG);
    bf16* QN = (bf16*)(ws + WS_QN); bf16* KN = (bf16*)(ws + WS_KN); bf16* VN = (bf16*)(ws + WS_VN); bf16* XN2 = (bf16*)(ws + WS_XN2);
    bf16* IQ = (bf16*)(ws + WS_IQ); bf16* MISC = (bf16*)(ws + WS_MISC); bf16* QB = (bf16*)(ws + WS_QB); bf16* KB = (bf16*)(ws + WS_KB); bf16* VB = (bf16*)(ws + WS_VB); bf16* RG = (bf16*)(ws + WS_RG);
    bf16* MIX = (bf16*)(ws + WS_MIX); float* U = (float*)(ws + WS_MIX); bf16* HID = (bf16*)(ws + WS_HID); bf16* Y = (bf16*)(ws + WS_Y);
    unsigned* CNT = (unsigned*)(ctl + CW_CNT);

    for (int u = tid; u < (LDS_BYTES - LDSCTL_OFF) / 4; u += NWAVES * 64) ((LAS unsigned*)(L + LDSCTL_OFF))[u] = 0u;
    __syncthreads();
    const int bli = (N_LAUNCHES == PER_PHASE) ? 0 : args.li;
    XcdBarrier bar; bar.bar = (unsigned*)(ctl + CW_BAR) + bli * XCD_BAR_WORDS; bar.x = 0; bar.st = nullptr;
    if (N_LAUNCHES != PER_PHASE) bar = xcd_barrier_post((unsigned*)(ctl + CW_BAR) + bli * XCD_BAR_WORDS, MISCW + 8);
#define GRID_BAR(seam) do { if (N_LAUNCHES == PER_PHASE) { if (tid == 0) __hip_atomic_store(ctl + CW_TMO, 0xBADBA0u | (unsigned)(seam), RLX_AGENT); } else { xcd_barrier(bar); } } while (0)
    const int lo = args.ph_lo, hi = args.ph_hi;
#define IN(k) (lo <= (k) && (k) < hi)
#define BOTH(k) (IN(k) && IN((k) + 1))
    const int gw = vcu * NWAVES + wave, NGW = G * NWAVES;

    constexpr int I_G = 16 * 8, I_D = 4 * 32, PER_E = 2 * I_G + I_D, NE1 = 18, NE2 = 25;
#define expert_weights(lo_, hi_, w0_, nw_) do { LAS float* scr_ = (LAS float*)(L + wave * 16384); \
        for (int it_ = (lo_) + (w0_); it_ < (hi_); it_ += (nw_)) { const int e_ = it_ / PER_E; int r_ = it_ - e_ * PER_E; \
            if (r_ < I_G) { p0_transpose_item<2>(w_eg + (size_t)e_ * 1024 * 256, 1024, 256, norm2_g, WGU_T + (size_t)e_ * 512 * 1024, scr_, r_, lane); continue; } r_ -= I_G; \
            if (r_ < I_G) { p0_transpose_item<3>(w_eu + (size_t)e_ * 1024 * 256, 1024, 256, norm2_g, WGU_T + (size_t)e_ * 512 * 1024, scr_, r_, lane); continue; } r_ -= I_G; \
            p0_transpose_item<1>(w_ed + (size_t)e_ * 256 * 1024, 256, 1024, nullptr, WD_T + (size_t)e_ * 1024 * 256, scr_, r_, lane); } } while (0)
    if (IN(0)) {
        LAS float* scr = (LAS float*)(L + wave * 16384);
        constexpr int I_IN = 16 * 106, I_O = 16 * 32;
        constexpr int NITEMS = I_IN + I_O;
        for (int it = gw; it < NITEMS; it += NGW) {
            int r = it;
            if (r < I_IN) { p0_transpose_item<0>(w_in, 1024, 3384, norm1_g, WIN_T, scr, r, lane); continue; } r -= I_IN;
            p0_transpose_item<1>(w_out, 1024, 1024, nullptr, WO_T, scr, r, lane);
        }
        expert_weights(NE2 * PER_E, 32 * PER_E, gw, NGW);
        for (int i = bx * (NWAVES * 64) + tid; i < 48 * 1024; i += G * NWAVES * 64) { const int n = i >> 10, k = i & 1023;
            const float v = (n < 4) ? w_rg[k * 4 + n] : (n < 36) ? w_re[k * 32 + (n - 4)] : 0.f; WR_T[i] = (bf16)f2bf(v * norm2_g[k]); }
        for (int m0 = 2 * gw; m0 < M; m0 += 2 * NGW) {
            f32x4 v[2][4]; float s[2];
#pragma unroll
            for (int r = 0; r < 2; ++r) { const GAS f32x4* xr = (const GAS f32x4*)(x + (size_t)(m0 + r) * 1024) + lane;
#pragma unroll
                for (int j = 0; j < 4; ++j) v[r][j] = xr[64 * j]; }
#pragma unroll
            for (int r = 0; r < 2; ++r) { s[r] = 0.f;
#pragma unroll
                for (int j = 0; j < 4; ++j) s[r] += (v[r][j].x * v[r][j].x + v[r][j].y * v[r][j].y) + (v[r][j].z * v[r][j].z + v[r][j].w * v[r][j].w);
                s[r] = wave_fsum(s[r]); if (lane == 0) RSTD1[m0 + r] = 1.0f / sqrtf(s[r] * (1.0f / 1024.0f) + 1e-6f);
                GAS unsigned long long* o8 = (GAS unsigned long long*)(XB + (size_t)(m0 + r) * 1024) + lane;
#pragma unroll
                for (int j = 0; j < 4; ++j) o8[64 * j] = (unsigned long long)pk2(v[r][j].x, v[r][j].y) | ((unsigned long long)pk2(v[r][j].z, v[r][j].w) << 32); }
        }
        if (BOTH(0)) GRID_BAR(0);
    }
    if (IN(1)) {
        pg8::Gemm g{XB, WIN_T, 1024}; pg8::StaticOrder S; S.init(M, 3584, G, bx);
        pg8::EpiProj E{RSTD1, q_norm_g, k_norm_g, QN, KN, VN, IQ, QB, KB, VB, RG, MISC, 0.125f * 1.4426950408889634f, 1e-6f};
        pg8::gemm_phase<pg8::EpiProj, pg8::StaticOrder, true>(L, g, S, E);
        {
            const int nshort = (896 % G == 0) ? G : G - (896 % G), first = G - nshort;
            if (bx >= first) expert_weights(0, NE1 * PER_E, (bx - first) * NWAVES + wave, nshort * NWAVES); }
        if (BOTH(1)) GRID_BAR(1);
    }
    if (IN(2)) {
        for (int rep = 0; rep < REP_IDX; ++rep)
        for (int it = bx; it < 1024; it += G) { const int b = it & 7, t_ = it >> 3, j_ = t_ >> 5, k0_ = t_ & 31;
            const int p = (j_ == 0) ? k0_ : (j_ == 1) ? 63 - k0_ : (j_ == 2) ? 64 + k0_ : 127 - k0_;
            idx_item(L, b, p, IQ, MISC, MASK, lane, wave); }
        for (int rep = 0; rep < REP_GLAA; ++rep)
        for (int it = bx; it < 1024; it += G) gla_a_item(L, it, KB, VB, MISC, gate_w2, gate_b, U, BLAST, EG, tid, lane, wave);
        if (BOTH(2)) GRID_BAR(2);
    }
    if (IN(3)) {
        for (int it = bx; it < 128; it += G) gla_b_item(it, U, BLAST, SB, tid);
        { const int first = (G > 128) ? 128 : 0, nb = G - first;
          if (bx >= first) expert_weights(NE1 * PER_E, NE2 * PER_E, (bx - first) * NWAVES + wave, nb * NWAVES); }
        if (BOTH(3)) GRID_BAR(3);
    }
    if (IN(4)) {
        const attn_body::AttnTensors AT{(const attn_body::bf16*)QN, (const attn_body::bf16*)KN, (const attn_body::bf16*)VN, (attn_body::bf16*)MIX, MASK, rel_bias};
        for (int rep = 0; rep < REP_ATT; ++rep)
        for (int pr = vcu; pr < 256; pr += G) { const int bh = pr >> 2, s = pr & 3;
            for (int k2 = 0; k2 < 2; ++k2) attn_body::attn_unit<8>(bh >> 3, bh & 7, k2 ? s : 7 - s, AT.Q, AT.K, AT.V, AT.O, AT.MASK, AT.relb, (char*)lds); }
        for (int rep = 0; rep < REP_GLAC; ++rep)
        for (int it = bx; it < 1024; it += G) gla_c_item(L, it, QB, KB, VB, RG, EG, out_norm_g, SB, MIX, tid, lane, wave);
        if (BOTH(4)) GRID_BAR(4);
    }
    if (IN(5)) {
        pg8::Gemm g{MIX, WO_T, 1024}; pg8::StaticOrder S; S.init(M, 1024, G, bx);
        pg8::EpiOut E{x, XN2, ROWSS};
        pg8::gemm_phase<pg8::EpiOut, pg8::StaticOrder, false>(L, g, S, E);
        if (BOTH(5)) GRID_BAR(5);
    }
    if (IN(6)) {
        { LAS bf16* WR = (LAS bf16*)L;
          for (int i = tid; i < 48 * 128; i += NWAVES * 64) { const int n = i >> 7, c8 = i & 127; *(LAS v4u*)(WR + n * WRP + c8 * 8) = *(const v4u*)(WR_T + n * 1024 + c8 * 8); } }
        WG_SYNC();
        for (int tile = bx; tile < 256; tile += G) router_tile(L, tile, XN2, ROWSS, b_rg, b_re, CNT, LISTS, LSC, TOKINFO, tid, lane, wave);
        if (BOTH(6)) GRID_BAR(6);
    }
#define LOAD_TOFF() do { if (tid < 32) CNTL[tid] = (int)__hip_atomic_load(CNT + tid, RLX_AGENT); WG_SYNC(); \
        if (tid == 0) { int acc_ = 0, bacc_ = 0, ns_ = 0; for (int e_ = 0; e_ < 32; ++e_) { const int c_ = CNTL[e_]; TOFF[e_] = acc_; BOFF[e_] = bacc_; \
        const int full_ = c_ >> 8, rem_ = c_ & 255; acc_ += (c_ + 255) >> 8; bacc_ += full_ + (rem_ > 128 ? 1 : 0); if (rem_ > 0 && rem_ <= 128) { SMALL[1 + ns_] = e_; ++ns_; } } TOFF[32] = acc_; BOFF[32] = bacc_; SMALL[0] = ns_; } WG_SYNC(); } while (0)
    if (IN(7)) {
        LOAD_TOFF();
        pg8::Gemm g{XN2, WGU_T, 1024}; GroupOrder<true> S{TOFF, BOFF, CNTL, LISTS, 2, G, vcu, 512u * 1024u * 2u};
        pg8::EpiGU E{LSC, HID};
        pg8::gemm_phase<pg8::EpiGU, GroupOrder<true>, false>(L, g, S, E);
        { const int ns = SMALL[0];
          for (int idx = G - 1 - bx; idx < ns * 32; idx += G) { const int e = SMALL[1 + (idx >> 5)], rg = (idx >> 2) & 7, cb = idx & 3; const int cnt = CNTL[e], full = cnt >> 8, rem = cnt & 255;
              if (16 * rg < rem) skinny_gu(L, e, full * 256, rem, rg, cb, (TOFF[e] + full) * 256, XN2, WGU_T, LISTS, LSC, HID, lane, wave); } }
        if (BOTH(7)) GRID_BAR(7);
    }
    if (IN(8)) {
        LOAD_TOFF();
        pg8::Gemm g{HID, WD_T, 256}; GroupOrder<false> S{TOFF, BOFF, CNTL, LISTS, 4, G, vcu, 1024u * 256u * 2u};
        pg8::EpiDown E{Y};
        pg8::gemm_phase<pg8::EpiDown, GroupOrder<false>, false>(L, g, S, E);
        { const int ns = SMALL[0];
          for (int idx = G - 1 - bx; idx < ns * 32; idx += G) { const int e = SMALL[1 + (idx >> 5)], rg = (idx >> 2) & 7, cq = idx & 3; const int cnt = CNTL[e], full = cnt >> 8, rem = cnt & 255;
              if (16 * rg < rem) skinny_down(e, rem, rg, cq, (TOFF[e] + full) * 256, HID, WD_T, Y, lane, wave); } }
        if (BOTH(8)) GRID_BAR(8);
    }
    if (IN(9)) {
        LOAD_TOFF();
        for (int m0 = 4 * gw; m0 < M; m0 += 4 * NGW) {
            int4 ti[4];
#pragma unroll
            for (int r = 0; r < 4; ++r) ti[r] = *(const int4*)(TOKINFO + (size_t)(m0 + r) * 4);
            v4u av[4][2], b0[4][2], b1[4][2];
#pragma unroll
            for (int r = 0; r < 4; ++r) { const size_t s0 = (size_t)TOFF[ti[r].x] * 256 + ti[r].y, s1 = (size_t)TOFF[ti[r].z] * 256 + ti[r].w;
                const GAS v4u* a = (const GAS v4u*)(XN2 + (size_t)(m0 + r) * 1024) + lane; const GAS v4u* y0 = (const GAS v4u*)(Y + s0 * 1024) + lane; const GAS v4u* y1 = (const GAS v4u*)(Y + s1 * 1024) + lane;
#pragma unroll
                for (int j = 0; j < 2; ++j) { av[r][j] = a[64 * j]; b0[r][j] = y0[64 * j]; b1[r][j] = y1[64 * j]; } }
#pragma unroll
            for (int r = 0; r < 4; ++r) { GAS f32x4* o = (GAS f32x4*)(out + (size_t)(m0 + r) * 1024) + 2 * lane;
#pragma unroll
                for (int j = 0; j < 2; ++j) { const v4u a_ = av[r][j], c0 = b0[r][j], c1 = b1[r][j]; f32x4 r0, r1;
                    r0[0] = bflo(a_.x) + bflo(c0.x) + bflo(c1.x); r0[1] = bfhi(a_.x) + bfhi(c0.x) + bfhi(c1.x); r0[2] = bflo(a_.y) + bflo(c0.y) + bflo(c1.y); r0[3] = bfhi(a_.y) + bfhi(c0.y) + bfhi(c1.y);
                    r1[0] = bflo(a_.z) + bflo(c0.z) + bflo(c1.z); r1[1] = bfhi(a_.z) + bfhi(c0.z) + bfhi(c1.z); r1[2] = bflo(a_.w) + bflo(c0.w) + bflo(c1.w); r1[3] = bfhi(a_.w) + bfhi(c0.w) + bfhi(c1.w);
                    o[128 * j] = r0; o[128 * j + 1] = r1; } }
        }
    }
#undef IN
#undef BOTH
}

extern "C" void kernel_launch(void* const* d_in, const int* in_sizes, int n_in, void* d_out, int out_size, void* d_ws, size_t ws_size, hipStream_t stream) {
    static int grid = 0;
    if (grid == 0) {
        if (n_in != 18 || out_size != M * 1024 || ws_size < WS_END) { fprintf(stderr, "kernel_launch: unexpected problem shape (n_in %d out %d ws %zu)\n", n_in, out_size, ws_size); grid = -1; return; }
        int dev = 0, cus = 0, per_cu = 0;
        if (hipGetDevice(&dev) != hipSuccess || hipDeviceGetAttribute(&cus, hipDeviceAttributeMultiprocessorCount, dev) != hipSuccess) { grid = -1; return; }
        if (hipFuncSetAttribute((const void*)hymba_fwd, hipFuncAttributeMaxDynamicSharedMemorySize, LDS_BYTES) != hipSuccess) { fprintf(stderr, "kernel_launch: hipFuncSetAttribute failed\n"); grid = -1; return; }
        if (hipOccupancyMaxActiveBlocksPerMultiprocessor(&per_cu, (const void*)hymba_fwd, NWAVES * 64, LDS_BYTES) != hipSuccess || per_cu < 1) { fprintf(stderr, "kernel_launch: occupancy query reports %d\n", per_cu); }
        (void)hipGetLastError();
        grid = cus;
    }
    if (grid < 0) return;
    (void)hipMemsetAsync((char*)d_ws + WS_CTL, 0, CTL_ZERO_BYTES, stream);
    Args a{};
    for (int i = 0; i < 18; ++i) a.in[i] = (const float*)d_in[i];
    a.out = (float*)d_out; a.ws = (unsigned char*)d_ws;
#if defined(PROBE_PHASE)
    { const int k = PROBE_PHASE; a.ph_lo = 0; a.ph_hi = k + 1; a.li = 0; hipLaunchKernelGGL(hymba_fwd, dim3(grid), dim3(NWAVES * 64), LDS_BYTES, stream, a);
      for (int r = 1; r < PROBE_REPS; ++r) { a.ph_lo = k; a.ph_hi = k + 1; a.li = 1; hipLaunchKernelGGL(hymba_fwd, dim3(grid), dim3(NWAVES * 64), LDS_BYTES, stream, a); }
      if (k + 1 < PER_PHASE) { a.ph_lo = k + 1; a.ph_hi = PER_PHASE; a.li = 2; hipLaunchKernelGGL(hymba_fwd, dim3(grid), dim3(NWAVES * 64), LDS_BYTES, stream, a); } }
#else
    if (N_LAUNCHES == 1) { a.ph_lo = 0; a.ph_hi = PER_PHASE; a.li = 0; hipLaunchKernelGGL(hymba_fwd, dim3(grid), dim3(NWAVES * 64), LDS_BYTES, stream, a); }
    else for (int li = 0; li < PER_PHASE; ++li) { a.ph_lo = li; a.ph_hi = li + 1; a.li = li; hipLaunchKernelGGL(hymba_fwd, dim3(grid), dim3(NWAVES * 64), LDS_BYTES, stream, a); }
#endif
}
```

```cpp
#include <hip/hip_runtime.h>
#include <hip/hip_bf16.h>
#include <cstdio>
#include <cstdint>
#include <cmath>
namespace pg8 {
#define PG8_LAS __attribute__((address_space(3)))
typedef unsigned short bf16_t;
typedef short bf16x8 __attribute__((ext_vector_type(8)));
typedef float f32x4 __attribute__((ext_vector_type(4)));
typedef float f32x2 __attribute__((ext_vector_type(2)));
typedef unsigned u32x4 __attribute__((ext_vector_type(4)));
constexpr int BM = 256, BK = 64, HALF = 128, HTB = HALF * BK * 2  , STAGE_BYTES = 8 * HTB, NXCD = 8, WGM = 8;

__host__ __device__ __forceinline__ int lds_byte(int r, int c) { const int st = (r >> 4) * 2 + (c >> 5), rr = r & 15, cc = c & 31, ob = rr * 64 + cc * 2; return st * 1024 + (ob ^ (((ob >> 9) & 1) << 5)); }
__host__ __device__ __forceinline__ void stage_rc(int b, int& R, int& C) { const int st = b / 1024, sb = b % 1024, swz = sb ^ (((sb >> 9) & 1) << 5); R = (st >> 1) * 16 + swz / 64; C = (st & 1) * 32 + (swz % 64) / 2; }
__host__ __device__ __forceinline__ int perm32(int rho) { const int n = rho >> 4, i = rho & 15; return 8 * (i >> 2) + 4 * n + (i & 3); }

struct Unit { int pm, pn; unsigned bo; int e, nv, p0; };
struct Gemm { const bf16_t* A; const bf16_t* Bt; int K; };

struct StaticOrder {
    int nM, nN, nwg, G, c;
    __device__ void init(int M, int N, int G_, int c_) { nM = M / BM; nN = N / BM; nwg = nM * nN; G = G_; c = c_; }
    __device__ bool next(int i, Unit& u) const {
        const long L = (long)i * G + c; if (L >= nwg) return false;
        int wgid = (int)L; { const int q = nwg / NXCD, r = nwg % NXCD, xcd = wgid % NXCD, off = wgid / NXCD; wgid = (xcd < r ? xcd * (q + 1) : r * (q + 1) + (xcd - r) * q) + off; }
        const int nig = WGM * nN, gid = wgid / nig, fm = gid * WGM, gsz = (nM - fm) < WGM ? (nM - fm) : WGM;
        u.pm = fm + ((wgid % nig) % gsz); u.pn = (wgid % nig) / gsz; u.bo = 0u; u.e = 0; u.nv = BM; u.p0 = 0; return true;
    }
    __device__ __forceinline__ unsigned arow(const Unit& u, int r) const { return (unsigned)(u.pm * BM + r); }
};

__device__ __forceinline__ unsigned cvt_pk_bf16(float lo, float hi) { unsigned r; asm volatile("v_cvt_pk_bf16_f32 %0, %1, %2" : "=v"(r) : "v"(lo), "v"(hi)); return r; }

template <class Epi, class Sched, bool ALIGN_EPI = false>
__device__ __forceinline__ void gemm_phase(PG8_LAS unsigned char* lds, const Gemm g, const Sched& S, const Epi& E) {
    const int tid = threadIdx.x, wid = __builtin_amdgcn_readfirstlane(tid >> 6), lane = tid & 63, wr = wid >> 2, wc = wid & 3, fr = lane & 15, fq = lane >> 4;
    const int K = g.K, nt = K / BK;
    int RA[2], CA[2]; unsigned voffB[2];
#pragma unroll
    for (int i = 0; i < 2; ++i) { int R, C; stage_rc(tid * 16 + i * 8192, R, C); const int Rb = ((R & ~31) + perm32(R & 31));
        RA[i] = R; CA[i] = C; voffB[i] = (unsigned)(Rb * K + C) * 2u; }
    const size_t kstep = (size_t)(BK * 2);
    const size_t hstep = (size_t)HALF * K * 2;
    const size_t tstep = 2 * hstep;
    const unsigned ldsw = (unsigned)wid * 1024u;
    const int aoff = lds_byte(wr * 64 + fr, fq * 8), boff = lds_byte(wc * 32 + fr, fq * 8);
#define PG8_SA(b, h) (((b) * 2 + (h)) * HTB)
#define PG8_SB(b, h) ((4 + (b) * 2 + (h)) * HTB)
#define PG8_STAGE(bufoff, gbase, voff) do { _Pragma("unroll") for (int _i = 0; _i < 2; ++_i) \
        __builtin_amdgcn_global_load_lds((const unsigned*)((const char*)(gbase) + (voff)[_i]), (PG8_LAS unsigned*)(lds + (bufoff) + ldsw + _i * 8192), 16, 0, 0); } while (0)
#define PG8_LDA(dst, b, h) do { _Pragma("unroll") for (int m = 0; m < 4; ++m) _Pragma("unroll") for (int k = 0; k < 2; ++k) dst[m][k] = *(const PG8_LAS bf16x8*)(lds + PG8_SA(b, h) + aoff + m * 2048 + k * 1024); } while (0)
#define PG8_LDB(dst, b, h) do { _Pragma("unroll") for (int n = 0; n < 2; ++n) _Pragma("unroll") for (int k = 0; k < 2; ++k) dst[n][k] = *(const PG8_LAS bf16x8*)(lds + PG8_SB(b, h) + boff + n * 2048 + k * 1024); } while (0)
#define PG8_MMA(ai, bj, At, Bt) do { __builtin_amdgcn_s_setprio(1); _Pragma("unroll") for (int m = 0; m < 4; ++m) _Pragma("unroll") for (int n = 0; n < 2; ++n) _Pragma("unroll") for (int k = 0; k < 2; ++k) \
        acc[ai][bj][m][n] = __builtin_amdgcn_mfma_f32_16x16x32_bf16(Bt[n][k], At[m][k], acc[ai][bj][m][n], 0, 0, 0); __builtin_amdgcn_s_setprio(0); } while (0)
#define PG8_WAIT_V(n) asm volatile("s_waitcnt vmcnt(" #n ")" ::: "memory")
#define PG8_WAIT_L(n) asm volatile("s_waitcnt lgkmcnt(" #n ")" ::: "memory")
#define PG8_BAR __builtin_amdgcn_s_barrier()
#define PG8_SCHED __builtin_amdgcn_sched_barrier(0)
#define PG8_AOFF(AO, U) do { _Pragma("unroll") for (int _h = 0; _h < 2; ++_h) _Pragma("unroll") for (int _i = 0; _i < 2; ++_i) \
        AO[_h][_i] = (S.arow(U, _h * HALF + RA[_i]) * (unsigned)K + (unsigned)CA[_i]) * 2u; } while (0)
    Unit cur, nxt; int ui = 0;
    if (!S.next(0, cur)) return;
    f32x4 acc[2][2][4][2];
#pragma unroll
    for (int a = 0; a < 2; ++a)
#pragma unroll
        for (int b = 0; b < 2; ++b)
#pragma unroll
            for (int m = 0; m < 4; ++m)
#pragma unroll
                for (int n = 0; n < 2; ++n) acc[a][b][m][n] = (f32x4){0.f, 0.f, 0.f, 0.f};
    bf16x8 At[4][2], B0[2][2], B1[2][2];
    unsigned aoC[2][2], aoN[2][2];
    PG8_AOFF(aoC, cur);
    const char* const gA = (const char*)g.A;
    const char* cB = (const char*)g.Bt + (size_t)cur.bo + (size_t)cur.pn * tstep;
    {
        PG8_STAGE(PG8_SB(0, 0), cB, voffB); PG8_STAGE(PG8_SB(0, 1), cB + hstep, voffB); PG8_STAGE(PG8_SA(0, 0), gA, aoC[0]); PG8_STAGE(PG8_SA(0, 1), gA, aoC[1]);
        if (wr == 1) PG8_BAR;
        PG8_WAIT_V(2); PG8_BAR;
        PG8_STAGE(PG8_SB(1, 0), cB + kstep, voffB); PG8_STAGE(PG8_SA(1, 0), gA + kstep, aoC[0]); PG8_STAGE(PG8_SB(1, 1), cB + hstep + kstep, voffB);
        PG8_WAIT_V(6); PG8_BAR;
    }
    for (;;) {
        const bool has_next = S.next(ui + 1, nxt);
        if (has_next) { PG8_AOFF(aoN, nxt); } else {
#pragma unroll
            for (int _h = 0; _h < 2; ++_h)
#pragma unroll
                for (int _i = 0; _i < 2; ++_i) aoN[_h][_i] = aoC[_h][_i]; }
        const char* nB = has_next ? (const char*)g.Bt + (size_t)nxt.bo + (size_t)nxt.pn * tstep : cB;
        for (int t = 0; t < nt; t += 2) {
            const bool last = (t == nt - 2);
            const char* a1 = gA + (size_t)(t + 1) * kstep;
            const char* a2 = last ? gA : gA + (size_t)(t + 2) * kstep; const char* b2 = last ? nB : cB + (size_t)(t + 2) * kstep;
            const char* a3 = a2 + kstep; const char* b3 = b2 + kstep;
            unsigned ao2[2][2];
#pragma unroll
            for (int _h = 0; _h < 2; ++_h)
#pragma unroll
                for (int _i = 0; _i < 2; ++_i) ao2[_h][_i] = last ? aoN[_h][_i] : aoC[_h][_i];
            PG8_LDB(B0, 0, 0); PG8_LDB(B1, 0, 1); PG8_SCHED; PG8_LDA(At, 0, 0); PG8_STAGE(PG8_SA(1, 1), a1, aoC[1]);
            PG8_WAIT_V(8); PG8_WAIT_L(0); PG8_BAR; PG8_MMA(0, 0, At, B0); PG8_MMA(0, 1, At, B1); PG8_BAR; PG8_SCHED;
            PG8_LDA(At, 0, 1); PG8_STAGE(PG8_SB(0, 0), b2, voffB); PG8_STAGE(PG8_SB(0, 1), b2 + hstep, voffB); PG8_STAGE(PG8_SA(0, 0), a2, ao2[0]);
            PG8_WAIT_V(8); PG8_WAIT_L(0); PG8_BAR; PG8_MMA(1, 0, At, B0); PG8_MMA(1, 1, At, B1); PG8_BAR; PG8_SCHED;
            PG8_LDB(B0, 1, 0); PG8_LDB(B1, 1, 1); PG8_SCHED; PG8_LDA(At, 1, 0); PG8_STAGE(PG8_SA(0, 1), a2, ao2[1]);
            PG8_WAIT_V(8); PG8_WAIT_L(0); PG8_BAR; PG8_MMA(0, 0, At, B0); PG8_MMA(0, 1, At, B1); PG8_BAR; PG8_SCHED;
            PG8_LDA(At, 1, 1); PG8_STAGE(PG8_SB(1, 0), b3, voffB); PG8_STAGE(PG8_SB(1, 1), b3 + hstep, voffB); PG8_STAGE(PG8_SA(1, 0), a3, ao2[0]);
            PG8_WAIT_V(8); PG8_WAIT_L(0); PG8_BAR; PG8_MMA(1, 0, At, B0); PG8_MMA(1, 1, At, B1); PG8_BAR; PG8_SCHED;
        }
        if constexpr (ALIGN_EPI) { if (wr == 0) PG8_BAR; }
        E(acc, cur, wr, wc, fr, fq);
        if (!has_next) break;
#pragma unroll
        for (int a = 0; a < 2; ++a)
#pragma unroll
            for (int b = 0; b < 2; ++b)
#pragma unroll
                for (int m = 0; m < 4; ++m)
#pragma unroll
                    for (int n = 0; n < 2; ++n) acc[a][b][m][n] = (f32x4){0.f, 0.f, 0.f, 0.f};
        cur = nxt; cB = nB; ++ui;
#pragma unroll
        for (int _h = 0; _h < 2; ++_h)
#pragma unroll
            for (int _i = 0; _i < 2; ++_i) aoC[_h][_i] = aoN[_h][_i];
        if constexpr (ALIGN_EPI) { if (wr == 1) PG8_BAR; }
    }
    PG8_WAIT_V(0);
    if constexpr (!ALIGN_EPI) { if (wr == 0) PG8_BAR; }
    PG8_BAR;
#undef PG8_SA
#undef PG8_SB
#undef PG8_STAGE
#undef PG8_LDA
#undef PG8_LDB
#undef PG8_MMA
#undef PG8_WAIT_V
#undef PG8_WAIT_L
#undef PG8_BAR
#undef PG8_SCHED
#undef PG8_AOFF
}
}
namespace pg8 {
__device__ __forceinline__ float row4_sum(float v) {
    { auto r = __builtin_amdgcn_permlane16_swap(__float_as_uint(v), __float_as_uint(v), false, false); v = __uint_as_float(r[0]) + __uint_as_float(r[1]); }
    { auto r = __builtin_amdgcn_permlane32_swap(__float_as_uint(v), __float_as_uint(v), false, false); v = __uint_as_float(r[0]) + __uint_as_float(r[1]); }
    return v;
}
__device__ __forceinline__ u32x4 pack8(const f32x4 v0, const f32x4 v1) { u32x4 w; w.x = cvt_pk_bf16(v0[0], v0[1]); w.y = cvt_pk_bf16(v0[2], v0[3]); w.z = cvt_pk_bf16(v1[0], v1[1]); w.w = cvt_pk_bf16(v1[2], v1[3]); return w; }

struct EpiProj {
    const float* rstd1; const float* qg; const float* kg;
    bf16_t *QN, *KN, *VN, *IQ, *QB, *KB, *VB, *RG, *MISC;
    float qscale, eps;
    __device__ __forceinline__ void operator()(const f32x4 (&acc)[2][2][4][2], const Unit& u, int wr, int wc, int fr, int fq) const {
        const int row0 = u.pm * BM + wr * 64 + fr; const int pn = u.pn;
        float rs1[2][4];
#pragma unroll
        for (int ai = 0; ai < 2; ++ai)
#pragma unroll
            for (int m = 0; m < 4; ++m) rs1[ai][m] = rstd1[row0 + ai * HALF + m * 16];
        if (pn < 4) {
            const bool isq = pn < 2; const float* gp = isq ? qg : kg; bf16_t* O = isq ? QN : KN; const float os = isq ? qscale : 1.f;
            f32x4 gv[2][2];
#pragma unroll
            for (int bj = 0; bj < 2; ++bj)
#pragma unroll
                for (int n = 0; n < 2; ++n) gv[bj][n] = *(const f32x4*)(gp + 32 * bj + 8 * fq + 4 * n) * os;
            const int hcol = (4 * (pn & 1) + wc) * 64 + 8 * fq;
#pragma unroll
            for (int ai = 0; ai < 2; ++ai)
#pragma unroll
                for (int m = 0; m < 4; ++m) { const int row = row0 + ai * HALF + m * 16; const float s = rs1[ai][m];
                    float ss = 0.f;
#pragma unroll
                    for (int bj = 0; bj < 2; ++bj)
#pragma unroll
                        for (int n = 0; n < 2; ++n) { const f32x4 x = acc[ai][bj][m][n]; ss += (x[0] * x[0] + x[1] * x[1]) + (x[2] * x[2] + x[3] * x[3]); }
                    ss = row4_sum(ss);
                    const float r = s * __builtin_amdgcn_rsqf(s * s * ss * (1.f / 64.f) + eps);
                    bf16_t* rowp = O + (size_t)row * 512 + hcol;
#pragma unroll
                    for (int bj = 0; bj < 2; ++bj) *(u32x4*)(rowp + 32 * bj) = pack8(acc[ai][bj][m][0] * r * gv[bj][0], acc[ai][bj][m][1] * r * gv[bj][1]); }
            return;
        }
        bf16_t* O; int pitch, coff, lim = 256;
        if (pn < 6) { O = VN; pitch = 512; coff = (pn - 4) * 256; }
        else if (pn == 6) { O = IQ; pitch = 256; coff = 0; }
        else if (pn == 7) { O = QB; pitch = 256; coff = 0; }
        else if (pn == 8) { O = KB; pitch = 256; coff = 0; }
        else if (pn < 11) { O = VB; pitch = 512; coff = (pn - 9) * 256; }
        else if (pn < 13) { O = RG; pitch = 512; coff = (pn - 11) * 256; }
        else { O = MISC; pitch = 64; coff = 0; lim = 56; }
        const int c0 = wc * 32 + 8 * fq;
#pragma unroll
        for (int ai = 0; ai < 2; ++ai)
#pragma unroll
            for (int m = 0; m < 4; ++m) { const int row = row0 + ai * HALF + m * 16; const float s = rs1[ai][m];
                bf16_t* rowp = O + (size_t)row * pitch + coff + c0;
#pragma unroll
                for (int bj = 0; bj < 2; ++bj) if (c0 + bj * HALF < lim) *(u32x4*)(rowp + bj * HALF) = pack8(acc[ai][bj][m][0] * s, acc[ai][bj][m][1] * s); }
    }
};

struct EpiOut {
    const float* x; bf16_t* XN2; float* ROWSS;
    __device__ __forceinline__ void operator()(const f32x4 (&acc)[2][2][4][2], const Unit& u, int wr, int wc, int fr, int fq) const {
        const int row0 = u.pm * BM + wr * 64 + fr; const int col0 = u.pn * BM + wc * 32 + 8 * fq;
        f32x4 xv[2][4];
#define EPO_LOAD(buf, g) do { const size_t off_ = (size_t)(row0 + ((g) >> 2) * HALF + ((g) & 3) * 16) * 1024 + col0; \
            xv[buf][0] = *(const f32x4*)(x + off_); xv[buf][1] = *(const f32x4*)(x + off_ + 4); xv[buf][2] = *(const f32x4*)(x + off_ + HALF); xv[buf][3] = *(const f32x4*)(x + off_ + HALF + 4); } while (0)
        EPO_LOAD(0, 0);
#pragma unroll
        for (int g = 0; g < 8; ++g) { const int ai = g >> 2, m = g & 3, cur = g & 1;
            if (g + 1 < 8) EPO_LOAD(cur ^ 1, g + 1);
            const int row = row0 + ai * HALF + m * 16; const size_t off = (size_t)row * 1024 + col0; float ss = 0.f;
#pragma unroll
            for (int bj = 0; bj < 2; ++bj) { const f32x4 a = xv[cur][2 * bj] + acc[ai][bj][m][0], b = xv[cur][2 * bj + 1] + acc[ai][bj][m][1];
                ss += (a[0] * a[0] + a[1] * a[1]) + (a[2] * a[2] + a[3] * a[3]) + (b[0] * b[0] + b[1] * b[1]) + (b[2] * b[2] + b[3] * b[3]);
                *(u32x4*)(XN2 + off + bj * HALF) = pack8(a, b); }
            ss = row4_sum(ss);
            if (fq == 0) ROWSS[(size_t)row * 16 + u.pn * 4 + wc] = ss; }
#undef EPO_LOAD
    }
};

struct EpiGU {
    const float* LSC; bf16_t* HID;
    __device__ __forceinline__ void operator()(const f32x4 (&acc)[2][2][4][2], const Unit& u, int wr, int wc, int fr, int fq) const {
        const int r0 = wr * 64 + fr; const int c0 = u.pn * HALF + wc * 32 + 8 * fq;
#pragma unroll
        for (int ai = 0; ai < 2; ++ai)
#pragma unroll
            for (int m = 0; m < 4; ++m) { const int r = r0 + ai * HALF + m * 16;
                f32x2 sw = (f32x2){0.f, 0.f};
                if (r < u.nv) sw = *(const f32x2*)(LSC + ((size_t)u.e * 16384 + (size_t)(u.p0 + r)) * 2);
                f32x4 h0, h1;
#pragma unroll
                for (int j = 0; j < 4; ++j) { const float a = acc[ai][0][m][0][j] * sw.x, uu = acc[ai][1][m][0][j] * sw.x; h0[j] = a * __builtin_amdgcn_rcpf(1.f + __expf(-a)) * uu * sw.y;
                                              const float a2 = acc[ai][0][m][1][j] * sw.x, u2 = acc[ai][1][m][1][j] * sw.x; h1[j] = a2 * __builtin_amdgcn_rcpf(1.f + __expf(-a2)) * u2 * sw.y; }
                *(u32x4*)(HID + (size_t)(u.pm * BM + r) * 256 + c0) = pack8(h0, h1); }
    }
};
struct EpiDown {
    bf16_t* Y;
    __device__ __forceinline__ void operator()(const f32x4 (&acc)[2][2][4][2], const Unit& u, int wr, int wc, int fr, int fq) const {
        const int r0 = u.pm * BM + wr * 64 + fr; const int c0 = u.pn * BM + wc * 32 + 8 * fq;
#pragma unroll
        for (int ai = 0; ai < 2; ++ai)
#pragma unroll
            for (int m = 0; m < 4; ++m) { bf16_t* rowp = Y + (size_t)(r0 + ai * HALF + m * 16) * 1024 + c0;
#pragma unroll
                for (int bj = 0; bj < 2; ++bj) *(u32x4*)(rowp + bj * HALF) = pack8(acc[ai][bj][m][0], acc[ai][bj][m][1]); }
    }
};
}
namespace attn_body {
using bf16=__hip_bfloat16;
using bf16x8=__attribute__((ext_vector_type(8)))short;
using s16x4=__attribute__((ext_vector_type(4)))short;
using f32x16=__attribute__((ext_vector_type(16)))float;
using u32x4=__attribute__((ext_vector_type(4)))unsigned;
constexpr int BATCH=8,NHEAD=8,SEQ=2048,D=64,DM=NHEAD*D,PO=1024;
constexpr int NW=8,QBLK=32,QB=QBLK*NW,KVBLK=64,NQB=SEQ/QB;
constexpr int ATTN_UNIT_ROWS=QB;
__device__ __forceinline__ int crow(int r,int hi){return (r&3)+8*(r>>2)+4*hi;}
#define SBAR() __builtin_amdgcn_sched_barrier(0)
typedef float f32x4a __attribute__((ext_vector_type(4)));
__device__ __forceinline__ void tbias(f32x16&p0,f32x16&p1,int t,int qpos,int hi,__attribute__((address_space(3))) const char* tabr){
  int base=qpos-64*t-4*hi; base=base<-4?-4:(base>200?200:base); const int a=200-base, s=a&3;
  const __attribute__((address_space(3))) f32x4a* tp=(const __attribute__((address_space(3))) f32x4a*)(tabr+s*1088+(a-s)*4);
  #pragma unroll
  for(int g=0;g<4;++g){ const f32x4a v0=tp[2*g], v1=tp[2*g+8];
    p0[4*g]+=v0[0];p0[4*g+1]+=v0[1];p0[4*g+2]+=v0[2];p0[4*g+3]+=v0[3]; p1[4*g]+=v1[0];p1[4*g+1]+=v1[1];p1[4*g+2]+=v1[2];p1[4*g+3]+=v1[3];
    asm volatile("":"+v"(p0),"+v"(p1)); }
}
__device__ __forceinline__ float mkeep(float v,unsigned mw,int bit){ const unsigned t=(unsigned)(((int)(mw<<(31-bit)))>>31); return __uint_as_float(__float_as_uint(v)&t); }
constexpr int NSLOT=3, SLOTB=8192;
constexpr int LDS_K=0, LDS_V=NSLOT*SLOTB, LDS_WS=2*NSLOT*SLOTB, LDS_OST=LDS_WS+NW*64*4, LDS_BYTES=LDS_OST+NW*4096, LDS_MSK=LDS_BYTES, LDS_TAB=LDS_MSK+65536, LDS_TOTAL=LDS_TAB+4352;
constexpr float C2=0.125f*1.4426950408889634f;
__device__ __forceinline__ void glds16(const void*gsrc,unsigned lds_dst){unsigned keep;
  asm volatile("s_mov_b32 %0, m0\n\ts_mov_b32 m0, %2\n\ts_nop 0\n\tglobal_load_lds_dwordx4 %1, off\n\ts_mov_b32 m0, %0":"=&s"(keep):"v"(gsrc),"s"(lds_dst):"memory");}
__device__ __forceinline__ float max3f(float a,float b,float c){float r;asm("v_max3_f32 %0, %1, %2, %3":"=v"(r):"v"(a),"v"(b),"v"(c));return r;}
__device__ __forceinline__ float max2f(float a,float b){float r;asm("v_max_f32_e32 %0, %1, %2":"=v"(r):"v"(a),"v"(b));return r;}
__device__ __forceinline__ float fadd_s(float a,float b){float r;asm("v_add_f32_e32 %0, %1, %2":"=v"(r):"v"(a),"v"(b));return r;}
__device__ __forceinline__ float fsub_s(float a,float b){float r;asm("v_sub_f32_e32 %0, %1, %2":"=v"(r):"v"(a),"v"(b));return r;}
typedef float f32x2_t __attribute__((ext_vector_type(2))); typedef __bf16 bf16x2_t __attribute__((ext_vector_type(2)));
__device__ __forceinline__ unsigned cvtpk_s(float lo,float hi){f32x2_t v={lo,hi};bf16x2_t b=__builtin_convertvector(v,bf16x2_t);return __builtin_bit_cast(unsigned,b);}
#define WAIT_BAR(N) asm volatile("s_waitcnt vmcnt(" #N ") lgkmcnt(0)\n\ts_barrier":::"memory")

__device__ __forceinline__ void qkt(f32x16&p0,f32x16&p1,const char*Kslot,const bf16x8*qr,const f32x16&negm,int r32,int hi){
  const char*kb=Kslot+hi*1024+r32*16;
  #pragma unroll
  for(int d0=0;d0<4;++d0){
    const bf16x8 b0=*reinterpret_cast<const bf16x8*>(kb+d0*2048);
    const bf16x8 b1=*reinterpret_cast<const bf16x8*>(kb+d0*2048+512);
    if(d0==0){p0=__builtin_amdgcn_mfma_f32_32x32x16_bf16(b0,qr[0],negm,0,0,0);p1=__builtin_amdgcn_mfma_f32_32x32x16_bf16(b1,qr[0],negm,0,0,0);}
    else{p0=__builtin_amdgcn_mfma_f32_32x32x16_bf16(b0,qr[d0],p0,0,0,0);p1=__builtin_amdgcn_mfma_f32_32x32x16_bf16(b1,qr[d0],p1,0,0,0);}}
}
typedef __attribute__((address_space(3))) const char* lds_cptr;
typedef short v4i16_t __attribute__((ext_vector_type(4)));
__device__ __forceinline__ void kload8(bf16x8*kf,lds_cptr kp){
  kf[0]=*(const __attribute__((address_space(3))) bf16x8*)(kp);      kf[1]=*(const __attribute__((address_space(3))) bf16x8*)(kp+512);
  kf[2]=*(const __attribute__((address_space(3))) bf16x8*)(kp+2048); kf[3]=*(const __attribute__((address_space(3))) bf16x8*)(kp+2560);
  kf[4]=*(const __attribute__((address_space(3))) bf16x8*)(kp+4096); kf[5]=*(const __attribute__((address_space(3))) bf16x8*)(kp+4608);
  kf[6]=*(const __attribute__((address_space(3))) bf16x8*)(kp+6144); kf[7]=*(const __attribute__((address_space(3))) bf16x8*)(kp+6656);
}
__device__ __forceinline__ void kload2(bf16x8*kf,lds_cptr kp,int j){ kf[2*j]=*(const __attribute__((address_space(3))) bf16x8*)(kp+j*2048); kf[2*j+1]=*(const __attribute__((address_space(3))) bf16x8*)(kp+j*2048+512); }
__device__ __forceinline__ s16x4 vtr(lds_cptr p){ return __builtin_bit_cast(s16x4,__builtin_amdgcn_ds_read_tr16_b64_v4i16((__attribute__((address_space(3))) v4i16_t*)p)); }
__device__ __forceinline__ float rowmax(const f32x16&p0,const f32x16&p1){
  float a=max3f(p0[0],p0[1],p1[0]),b=max3f(p0[2],p0[3],p1[1]);a=max3f(a,p1[2],p1[3]);
  #pragma unroll
  for(int r=4;r<16;r+=4){a=max3f(a,p0[r],p0[r+1]);b=max3f(b,p0[r+2],p0[r+3]);a=max3f(a,p1[r],p1[r+1]);b=max3f(b,p1[r+2],p1[r+3]);}
  const float m=max2f(a,b);
  auto rr=__builtin_amdgcn_permlane32_swap(__float_as_uint(m),__float_as_uint(m),false,false);
  return max2f(__uint_as_float(rr[0]),__uint_as_float(rr[1]));
}
__device__ __forceinline__ void pv(f32x16*o,int vb,bf16x8 pa0,bf16x8 pa1,bf16x8 pa2,bf16x8 pa3){
  #pragma unroll
  for(int d0=0;d0<2;++d0){s16x4 lo[4],hi[4];
    #pragma unroll
    for(int ks=0;ks<4;++ks){
      asm volatile("ds_read_b64_tr_b16 %0,%1 offset:%c2":"=&v"(lo[ks]):"v"(vb),"i"(d0*4096+ks*1024):"memory");
      asm volatile("ds_read_b64_tr_b16 %0,%1 offset:%c2":"=&v"(hi[ks]):"v"(vb),"i"(d0*4096+ks*1024+512):"memory");}
    asm volatile("s_waitcnt lgkmcnt(0)":::"memory");SBAR();
    #define PK(k) (bf16x8){lo[k][0],lo[k][1],lo[k][2],lo[k][3],hi[k][0],hi[k][1],hi[k][2],hi[k][3]}
    o[d0]=__builtin_amdgcn_mfma_f32_32x32x16_bf16(pa0,PK(0),o[d0],0,0,0);
    o[d0]=__builtin_amdgcn_mfma_f32_32x32x16_bf16(pa1,PK(1),o[d0],0,0,0);
    o[d0]=__builtin_amdgcn_mfma_f32_32x32x16_bf16(pa2,PK(2),o[d0],0,0,0);
    o[d0]=__builtin_amdgcn_mfma_f32_32x32x16_bf16(pa3,PK(3),o[d0],0,0,0);
    #undef PK
  }
}

#ifndef ATTN_STORE16
#define ATTN_STORE16(p,v) (*(u32x4*)(p)=(v))
#endif
template<int THRL> __device__ __forceinline__ void attn_unit(int b,int h,int qb,const bf16*Q,const bf16*__restrict__ K,const bf16*__restrict__ V,bf16*O,const unsigned*__restrict__ MASK,const float*__restrict__ relb,char*shm){
  int tid0_=threadIdx.x; asm volatile("":"+v"(tid0_));
  const int tid=tid0_,lane=tid&63,r32=lane&31,hi=lane>>5; const int wid=__builtin_amdgcn_readfirstlane(tid>>6);
  const long rowbase=(long)b*SEQ; const int q0=qb*QB;
  const bf16*Qw=Q+(rowbase+q0+wid*QBLK)*DM+h*D;
  const bf16*Kh=K+rowbase*DM+h*D,*Vh=V+rowbase*DM+h*D;
  const unsigned lds0=(unsigned)(uintptr_t)shm;
  float*wsf=(float*)(shm+LDS_WS)+wid*64;
  const bf16*ksrc=Kh+(long)lane*DM+wid*8;
  const bf16*vsrc=Vh+(long)(16*(wid&3)+(lane>>2))*DM+(wid>>2)*32+(lane&3)*8;
  const unsigned kdst=lds0+LDS_K+wid*1024, vdst=lds0+LDS_V+wid*1024;
  #define DMA_K(t,slot) glds16(ksrc+(long)(t)*KVBLK*DM,(unsigned)__builtin_amdgcn_readfirstlane(kdst+(slot)))
  #define DMA_V(t,slot) glds16(vsrc+(long)(t)*KVBLK*DM,(unsigned)__builtin_amdgcn_readfirstlane(vdst+(slot)))
  const int vb0=(int)(lds0+LDS_V)+((lane>>4)&1)*32+(lane&3)*8+(4*hi+((lane&15)>>2))*64;
  const char*Kbase=shm+LDS_K; bf16x8 kf[8];
  const lds_cptr shm3=(lds_cptr)shm; const lds_cptr kp0=shm3+LDS_K+hi*1024+r32*16; const lds_cptr vp0=shm3+LDS_V+((lane>>4)&1)*32+(lane&3)*8+(4*hi+((lane&15)>>2))*64;
  const int NT=(q0+QB)/KVBLK;
  { int tid_=tid; asm volatile("":"+v"(tid_));
    const u32x4*msrc=(const u32x4*)(MASK+((size_t)(b*32)*SEQ+q0)*2); u32x4*mdst=(u32x4*)(shm+LDS_MSK);
    u32x4 mv[8]; const int nit=NT>>2;
    _Pragma("unroll") for(int k=0;k<8;++k){ const int i=tid_+k*(NW*64); if(k<nit) mv[k]=msrc[(size_t)(i>>7)*(SEQ*2/4)+(i&127)]; }
    _Pragma("unroll") for(int k=0;k<8;++k){ const int i=tid_+k*(NW*64); if(k<nit) mdst[i]=mv[k]; }
    for(int i=tid_;i<4*272;i+=NW*64){ const int sft=i/272, k=i-sft*272, d=200-(k+sft); float v=0.f;
      if(d>=0&&d<=112){ int bk; if(d<16)bk=d; else { bk=16+(int)(logf((float)d*(1.0f/16.0f))/2.0794415416798357f*16.0f); bk=bk>31?31:bk; } v=(relb[bk*NHEAD+h]-relb[31*NHEAD+h])*1.4426950408889634f; }
      ((float*)(shm+LDS_TAB))[i]=v; } }
  const unsigned*mskw=(const unsigned*)(shm+LDS_MSK)+(wid*QBLK+r32)*2+hi;
  const int qpos=q0+wid*QBLK+r32;
  DMA_K(0,0);DMA_V(0,0);DMA_K(1,SLOTB);
  bf16x8 qr[4];
  #pragma unroll
  for(int d0=0;d0<4;++d0)qr[d0]=*reinterpret_cast<const bf16x8*>(&Qw[(long)r32*DM+d0*16+hi*8]);
  float mhat=0.f,l_reg=0.f;f32x16 o[2];o[0]=f32x16{};o[1]=f32x16{};f32x16 negm=f32x16{};asm volatile("":"+v"(negm));
  #define CMASK(P0,P1,t) do{ if((t)>=NT-7 && 64*(t)+63+127>=q0+wid*QBLK) tbias(P0,P1,(t),qpos,hi,shm3+LDS_TAB); }while(0)
  bool resc=false;
  #define START(P0,P1) do{ const float rm=rowmax(P0,P1); resc=false; \
    { const float dl=rm; mhat=fadd_s(mhat,dl); \
      _Pragma("unroll") for(int r=0;r<16;++r){P0[r]=fsub_s(P0[r],dl);P1[r]=fsub_s(P1[r],dl);} \
      _Pragma("unroll") for(int r=0;r<16;++r)negm[r]=-mhat; asm volatile("":"+v"(negm)); } \
    _Pragma("unroll") for(int r=0;r<16;++r)P0[r]=__builtin_amdgcn_exp2f(P0[r]); }while(0)
  #define RESC() do{ if(resc){ asm volatile("s_waitcnt lgkmcnt(0)":::"memory"); \
      _Pragma("unroll") for(int d_=0;d_<2;++d_) _Pragma("unroll") for(int r=0;r<16;++r)o[d_][r]*=wsf[crow(r,hi)]; } }while(0)
  f32x16 pA0,pA1,pB0,pB1;
  int sl_prev=0,sl_cur=0,sl_next=SLOTB;
  #define ROT() do{sl_prev=sl_cur;sl_cur=sl_next;sl_next=(sl_next==(NSLOT-1)*SLOTB)?0:sl_next+SLOTB;}while(0)
  DMA_K(2,2*SLOTB);
  WAIT_BAR(3);
  qkt(pA0,pA1,Kbase,qr,negm,r32,hi);asm volatile("s_nop 15\n\ts_nop 7":"+v"(pA0),"+v"(pA1));CMASK(pA0,pA1,0);
  START(pA0,pA1);
  _Pragma("unroll") for(int r=0;r<16;++r)pA1[r]=__builtin_amdgcn_exp2f(pA1[r]);
  { const unsigned mw0=mskw[0]; _Pragma("unroll") for(int r=0;r<16;++r){pA0[r]=mkeep(pA0[r],mw0,r);pA1[r]=mkeep(pA1[r],mw0,16+r);} }
  WAIT_BAR(0);
  DMA_K(3,0);DMA_V(1,SLOTB);
  ROT();
  kload8(kf,kp0+sl_cur);
  WAIT_BAR(2);
  s16x4 vlo[8],vhi[8]; u32x4 pw0,pw1,pw2,pw3;
  #define PKW(P,B) cvtpk_s(P[B],P[B+1])
  #define PAF(k) __builtin_bit_cast(bf16x8,pw##k)
  #define VFR(i) (bf16x8){vlo[i][0],vlo[i][1],vlo[i][2],vlo[i][3],vhi[i][0],vhi[i][1],vhi[i][2],vhi[i][3]}
  #define PIN(x) asm volatile("":"+v"(x))
  #define MX3(a,b,c) __builtin_fmaxf(__builtin_fmaxf((a),(b)),(c))
  #define GAPA(MF,A0,A1,A2,A3,W0,W1,PW) do{ MF; sacc+=A0; sacc+=A1; sacc+=A2; sacc+=A3; PIN(sacc); W0; W1; PIN(PW); SBAR(); }while(0)
  #define EX(v) __builtin_amdgcn_exp2f(v)
  #define GAPB(MF,X,B,MB) do{ MF; X[B]=mkeep(EX(X[B]),mw_,MB+B); X[B+1]=mkeep(EX(X[B+1]),mw_,MB+B+1); X[B+2]=mkeep(EX(X[B+2]),mw_,MB+B+2); X[B+3]=mkeep(EX(X[B+3]),mw_,MB+B+3); PIN(X); SBAR(); }while(0)
  #define VRD(i) do{ vlo[i]=vtr(vp_+(((i)>>2)*4096+((i)&3)*1024)); vhi[i]=vtr(vp_+(((i)>>2)*4096+((i)&3)*1024+512)); }while(0)
  #define KRD(G,j) do{ if(G){ kload2(kf,kp0+sl_next,j); SBAR(); } }while(0)
  #define STEP(C0,C1,P0,P1,t,GK,GV,GL) do{ SBAR(); \
    const lds_cptr vp_=vp0+sl_prev; const unsigned mw_=mskw[(t)*512]; \
    VRD(0); SBAR(); float sacc=(P0[0]+P0[1]); \
    GAPA(C0=__builtin_amdgcn_mfma_f32_32x32x16_bf16(kf[0],qr[0],negm,0,0,0), P0[2],P0[3],P0[4],P0[5],     pw0[0]=PKW(P0,0), pw0[1]=PKW(P0,2), pw0); \
    VRD(4); SBAR(); GAPA(C1=__builtin_amdgcn_mfma_f32_32x32x16_bf16(kf[1],qr[0],negm,0,0,0), P0[6],P0[7],P0[8],P0[9],     pw0[2]=PKW(P0,4), pw0[3]=PKW(P0,6), pw0); \
    VRD(1); SBAR(); GAPA(C0=__builtin_amdgcn_mfma_f32_32x32x16_bf16(kf[2],qr[1],C0,0,0,0),   P0[10],P0[11],P0[12],P0[13], pw1[0]=PKW(P0,8), pw1[1]=PKW(P0,10), pw1); \
    VRD(5); SBAR(); GAPA(C1=__builtin_amdgcn_mfma_f32_32x32x16_bf16(kf[3],qr[1],C1,0,0,0),   P0[14],P0[15],P1[0],P1[1],   pw1[2]=PKW(P0,12),pw1[3]=PKW(P0,14), pw1); \
    VRD(2); SBAR(); GAPA(C0=__builtin_amdgcn_mfma_f32_32x32x16_bf16(kf[4],qr[2],C0,0,0,0),   P1[2],P1[3],P1[4],P1[5],     pw2[0]=PKW(P1,0), pw2[1]=PKW(P1,2), pw2); \
    VRD(6); SBAR(); GAPA(C1=__builtin_amdgcn_mfma_f32_32x32x16_bf16(kf[5],qr[2],C1,0,0,0),   P1[6],P1[7],P1[8],P1[9],     pw2[2]=PKW(P1,4), pw2[3]=PKW(P1,6), pw2); \
    VRD(3); SBAR(); GAPA(C0=__builtin_amdgcn_mfma_f32_32x32x16_bf16(kf[6],qr[3],C0,0,0,0),   P1[10],P1[11],P1[12],P1[13], pw3[0]=PKW(P1,8), pw3[1]=PKW(P1,10), pw3); \
    VRD(7); SBAR(); GAPA(C1=__builtin_amdgcn_mfma_f32_32x32x16_bf16(kf[7],qr[3],C1,0,0,0),   P1[14],P1[15],0.f,0.f,       pw3[2]=PKW(P1,12),pw3[3]=PKW(P1,14), pw3); \
    l_reg+=sacc; \
    if(GK){DMA_K((t)+3,sl_cur);} if(GV){DMA_V((t)+1,sl_next);} \
    CMASK(C0,C1,t); \
    { float a=MX3(C0[0],C0[1],C1[0]),b=MX3(C0[2],C0[3],C1[1]); a=MX3(a,C1[2],C1[3]); \
      _Pragma("unroll") for(int r=4;r<16;r+=4){a=MX3(a,C0[r],C0[r+1]);b=MX3(b,C0[r+2],C0[r+3]);a=MX3(a,C1[r],C1[r+1]);b=MX3(b,C1[r+2],C1[r+3]);} \
      float rm=__builtin_fmaxf(a,b); { auto rr=__builtin_amdgcn_permlane32_swap(__float_as_uint(rm),__float_as_uint(rm),false,false); rm=__builtin_fmaxf(__uint_as_float(rr[0]),__uint_as_float(rr[1])); } \
      resc=false; \
      if(__builtin_expect(__any(rm>(float)THRL),0)){ const float dl=__builtin_fmaxf(rm,0.f); mhat+=dl; \
        _Pragma("unroll") for(int r=0;r<16;++r){C0[r]-=dl;C1[r]-=dl;} \
        _Pragma("unroll") for(int r=0;r<16;++r)negm[r]=-mhat; asm volatile("":"+v"(negm)); \
        const float f=__builtin_amdgcn_exp2f(-dl); l_reg*=f; if(hi==0)wsf[r32]=f; resc=true; } } \
    SBAR(); \
    GAPB(o[0]=__builtin_amdgcn_mfma_f32_32x32x16_bf16(PAF(0),VFR(0),o[0],0,0,0), C0,0,0); \
    GAPB(o[1]=__builtin_amdgcn_mfma_f32_32x32x16_bf16(PAF(0),VFR(4),o[1],0,0,0), C0,4,0); \
    KRD(GL,0); GAPB(o[0]=__builtin_amdgcn_mfma_f32_32x32x16_bf16(PAF(1),VFR(1),o[0],0,0,0), C0,8,0); \
    KRD(GL,1); GAPB(o[1]=__builtin_amdgcn_mfma_f32_32x32x16_bf16(PAF(1),VFR(5),o[1],0,0,0), C0,12,0); \
    KRD(GL,2); GAPB(o[0]=__builtin_amdgcn_mfma_f32_32x32x16_bf16(PAF(2),VFR(2),o[0],0,0,0), C1,0,16); \
    KRD(GL,3); GAPB(o[1]=__builtin_amdgcn_mfma_f32_32x32x16_bf16(PAF(2),VFR(6),o[1],0,0,0), C1,4,16); \
    GAPB(o[0]=__builtin_amdgcn_mfma_f32_32x32x16_bf16(PAF(3),VFR(3),o[0],0,0,0), C1,8,16); \
    GAPB(o[1]=__builtin_amdgcn_mfma_f32_32x32x16_bf16(PAF(3),VFR(7),o[1],0,0,0), C1,12,16); \
    }while(0)
  int t=1;
  #undef CMASK
  #define CMASK(P0,P1,t) do{}while(0)
  for(;t+7<NT;t+=2){
    STEP(pB0,pB1,pA0,pA1,t,true,true,true);     WAIT_BAR(2); RESC(); ROT();
    STEP(pA0,pA1,pB0,pB1,t+1,true,true,true);   WAIT_BAR(2); RESC(); ROT();
  }
  #undef CMASK
  #define CMASK(P0,P1,t) do{ if(64*(t)+63+127>=q0+wid*QBLK) tbias(P0,P1,(t),qpos,hi,shm3+LDS_TAB); }while(0)
  #define ENDW(tt) do{ if((tt)+3<NT){WAIT_BAR(2);} else if((tt)+2<NT){WAIT_BAR(1);} else {WAIT_BAR(0);} }while(0)
  for(;t+1<NT;t+=2){
    STEP(pB0,pB1,pA0,pA1,t,(t+3<NT),(t+1<NT),(t+1<NT));       ENDW(t);   RESC(); ROT();
    STEP(pA0,pA1,pB0,pB1,t+1,(t+4<NT),(t+2<NT),(t+2<NT));     ENDW(t+1); RESC(); ROT();
  }
  STEP(pB0,pB1,pA0,pA1,NT-1,false,false,false); RESC();
  { float sacc=pB0[0]+pB0[1]; _Pragma("unroll") for(int r=2;r<16;++r)sacc+=pB0[r]; _Pragma("unroll") for(int r=0;r<16;++r)sacc+=pB1[r]; l_reg+=sacc;
    pw0=(u32x4){PKW(pB0,0),PKW(pB0,2),PKW(pB0,4),PKW(pB0,6)};pw1=(u32x4){PKW(pB0,8),PKW(pB0,10),PKW(pB0,12),PKW(pB0,14)};pw2=(u32x4){PKW(pB1,0),PKW(pB1,2),PKW(pB1,4),PKW(pB1,6)};pw3=(u32x4){PKW(pB1,8),PKW(pB1,10),PKW(pB1,12),PKW(pB1,14)};
    SBAR(); pv(o,vb0+sl_cur,PAF(0),PAF(1),PAF(2),PAF(3)); }
  #undef PKW
  #undef PAF
  #undef VFR
  #undef PIN
  #undef MX3
  #undef GAPA
  #undef GAPB
  #undef EX
  #undef VRD
  #undef KRD
  #undef STEP
  #undef ENDW
  {auto rr=__builtin_amdgcn_permlane32_swap(__float_as_uint(l_reg),__float_as_uint(l_reg),false,false);l_reg=__uint_as_float(rr[0])+__uint_as_float(rr[1]);}
  if(hi==0)wsf[32+r32]=l_reg;asm volatile("s_waitcnt lgkmcnt(0)":::"memory");
  float rli[16];
  #pragma unroll
  for(int r=0;r<16;++r)rli[r]=__builtin_amdgcn_rcpf(wsf[32+crow(r,hi)]);
  bf16*Ow=O+(rowbase+q0+wid*QBLK)*PO+h*D;
  { bf16*stg=(bf16*)(shm+LDS_OST)+wid*2048;
    #pragma unroll
    for(int r=0;r<16;++r){const int orow=crow(r,hi);
      #pragma unroll
      for(int d0=0;d0<2;++d0)stg[orow*64+d0*32+r32]=__float2bfloat16(o[d0][r]*rli[r]);}
    asm volatile("s_waitcnt lgkmcnt(0)":::"memory");
    #pragma unroll
    for(int i=0;i<4;++i){const int row=i*8+(lane>>3),ch=lane&7; const u32x4 v=*(const u32x4*)(stg+row*64+ch*8); ATTN_STORE16(Ow+(long)row*PO+ch*8,v);} }
  asm volatile("s_waitcnt lgkmcnt(0)\n\ts_barrier":::"memory");
  #undef DMA_K
  #undef DMA_V
  #undef CMASK
  #undef START
  #undef RESC
  #undef ROT
}
struct AttnTensors { const bf16* Q; const bf16* K; const bf16* V; bf16* O; const unsigned* MASK; const float* relb; };
struct AttnUnit { int bh; int qb; };
constexpr int ATTN_LDS_BYTES=LDS_TOTAL;
#undef SBAR
#undef WAIT_BAR
}
constexpr int NWAVES = 8;
#ifndef MK_N_LAUNCHES
#define MK_N_LAUNCHES 1
#endif
constexpr int PER_PHASE = 10;
constexpr int N_LAUNCHES = (MK_N_LAUNCHES == 1) ? 1 : PER_PHASE;
constexpr int M = 8 * 2048;
constexpr size_t MiB = 1u << 20;
constexpr size_t WS_CTL = 0, CTL_ZERO_BYTES = 65536;
constexpr size_t WS_RSTD1 = 1 * MiB, WS_ROWSS = 2 * MiB, WS_WR = 3 * MiB, WS_BLAST = 3 * MiB + 512 * 1024, WS_TOKINFO = 4 * MiB, WS_LISTS = 5 * MiB, WS_LSC = 7 * MiB;
constexpr size_t WS_WO = 16 * MiB, WS_WGU = 18 * MiB, WS_WD = 50 * MiB, WS_XB = 66 * MiB, WS_MASK = 66 * MiB, WS_SB = 70 * MiB, WS_EG = 86 * MiB  , WS_WIN = 98 * MiB;
constexpr size_t WS_QN = 106 * MiB, WS_KN = 122 * MiB, WS_VN = 138 * MiB, WS_XN2 = 106 * MiB, WS_IQ = 154 * MiB, WS_MISC = 162 * MiB, WS_QB = 164 * MiB, WS_KB = 172 * MiB, WS_VB = 180 * MiB, WS_RG = 196 * MiB;
constexpr size_t WS_MIX = 212 * MiB, WS_HID = 138 * MiB, WS_Y = 158 * MiB, WS_END = 244 * MiB;
constexpr int CW_TMO = 0, CW_CODE = 1, CW_BAR = 4096, CW_CNT = 15360;
constexpr int RING_BYTES = 154624;
constexpr int LDSCTL_OFF = RING_BYTES, MISC_OFF = LDSCTL_OFF, TOFF_OFF = LDSCTL_OFF + 256;
constexpr int LDS_BYTES = RING_BYTES + 1024;
static_assert(attn_body::ATTN_LDS_BYTES <= RING_BYTES, "attention LDS");
#ifndef REP_IDX
#define REP_IDX 1
#endif
#ifndef REP_GLAA
#define REP_GLAA 1
#endif
#ifndef REP_ATT
#define REP_ATT 1
#endif
#ifndef REP_GLAC
#define REP_GLAC 1
#endif
#ifndef REP_IDX_SCORE
#define REP_IDX_SCORE 1
#endif
#ifndef REP_IDX_SEL
#define REP_IDX_SEL 1
#endif
#ifndef REP_SEL_A
#define REP_SEL_A 1
#endif
#ifndef REP_SEL_B
#define REP_SEL_B 1
#endif
#ifndef REP_SEL_C
#define REP_SEL_C 1
#endif
#ifndef REP_SEL_CNT
#define REP_SEL_CNT 1
#endif
#ifndef REP_SEL_ST
#define REP_SEL_ST 1
#endif
#define GAS __attribute__((address_space(1)))
#define LAS __attribute__((address_space(3)))
typedef unsigned short bf16;
typedef unsigned v4u __attribute__((ext_vector_type(4)));
typedef float f32x4 __attribute__((ext_vector_type(4)));
typedef short bf16x8 __attribute__((ext_vector_type(8)));
typedef GAS unsigned gu32;
typedef GAS unsigned long long gu64;
#define RLX_AGENT __ATOMIC_RELAXED, __HIP_MEMORY_SCOPE_AGENT
#define LDS_WAIT() asm volatile("s_waitcnt lgkmcnt(0)" ::: "memory")
#define VM_WAIT() asm volatile("s_waitcnt vmcnt(0)" ::: "memory")
__device__ __forceinline__ unsigned long long rt() { return __builtin_amdgcn_s_memrealtime(); }
__device__ __forceinline__ unsigned f2bf(float f) { unsigned u = __builtin_bit_cast(unsigned, f); return (u + 0x7fffu + ((u >> 16) & 1u)) >> 16; }
__device__ __forceinline__ unsigned pk2(float lo, float hi) { return f2bf(lo) | (f2bf(hi) << 16); }

#define XB_TMO      128
#define XB_XCNT(j)  (256  + 64 * (j))
#define XB_XSUB(j)  (1280 + 64 * (j))
#define XB_XGEN(j)  (2304 + 64 * (j))
#define XB_TOP      3328
#define XB_TOPGEN   3392
#define XCD_BAR_WORDS 3456
#define XB_SPIN_CAP (1u << 18)

__device__ __forceinline__ unsigned xb_ld(unsigned* p)              { return __hip_atomic_load(p, __ATOMIC_RELAXED, __HIP_MEMORY_SCOPE_AGENT); }
__device__ __forceinline__ unsigned xb_add(unsigned* p, unsigned v) { return __hip_atomic_fetch_add(p, v, __ATOMIC_RELAXED, __HIP_MEMORY_SCOPE_AGENT); }
__device__ __forceinline__ unsigned xb_xcc_id() { return (unsigned)__builtin_amdgcn_s_getreg((3 << 11) | 20) & 0xFu; }
#define XB_SPIN(cond, bar) do { unsigned _sp = 0; while (cond) { __builtin_amdgcn_s_sleep(1); \
    if ((++_sp & 255u) == 0u) { if (xb_ld(&(bar)[XB_TMO])) break; if (_sp > XB_SPIN_CAP) { atomicAdd(&(bar)[XB_TMO], 1u); break; } } } } while (0)

struct XcdBarrier {
    unsigned* bar; unsigned x;
    volatile LAS unsigned* st;
};

__device__ __forceinline__ XcdBarrier xcd_barrier_post(unsigned* bar, volatile LAS unsigned* st) {
    XcdBarrier b; b.bar = bar; b.x = xb_xcc_id(); b.st = st;
    if (threadIdx.x == 0) (void)xb_add(&bar[XB_XCNT(b.x)], 1u);
    return b;
}
__device__ __forceinline__ void xcd_barrier_complete(unsigned* bar, unsigned x, unsigned& nloc, unsigned& nx) {
    const unsigned G = gridDim.x * gridDim.y * gridDim.z;
    unsigned sum, cnt, mine, sp = 0u;
    for (;;) {
        sum = 0u; cnt = 0u; mine = 0u;
#pragma unroll
        for (unsigned j = 0; j < 16; ++j) { const unsigned c = xb_ld(&bar[XB_XCNT(j)]); sum += c; cnt += (c > 0u) ? 1u : 0u; mine = (j == x) ? c : mine; }
        if (sum == G) break;
        __builtin_amdgcn_s_sleep(1);
        if ((++sp & 255u) == 0u) { if (xb_ld(&bar[XB_TMO])) break; if (sp > XB_SPIN_CAP) { atomicAdd(&bar[XB_TMO], 1u); break; } }
    }
    nloc = mine > 0u ? mine : 1u; nx = cnt > 0u ? cnt : 1u;
}

__device__ __forceinline__ void xcd_barrier(const XcdBarrier& b) {
    asm volatile("s_waitcnt vmcnt(0)" ::: "memory");
    __syncthreads();
    if (threadIdx.x == 0) {
        unsigned* bar = b.bar;
        __builtin_amdgcn_s_waitcnt(0);
        unsigned nloc = b.st[0], nx = b.st[1];
        if (nloc == 0u) { xcd_barrier_complete(bar, b.x, nloc, nx); b.st[0] = nloc; b.st[1] = nx; }
        const unsigned old = xb_add(&bar[XB_XSUB(b.x)], 1u);
        const unsigned gen = old / nloc;
        if (old + 1u == (gen + 1u) * nloc) {
            __builtin_amdgcn_fence(__ATOMIC_RELEASE, "agent");
            asm volatile("s_waitcnt vmcnt(0)" ::: "memory");
            const unsigned og = xb_add(&bar[XB_TOP], 1u);
            const unsigned tg = og / nx;
            if (og + 1u == (tg + 1u) * nx) xb_add(&bar[XB_TOPGEN], 1u);
            else XB_SPIN(xb_ld(&bar[XB_TOPGEN]) == tg, bar);
            __builtin_amdgcn_fence(__ATOMIC_ACQUIRE, "agent");
            xb_add(&bar[XB_XGEN(b.x)], 1u);
            asm volatile("s_waitcnt vmcnt(0)" ::: "memory");
        } else {
            XB_SPIN(xb_ld(&bar[XB_XGEN(b.x)]) == gen, bar);
            __builtin_amdgcn_fence(__ATOMIC_ACQUIRE, "agent");
            asm volatile("s_waitcnt vmcnt(0)" ::: "memory");
        }
    }
    __syncthreads();
}
typedef float f32x2 __attribute__((ext_vector_type(2)));
typedef unsigned v2u __attribute__((ext_vector_type(2)));
__device__ __forceinline__ float bf2f(unsigned short b) { return __uint_as_float((unsigned)b << 16); }
__device__ __forceinline__ float bflo(unsigned w) { return __uint_as_float(w << 16); }
__device__ __forceinline__ float bfhi(unsigned w) { return __uint_as_float(w & 0xffff0000u); }
__device__ __forceinline__ float wave_sum(float v) {
#pragma unroll
    for (int o = 1; o < 64; o <<= 1) v += __shfl_xor(v, o);
    return v;
}
__device__ __forceinline__ float wave_max(float v) {
#pragma unroll
    for (int o = 1; o < 64; o <<= 1) v = fmaxf(v, __shfl_xor(v, o));
    return v;
}
__device__ __forceinline__ float wave_min(float v) {
#pragma unroll
    for (int o = 1; o < 64; o <<= 1) v = fminf(v, __shfl_xor(v, o));
    return v;
}
#define WG_SYNC() __syncthreads()
#define DPP_STEP_I(v, ctrl) __builtin_amdgcn_update_dpp(0, (v), (ctrl), 0xF, 0xF, false)
__device__ __forceinline__ int wave_isum(int v) {
    v += DPP_STEP_I(v, 0xB1); v += DPP_STEP_I(v, 0x4E); v += DPP_STEP_I(v, 0x141); v += DPP_STEP_I(v, 0x140);
    return __builtin_amdgcn_readlane(v, 0) + __builtin_amdgcn_readlane(v, 16) + __builtin_amdgcn_readlane(v, 32) + __builtin_amdgcn_readlane(v, 48);
}
#define DPP_STEP_F(v, ctrl) __uint_as_float((unsigned)__builtin_amdgcn_update_dpp(0, (int)__float_as_uint(v), (ctrl), 0xF, 0xF, false))
#define RDL_F(v, l) __uint_as_float((unsigned)__builtin_amdgcn_readlane((int)__float_as_uint(v), (l)))
__device__ __forceinline__ float wave_fsum(float v) {
    v += DPP_STEP_F(v, 0xB1); v += DPP_STEP_F(v, 0x4E); v += DPP_STEP_F(v, 0x141); v += DPP_STEP_F(v, 0x140);
    return (RDL_F(v, 0) + RDL_F(v, 16)) + (RDL_F(v, 32) + RDL_F(v, 48));
}
__device__ __forceinline__ float wave_fmax(float v) {
    v = fmaxf(v, DPP_STEP_F(v, 0xB1)); v = fmaxf(v, DPP_STEP_F(v, 0x4E)); v = fmaxf(v, DPP_STEP_F(v, 0x141)); v = fmaxf(v, DPP_STEP_F(v, 0x140));
    return fmaxf(fmaxf(RDL_F(v, 0), RDL_F(v, 16)), fmaxf(RDL_F(v, 32), RDL_F(v, 48)));
}
__device__ __forceinline__ float wave_fmin(float v) {
    v = fminf(v, DPP_STEP_F(v, 0xB1)); v = fminf(v, DPP_STEP_F(v, 0x4E)); v = fminf(v, DPP_STEP_F(v, 0x141)); v = fminf(v, DPP_STEP_F(v, 0x140));
    return fminf(fminf(RDL_F(v, 0), RDL_F(v, 16)), fminf(RDL_F(v, 32), RDL_F(v, 48)));
}

__device__ __forceinline__ int win_vrow(int n) {
    if (n < 1024) { const int base = (n < 512) ? 0 : 512, m = n - base, hh = m >> 6, d = m & 63; return base + 256 * (hh >> 2) + 128 * (d >> 5) + 32 * (hh & 3) + (d & 31); }
    if (n < 1792) return n;
    if (n < 1832) return 3328 + (n - 1792);
    if (n < 2088) return 1792 + (n - 1832);
    if (n < 2344) return 2048 + (n - 2088);
    if (n < 2856) return 2304 + (n - 2344);
    if (n < 2872) return 3328 + 40 + (n - 2856);
    return 2816 + (n - 2872);
}
template <int KIND>
__device__ __forceinline__ void p0_transpose_item(const float* __restrict__ W, int K, int N, const float* __restrict__ gain, bf16* WT, LAS float* scr, int item, int lane) {
    const int nblk = (N + 31) / 32, kb = item / nblk, nb = item % nblk, k0 = 64 * kb, n0 = 32 * nb;
    f32x4 v[8];
#pragma unroll
    for (int j = 0; j < 8; ++j) { const int i = lane + 64 * j, kk = i >> 3, c4 = (i & 7) * 4; v[j] = (n0 + c4 < N) ? *(const f32x4*)(W + (size_t)(k0 + kk) * N + n0 + c4) : (f32x4){0.f, 0.f, 0.f, 0.f}; }
#pragma unroll
    for (int j = 0; j < 8; ++j) { const int i = lane + 64 * j, kk = i >> 3, c4 = (i & 7) * 4; f32x4 x = v[j]; if (gain) x = x * gain[k0 + kk];
        scr[kk * 33 + c4] = x[0]; scr[kk * 33 + c4 + 1] = x[1]; scr[kk * 33 + c4 + 2] = x[2]; scr[kk * 33 + c4 + 3] = x[3]; }
    LDS_WAIT(); asm volatile("" ::: "memory");
    const int c = lane & 7;
#pragma unroll
    for (int j = 0; j < 4; ++j) { const int n = (lane >> 3) + 8 * j; const LAS float* s = scr + (8 * c) * 33 + n;
        v4u o; o.x = pk2(s[0 * 33], s[1 * 33]); o.y = pk2(s[2 * 33], s[3 * 33]); o.z = pk2(s[4 * 33], s[5 * 33]); o.w = pk2(s[6 * 33], s[7 * 33]);
        const int gn = n0 + n; int row;
        if (KIND == 0) row = win_vrow(gn); else if (KIND == 1) row = gn; else if (KIND == 2) row = (gn >> 7) * 256 + (gn & 127); else row = (gn >> 7) * 256 + 128 + (gn & 127);
        if (gn < N) *(GAS v4u*)(WT + (size_t)row * K + k0 + 8 * c) = o; }
    LDS_WAIT(); asm volatile("" ::: "memory");
}

constexpr int SCP = 2064;
__device__ __forceinline__ int crow_(int r, int hi) { return (r & 3) + 8 * (r >> 2) + 4 * hi; }
__device__ __forceinline__ void idx_item(LAS unsigned char* lds, int b, int p, const bf16* __restrict__ IQ, const bf16* __restrict__ MISC, unsigned* __restrict__ MASK, int lane, int wid) {
    const int q0 = p * 16, fr = lane & 15, fq = lane >> 4;
    LAS float* SC = (LAS float*)lds;
    const size_t rowq = (size_t)b * 2048 + q0 + fr;
    bf16x8 Bq[8]; float sinf[8];
    {   const v4u wraw = *(const v4u*)(MISC + rowq * 64 + 32);
        const unsigned wr_[4] = {wraw.x, wraw.y, wraw.z, wraw.w};
#pragma unroll
        for (int h = 0; h < 8; ++h) { const float w = ((h & 1) ? bfhi(wr_[h >> 1]) : bflo(wr_[h >> 1])) * 0.0625f;
            const v4u raw = *(const v4u*)(IQ + rowq * 256 + h * 32 + fq * 8);
            v4u o; o.x = pg8::cvt_pk_bf16(bflo(raw.x) * w, bfhi(raw.x) * w); o.y = pg8::cvt_pk_bf16(bflo(raw.y) * w, bfhi(raw.y) * w); o.z = pg8::cvt_pk_bf16(bflo(raw.z) * w, bfhi(raw.z) * w); o.w = pg8::cvt_pk_bf16(bflo(raw.w) * w, bfhi(raw.w) * w);
            Bq[h] = __builtin_bit_cast(bf16x8, o); sinf[h] = (w > 0.f) ? __builtin_inff() : -__builtin_inff(); } }
    const int nkt = p + 1;
    LAS int* const ROWCTR = (LAS int*)(lds + 16 * SCP * 4);
    if (wid == 0 && lane == 0) ROWCTR[0] = 0;
    const bf16* ikb = MISC + ((size_t)b * 2048 + fr) * 64 + fq * 8;
    for (int rep_ = 0; rep_ < REP_IDX_SCORE; ++rep_)
    for (int kt0 = wid; kt0 < nkt; kt0 += 32) {
        f32x4 acc[4]; bf16x8 A[4];
#pragma unroll
        for (int u = 0; u < 4; ++u) { const int kt = kt0 + 8 * u; acc[u] = (f32x4){0.f, 0.f, 0.f, 0.f}; if (kt < nkt) A[u] = *(const bf16x8*)(ikb + (size_t)kt * 16 * 64); else A[u] = (bf16x8){0, 0, 0, 0, 0, 0, 0, 0}; }
#pragma unroll
        for (int h = 0; h < 8; ++h)
#pragma unroll
            for (int u = 0; u < 4; ++u) { const f32x4 t = __builtin_amdgcn_mfma_f32_16x16x32_bf16(A[u], Bq[h], acc[u], 0, 0, 0);
#pragma unroll
                for (int i = 0; i < 4; ++i) acc[u][i] = __builtin_amdgcn_fmed3f(t[i], acc[u][i], sinf[h]); }
#pragma unroll
        for (int u = 0; u < 4; ++u) { const int kt = kt0 + 8 * u;
            if (kt < nkt) { if (kt == nkt - 1) {
#pragma unroll
                    for (int i = 0; i < 4; ++i) if (4 * fq + i > fr) acc[u][i] = -__builtin_inff(); }
                *(LAS f32x4*)(SC + fr * SCP + kt * 16 + 4 * fq) = acc[u]; } }
    }
    WG_SYNC();
    const int kap = 32 * ((lane >> 4) & 1) + crow_(lane & 15, lane >> 5);
#define IDX_COUNT(dst, expr) do { int cl__ = 0; _Pragma("unroll") for (int g__ = 0; g__ < 4; ++g__) if (8 * g__ < ntile) { _Pragma("unroll") for (int jj__ = 0; jj__ < 8; ++jj__) { const int j = 8 * g__ + jj__; cl__ += (expr) ? 1 : 0; } } \
        dst = wave_isum(cl__); } while (0)
#define IDX_UNI(v) __uint_as_float((unsigned)__builtin_amdgcn_readfirstlane((int)__float_as_uint(v)))
    for (;;) {
        int r = 0; if (lane == 0) r = __hip_atomic_fetch_add(ROWCTR, 1, __ATOMIC_RELAXED, __HIP_MEMORY_SCOPE_WORKGROUP);
        r = __builtin_amdgcn_readfirstlane(r); if (r >= 16) break;
        r = 15 - r;
        const int q = q0 + r, n = q + 1, ntile = (q >> 6) + 1, ngrp = (ntile + 7) >> 3;
        const float NINF = -__builtin_inff();
        float x[32]; unsigned vmask = 0u;
        for (int rpa = 0; rpa < REP_SEL_A; ++rpa) { int off_ = 0; asm volatile("" : "+v"(off_)); vmask = 0u;
#pragma unroll
        for (int j = 0; j < 32; ++j) x[j] = SC[r * SCP + 64 * j + kap + off_];
#pragma unroll
        for (int j = 0; j < 32; ++j) { const bool v = (64 * j + kap + off_) <= q; vmask |= v ? (1u << j) : 0u; x[j] = v ? x[j] : NINF; }
        }
        unsigned selm = vmask;
        for (int rpb = 0; rpb < REP_SEL_B; ++rpb) { asm volatile("" : "+v"(x[0]), "+v"(vmask)); selm = vmask;
        if (n > 256) {
            float mx = NINF, mn = __builtin_inff(), s1 = 0.f, s2 = 0.f;
#pragma unroll
            for (int g = 0; g < 4; ++g) if (g < ngrp) {
#pragma unroll
                for (int jj = 0; jj < 8; ++jj) { const int j = 8 * g + jj; const bool v = (vmask >> j) & 1u; const float xv = v ? x[j] : 0.f; mx = fmaxf(mx, x[j]); mn = fminf(mn, v ? x[j] : __builtin_inff()); s1 += xv; s2 += xv * xv; } }
            float hi = IDX_UNI(wave_fmax(mx)), lo = IDX_UNI(wave_fmin(mn));
            const float fn = (float)n, mu = wave_fsum(s1) / fn, var = fmaxf(wave_fsum(s2) / fn - mu * mu, 0.f);
            int c_lo = n, c_hi = 1;
            bool tie = false, found = false; float tv = hi, thr = hi; int need = 256;
            float mid; { const float pq = 256.0f / fn, pp = pq <= 0.5f ? pq : 1.0f - pq; const float t = sqrtf(-2.0f * __logf(pp)); float z = t - (2.30753f + 0.27061f * t) / (1.0f + t * (0.99229f + 0.04481f * t)); z = pq <= 0.5f ? z : -z; mid = IDX_UNI(mu + z * sqrtf(var)); }
            int side = 0;
            for (int it = 0; it < 40; ++it) {
                if (it > 0 || !(mid > lo && mid < hi)) {
                    mid = 0.5f * lo + 0.5f * hi;
                    if (side > -2 && side < 2) { const float fr_ = ((float)(c_lo - 256) + 0.5f) * __builtin_amdgcn_rcpf((float)(c_lo - c_hi)); const float m2 = lo + (hi - lo) * fr_; if (m2 > lo && m2 < hi) mid = m2; } else side = 0;
                    mid = IDX_UNI(mid);
                }
                if (!(mid > lo && mid < hi)) break;
                unsigned a0 = 0u, a1 = 0u; const f32x2 mid2 = (f32x2){mid, mid};
#pragma unroll
                for (int g = 1; g >= 0; --g) if (g < ngrp) {
#pragma unroll
                    for (int jj = 6; jj >= 0; jj -= 2) { const f32x2 d = (f32x2){x[8 * g + jj], x[8 * g + jj + 1]} - mid2; a0 = __builtin_amdgcn_alignbit(a0, __float_as_uint(d[1]), 31); a0 = __builtin_amdgcn_alignbit(a0, __float_as_uint(d[0]), 31); } }
#pragma unroll
                for (int g = 3; g >= 2; --g) if (g < ngrp) {
#pragma unroll
                    for (int jj = 6; jj >= 0; jj -= 2) { const f32x2 d = (f32x2){x[8 * g + jj], x[8 * g + jj + 1]} - mid2; a1 = __builtin_amdgcn_alignbit(a1, __float_as_uint(d[1]), 31); a1 = __builtin_amdgcn_alignbit(a1, __float_as_uint(d[0]), 31); } }
                const int c = 64 * 8 * ngrp - wave_isum(__builtin_popcount(a0) + __builtin_popcount(a1));
                if (c == 256) { found = true; selm = vmask & ~(a0 | (a1 << 16)); thr = mid; break; }
                if (c > 256) { lo = mid; c_lo = c; side = side > 0 ? side + 1 : 1; } else { hi = mid; c_hi = c; side = side < 0 ? side - 1 : -1; }
            }
            if (!found) {
                IDX_COUNT(c_hi, x[j] >= hi);
                if (c_hi >= 256) { if (c_hi == 256) { thr = hi; found = true; } else { tie = true; tv = hi; need = 256; } }
                else for (int it = 0; it < 4096; ++it) {
                    float m = NINF;
#pragma unroll
                    for (int g = 0; g < 4; ++g) if (g < ngrp) {
#pragma unroll
                        for (int jj = 0; jj < 8; ++jj) { const int j = 8 * g + jj; m = fmaxf(m, (x[j] < hi) ? x[j] : NINF); } }
                    const float v1 = IDX_UNI(wave_fmax(m));
                    int c; IDX_COUNT(c, x[j] >= v1);
                    if (c >= 256) { if (c == 256) { thr = v1; found = true; } else { tie = true; tv = v1; need = 256 - c_hi; } break; }
                    hi = v1; c_hi = c;
                }
                if (!tie) { selm = 0u;
#pragma unroll
                    for (int j = 0; j < 32; ++j) selm |= (x[j] >= thr) ? (1u << j) : 0u;
                } else {
                    int cum = 0, jstar = 32, needp = 0; unsigned tiem = 0u; selm = 0u;
#pragma unroll
                    for (int j = 0; j < 32; ++j) { const bool t = (x[j] == tv); tiem |= t ? (1u << j) : 0u; const int cj = __builtin_popcountll(__ballot(t));
                        if (jstar == 32 && cum + cj > need) { jstar = j; needp = need - cum; } cum += cj; }
                    const bool tstar = (jstar < 32) && ((tiem >> (jstar & 31)) & 1u);
                    int kL = 0, kH = 63;
                    if (jstar < 32 && needp > 0) { while (kL < kH) { const int km = (kL + kH) >> 1; const int c = __builtin_popcountll(__ballot(tstar && kap <= km)); if (c >= needp) kH = km; else kL = km + 1; } }
                    else kL = -1;
#pragma unroll
                    for (int j = 0; j < 32; ++j) { const bool t = (tiem >> j) & 1u; const bool ts = t && (j < jstar || (j == jstar && kap <= kL)); selm |= (x[j] > tv || ts) ? (1u << j) : 0u; }
                }
            }
        }
        }
        unsigned wlo = 0u, whi = 0u;
        for (int rpc = 0; rpc < REP_SEL_C; ++rpc) { asm volatile("" : "+v"(selm));
#pragma unroll
        for (int j = 0; j < 32; ++j) { const unsigned long long bal = __ballot((selm >> j) & 1u); if (lane == j) { wlo = (unsigned)bal; whi = (unsigned)(bal >> 32); } }
        if (lane < 32) { v2u o; o.x = wlo; o.y = whi; *(v2u*)(MASK + (((size_t)(b * 32 + lane)) * 2048 + q) * 2) = o; }
        }
    }
#undef IDX_COUNT
#undef IDX_UNI
    WG_SYNC();
}

constexpr int KTP = 72;
constexpr int VRP = 136;
constexpr int EP = 68;
constexpr int OTP = 132;
constexpr int GL_OFF = 0, TOT_OFF = 4096, E_OFF = 6144, QA_OFF = 23552, KR_OFF = 32768, PM_OFF = 41984, VR_OFF = 51200, OT_OFF = 68608;
typedef short v4i16g __attribute__((ext_vector_type(4)));
__device__ __forceinline__ bf16x8 tr_frag(const LAS bf16* T, int pitch, int k0, int n0, int lane) {
    const int g = lane >> 4, q = (lane & 15) >> 2, p = lane & 3;
    const LAS bf16* a = T + (k0 + 8 * g + q) * pitch + n0 + 4 * p;
    const v4i16g lo = __builtin_amdgcn_ds_read_tr16_b64_v4i16((LAS v4i16g*)a), hi = __builtin_amdgcn_ds_read_tr16_b64_v4i16((LAS v4i16g*)(a + 4 * pitch));
    return (bf16x8){lo[0], lo[1], lo[2], lo[3], hi[0], hi[1], hi[2], hi[3]};
}
__device__ __forceinline__ float fexp(float x) { return __builtin_amdgcn_exp2f(x * 1.4426950408889634f); }
__device__ __forceinline__ float gla_decay(LAS unsigned char* lds, const bf16* __restrict__ MISC, const float* __restrict__ w2, const float* __restrict__ gb, size_t row0, int h, int tid) {
    LAS float* GL = (LAS float*)(lds + GL_OFF); LAS float* TOT = (LAS float*)(lds + TOT_OFF); LAS float* E = (LAS float*)(lds + E_OFF);
    const int d = tid & 63, tg = tid >> 6;
    { const int t = tid >> 3, r2 = (tid & 7) * 2; const unsigned w = *(const unsigned*)(MISC + (row0 + t) * 64 + 40 + r2); GL[t * 16 + r2] = bflo(w); GL[t * 16 + r2 + 1] = bfhi(w); }
    float wc[16];
#pragma unroll
    for (int r = 0; r < 16; ++r) wc[r] = w2[r * 256 + h * 64 + d];
    const float bias = gb[h * 64 + d];
    WG_SYNC();
    float bc[8]; float run = 0.f;
#pragma unroll
    for (int i = 0; i < 8; ++i) { const int t = 8 * tg + i; float z = bias;
#pragma unroll
        for (int r4 = 0; r4 < 4; ++r4) { const f32x4 g = *(const LAS f32x4*)(GL + t * 16 + 4 * r4); z += g[0] * wc[4 * r4] + g[1] * wc[4 * r4 + 1] + g[2] * wc[4 * r4 + 2] + g[3] * wc[4 * r4 + 3]; }
        const float ls = fminf(z, 0.f) - 0.6931471805599453f * __builtin_amdgcn_logf(1.0f + __builtin_amdgcn_exp2f(-1.4426950408889634f * fabsf(z)));
        run += ls * (1.0f / 16.0f); bc[i] = run; }
    TOT[tg * 64 + d] = run;
    WG_SYNC();
    float pre = 0.f, tot = 0.f;
#pragma unroll
    for (int g = 0; g < 8; ++g) { const float v = TOT[g * 64 + d]; tot += v; if (g < tg) pre += v; }
#pragma unroll
    for (int i = 0; i < 8; ++i) E[(8 * tg + i) * EP + d] = fexp(tot - (bc[i] + pre));
    return tot;
}
__device__ __forceinline__ void gla_load_v(LAS unsigned char* lds, const bf16* __restrict__ VB, size_t row0, int h, int tid) {
    LAS bf16* VR = (LAS bf16*)(lds + VR_OFF); const int t = tid >> 3, v0 = (tid & 7) * 16; const bf16* src = VB + (row0 + t) * 512 + h * 128 + v0;
    const v4u a = *(const v4u*)src, b = *(const v4u*)(src + 8);
    *(LAS v4u*)(VR + t * VRP + v0) = a; *(LAS v4u*)(VR + t * VRP + v0 + 8) = b;
}
__device__ __forceinline__ v4u scale8(v4u raw, const f32x4 e0, const f32x4 e1) {
    v4u o; o.x = pg8::cvt_pk_bf16(bflo(raw.x) * e0[0], bfhi(raw.x) * e0[1]); o.y = pg8::cvt_pk_bf16(bflo(raw.y) * e0[2], bfhi(raw.y) * e0[3]);
    o.z = pg8::cvt_pk_bf16(bflo(raw.z) * e1[0], bfhi(raw.z) * e1[1]); o.w = pg8::cvt_pk_bf16(bflo(raw.w) * e1[2], bfhi(raw.w) * e1[3]); return o;
}
__device__ __forceinline__ void gla_a_item(LAS unsigned char* lds, int id, const bf16* __restrict__ KB, const bf16* __restrict__ VB, const bf16* __restrict__ MISC, const float* __restrict__ w2, const float* __restrict__ gb,
                                           float* __restrict__ U, float* __restrict__ BLAST, float* __restrict__ EG, int tid, int lane, int wid) {
    const int b = id >> 7, h = (id >> 5) & 3, c = id & 31; const size_t row0 = (size_t)b * 2048 + 64 * c;
    const v4u kraw = *(const v4u*)(KB + (row0 + (tid >> 3)) * 256 + h * 64 + (tid & 7) * 8);
    gla_load_v(lds, VB, row0, h, tid);
    const float blast = gla_decay(lds, MISC, w2, gb, row0, h, tid);
    if (tid < 64) BLAST[(size_t)id * 64 + tid] = blast;
    WG_SYNC();
    LAS bf16* KR = (LAS bf16*)(lds + KR_OFF); LAS bf16* VR = (LAS bf16*)(lds + VR_OFF); const LAS float* E = (const LAS float*)(lds + E_OFF);
    { const int t = tid >> 3, d8 = (tid & 7) * 8; const f32x4 e0 = *(const LAS f32x4*)(E + t * EP + d8), e1 = *(const LAS f32x4*)(E + t * EP + d8 + 4); *(LAS v4u*)(KR + t * KTP + d8) = scale8(kraw, e0, e1);
      float* eg = EG + ((size_t)id * 64 + t) * 64 + d8; *(f32x4*)eg = e0; *(f32x4*)(eg + 4) = e1; }
    WG_SYNC();
    const int fr = lane & 15, fq = lane >> 4;
    bf16x8 Bf[2];
#pragma unroll
    for (int kk = 0; kk < 2; ++kk) Bf[kk] = tr_frag(VR, VRP, 32 * kk, 16 * wid, lane);
#pragma unroll
    for (int dt = 0; dt < 4; ++dt) { f32x4 acc = (f32x4){0.f, 0.f, 0.f, 0.f};
#pragma unroll
        for (int kk = 0; kk < 2; ++kk) { const bf16x8 Af = tr_frag(KR, KTP, 32 * kk, 16 * dt, lane); acc = __builtin_amdgcn_mfma_f32_16x16x32_bf16(Af, Bf[kk], acc, 0, 0, 0); }
        *(f32x4*)(U + ((size_t)id * 128 + 16 * wid + fr) * 64 + 16 * dt + 4 * fq) = acc; }
    WG_SYNC();
}
__device__ __forceinline__ void gla_b_item(int item, const float* __restrict__ U, const float* __restrict__ BLAST, bf16* __restrict__ SB, int tid) {
    const int bh = item >> 2, qt = item & 3; const size_t eoff = (size_t)qt * 2048 + (size_t)tid * 4; const int d0 = (tid * 4) & 63;
    f32x4 S = (f32x4){0.f, 0.f, 0.f, 0.f};
#pragma unroll 1
    for (int half = 0; half < 2; ++half) {
        f32x4 u[16], bl[16];
#pragma unroll
        for (int c = 0; c < 16; ++c) { const size_t id = (size_t)bh * 32 + 16 * half + c; u[c] = *(const f32x4*)(U + id * 8192 + eoff); bl[c] = *(const f32x4*)(BLAST + id * 64 + d0); }
#pragma unroll
        for (int c = 0; c < 16; ++c) { const size_t id = (size_t)bh * 32 + 16 * half + c;
            f32x4 e; e[0] = __expf(bl[c][0]); e[1] = __expf(bl[c][1]); e[2] = __expf(bl[c][2]); e[3] = __expf(bl[c][3]);
            const f32x4 sd = S * e; v2u o; o.x = pk2(sd[0], sd[1]); o.y = pk2(sd[2], sd[3]); *(v2u*)(SB + id * 8192 + eoff) = o; S = sd + u[c]; }
    }
}
__device__ __forceinline__ void gla_c_item(LAS unsigned char* lds, int id, const bf16* __restrict__ QB, const bf16* __restrict__ KB, const bf16* __restrict__ VB, const bf16* __restrict__ RG, const float* __restrict__ EG,
                                           const float* __restrict__ og, const bf16* __restrict__ SB, bf16* __restrict__ MIX, int tid, int lane, int wid) {
    const int b = id >> 7, h = (id >> 5) & 3, c = id & 31; const size_t row0 = (size_t)b * 2048 + 64 * c;
    const int st_t = tid >> 3, st_d8 = (tid & 7) * 8;
    const v4u kraw = *(const v4u*)(KB + (row0 + st_t) * 256 + h * 64 + st_d8), qraw = *(const v4u*)(QB + (row0 + st_t) * 256 + h * 64 + st_d8);
    const float* eg = EG + ((size_t)id * 64 + st_t) * 64 + st_d8; const f32x4 e0 = *(const f32x4*)eg, e1 = *(const f32x4*)(eg + 4);
    gla_load_v(lds, VB, row0, h, tid);
    const int fr = lane & 15, fq = lane >> 4;
    bf16x8 Bs[2];
    { const bf16* sbp = SB + ((size_t)id * 128 + 16 * wid + fr) * 64 + 8 * fq; Bs[0] = *(const bf16x8*)sbp; Bs[1] = *(const bf16x8*)(sbp + 32); }
    LAS bf16* QA = (LAS bf16*)(lds + QA_OFF); LAS bf16* KR = (LAS bf16*)(lds + KR_OFF); LAS bf16* PM = (LAS bf16*)(lds + PM_OFF); LAS bf16* VR = (LAS bf16*)(lds + VR_OFF);
    LAS float* OT = (LAS float*)(lds + OT_OFF);
    { f32x4 r0, r1;
#pragma unroll
      for (int i = 0; i < 4; ++i) { r0[i] = 0.125f * __builtin_amdgcn_rcpf(e0[i]); r1[i] = 0.125f * __builtin_amdgcn_rcpf(e1[i]); }
      *(LAS v4u*)(KR + st_t * KTP + st_d8) = scale8(kraw, e0, e1); *(LAS v4u*)(QA + st_t * KTP + st_d8) = scale8(qraw, r0, r1); }
    WG_SYNC();
    { const int tt = wid >> 1;
#pragma unroll
      for (int s2 = 0; s2 < 2; ++s2) { const int st = 2 * (wid & 1) + s2; f32x4 acc = (f32x4){0.f, 0.f, 0.f, 0.f};
        if (st <= tt) {
#pragma unroll
            for (int kk = 0; kk < 2; ++kk) { const bf16x8 Af = *(const LAS bf16x8*)(KR + (16 * st + fr) * KTP + 32 * kk + 8 * fq); const bf16x8 Bf = *(const LAS bf16x8*)(QA + (16 * tt + fr) * KTP + 32 * kk + 8 * fq);
                acc = __builtin_amdgcn_mfma_f32_16x16x32_bf16(Af, Bf, acc, 0, 0, 0); } }
        const int t = 16 * tt + fr, s0 = 16 * st + 4 * fq; v2u o;
        o.x = pg8::cvt_pk_bf16((s0 <= t) ? acc[0] : 0.f, (s0 + 1 <= t) ? acc[1] : 0.f); o.y = pg8::cvt_pk_bf16((s0 + 2 <= t) ? acc[2] : 0.f, (s0 + 3 <= t) ? acc[3] : 0.f);
        *(LAS v2u*)(PM + t * KTP + s0) = o; } }
    WG_SYNC();
    bf16x8 Bv[2];
#pragma unroll
    for (int kk = 0; kk < 2; ++kk) Bv[kk] = tr_frag(VR, VRP, 32 * kk, 16 * wid, lane);
#pragma unroll
    for (int tt = 0; tt < 4; ++tt) { f32x4 acc = (f32x4){0.f, 0.f, 0.f, 0.f};
#pragma unroll
        for (int kk = 0; kk < 2; ++kk) { const bf16x8 Ap = *(const LAS bf16x8*)(PM + (16 * tt + fr) * KTP + 32 * kk + 8 * fq); acc = __builtin_amdgcn_mfma_f32_16x16x32_bf16(Ap, Bv[kk], acc, 0, 0, 0);
                                         const bf16x8 Aq = *(const LAS bf16x8*)(QA + (16 * tt + fr) * KTP + 32 * kk + 8 * fq); acc = __builtin_amdgcn_mfma_f32_16x16x32_bf16(Aq, Bs[kk], acc, 0, 0, 0); }
#pragma unroll
        for (int i = 0; i < 4; ++i) OT[(16 * tt + 4 * fq + i) * OTP + 16 * wid + fr] = acc[i]; }
    WG_SYNC();
    { const int t = tid >> 3, v0 = (tid & 7) * 16; f32x4 ov[4]; float ss = 0.f;
#pragma unroll
      for (int k = 0; k < 4; ++k) { ov[k] = *(const LAS f32x4*)(OT + t * OTP + v0 + 4 * k); ss += (ov[k][0] * ov[k][0] + ov[k][1] * ov[k][1]) + (ov[k][2] * ov[k][2] + ov[k][3] * ov[k][3]); }
      ss += DPP_STEP_F(ss, 0xB1); ss += DPP_STEP_F(ss, 0x4E); ss += DPP_STEP_F(ss, 0x141);
      const float rs = __builtin_amdgcn_rsqf(ss * (1.0f / 128.0f) + 1e-6f);
      const bf16* rgp = RG + (row0 + t) * 512 + h * 128 + v0; const v4u ra = *(const v4u*)rgp, rb = *(const v4u*)(rgp + 8);
      const unsigned rw[8] = {ra.x, ra.y, ra.z, ra.w, rb.x, rb.y, rb.z, rb.w}; unsigned ow[8];
#pragma unroll
      for (int k = 0; k < 4; ++k) { const f32x4 g = *(const f32x4*)(og + v0 + 4 * k); float y[4];
#pragma unroll
          for (int i = 0; i < 4; ++i) { const unsigned w = rw[2 * k + (i >> 1)]; const float r = (i & 1) ? bfhi(w) : bflo(w); const float sg = r * __builtin_amdgcn_rcpf(1.0f + __builtin_amdgcn_exp2f(-1.4426950408889634f * r)); y[i] = ov[k][i] * rs * g[i] * sg; }
          ow[2 * k] = pg8::cvt_pk_bf16(y[0], y[1]); ow[2 * k + 1] = pg8::cvt_pk_bf16(y[2], y[3]); }
      bf16* op = MIX + (row0 + t) * 1024 + 512 + h * 128 + v0;
      *(v4u*)op = (v4u){ow[0], ow[1], ow[2], ow[3]}; *(v4u*)(op + 8) = (v4u){ow[4], ow[5], ow[6], ow[7]}; }
    WG_SYNC();
}

constexpr int WRP = 1032;
constexpr int WR_LDS_BYTES = 48 * WRP * 2;
__device__ __forceinline__ void router_tile(LAS unsigned char* lds, int tile, const bf16* __restrict__ XN2, const float* __restrict__ ROWSS, const float* __restrict__ brg, const float* __restrict__ bre,
                                            unsigned* __restrict__ CNT, int* __restrict__ LISTS, float* __restrict__ LSC, int* __restrict__ TOKINFO, int tid, int lane, int wid) {
    LAS bf16* WR = (LAS bf16*)lds; LAS float* PL = (LAS float*)(lds + WR_LDS_BYTES); LAS unsigned* CL = (LAS unsigned*)(lds + WR_LDS_BYTES + 24576); LAS unsigned* BS = CL + 32;
    if (tid < 32) CL[tid] = 0u;
    const int fr = lane & 15, fq = lane >> 4, rt = wid >> 1, kh = wid & 1;
    {   const size_t row = (size_t)tile * 64 + 16 * rt + fr; const bf16* ap = XN2 + row * 1024 + 512 * kh + 8 * fq;
        bf16x8 Af[16];
#pragma unroll
        for (int kk = 0; kk < 16; ++kk) Af[kk] = *(const bf16x8*)(ap + 32 * kk);
        f32x4 acc[3];
#pragma unroll
        for (int nt = 0; nt < 3; ++nt) acc[nt] = (f32x4){0.f, 0.f, 0.f, 0.f};
#pragma unroll
        for (int kk = 0; kk < 16; ++kk)
#pragma unroll
            for (int nt = 0; nt < 3; ++nt) { const bf16x8 Bf = *(const LAS bf16x8*)(WR + (16 * nt + fr) * WRP + 512 * kh + 32 * kk + 8 * fq); acc[nt] = __builtin_amdgcn_mfma_f32_16x16x32_bf16(Af[kk], Bf, acc[nt], 0, 0, 0); }
#pragma unroll
        for (int nt = 0; nt < 3; ++nt)
#pragma unroll
            for (int i = 0; i < 4; ++i) PL[(wid * 16 + 4 * fq + i) * 48 + 16 * nt + fr] = acc[nt][i];
    }
    WG_SYNC();
    int e_[2] = {0, 0}; unsigned lp[2] = {0u, 0u}; float wk[2] = {0.f, 0.f}; float rstd2 = 0.f; const bool act = tid < 64;
    const int token = tile * 64 + tid;
    if (act) {
        const LAS float* l0 = PL + ((2 * (tid >> 4)) * 16 + (tid & 15)) * 48; const LAS float* l1 = l0 + 16 * 48; float ss = 0.f;
        const f32x4* rp = (const f32x4*)(ROWSS + (size_t)token * 16);
#pragma unroll
        for (int j = 0; j < 4; ++j) { const f32x4 v = rp[j]; ss += (v[0] + v[1]) + (v[2] + v[3]); }
        rstd2 = 1.0f / sqrtf(ss * (1.0f / 1024.0f) + 1e-6f);
        float gl[4]; int gs = 0;
#pragma unroll
        for (int j = 0; j < 4; ++j) gl[j] = (l0[j] + l1[j]) * rstd2 + brg[j];
#pragma unroll
        for (int j = 1; j < 4; ++j) if (gl[j] > gl[gs]) gs = j;
        float den = 0.f;
#pragma unroll
        for (int j = 0; j < 4; ++j) den += __expf(gl[j] - gl[gs]);
        const float gw = 1.0f / den;
        float el[8];
#pragma unroll
        for (int j = 0; j < 8; ++j) el[j] = (l0[4 + gs * 8 + j] + l1[4 + gs * 8 + j]) * rstd2 + bre[gs * 8 + j];
        int i0 = 0;
#pragma unroll
        for (int j = 1; j < 8; ++j) if (el[j] > el[i0]) i0 = j;
        int i1 = (i0 == 0) ? 1 : 0;
#pragma unroll
        for (int j = 0; j < 8; ++j) if (j != i0 && j != i1 && el[j] > el[i1]) i1 = j;
        const float ex = __expf(el[i1] - el[i0]); const float w0 = 1.0f / (1.0f + ex);
        wk[0] = w0 * gw; wk[1] = ex * w0 * gw; e_[0] = gs * 8 + i0; e_[1] = gs * 8 + i1;
        lp[0] = __hip_atomic_fetch_add(CL + e_[0], 1u, __ATOMIC_RELAXED, __HIP_MEMORY_SCOPE_WORKGROUP); lp[1] = __hip_atomic_fetch_add(CL + e_[1], 1u, __ATOMIC_RELAXED, __HIP_MEMORY_SCOPE_WORKGROUP);
    }
    WG_SYNC();
    if (tid < 32) { const unsigned n = CL[tid]; BS[tid] = n ? __hip_atomic_fetch_add(CNT + tid, n, __ATOMIC_RELAXED, __HIP_MEMORY_SCOPE_AGENT) : 0u; }
    WG_SYNC();
    if (act) {
#pragma unroll
        for (int k = 0; k < 2; ++k) { const unsigned pos = BS[e_[k]] + lp[k]; LISTS[(size_t)e_[k] * 16384 + pos] = token; *(f32x2*)(LSC + ((size_t)e_[k] * 16384 + pos) * 2) = (f32x2){rstd2, wk[k]}; }
        *(int4*)(TOKINFO + (size_t)token * 4) = make_int4(e_[0], (int)(BS[e_[0]] + lp[0]), e_[1], (int)(BS[e_[1]] + lp[1]));
    }
    WG_SYNC();
}

template <bool GATHER> struct GroupOrder {
    const LAS int* TOFF; const LAS int* BOFF; const LAS int* CNTL; const int* LISTS; int NPN, G, c; unsigned bstride;
    __device__ bool next(int i, pg8::Unit& u) const {
        const int L = i * G + c; const int ntile = BOFF[32]; if (L >= ntile * NPN) return false;
        const int Tb = L / NPN; int e = 0;
#pragma unroll
        for (int s = 16; s >= 1; s >>= 1) if (BOFF[e + s] <= Tb) e += s;
        const int jt = Tb - BOFF[e];
        u.pm = TOFF[e] + jt; u.pn = L - Tb * NPN; u.e = e; u.p0 = jt * 256; const int rem = CNTL[e] - u.p0; u.nv = rem < 256 ? rem : 256; u.bo = (unsigned)e * bstride; return true;
    }
    __device__ __forceinline__ unsigned arow(const pg8::Unit& u, int r) const {
        if (GATHER) return (unsigned)LISTS[(size_t)u.e * 16384 + u.p0 + (r < u.nv ? r : 0)];
        return (unsigned)(u.pm * 256 + r);
    }
};
__device__ __forceinline__ void skinny_gu(LAS unsigned char* lds, int e, int p0, int rem, int rg, int cb, int slot0, const bf16* __restrict__ XN2, const bf16* __restrict__ WGU, const int* __restrict__ LISTS, const float* __restrict__ LSC, bf16* __restrict__ HID, int lane, int wid) {
    const int fr = lane & 15, fq = lane >> 4; const int r = 16 * rg + fr; const int tok = LISTS[(size_t)e * 16384 + p0 + (r < rem ? r : 0)];
    const bf16* ap = XN2 + (size_t)tok * 1024 + 128 * wid + 8 * fq; const bf16* wb = WGU + (size_t)e * 512 * 1024 + 128 * wid + 8 * fq;
    LAS f32x4* PART = (LAS f32x4*)lds;
    bf16x8 Af[4];
#pragma unroll
    for (int k = 0; k < 4; ++k) Af[k] = *(const bf16x8*)(ap + 32 * k);
#pragma unroll
    for (int nt = 0; nt < 4; ++nt) { const int j = 64 * cb + 16 * nt + fr; const bf16* bp = wb + (size_t)((j >> 7) * 256 + (j & 127)) * 1024;
        bf16x8 Bg[4], Bu[4];
#pragma unroll
        for (int k = 0; k < 4; ++k) { Bg[k] = *(const bf16x8*)(bp + 32 * k); Bu[k] = *(const bf16x8*)(bp + 128 * 1024 + 32 * k); }
        f32x4 ag = (f32x4){0.f, 0.f, 0.f, 0.f}, au = (f32x4){0.f, 0.f, 0.f, 0.f};
#pragma unroll
        for (int k = 0; k < 4; ++k) { ag = __builtin_amdgcn_mfma_f32_16x16x32_bf16(Af[k], Bg[k], ag, 0, 0, 0); au = __builtin_amdgcn_mfma_f32_16x16x32_bf16(Af[k], Bu[k], au, 0, 0, 0); }
        PART[(wid * 8 + nt) * 64 + lane] = ag; PART[(wid * 8 + 4 + nt) * 64 + lane] = au; }
    WG_SYNC();
    if (wid < 4) { const int nt = wid; f32x4 g = (f32x4){0.f, 0.f, 0.f, 0.f}, u = (f32x4){0.f, 0.f, 0.f, 0.f};
#pragma unroll
        for (int w = 0; w < 8; ++w) { g += PART[(w * 8 + nt) * 64 + lane]; u += PART[(w * 8 + 4 + nt) * 64 + lane]; }
#pragma unroll
        for (int i = 0; i < 4; ++i) { const int rr = 16 * rg + 4 * fq + i; if (rr < rem) { const f32x2 sw = *(const f32x2*)(LSC + ((size_t)e * 16384 + p0 + rr) * 2);
            const float a = g[i] * sw.x, uu = u[i] * sw.x; HID[(size_t)(slot0 + rr) * 256 + 64 * cb + 16 * nt + fr] = (bf16)f2bf(a * __builtin_amdgcn_rcpf(1.f + __expf(-a)) * uu * sw.y); } } }
    WG_SYNC();
}
__device__ __forceinline__ void skinny_down(int e, int rem, int rg, int cq, int slot0, const bf16* __restrict__ HID, const bf16* __restrict__ WD, bf16* __restrict__ Y, int lane, int wid) {
    const int fr = lane & 15, fq = lane >> 4; const int r = 16 * rg + fr; const int col0 = 256 * cq + 32 * wid;
    const bf16* ap = HID + (size_t)(slot0 + (r < rem ? r : 0)) * 256 + 8 * fq; const bf16* wb = WD + (size_t)e * 1024 * 256 + (size_t)(col0 + fr) * 256 + 8 * fq;
    bf16x8 Af[8], B0[8], B1[8];
#pragma unroll
    for (int k = 0; k < 8; ++k) { Af[k] = *(const bf16x8*)(ap + 32 * k); B0[k] = *(const bf16x8*)(wb + 32 * k); B1[k] = *(const bf16x8*)(wb + (size_t)16 * 256 + 32 * k); }
    f32x4 a0 = (f32x4){0.f, 0.f, 0.f, 0.f}, a1 = (f32x4){0.f, 0.f, 0.f, 0.f};
#pragma unroll
    for (int k = 0; k < 8; ++k) { a0 = __builtin_amdgcn_mfma_f32_16x16x32_bf16(Af[k], B0[k], a0, 0, 0, 0); a1 = __builtin_amdgcn_mfma_f32_16x16x32_bf16(Af[k], B1[k], a1, 0, 0, 0); }
#pragma unroll
    for (int i = 0; i < 4; ++i) { const int rr = 16 * rg + 4 * fq + i; if (rr < rem) { bf16* yp = Y + (size_t)(slot0 + rr) * 1024 + col0 + fr; yp[0] = (bf16)f2bf(a0[i]); yp[16] = (bf16)f2bf(a1[i]); } }
}
struct Args { const float* in[18]; float* out; unsigned char* ws; int ph_lo, ph_hi, li, pad; };
__global__ void __launch_bounds__(NWAVES * 64, 2) hymba_fwd(Args args) {
    extern __shared__ __attribute__((aligned(16))) unsigned char lds[];
    LAS unsigned char* const L = (LAS unsigned char*)lds;
    volatile LAS unsigned* const MISCW = (volatile LAS unsigned*)(L + MISC_OFF);
    LAS int* const TOFF = (LAS int*)(L + TOFF_OFF); LAS int* const CNTL = TOFF + 40; LAS int* const BOFF = TOFF + 80; LAS int* const SMALL = TOFF + 120;
    const int tid = threadIdx.x, lane = tid & 63, wave = __builtin_amdgcn_readfirstlane(tid >> 6);
    const int G = gridDim.x; const int bx = blockIdx.x; const int vcu = (G % 8 == 0) ? (bx % 8) * (G / 8) + bx / 8 : bx;
    unsigned char* const ws = args.ws;
    gu32* const ctl = (gu32*)(ws + WS_CTL);
    const float* x = args.in[0]; const float* norm1_g = args.in[1]; const float* w_in = args.in[2]; const float* q_norm_g = args.in[3]; const float* k_norm_g = args.in[4];
    const float* rel_bias = args.in[5]; const float* gate_w2 = args.in[6]; const float* gate_b = args.in[7]; const float* out_norm_g = args.in[8]; const float* w_out = args.in[9];
    const float* norm2_g = args.in[10]; const float* w_rg = args.in[11]; const float* b_rg = args.in[12]; const float* w_re = args.in[13]; const float* b_re = args.in[14];
    const float* w_eg = args.in[15]; const float* w_eu = args.in[16]; const float* w_ed = args.in[17];
    float* out = args.out;
    float* RSTD1 = (float*)(ws + WS_RSTD1); float* ROWSS = (float*)(ws + WS_ROWSS); bf16* WR_T = (bf16*)(ws + WS_WR); float* BLAST = (float*)(ws + WS_BLAST);
    int* TOKINFO = (int*)(ws + WS_TOKINFO); int* LISTS = (int*)(ws + WS_LISTS); float* LSC = (float*)(ws + WS_LSC);
    bf16* WO_T = (bf16*)(ws + WS_WO); bf16* WGU_T = (bf16*)(ws + WS_WGU); bf16* WD_T = (bf16*)(ws + WS_WD); bf16* XB = (bf16*)(ws + WS_XB); bf16* WIN_T = (bf16*)(ws + WS_WIN);
    unsigned* MASK = (unsigned*)(ws + WS_MASK); bf16* SB = (bf16*)(ws + WS_SB); float* EG = (float*)(ws + WS_EG);
    bf16* QN = (bf16*)(ws + WS_QN); bf16* KN = (bf16*)(ws + WS_KN); bf16* VN = (bf16*)(ws + WS_VN); bf16* XN2 = (bf16*)(ws + WS_XN2);
    bf16* IQ = (bf16*)(ws + WS_IQ); bf16* MISC = (bf16*)(ws + WS_MISC); bf16* QB = (bf16*)(ws + WS_QB); bf16* KB = (bf16*)(ws + WS_KB); bf16* VB = (bf16*)(ws + WS_VB); bf16* RG = (bf16*)(ws + WS_RG);
    bf16* MIX = (bf16*)(ws + WS_MIX); float* U = (float*)(ws + WS_MIX); bf16* HID = (bf16*)(ws + WS_HID); bf16* Y = (bf16*)(ws + WS_Y);
    unsigned* CNT = (unsigned*)(ctl + CW_CNT);

    for (int u = tid; u < (LDS_BYTES - LDSCTL_OFF) / 4; u += NWAVES * 64) ((LAS unsigned*)(L + LDSCTL_OFF))[u] = 0u;
    __syncthreads();
    const int bli = (N_LAUNCHES == PER_PHASE) ? 0 : args.li;
    XcdBarrier bar; bar.bar = (unsigned*)(ctl + CW_BAR) + bli * XCD_BAR_WORDS; bar.x = 0; bar.st = nullptr;
    if (N_LAUNCHES != PER_PHASE) bar = xcd_barrier_post((unsigned*)(ctl + CW_BAR) + bli * XCD_BAR_WORDS, MISCW + 8);
#define GRID_BAR(seam) do { if (N_LAUNCHES == PER_PHASE) { if (tid == 0) __hip_atomic_store(ctl + CW_TMO, 0xBADBA0u | (unsigned)(seam), RLX_AGENT); } else { xcd_barrier(bar); } } while (0)
    const int lo = args.ph_lo, hi = args.ph_hi;
#define IN(k) (lo <= (k) && (k) < hi)
#define BOTH(k) (IN(k) && IN((k) + 1))
    const int gw = vcu * NWAVES + wave, NGW = G * NWAVES;

    constexpr int I_G = 16 * 8, I_D = 4 * 32, PER_E = 2 * I_G + I_D, NE1 = 18, NE2 = 25;
#define expert_weights(lo_, hi_, w0_, nw_) do { LAS float* scr_ = (LAS float*)(L + wave * 16384); \
        for (int it_ = (lo_) + (w0_); it_ < (hi_); it_ += (nw_)) { const int e_ = it_ / PER_E; int r_ = it_ - e_ * PER_E; \
            if (r_ < I_G) { p0_transpose_item<2>(w_eg + (size_t)e_ * 1024 * 256, 1024, 256, norm2_g, WGU_T + (size_t)e_ * 512 * 1024, scr_, r_, lane); continue; } r_ -= I_G; \
            if (r_ < I_G) { p0_transpose_item<3>(w_eu + (size_t)e_ * 1024 * 256, 1024, 256, norm2_g, WGU_T + (size_t)e_ * 512 * 1024, scr_, r_, lane); continue; } r_ -= I_G; \
            p0_transpose_item<1>(w_ed + (size_t)e_ * 256 * 1024, 256, 1024, nullptr, WD_T + (size_t)e_ * 1024 * 256, scr_, r_, lane); } } while (0)
    if (IN(0)) {
        LAS float* scr = (LAS float*)(L + wave * 16384);
        constexpr int I_IN = 16 * 106, I_O = 16 * 32;
        constexpr int NITEMS = I_IN + I_O;
        for (int it = gw; it < NITEMS; it += NGW) {
            int r = it;
            if (r < I_IN) { p0_transpose_item<0>(w_in, 1024, 3384, norm1_g, WIN_T, scr, r, lane); continue; } r -= I_IN;
            p0_transpose_item<1>(w_out, 1024, 1024, nullptr, WO_T, scr, r, lane);
        }
        expert_weights(NE2 * PER_E, 32 * PER_E, gw, NGW);
        for (int i = bx * (NWAVES * 64) + tid; i < 48 * 1024; i += G * NWAVES * 64) { const int n = i >> 10, k = i & 1023;
            const float v = (n < 4) ? w_rg[k * 4 + n] : (n < 36) ? w_re[k * 32 + (n - 4)] : 0.f; WR_T[i] = (bf16)f2bf(v * norm2_g[k]); }
        for (int m0 = 2 * gw; m0 < M; m0 += 2 * NGW) {
            f32x4 v[2][4]; float s[2];
#pragma unroll
            for (int r = 0; r < 2; ++r) { const GAS f32x4* xr = (const GAS f32x4*)(x + (size_t)(m0 + r) * 1024) + lane;
#pragma unroll
                for (int j = 0; j < 4; ++j) v[r][j] = xr[64 * j]; }
#pragma unroll
            for (int r = 0; r < 2; ++r) { s[r] = 0.f;
#pragma unroll
                for (int j = 0; j < 4; ++j) s[r] += (v[r][j].x * v[r][j].x + v[r][j].y * v[r][j].y) + (v[r][j].z * v[r][j].z + v[r][j].w * v[r][j].w);
                s[r] = wave_fsum(s[r]); if (lane == 0) RSTD1[m0 + r] = 1.0f / sqrtf(s[r] * (1.0f / 1024.0f) + 1e-6f);
                GAS unsigned long long* o8 = (GAS unsigned long long*)(XB + (size_t)(m0 + r) * 1024) + lane;
#pragma unroll
                for (int j = 0; j < 4; ++j) o8[64 * j] = (unsigned long long)pk2(v[r][j].x, v[r][j].y) | ((unsigned long long)pk2(v[r][j].z, v[r][j].w) << 32); }
        }
        if (BOTH(0)) GRID_BAR(0);
    }
    if (IN(1)) {
        pg8::Gemm g{XB, WIN_T, 1024}; pg8::StaticOrder S; S.init(M, 3584, G, bx);
        pg8::EpiProj E{RSTD1, q_norm_g, k_norm_g, QN, KN, VN, IQ, QB, KB, VB, RG, MISC, 0.125f * 1.4426950408889634f, 1e-6f};
        pg8::gemm_phase<pg8::EpiProj, pg8::StaticOrder, true>(L, g, S, E);
        {
            const int nshort = (896 % G == 0) ? G : G - (896 % G), first = G - nshort;
            if (bx >= first) expert_weights(0, NE1 * PER_E, (bx - first) * NWAVES + wave, nshort * NWAVES); }
        if (BOTH(1)) GRID_BAR(1);
    }
    if (IN(2)) {
        for (int rep = 0; rep < REP_IDX; ++rep)
        for (int it = bx; it < 1024; it += G) { const int b = it & 7, t_ = it >> 3, j_ = t_ >> 5, k0_ = t_ & 31;
            const int p = (j_ == 0) ? k0_ : (j_ == 1) ? 63 - k0_ : (j_ == 2) ? 64 + k0_ : 127 - k0_;
            idx_item(L, b, p, IQ, MISC, MASK, lane, wave); }
        for (int rep = 0; rep < REP_GLAA; ++rep)
        for (int it = bx; it < 1024; it += G) gla_a_item(L, it, KB, VB, MISC, gate_w2, gate_b, U, BLAST, EG, tid, lane, wave);
        if (BOTH(2)) GRID_BAR(2);
    }
    if (IN(3)) {
        for (int it = bx; it < 128; it += G) gla_b_item(it, U, BLAST, SB, tid);
        { const int first = (G > 128) ? 128 : 0, nb = G - first;
          if (bx >= first) expert_weights(NE1 * PER_E, NE2 * PER_E, (bx - first) * NWAVES + wave, nb * NWAVES); }
        if (BOTH(3)) GRID_BAR(3);
    }
    if (IN(4)) {
        const attn_body::AttnTensors AT{(const attn_body::bf16*)QN, (const attn_body::bf16*)KN, (const attn_body::bf16*)VN, (attn_body::bf16*)MIX, MASK, rel_bias};
        for (int rep = 0; rep < REP_ATT; ++rep)
        for (int pr = vcu; pr < 256; pr += G) { const int bh = pr >> 2, s = pr & 3;
            for (int k2 = 0; k2 < 2; ++k2) attn_body::attn_unit<8>(bh >> 3, bh & 7, k2 ? s : 7 - s, AT.Q, AT.K, AT.V, AT.O, AT.MASK, AT.relb, (char*)lds); }
        for (int rep = 0; rep < REP_GLAC; ++rep)
        for (int it = bx; it < 1024; it += G) gla_c_item(L, it, QB, KB, VB, RG, EG, out_norm_g, SB, MIX, tid, lane, wave);
        if (BOTH(4)) GRID_BAR(4);
    }
    if (IN(5)) {
        pg8::Gemm g{MIX, WO_T, 1024}; pg8::StaticOrder S; S.init(M, 1024, G, bx);
        pg8::EpiOut E{x, XN2, ROWSS};
        pg8::gemm_phase<pg8::EpiOut, pg8::StaticOrder, false>(L, g, S, E);
        if (BOTH(5)) GRID_BAR(5);
    }
    if (IN(6)) {
        { LAS bf16* WR = (LAS bf16*)L;
          for (int i = tid; i < 48 * 128; i += NWAVES * 64) { const int n = i >> 7, c8 = i & 127; *(LAS v4u*)(WR + n * WRP + c8 * 8) = *(const v4u*)(WR_T + n * 1024 + c8 * 8); } }
        WG_SYNC();
        for (int tile = bx; tile < 256; tile += G) router_tile(L, tile, XN2, ROWSS, b_rg, b_re, CNT, LISTS, LSC, TOKINFO, tid, lane, wave);
        if (BOTH(6)) GRID_BAR(6);
    }
#define LOAD_TOFF() do { if (tid < 32) CNTL[tid] = (int)__hip_atomic_load(CNT + tid, RLX_AGENT); WG_SYNC(); \
        if (tid == 0) { int acc_ = 0, bacc_ = 0, ns_ = 0; for (int e_ = 0; e_ < 32; ++e_) { const int c_ = CNTL[e_]; TOFF[e_] = acc_; BOFF[e_] = bacc_; \
        const int full_ = c_ >> 8, rem_ = c_ & 255; acc_ += (c_ + 255) >> 8; bacc_ += full_ + (rem_ > 128 ? 1 : 0); if (rem_ > 0 && rem_ <= 128) { SMALL[1 + ns_] = e_; ++ns_; } } TOFF[32] = acc_; BOFF[32] = bacc_; SMALL[0] = ns_; } WG_SYNC(); } while (0)
    if (IN(7)) {
        LOAD_TOFF();
        pg8::Gemm g{XN2, WGU_T, 1024}; GroupOrder<true> S{TOFF, BOFF, CNTL, LISTS, 2, G, vcu, 512u * 1024u * 2u};
        pg8::EpiGU E{LSC, HID};
        pg8::gemm_phase<pg8::EpiGU, GroupOrder<true>, false>(L, g, S, E);
        { const int ns = SMALL[0];
          for (int idx = G - 1 - bx; idx < ns * 32; idx += G) { const int e = SMALL[1 + (idx >> 5)], rg = (idx >> 2) & 7, cb = idx & 3; const int cnt = CNTL[e], full = cnt >> 8, rem = cnt & 255;
              if (16 * rg < rem) skinny_gu(L, e, full * 256, rem, rg, cb, (TOFF[e] + full) * 256, XN2, WGU_T, LISTS, LSC, HID, lane, wave); } }
        if (BOTH(7)) GRID_BAR(7);
    }
    if (IN(8)) {
        LOAD_TOFF();
        pg8::Gemm g{HID, WD_T, 256}; GroupOrder<false> S{TOFF, BOFF, CNTL, LISTS, 4, G, vcu, 1024u * 256u * 2u};
        pg8::EpiDown E{Y};
        pg8::gemm_phase<pg8::EpiDown, GroupOrder<false>, false>(L, g, S, E);
        { const int ns = SMALL[0];
          for (int idx = G - 1 - bx; idx < ns * 32; idx += G) { const int e = SMALL[1 + (idx >> 5)], rg = (idx >> 2) & 7, cq = idx & 3; const int cnt = CNTL[e], full = cnt >> 8, rem = cnt & 255;
              if (16 * rg < rem) skinny_down(e, rem, rg, cq, (TOFF[e] + full) * 256, HID, WD_T, Y, lane, wave); } }
        if (BOTH(8)) GRID_BAR(8);
    }
    if (IN(9)) {
        LOAD_TOFF();
        for (int m0 = 4 * gw; m0 < M; m0 += 4 * NGW) {
            int4 ti[4];
#pragma unroll
            for (int r = 0; r < 4; ++r) ti[r] = *(const int4*)(TOKINFO + (size_t)(m0 + r) * 4);
            v4u av[4][2], b0[4][2], b1[4][2];
#pragma unroll
            for (int r = 0; r < 4; ++r) { const size_t s0 = (size_t)TOFF[ti[r].x] * 256 + ti[r].y, s1 = (size_t)TOFF[ti[r].z] * 256 + ti[r].w;
                const GAS v4u* a = (const GAS v4u*)(XN2 + (size_t)(m0 + r) * 1024) + lane; const GAS v4u* y0 = (const GAS v4u*)(Y + s0 * 1024) + lane; const GAS v4u* y1 = (const GAS v4u*)(Y + s1 * 1024) + lane;
#pragma unroll
                for (int j = 0; j < 2; ++j) { av[r][j] = a[64 * j]; b0[r][j] = y0[64 * j]; b1[r][j] = y1[64 * j]; } }
#pragma unroll
            for (int r = 0; r < 4; ++r) { GAS f32x4* o = (GAS f32x4*)(out + (size_t)(m0 + r) * 1024) + 2 * lane;
#pragma unroll
                for (int j = 0; j < 2; ++j) { const v4u a_ = av[r][j], c0 = b0[r][j], c1 = b1[r][j]; f32x4 r0, r1;
                    r0[0] = bflo(a_.x) + bflo(c0.x) + bflo(c1.x); r0[1] = bfhi(a_.x) + bfhi(c0.x) + bfhi(c1.x); r0[2] = bflo(a_.y) + bflo(c0.y) + bflo(c1.y); r0[3] = bfhi(a_.y) + bfhi(c0.y) + bfhi(c1.y);
                    r1[0] = bflo(a_.z) + bflo(c0.z) + bflo(c1.z); r1[1] = bfhi(a_.z) + bfhi(c0.z) + bfhi(c1.z); r1[2] = bflo(a_.w) + bflo(c0.w) + bflo(c1.w); r1[3] = bfhi(a_.w) + bfhi(c0.w) + bfhi(c1.w);
                    o[128 * j] = r0; o[128 * j + 1] = r1; } }
        }
    }
#undef IN
#undef BOTH
}

extern "C" void kernel_launch(void* const* d_in, const int* in_sizes, int n_in, void* d_out, int out_size, void* d_ws, size_t ws_size, hipStream_t stream) {
    static int grid = 0;
    if (grid == 0) {
        if (n_in != 18 || out_size != M * 1024 || ws_size < WS_END) { fprintf(stderr, "kernel_launch: unexpected problem shape (n_in %d out %d ws %zu)\n", n_in, out_size, ws_size); grid = -1; return; }
        int dev = 0, cus = 0, per_cu = 0;
        if (hipGetDevice(&dev) != hipSuccess || hipDeviceGetAttribute(&cus, hipDeviceAttributeMultiprocessorCount, dev) != hipSuccess) { grid = -1; return; }
        if (hipFuncSetAttribute((const void*)hymba_fwd, hipFuncAttributeMaxDynamicSharedMemorySize, LDS_BYTES) != hipSuccess) { fprintf(stderr, "kernel_launch: hipFuncSetAttribute failed\n"); grid = -1; return; }
        if (hipOccupancyMaxActiveBlocksPerMultiprocessor(&per_cu, (const void*)hymba_fwd, NWAVES * 64, LDS_BYTES) != hipSuccess || per_cu < 1) { fprintf(stderr, "kernel_launch: occupancy query reports %d\n", per_cu); }
        (void)hipGetLastError();
        grid = cus;
    }
    if (grid < 0) return;
    (void)hipMemsetAsync((char*)d_ws + WS_CTL, 0, CTL_ZERO_BYTES, stream);
    Args a{};
    for (int i = 0; i < 18; ++i) a.in[i] = (const float*)d_in[i];
    a.out = (float*)d_out; a.ws = (unsigned char*)d_ws;
#if defined(PROBE_PHASE)
    { const int k = PROBE_PHASE; a.ph_lo = 0; a.ph_hi = k + 1; a.li = 0; hipLaunchKernelGGL(hymba_fwd, dim3(grid), dim3(NWAVES * 64), LDS_BYTES, stream, a);
      for (int r = 1; r < PROBE_REPS; ++r) { a.ph_lo = k; a.ph_hi = k + 1; a.li = 1; hipLaunchKernelGGL(hymba_fwd, dim3(grid), dim3(NWAVES * 64), LDS_BYTES, stream, a); }
      if (k + 1 < PER_PHASE) { a.ph_lo = k + 1; a.ph_hi = PER_PHASE; a.li = 2; hipLaunchKernelGGL(hymba_fwd, dim3(grid), dim3(NWAVES * 64), LDS_BYTES, stream, a); } }
#else
    if (N_LAUNCHES == 1) { a.ph_lo = 0; a.ph_hi = PER_PHASE; a.li = 0; hipLaunchKernelGGL(hymba_fwd, dim3(grid), dim3(NWAVES * 64), LDS_BYTES, stream, a); }
    else for (int li = 0; li < PER_PHASE; ++li) { a.ph_lo = li; a.ph_hi = li + 1; a.li = li; hipLaunchKernelGGL(hymba_fwd, dim3(grid), dim3(NWAVES * 64), LDS_BYTES, stream, a); }
#endif
}
```

```cpp
#include <hip/hip_runtime.h>
#include <hip/hip_bf16.h>
#include <cstdio>
#include <cstdint>
#include <cmath>
namespace pg8 {
#define PG8_LAS __attribute__((address_space(3)))
typedef unsigned short bf16_t;
typedef short bf16x8 __attribute__((ext_vector_type(8)));
typedef float f32x4 __attribute__((ext_vector_type(4)));
typedef float f32x2 __attribute__((ext_vector_type(2)));
typedef unsigned u32x4 __attribute__((ext_vector_type(4)));
constexpr int BM = 256, BK = 64, HALF = 128, HTB = HALF * BK * 2  , STAGE_BYTES = 8 * HTB, NXCD = 8, WGM = 8;

__host__ __device__ __forceinline__ int lds_byte(int r, int c) { const int st = (r >> 4) * 2 + (c >> 5), rr = r & 15, cc = c & 31, ob = rr * 64 + cc * 2; return st * 1024 + (ob ^ (((ob >> 9) & 1) << 5)); }
__host__ __device__ __forceinline__ void stage_rc(int b, int& R, int& C) { const int st = b / 1024, sb = b % 1024, swz = sb ^ (((sb >> 9) & 1) << 5); R = (st >> 1) * 16 + swz / 64; C = (st & 1) * 32 + (swz % 64) / 2; }
__host__ __device__ __forceinline__ int perm32(int rho) { const int n = rho >> 4, i = rho & 15; return 8 * (i >> 2) + 4 * n + (i & 3); }

struct Unit { int pm, pn; unsigned bo; int e, nv, p0; };
struct Gemm { const bf16_t* A; const bf16_t* Bt; int K; };

struct StaticOrder {
    int nM, nN, nwg, G, c;
    __device__ void init(int M, int N, int G_, int c_) { nM = M / BM; nN = N / BM; nwg = nM * nN; G = G_; c = c_; }
    __device__ bool next(int i, Unit& u) const {
        const long L = (long)i * G + c; if (L >= nwg) return false;
        int wgid = (int)L; { const int q = nwg / NXCD, r = nwg % NXCD, xcd = wgid % NXCD, off = wgid / NXCD; wgid = (xcd < r ? xcd * (q + 1) : r * (q + 1) + (xcd - r) * q) + off; }
        const int nig = WGM * nN, gid = wgid / nig, fm = gid * WGM, gsz = (nM - fm) < WGM ? (nM - fm) : WGM;
        u.pm = fm + ((wgid % nig) % gsz); u.pn = (wgid % nig) / gsz; u.bo = 0u; u.e = 0; u.nv = BM; u.p0 = 0; return true;
    }
    __device__ __forceinline__ unsigned arow(const Unit& u, int r) const { return (unsigned)(u.pm * BM + r); }
};

__device__ __forceinline__ unsigned cvt_pk_bf16(float lo, float hi) { unsigned r; asm volatile("v_cvt_pk_bf16_f32 %0, %1, %2" : "=v"(r) : "v"(lo), "v"(hi)); return r; }

template <class Epi, class Sched, bool ALIGN_EPI = false>
__device__ __forceinline__ void gemm_phase(PG8_LAS unsigned char* lds, const Gemm g, const Sched& S, const Epi& E) {
    const int tid = threadIdx.x, wid = __builtin_amdgcn_readfirstlane(tid >> 6), lane = tid & 63, wr = wid >> 2, wc = wid & 3, fr = lane & 15, fq = lane >> 4;
    const int K = g.K, nt = K / BK;
    int RA[2], CA[2]; unsigned voffB[2];
#pragma unroll
    for (int i = 0; i < 2; ++i) { int R, C; stage_rc(tid * 16 + i * 8192, R, C); const int Rb = ((R & ~31) + perm32(R & 31));
        RA[i] = R; CA[i] = C; voffB[i] = (unsigned)(Rb * K + C) * 2u; }
    const size_t kstep = (size_t)(BK * 2);
    const size_t hstep = (size_t)HALF * K * 2;
    const size_t tstep = 2 * hstep;
    const unsigned ldsw = (unsigned)wid * 1024u;
    const int aoff = lds_byte(wr * 64 + fr, fq * 8), boff = lds_byte(wc * 32 + fr, fq * 8);
#define PG8_SA(b, h) (((b) * 2 + (h)) * HTB)
#define PG8_SB(b, h) ((4 + (b) * 2 + (h)) * HTB)
#define PG8_STAGE(bufoff, gbase, voff) do { _Pragma("unroll") for (int _i = 0; _i < 2; ++_i) \
        __builtin_amdgcn_global_load_lds((const unsigned*)((const char*)(gbase) + (voff)[_i]), (PG8_LAS unsigned*)(lds + (bufoff) + ldsw + _i * 8192), 16, 0, 0); } while (0)
#define PG8_LDA(dst, b, h) do { _Pragma("unroll") for (int m = 0; m < 4; ++m) _Pragma("unroll") for (int k = 0; k < 2; ++k) dst[m][k] = *(const PG8_LAS bf16x8*)(lds + PG8_SA(b, h) + aoff + m * 2048 + k * 1024); } while (0)
#define PG8_LDB(dst, b, h) do { _Pragma("unroll") for (int n = 0; n < 2; ++n) _Pragma("unroll") for (int k = 0; k < 2; ++k) dst[n][k] = *(const PG8_LAS bf16x8*)(lds + PG8_SB(b, h) + boff + n * 2048 + k * 1024); } while (0)
#define PG8_MMA(ai, bj, At, Bt) do { __builtin_amdgcn_s_setprio(1); _Pragma("unroll") for (int m = 0; m < 4; ++m) _Pragma("unroll") for (int n = 0; n < 2; ++n) _Pragma("unroll") for (int k = 0; k < 2; ++k) \
        acc[ai][bj][m][n] = __builtin_amdgcn_mfma_f32_16x16x32_bf16(Bt[n][k], At[m][k], acc[ai][bj][m][n], 0, 0, 0); __builtin_amdgcn_s_setprio(0); } while (0)
#define PG8_WAIT_V(n) asm volatile("s_waitcnt vmcnt(" #n ")" ::: "memory")
#define PG8_WAIT_L(n) asm volatile("s_waitcnt lgkmcnt(" #n ")" ::: "memory")
#define PG8_BAR __builtin_amdgcn_s_barrier()
#define PG8_SCHED __builtin_amdgcn_sched_barrier(0)
#define PG8_AOFF(AO, U) do { _Pragma("unroll") for (int _h = 0; _h < 2; ++_h) _Pragma("unroll") for (int _i = 0; _i < 2; ++_i) \
        AO[_h][_i] = (S.arow(U, _h * HALF + RA[_i]) * (unsigned)K + (unsigned)CA[_i]) * 2u; } while (0)
    Unit cur, nxt; int ui = 0;
    if (!S.next(0, cur)) return;
    f32x4 acc[2][2][4][2];
#pragma unroll
    for (int a = 0; a < 2; ++a)
#pragma unroll
        for (int b = 0; b < 2; ++b)
#pragma unroll
            for (int m = 0; m < 4; ++m)
#pragma unroll
                for (int n = 0; n < 2; ++n) acc[a][b][m][n] = (f32x4){0.f, 0.f, 0.f, 0.f};
    bf16x8 At[4][2], B0[2][2], B1[2][2];
    unsigned aoC[2][2], aoN[2][2];
    PG8_AOFF(aoC, cur);
    const char* const gA = (const char*)g.A;
    const char* cB = (const char*)g.Bt + (size_t)cur.bo + (size_t)cur.pn * tstep;
    {
        PG8_STAGE(PG8_SB(0, 0), cB, voffB); PG8_STAGE(PG8_SB(0, 1), cB + hstep, voffB); PG8_STAGE(PG8_SA(0, 0), gA, aoC[0]); PG8_STAGE(PG8_SA(0, 1), gA, aoC[1]);
        if (wr == 1) PG8_BAR;
        PG8_WAIT_V(2); PG8_BAR;
        PG8_STAGE(PG8_SB(1, 0), cB + kstep, voffB); PG8_STAGE(PG8_SA(1, 0), gA + kstep, aoC[0]); PG8_STAGE(PG8_SB(1, 1), cB + hstep + kstep, voffB);
        PG8_WAIT_V(6); PG8_BAR;
    }
    for (;;) {
        const bool has_next = S.next(ui + 1, nxt);
        if (has_next) { PG8_AOFF(aoN, nxt); } else {
#pragma unroll
            for (int _h = 0; _h < 2; ++_h)
#pragma unroll
                for (int _i = 0; _i < 2; ++_i) aoN[_h][_i] = aoC[_h][_i]; }
        const char* nB = has_next ? (const char*)g.Bt + (size_t)nxt.bo + (size_t)nxt.pn * tstep : cB;
        for (int t = 0; t < nt; t += 2) {
            const bool last = (t == nt - 2);
            const char* a1 = gA + (size_t)(t + 1) * kstep;
            const char* a2 = last ? gA : gA + (size_t)(t + 2) * kstep; const char* b2 = last ? nB : cB + (size_t)(t + 2) * kstep;
            const char* a3 = a2 + kstep; const char* b3 = b2 + kstep;
            unsigned ao2[2][2];
#pragma unroll
            for (int _h = 0; _h < 2; ++_h)
#pragma unroll
                for (int _i = 0; _i < 2; ++_i) ao2[_h][_i] = last ? aoN[_h][_i] : aoC[_h][_i];
            PG8_LDB(B0, 0, 0); PG8_LDB(B1, 0, 1); PG8_SCHED; PG8_LDA(At, 0, 0); PG8_STAGE(PG8_SA(1, 1), a1, aoC[1]);
            PG8_WAIT_V(8); PG8_WAIT_L(0); PG8_BAR; PG8_MMA(0, 0, At, B0); PG8_MMA(0, 1, At, B1); PG8_BAR; PG8_SCHED;
            PG8_LDA(At, 0, 1); PG8_STAGE(PG8_SB(0, 0), b2, voffB); PG8_STAGE(PG8_SB(0, 1), b2 + hstep, voffB); PG8_STAGE(PG8_SA(0, 0), a2, ao2[0]);
            PG8_WAIT_V(8); PG8_WAIT_L(0); PG8_BAR; PG8_MMA(1, 0, At, B0); PG8_MMA(1, 1, At, B1); PG8_BAR; PG8_SCHED;
            PG8_LDB(B0, 1, 0); PG8_LDB(B1, 1, 1); PG8_SCHED; PG8_LDA(At, 1, 0); PG8_STAGE(PG8_SA(0, 1), a2, ao2[1]);
            PG8_WAIT_V(8); PG8_WAIT_L(0); PG8_BAR; PG8_MMA(0, 0, At, B0); PG8_MMA(0, 1, At, B1); PG8_BAR; PG8_SCHED;
            PG8_LDA(At, 1, 1); PG8_STAGE(PG8_SB(1, 0), b3, voffB); PG8_STAGE(PG8_SB(1, 1), b3 + hstep, voffB); PG8_STAGE(PG8_SA(1, 0), a3, ao2[0]);
            PG8_WAIT_V(8); PG8_WAIT_L(0); PG8_BAR; PG8_MMA(1, 0, At, B0); PG8_MMA(1, 1, At, B1); PG8_BAR; PG8_SCHED;
        }
        if constexpr (ALIGN_EPI) { if (wr == 0) PG8_BAR; }
        E(acc, cur, wr, wc, fr, fq);
        if (!has_next) break;
#pragma unroll
        for (int a = 0; a < 2; ++a)
#pragma unroll
            for (int b = 0; b < 2; ++b)
#pragma unroll
                for (int m = 0; m < 4; ++m)
#pragma unroll
                    for (int n = 0; n < 2; ++n) acc[a][b][m][n] = (f32x4){0.f, 0.f, 0.f, 0.f};
        cur = nxt; cB = nB; ++ui;
#pragma unroll
        for (int _h = 0; _h < 2; ++_h)
#pragma unroll
            for (int _i = 0; _i < 2; ++_i) aoC[_h][_i] = aoN[_h][_i];
        if constexpr (ALIGN_EPI) { if (wr == 1) PG8_BAR; }
    }
    PG8_WAIT_V(0);
    if constexpr (!ALIGN_EPI) { if (wr == 0) PG8_BAR; }
    PG8_BAR;
#undef PG8_SA
#undef PG8_SB
#undef PG8_STAGE
#undef PG8_LDA
#undef PG8_LDB
#undef PG8_MMA
#undef PG8_WAIT_V
#undef PG8_WAIT_L
#undef PG8_BAR
#undef PG8_SCHED
#undef PG8_AOFF
}
}
namespace pg8 {
__device__ __forceinline__ float row4_sum(float v) {
    { auto r = __builtin_amdgcn_permlane16_swap(__float_as_uint(v), __float_as_uint(v), false, false); v = __uint_as_float(r[0]) + __uint_as_float(r[1]); }
    { auto r = __builtin_amdgcn_permlane32_swap(__float_as_uint(v), __float_as_uint(v), false, false); v = __uint_as_float(r[0]) + __uint_as_float(r[1]); }
    return v;
}
__device__ __forceinline__ u32x4 pack8(const f32x4 v0, const f32x4 v1) { u32x4 w; w.x = cvt_pk_bf16(v0[0], v0[1]); w.y = cvt_pk_bf16(v0[2], v0[3]); w.z = cvt_pk_bf16(v1[0], v1[1]); w.w = cvt_pk_bf16(v1[2], v1[3]); return w; }

struct EpiProj {
    const float* rstd1; const float* qg; const float* kg;
    bf16_t *QN, *KN, *VN, *IQ, *QB, *KB, *VB, *RG, *MISC;
    float qscale, eps;
    __device__ __forceinline__ void operator()(const f32x4 (&acc)[2][2][4][2], const Unit& u, int wr, int wc, int fr, int fq) const {
        const int row0 = u.pm * BM + wr * 64 + fr; const int pn = u.pn;
        float rs1[2][4];
#pragma unroll
        for (int ai = 0; ai < 2; ++ai)
#pragma unroll
            for (int m = 0; m < 4; ++m) rs1[ai][m] = rstd1[row0 + ai * HALF + m * 16];
        if (pn < 4) {
            const bool isq = pn < 2; const float* gp = isq ? qg : kg; bf16_t* O = isq ? QN : KN; const float os = isq ? qscale : 1.f;
            f32x4 gv[2][2];
#pragma unroll
            for (int bj = 0; bj < 2; ++bj)
#pragma unroll
                for (int n = 0; n < 2; ++n) gv[bj][n] = *(const f32x4*)(gp + 32 * bj + 8 * fq + 4 * n) * os;
            const int hcol = (4 * (pn & 1) + wc) * 64 + 8 * fq;
#pragma unroll
            for (int ai = 0; ai < 2; ++ai)
#pragma unroll
                for (int m = 0; m < 4; ++m) { const int row = row0 + ai * HALF + m * 16; const float s = rs1[ai][m];
                    float ss = 0.f;
#pragma unroll
                    for (int bj = 0; bj < 2; ++bj)
#pragma unroll
                        for (int n = 0; n < 2; ++n) { const f32x4 x = acc[ai][bj][m][n]; ss += (x[0] * x[0] + x[1] * x[1]) + (x[2] * x[2] + x[3] * x[3]); }
                    ss = row4_sum(ss);
                    const float r = s * __builtin_amdgcn_rsqf(s * s * ss * (1.f / 64.f) + eps);
                    bf16_t* rowp = O + (size_t)row * 512 + hcol;
#pragma unroll
                    for (int bj = 0; bj < 2; ++bj) *(u32x4*)(rowp + 32 * bj) = pack8(acc[ai][bj][m][0] * r * gv[bj][0], acc[ai][bj][m][1] * r * gv[bj][1]); }
            return;
        }
        bf16_t* O; int pitch, coff, lim = 256;
        if (pn < 6) { O = VN; pitch = 512; coff = (pn - 4) * 256; }
        else if (pn == 6) { O = IQ; pitch = 256; coff = 0; }
        else if (pn == 7) { O = QB; pitch = 256; coff = 0; }
        else if (pn == 8) { O = KB; pitch = 256; coff = 0; }
        else if (pn < 11) { O = VB; pitch = 512; coff = (pn - 9) * 256; }
        else if (pn < 13) { O = RG; pitch = 512; coff = (pn - 11) * 256; }
        else { O = MISC; pitch = 64; coff = 0; lim = 56; }
        const int c0 = wc * 32 + 8 * fq;
#pragma unroll
        for (int ai = 0; ai < 2; ++ai)
#pragma unroll
            for (int m = 0; m < 4; ++m) { const int row = row0 + ai * HALF + m * 16; const float s = rs1[ai][m];
                bf16_t* rowp = O + (size_t)row * pitch + coff + c0;
#pragma unroll
                for (int bj = 0; bj < 2; ++bj) if (c0 + bj * HALF < lim) *(u32x4*)(rowp + bj * HALF) = pack8(acc[ai][bj][m][0] * s, acc[ai][bj][m][1] * s); }
    }
};

struct EpiOut {
    const float* x; bf16_t* XN2; float* ROWSS;
    __device__ __forceinline__ void operator()(const f32x4 (&acc)[2][2][4][2], const Unit& u, int wr, int wc, int fr, int fq) const {
        const int row0 = u.pm * BM + wr * 64 + fr; const int col0 = u.pn * BM + wc * 32 + 8 * fq;
        f32x4 xv[2][4];
#define EPO_LOAD(buf, g) do { const size_t off_ = (size_t)(row0 + ((g) >> 2) * HALF + ((g) & 3) * 16) * 1024 + col0; \
            xv[buf][0] = *(const f32x4*)(x + off_); xv[buf][1] = *(const f32x4*)(x + off_ + 4); xv[buf][2] = *(const f32x4*)(x + off_ + HALF); xv[buf][3] = *(const f32x4*)(x + off_ + HALF + 4); } while (0)
        EPO_LOAD(0, 0);
#pragma unroll
        for (int g = 0; g < 8; ++g) { const int ai = g >> 2, m = g & 3, cur = g & 1;
            if (g + 1 < 8) EPO_LOAD(cur ^ 1, g + 1);
            const int row = row0 + ai * HALF + m * 16; const size_t off = (size_t)row * 1024 + col0; float ss = 0.f;
#pragma unroll
            for (int bj = 0; bj < 2; ++bj) { const f32x4 a = xv[cur][2 * bj] + acc[ai][bj][m][0], b = xv[cur][2 * bj + 1] + acc[ai][bj][m][1];
                ss += (a[0] * a[0] + a[1] * a[1]) + (a[2] * a[2] + a[3] * a[3]) + (b[0] * b[0] + b[1] * b[1]) + (b[2] * b[2] + b[3] * b[3]);
                *(u32x4*)(XN2 + off + bj * HALF) = pack8(a, b); }
            ss = row4_sum(ss);
            if (fq == 0) ROWSS[(size_t)row * 16 + u.pn * 4 + wc] = ss; }
#undef EPO_LOAD
    }
};

struct EpiGU {
    const float* LSC; bf16_t* HID;
    __device__ __forceinline__ void operator()(const f32x4 (&acc)[2][2][4][2], const Unit& u, int wr, int wc, int fr, int fq) const {
        const int r0 = wr * 64 + fr; const int c0 = u.pn * HALF + wc * 32 + 8 * fq;
#pragma unroll
        for (int ai = 0; ai < 2; ++ai)
#pragma unroll
            for (int m = 0; m < 4; ++m) { const int r = r0 + ai * HALF + m * 16;
                f32x2 sw = (f32x2){0.f, 0.f};
                if (r < u.nv) sw = *(const f32x2*)(LSC + ((size_t)u.e * 16384 + (size_t)(u.p0 + r)) * 2);
                f32x4 h0, h1;
#pragma unroll
                for (int j = 0; j < 4; ++j) { const float a = acc[ai][0][m][0][j] * sw.x, uu = acc[ai][1][m][0][j] * sw.x; h0[j] = a * __builtin_amdgcn_rcpf(1.f + __expf(-a)) * uu * sw.y;
                                              const float a2 = acc[ai][0][m][1][j] * sw.x, u2 = acc[ai][1][m][1][j] * sw.x; h1[j] = a2 * __builtin_amdgcn_rcpf(1.f + __expf(-a2)) * u2 * sw.y; }
                *(u32x4*)(HID + (size_t)(u.pm * BM + r) * 256 + c0) = pack8(h0, h1); }
    }
};
struct EpiDown {
    bf16_t* Y;
    __device__ __forceinline__ void operator()(const f32x4 (&acc)[2][2][4][2], const Unit& u, int wr, int wc, int fr, int fq) const {
        const int r0 = u.pm * BM + wr * 64 + fr; const int c0 = u.pn * BM + wc * 32 + 8 * fq;
#pragma unroll
        for (int ai = 0; ai < 2; ++ai)
#pragma unroll
            for (int m = 0; m < 4; ++m) { bf16_t* rowp = Y + (size_t)(r0 + ai * HALF + m * 16) * 1024 + c0;
#pragma unroll
                for (int bj = 0; bj < 2; ++bj) *(u32x4*)(rowp + bj * HALF) = pack8(acc[ai][bj][m][0], acc[ai][bj][m][1]); }
    }
};
}
namespace attn_body {
using bf16=__hip_bfloat16;
using bf16x8=__attribute__((ext_vector_type(8)))short;
using s16x4=__attribute__((ext_vector_type(4)))short;
using f32x16=__attribute__((ext_vector_type(16)))float;
using u32x4=__attribute__((ext_vector_type(4)))unsigned;
constexpr int BATCH=8,NHEAD=8,SEQ=2048,D=64,DM=NHEAD*D,PO=1024;
constexpr int NW=8,QBLK=32,QB=QBLK*NW,KVBLK=64,NQB=SEQ/QB;
constexpr int ATTN_UNIT_ROWS=QB;
__device__ __forceinline__ int crow(int r,int hi){return (r&3)+8*(r>>2)+4*hi;}
#define SBAR() __builtin_amdgcn_sched_barrier(0)
typedef float f32x4a __attribute__((ext_vector_type(4)));
__device__ __forceinline__ void tbias(f32x16&p0,f32x16&p1,int t,int qpos,int hi,__attribute__((address_space(3))) const char* tabr){
  int base=qpos-64*t-4*hi; base=base<-4?-4:(base>200?200:base); const int a=200-base, s=a&3;
  const __attribute__((address_space(3))) f32x4a* tp=(const __attribute__((address_space(3))) f32x4a*)(tabr+s*1088+(a-s)*4);
  #pragma unroll
  for(int g=0;g<4;++g){ const f32x4a v0=tp[2*g], v1=tp[2*g+8];
    p0[4*g]+=v0[0];p0[4*g+1]+=v0[1];p0[4*g+2]+=v0[2];p0[4*g+3]+=v0[3]; p1[4*g]+=v1[0];p1[4*g+1]+=v1[1];p1[4*g+2]+=v1[2];p1[4*g+3]+=v1[3];
    asm volatile("":"+v"(p0),"+v"(p1)); }
}
__device__ __forceinline__ float mkeep(float v,unsigned mw,int bit){ const unsigned t=(unsigned)(((int)(mw<<(31-bit)))>>31); return __uint_as_float(__float_as_uint(v)&t); }
constexpr int NSLOT=3, SLOTB=8192;
constexpr int LDS_K=0, LDS_V=NSLOT*SLOTB, LDS_WS=2*NSLOT*SLOTB, LDS_OST=LDS_WS+NW*64*4, LDS_BYTES=LDS_OST+NW*4096, LDS_MSK=LDS_BYTES, LDS_TAB=LDS_MSK+65536, LDS_TOTAL=LDS_TAB+4352;
constexpr float C2=0.125f*1.4426950408889634f;
__device__ __forceinline__ void glds16(const void*gsrc,unsigned lds_dst){unsigned keep;
  asm volatile("s_mov_b32 %0, m0\n\ts_mov_b32 m0, %2\n\ts_nop 0\n\tglobal_load_lds_dwordx4 %1, off\n\ts_mov_b32 m0, %0":"=&s"(keep):"v"(gsrc),"s"(lds_dst):"memory");}
__device__ __forceinline__ float max3f(float a,float b,float c){float r;asm("v_max3_f32 %0, %1, %2, %3":"=v"(r):"v"(a),"v"(b),"v"(c));return r;}
__device__ __forceinline__ float max2f(float a,float b){float r;asm("v_max_f32_e32 %0, %1, %2":"=v"(r):"v"(a),"v"(b));return r;}
__device__ __forceinline__ float fadd_s(float a,float b){float r;asm("v_add_f32_e32 %0, %1, %2":"=v"(r):"v"(a),"v"(b));return r;}
__device__ __forceinline__ float fsub_s(float a,float b){float r;asm("v_sub_f32_e32 %0, %1, %2":"=v"(r):"v"(a),"v"(b));return r;}
typedef float f32x2_t __attribute__((ext_vector_type(2))); typedef __bf16 bf16x2_t __attribute__((ext_vector_type(2)));
__device__ __forceinline__ unsigned cvtpk_s(float lo,float hi){f32x2_t v={lo,hi};bf16x2_t b=__builtin_convertvector(v,bf16x2_t);return __builtin_bit_cast(unsigned,b);}
#define WAIT_BAR(N) asm volatile("s_waitcnt vmcnt(" #N ") lgkmcnt(0)\n\ts_barrier":::"memory")

__device__ __forceinline__ void qkt(f32x16&p0,f32x16&p1,const char*Kslot,const bf16x8*qr,const f32x16&negm,int r32,int hi){
  const char*kb=Kslot+hi*1024+r32*16;
  #pragma unroll
  for(int d0=0;d0<4;++d0){
    const bf16x8 b0=*reinterpret_cast<const bf16x8*>(kb+d0*2048);
    const bf16x8 b1=*reinterpret_cast<const bf16x8*>(kb+d0*2048+512);
    if(d0==0){p0=__builtin_amdgcn_mfma_f32_32x32x16_bf16(b0,qr[0],negm,0,0,0);p1=__builtin_amdgcn_mfma_f32_32x32x16_bf16(b1,qr[0],negm,0,0,0);}
    else{p0=__builtin_amdgcn_mfma_f32_32x32x16_bf16(b0,qr[d0],p0,0,0,0);p1=__builtin_amdgcn_mfma_f32_32x32x16_bf16(b1,qr[d0],p1,0,0,0);}}
}
typedef __attribute__((address_space(3))) const char* lds_cptr;
typedef short v4i16_t __attribute__((ext_vector_type(4)));
__device__ __forceinline__ void kload8(bf16x8*kf,lds_cptr kp){
  kf[0]=*(const __attribute__((address_space(3))) bf16x8*)(kp);      kf[1]=*(const __attribute__((address_space(3))) bf16x8*)(kp+512);
  kf[2]=*(const __attribute__((address_space(3))) bf16x8*)(kp+2048); kf[3]=*(const __attribute__((address_space(3))) bf16x8*)(kp+2560);
  kf[4]=*(const __attribute__((address_space(3))) bf16x8*)(kp+4096); kf[5]=*(const __attribute__((address_space(3))) bf16x8*)(kp+4608);
  kf[6]=*(const __attribute__((address_space(3))) bf16x8*)(kp+6144); kf[7]=*(const __attribute__((address_space(3))) bf16x8*)(kp+6656);
}
__device__ __forceinline__ void kload2(bf16x8*kf,lds_cptr kp,int j){ kf[2*j]=*(const __attribute__((address_space(3))) bf16x8*)(kp+j*2048); kf[2*j+1]=*(const __attribute__((address_space(3))) bf16x8*)(kp+j*2048+512); }
__device__ __forceinline__ s16x4 vtr(lds_cptr p){ return __builtin_bit_cast(s16x4,__builtin_amdgcn_ds_read_tr16_b64_v4i16((__attribute__((address_space(3))) v4i16_t*)p)); }
__device__ __forceinline__ float rowmax(const f32x16&p0,const f32x16&p1){
  float a=max3f(p0[0],p0[1],p1[0]),b=max3f(p0[2],p0[3],p1[1]);a=max3f(a,p1[2],p1[3]);
  #pragma unroll
  for(int r=4;r<16;r+=4){a=max3f(a,p0[r],p0[r+1]);b=max3f(b,p0[r+2],p0[r+3]);a=max3f(a,p1[r],p1[r+1]);b=max3f(b,p1[r+2],p1[r+3]);}
  const float m=max2f(a,b);
  auto rr=__builtin_amdgcn_permlane32_swap(__float_as_uint(m),__float_as_uint(m),false,false);
  return max2f(__uint_as_float(rr[0]),__uint_as_float(rr[1]));
}
__device__ __forceinline__ void pv(f32x16*o,int vb,bf16x8 pa0,bf16x8 pa1,bf16x8 pa2,bf16x8 pa3){
  #pragma unroll
  for(int d0=0;d0<2;++d0){s16x4 lo[4],hi[4];
    #pragma unroll
    for(int ks=0;ks<4;++ks){
      asm volatile("ds_read_b64_tr_b16 %0,%1 offset:%c2":"=&v"(lo[ks]):"v"(vb),"i"(d0*4096+ks*1024):"memory");
      asm volatile("ds_read_b64_tr_b16 %0,%1 offset:%c2":"=&v"(hi[ks]):"v"(vb),"i"(d0*4096+ks*1024+512):"memory");}
    asm volatile("s_waitcnt lgkmcnt(0)":::"memory");SBAR();
    #define PK(k) (bf16x8){lo[k][0],lo[k][1],lo[k][2],lo[k][3],hi[k][0],hi[k][1],hi[k][2],hi[k][3]}
    o[d0]=__builtin_amdgcn_mfma_f32_32x32x16_bf16(pa0,PK(0),o[d0],0,0,0);
    o[d0]=__builtin_amdgcn_mfma_f32_32x32x16_bf16(pa1,PK(1),o[d0],0,0,0);
    o[d0]=__builtin_amdgcn_mfma_f32_32x32x16_bf16(pa2,PK(2),o[d0],0,0,0);
    o[d0]=__builtin_amdgcn_mfma_f32_32x32x16_bf16(pa3,PK(3),o[d0],0,0,0);
    #undef PK
  }
}

#ifndef ATTN_STORE16
#define ATTN_STORE16(p,v) (*(u32x4*)(p)=(v))
#endif
template<int THRL> __device__ __forceinline__ void attn_unit(int b,int h,int qb,const bf16*Q,const bf16*__restrict__ K,const bf16*__restrict__ V,bf16*O,const unsigned*__restrict__ MASK,const float*__restrict__ relb,char*shm){
  int tid0_=threadIdx.x; asm volatile("":"+v"(tid0_));
  const int tid=tid0_,lane=tid&63,r32=lane&31,hi=lane>>5; const int wid=__builtin_amdgcn_readfirstlane(tid>>6);
  const long rowbase=(long)b*SEQ; const int q0=qb*QB;
  const bf16*Qw=Q+(rowbase+q0+wid*QBLK)*DM+h*D;
  const bf16*Kh=K+rowbase*DM+h*D,*Vh=V+rowbase*DM+h*D;
  const unsigned lds0=(unsigned)(uintptr_t)shm;
  float*wsf=(float*)(shm+LDS_WS)+wid*64;
  const bf16*ksrc=Kh+(long)lane*DM+wid*8;
  const bf16*vsrc=Vh+(long)(16*(wid&3)+(lane>>2))*DM+(wid>>2)*32+(lane&3)*8;
  const unsigned kdst=lds0+LDS_K+wid*1024, vdst=lds0+LDS_V+wid*1024;
  #define DMA_K(t,slot) glds16(ksrc+(long)(t)*KVBLK*DM,(unsigned)__builtin_amdgcn_readfirstlane(kdst+(slot)))
  #define DMA_V(t,slot) glds16(vsrc+(long)(t)*KVBLK*DM,(unsigned)__builtin_amdgcn_readfirstlane(vdst+(slot)))
  const int vb0=(int)(lds0+LDS_V)+((lane>>4)&1)*32+(lane&3)*8+(4*hi+((lane&15)>>2))*64;
  const char*Kbase=shm+LDS_K; bf16x8 kf[8];
  const lds_cptr shm3=(lds_cptr)shm; const lds_cptr kp0=shm3+LDS_K+hi*1024+r32*16; const lds_cptr vp0=shm3+LDS_V+((lane>>4)&1)*32+(lane&3)*8+(4*hi+((lane&15)>>2))*64;
  const int NT=(q0+QB)/KVBLK;
  { int tid_=tid; asm volatile("":"+v"(tid_));
    const u32x4*msrc=(const u32x4*)(MASK+((size_t)(b*32)*SEQ+q0)*2); u32x4*mdst=(u32x4*)(shm+LDS_MSK);
    u32x4 mv[8]; const int nit=NT>>2;
    _Pragma("unroll") for(int k=0;k<8;++k){ const int i=tid_+k*(NW*64); if(k<nit) mv[k]=msrc[(size_t)(i>>7)*(SEQ*2/4)+(i&127)]; }
    _Pragma("unroll") for(int k=0;k<8;++k){ const int i=tid_+k*(NW*64); if(k<nit) mdst[i]=mv[k]; }
    for(int i=tid_;i<4*272;i+=NW*64){ const int sft=i/272, k=i-sft*272, d=200-(k+sft); float v=0.f;
      if(d>=0&&d<=112){ int bk; if(d<16)bk=d; else { bk=16+(int)(logf((float)d*(1.0f/16.0f))/2.0794415416798357f*16.0f); bk=bk>31?31:bk; } v=(relb[bk*NHEAD+h]-relb[31*NHEAD+h])*1.4426950408889634f; }
      ((float*)(shm+LDS_TAB))[i]=v; } }
  const unsigned*mskw=(const unsigned*)(shm+LDS_MSK)+(wid*QBLK+r32)*2+hi;
  const int qpos=q0+wid*QBLK+r32;
  DMA_K(0,0);DMA_V(0,0);DMA_K(1,SLOTB);
  bf16x8 qr[4];
  #pragma unroll
  for(int d0=0;d0<4;++d0)qr[d0]=*reinterpret_cast<const bf16x8*>(&Qw[(long)r32*DM+d0*16+hi*8]);
  float mhat=0.f,l_reg=0.f;f32x16 o[2];o[0]=f32x16{};o[1]=f32x16{};f32x16 negm=f32x16{};asm volatile("":"+v"(negm));
  #define CMASK(P0,P1,t) do{ if((t)>=NT-7 && 64*(t)+63+127>=q0+wid*QBLK) tbias(P0,P1,(t),qpos,hi,shm3+LDS_TAB); }while(0)
  bool resc=false;
  #define START(P0,P1) do{ const float rm=rowmax(P0,P1); resc=false; \
    { const float dl=rm; mhat=fadd_s(mhat,dl); \
      _Pragma("unroll") for(int r=0;r<16;++r){P0[r]=fsub_s(P0[r],dl);P1[r]=fsub_s(P1[r],dl);} \
      _Pragma("unroll") for(int r=0;r<16;++r)negm[r]=-mhat; asm volatile("":"+v"(negm)); } \
    _Pragma("unroll") for(int r=0;r<16;++r)P0[r]=__builtin_amdgcn_exp2f(P0[r]); }while(0)
  #define RESC() do{ if(resc){ asm volatile("s_waitcnt lgkmcnt(0)":::"memory"); \
      _Pragma("unroll") for(int d_=0;d_<2;++d_) _Pragma("unroll") for(int r=0;r<16;++r)o[d_][r]*=wsf[crow(r,hi)]; } }while(0)
  f32x16 pA0,pA1,pB0,pB1;
  int sl_prev=0,sl_cur=0,sl_next=SLOTB;
  #define ROT() do{sl_prev=sl_cur;sl_cur=sl_next;sl_next=(sl_next==(NSLOT-1)*SLOTB)?0:sl_next+SLOTB;}while(0)
  DMA_K(2,2*SLOTB);
  WAIT_BAR(3);
  qkt(pA0,pA1,Kbase,qr,negm,r32,hi);asm volatile("s_nop 15\n\ts_nop 7":"+v"(pA0),"+v"(pA1));CMASK(pA0,pA1,0);
  START(pA0,pA1);
  _Pragma("unroll") for(int r=0;r<16;++r)pA1[r]=__builtin_amdgcn_exp2f(pA1[r]);
  { const unsigned mw0=mskw[0]; _Pragma("unroll") for(int r=0;r<16;++r){pA0[r]=mkeep(pA0[r],mw0,r);pA1[r]=mkeep(pA1[r],mw0,16+r);} }
  WAIT_BAR(0);
  DMA_K(3,0);DMA_V(1,SLOTB);
  ROT();
  kload8(kf,kp0+sl_cur);
  WAIT_BAR(2);
  s16x4 vlo[8],vhi[8]; u32x4 pw0,pw1,pw2,pw3;
  #define PKW(P,B) cvtpk_s(P[B],P[B+1])
  #define PAF(k) __builtin_bit_cast(bf16x8,pw##k)
  #define VFR(i) (bf16x8){vlo[i][0],vlo[i][1],vlo[i][2],vlo[i][3],vhi[i][0],vhi[i][1],vhi[i][2],vhi[i][3]}
  #define PIN(x) asm volatile("":"+v"(x))
  #define MX3(a,b,c) __builtin_fmaxf(__builtin_fmaxf((a),(b)),(c))
  #define GAPA(MF,A0,A1,A2,A3,W0,W1,PW) do{ MF; sacc+=A0; sacc+=A1; sacc+=A2; sacc+=A3; PIN(sacc); W0; W1; PIN(PW); SBAR(); }while(0)
  #define EX(v) __builtin_amdgcn_exp2f(v)
  #define GAPB(MF,X,B,MB) do{ MF; X[B]=mkeep(EX(X[B]),mw_,MB+B); X[B+1]=mkeep(EX(X[B+1]),mw_,MB+B+1); X[B+2]=mkeep(EX(X[B+2]),mw_,MB+B+2); X[B+3]=mkeep(EX(X[B+3]),mw_,MB+B+3); PIN(X); SBAR(); }while(0)
  #define VRD(i) do{ vlo[i]=vtr(vp_+(((i)>>2)*4096+((i)&3)*1024)); vhi[i]=vtr(vp_+(((i)>>2)*4096+((i)&3)*1024+512)); }while(0)
  #define KRD(G,j) do{ if(G){ kload2(kf,kp0+sl_next,j); SBAR(); } }while(0)
  #define STEP(C0,C1,P0,P1,t,GK,GV,GL) do{ SBAR(); \
    const lds_cptr vp_=vp0+sl_prev; const unsigned mw_=mskw[(t)*512]; \
    VRD(0); SBAR(); float sacc=(P0[0]+P0[1]); \
    GAPA(C0=__builtin_amdgcn_mfma_f32_32x32x16_bf16(kf[0],qr[0],negm,0,0,0), P0[2],P0[3],P0[4],P0[5],     pw0[0]=PKW(P0,0), pw0[1]=PKW(P0,2), pw0); \
    VRD(4); SBAR(); GAPA(C1=__builtin_amdgcn_mfma_f32_32x32x16_bf16(kf[1],qr[0],negm,0,0,0), P0[6],P0[7],P0[8],P0[9],     pw0[2]=PKW(P0,4), pw0[3]=PKW(P0,6), pw0); \
    VRD(1); SBAR(); GAPA(C0=__builtin_amdgcn_mfma_f32_32x32x16_bf16(kf[2],qr[1],C0,0,0,0),   P0[10],P0[11],P0[12],P0[13], pw1[0]=PKW(P0,8), pw1[1]=PKW(P0,10), pw1); \
    VRD(5); SBAR(); GAPA(C1=__builtin_amdgcn_mfma_f32_32x32x16_bf16(kf[3],qr[1],C1,0,0,0),   P0[14],P0[15],P1[0],P1[1],   pw1[2]=PKW(P0,12),pw1[3]=PKW(P0,14), pw1); \
    VRD(2); SBAR(); GAPA(C0=__builtin_amdgcn_mfma_f32_32x32x16_bf16(kf[4],qr[2],C0,0,0,0),   P1[2],P1[3],P1[4],P1[5],     pw2[0]=PKW(P1,0), pw2[1]=PKW(P1,2), pw2); \
    VRD(6); SBAR(); GAPA(C1=__builtin_amdgcn_mfma_f32_32x32x16_bf16(kf[5],qr[2],C1,0,0,0),   P1[6],P1[7],P1[8],P1[9],     pw2[2]=PKW(P1,4), pw2[3]=PKW(P1,6), pw2); \
    VRD(3); SBAR(); GAPA(C0=__builtin_amdgcn_mfma_f32_32x32x16_bf16(kf[6],qr[3],C0,0,0,0),   P1[10],P1[11],P1[12],P1[13], pw3[0]=PKW(P1,8), pw3[1]=PKW(P1,10), pw3); \
    VRD(7); SBAR(); GAPA(C1=__builtin_amdgcn_mfma_f32_32x32x16_bf16(kf[7],qr[3],C1,0,0,0),   P1[14],P1[15],0.f,0.f,       pw3[2]=PKW(P1,12),pw3[3]=PKW(P1,14), pw3); \
    l_reg+=sacc; \
    if(GK){DMA_K((t)+3,sl_cur);} if(GV){DMA_V((t)+1,sl_next);} \
    CMASK(C0,C1,t); \
    { float a=MX3(C0[0],C0[1],C1[0]),b=MX3(C0[2],C0[3],C1[1]); a=MX3(a,C1[2],C1[3]); \
      _Pragma("unroll") for(int r=4;r<16;r+=4){a=MX3(a,C0[r],C0[r+1]);b=MX3(b,C0[r+2],C0[r+3]);a=MX3(a,C1[r],C1[r+1]);b=MX3(b,C1[r+2],C1[r+3]);} \
      float rm=__builtin_fmaxf(a,b); { auto rr=__builtin_amdgcn_permlane32_swap(__float_as_uint(rm),__float_as_uint(rm),false,false); rm=__builtin_fmaxf(__uint_as_float(rr[0]),__uint_as_float(rr[1])); } \
      resc=false; \
      if(__builtin_expect(__any(rm>(float)THRL),0)){ const float dl=__builtin_fmaxf(rm,0.f); mhat+=dl; \
        _Pragma("unroll") for(int r=0;r<16;++r){C0[r]-=dl;C1[r]-=dl;} \
        _Pragma("unroll") for(int r=0;r<16;++r)negm[r]=-mhat; asm volatile("":"+v"(negm)); \
        const float f=__builtin_amdgcn_exp2f(-dl); l_reg*=f; if(hi==0)wsf[r32]=f; resc=true; } } \
    SBAR(); \
    GAPB(o[0]=__builtin_amdgcn_mfma_f32_32x32x16_bf16(PAF(0),VFR(0),o[0],0,0,0), C0,0,0); \
    GAPB(o[1]=__builtin_amdgcn_mfma_f32_32x32x16_bf16(PAF(0),VFR(4),o[1],0,0,0), C0,4,0); \
    KRD(GL,0); GAPB(o[0]=__builtin_amdgcn_mfma_f32_32x32x16_bf16(PAF(1),VFR(1),o[0],0,0,0), C0,8,0); \
    KRD(GL,1); GAPB(o[1]=__builtin_amdgcn_mfma_f32_32x32x16_bf16(PAF(1),VFR(5),o[1],0,0,0), C0,12,0); \
    KRD(GL,2); GAPB(o[0]=__builtin_amdgcn_mfma_f32_32x32x16_bf16(PAF(2),VFR(2),o[0],0,0,0), C1,0,16); \
    KRD(GL,3); GAPB(o[1]=__builtin_amdgcn_mfma_f32_32x32x16_bf16(PAF(2),VFR(6),o[1],0,0,0), C1,4,16); \
    GAPB(o[0]=__builtin_amdgcn_mfma_f32_32x32x16_bf16(PAF(3),VFR(3),o[0],0,0,0), C1,8,16); \
    GAPB(o[1]=__builtin_amdgcn_mfma_f32_32x32x16_bf16(PAF(3),VFR(7),o[1],0,0,0), C1,12,16); \
    }while(0)
  int t=1;
  #undef CMASK
  #define CMASK(P0,P1,t) do{}while(0)
  for(;t+7<NT;t+=2){
    STEP(pB0,pB1,pA0,pA1,t,true,true,true);     WAIT_BAR(2); RESC(); ROT();
    STEP(pA0,pA1,pB0,pB1,t+1,true,true,true);   WAIT_BAR(2); RESC(); ROT();
  }
  #undef CMASK
  #define CMASK(P0,P1,t) do{ if(64*(t)+63+127>=q0+wid*QBLK) tbias(P0,P1,(t),qpos,hi,shm3+LDS_TAB); }while(0)
  #define ENDW(tt) do{ if((tt)+3<NT){WAIT_BAR(2);} else if((tt)+2<NT){WAIT_BAR(1);} else {WAIT_BAR(0);} }while(0)
  for(;t+1<NT;t+=2){
    STEP(pB0,pB1,pA0,pA1,t,(t+3<NT),(t+1<NT),(t+1<NT));       ENDW(t);   RESC(); ROT();
    STEP(pA0,pA1,pB0,pB1,t+1,(t+4<NT),(t+2<NT),(t+2<NT));     ENDW(t+1); RESC(); ROT();
  }
  STEP(pB0,pB1,pA0,pA1,NT-1,false,false,false); RESC();
  { float sacc=pB0[0]+pB0[1]; _Pragma("unroll") for(int r=2;r<16;++r)sacc+=pB0[r]; _Pragma("unroll") for(int r=0;r<16;++r)sacc+=pB1[r]; l_reg+=sacc;
    pw0=(u32x4){PKW(pB0,0),PKW(pB0,2),PKW(pB0,4),PKW(pB0,6)};pw1=(u32x4){PKW(pB0,8),PKW(pB0,10),PKW(pB0,12),PKW(pB0,14)};pw2=(u32x4){PKW(pB1,0),PKW(pB1,2),PKW(pB1,4),PKW(pB1,6)};pw3=(u32x4){PKW(pB1,8),PKW(pB1,10),PKW(pB1,12),PKW(pB1,14)};
    SBAR(); pv(o,vb0+sl_cur,PAF(0),PAF(1),PAF(2),PAF(3)); }
  #undef PKW
  #undef PAF
  #undef VFR
  #undef PIN
  #undef MX3
  #undef GAPA
  #undef GAPB
  #undef EX
  #undef VRD
  #undef KRD
  #undef STEP
  #undef ENDW
  {auto rr=__builtin_amdgcn_permlane32_swap(__float_as_uint(l_reg),__float_as_uint(l_reg),false,false);l_reg=__uint_as_float(rr[0])+__uint_as_float(rr[1]);}
  if(hi==0)wsf[32+r32]=l_reg;asm volatile("s_waitcnt lgkmcnt(0)":::"memory");
  float rli[16];
  #pragma unroll
  for(int r=0;r<16;++r)rli[r]=__builtin_amdgcn_rcpf(wsf[32+crow(r,hi)]);
  bf16*Ow=O+(rowbase+q0+wid*QBLK)*PO+h*D;
  { bf16*stg=(bf16*)(shm+LDS_OST)+wid*2048;
    #pragma unroll
    for(int r=0;r<16;++r){const int orow=crow(r,hi);
      #pragma unroll
      for(int d0=0;d0<2;++d0)stg[orow*64+d0*32+r32]=__float2bfloat16(o[d0][r]*rli[r]);}
    asm volatile("s_waitcnt lgkmcnt(0)":::"memory");
    #pragma unroll
    for(int i=0;i<4;++i){const int row=i*8+(lane>>3),ch=lane&7; const u32x4 v=*(const u32x4*)(stg+row*64+ch*8); ATTN_STORE16(Ow+(long)row*PO+ch*8,v);} }
  asm volatile("s_waitcnt lgkmcnt(0)\n\ts_barrier":::"memory");
  #undef DMA_K
  #undef DMA_V
  #undef CMASK
  #undef START
  #undef RESC
  #undef ROT
}
struct AttnTensors { const bf16* Q; const bf16* K; const bf16* V; bf16* O; const unsigned* MASK; const float* relb; };
struct AttnUnit { int bh; int qb; };
constexpr int ATTN_LDS_BYTES=LDS_TOTAL;
#undef SBAR
#undef WAIT_BAR
}
constexpr int NWAVES = 8;
#ifndef MK_N_LAUNCHES
#define MK_N_LAUNCHES 1
#endif
constexpr int PER_PHASE = 10;
constexpr int N_LAUNCHES = (MK_N_LAUNCHES == 1) ? 1 : PER_PHASE;
constexpr int M = 8 * 2048;
constexpr size_t MiB = 1u << 20;
constexpr size_t WS_CTL = 0, CTL_ZERO_BYTES = 65536;
constexpr size_t WS_RSTD1 = 1 * MiB, WS_ROWSS = 2 * MiB, WS_WR = 3 * MiB, WS_BLAST = 3 * MiB + 512 * 1024, WS_TOKINFO = 4 * MiB, WS_LISTS = 5 * MiB, WS_LSC = 7 * MiB;
constexpr size_t WS_WO = 16 * MiB, WS_WGU = 18 * MiB, WS_WD = 50 * MiB, WS_XB = 66 * MiB, WS_MASK = 66 * MiB, WS_SB = 70 * MiB, WS_EG = 86 * MiB  , WS_WIN = 98 * MiB;
constexpr size_t WS_QN = 106 * MiB, WS_KN = 122 * MiB, WS_VN = 138 * MiB, WS_XN2 = 106 * MiB, WS_IQ = 154 * MiB, WS_MISC = 162 * MiB, WS_QB = 164 * MiB, WS_KB = 172 * MiB, WS_VB = 180 * MiB, WS_RG = 196 * MiB;
constexpr size_t WS_MIX = 212 * MiB, WS_HID = 138 * MiB, WS_Y = 158 * MiB, WS_END = 244 * MiB;
constexpr int CW_TMO = 0, CW_CODE = 1, CW_BAR = 4096, CW_CNT = 15360;
constexpr int RING_BYTES = 154624;
constexpr int LDSCTL_OFF = RING_BYTES, MISC_OFF = LDSCTL_OFF, TOFF_OFF = LDSCTL_OFF + 256;
constexpr int LDS_BYTES = RING_BYTES + 1024;
static_assert(attn_body::ATTN_LDS_BYTES <= RING_BYTES, "attention LDS");
#ifndef REP_IDX
#define REP_IDX 1
#endif
#ifndef REP_GLAA
#define REP_GLAA 1
#endif
#ifndef REP_ATT
#define REP_ATT 1
#endif
#ifndef REP_GLAC
#define REP_GLAC 1
#endif
#ifndef REP_IDX_SCORE
#define REP_IDX_SCORE 1
#endif
#ifndef REP_IDX_SEL
#define REP_IDX_SEL 1
#endif
#ifndef REP_SEL_A
#define REP_SEL_A 1
#endif
#ifndef REP_SEL_B
#define REP_SEL_B 1
#endif
#ifndef REP_SEL_C
#define REP_SEL_C 1
#endif
#ifndef REP_SEL_CNT
#define REP_SEL_CNT 1
#endif
#ifndef REP_SEL_ST
#define REP_SEL_ST 1
#endif
#define GAS __attribute__((address_space(1)))
#define LAS __attribute__((address_space(3)))
typedef unsigned short bf16;
typedef unsigned v4u __attribute__((ext_vector_type(4)));
typedef float f32x4 __attribute__((ext_vector_type(4)));
typedef short bf16x8 __attribute__((ext_vector_type(8)));
typedef GAS unsigned gu32;
typedef GAS unsigned long long gu64;
#define RLX_AGENT __ATOMIC_RELAXED, __HIP_MEMORY_SCOPE_AGENT
#define LDS_WAIT() asm volatile("s_waitcnt lgkmcnt(0)" ::: "memory")
#define VM_WAIT() asm volatile("s_waitcnt vmcnt(0)" ::: "memory")
__device__ __forceinline__ unsigned long long rt() { return __builtin_amdgcn_s_memrealtime(); }
__device__ __forceinline__ unsigned f2bf(float f) { unsigned u = __builtin_bit_cast(unsigned, f); return (u + 0x7fffu + ((u >> 16) & 1u)) >> 16; }
__device__ __forceinline__ unsigned pk2(float lo, float hi) { return f2bf(lo) | (f2bf(hi) << 16); }

#define XB_TMO      128
#define XB_XCNT(j)  (256  + 64 * (j))
#define XB_XSUB(j)  (1280 + 64 * (j))
#define XB_XGEN(j)  (2304 + 64 * (j))
#define XB_TOP      3328
#define XB_TOPGEN   3392
#define XCD_BAR_WORDS 3456
#define XB_SPIN_CAP (1u << 18)

__device__ __forceinline__ unsigned xb_ld(unsigned* p)              { return __hip_atomic_load(p, __ATOMIC_RELAXED, __HIP_MEMORY_SCOPE_AGENT); }
__device__ __forceinline__ unsigned xb_add(unsigned* p, unsigned v) { return __hip_atomic_fetch_add(p, v, __ATOMIC_RELAXED, __HIP_MEMORY_SCOPE_AGENT); }
__device__ __forceinline__ unsigned xb_xcc_id() { return (unsigned)__builtin_amdgcn_s_getreg((3 << 11) | 20) & 0xFu; }
#define XB_SPIN(cond, bar) do { unsigned _sp = 0; while (cond) { __builtin_amdgcn_s_sleep(1); \
    if ((++_sp & 255u) == 0u) { if (xb_ld(&(bar)[XB_TMO])) break; if (_sp > XB_SPIN_CAP) { atomicAdd(&(bar)[XB_TMO], 1u); break; } } } } while (0)

struct XcdBarrier {
    unsigned* bar; unsigned x;
    volatile LAS unsigned* st;
};

__device__ __forceinline__ XcdBarrier xcd_barrier_post(unsigned* bar, volatile LAS unsigned* st) {
    XcdBarrier b; b.bar = bar; b.x = xb_xcc_id(); b.st = st;
    if (threadIdx.x == 0) (void)xb_add(&bar[XB_XCNT(b.x)], 1u);
    return b;
}
__device__ __forceinline__ void xcd_barrier_complete(unsigned* bar, unsigned x, unsigned& nloc, unsigned& nx) {
    const unsigned G = gridDim.x * gridDim.y * gridDim.z;
    unsigned sum, cnt, mine, sp = 0u;
    for (;;) {
        sum = 0u; cnt = 0u; mine = 0u;
#pragma unroll
        for (unsigned j = 0; j < 16; ++j) { const unsigned c = xb_ld(&bar[XB_XCNT(j)]); sum += c; cnt += (c > 0u) ? 1u : 0u; mine = (j == x) ? c : mine; }
        if (sum == G) break;
        __builtin_amdgcn_s_sleep(1);
        if ((++sp & 255u) == 0u) { if (xb_ld(&bar[XB_TMO])) break; if (sp > XB_SPIN_CAP) { atomicAdd(&bar[XB_TMO], 1u); break; } }
    }
    nloc = mine > 0u ? mine : 1u; nx = cnt > 0u ? cnt : 1u;
}

__device__ __forceinline__ void xcd_barrier(const XcdBarrier& b) {
    asm volatile("s_waitcnt vmcnt(0)" ::: "memory");
    __syncthreads();
    if (threadIdx.x == 0) {
        unsigned* bar = b.bar;
        __builtin_amdgcn_s_waitcnt(0);
        unsigned nloc = b.st[0], nx = b.st[1];
        if (nloc == 0u) { xcd_barrier_complete(bar, b.x, nloc, nx); b.st[0] = nloc; b.st[1] = nx; }
        const unsigned old = xb_add(&bar[XB_XSUB(b.x)], 1u);
        const unsigned gen = old / nloc;
        if (old + 1u == (gen + 1u) * nloc) {
            __builtin_amdgcn_fence(__ATOMIC_RELEASE, "agent");
            asm volatile("s_waitcnt vmcnt(0)" ::: "memory");
            const unsigned og = xb_add(&bar[XB_TOP], 1u);
            const unsigned tg = og / nx;
            if (og + 1u == (tg + 1u) * nx) xb_add(&bar[XB_TOPGEN], 1u);
            else XB_SPIN(xb_ld(&bar[XB_TOPGEN]) == tg, bar);
            __builtin_amdgcn_fence(__ATOMIC_ACQUIRE, "agent");
            xb_add(&bar[XB_XGEN(b.x)], 1u);
            asm volatile("s_waitcnt vmcnt(0)" ::: "memory");
        } else {
            XB_SPIN(xb_ld(&bar[XB_XGEN(b.x)]) == gen, bar);
            __builtin_amdgcn_fence(__ATOMIC_ACQUIRE, "agent");
            asm volatile("s_waitcnt vmcnt(0)" ::: "memory");
        }
    }
    __syncthreads();
}
typedef float f32x2 __attribute__((ext_vector_type(2)));
typedef unsigned v2u __attribute__((ext_vector_type(2)));
__device__ __forceinline__ float bf2f(unsigned short b) { return __uint_as_float((unsigned)b << 16); }
__device__ __forceinline__ float bflo(unsigned w) { return __uint_as_float(w << 16); }
__device__ __forceinline__ float bfhi(unsigned w) { return __uint_as_float(w & 0xffff0000u); }
__device__ __forceinline__ float wave_sum(float v) {
#pragma unroll
    for (int o = 1; o < 64; o <<= 1) v += __shfl_xor(v, o);
    return v;
}
__device__ __forceinline__ float wave_max(float v) {
#pragma unroll
    for (int o = 1; o < 64; o <<= 1) v = fmaxf(v, __shfl_xor(v, o));
    return v;
}
__device__ __forceinline__ float wave_min(float v) {
#pragma unroll
    for (int o = 1; o < 64; o <<= 1) v = fminf(v, __shfl_xor(v, o));
    return v;
}
#define WG_SYNC() __syncthreads()
#define DPP_STEP_I(v, ctrl) __builtin_amdgcn_update_dpp(0, (v), (ctrl), 0xF, 0xF, false)
__device__ __forceinline__ int wave_isum(int v) {
    v += DPP_STEP_I(v, 0xB1); v += DPP_STEP_I(v, 0x4E); v += DPP_STEP_I(v, 0x141); v += DPP_STEP_I(v, 0x140);
    return __builtin_amdgcn_readlane(v, 0) + __builtin_amdgcn_readlane(v, 16) + __builtin_amdgcn_readlane(v, 32) + __builtin_amdgcn_readlane(v, 48);
}
#define DPP_STEP_F(v, ctrl) __uint_as_float((unsigned)__builtin_amdgcn_update_dpp(0, (int)__float_as_uint(v), (ctrl), 0xF, 0xF, false))
#define RDL_F(v, l) __uint_as_float((unsigned)__builtin_amdgcn_readlane((int)__float_as_uint(v), (l)))
__device__ __forceinline__ float wave_fsum(float v) {
    v += DPP_STEP_F(v, 0xB1); v += DPP_STEP_F(v, 0x4E); v += DPP_STEP_F(v, 0x141); v += DPP_STEP_F(v, 0x140);
    return (RDL_F(v, 0) + RDL_F(v, 16)) + (RDL_F(v, 32) + RDL_F(v, 48));
}
__device__ __forceinline__ float wave_fmax(float v) {
    v = fmaxf(v, DPP_STEP_F(v, 0xB1)); v = fmaxf(v, DPP_STEP_F(v, 0x4E)); v = fmaxf(v, DPP_STEP_F(v, 0x141)); v = fmaxf(v, DPP_STEP_F(v, 0x140));
    return fmaxf(fmaxf(RDL_F(v, 0), RDL_F(v, 16)), fmaxf(RDL_F(v, 32), RDL_F(v, 48)));
}
__device__ __forceinline__ float wave_fmin(float v) {
    v = fminf(v, DPP_STEP_F(v, 0xB1)); v = fminf(v, DPP_STEP_F(v, 0x4E)); v = fminf(v, DPP_STEP_F(v, 0x141)); v = fminf(v, DPP_STEP_F(v, 0x140));
    return fminf(fminf(RDL_F(v, 0), RDL_F(v, 16)), fminf(RDL_F(v, 32), RDL_F(v, 48)));
}

__device__ __forceinline__ int win_vrow(int n) {
    if (n < 1024) { const int base = (n < 512) ? 0 : 512, m = n - base, hh = m >> 6, d = m & 63; return base + 256 * (hh >> 2) + 128 * (d >> 5) + 32 * (hh & 3) + (d & 31); }
    if (n < 1792) return n;
    if (n < 1832) return 3328 + (n - 1792);
    if (n < 2088) return 1792 + (n - 1832);
    if (n < 2344) return 2048 + (n - 2088);
    if (n < 2856) return 2304 + (n - 2344);
    if (n < 2872) return 3328 + 40 + (n - 2856);
    return 2816 + (n - 2872);
}
template <int KIND>
__device__ __forceinline__ void p0_transpose_item(const float* __restrict__ W, int K, int N, const float* __restrict__ gain, bf16* WT, LAS float* scr, int item, int lane) {
    const int nblk = (N + 31) / 32, kb = item / nblk, nb = item % nblk, k0 = 64 * kb, n0 = 32 * nb;
    f32x4 v[8];
#pragma unroll
    for (int j = 0; j < 8; ++j) { const int i = lane + 64 * j, kk = i >> 3, c4 = (i & 7) * 4; v[j] = (n0 + c4 < N) ? *(const f32x4*)(W + (size_t)(k0 + kk) * N + n0 + c4) : (f32x4){0.f, 0.f, 0.f, 0.f}; }
#pragma unroll
    for (int j = 0; j < 8; ++j) { const int i = lane + 64 * j, kk = i >> 3, c4 = (i & 7) * 4; f32x4 x = v[j]; if (gain) x = x * gain[k0 + kk];
        scr[kk * 33 + c4] = x[0]; scr[kk * 33 + c4 + 1] = x[1]; scr[kk * 33 + c4 + 2] = x[2]; scr[kk * 33 + c4 + 3] = x[3]; }
    LDS_WAIT(); asm volatile("" ::: "memory");
    const int c = lane & 7;
#pragma unroll
    for (int j = 0; j < 4; ++j) { const int n = (lane >> 3) + 8 * j; const LAS float* s = scr + (8 * c) * 33 + n;
        v4u o; o.x = pk2(s[0 * 33], s[1 * 33]); o.y = pk2(s[2 * 33], s[3 * 33]); o.z = pk2(s[4 * 33], s[5 * 33]); o.w = pk2(s[6 * 33], s[7 * 33]);
        const int gn = n0 + n; int row;
        if (KIND == 0) row = win_vrow(gn); else if (KIND == 1) row = gn; else if (KIND == 2) row = (gn >> 7) * 256 + (gn & 127); else row = (gn >> 7) * 256 + 128 + (gn & 127);
        if (gn < N) *(GAS v4u*)(WT + (size_t)row * K + k0 + 8 * c) = o; }
    LDS_WAIT(); asm volatile("" ::: "memory");
}

constexpr int SCP = 2064;
__device__ __forceinline__ int crow_(int r, int hi) { return (r & 3) + 8 * (r >> 2) + 4 * hi; }
__device__ __forceinline__ void idx_item(LAS unsigned char* lds, int b, int p, const bf16* __restrict__ IQ, const bf16* __restrict__ MISC, unsigned* __restrict__ MASK, int lane, int wid) {
    const int q0 = p * 16, fr = lane & 15, fq = lane >> 4;
    LAS float* SC = (LAS float*)lds;
    const size_t rowq = (size_t)b * 2048 + q0 + fr;
    bf16x8 Bq[8]; float sinf[8];
    {   const v4u wraw = *(const v4u*)(MISC + rowq * 64 + 32);
        const unsigned wr_[4] = {wraw.x, wraw.y, wraw.z, wraw.w};
#pragma unroll
        for (int h = 0; h < 8; ++h) { const float w = ((h & 1) ? bfhi(wr_[h >> 1]) : bflo(wr_[h >> 1])) * 0.0625f;
            const v4u raw = *(const v4u*)(IQ + rowq * 256 + h * 32 + fq * 8);
            v4u o; o.x = pg8::cvt_pk_bf16(bflo(raw.x) * w, bfhi(raw.x) * w); o.y = pg8::cvt_pk_bf16(bflo(raw.y) * w, bfhi(raw.y) * w); o.z = pg8::cvt_pk_bf16(bflo(raw.z) * w, bfhi(raw.z) * w); o.w = pg8::cvt_pk_bf16(bflo(raw.w) * w, bfhi(raw.w) * w);
            Bq[h] = __builtin_bit_cast(bf16x8, o); sinf[h] = (w > 0.f) ? __builtin_inff() : -__builtin_inff(); } }
    const int nkt = p + 1;
    LAS int* const ROWCTR = (LAS int*)(lds + 16 * SCP * 4);
    if (wid == 0 && lane == 0) ROWCTR[0] = 0;
    const bf16* ikb = MISC + ((size_t)b * 2048 + fr) * 64 + fq * 8;
    for (int rep_ = 0; rep_ < REP_IDX_SCORE; ++rep_)
    for (int kt0 = wid; kt0 < nkt; kt0 += 32) {
        f32x4 acc[4]; bf16x8 A[4];
#pragma unroll
        for (int u = 0; u < 4; ++u) { const int kt = kt0 + 8 * u; acc[u] = (f32x4){0.f, 0.f, 0.f, 0.f}; if (kt < nkt) A[u] = *(const bf16x8*)(ikb + (size_t)kt * 16 * 64); else A[u] = (bf16x8){0, 0, 0, 0, 0, 0, 0, 0}; }
#pragma unroll
        for (int h = 0; h < 8; ++h)
#pragma unroll
            for (int u = 0; u < 4; ++u) { const f32x4 t = __builtin_amdgcn_mfma_f32_16x16x32_bf16(A[u], Bq[h], acc[u], 0, 0, 0);
#pragma unroll
                for (int i = 0; i < 4; ++i) acc[u][i] = __builtin_amdgcn_fmed3f(t[i], acc[u][i], sinf[h]); }
#pragma unroll
        for (int u = 0; u < 4; ++u) { const int kt = kt0 + 8 * u;
            if (kt < nkt) { if (kt == nkt - 1) {
#pragma unroll
                    for (int i = 0; i < 4; ++i) if (4 * fq + i > fr) acc[u][i] = -__builtin_inff(); }
                *(LAS f32x4*)(SC + fr * SCP + kt * 16 + 4 * fq) = acc[u]; } }
    }
    WG_SYNC();
    const int kap = 32 * ((lane >> 4) & 1) + crow_(lane & 15, lane >> 5);
#define IDX_COUNT(dst, expr) do { int cl__ = 0; _Pragma("unroll") for (int g__ = 0; g__ < 4; ++g__) if (8 * g__ < ntile) { _Pragma("unroll") for (int jj__ = 0; jj__ < 8; ++jj__) { const int j = 8 * g__ + jj__; cl__ += (expr) ? 1 : 0; } } \
        dst = wave_isum(cl__); } while (0)
#define IDX_UNI(v) __uint_as_float((unsigned)__builtin_amdgcn_readfirstlane((int)__float_as_uint(v)))
    for (;;) {
        int r = 0; if (lane == 0) r = __hip_atomic_fetch_add(ROWCTR, 1, __ATOMIC_RELAXED, __HIP_MEMORY_SCOPE_WORKGROUP);
        r = __builtin_amdgcn_readfirstlane(r); if (r >= 16) break;
        r = 15 - r;
        const int q = q0 + r, n = q + 1, ntile = (q >> 6) + 1, ngrp = (ntile + 7) >> 3;
        const float NINF = -__builtin_inff();
        float x[32]; unsigned vmask = 0u; float s1 = 0.f, s2 = 0.f;
        const int tb = ntile - 1;
#pragma unroll
        for (int g = 0; g < 4; ++g) {
            if (8 * g + 7 < tb) {
#pragma unroll
                for (int jj = 0; jj < 8; ++jj) x[8 * g + jj] = SC[r * SCP + 64 * (8 * g + jj) + kap];
#pragma unroll
                for (int jj = 0; jj < 8; ++jj) { s1 += x[8 * g + jj]; s2 += x[8 * g + jj] * x[8 * g + jj]; }
                vmask |= 0xFFu << (8 * g);
            } else if (8 * g <= tb) {
#pragma unroll
                for (int jj = 0; jj < 8; ++jj) x[8 * g + jj] = SC[r * SCP + 64 * (8 * g + jj) + kap];
#pragma unroll
                for (int jj = 0; jj < 8; ++jj) { const int j = 8 * g + jj; const bool v = (64 * j + kap) <= q; vmask |= v ? (1u << j) : 0u; const float xv = v ? x[j] : 0.f; x[j] = v ? x[j] : NINF; s1 += xv; s2 += xv * xv; }
            } else {
#pragma unroll
                for (int jj = 0; jj < 8; ++jj) x[8 * g + jj] = NINF;
            }
        }
        unsigned selm = vmask;
        for (int rpb = 0; rpb < REP_SEL_B; ++rpb) { asm volatile("" : "+v"(x[0]), "+v"(vmask)); selm = vmask;
        if (n > 256) {
            const float fn = (float)n, rn = __builtin_amdgcn_rcpf(fn), mu = wave_fsum(s1) * rn, var = fmaxf(wave_fsum(s2) * rn - mu * mu, 0.f), sd = __builtin_amdgcn_sqrtf(var);
            float zq; { const float pq = 256.0f * rn, pp = pq <= 0.5f ? pq : 1.0f - pq; const float t = __builtin_amdgcn_sqrtf(-1.3862943611f * __builtin_amdgcn_logf(fmaxf(pp, 1e-6f)));
                float z = t - (2.30753f + 0.27061f * t) * __builtin_amdgcn_rcpf(1.0f + t * (0.99229f + 0.04481f * t)); zq = pq <= 0.5f ? z : -z; }
            const float sp = sd * __builtin_amdgcn_rcpf(fmaxf(fn * (__builtin_amdgcn_exp2f(-0.7213475204f * zq * zq) * 0.3989422804f), 1e-3f));
            float lo = NINF;
            const float PINF = __builtin_inff();
            float hi = PINF, grow = 1.5f; int c_lo = n, c_hi = 0, side = 0; unsigned lt_lo = 0u, lt_hi = 0xFFFFFFFFu; bool have_lo = false, have_hi = false;
            bool tie = false, found = false, needfinish = false; float tv = 0.f, thr = 0.f; int need = 256;
#pragma unroll 1
            for (int it = 0; it < 48; ++it) {
                if (have_lo && have_hi && (c_lo - c_hi) <= 64) { needfinish = true; break; }
                float mid;
                if (it == 0) mid = mu + zq * sd;
                else if (have_lo && have_hi) {
                    mid = 0.5f * lo + 0.5f * hi;
                    if (side > -2 && side < 2) { const float fr_ = ((float)(c_lo - 256) + 0.5f) * __builtin_amdgcn_rcpf((float)(c_lo - c_hi)); const float m2 = lo + (hi - lo) * fr_; if (m2 > lo && m2 < hi) mid = m2; } else side = 0;
                } else if (have_lo) { mid = lo + ((float)(c_lo - 256) + 4.0f) * sp * grow; grow *= 2.0f; }
                else { mid = hi - ((float)(256 - c_hi) + 4.0f) * sp * grow; grow *= 2.0f; }
                if (!(mid > lo && mid < hi)) { mid = (hi == PINF) ? lo + fabsf(lo) * 0.5f + sp : (lo == NINF) ? hi - fabsf(hi) * 0.5f - sp : 0.5f * lo + 0.5f * hi; if (!(mid > lo && mid < hi)) break; }
                mid = IDX_UNI(mid);
                unsigned a0 = 0u, a1 = 0u;
#pragma unroll
                for (int g = 1; g >= 0; --g) if (g < ngrp) {
#pragma unroll
                    for (int jj = 7; jj >= 0; --jj) a0 = __builtin_amdgcn_alignbit(a0, __float_as_uint(x[8 * g + jj] - mid), 31); }
#pragma unroll
                for (int g = 3; g >= 2; --g) if (g < ngrp) {
#pragma unroll
                    for (int jj = 7; jj >= 0; --jj) a1 = __builtin_amdgcn_alignbit(a1, __float_as_uint(x[8 * g + jj] - mid), 31); }
                const unsigned ltm = a0 | (a1 << 16);
                const int c = 64 * 8 * ngrp - wave_isum(__builtin_popcount(ltm));
                if (c == 256) { found = true; selm = vmask & ~ltm; thr = mid; break; }
                if (c > 256) { lo = mid; c_lo = c; lt_lo = ltm; have_lo = true; side = side > 0 ? side + 1 : 1; } else { hi = mid; c_hi = c; lt_hi = ltm; have_hi = true; side = side < 0 ? side - 1 : -1; }
            }
            if (needfinish) {
                LAS float* CV = (LAS float*)((LAS unsigned char*)SC + 16 * SCP * 4 + 64) + 128 * wid; LAS int* CI = (LAS int*)(CV + 64);
                unsigned cb = lt_hi & ~lt_lo & vmask; int k = 256 - c_hi, base = 0;
                for (;;) { const bool has = cb != 0u; const unsigned long long bal = __ballot(has); if (bal == 0ull) break;
                    if (has) { const int jb = __builtin_ctz(cb); const int key = 64 * jb + kap; const int pos = base + (int)__builtin_amdgcn_mbcnt_hi((unsigned)(bal >> 32), __builtin_amdgcn_mbcnt_lo((unsigned)bal, 0u));
                        CV[pos] = SC[r * SCP + key]; CI[pos] = key; cb &= cb - 1u; }
                    base += __builtin_popcountll(bal); }
                asm volatile("s_waitcnt lgkmcnt(0)" ::: "memory");
                const int m = base; bool active = lane < m; float v_c = active ? CV[lane] : NINF; int i_c = active ? CI[lane] : 0x7fffffff;
                float Tv = 0.f; int Ti = 0;
                for (int qs = 0; qs < 128; ++qs) { const unsigned long long ab = __ballot(active); const int pl = __builtin_ctzll(ab);
                    const float pv = __uint_as_float((unsigned)__builtin_amdgcn_readlane((int)__float_as_uint(v_c), pl)); const int pi = __builtin_amdgcn_readlane(i_c, pl);
                    const bool before = active && ((v_c > pv) || (v_c == pv && i_c < pi)); const int g = __builtin_popcountll(__ballot(before));
                    if (g == k - 1) { Tv = pv; Ti = pi; break; }
                    if (g >= k) active = before; else { k -= g + 1; active = active && !before && (lane != pl); } }
                { const float TvU = IDX_UNI(Tv); unsigned b0 = 0u, b1 = 0u;
#pragma unroll
                  for (int g = 1; g >= 0; --g) if (g < ngrp) {
#pragma unroll
                      for (int jj = 7; jj >= 0; --jj) b0 = __builtin_amdgcn_alignbit(b0, __float_as_uint(x[8 * g + jj] - TvU), 31); }
#pragma unroll
                  for (int g = 3; g >= 2; --g) if (g < ngrp) {
#pragma unroll
                      for (int jj = 7; jj >= 0; --jj) b1 = __builtin_amdgcn_alignbit(b1, __float_as_uint(x[8 * g + jj] - TvU), 31); }
                  const unsigned ltT = b0 | (b1 << 16); selm = vmask & ~ltT;
                  if (64 * 8 * ngrp - wave_isum(__builtin_popcount(ltT)) != 256) {
#pragma unroll
                      for (int jx = 0; jx < 32; ++jx) if (x[jx] == TvU && (64 * jx + kap) > Ti) selm &= ~(1u << jx); } }
            } else
            if (!found) {
                IDX_COUNT(c_hi, x[j] >= hi);
                if (c_hi >= 256) { if (c_hi == 256) { thr = hi; found = true; } else { tie = true; tv = hi; need = 256; } }
                else for (int it = 0; it < 4096; ++it) {
                    float m = NINF;
#pragma unroll
                    for (int g = 0; g < 4; ++g) if (g < ngrp) {
#pragma unroll
                        for (int jj = 0; jj < 8; ++jj) { const int j = 8 * g + jj; m = fmaxf(m, (x[j] < hi) ? x[j] : NINF); } }
                    const float v1 = IDX_UNI(wave_fmax(m));
                    int c; IDX_COUNT(c, x[j] >= v1);
                    if (c >= 256) { if (c == 256) { thr = v1; found = true; } else { tie = true; tv = v1; need = 256 - c_hi; } break; }
                    hi = v1; c_hi = c;
                }
                if (!tie) { selm = 0u;
#pragma unroll
                    for (int j = 0; j < 32; ++j) selm |= (x[j] >= thr) ? (1u << j) : 0u;
                } else {
                    int cum = 0, jstar = 32, needp = 0; unsigned tiem = 0u; selm = 0u;
#pragma unroll
                    for (int j = 0; j < 32; ++j) { const bool t = (x[j] == tv); tiem |= t ? (1u << j) : 0u; const int cj = __builtin_popcountll(__ballot(t));
                        if (jstar == 32 && cum + cj > need) { jstar = j; needp = need - cum; } cum += cj; }
                    const bool tstar = (jstar < 32) && ((tiem >> (jstar & 31)) & 1u);
                    int kL = 0, kH = 63;
                    if (jstar < 32 && needp > 0) { while (kL < kH) { const int km = (kL + kH) >> 1; const int c = __builtin_popcountll(__ballot(tstar && kap <= km)); if (c >= needp) kH = km; else kL = km + 1; } }
                    else kL = -1;
#pragma unroll
                    for (int j = 0; j < 32; ++j) { const bool t = (tiem >> j) & 1u; const bool ts = t && (j < jstar || (j == jstar && kap <= kL)); selm |= (x[j] > tv || ts) ? (1u << j) : 0u; }
                }
            }
        }
        }
        unsigned wlo = 0u, whi = 0u;
        for (int rpc = 0; rpc < REP_SEL_C; ++rpc) { asm volatile("" : "+v"(selm));
#pragma unroll
        for (int j = 0; j < 32; ++j) { const unsigned long long bal = __ballot((selm >> j) & 1u); if (lane == j) { wlo = (unsigned)bal; whi = (unsigned)(bal >> 32); } }
        if (lane < 32) { v2u o; o.x = wlo; o.y = whi; *(v2u*)(MASK + (((size_t)(b * 32 + lane)) * 2048 + q) * 2) = o; }
        }
    }
#undef IDX_COUNT
#undef IDX_UNI
    WG_SYNC();
}

constexpr int KTP = 72;
constexpr int VRP = 136;
constexpr int EP = 68;
constexpr int OTP = 132;
constexpr int GL_OFF = 0, TOT_OFF = 4096, E_OFF = 6144, QA_OFF = 23552, KR_OFF = 32768, PM_OFF = 41984, VR_OFF = 51200, OT_OFF = 68608;
typedef short v4i16g __attribute__((ext_vector_type(4)));
__device__ __forceinline__ bf16x8 tr_frag(const LAS bf16* T, int pitch, int k0, int n0, int lane) {
    const int g = lane >> 4, q = (lane & 15) >> 2, p = lane & 3;
    const LAS bf16* a = T + (k0 + 8 * g + q) * pitch + n0 + 4 * p;
    const v4i16g lo = __builtin_amdgcn_ds_read_tr16_b64_v4i16((LAS v4i16g*)a), hi = __builtin_amdgcn_ds_read_tr16_b64_v4i16((LAS v4i16g*)(a + 4 * pitch));
    return (bf16x8){lo[0], lo[1], lo[2], lo[3], hi[0], hi[1], hi[2], hi[3]};
}
__device__ __forceinline__ float fexp(float x) { return __builtin_amdgcn_exp2f(x * 1.4426950408889634f); }
__device__ __forceinline__ float gla_decay(LAS unsigned char* lds, const bf16* __restrict__ MISC, const float* __restrict__ w2, const float* __restrict__ gb, size_t row0, int h, int tid) {
    LAS float* GL = (LAS float*)(lds + GL_OFF); LAS float* TOT = (LAS float*)(lds + TOT_OFF); LAS float* E = (LAS float*)(lds + E_OFF);
    const int d = tid & 63, tg = tid >> 6;
    { const int t = tid >> 3, r2 = (tid & 7) * 2; const unsigned w = *(const unsigned*)(MISC + (row0 + t) * 64 + 40 + r2); GL[t * 16 + r2] = bflo(w); GL[t * 16 + r2 + 1] = bfhi(w); }
    float wc[16];
#pragma unroll
    for (int r = 0; r < 16; ++r) wc[r] = w2[r * 256 + h * 64 + d];
    const float bias = gb[h * 64 + d];
    WG_SYNC();
    float bc[8]; float run = 0.f;
#pragma unroll
    for (int i = 0; i < 8; ++i) { const int t = 8 * tg + i; float z = bias;
#pragma unroll
        for (int r4 = 0; r4 < 4; ++r4) { const f32x4 g = *(const LAS f32x4*)(GL + t * 16 + 4 * r4); z += g[0] * wc[4 * r4] + g[1] * wc[4 * r4 + 1] + g[2] * wc[4 * r4 + 2] + g[3] * wc[4 * r4 + 3]; }
        const float ls = fminf(z, 0.f) - 0.6931471805599453f * __builtin_amdgcn_logf(1.0f + __builtin_amdgcn_exp2f(-1.4426950408889634f * fabsf(z)));
        run += ls * (1.0f / 16.0f); bc[i] = run; }
    TOT[tg * 64 + d] = run;
    WG_SYNC();
    float pre = 0.f, tot = 0.f;
#pragma unroll
    for (int g = 0; g < 8; ++g) { const float v = TOT[g * 64 + d]; tot += v; if (g < tg) pre += v; }
#pragma unroll
    for (int i = 0; i < 8; ++i) E[(8 * tg + i) * EP + d] = fexp(tot - (bc[i] + pre));
    return tot;
}
__device__ __forceinline__ void gla_load_v(LAS unsigned char* lds, const bf16* __restrict__ VB, size_t row0, int h, int tid) {
    LAS bf16* VR = (LAS bf16*)(lds + VR_OFF); const int t = tid >> 3, v0 = (tid & 7) * 16; const bf16* src = VB + (row0 + t) * 512 + h * 128 + v0;
    const v4u a = *(const v4u*)src, b = *(const v4u*)(src + 8);
    *(LAS v4u*)(VR + t * VRP + v0) = a; *(LAS v4u*)(VR + t * VRP + v0 + 8) = b;
}
__device__ __forceinline__ v4u scale8(v4u raw, const f32x4 e0, const f32x4 e1) {
    v4u o; o.x = pg8::cvt_pk_bf16(bflo(raw.x) * e0[0], bfhi(raw.x) * e0[1]); o.y = pg8::cvt_pk_bf16(bflo(raw.y) * e0[2], bfhi(raw.y) * e0[3]);
    o.z = pg8::cvt_pk_bf16(bflo(raw.z) * e1[0], bfhi(raw.z) * e1[1]); o.w = pg8::cvt_pk_bf16(bflo(raw.w) * e1[2], bfhi(raw.w) * e1[3]); return o;
}
__device__ __forceinline__ void gla_a_item(LAS unsigned char* lds, int id, const bf16* __restrict__ KB, const bf16* __restrict__ VB, const bf16* __restrict__ MISC, const float* __restrict__ w2, const float* __restrict__ gb,
                                           float* __restrict__ U, float* __restrict__ BLAST, float* __restrict__ EG, int tid, int lane, int wid) {
    const int b = id >> 7, h = (id >> 5) & 3, c = id & 31; const size_t row0 = (size_t)b * 2048 + 64 * c;
    const v4u kraw = *(const v4u*)(KB + (row0 + (tid >> 3)) * 256 + h * 64 + (tid & 7) * 8);
    gla_load_v(lds, VB, row0, h, tid);
    const float blast = gla_decay(lds, MISC, w2, gb, row0, h, tid);
    if (tid < 64) BLAST[(size_t)id * 64 + tid] = blast;
    WG_SYNC();
    LAS bf16* KR = (LAS bf16*)(lds + KR_OFF); LAS bf16* VR = (LAS bf16*)(lds + VR_OFF); const LAS float* E = (const LAS float*)(lds + E_OFF);
    { const int t = tid >> 3, d8 = (tid & 7) * 8; const f32x4 e0 = *(const LAS f32x4*)(E + t * EP + d8), e1 = *(const LAS f32x4*)(E + t * EP + d8 + 4); *(LAS v4u*)(KR + t * KTP + d8) = scale8(kraw, e0, e1);
      float* eg = EG + ((size_t)id * 64 + t) * 64 + d8; *(f32x4*)eg = e0; *(f32x4*)(eg + 4) = e1; }
    WG_SYNC();
    const int fr = lane & 15, fq = lane >> 4;
    bf16x8 Bf[2];
#pragma unroll
    for (int kk = 0; kk < 2; ++kk) Bf[kk] = tr_frag(VR, VRP, 32 * kk, 16 * wid, lane);
#pragma unroll
    for (int dt = 0; dt < 4; ++dt) { f32x4 acc = (f32x4){0.f, 0.f, 0.f, 0.f};
#pragma unroll
        for (int kk = 0; kk < 2; ++kk) { const bf16x8 Af = tr_frag(KR, KTP, 32 * kk, 16 * dt, lane); acc = __builtin_amdgcn_mfma_f32_16x16x32_bf16(Af, Bf[kk], acc, 0, 0, 0); }
        *(f32x4*)(U + ((size_t)id * 128 + 16 * wid + fr) * 64 + 16 * dt + 4 * fq) = acc; }
    WG_SYNC();
}
__device__ __forceinline__ void gla_b_item(int item, const float* __restrict__ U, const float* __restrict__ BLAST, bf16* __restrict__ SB, int tid) {
    const int bh = item >> 2, qt = item & 3; const size_t eoff = (size_t)qt * 2048 + (size_t)tid * 4; const int d0 = (tid * 4) & 63;
    f32x4 S = (f32x4){0.f, 0.f, 0.f, 0.f};
#pragma unroll 1
    for (int half = 0; half < 2; ++half) {
        f32x4 u[16], bl[16];
#pragma unroll
        for (int c = 0; c < 16; ++c) { const size_t id = (size_t)bh * 32 + 16 * half + c; u[c] = *(const f32x4*)(U + id * 8192 + eoff); bl[c] = *(const f32x4*)(BLAST + id * 64 + d0); }
#pragma unroll
        for (int c = 0; c < 16; ++c) { const size_t id = (size_t)bh * 32 + 16 * half + c;
            f32x4 e; e[0] = __expf(bl[c][0]); e[1] = __expf(bl[c][1]); e[2] = __expf(bl[c][2]); e[3] = __expf(bl[c][3]);
            const f32x4 sd = S * e; v2u o; o.x = pk2(sd[0], sd[1]); o.y = pk2(sd[2], sd[3]); *(v2u*)(SB + id * 8192 + eoff) = o; S = sd + u[c]; }
    }
}
__device__ __forceinline__ void gla_c_item(LAS unsigned char* lds, int id, const bf16* __restrict__ QB, const bf16* __restrict__ KB, const bf16* __restrict__ VB, const bf16* __restrict__ RG, const float* __restrict__ EG,
                                           const float* __restrict__ og, const bf16* __restrict__ SB, bf16* __restrict__ MIX, int tid, int lane, int wid) {
    const int b = id >> 7, h = (id >> 5) & 3, c = id & 31; const size_t row0 = (size_t)b * 2048 + 64 * c;
    const int st_t = tid >> 3, st_d8 = (tid & 7) * 8;
    const v4u kraw = *(const v4u*)(KB + (row0 + st_t) * 256 + h * 64 + st_d8), qraw = *(const v4u*)(QB + (row0 + st_t) * 256 + h * 64 + st_d8);
    const float* eg = EG + ((size_t)id * 64 + st_t) * 64 + st_d8; const f32x4 e0 = *(const f32x4*)eg, e1 = *(const f32x4*)(eg + 4);
    gla_load_v(lds, VB, row0, h, tid);
    const int fr = lane & 15, fq = lane >> 4;
    bf16x8 Bs[2];
    { const bf16* sbp = SB + ((size_t)id * 128 + 16 * wid + fr) * 64 + 8 * fq; Bs[0] = *(const bf16x8*)sbp; Bs[1] = *(const bf16x8*)(sbp + 32); }
    LAS bf16* QA = (LAS bf16*)(lds + QA_OFF); LAS bf16* KR = (LAS bf16*)(lds + KR_OFF); LAS bf16* PM = (LAS bf16*)(lds + PM_OFF); LAS bf16* VR = (LAS bf16*)(lds + VR_OFF);
    LAS float* OT = (LAS float*)(lds + OT_OFF);
    { f32x4 r0, r1;
#pragma unroll
      for (int i = 0; i < 4; ++i) { r0[i] = 0.125f * __builtin_amdgcn_rcpf(e0[i]); r1[i] = 0.125f * __builtin_amdgcn_rcpf(e1[i]); }
      *(LAS v4u*)(KR + st_t * KTP + st_d8) = scale8(kraw, e0, e1); *(LAS v4u*)(QA + st_t * KTP + st_d8) = scale8(qraw, r0, r1); }
    WG_SYNC();
    { const int tt = wid >> 1;
#pragma unroll
      for (int s2 = 0; s2 < 2; ++s2) { const int st = 2 * (wid & 1) + s2; f32x4 acc = (f32x4){0.f, 0.f, 0.f, 0.f};
        if (st <= tt) {
#pragma unroll
            for (int kk = 0; kk < 2; ++kk) { const bf16x8 Af = *(const LAS bf16x8*)(KR + (16 * st + fr) * KTP + 32 * kk + 8 * fq); const bf16x8 Bf = *(const LAS bf16x8*)(QA + (16 * tt + fr) * KTP + 32 * kk + 8 * fq);
                acc = __builtin_amdgcn_mfma_f32_16x16x32_bf16(Af, Bf, acc, 0, 0, 0); } }
        const int t = 16 * tt + fr, s0 = 16 * st + 4 * fq; v2u o;
        o.x = pg8::cvt_pk_bf16((s0 <= t) ? acc[0] : 0.f, (s0 + 1 <= t) ? acc[1] : 0.f); o.y = pg8::cvt_pk_bf16((s0 + 2 <= t) ? acc[2] : 0.f, (s0 + 3 <= t) ? acc[3] : 0.f);
        *(LAS v2u*)(PM + t * KTP + s0) = o; } }
    WG_SYNC();
    bf16x8 Bv[2];
#pragma unroll
    for (int kk = 0; kk < 2; ++kk) Bv[kk] = tr_frag(VR, VRP, 32 * kk, 16 * wid, lane);
#pragma unroll
    for (int tt = 0; tt < 4; ++tt) { f32x4 acc = (f32x4){0.f, 0.f, 0.f, 0.f};
#pragma unroll
        for (int kk = 0; kk < 2; ++kk) { const bf16x8 Ap = *(const LAS bf16x8*)(PM + (16 * tt + fr) * KTP + 32 * kk + 8 * fq); acc = __builtin_amdgcn_mfma_f32_16x16x32_bf16(Ap, Bv[kk], acc, 0, 0, 0);
                                         const bf16x8 Aq = *(const LAS bf16x8*)(QA + (16 * tt + fr) * KTP + 32 * kk + 8 * fq); acc = __builtin_amdgcn_mfma_f32_16x16x32_bf16(Aq, Bs[kk], acc, 0, 0, 0); }
#pragma unroll
        for (int i = 0; i < 4; ++i) OT[(16 * tt + 4 * fq + i) * OTP + 16 * wid + fr] = acc[i]; }
    WG_SYNC();
    { const int t = tid >> 3, v0 = (tid & 7) * 16; f32x4 ov[4]; float ss = 0.f;
#pragma unroll
      for (int k = 0; k < 4; ++k) { ov[k] = *(const LAS f32x4*)(OT + t * OTP + v0 + 4 * k); ss += (ov[k][0] * ov[k][0] + ov[k][1] * ov[k][1]) + (ov[k][2] * ov[k][2] + ov[k][3] * ov[k][3]); }
      ss += DPP_STEP_F(ss, 0xB1); ss += DPP_STEP_F(ss, 0x4E); ss += DPP_STEP_F(ss, 0x141);
      const float rs = __builtin_amdgcn_rsqf(ss * (1.0f / 128.0f) + 1e-6f);
      const bf16* rgp = RG + (row0 + t) * 512 + h * 128 + v0; const v4u ra = *(const v4u*)rgp, rb = *(const v4u*)(rgp + 8);
      const unsigned rw[8] = {ra.x, ra.y, ra.z, ra.w, rb.x, rb.y, rb.z, rb.w}; unsigned ow[8];
#pragma unroll
      for (int k = 0; k < 4; ++k) { const f32x4 g = *(const f32x4*)(og + v0 + 4 * k); float y[4];
#pragma unroll
          for (int i = 0; i < 4; ++i) { const unsigned w = rw[2 * k + (i >> 1)]; const float r = (i & 1) ? bfhi(w) : bflo(w); const float sg = r * __builtin_amdgcn_rcpf(1.0f + __builtin_amdgcn_exp2f(-1.4426950408889634f * r)); y[i] = ov[k][i] * rs * g[i] * sg; }
          ow[2 * k] = pg8::cvt_pk_bf16(y[0], y[1]); ow[2 * k + 1] = pg8::cvt_pk_bf16(y[2], y[3]); }
      bf16* op = MIX + (row0 + t) * 1024 + 512 + h * 128 + v0;
      *(v4u*)op = (v4u){ow[0], ow[1], ow[2], ow[3]}; *(v4u*)(op + 8) = (v4u){ow[4], ow[5], ow[6], ow[7]}; }
    WG_SYNC();
}

constexpr int WRP = 1032;
constexpr int WR_LDS_BYTES = 48 * WRP * 2;
__device__ __forceinline__ void router_tile(LAS unsigned char* lds, int tile, const bf16* __restrict__ XN2, const float* __restrict__ ROWSS, const float* __restrict__ brg, const float* __restrict__ bre,
                                            unsigned* __restrict__ CNT, int* __restrict__ LISTS, float* __restrict__ LSC, int* __restrict__ TOKINFO, int tid, int lane, int wid) {
    LAS bf16* WR = (LAS bf16*)lds; LAS float* PL = (LAS float*)(lds + WR_LDS_BYTES); LAS unsigned* CL = (LAS unsigned*)(lds + WR_LDS_BYTES + 24576); LAS unsigned* BS = CL + 32;
    if (tid < 32) CL[tid] = 0u;
    const int fr = lane & 15, fq = lane >> 4, rt = wid >> 1, kh = wid & 1;
    {   const size_t row = (size_t)tile * 64 + 16 * rt + fr; const bf16* ap = XN2 + row * 1024 + 512 * kh + 8 * fq;
        bf16x8 Af[16];
#pragma unroll
        for (int kk = 0; kk < 16; ++kk) Af[kk] = *(const bf16x8*)(ap + 32 * kk);
        f32x4 acc[3];
#pragma unroll
        for (int nt = 0; nt < 3; ++nt) acc[nt] = (f32x4){0.f, 0.f, 0.f, 0.f};
#pragma unroll
        for (int kk = 0; kk < 16; ++kk)
#pragma unroll
            for (int nt = 0; nt < 3; ++nt) { const bf16x8 Bf = *(const LAS bf16x8*)(WR + (16 * nt + fr) * WRP + 512 * kh + 32 * kk + 8 * fq); acc[nt] = __builtin_amdgcn_mfma_f32_16x16x32_bf16(Af[kk], Bf, acc[nt], 0, 0, 0); }
#pragma unroll
        for (int nt = 0; nt < 3; ++nt)
#pragma unroll
            for (int i = 0; i < 4; ++i) PL[(wid * 16 + 4 * fq + i) * 48 + 16 * nt + fr] = acc[nt][i];
    }
    WG_SYNC();
    int e_[2] = {0, 0}; unsigned lp[2] = {0u, 0u}; float wk[2] = {0.f, 0.f}; float rstd2 = 0.f; const bool act = tid < 64;
    const int token = tile * 64 + tid;
    if (act) {
        const LAS float* l0 = PL + ((2 * (tid >> 4)) * 16 + (tid & 15)) * 48; const LAS float* l1 = l0 + 16 * 48; float ss = 0.f;
        const f32x4* rp = (const f32x4*)(ROWSS + (size_t)token * 16);
#pragma unroll
        for (int j = 0; j < 4; ++j) { const f32x4 v = rp[j]; ss += (v[0] + v[1]) + (v[2] + v[3]); }
        rstd2 = 1.0f / sqrtf(ss * (1.0f / 1024.0f) + 1e-6f);
        float gl[4]; int gs = 0;
#pragma unroll
        for (int j = 0; j < 4; ++j) gl[j] = (l0[j] + l1[j]) * rstd2 + brg[j];
#pragma unroll
        for (int j = 1; j < 4; ++j) if (gl[j] > gl[gs]) gs = j;
        float den = 0.f;
#pragma unroll
        for (int j = 0; j < 4; ++j) den += __expf(gl[j] - gl[gs]);
        const float gw = 1.0f / den;
        float el[8];
#pragma unroll
        for (int j = 0; j < 8; ++j) el[j] = (l0[4 + gs * 8 + j] + l1[4 + gs * 8 + j]) * rstd2 + bre[gs * 8 + j];
        int i0 = 0;
#pragma unroll
        for (int j = 1; j < 8; ++j) if (el[j] > el[i0]) i0 = j;
        int i1 = (i0 == 0) ? 1 : 0;
#pragma unroll
        for (int j = 0; j < 8; ++j) if (j != i0 && j != i1 && el[j] > el[i1]) i1 = j;
        const float ex = __expf(el[i1] - el[i0]); const float w0 = 1.0f / (1.0f + ex);
        wk[0] = w0 * gw; wk[1] = ex * w0 * gw; e_[0] = gs * 8 + i0; e_[1] = gs * 8 + i1;
        lp[0] = __hip_atomic_fetch_add(CL + e_[0], 1u, __ATOMIC_RELAXED, __HIP_MEMORY_SCOPE_WORKGROUP); lp[1] = __hip_atomic_fetch_add(CL + e_[1], 1u, __ATOMIC_RELAXED, __HIP_MEMORY_SCOPE_WORKGROUP);
    }
    WG_SYNC();
    if (tid < 32) { const unsigned n = CL[tid]; BS[tid] = n ? __hip_atomic_fetch_add(CNT + tid, n, __ATOMIC_RELAXED, __HIP_MEMORY_SCOPE_AGENT) : 0u; }
    WG_SYNC();
    if (act) {
#pragma unroll
        for (int k = 0; k < 2; ++k) { const unsigned pos = BS[e_[k]] + lp[k]; LISTS[(size_t)e_[k] * 16384 + pos] = token; *(f32x2*)(LSC + ((size_t)e_[k] * 16384 + pos) * 2) = (f32x2){rstd2, wk[k]}; }
        *(int4*)(TOKINFO + (size_t)token * 4) = make_int4(e_[0], (int)(BS[e_[0]] + lp[0]), e_[1], (int)(BS[e_[1]] + lp[1]));
    }
    WG_SYNC();
}

template <bool GATHER> struct GroupOrder {
    const LAS int* TOFF; const LAS int* BOFF; const LAS int* CNTL; const int* LISTS; int NPN, G, c; unsigned bstride;
    __device__ bool next(int i, pg8::Unit& u) const {
        const int L = i * G + c; const int ntile = BOFF[32]; if (L >= ntile * NPN) return false;
        const int Tb = L / NPN; int e = 0;
#pragma unroll
        for (int s = 16; s >= 1; s >>= 1) if (BOFF[e + s] <= Tb) e += s;
        const int jt = Tb - BOFF[e];
        u.pm = TOFF[e] + jt; u.pn = L - Tb * NPN; u.e = e; u.p0 = jt * 256; const int rem = CNTL[e] - u.p0; u.nv = rem < 256 ? rem : 256; u.bo = (unsigned)e * bstride; return true;
    }
    __device__ __forceinline__ unsigned arow(const pg8::Unit& u, int r) const {
        if (GATHER) return (unsigned)LISTS[(size_t)u.e * 16384 + u.p0 + (r < u.nv ? r : 0)];
        return (unsigned)(u.pm * 256 + r);
    }
};
__device__ __forceinline__ void skinny_gu(LAS unsigned char* lds, int e, int p0, int rem, int rg, int cb, int slot0, const bf16* __restrict__ XN2, const bf16* __restrict__ WGU, const int* __restrict__ LISTS, const float* __restrict__ LSC, bf16* __restrict__ HID, int lane, int wid) {
    const int fr = lane & 15, fq = lane >> 4; const int r = 16 * rg + fr; const int tok = LISTS[(size_t)e * 16384 + p0 + (r < rem ? r : 0)];
    const bf16* ap = XN2 + (size_t)tok * 1024 + 128 * wid + 8 * fq; const bf16* wb = WGU + (size_t)e * 512 * 1024 + 128 * wid + 8 * fq;
    LAS f32x4* PART = (LAS f32x4*)lds;
    bf16x8 Af[4];
#pragma unroll
    for (int k = 0; k < 4; ++k) Af[k] = *(const bf16x8*)(ap + 32 * k);
#pragma unroll
    for (int nt = 0; nt < 4; ++nt) { const int j = 64 * cb + 16 * nt + fr; const bf16* bp = wb + (size_t)((j >> 7) * 256 + (j & 127)) * 1024;
        bf16x8 Bg[4], Bu[4];
#pragma unroll
        for (int k = 0; k < 4; ++k) { Bg[k] = *(const bf16x8*)(bp + 32 * k); Bu[k] = *(const bf16x8*)(bp + 128 * 1024 + 32 * k); }
        f32x4 ag = (f32x4){0.f, 0.f, 0.f, 0.f}, au = (f32x4){0.f, 0.f, 0.f, 0.f};
#pragma unroll
        for (int k = 0; k < 4; ++k) { ag = __builtin_amdgcn_mfma_f32_16x16x32_bf16(Af[k], Bg[k], ag, 0, 0, 0); au = __builtin_amdgcn_mfma_f32_16x16x32_bf16(Af[k], Bu[k], au, 0, 0, 0); }
        PART[(wid * 8 + nt) * 64 + lane] = ag; PART[(wid * 8 + 4 + nt) * 64 + lane] = au; }
    WG_SYNC();
    if (wid < 4) { const int nt = wid; f32x4 g = (f32x4){0.f, 0.f, 0.f, 0.f}, u = (f32x4){0.f, 0.f, 0.f, 0.f};
#pragma unroll
        for (int w = 0; w < 8; ++w) { g += PART[(w * 8 + nt) * 64 + lane]; u += PART[(w * 8 + 4 + nt) * 64 + lane]; }
#pragma unroll
        for (int i = 0; i < 4; ++i) { const int rr = 16 * rg + 4 * fq + i; if (rr < rem) { const f32x2 sw = *(const f32x2*)(LSC + ((size_t)e * 16384 + p0 + rr) * 2);
            const float a = g[i] * sw.x, uu = u[i] * sw.x; HID[(size_t)(slot0 + rr) * 256 + 64 * cb + 16 * nt + fr] = (bf16)f2bf(a * __builtin_amdgcn_rcpf(1.f + __expf(-a)) * uu * sw.y); } } }
    WG_SYNC();
}
__device__ __forceinline__ void skinny_down(int e, int rem, int rg, int cq, int slot0, const bf16* __restrict__ HID, const bf16* __restrict__ WD, bf16* __restrict__ Y, int lane, int wid) {
    const int fr = lane & 15, fq = lane >> 4; const int r = 16 * rg + fr; const int col0 = 256 * cq + 32 * wid;
    const bf16* ap = HID + (size_t)(slot0 + (r < rem ? r : 0)) * 256 + 8 * fq; const bf16* wb = WD + (size_t)e * 1024 * 256 + (size_t)(col0 + fr) * 256 + 8 * fq;
    bf16x8 Af[8], B0[8], B1[8];
#pragma unroll
    for (int k = 0; k < 8; ++k) { Af[k] = *(const bf16x8*)(ap + 32 * k); B0[k] = *(const bf16x8*)(wb + 32 * k); B1[k] = *(const bf16x8*)(wb + (size_t)16 * 256 + 32 * k); }
    f32x4 a0 = (f32x4){0.f, 0.f, 0.f, 0.f}, a1 = (f32x4){0.f, 0.f, 0.f, 0.f};
#pragma unroll
    for (int k = 0; k < 8; ++k) { a0 = __builtin_amdgcn_mfma_f32_16x16x32_bf16(Af[k], B0[k], a0, 0, 0, 0); a1 = __builtin_amdgcn_mfma_f32_16x16x32_bf16(Af[k], B1[k], a1, 0, 0, 0); }
#pragma unroll
    for (int i = 0; i < 4; ++i) { const int rr = 16 * rg + 4 * fq + i; if (rr < rem) { bf16* yp = Y + (size_t)(slot0 + rr) * 1024 + col0 + fr; yp[0] = (bf16)f2bf(a0[i]); yp[16] = (bf16)f2bf(a1[i]); } }
}
struct Args { const float* in[18]; float* out; unsigned char* ws; int ph_lo, ph_hi, li, pad; };
__global__ void __launch_bounds__(NWAVES * 64, 2) hymba_fwd(Args args) {
    extern __shared__ __attribute__((aligned(16))) unsigned char lds[];
    LAS unsigned char* const L = (LAS unsigned char*)lds;
    volatile LAS unsigned* const MISCW = (volatile LAS unsigned*)(L + MISC_OFF);
    LAS int* const TOFF = (LAS int*)(L + TOFF_OFF); LAS int* const CNTL = TOFF + 40; LAS int* const BOFF = TOFF + 80; LAS int* const SMALL = TOFF + 120;
    const int tid = threadIdx.x, lane = tid & 63, wave = __builtin_amdgcn_readfirstlane(tid >> 6);
    const int G = gridDim.x; const int bx = blockIdx.x; const int vcu = (G % 8 == 0) ? (bx % 8) * (G / 8) + bx / 8 : bx;
    unsigned char* const ws = args.ws;
    gu32* const ctl = (gu32*)(ws + WS_CTL);
    const float* x = args.in[0]; const float* norm1_g = args.in[1]; const float* w_in = args.in[2]; const float* q_norm_g = args.in[3]; const float* k_norm_g = args.in[4];
    const float* rel_bias = args.in[5]; const float* gate_w2 = args.in[6]; const float* gate_b = args.in[7]; const float* out_norm_g = args.in[8]; const float* w_out = args.in[9];
    const float* norm2_g = args.in[10]; const float* w_rg = args.in[11]; const float* b_rg = args.in[12]; const float* w_re = args.in[13]; const float* b_re = args.in[14];
    const float* w_eg = args.in[15]; const float* w_eu = args.in[16]; const float* w_ed = args.in[17];
    float* out = args.out;
    float* RSTD1 = (float*)(ws + WS_RSTD1); float* ROWSS = (float*)(ws + WS_ROWSS); bf16* WR_T = (bf16*)(ws + WS_WR); float* BLAST = (float*)(ws + WS_BLAST);
    int* TOKINFO = (int*)(ws + WS_TOKINFO); int* LISTS = (int*)(ws + WS_LISTS); float* LSC = (float*)(ws + WS_LSC);
    bf16* WO_T = (bf16*)(ws + WS_WO); bf16* WGU_T = (bf16*)(ws + WS_WGU); bf16* WD_T = (bf16*)(ws + WS_WD); bf16* XB = (bf16*)(ws + WS_XB); bf16* WIN_T = (bf16*)(ws + WS_WIN);
    unsigned* MASK = (unsigned*)(ws + WS_MASK); bf16* SB = (bf16*)(ws + WS_SB); float* EG = (float*)(ws + WS_EG);
    bf16* QN = (bf16*)(ws + WS_QN); bf16* KN = (bf16*)(ws + WS_KN); bf16* VN = (bf16*)(ws + WS_VN); bf16* XN2 = (bf16*)(ws + WS_XN2);
    bf16* IQ = (bf16*)(ws + WS_IQ); bf16* MISC = (bf16*)(ws + WS_MISC); bf16* QB = (bf16*)(ws + WS_QB); bf16* KB = (bf16*)(ws + WS_KB); bf16* VB = (bf16*)(ws + WS_VB); bf16* RG = (bf16*)(ws + WS_RG);
    bf16* MIX = (bf16*)(ws + WS_MIX); float* U = (float*)(ws + WS_MIX); bf16* HID = (bf16*)(ws + WS_HID); bf16* Y = (bf16*)(ws + WS_Y);
    unsigned* CNT = (unsigned*)(ctl + CW_CNT);

    for (int u = tid; u < (LDS_BYTES - LDSCTL_OFF) / 4; u += NWAVES * 64) ((LAS unsigned*)(L + LDSCTL_OFF))[u] = 0u;
    __syncthreads();
    const int bli = (N_LAUNCHES == PER_PHASE) ? 0 : args.li;
    XcdBarrier bar; bar.bar = (unsigned*)(ctl + CW_BAR) + bli * XCD_BAR_WORDS; bar.x = 0; bar.st = nullptr;
    if (N_LAUNCHES != PER_PHASE) bar = xcd_barrier_post((unsigned*)(ctl + CW_BAR) + bli * XCD_BAR_WORDS, MISCW + 8);
#define GRID_BAR(seam) do { if (N_LAUNCHES == PER_PHASE) { if (tid == 0) __hip_atomic_store(ctl + CW_TMO, 0xBADBA0u | (unsigned)(seam), RLX_AGENT); } else { xcd_barrier(bar); } } while (0)
    const int lo = args.ph_lo, hi = args.ph_hi;
#define IN(k) (lo <= (k) && (k) < hi)
#define BOTH(k) (IN(k) && IN((k) + 1))
    const int gw = vcu * NWAVES + wave, NGW = G * NWAVES;

    constexpr int I_G = 16 * 8, I_D = 4 * 32, PER_E = 2 * I_G + I_D, NE1 = 18, NE2 = 25;
#define expert_weights(lo_, hi_, w0_, nw_) do { LAS float* scr_ = (LAS float*)(L + wave * 16384); \
        for (int it_ = (lo_) + (w0_); it_ < (hi_); it_ += (nw_)) { const int e_ = it_ / PER_E; int r_ = it_ - e_ * PER_E; \
            if (r_ < I_G) { p0_transpose_item<2>(w_eg + (size_t)e_ * 1024 * 256, 1024, 256, norm2_g, WGU_T + (size_t)e_ * 512 * 1024, scr_, r_, lane); continue; } r_ -= I_G; \
            if (r_ < I_G) { p0_transpose_item<3>(w_eu + (size_t)e_ * 1024 * 256, 1024, 256, norm2_g, WGU_T + (size_t)e_ * 512 * 1024, scr_, r_, lane); continue; } r_ -= I_G; \
            p0_transpose_item<1>(w_ed + (size_t)e_ * 256 * 1024, 256, 1024, nullptr, WD_T + (size_t)e_ * 1024 * 256, scr_, r_, lane); } } while (0)
    if (IN(0)) {
        LAS float* scr = (LAS float*)(L + wave * 16384);
        constexpr int I_IN = 16 * 106, I_O = 16 * 32;
        constexpr int NITEMS = I_IN + I_O;
        for (int it = gw; it < NITEMS; it += NGW) {
            int r = it;
            if (r < I_IN) { p0_transpose_item<0>(w_in, 1024, 3384, norm1_g, WIN_T, scr, r, lane); continue; } r -= I_IN;
            p0_transpose_item<1>(w_out, 1024, 1024, nullptr, WO_T, scr, r, lane);
        }
        expert_weights(NE2 * PER_E, 32 * PER_E, gw, NGW);
        for (int i = bx * (NWAVES * 64) + tid; i < 48 * 1024; i += G * NWAVES * 64) { const int n = i >> 10, k = i & 1023;
            const float v = (n < 4) ? w_rg[k * 4 + n] : (n < 36) ? w_re[k * 32 + (n - 4)] : 0.f; WR_T[i] = (bf16)f2bf(v * norm2_g[k]); }
        for (int m0 = 2 * gw; m0 < M; m0 += 2 * NGW) {
            f32x4 v[2][4]; float s[2];
#pragma unroll
            for (int r = 0; r < 2; ++r) { const GAS f32x4* xr = (const GAS f32x4*)(x + (size_t)(m0 + r) * 1024) + lane;
#pragma unroll
                for (int j = 0; j < 4; ++j) v[r][j] = __builtin_nontemporal_load(xr + 64 * j); }
#pragma unroll
            for (int r = 0; r < 2; ++r) { s[r] = 0.f;
#pragma unroll
                for (int j = 0; j < 4; ++j) s[r] += (v[r][j].x * v[r][j].x + v[r][j].y * v[r][j].y) + (v[r][j].z * v[r][j].z + v[r][j].w * v[r][j].w);
                s[r] = wave_fsum(s[r]); if (lane == 0) RSTD1[m0 + r] = 1.0f / sqrtf(s[r] * (1.0f / 1024.0f) + 1e-6f);
                GAS unsigned long long* o8 = (GAS unsigned long long*)(XB + (size_t)(m0 + r) * 1024) + lane;
#pragma unroll
                for (int j = 0; j < 4; ++j) o8[64 * j] = (unsigned long long)pk2(v[r][j].x, v[r][j].y) | ((unsigned long long)pk2(v[r][j].z, v[r][j].w) << 32); }
        }
        if (BOTH(0)) GRID_BAR(0);
    }
    if (IN(1)) {
        pg8::Gemm g{XB, WIN_T, 1024}; pg8::StaticOrder S; S.init(M, 3584, G, bx);
        pg8::EpiProj E{RSTD1, q_norm_g, k_norm_g, QN, KN, VN, IQ, QB, KB, VB, RG, MISC, 0.125f * 1.4426950408889634f, 1e-6f};
        pg8::gemm_phase<pg8::EpiProj, pg8::StaticOrder, true>(L, g, S, E);
        {
            const int nshort = (896 % G == 0) ? G : G - (896 % G), first = G - nshort;
            if (bx >= first) expert_weights(0, NE1 * PER_E, (bx - first) * NWAVES + wave, nshort * NWAVES); }
        if (BOTH(1)) GRID_BAR(1);
    }
    if (IN(2)) {
        for (int rep = 0; rep < REP_IDX; ++rep)
        for (int it = bx; it < 1024; it += G) { const int b = it & 7, t_ = it >> 3, j_ = t_ >> 5, k0_ = t_ & 31;
            const int p = (j_ == 0) ? k0_ : (j_ == 1) ? 63 - k0_ : (j_ == 2) ? 64 + k0_ : 127 - k0_;
            idx_item(L, b, p, IQ, MISC, MASK, lane, wave); }
        for (int rep = 0; rep < REP_GLAA; ++rep)
        for (int it = bx; it < 1024; it += G) gla_a_item(L, it, KB, VB, MISC, gate_w2, gate_b, U, BLAST, EG, tid, lane, wave);
        if (BOTH(2)) GRID_BAR(2);
    }
    if (IN(3)) {
        for (int it = bx; it < 128; it += G) gla_b_item(it, U, BLAST, SB, tid);
        { const int first = (G > 128) ? 128 : 0, nb = G - first;
          if (bx >= first) expert_weights(NE1 * PER_E, NE2 * PER_E, (bx - first) * NWAVES + wave, nb * NWAVES); }
        if (BOTH(3)) GRID_BAR(3);
    }
    if (IN(4)) {
        const attn_body::AttnTensors AT{(const attn_body::bf16*)QN, (const attn_body::bf16*)KN, (const attn_body::bf16*)VN, (attn_body::bf16*)MIX, MASK, rel_bias};
        for (int rep = 0; rep < REP_ATT; ++rep)
        for (int pr = vcu; pr < 256; pr += G) { const int bh = pr >> 2, s = pr & 3;
            for (int k2 = 0; k2 < 2; ++k2) attn_body::attn_unit<8>(bh >> 3, bh & 7, k2 ? s : 7 - s, AT.Q, AT.K, AT.V, AT.O, AT.MASK, AT.relb, (char*)lds); }
        for (int rep = 0; rep < REP_GLAC; ++rep)
        for (int it = bx; it < 1024; it += G) gla_c_item(L, it, QB, KB, VB, RG, EG, out_norm_g, SB, MIX, tid, lane, wave);
        if (BOTH(4)) GRID_BAR(4);
    }
    if (IN(5)) {
        pg8::Gemm g{MIX, WO_T, 1024}; pg8::StaticOrder S; S.init(M, 1024, G, bx);
        pg8::EpiOut E{x, XN2, ROWSS};
        pg8::gemm_phase<pg8::EpiOut, pg8::StaticOrder, false>(L, g, S, E);
        if (BOTH(5)) GRID_BAR(5);
    }
    if (IN(6)) {
        { LAS bf16* WR = (LAS bf16*)L;
          for (int i = tid; i < 48 * 128; i += NWAVES * 64) { const int n = i >> 7, c8 = i & 127; *(LAS v4u*)(WR + n * WRP + c8 * 8) = *(const v4u*)(WR_T + n * 1024 + c8 * 8); } }
        WG_SYNC();
        for (int tile = bx; tile < 256; tile += G) router_tile(L, tile, XN2, ROWSS, b_rg, b_re, CNT, LISTS, LSC, TOKINFO, tid, lane, wave);
        if (BOTH(6)) GRID_BAR(6);
    }
#define LOAD_TOFF() do { if (tid < 32) CNTL[tid] = (int)__hip_atomic_load(CNT + tid, RLX_AGENT); WG_SYNC(); \
        if (tid == 0) { int acc_ = 0, bacc_ = 0, ns_ = 0; for (int e_ = 0; e_ < 32; ++e_) { const int c_ = CNTL[e_]; TOFF[e_] = acc_; BOFF[e_] = bacc_; \
        const int full_ = c_ >> 8, rem_ = c_ & 255; acc_ += (c_ + 255) >> 8; bacc_ += full_ + (rem_ > 128 ? 1 : 0); if (rem_ > 0 && rem_ <= 128) { SMALL[1 + ns_] = e_; ++ns_; } } TOFF[32] = acc_; BOFF[32] = bacc_; SMALL[0] = ns_; } WG_SYNC(); } while (0)
    if (IN(7)) {
        LOAD_TOFF();
        pg8::Gemm g{XN2, WGU_T, 1024}; GroupOrder<true> S{TOFF, BOFF, CNTL, LISTS, 2, G, vcu, 512u * 1024u * 2u};
        pg8::EpiGU E{LSC, HID};
        pg8::gemm_phase<pg8::EpiGU, GroupOrder<true>, false>(L, g, S, E);
        { const int ns = SMALL[0];
          for (int idx = G - 1 - bx; idx < ns * 32; idx += G) { const int e = SMALL[1 + (idx >> 5)], rg = (idx >> 2) & 7, cb = idx & 3; const int cnt = CNTL[e], full = cnt >> 8, rem = cnt & 255;
              if (16 * rg < rem) skinny_gu(L, e, full * 256, rem, rg, cb, (TOFF[e] + full) * 256, XN2, WGU_T, LISTS, LSC, HID, lane, wave); } }
        if (BOTH(7)) GRID_BAR(7);
    }
    if (IN(8)) {
        LOAD_TOFF();
        pg8::Gemm g{HID, WD_T, 256}; GroupOrder<false> S{TOFF, BOFF, CNTL, LISTS, 4, G, vcu, 1024u * 256u * 2u};
        pg8::EpiDown E{Y};
        pg8::gemm_phase<pg8::EpiDown, GroupOrder<false>, false>(L, g, S, E);
        { const int ns = SMALL[0];
          for (int idx = G - 1 - bx; idx < ns * 32; idx += G) { const int e = SMALL[1 + (idx >> 5)], rg = (idx >> 2) & 7, cq = idx & 3; const int cnt = CNTL[e], full = cnt >> 8, rem = cnt & 255;
              if (16 * rg < rem) skinny_down(e, rem, rg, cq, (TOFF[e] + full) * 256, HID, WD_T, Y, lane, wave); } }
        if (BOTH(8)) GRID_BAR(8);
    }
    if (IN(9)) {
        LOAD_TOFF();
        for (int m0 = 4 * gw; m0 < M; m0 += 4 * NGW) {
            int4 ti[4];
#pragma unroll
            for (int r = 0; r < 4; ++r) ti[r] = *(const int4*)(TOKINFO + (size_t)(m0 + r) * 4);
            v4u av[4][2], b0[4][2], b1[4][2];
#pragma unroll
            for (int r = 0; r < 4; ++r) { const size_t s0 = (size_t)TOFF[ti[r].x] * 256 + ti[r].y, s1 = (size_t)TOFF[ti[r].z] * 256 + ti[r].w;
                const GAS v4u* a = (const GAS v4u*)(XN2 + (size_t)(m0 + r) * 1024) + lane; const GAS v4u* y0 = (const GAS v4u*)(Y + s0 * 1024) + lane; const GAS v4u* y1 = (const GAS v4u*)(Y + s1 * 1024) + lane;
#pragma unroll
                for (int j = 0; j < 2; ++j) { av[r][j] = __builtin_nontemporal_load(a + 64 * j); b0[r][j] = __builtin_nontemporal_load(y0 + 64 * j); b1[r][j] = __builtin_nontemporal_load(y1 + 64 * j); } }
#pragma unroll
            for (int r = 0; r < 4; ++r) { GAS f32x4* o = (GAS f32x4*)(out + (size_t)(m0 + r) * 1024) + 2 * lane;
#pragma unroll
                for (int j = 0; j < 2; ++j) { const v4u a_ = av[r][j], c0 = b0[r][j], c1 = b1[r][j]; f32x4 r0, r1;
                    r0[0] = bflo(a_.x) + bflo(c0.x) + bflo(c1.x); r0[1] = bfhi(a_.x) + bfhi(c0.x) + bfhi(c1.x); r0[2] = bflo(a_.y) + bflo(c0.y) + bflo(c1.y); r0[3] = bfhi(a_.y) + bfhi(c0.y) + bfhi(c1.y);
                    r1[0] = bflo(a_.z) + bflo(c0.z) + bflo(c1.z); r1[1] = bfhi(a_.z) + bfhi(c0.z) + bfhi(c1.z); r1[2] = bflo(a_.w) + bflo(c0.w) + bflo(c1.w); r1[3] = bfhi(a_.w) + bfhi(c0.w) + bfhi(c1.w);
                    __builtin_nontemporal_store(r0, o + 128 * j); __builtin_nontemporal_store(r1, o + 128 * j + 1); } }
        }
    }
#undef IN
#undef BOTH
}

extern "C" void kernel_launch(void* const* d_in, const int* in_sizes, int n_in, void* d_out, int out_size, void* d_ws, size_t ws_size, hipStream_t stream) {
    static int grid = 0;
    if (grid == 0) {
        if (n_in != 18 || out_size != M * 1024 || ws_size < WS_END) { fprintf(stderr, "kernel_launch: unexpected problem shape (n_in %d out %d ws %zu)\n", n_in, out_size, ws_size); grid = -1; return; }
        int dev = 0, cus = 0, per_cu = 0;
        if (hipGetDevice(&dev) != hipSuccess || hipDeviceGetAttribute(&cus, hipDeviceAttributeMultiprocessorCount, dev) != hipSuccess) { grid = -1; return; }
        if (hipFuncSetAttribute((const void*)hymba_fwd, hipFuncAttributeMaxDynamicSharedMemorySize, LDS_BYTES) != hipSuccess) { fprintf(stderr, "kernel_launch: hipFuncSetAttribute failed\n"); grid = -1; return; }
        if (hipOccupancyMaxActiveBlocksPerMultiprocessor(&per_cu, (const void*)hymba_fwd, NWAVES * 64, LDS_BYTES) != hipSuccess || per_cu < 1) { fprintf(stderr, "kernel_launch: occupancy query reports %d\n", per_cu); }
        (void)hipGetLastError();
        grid = cus;
    }
    if (grid < 0) return;
    (void)hipMemsetAsync((char*)d_ws + WS_CTL, 0, CTL_ZERO_BYTES, stream);
    Args a{};
    for (int i = 0; i < 18; ++i) a.in[i] = (const float*)d_in[i];
    a.out = (float*)d_out; a.ws = (unsigned char*)d_ws;
#if defined(PROBE_PHASE)
    { const int k = PROBE_PHASE; a.ph_lo = 0; a.ph_hi = k + 1; a.li = 0; hipLaunchKernelGGL(hymba_fwd, dim3(grid), dim3(NWAVES * 64), LDS_BYTES, stream, a);
      for (int r = 1; r < PROBE_REPS; ++r) { a.ph_lo = k; a.ph_hi = k + 1; a.li = 1; hipLaunchKernelGGL(hymba_fwd, dim3(grid), dim3(NWAVES * 64), LDS_BYTES, stream, a); }
      if (k + 1 < PER_PHASE) { a.ph_lo = k + 1; a.ph_hi = PER_PHASE; a.li = 2; hipLaunchKernelGGL(hymba_fwd, dim3(grid), dim3(NWAVES * 64), LDS_BYTES, stream, a); } }
#else
    if (N_LAUNCHES == 1) { a.ph_lo = 0; a.ph_hi = PER_PHASE; a.li = 0; hipLaunchKernelGGL(hymba_fwd, dim3(grid), dim3(NWAVES * 64), LDS_BYTES, stream, a); }
    else for (int li = 0; li < PER_PHASE; ++li) { a.ph_lo = li; a.ph_hi = li + 1; a.li = li; hipLaunchKernelGGL(hymba_fwd, dim3(grid), dim3(NWAVES * 64), LDS_BYTES, stream, a); }
#endif
}
```

```cpp
#include <hip/hip_runtime.h>
#include <hip/hip_bf16.h>
#include <cstdio>
#include <cstdint>
#include <cmath>
namespace pg8 {
#define PG8_LAS __attribute__((address_space(3)))
typedef unsigned short bf16_t;
typedef short bf16x8 __attribute__((ext_vector_type(8)));
typedef float f32x4 __attribute__((ext_vector_type(4)));
typedef float f32x2 __attribute__((ext_vector_type(2)));
typedef unsigned u32x4 __attribute__((ext_vector_type(4)));
constexpr int BM = 256, BK = 64, HALF = 128, HTB = HALF * BK * 2  , STAGE_BYTES = 8 * HTB, NXCD = 8, WGM = 8;

__host__ __device__ __forceinline__ int lds_byte(int r, int c) { const int st = (r >> 4) * 2 + (c >> 5), rr = r & 15, cc = c & 31, ob = rr * 64 + cc * 2; return st * 1024 + (ob ^ (((ob >> 9) & 1) << 5)); }
__host__ __device__ __forceinline__ void stage_rc(int b, int& R, int& C) { const int st = b / 1024, sb = b % 1024, swz = sb ^ (((sb >> 9) & 1) << 5); R = (st >> 1) * 16 + swz / 64; C = (st & 1) * 32 + (swz % 64) / 2; }
__host__ __device__ __forceinline__ int perm32(int rho) { const int n = rho >> 4, i = rho & 15; return 8 * (i >> 2) + 4 * n + (i & 3); }

struct Unit { int pm, pn; unsigned bo; int e, nv, p0; };
struct Gemm { const bf16_t* A; const bf16_t* Bt; int K; };

struct StaticOrder {
    int nM, nN, nwg, G, c;
    __device__ void init(int M, int N, int G_, int c_) { nM = M / BM; nN = N / BM; nwg = nM * nN; G = G_; c = c_; }
    __device__ bool next(int i, Unit& u) const {
        const long L = (long)i * G + c; if (L >= nwg) return false;
        int wgid = (int)L; { const int q = nwg / NXCD, r = nwg % NXCD, xcd = wgid % NXCD, off = wgid / NXCD; wgid = (xcd < r ? xcd * (q + 1) : r * (q + 1) + (xcd - r) * q) + off; }
        const int nig = WGM * nN, gid = wgid / nig, fm = gid * WGM, gsz = (nM - fm) < WGM ? (nM - fm) : WGM;
        u.pm = fm + ((wgid % nig) % gsz); u.pn = (wgid % nig) / gsz; u.bo = 0u; u.e = 0; u.nv = BM; u.p0 = 0; return true;
    }
    __device__ __forceinline__ unsigned arow(const Unit& u, int r) const { return (unsigned)(u.pm * BM + r); }
};

__device__ __forceinline__ unsigned cvt_pk_bf16(float lo, float hi) { unsigned r; asm volatile("v_cvt_pk_bf16_f32 %0, %1, %2" : "=v"(r) : "v"(lo), "v"(hi)); return r; }

template <class Epi, class Sched, bool ALIGN_EPI = false>
__device__ __forceinline__ void gemm_phase(PG8_LAS unsigned char* lds, const Gemm g, const Sched& S, const Epi& E) {
    const int tid = threadIdx.x, wid = __builtin_amdgcn_readfirstlane(tid >> 6), lane = tid & 63, wr = wid >> 2, wc = wid & 3, fr = lane & 15, fq = lane >> 4;
    const int K = g.K, nt = K / BK;
    int RA[2], CA[2]; unsigned voffB[2];
#pragma unroll
    for (int i = 0; i < 2; ++i) { int R, C; stage_rc(tid * 16 + i * 8192, R, C); const int Rb = ((R & ~31) + perm32(R & 31));
        RA[i] = R; CA[i] = C; voffB[i] = (unsigned)(Rb * K + C) * 2u; }
    const size_t kstep = (size_t)(BK * 2);
    const size_t hstep = (size_t)HALF * K * 2;
    const size_t tstep = 2 * hstep;
    const unsigned ldsw = (unsigned)wid * 1024u;
    const int aoff = lds_byte(wr * 64 + fr, fq * 8), boff = lds_byte(wc * 32 + fr, fq * 8);
#define PG8_SA(b, h) (((b) * 2 + (h)) * HTB)
#define PG8_SB(b, h) ((4 + (b) * 2 + (h)) * HTB)
#define PG8_STAGE(bufoff, gbase, voff) do { _Pragma("unroll") for (int _i = 0; _i < 2; ++_i) \
        __builtin_amdgcn_global_load_lds((const unsigned*)((const char*)(gbase) + (voff)[_i]), (PG8_LAS unsigned*)(lds + (bufoff) + ldsw + _i * 8192), 16, 0, 0); } while (0)
#define PG8_LDA(dst, b, h) do { _Pragma("unroll") for (int m = 0; m < 4; ++m) _Pragma("unroll") for (int k = 0; k < 2; ++k) dst[m][k] = *(const PG8_LAS bf16x8*)(lds + PG8_SA(b, h) + aoff + m * 2048 + k * 1024); } while (0)
#define PG8_LDB(dst, b, h) do { _Pragma("unroll") for (int n = 0; n < 2; ++n) _Pragma("unroll") for (int k = 0; k < 2; ++k) dst[n][k] = *(const PG8_LAS bf16x8*)(lds + PG8_SB(b, h) + boff + n * 2048 + k * 1024); } while (0)
#define PG8_MMA(ai, bj, At, Bt) do { __builtin_amdgcn_s_setprio(1); _Pragma("unroll") for (int m = 0; m < 4; ++m) _Pragma("unroll") for (int n = 0; n < 2; ++n) _Pragma("unroll") for (int k = 0; k < 2; ++k) \
        acc[ai][bj][m][n] = __builtin_amdgcn_mfma_f32_16x16x32_bf16(Bt[n][k], At[m][k], acc[ai][bj][m][n], 0, 0, 0); __builtin_amdgcn_s_setprio(0); } while (0)
#define PG8_WAIT_V(n) asm volatile("s_waitcnt vmcnt(" #n ")" ::: "memory")
#define PG8_WAIT_L(n) asm volatile("s_waitcnt lgkmcnt(" #n ")" ::: "memory")
#define PG8_BAR __builtin_amdgcn_s_barrier()
#define PG8_SCHED __builtin_amdgcn_sched_barrier(0)
#define PG8_AOFF(AO, U) do { _Pragma("unroll") for (int _h = 0; _h < 2; ++_h) _Pragma("unroll") for (int _i = 0; _i < 2; ++_i) \
        AO[_h][_i] = (S.arow(U, _h * HALF + RA[_i]) * (unsigned)K + (unsigned)CA[_i]) * 2u; } while (0)
    Unit cur, nxt; int ui = 0;
    if (!S.next(0, cur)) return;
    f32x4 acc[2][2][4][2];
#pragma unroll
    for (int a = 0; a < 2; ++a)
#pragma unroll
        for (int b = 0; b < 2; ++b)
#pragma unroll
            for (int m = 0; m < 4; ++m)
#pragma unroll
                for (int n = 0; n < 2; ++n) acc[a][b][m][n] = (f32x4){0.f, 0.f, 0.f, 0.f};
    bf16x8 At[4][2], B0[2][2], B1[2][2];
    unsigned aoC[2][2], aoN[2][2];
    PG8_AOFF(aoC, cur);
    const char* const gA = (const char*)g.A;
    const char* cB = (const char*)g.Bt + (size_t)cur.bo + (size_t)cur.pn * tstep;
    {
        PG8_STAGE(PG8_SB(0, 0), cB, voffB); PG8_STAGE(PG8_SB(0, 1), cB + hstep, voffB); PG8_STAGE(PG8_SA(0, 0), gA, aoC[0]); PG8_STAGE(PG8_SA(0, 1), gA, aoC[1]);
        if (wr == 1) PG8_BAR;
        PG8_WAIT_V(2); PG8_BAR;
        PG8_STAGE(PG8_SB(1, 0), cB + kstep, voffB); PG8_STAGE(PG8_SA(1, 0), gA + kstep, aoC[0]); PG8_STAGE(PG8_SB(1, 1), cB + hstep + kstep, voffB);
        PG8_WAIT_V(6); PG8_BAR;
    }
    for (;;) {
        const bool has_next = S.next(ui + 1, nxt);
        if (has_next) { PG8_AOFF(aoN, nxt); } else {
#pragma unroll
            for (int _h = 0; _h < 2; ++_h)
#pragma unroll
                for (int _i = 0; _i < 2; ++_i) aoN[_h][_i] = aoC[_h][_i]; }
        const char* nB = has_next ? (const char*)g.Bt + (size_t)nxt.bo + (size_t)nxt.pn * tstep : cB;
        for (int t = 0; t < nt; t += 2) {
            const bool last = (t == nt - 2);
            const char* a1 = gA + (size_t)(t + 1) * kstep;
            const char* a2 = last ? gA : gA + (size_t)(t + 2) * kstep; const char* b2 = last ? nB : cB + (size_t)(t + 2) * kstep;
            const char* a3 = a2 + kstep; const char* b3 = b2 + kstep;
            unsigned ao2[2][2];
#pragma unroll
            for (int _h = 0; _h < 2; ++_h)
#pragma unroll
                for (int _i = 0; _i < 2; ++_i) ao2[_h][_i] = last ? aoN[_h][_i] : aoC[_h][_i];
            PG8_LDB(B0, 0, 0); PG8_LDB(B1, 0, 1); PG8_SCHED; PG8_LDA(At, 0, 0); PG8_STAGE(PG8_SA(1, 1), a1, aoC[1]);
            PG8_WAIT_V(8); PG8_WAIT_L(0); PG8_BAR; PG8_MMA(0, 0, At, B0); PG8_MMA(0, 1, At, B1); PG8_BAR; PG8_SCHED;
            PG8_LDA(At, 0, 1); PG8_STAGE(PG8_SB(0, 0), b2, voffB); PG8_STAGE(PG8_SB(0, 1), b2 + hstep, voffB); PG8_STAGE(PG8_SA(0, 0), a2, ao2[0]);
            PG8_WAIT_V(8); PG8_WAIT_L(0); PG8_BAR; PG8_MMA(1, 0, At, B0); PG8_MMA(1, 1, At, B1); PG8_BAR; PG8_SCHED;
            PG8_LDB(B0, 1, 0); PG8_LDB(B1, 1, 1); PG8_SCHED; PG8_LDA(At, 1, 0); PG8_STAGE(PG8_SA(0, 1), a2, ao2[1]);
            PG8_WAIT_V(8); PG8_WAIT_L(0); PG8_BAR; PG8_MMA(0, 0, At, B0); PG8_MMA(0, 1, At, B1); PG8_BAR; PG8_SCHED;
            PG8_LDA(At, 1, 1); PG8_STAGE(PG8_SB(1, 0), b3, voffB); PG8_STAGE(PG8_SB(1, 1), b3 + hstep, voffB); PG8_STAGE(PG8_SA(1, 0), a3, ao2[0]);
            PG8_WAIT_V(8); PG8_WAIT_L(0); PG8_BAR; PG8_MMA(1, 0, At, B0); PG8_MMA(1, 1, At, B1); PG8_BAR; PG8_SCHED;
        }
        if constexpr (ALIGN_EPI) { if (wr == 0) PG8_BAR; }
        E(acc, cur, wr, wc, fr, fq);
        if (!has_next) break;
#pragma unroll
        for (int a = 0; a < 2; ++a)
#pragma unroll
            for (int b = 0; b < 2; ++b)
#pragma unroll
                for (int m = 0; m < 4; ++m)
#pragma unroll
                    for (int n = 0; n < 2; ++n) acc[a][b][m][n] = (f32x4){0.f, 0.f, 0.f, 0.f};
        cur = nxt; cB = nB; ++ui;
#pragma unroll
        for (int _h = 0; _h < 2; ++_h)
#pragma unroll
            for (int _i = 0; _i < 2; ++_i) aoC[_h][_i] = aoN[_h][_i];
        if constexpr (ALIGN_EPI) { if (wr == 1) PG8_BAR; }
    }
    PG8_WAIT_V(0);
    if constexpr (!ALIGN_EPI) { if (wr == 0) PG8_BAR; }
    PG8_BAR;
#undef PG8_SA
#undef PG8_SB
#undef PG8_STAGE
#undef PG8_LDA
#undef PG8_LDB
#undef PG8_MMA
#undef PG8_WAIT_V
#undef PG8_WAIT_L
#undef PG8_BAR
#undef PG8_SCHED
#undef PG8_AOFF
}
}
namespace pg8 {
__device__ __forceinline__ float row4_sum(float v) {
    { auto r = __builtin_amdgcn_permlane16_swap(__float_as_uint(v), __float_as_uint(v), false, false); v = __uint_as_float(r[0]) + __uint_as_float(r[1]); }
    { auto r = __builtin_amdgcn_permlane32_swap(__float_as_uint(v), __float_as_uint(v), false, false); v = __uint_as_float(r[0]) + __uint_as_float(r[1]); }
    return v;
}
__device__ __forceinline__ u32x4 pack8(const f32x4 v0, const f32x4 v1) { u32x4 w; w.x = cvt_pk_bf16(v0[0], v0[1]); w.y = cvt_pk_bf16(v0[2], v0[3]); w.z = cvt_pk_bf16(v1[0], v1[1]); w.w = cvt_pk_bf16(v1[2], v1[3]); return w; }

struct EpiProj {
    const float* rstd1; const float* qg; const float* kg;
    bf16_t *QN, *KN, *VN, *IQ, *QB, *KB, *VB, *RG, *MISC;
    float qscale, eps;
    __device__ __forceinline__ void operator()(const f32x4 (&acc)[2][2][4][2], const Unit& u, int wr, int wc, int fr, int fq) const {
        const int row0 = u.pm * BM + wr * 64 + fr; const int pn = u.pn;
        float rs1[2][4];
#pragma unroll
        for (int ai = 0; ai < 2; ++ai)
#pragma unroll
            for (int m = 0; m < 4; ++m) rs1[ai][m] = rstd1[row0 + ai * HALF + m * 16];
        if (pn < 4) {
            const bool isq = pn < 2; const float* gp = isq ? qg : kg; bf16_t* O = isq ? QN : KN; const float os = isq ? qscale : 1.f;
            f32x4 gv[2][2];
#pragma unroll
            for (int bj = 0; bj < 2; ++bj)
#pragma unroll
                for (int n = 0; n < 2; ++n) gv[bj][n] = *(const f32x4*)(gp + 32 * bj + 8 * fq + 4 * n) * os;
            const int hcol = (4 * (pn & 1) + wc) * 64 + 8 * fq;
#pragma unroll
            for (int ai = 0; ai < 2; ++ai)
#pragma unroll
                for (int m = 0; m < 4; ++m) { const int row = row0 + ai * HALF + m * 16; const float s = rs1[ai][m];
                    float ss = 0.f;
#pragma unroll
                    for (int bj = 0; bj < 2; ++bj)
#pragma unroll
                        for (int n = 0; n < 2; ++n) { const f32x4 x = acc[ai][bj][m][n]; ss += (x[0] * x[0] + x[1] * x[1]) + (x[2] * x[2] + x[3] * x[3]); }
                    ss = row4_sum(ss);
                    const float r = s * __builtin_amdgcn_rsqf(s * s * ss * (1.f / 64.f) + eps);
                    bf16_t* rowp = O + (size_t)row * 512 + hcol;
#pragma unroll
                    for (int bj = 0; bj < 2; ++bj) *(u32x4*)(rowp + 32 * bj) = pack8(acc[ai][bj][m][0] * r * gv[bj][0], acc[ai][bj][m][1] * r * gv[bj][1]); }
            return;
        }
        bf16_t* O; int pitch, coff, lim = 256;
        if (pn < 6) { O = VN; pitch = 512; coff = (pn - 4) * 256; }
        else if (pn == 6) { O = IQ; pitch = 256; coff = 0; }
        else if (pn == 7) { O = QB; pitch = 256; coff = 0; }
        else if (pn == 8) { O = KB; pitch = 256; coff = 0; }
        else if (pn < 11) { O = VB; pitch = 512; coff = (pn - 9) * 256; }
        else if (pn < 13) { O = RG; pitch = 512; coff = (pn - 11) * 256; }
        else { O = MISC; pitch = 64; coff = 0; lim = 56; }
        const int c0 = wc * 32 + 8 * fq;
#pragma unroll
        for (int ai = 0; ai < 2; ++ai)
#pragma unroll
            for (int m = 0; m < 4; ++m) { const int row = row0 + ai * HALF + m * 16; const float s = rs1[ai][m];
                bf16_t* rowp = O + (size_t)row * pitch + coff + c0;
#pragma unroll
                for (int bj = 0; bj < 2; ++bj) if (c0 + bj * HALF < lim) *(u32x4*)(rowp + bj * HALF) = pack8(acc[ai][bj][m][0] * s, acc[ai][bj][m][1] * s); }
    }
};

struct EpiOut {
    const float* x; bf16_t* XN2; float* ROWSS;
    __device__ __forceinline__ void operator()(const f32x4 (&acc)[2][2][4][2], const Unit& u, int wr, int wc, int fr, int fq) const {
        const int row0 = u.pm * BM + wr * 64 + fr; const int col0 = u.pn * BM + wc * 32 + 8 * fq;
        f32x4 xv[2][4];
#define EPO_LOAD(buf, g) do { const size_t off_ = (size_t)(row0 + ((g) >> 2) * HALF + ((g) & 3) * 16) * 1024 + col0; \
            xv[buf][0] = *(const f32x4*)(x + off_); xv[buf][1] = *(const f32x4*)(x + off_ + 4); xv[buf][2] = *(const f32x4*)(x + off_ + HALF); xv[buf][3] = *(const f32x4*)(x + off_ + HALF + 4); } while (0)
        EPO_LOAD(0, 0);
#pragma unroll
        for (int g = 0; g < 8; ++g) { const int ai = g >> 2, m = g & 3, cur = g & 1;
            if (g + 1 < 8) EPO_LOAD(cur ^ 1, g + 1);
            const int row = row0 + ai * HALF + m * 16; const size_t off = (size_t)row * 1024 + col0; float ss = 0.f;
#pragma unroll
            for (int bj = 0; bj < 2; ++bj) { const f32x4 a = xv[cur][2 * bj] + acc[ai][bj][m][0], b = xv[cur][2 * bj + 1] + acc[ai][bj][m][1];
                ss += (a[0] * a[0] + a[1] * a[1]) + (a[2] * a[2] + a[3] * a[3]) + (b[0] * b[0] + b[1] * b[1]) + (b[2] * b[2] + b[3] * b[3]);
                *(u32x4*)(XN2 + off + bj * HALF) = pack8(a, b); }
            ss = row4_sum(ss);
            if (fq == 0) ROWSS[(size_t)row * 16 + u.pn * 4 + wc] = ss; }
#undef EPO_LOAD
    }
};

struct EpiGU {
    const float* LSC; bf16_t* HID;
    __device__ __forceinline__ void operator()(const f32x4 (&acc)[2][2][4][2], const Unit& u, int wr, int wc, int fr, int fq) const {
        const int r0 = wr * 64 + fr; const int c0 = u.pn * HALF + wc * 32 + 8 * fq;
#pragma unroll
        for (int ai = 0; ai < 2; ++ai)
#pragma unroll
            for (int m = 0; m < 4; ++m) { const int r = r0 + ai * HALF + m * 16;
                f32x2 sw = (f32x2){0.f, 0.f};
                if (r < u.nv) sw = *(const f32x2*)(LSC + ((size_t)u.e * 16384 + (size_t)(u.p0 + r)) * 2);
                f32x4 h0, h1;
#pragma unroll
                for (int j = 0; j < 4; ++j) { const float a = acc[ai][0][m][0][j] * sw.x, uu = acc[ai][1][m][0][j] * sw.x; h0[j] = a * __builtin_amdgcn_rcpf(1.f + __expf(-a)) * uu * sw.y;
                                              const float a2 = acc[ai][0][m][1][j] * sw.x, u2 = acc[ai][1][m][1][j] * sw.x; h1[j] = a2 * __builtin_amdgcn_rcpf(1.f + __expf(-a2)) * u2 * sw.y; }
                *(u32x4*)(HID + (size_t)(u.pm * BM + r) * 256 + c0) = pack8(h0, h1); }
    }
};
struct EpiDown {
    bf16_t* Y;
    __device__ __forceinline__ void operator()(const f32x4 (&acc)[2][2][4][2], const Unit& u, int wr, int wc, int fr, int fq) const {
        const int r0 = u.pm * BM + wr * 64 + fr; const int c0 = u.pn * BM + wc * 32 + 8 * fq;
#pragma unroll
        for (int ai = 0; ai < 2; ++ai)
#pragma unroll
            for (int m = 0; m < 4; ++m) { bf16_t* rowp = Y + (size_t)(r0 + ai * HALF + m * 16) * 1024 + c0;
#pragma unroll
                for (int bj = 0; bj < 2; ++bj) *(u32x4*)(rowp + bj * HALF) = pack8(acc[ai][bj][m][0], acc[ai][bj][m][1]); }
    }
};
}
namespace attn_body {
using bf16=__hip_bfloat16;
using bf16x8=__attribute__((ext_vector_type(8)))short;
using s16x4=__attribute__((ext_vector_type(4)))short;
using f32x16=__attribute__((ext_vector_type(16)))float;
using u32x4=__attribute__((ext_vector_type(4)))unsigned;
constexpr int BATCH=8,NHEAD=8,SEQ=2048,D=64,DM=NHEAD*D,PO=1024;
constexpr int NW=8,QBLK=32,QB=QBLK*NW,KVBLK=64,NQB=SEQ/QB;
constexpr int ATTN_UNIT_ROWS=QB;
__device__ __forceinline__ int crow(int r,int hi){return (r&3)+8*(r>>2)+4*hi;}
#define SBAR() __builtin_amdgcn_sched_barrier(0)
typedef float f32x4a __attribute__((ext_vector_type(4)));
__device__ __forceinline__ void tbias(f32x16&p0,f32x16&p1,int t,int qpos,int hi,__attribute__((address_space(3))) const char* tabr){
  int base=qpos-64*t-4*hi; base=base<-4?-4:(base>200?200:base); const int a=200-base, s=a&3;
  const __attribute__((address_space(3))) f32x4a* tp=(const __attribute__((address_space(3))) f32x4a*)(tabr+s*1088+(a-s)*4);
  #pragma unroll
  for(int g=0;g<4;++g){ const f32x4a v0=tp[2*g], v1=tp[2*g+8];
    p0[4*g]+=v0[0];p0[4*g+1]+=v0[1];p0[4*g+2]+=v0[2];p0[4*g+3]+=v0[3]; p1[4*g]+=v1[0];p1[4*g+1]+=v1[1];p1[4*g+2]+=v1[2];p1[4*g+3]+=v1[3];
    asm volatile("":"+v"(p0),"+v"(p1)); }
}
__device__ __forceinline__ float mkeep(float v,unsigned mw,int bit){ const unsigned t=(unsigned)(((int)(mw<<(31-bit)))>>31); return __uint_as_float(__float_as_uint(v)&t); }
constexpr int NSLOT=3, SLOTB=8192;
constexpr int LDS_K=0, LDS_V=NSLOT*SLOTB, LDS_WS=2*NSLOT*SLOTB, LDS_OST=LDS_WS+NW*64*4, LDS_BYTES=LDS_OST+NW*4096, LDS_MSK=LDS_BYTES, LDS_TAB=LDS_MSK+65536, LDS_TOTAL=LDS_TAB+4352;
constexpr float C2=0.125f*1.4426950408889634f;
__device__ __forceinline__ void glds16(const void*gsrc,unsigned lds_dst){unsigned keep;
  asm volatile("s_mov_b32 %0, m0\n\ts_mov_b32 m0, %2\n\ts_nop 0\n\tglobal_load_lds_dwordx4 %1, off\n\ts_mov_b32 m0, %0":"=&s"(keep):"v"(gsrc),"s"(lds_dst):"memory");}
__device__ __forceinline__ float max3f(float a,float b,float c){float r;asm("v_max3_f32 %0, %1, %2, %3":"=v"(r):"v"(a),"v"(b),"v"(c));return r;}
__device__ __forceinline__ float max2f(float a,float b){float r;asm("v_max_f32_e32 %0, %1, %2":"=v"(r):"v"(a),"v"(b));return r;}
__device__ __forceinline__ float fadd_s(float a,float b){float r;asm("v_add_f32_e32 %0, %1, %2":"=v"(r):"v"(a),"v"(b));return r;}
__device__ __forceinline__ float fsub_s(float a,float b){float r;asm("v_sub_f32_e32 %0, %1, %2":"=v"(r):"v"(a),"v"(b));return r;}
typedef float f32x2_t __attribute__((ext_vector_type(2))); typedef __bf16 bf16x2_t __attribute__((ext_vector_type(2)));
__device__ __forceinline__ unsigned cvtpk_s(float lo,float hi){f32x2_t v={lo,hi};bf16x2_t b=__builtin_convertvector(v,bf16x2_t);return __builtin_bit_cast(unsigned,b);}
#define WAIT_BAR(N) asm volatile("s_waitcnt vmcnt(" #N ") lgkmcnt(0)\n\ts_barrier":::"memory")

__device__ __forceinline__ void qkt(f32x16&p0,f32x16&p1,const char*Kslot,const bf16x8*qr,const f32x16&negm,int r32,int hi){
  const char*kb=Kslot+hi*1024+r32*16;
  #pragma unroll
  for(int d0=0;d0<4;++d0){
    const bf16x8 b0=*reinterpret_cast<const bf16x8*>(kb+d0*2048);
    const bf16x8 b1=*reinterpret_cast<const bf16x8*>(kb+d0*2048+512);
    if(d0==0){p0=__builtin_amdgcn_mfma_f32_32x32x16_bf16(b0,qr[0],negm,0,0,0);p1=__builtin_amdgcn_mfma_f32_32x32x16_bf16(b1,qr[0],negm,0,0,0);}
    else{p0=__builtin_amdgcn_mfma_f32_32x32x16_bf16(b0,qr[d0],p0,0,0,0);p1=__builtin_amdgcn_mfma_f32_32x32x16_bf16(b1,qr[d0],p1,0,0,0);}}
}
typedef __attribute__((address_space(3))) const char* lds_cptr;
typedef short v4i16_t __attribute__((ext_vector_type(4)));
__device__ __forceinline__ void kload8(bf16x8*kf,lds_cptr kp){
  kf[0]=*(const __attribute__((address_space(3))) bf16x8*)(kp);      kf[1]=*(const __attribute__((address_space(3))) bf16x8*)(kp+512);
  kf[2]=*(const __attribute__((address_space(3))) bf16x8*)(kp+2048); kf[3]=*(const __attribute__((address_space(3))) bf16x8*)(kp+2560);
  kf[4]=*(const __attribute__((address_space(3))) bf16x8*)(kp+4096); kf[5]=*(const __attribute__((address_space(3))) bf16x8*)(kp+4608);
  kf[6]=*(const __attribute__((address_space(3))) bf16x8*)(kp+6144); kf[7]=*(const __attribute__((address_space(3))) bf16x8*)(kp+6656);
}
__device__ __forceinline__ void kload2(bf16x8*kf,lds_cptr kp,int j){ kf[2*j]=*(const __attribute__((address_space(3))) bf16x8*)(kp+j*2048); kf[2*j+1]=*(const __attribute__((address_space(3))) bf16x8*)(kp+j*2048+512); }
__device__ __forceinline__ s16x4 vtr(lds_cptr p){ return __builtin_bit_cast(s16x4,__builtin_amdgcn_ds_read_tr16_b64_v4i16((__attribute__((address_space(3))) v4i16_t*)p)); }
__device__ __forceinline__ float rowmax(const f32x16&p0,const f32x16&p1){
  float a=max3f(p0[0],p0[1],p1[0]),b=max3f(p0[2],p0[3],p1[1]);a=max3f(a,p1[2],p1[3]);
  #pragma unroll
  for(int r=4;r<16;r+=4){a=max3f(a,p0[r],p0[r+1]);b=max3f(b,p0[r+2],p0[r+3]);a=max3f(a,p1[r],p1[r+1]);b=max3f(b,p1[r+2],p1[r+3]);}
  const float m=max2f(a,b);
  auto rr=__builtin_amdgcn_permlane32_swap(__float_as_uint(m),__float_as_uint(m),false,false);
  return max2f(__uint_as_float(rr[0]),__uint_as_float(rr[1]));
}
__device__ __forceinline__ void pv(f32x16*o,int vb,bf16x8 pa0,bf16x8 pa1,bf16x8 pa2,bf16x8 pa3){
  #pragma unroll
  for(int d0=0;d0<2;++d0){s16x4 lo[4],hi[4];
    #pragma unroll
    for(int ks=0;ks<4;++ks){
      asm volatile("ds_read_b64_tr_b16 %0,%1 offset:%c2":"=&v"(lo[ks]):"v"(vb),"i"(d0*4096+ks*1024):"memory");
      asm volatile("ds_read_b64_tr_b16 %0,%1 offset:%c2":"=&v"(hi[ks]):"v"(vb),"i"(d0*4096+ks*1024+512):"memory");}
    asm volatile("s_waitcnt lgkmcnt(0)":::"memory");SBAR();
    #define PK(k) (bf16x8){lo[k][0],lo[k][1],lo[k][2],lo[k][3],hi[k][0],hi[k][1],hi[k][2],hi[k][3]}
    o[d0]=__builtin_amdgcn_mfma_f32_32x32x16_bf16(pa0,PK(0),o[d0],0,0,0);
    o[d0]=__builtin_amdgcn_mfma_f32_32x32x16_bf16(pa1,PK(1),o[d0],0,0,0);
    o[d0]=__builtin_amdgcn_mfma_f32_32x32x16_bf16(pa2,PK(2),o[d0],0,0,0);
    o[d0]=__builtin_amdgcn_mfma_f32_32x32x16_bf16(pa3,PK(3),o[d0],0,0,0);
    #undef PK
  }
}

#ifndef ATTN_STORE16
#define ATTN_STORE16(p,v) (*(u32x4*)(p)=(v))
#endif
template<int THRL> __device__ __forceinline__ void attn_unit(int b,int h,int qb,const bf16*Q,const bf16*__restrict__ K,const bf16*__restrict__ V,bf16*O,const unsigned*__restrict__ MASK,const float*__restrict__ relb,char*shm){
  int tid0_=threadIdx.x; asm volatile("":"+v"(tid0_));
  const int tid=tid0_,lane=tid&63,r32=lane&31,hi=lane>>5; const int wid=__builtin_amdgcn_readfirstlane(tid>>6);
  const long rowbase=(long)b*SEQ; const int q0=qb*QB;
  const bf16*Qw=Q+(rowbase+q0+wid*QBLK)*DM+h*D;
  const bf16*Kh=K+rowbase*DM+h*D,*Vh=V+rowbase*DM+h*D;
  const unsigned lds0=(unsigned)(uintptr_t)shm;
  float*wsf=(float*)(shm+LDS_WS)+wid*64;
  const bf16*ksrc=Kh+(long)lane*DM+wid*8;
  const bf16*vsrc=Vh+(long)(16*(wid&3)+(lane>>2))*DM+(wid>>2)*32+(lane&3)*8;
  const unsigned kdst=lds0+LDS_K+wid*1024, vdst=lds0+LDS_V+wid*1024;
  #define DMA_K(t,slot) glds16(ksrc+(long)(t)*KVBLK*DM,(unsigned)__builtin_amdgcn_readfirstlane(kdst+(slot)))
  #define DMA_V(t,slot) glds16(vsrc+(long)(t)*KVBLK*DM,(unsigned)__builtin_amdgcn_readfirstlane(vdst+(slot)))
  const int vb0=(int)(lds0+LDS_V)+((lane>>4)&1)*32+(lane&3)*8+(4*hi+((lane&15)>>2))*64;
  const char*Kbase=shm+LDS_K; bf16x8 kf[8];
  const lds_cptr shm3=(lds_cptr)shm; const lds_cptr kp0=shm3+LDS_K+hi*1024+r32*16; const lds_cptr vp0=shm3+LDS_V+((lane>>4)&1)*32+(lane&3)*8+(4*hi+((lane&15)>>2))*64;
  const int NT=(q0+QB)/KVBLK;
  { int tid_=tid; asm volatile("":"+v"(tid_));
    const u32x4*msrc=(const u32x4*)(MASK+((size_t)(b*32)*SEQ+q0)*2); u32x4*mdst=(u32x4*)(shm+LDS_MSK);
    u32x4 mv[8]; const int nit=NT>>2;
    _Pragma("unroll") for(int k=0;k<8;++k){ const int i=tid_+k*(NW*64); if(k<nit) mv[k]=msrc[(size_t)(i>>7)*(SEQ*2/4)+(i&127)]; }
    _Pragma("unroll") for(int k=0;k<8;++k){ const int i=tid_+k*(NW*64); if(k<nit) mdst[i]=mv[k]; }
    for(int i=tid_;i<4*272;i+=NW*64){ const int sft=i/272, k=i-sft*272, d=200-(k+sft); float v=0.f;
      if(d>=0&&d<=112){ int bk; if(d<16)bk=d; else { bk=16+(int)(logf((float)d*(1.0f/16.0f))/2.0794415416798357f*16.0f); bk=bk>31?31:bk; } v=(relb[bk*NHEAD+h]-relb[31*NHEAD+h])*1.4426950408889634f; }
      ((float*)(shm+LDS_TAB))[i]=v; } }
  const unsigned*mskw=(const unsigned*)(shm+LDS_MSK)+(wid*QBLK+r32)*2+hi;
  const int qpos=q0+wid*QBLK+r32;
  DMA_K(0,0);DMA_V(0,0);DMA_K(1,SLOTB);
  bf16x8 qr[4];
  #pragma unroll
  for(int d0=0;d0<4;++d0)qr[d0]=*reinterpret_cast<const bf16x8*>(&Qw[(long)r32*DM+d0*16+hi*8]);
  float mhat=0.f,l_reg=0.f;f32x16 o[2];o[0]=f32x16{};o[1]=f32x16{};f32x16 negm=f32x16{};asm volatile("":"+v"(negm));
  #define CMASK(P0,P1,t) do{ if((t)>=NT-7 && 64*(t)+63+127>=q0+wid*QBLK) tbias(P0,P1,(t),qpos,hi,shm3+LDS_TAB); }while(0)
  bool resc=false;
  #define START(P0,P1) do{ const float rm=rowmax(P0,P1); resc=false; \
    { const float dl=rm; mhat=fadd_s(mhat,dl); \
      _Pragma("unroll") for(int r=0;r<16;++r){P0[r]=fsub_s(P0[r],dl);P1[r]=fsub_s(P1[r],dl);} \
      _Pragma("unroll") for(int r=0;r<16;++r)negm[r]=-mhat; asm volatile("":"+v"(negm)); } \
    _Pragma("unroll") for(int r=0;r<16;++r)P0[r]=__builtin_amdgcn_exp2f(P0[r]); }while(0)
  #define RESC() do{ if(resc){ asm volatile("s_waitcnt lgkmcnt(0)":::"memory"); \
      _Pragma("unroll") for(int d_=0;d_<2;++d_) _Pragma("unroll") for(int r=0;r<16;++r)o[d_][r]*=wsf[crow(r,hi)]; } }while(0)
  f32x16 pA0,pA1,pB0,pB1;
  int sl_prev=0,sl_cur=0,sl_next=SLOTB;
  #define ROT() do{sl_prev=sl_cur;sl_cur=sl_next;sl_next=(sl_next==(NSLOT-1)*SLOTB)?0:sl_next+SLOTB;}while(0)
  DMA_K(2,2*SLOTB);
  WAIT_BAR(3);
  qkt(pA0,pA1,Kbase,qr,negm,r32,hi);asm volatile("s_nop 15\n\ts_nop 7":"+v"(pA0),"+v"(pA1));CMASK(pA0,pA1,0);
  START(pA0,pA1);
  _Pragma("unroll") for(int r=0;r<16;++r)pA1[r]=__builtin_amdgcn_exp2f(pA1[r]);
  { const unsigned mw0=mskw[0]; _Pragma("unroll") for(int r=0;r<16;++r){pA0[r]=mkeep(pA0[r],mw0,r);pA1[r]=mkeep(pA1[r],mw0,16+r);} }
  WAIT_BAR(0);
  DMA_K(3,0);DMA_V(1,SLOTB);
  ROT();
  kload8(kf,kp0+sl_cur);
  WAIT_BAR(2);
  s16x4 vlo[8],vhi[8]; u32x4 pw0,pw1,pw2,pw3;
  #define PKW(P,B) cvtpk_s(P[B],P[B+1])
  #define PAF(k) __builtin_bit_cast(bf16x8,pw##k)
  #define VFR(i) (bf16x8){vlo[i][0],vlo[i][1],vlo[i][2],vlo[i][3],vhi[i][0],vhi[i][1],vhi[i][2],vhi[i][3]}
  #define PIN(x) asm volatile("":"+v"(x))
  #define MX3(a,b,c) __builtin_fmaxf(__builtin_fmaxf((a),(b)),(c))
  #define GAPA(MF,A0,A1,A2,A3,W0,W1,PW) do{ MF; sacc+=A0; sacc+=A1; sacc+=A2; sacc+=A3; PIN(sacc); W0; W1; PIN(PW); SBAR(); }while(0)
  #define EX(v) __builtin_amdgcn_exp2f(v)
  #define GAPB(MF,X,B,MB) do{ MF; X[B]=mkeep(EX(X[B]),mw_,MB+B); X[B+1]=mkeep(EX(X[B+1]),mw_,MB+B+1); X[B+2]=mkeep(EX(X[B+2]),mw_,MB+B+2); X[B+3]=mkeep(EX(X[B+3]),mw_,MB+B+3); PIN(X); SBAR(); }while(0)
  #define VRD(i) do{ vlo[i]=vtr(vp_+(((i)>>2)*4096+((i)&3)*1024)); vhi[i]=vtr(vp_+(((i)>>2)*4096+((i)&3)*1024+512)); }while(0)
  #define KRD(G,j) do{ if(G){ kload2(kf,kp0+sl_next,j); SBAR(); } }while(0)
  #define STEP(C0,C1,P0,P1,t,GK,GV,GL) do{ SBAR(); \
    const lds_cptr vp_=vp0+sl_prev; const unsigned mw_=mskw[(t)*512]; \
    VRD(0); SBAR(); float sacc=(P0[0]+P0[1]); \
    GAPA(C0=__builtin_amdgcn_mfma_f32_32x32x16_bf16(kf[0],qr[0],negm,0,0,0), P0[2],P0[3],P0[4],P0[5],     pw0[0]=PKW(P0,0), pw0[1]=PKW(P0,2), pw0); \
    VRD(4); SBAR(); GAPA(C1=__builtin_amdgcn_mfma_f32_32x32x16_bf16(kf[1],qr[0],negm,0,0,0), P0[6],P0[7],P0[8],P0[9],     pw0[2]=PKW(P0,4), pw0[3]=PKW(P0,6), pw0); \
    VRD(1); SBAR(); GAPA(C0=__builtin_amdgcn_mfma_f32_32x32x16_bf16(kf[2],qr[1],C0,0,0,0),   P0[10],P0[11],P0[12],P0[13], pw1[0]=PKW(P0,8), pw1[1]=PKW(P0,10), pw1); \
    VRD(5); SBAR(); GAPA(C1=__builtin_amdgcn_mfma_f32_32x32x16_bf16(kf[3],qr[1],C1,0,0,0),   P0[14],P0[15],P1[0],P1[1],   pw1[2]=PKW(P0,12),pw1[3]=PKW(P0,14), pw1); \
    VRD(2); SBAR(); GAPA(C0=__builtin_amdgcn_mfma_f32_32x32x16_bf16(kf[4],qr[2],C0,0,0,0),   P1[2],P1[3],P1[4],P1[5],     pw2[0]=PKW(P1,0), pw2[1]=PKW(P1,2), pw2); \
    VRD(6); SBAR(); GAPA(C1=__builtin_amdgcn_mfma_f32_32x32x16_bf16(kf[5],qr[2],C1,0,0,0),   P1[6],P1[7],P1[8],P1[9],     pw2[2]=PKW(P1,4), pw2[3]=PKW(P1,6), pw2); \
    VRD(3); SBAR(); GAPA(C0=__builtin_amdgcn_mfma_f32_32x32x16_bf16(kf[6],qr[3],C0,0,0,0),   P1[10],P1[11],P1[12],P1[13], pw3[0]=PKW(P1,8), pw3[1]=PKW(P1,10), pw3); \
    VRD(7); SBAR(); GAPA(C1=__builtin_amdgcn_mfma_f32_32x32x16_bf16(kf[7],qr[3],C1,0,0,0),   P1[14],P1[15],0.f,0.f,       pw3[2]=PKW(P1,12),pw3[3]=PKW(P1,14), pw3); \
    l_reg+=sacc; \
    if(GK){DMA_K((t)+3,sl_cur);} if(GV){DMA_V((t)+1,sl_next);} \
    CMASK(C0,C1,t); \
    { float a=MX3(C0[0],C0[1],C1[0]),b=MX3(C0[2],C0[3],C1[1]); a=MX3(a,C1[2],C1[3]); \
      _Pragma("unroll") for(int r=4;r<16;r+=4){a=MX3(a,C0[r],C0[r+1]);b=MX3(b,C0[r+2],C0[r+3]);a=MX3(a,C1[r],C1[r+1]);b=MX3(b,C1[r+2],C1[r+3]);} \
      float rm=__builtin_fmaxf(a,b); { auto rr=__builtin_amdgcn_permlane32_swap(__float_as_uint(rm),__float_as_uint(rm),false,false); rm=__builtin_fmaxf(__uint_as_float(rr[0]),__uint_as_float(rr[1])); } \
      resc=false; \
      if(__builtin_expect(__any(rm>(float)THRL),0)){ const float dl=__builtin_fmaxf(rm,0.f); mhat+=dl; \
        _Pragma("unroll") for(int r=0;r<16;++r){C0[r]-=dl;C1[r]-=dl;} \
        _Pragma("unroll") for(int r=0;r<16;++r)negm[r]=-mhat; asm volatile("":"+v"(negm)); \
        const float f=__builtin_amdgcn_exp2f(-dl); l_reg*=f; if(hi==0)wsf[r32]=f; resc=true; } } \
    SBAR(); \
    GAPB(o[0]=__builtin_amdgcn_mfma_f32_32x32x16_bf16(PAF(0),VFR(0),o[0],0,0,0), C0,0,0); \
    GAPB(o[1]=__builtin_amdgcn_mfma_f32_32x32x16_bf16(PAF(0),VFR(4),o[1],0,0,0), C0,4,0); \
    KRD(GL,0); GAPB(o[0]=__builtin_amdgcn_mfma_f32_32x32x16_bf16(PAF(1),VFR(1),o[0],0,0,0), C0,8,0); \
    KRD(GL,1); GAPB(o[1]=__builtin_amdgcn_mfma_f32_32x32x16_bf16(PAF(1),VFR(5),o[1],0,0,0), C0,12,0); \
    KRD(GL,2); GAPB(o[0]=__builtin_amdgcn_mfma_f32_32x32x16_bf16(PAF(2),VFR(2),o[0],0,0,0), C1,0,16); \
    KRD(GL,3); GAPB(o[1]=__builtin_amdgcn_mfma_f32_32x32x16_bf16(PAF(2),VFR(6),o[1],0,0,0), C1,4,16); \
    GAPB(o[0]=__builtin_amdgcn_mfma_f32_32x32x16_bf16(PAF(3),VFR(3),o[0],0,0,0), C1,8,16); \
    GAPB(o[1]=__builtin_amdgcn_mfma_f32_32x32x16_bf16(PAF(3),VFR(7),o[1],0,0,0), C1,12,16); \
    }while(0)
  int t=1;
  #undef CMASK
  #define CMASK(P0,P1,t) do{}while(0)
  for(;t+7<NT;t+=2){
    STEP(pB0,pB1,pA0,pA1,t,true,true,true);     WAIT_BAR(2); RESC(); ROT();
    STEP(pA0,pA1,pB0,pB1,t+1,true,true,true);   WAIT_BAR(2); RESC(); ROT();
  }
  #undef CMASK
  #define CMASK(P0,P1,t) do{ if(64*(t)+63+127>=q0+wid*QBLK) tbias(P0,P1,(t),qpos,hi,shm3+LDS_TAB); }while(0)
  #define ENDW(tt) do{ if((tt)+3<NT){WAIT_BAR(2);} else if((tt)+2<NT){WAIT_BAR(1);} else {WAIT_BAR(0);} }while(0)
  for(;t+1<NT;t+=2){
    STEP(pB0,pB1,pA0,pA1,t,(t+3<NT),(t+1<NT),(t+1<NT));       ENDW(t);   RESC(); ROT();
    STEP(pA0,pA1,pB0,pB1,t+1,(t+4<NT),(t+2<NT),(t+2<NT));     ENDW(t+1); RESC(); ROT();
  }
  STEP(pB0,pB1,pA0,pA1,NT-1,false,false,false); RESC();
  { float sacc=pB0[0]+pB0[1]; _Pragma("unroll") for(int r=2;r<16;++r)sacc+=pB0[r]; _Pragma("unroll") for(int r=0;r<16;++r)sacc+=pB1[r]; l_reg+=sacc;
    pw0=(u32x4){PKW(pB0,0),PKW(pB0,2),PKW(pB0,4),PKW(pB0,6)};pw1=(u32x4){PKW(pB0,8),PKW(pB0,10),PKW(pB0,12),PKW(pB0,14)};pw2=(u32x4){PKW(pB1,0),PKW(pB1,2),PKW(pB1,4),PKW(pB1,6)};pw3=(u32x4){PKW(pB1,8),PKW(pB1,10),PKW(pB1,12),PKW(pB1,14)};
    SBAR(); pv(o,vb0+sl_cur,PAF(0),PAF(1),PAF(2),PAF(3)); }
  #undef PKW
  #undef PAF
  #undef VFR
  #undef PIN
  #undef MX3
  #undef GAPA
  #undef GAPB
  #undef EX
  #undef VRD
  #undef KRD
  #undef STEP
  #undef ENDW
  {auto rr=__builtin_amdgcn_permlane32_swap(__float_as_uint(l_reg),__float_as_uint(l_reg),false,false);l_reg=__uint_as_float(rr[0])+__uint_as_float(rr[1]);}
  if(hi==0)wsf[32+r32]=l_reg;asm volatile("s_waitcnt lgkmcnt(0)":::"memory");
  float rli[16];
  #pragma unroll
  for(int r=0;r<16;++r)rli[r]=__builtin_amdgcn_rcpf(wsf[32+crow(r,hi)]);
  bf16*Ow=O+(rowbase+q0+wid*QBLK)*PO+h*D;
  { bf16*stg=(bf16*)(shm+LDS_OST)+wid*2048;
    #pragma unroll
    for(int r=0;r<16;++r){const int orow=crow(r,hi);
      #pragma unroll
      for(int d0=0;d0<2;++d0)stg[orow*64+d0*32+r32]=__float2bfloat16(o[d0][r]*rli[r]);}
    asm volatile("s_waitcnt lgkmcnt(0)":::"memory");
    #pragma unroll
    for(int i=0;i<4;++i){const int row=i*8+(lane>>3),ch=lane&7; const u32x4 v=*(const u32x4*)(stg+row*64+ch*8); ATTN_STORE16(Ow+(long)row*PO+ch*8,v);} }
  asm volatile("s_waitcnt lgkmcnt(0)\n\ts_barrier":::"memory");
  #undef DMA_K
  #undef DMA_V
  #undef CMASK
  #undef START
  #undef RESC
  #undef ROT
}
struct AttnTensors { const bf16* Q; const bf16* K; const bf16* V; bf16* O; const unsigned* MASK; const float* relb; };
struct AttnUnit { int bh; int qb; };
constexpr int ATTN_LDS_BYTES=LDS_TOTAL;
#undef SBAR
#undef WAIT_BAR
}
constexpr int NWAVES = 8;
#ifndef MK_N_LAUNCHES
#define MK_N_LAUNCHES 1
#endif
constexpr int PER_PHASE = 10;
constexpr int N_LAUNCHES = (MK_N_LAUNCHES == 1) ? 1 : PER_PHASE;
constexpr int M = 8 * 2048;
constexpr size_t MiB = 1u << 20;
constexpr size_t WS_CTL = 0, CTL_ZERO_BYTES = 65536;
constexpr size_t WS_RSTD1 = 1 * MiB, WS_ROWSS = 2 * MiB, WS_WR = 3 * MiB, WS_BLAST = 3 * MiB + 512 * 1024, WS_TOKINFO = 4 * MiB, WS_LISTS = 5 * MiB, WS_LSC = 7 * MiB;
constexpr size_t WS_WO = 16 * MiB, WS_WGU = 18 * MiB, WS_WD = 50 * MiB, WS_XB = 66 * MiB, WS_MASK = 66 * MiB, WS_SB = 70 * MiB, WS_EG = 86 * MiB  , WS_WIN = 98 * MiB;
constexpr size_t WS_QN = 106 * MiB, WS_KN = 122 * MiB, WS_VN = 138 * MiB, WS_XN2 = 106 * MiB, WS_IQ = 154 * MiB, WS_MISC = 162 * MiB, WS_QB = 164 * MiB, WS_KB = 172 * MiB, WS_VB = 180 * MiB, WS_RG = 196 * MiB;
constexpr size_t WS_MIX = 212 * MiB, WS_HID = 138 * MiB, WS_Y = 158 * MiB, WS_END = 244 * MiB;
constexpr int CW_TMO = 0, CW_CODE = 1, CW_BAR = 4096, CW_CNT = 15360;
constexpr int RING_BYTES = 154624;
constexpr int LDSCTL_OFF = RING_BYTES, MISC_OFF = LDSCTL_OFF, TOFF_OFF = LDSCTL_OFF + 256;
constexpr int LDS_BYTES = RING_BYTES + 1024;
static_assert(attn_body::ATTN_LDS_BYTES <= RING_BYTES, "attention LDS");
#ifndef REP_IDX
#define REP_IDX 1
#endif
#ifndef REP_GLAA
#define REP_GLAA 1
#endif
#ifndef REP_ATT
#define REP_ATT 1
#endif
#ifndef REP_GLAC
#define REP_GLAC 1
#endif
#ifndef REP_IDX_SCORE
#define REP_IDX_SCORE 1
#endif
#ifndef REP_IDX_SEL
#define REP_IDX_SEL 1
#endif
#ifndef REP_SEL_A
#define REP_SEL_A 1
#endif
#ifndef REP_SEL_B
#define REP_SEL_B 1
#endif
#ifndef REP_SEL_C
#define REP_SEL_C 1
#endif
#ifndef REP_SEL_CNT
#define REP_SEL_CNT 1
#endif
#ifndef REP_SEL_ST
#define REP_SEL_ST 1
#endif
#define GAS __attribute__((address_space(1)))
#define LAS __attribute__((address_space(3)))
typedef unsigned short bf16;
typedef unsigned v4u __attribute__((ext_vector_type(4)));
typedef float f32x4 __attribute__((ext_vector_type(4)));
typedef short bf16x8 __attribute__((ext_vector_type(8)));
typedef GAS unsigned gu32;
typedef GAS unsigned long long gu64;
#define RLX_AGENT __ATOMIC_RELAXED, __HIP_MEMORY_SCOPE_AGENT
#define LDS_WAIT() asm volatile("s_waitcnt lgkmcnt(0)" ::: "memory")
#define VM_WAIT() asm volatile("s_waitcnt vmcnt(0)" ::: "memory")
__device__ __forceinline__ unsigned long long rt() { return __builtin_amdgcn_s_memrealtime(); }
__device__ __forceinline__ unsigned f2bf(float f) { unsigned u = __builtin_bit_cast(unsigned, f); return (u + 0x7fffu + ((u >> 16) & 1u)) >> 16; }
__device__ __forceinline__ unsigned pk2(float lo, float hi) { return f2bf(lo) | (f2bf(hi) << 16); }

#define XB_TMO      128
#define XB_XCNT(j)  (256  + 64 * (j))
#define XB_XSUB(j)  (1280 + 64 * (j))
#define XB_XGEN(j)  (2304 + 64 * (j))
#define XB_TOP      3328
#define XB_TOPGEN   3392
#define XCD_BAR_WORDS 3456
#define XB_SPIN_CAP (1u << 18)

__device__ __forceinline__ unsigned xb_ld(unsigned* p)              { return __hip_atomic_load(p, __ATOMIC_RELAXED, __HIP_MEMORY_SCOPE_AGENT); }
__device__ __forceinline__ unsigned xb_add(unsigned* p, unsigned v) { return __hip_atomic_fetch_add(p, v, __ATOMIC_RELAXED, __HIP_MEMORY_SCOPE_AGENT); }
__device__ __forceinline__ unsigned xb_xcc_id() { return (unsigned)__builtin_amdgcn_s_getreg((3 << 11) | 20) & 0xFu; }
#define XB_SPIN(cond, bar) do { unsigned _sp = 0; while (cond) { __builtin_amdgcn_s_sleep(1); \
    if ((++_sp & 255u) == 0u) { if (xb_ld(&(bar)[XB_TMO])) break; if (_sp > XB_SPIN_CAP) { atomicAdd(&(bar)[XB_TMO], 1u); break; } } } } while (0)

struct XcdBarrier {
    unsigned* bar; unsigned x;
    volatile LAS unsigned* st;
};

__device__ __forceinline__ XcdBarrier xcd_barrier_post(unsigned* bar, volatile LAS unsigned* st) {
    XcdBarrier b; b.bar = bar; b.x = xb_xcc_id(); b.st = st;
    if (threadIdx.x == 0) (void)xb_add(&bar[XB_XCNT(b.x)], 1u);
    return b;
}
__device__ __forceinline__ void xcd_barrier_complete(unsigned* bar, unsigned x, unsigned& nloc, unsigned& nx) {
    const unsigned G = gridDim.x * gridDim.y * gridDim.z;
    unsigned sum, cnt, mine, sp = 0u;
    for (;;) {
        sum = 0u; cnt = 0u; mine = 0u;
#pragma unroll
        for (unsigned j = 0; j < 16; ++j) { const unsigned c = xb_ld(&bar[XB_XCNT(j)]); sum += c; cnt += (c > 0u) ? 1u : 0u; mine = (j == x) ? c : mine; }
        if (sum == G) break;
        __builtin_amdgcn_s_sleep(1);
        if ((++sp & 255u) == 0u) { if (xb_ld(&bar[XB_TMO])) break; if (sp > XB_SPIN_CAP) { atomicAdd(&bar[XB_TMO], 1u); break; } }
    }
    nloc = mine > 0u ? mine : 1u; nx = cnt > 0u ? cnt : 1u;
}

__device__ __forceinline__ void xcd_barrier(const XcdBarrier& b) {
    asm volatile("s_waitcnt vmcnt(0)" ::: "memory");
    __syncthreads();
    if (threadIdx.x == 0) {
        unsigned* bar = b.bar;
        __builtin_amdgcn_s_waitcnt(0);
        unsigned nloc = b.st[0], nx = b.st[1];
        if (nloc == 0u) { xcd_barrier_complete(bar, b.x, nloc, nx); b.st[0] = nloc; b.st[1] = nx; }
        const unsigned old = xb_add(&bar[XB_XSUB(b.x)], 1u);
        const unsigned gen = old / nloc;
        if (old + 1u == (gen + 1u) * nloc) {
            __builtin_amdgcn_fence(__ATOMIC_RELEASE, "agent");
            asm volatile("s_waitcnt vmcnt(0)" ::: "memory");
            const unsigned og = xb_add(&bar[XB_TOP], 1u);
            const unsigned tg = og / nx;
            if (og + 1u == (tg + 1u) * nx) xb_add(&bar[XB_TOPGEN], 1u);
            else XB_SPIN(xb_ld(&bar[XB_TOPGEN]) == tg, bar);
            __builtin_amdgcn_fence(__ATOMIC_ACQUIRE, "agent");
            xb_add(&bar[XB_XGEN(b.x)], 1u);
            asm volatile("s_waitcnt vmcnt(0)" ::: "memory");
        } else {
            XB_SPIN(xb_ld(&bar[XB_XGEN(b.x)]) == gen, bar);
            __builtin_amdgcn_fence(__ATOMIC_ACQUIRE, "agent");
            asm volatile("s_waitcnt vmcnt(0)" ::: "memory");
        }
    }
    __syncthreads();
}
typedef float f32x2 __attribute__((ext_vector_type(2)));
typedef unsigned v2u __attribute__((ext_vector_type(2)));
__device__ __forceinline__ float bf2f(unsigned short b) { return __uint_as_float((unsigned)b << 16); }
__device__ __forceinline__ float bflo(unsigned w) { return __uint_as_float(w << 16); }
__device__ __forceinline__ float bfhi(unsigned w) { return __uint_as_float(w & 0xffff0000u); }
__device__ __forceinline__ float wave_sum(float v) {
#pragma unroll
    for (int o = 1; o < 64; o <<= 1) v += __shfl_xor(v, o);
    return v;
}
__device__ __forceinline__ float wave_max(float v) {
#pragma unroll
    for (int o = 1; o < 64; o <<= 1) v = fmaxf(v, __shfl_xor(v, o));
    return v;
}
__device__ __forceinline__ float wave_min(float v) {
#pragma unroll
    for (int o = 1; o < 64; o <<= 1) v = fminf(v, __shfl_xor(v, o));
    return v;
}
#define WG_SYNC() __syncthreads()
#define DPP_STEP_I(v, ctrl) __builtin_amdgcn_update_dpp(0, (v), (ctrl), 0xF, 0xF, false)
__device__ __forceinline__ int wave_isum(int v) {
    v += DPP_STEP_I(v, 0xB1); v += DPP_STEP_I(v, 0x4E); v += DPP_STEP_I(v, 0x141); v += DPP_STEP_I(v, 0x140);
    return __builtin_amdgcn_readlane(v, 0) + __builtin_amdgcn_readlane(v, 16) + __builtin_amdgcn_readlane(v, 32) + __builtin_amdgcn_readlane(v, 48);
}
#define DPP_STEP_F(v, ctrl) __uint_as_float((unsigned)__builtin_amdgcn_update_dpp(0, (int)__float_as_uint(v), (ctrl), 0xF, 0xF, false))
#define RDL_F(v, l) __uint_as_float((unsigned)__builtin_amdgcn_readlane((int)__float_as_uint(v), (l)))
__device__ __forceinline__ float wave_fsum(float v) {
    v += DPP_STEP_F(v, 0xB1); v += DPP_STEP_F(v, 0x4E); v += DPP_STEP_F(v, 0x141); v += DPP_STEP_F(v, 0x140);
    return (RDL_F(v, 0) + RDL_F(v, 16)) + (RDL_F(v, 32) + RDL_F(v, 48));
}
__device__ __forceinline__ float wave_fmax(float v) {
    v = fmaxf(v, DPP_STEP_F(v, 0xB1)); v = fmaxf(v, DPP_STEP_F(v, 0x4E)); v = fmaxf(v, DPP_STEP_F(v, 0x141)); v = fmaxf(v, DPP_STEP_F(v, 0x140));
    return fmaxf(fmaxf(RDL_F(v, 0), RDL_F(v, 16)), fmaxf(RDL_F(v, 32), RDL_F(v, 48)));
}
__device__ __forceinline__ float wave_fmin(float v) {
    v = fminf(v, DPP_STEP_F(v, 0xB1)); v = fminf(v, DPP_STEP_F(v, 0x4E)); v = fminf(v, DPP_STEP_F(v, 0x141)); v = fminf(v, DPP_STEP_F(v, 0x140));
    return fminf(fminf(RDL_F(v, 0), RDL_F(v, 16)), fminf(RDL_F(v, 32), RDL_F(v, 48)));
}

__device__ __forceinline__ int win_vrow(int n) {
    if (n < 1024) { const int base = (n < 512) ? 0 : 512, m = n - base, hh = m >> 6, d = m & 63; return base + 256 * (hh >> 2) + 128 * (d >> 5) + 32 * (hh & 3) + (d & 31); }
    if (n < 1792) return n;
    if (n < 1832) return 3328 + (n - 1792);
    if (n < 2088) return 1792 + (n - 1832);
    if (n < 2344) return 2048 + (n - 2088);
    if (n < 2856) return 2304 + (n - 2344);
    if (n < 2872) return 3328 + 40 + (n - 2856);
    return 2816 + (n - 2872);
}
template <int KIND>
__device__ __forceinline__ void p0_transpose_item(const float* __restrict__ W, int K, int N, const float* __restrict__ gain, bf16* WT, LAS float* scr, int item, int lane) {
    const int nblk = (N + 31) / 32, kb = item / nblk, nb = item % nblk, k0 = 64 * kb, n0 = 32 * nb;
    f32x4 v[8];
#pragma unroll
    for (int j = 0; j < 8; ++j) { const int i = lane + 64 * j, kk = i >> 3, c4 = (i & 7) * 4; v[j] = (n0 + c4 < N) ? *(const f32x4*)(W + (size_t)(k0 + kk) * N + n0 + c4) : (f32x4){0.f, 0.f, 0.f, 0.f}; }
#pragma unroll
    for (int j = 0; j < 8; ++j) { const int i = lane + 64 * j, kk = i >> 3, c4 = (i & 7) * 4; f32x4 x = v[j]; if (gain) x = x * gain[k0 + kk];
        scr[kk * 33 + c4] = x[0]; scr[kk * 33 + c4 + 1] = x[1]; scr[kk * 33 + c4 + 2] = x[2]; scr[kk * 33 + c4 + 3] = x[3]; }
    LDS_WAIT(); asm volatile("" ::: "memory");
    const int c = lane & 7;
#pragma unroll
    for (int j = 0; j < 4; ++j) { const int n = (lane >> 3) + 8 * j; const LAS float* s = scr + (8 * c) * 33 + n;
        v4u o; o.x = pg8::cvt_pk_bf16(s[0 * 33], s[1 * 33]); o.y = pg8::cvt_pk_bf16(s[2 * 33], s[3 * 33]); o.z = pg8::cvt_pk_bf16(s[4 * 33], s[5 * 33]); o.w = pg8::cvt_pk_bf16(s[6 * 33], s[7 * 33]);
        const int gn = n0 + n; int row;
        if (KIND == 0) row = win_vrow(gn); else if (KIND == 1) row = gn; else if (KIND == 2) row = (gn >> 7) * 256 + (gn & 127); else row = (gn >> 7) * 256 + 128 + (gn & 127);
        if (gn < N) *(GAS v4u*)(WT + (size_t)row * K + k0 + 8 * c) = o; }
    LDS_WAIT(); asm volatile("" ::: "memory");
}

constexpr int SCP = 2064;
__device__ __forceinline__ int crow_(int r, int hi) { return (r & 3) + 8 * (r >> 2) + 4 * hi; }
__device__ __forceinline__ void idx_item(LAS unsigned char* lds, int b, int p, const bf16* __restrict__ IQ, const bf16* __restrict__ MISC, unsigned* __restrict__ MASK, int lane, int wid) {
    const int q0 = p * 16, fr = lane & 15, fq = lane >> 4;
    LAS float* SC = (LAS float*)lds;
    const size_t rowq = (size_t)b * 2048 + q0 + fr;
    bf16x8 Bq[8]; float sinf[8];
    {   const v4u wraw = *(const v4u*)(MISC + rowq * 64 + 32);
        const unsigned wr_[4] = {wraw.x, wraw.y, wraw.z, wraw.w};
#pragma unroll
        for (int h = 0; h < 8; ++h) { const float w = ((h & 1) ? bfhi(wr_[h >> 1]) : bflo(wr_[h >> 1])) * 0.0625f;
            const v4u raw = *(const v4u*)(IQ + rowq * 256 + h * 32 + fq * 8);
            v4u o; o.x = pg8::cvt_pk_bf16(bflo(raw.x) * w, bfhi(raw.x) * w); o.y = pg8::cvt_pk_bf16(bflo(raw.y) * w, bfhi(raw.y) * w); o.z = pg8::cvt_pk_bf16(bflo(raw.z) * w, bfhi(raw.z) * w); o.w = pg8::cvt_pk_bf16(bflo(raw.w) * w, bfhi(raw.w) * w);
            Bq[h] = __builtin_bit_cast(bf16x8, o); sinf[h] = (w > 0.f) ? __builtin_inff() : -__builtin_inff(); } }
    const int nkt = p + 1;
    LAS int* const ROWCTR = (LAS int*)(lds + 16 * SCP * 4);
    if (wid == 0 && lane == 0) ROWCTR[0] = 0;
    const bf16* ikb = MISC + ((size_t)b * 2048 + fr) * 64 + fq * 8;
    for (int rep_ = 0; rep_ < REP_IDX_SCORE; ++rep_)
    for (int kt0 = wid; kt0 < nkt; kt0 += 32) {
        f32x4 acc[4]; bf16x8 A[4];
#pragma unroll
        for (int u = 0; u < 4; ++u) { const int kt = kt0 + 8 * u; acc[u] = (f32x4){0.f, 0.f, 0.f, 0.f}; if (kt < nkt) A[u] = *(const bf16x8*)(ikb + (size_t)kt * 16 * 64); else A[u] = (bf16x8){0, 0, 0, 0, 0, 0, 0, 0}; }
#pragma unroll
        for (int h = 0; h < 8; ++h)
#pragma unroll
            for (int u = 0; u < 4; ++u) { const f32x4 t = __builtin_amdgcn_mfma_f32_16x16x32_bf16(A[u], Bq[h], acc[u], 0, 0, 0);
#pragma unroll
                for (int i = 0; i < 4; ++i) acc[u][i] = __builtin_amdgcn_fmed3f(t[i], acc[u][i], sinf[h]); }
#pragma unroll
        for (int u = 0; u < 4; ++u) { const int kt = kt0 + 8 * u;
            if (kt < nkt) { if (kt == nkt - 1) {
#pragma unroll
                    for (int i = 0; i < 4; ++i) if (4 * fq + i > fr) acc[u][i] = -__builtin_inff(); }
                *(LAS f32x4*)(SC + fr * SCP + kt * 16 + 4 * fq) = acc[u]; } }
    }
    WG_SYNC();
    const int kap = 32 * ((lane >> 4) & 1) + crow_(lane & 15, lane >> 5);
#define IDX_COUNT(dst, expr) do { int cl__ = 0; _Pragma("unroll") for (int g__ = 0; g__ < 4; ++g__) if (8 * g__ < ntile) { _Pragma("unroll") for (int jj__ = 0; jj__ < 8; ++jj__) { const int j = 8 * g__ + jj__; cl__ += (expr) ? 1 : 0; } } \
        dst = wave_isum(cl__); } while (0)
#define IDX_UNI(v) __uint_as_float((unsigned)__builtin_amdgcn_readfirstlane((int)__float_as_uint(v)))
    for (;;) {
        int r = 0; if (lane == 0) r = __hip_atomic_fetch_add(ROWCTR, 1, __ATOMIC_RELAXED, __HIP_MEMORY_SCOPE_WORKGROUP);
        r = __builtin_amdgcn_readfirstlane(r); if (r >= 16) break;
        r = 15 - r;
        const int q = q0 + r, n = q + 1, ntile = (q >> 6) + 1, ngrp = (ntile + 7) >> 3;
        const float NINF = -__builtin_inff();
        float x[32]; unsigned vmask = 0u; float s1 = 0.f, s2 = 0.f;
        const int tb = ntile - 1;
#pragma unroll
        for (int g = 0; g < 4; ++g) {
            if (8 * g + 7 < tb) {
#pragma unroll
                for (int jj = 0; jj < 8; ++jj) x[8 * g + jj] = SC[r * SCP + 64 * (8 * g + jj) + kap];
#pragma unroll
                for (int jj = 0; jj < 8; ++jj) { s1 += x[8 * g + jj]; s2 += x[8 * g + jj] * x[8 * g + jj]; }
                vmask |= 0xFFu << (8 * g);
            } else if (8 * g <= tb) {
#pragma unroll
                for (int jj = 0; jj < 8; ++jj) x[8 * g + jj] = SC[r * SCP + 64 * (8 * g + jj) + kap];
#pragma unroll
                for (int jj = 0; jj < 8; ++jj) { const int j = 8 * g + jj; const bool v = (64 * j + kap) <= q; vmask |= v ? (1u << j) : 0u; const float xv = v ? x[j] : 0.f; x[j] = v ? x[j] : NINF; s1 += xv; s2 += xv * xv; }
            } else {
#pragma unroll
                for (int jj = 0; jj < 8; ++jj) x[8 * g + jj] = NINF;
            }
        }
        unsigned selm = vmask;
        for (int rpb = 0; rpb < REP_SEL_B; ++rpb) { asm volatile("" : "+v"(x[0]), "+v"(vmask)); selm = vmask;
        if (n > 256) {
            const float fn = (float)n, rn = __builtin_amdgcn_rcpf(fn), mu = wave_fsum(s1) * rn, var = fmaxf(wave_fsum(s2) * rn - mu * mu, 0.f), sd = __builtin_amdgcn_sqrtf(var);
            float zq; { const float pq = 256.0f * rn, pp = pq <= 0.5f ? pq : 1.0f - pq; const float t = __builtin_amdgcn_sqrtf(-1.3862943611f * __builtin_amdgcn_logf(fmaxf(pp, 1e-6f)));
                float z = t - (2.30753f + 0.27061f * t) * __builtin_amdgcn_rcpf(1.0f + t * (0.99229f + 0.04481f * t)); zq = pq <= 0.5f ? z : -z; }
            const float sp = sd * __builtin_amdgcn_rcpf(fmaxf(fn * (__builtin_amdgcn_exp2f(-0.7213475204f * zq * zq) * 0.3989422804f), 1e-3f));
            float lo = NINF;
            const float PINF = __builtin_inff();
            float hi = PINF, grow = 1.5f; int c_lo = n, c_hi = 0, side = 0; unsigned lt_lo = 0u, lt_hi = 0xFFFFFFFFu; bool have_lo = false, have_hi = false;
            bool tie = false, found = false, needfinish = false; float tv = 0.f, thr = 0.f; int need = 256;
#pragma unroll 1
            for (int it = 0; it < 48; ++it) {
                if (have_lo && have_hi && (c_lo - c_hi) <= 64) { needfinish = true; break; }
                float mid;
                if (it == 0) mid = mu + zq * sd;
                else if (have_lo && have_hi) {
                    mid = 0.5f * lo + 0.5f * hi;
                    if (side > -2 && side < 2) { const float fr_ = ((float)(c_lo - 256) + 0.5f) * __builtin_amdgcn_rcpf((float)(c_lo - c_hi)); const float m2 = lo + (hi - lo) * fr_; if (m2 > lo && m2 < hi) mid = m2; } else side = 0;
                } else if (have_lo) { mid = lo + ((float)(c_lo - 256) + 4.0f) * sp * grow; grow *= 2.0f; }
                else { mid = hi - ((float)(256 - c_hi) + 4.0f) * sp * grow; grow *= 2.0f; }
                if (!(mid > lo && mid < hi)) { mid = (hi == PINF) ? lo + fabsf(lo) * 0.5f + sp : (lo == NINF) ? hi - fabsf(hi) * 0.5f - sp : 0.5f * lo + 0.5f * hi; if (!(mid > lo && mid < hi)) break; }
                mid = IDX_UNI(mid);
                unsigned a0 = 0u, a1 = 0u;
#pragma unroll
                for (int g = 1; g >= 0; --g) if (g < ngrp) {
#pragma unroll
                    for (int jj = 7; jj >= 0; --jj) a0 = __builtin_amdgcn_alignbit(a0, __float_as_uint(x[8 * g + jj] - mid), 31); }
#pragma unroll
                for (int g = 3; g >= 2; --g) if (g < ngrp) {
#pragma unroll
                    for (int jj = 7; jj >= 0; --jj) a1 = __builtin_amdgcn_alignbit(a1, __float_as_uint(x[8 * g + jj] - mid), 31); }
                const unsigned ltm = a0 | (a1 << 16);
                const int c = 64 * 8 * ngrp - wave_isum(__builtin_popcount(ltm));
                if (c == 256) { found = true; selm = vmask & ~ltm; thr = mid; break; }
                if (c > 256) { lo = mid; c_lo = c; lt_lo = ltm; have_lo = true; side = side > 0 ? side + 1 : 1; } else { hi = mid; c_hi = c; lt_hi = ltm; have_hi = true; side = side < 0 ? side - 1 : -1; }
            }
            if (needfinish) {
                LAS float* CV = (LAS float*)((LAS unsigned char*)SC + 16 * SCP * 4 + 64) + 128 * wid; LAS int* CI = (LAS int*)(CV + 64);
                unsigned cb = lt_hi & ~lt_lo & vmask; int k = 256 - c_hi, base = 0;
                for (;;) { const bool has = cb != 0u; const unsigned long long bal = __ballot(has); if (bal == 0ull) break;
                    if (has) { const int jb = __builtin_ctz(cb); const int key = 64 * jb + kap; const int pos = base + (int)__builtin_amdgcn_mbcnt_hi((unsigned)(bal >> 32), __builtin_amdgcn_mbcnt_lo((unsigned)bal, 0u));
                        CV[pos] = SC[r * SCP + key]; CI[pos] = key; cb &= cb - 1u; }
                    base += __builtin_popcountll(bal); }
                asm volatile("s_waitcnt lgkmcnt(0)" ::: "memory");
                const int m = base; bool active = lane < m; float v_c = active ? CV[lane] : NINF; int i_c = active ? CI[lane] : 0x7fffffff;
                float Tv = 0.f; int Ti = 0;
                for (int qs = 0; qs < 128; ++qs) { const unsigned long long ab = __ballot(active); const int pl = __builtin_ctzll(ab);
                    const float pv = __uint_as_float((unsigned)__builtin_amdgcn_readlane((int)__float_as_uint(v_c), pl)); const int pi = __builtin_amdgcn_readlane(i_c, pl);
                    const bool before = active && ((v_c > pv) || (v_c == pv && i_c < pi)); const int g = __builtin_popcountll(__ballot(before));
                    if (g == k - 1) { Tv = pv; Ti = pi; break; }
                    if (g >= k) active = before; else { k -= g + 1; active = active && !before && (lane != pl); } }
                { const float TvU = IDX_UNI(Tv); unsigned b0 = 0u, b1 = 0u;
#pragma unroll
                  for (int g = 1; g >= 0; --g) if (g < ngrp) {
#pragma unroll
                      for (int jj = 7; jj >= 0; --jj) b0 = __builtin_amdgcn_alignbit(b0, __float_as_uint(x[8 * g + jj] - TvU), 31); }
#pragma unroll
                  for (int g = 3; g >= 2; --g) if (g < ngrp) {
#pragma unroll
                      for (int jj = 7; jj >= 0; --jj) b1 = __builtin_amdgcn_alignbit(b1, __float_as_uint(x[8 * g + jj] - TvU), 31); }
                  const unsigned ltT = b0 | (b1 << 16); selm = vmask & ~ltT;
                  if (64 * 8 * ngrp - wave_isum(__builtin_popcount(ltT)) != 256) {
#pragma unroll
                      for (int jx = 0; jx < 32; ++jx) if (x[jx] == TvU && (64 * jx + kap) > Ti) selm &= ~(1u << jx); } }
            } else
            if (!found) {
                IDX_COUNT(c_hi, x[j] >= hi);
                if (c_hi >= 256) { if (c_hi == 256) { thr = hi; found = true; } else { tie = true; tv = hi; need = 256; } }
                else for (int it = 0; it < 4096; ++it) {
                    float m = NINF;
#pragma unroll
                    for (int g = 0; g < 4; ++g) if (g < ngrp) {
#pragma unroll
                        for (int jj = 0; jj < 8; ++jj) { const int j = 8 * g + jj; m = fmaxf(m, (x[j] < hi) ? x[j] : NINF); } }
                    const float v1 = IDX_UNI(wave_fmax(m));
                    int c; IDX_COUNT(c, x[j] >= v1);
                    if (c >= 256) { if (c == 256) { thr = v1; found = true; } else { tie = true; tv = v1; need = 256 - c_hi; } break; }
                    hi = v1; c_hi = c;
                }
                if (!tie) { selm = 0u;
#pragma unroll
                    for (int j = 0; j < 32; ++j) selm |= (x[j] >= thr) ? (1u << j) : 0u;
                } else {
                    int cum = 0, jstar = 32, needp = 0; unsigned tiem = 0u; selm = 0u;
#pragma unroll
                    for (int j = 0; j < 32; ++j) { const bool t = (x[j] == tv); tiem |= t ? (1u << j) : 0u; const int cj = __builtin_popcountll(__ballot(t));
                        if (jstar == 32 && cum + cj > need) { jstar = j; needp = need - cum; } cum += cj; }
                    const bool tstar = (jstar < 32) && ((tiem >> (jstar & 31)) & 1u);
                    int kL = 0, kH = 63;
                    if (jstar < 32 && needp > 0) { while (kL < kH) { const int km = (kL + kH) >> 1; const int c = __builtin_popcountll(__ballot(tstar && kap <= km)); if (c >= needp) kH = km; else kL = km + 1; } }
                    else kL = -1;
#pragma unroll
                    for (int j = 0; j < 32; ++j) { const bool t = (tiem >> j) & 1u; const bool ts = t && (j < jstar || (j == jstar && kap <= kL)); selm |= (x[j] > tv || ts) ? (1u << j) : 0u; }
                }
            }
        }
        }
        unsigned wlo = 0u, whi = 0u;
        for (int rpc = 0; rpc < REP_SEL_C; ++rpc) { asm volatile("" : "+v"(selm));
#pragma unroll
        for (int g = 0; g < 4; ++g) if (g < ngrp) {
#pragma unroll
            for (int jj = 0; jj < 8; ++jj) { const int j = 8 * g + jj; const unsigned long long bal = __ballot((selm >> j) & 1u); if (lane == j) { wlo = (unsigned)bal; whi = (unsigned)(bal >> 32); } } }
        if (lane < 32) { v2u o; o.x = wlo; o.y = whi; *(v2u*)(MASK + (((size_t)(b * 32 + lane)) * 2048 + q) * 2) = o; }
        }
    }
#undef IDX_COUNT
#undef IDX_UNI
    WG_SYNC();
}

constexpr int KTP = 72;
constexpr int VRP = 136;
constexpr int EP = 68;
constexpr int OTP = 132;
constexpr int GL_OFF = 0, TOT_OFF = 4096, E_OFF = 6144, QA_OFF = 23552, KR_OFF = 32768, PM_OFF = 41984, VR_OFF = 51200, OT_OFF = 68608;
typedef short v4i16g __attribute__((ext_vector_type(4)));
__device__ __forceinline__ bf16x8 tr_frag(const LAS bf16* T, int pitch, int k0, int n0, int lane) {
    const int g = lane >> 4, q = (lane & 15) >> 2, p = lane & 3;
    const LAS bf16* a = T + (k0 + 8 * g + q) * pitch + n0 + 4 * p;
    const v4i16g lo = __builtin_amdgcn_ds_read_tr16_b64_v4i16((LAS v4i16g*)a), hi = __builtin_amdgcn_ds_read_tr16_b64_v4i16((LAS v4i16g*)(a + 4 * pitch));
    return (bf16x8){lo[0], lo[1], lo[2], lo[3], hi[0], hi[1], hi[2], hi[3]};
}
__device__ __forceinline__ float fexp(float x) { return __builtin_amdgcn_exp2f(x * 1.4426950408889634f); }
__device__ __forceinline__ float gla_decay(LAS unsigned char* lds, const bf16* __restrict__ MISC, const float* __restrict__ w2, const float* __restrict__ gb, size_t row0, int h, int tid) {
    LAS float* GL = (LAS float*)(lds + GL_OFF); LAS float* TOT = (LAS float*)(lds + TOT_OFF); LAS float* E = (LAS float*)(lds + E_OFF);
    const int d = tid & 63, tg = tid >> 6;
    { const int t = tid >> 3, r2 = (tid & 7) * 2; const unsigned w = *(const unsigned*)(MISC + (row0 + t) * 64 + 40 + r2); GL[t * 16 + r2] = bflo(w); GL[t * 16 + r2 + 1] = bfhi(w); }
    float wc[16];
#pragma unroll
    for (int r = 0; r < 16; ++r) wc[r] = w2[r * 256 + h * 64 + d];
    const float bias = gb[h * 64 + d];
    WG_SYNC();
    float bc[8]; float run = 0.f;
#pragma unroll
    for (int i = 0; i < 8; ++i) { const int t = 8 * tg + i; float z = bias;
#pragma unroll
        for (int r4 = 0; r4 < 4; ++r4) { const f32x4 g = *(const LAS f32x4*)(GL + t * 16 + 4 * r4); z += g[0] * wc[4 * r4] + g[1] * wc[4 * r4 + 1] + g[2] * wc[4 * r4 + 2] + g[3] * wc[4 * r4 + 3]; }
        const float ls = fminf(z, 0.f) - 0.6931471805599453f * __builtin_amdgcn_logf(1.0f + __builtin_amdgcn_exp2f(-1.4426950408889634f * fabsf(z)));
        run += ls * (1.0f / 16.0f); bc[i] = run; }
    TOT[tg * 64 + d] = run;
    WG_SYNC();
    float pre = 0.f, tot = 0.f;
#pragma unroll
    for (int g = 0; g < 8; ++g) { const float v = TOT[g * 64 + d]; tot += v; if (g < tg) pre += v; }
#pragma unroll
    for (int i = 0; i < 8; ++i) E[(8 * tg + i) * EP + d] = fexp(tot - (bc[i] + pre));
    return tot;
}
__device__ __forceinline__ void gla_load_v(LAS unsigned char* lds, const bf16* __restrict__ VB, size_t row0, int h, int tid) {
    LAS bf16* VR = (LAS bf16*)(lds + VR_OFF); const int t = tid >> 3, v0 = (tid & 7) * 16; const bf16* src = VB + (row0 + t) * 512 + h * 128 + v0;
    const v4u a = *(const v4u*)src, b = *(const v4u*)(src + 8);
    *(LAS v4u*)(VR + t * VRP + v0) = a; *(LAS v4u*)(VR + t * VRP + v0 + 8) = b;
}
__device__ __forceinline__ v4u scale8(v4u raw, const f32x4 e0, const f32x4 e1) {
    v4u o; o.x = pg8::cvt_pk_bf16(bflo(raw.x) * e0[0], bfhi(raw.x) * e0[1]); o.y = pg8::cvt_pk_bf16(bflo(raw.y) * e0[2], bfhi(raw.y) * e0[3]);
    o.z = pg8::cvt_pk_bf16(bflo(raw.z) * e1[0], bfhi(raw.z) * e1[1]); o.w = pg8::cvt_pk_bf16(bflo(raw.w) * e1[2], bfhi(raw.w) * e1[3]); return o;
}
__device__ __forceinline__ void gla_a_item(LAS unsigned char* lds, int id, const bf16* __restrict__ KB, const bf16* __restrict__ VB, const bf16* __restrict__ MISC, const float* __restrict__ w2, const float* __restrict__ gb,
                                           float* __restrict__ U, float* __restrict__ BLAST, float* __restrict__ EG, int tid, int lane, int wid) {
    const int b = id >> 7, h = (id >> 5) & 3, c = id & 31; const size_t row0 = (size_t)b * 2048 + 64 * c;
    const v4u kraw = *(const v4u*)(KB + (row0 + (tid >> 3)) * 256 + h * 64 + (tid & 7) * 8);
    gla_load_v(lds, VB, row0, h, tid);
    const float blast = gla_decay(lds, MISC, w2, gb, row0, h, tid);
    if (tid < 64) BLAST[(size_t)id * 64 + tid] = blast;
    WG_SYNC();
    LAS bf16* KR = (LAS bf16*)(lds + KR_OFF); LAS bf16* VR = (LAS bf16*)(lds + VR_OFF); const LAS float* E = (const LAS float*)(lds + E_OFF);
    { const int t = tid >> 3, d8 = (tid & 7) * 8; const f32x4 e0 = *(const LAS f32x4*)(E + t * EP + d8), e1 = *(const LAS f32x4*)(E + t * EP + d8 + 4); *(LAS v4u*)(KR + t * KTP + d8) = scale8(kraw, e0, e1);
      float* eg = EG + ((size_t)id * 64 + t) * 64 + d8; *(f32x4*)eg = e0; *(f32x4*)(eg + 4) = e1; }
    WG_SYNC();
    const int fr = lane & 15, fq = lane >> 4;
    bf16x8 Bf[2];
#pragma unroll
    for (int kk = 0; kk < 2; ++kk) Bf[kk] = tr_frag(VR, VRP, 32 * kk, 16 * wid, lane);
#pragma unroll
    for (int dt = 0; dt < 4; ++dt) { f32x4 acc = (f32x4){0.f, 0.f, 0.f, 0.f};
#pragma unroll
        for (int kk = 0; kk < 2; ++kk) { const bf16x8 Af = tr_frag(KR, KTP, 32 * kk, 16 * dt, lane); acc = __builtin_amdgcn_mfma_f32_16x16x32_bf16(Af, Bf[kk], acc, 0, 0, 0); }
        *(f32x4*)(U + ((size_t)id * 128 + 16 * wid + fr) * 64 + 16 * dt + 4 * fq) = acc; }
    WG_SYNC();
}
__device__ __forceinline__ void gla_b_item(int item, const float* __restrict__ U, const float* __restrict__ BLAST, bf16* __restrict__ SB, int tid) {
    const int bh = item >> 2, qt = item & 3; const size_t eoff = (size_t)qt * 2048 + (size_t)tid * 4; const int d0 = (tid * 4) & 63;
    f32x4 S = (f32x4){0.f, 0.f, 0.f, 0.f};
#pragma unroll 1
    for (int half = 0; half < 2; ++half) {
        f32x4 u[16], bl[16];
#pragma unroll
        for (int c = 0; c < 16; ++c) { const size_t id = (size_t)bh * 32 + 16 * half + c; u[c] = *(const f32x4*)(U + id * 8192 + eoff); bl[c] = *(const f32x4*)(BLAST + id * 64 + d0); }
#pragma unroll
        for (int c = 0; c < 16; ++c) { const size_t id = (size_t)bh * 32 + 16 * half + c;
            f32x4 e; e[0] = __expf(bl[c][0]); e[1] = __expf(bl[c][1]); e[2] = __expf(bl[c][2]); e[3] = __expf(bl[c][3]);
            const f32x4 sd = S * e; v2u o; o.x = pk2(sd[0], sd[1]); o.y = pk2(sd[2], sd[3]); *(v2u*)(SB + id * 8192 + eoff) = o; S = sd + u[c]; }
    }
}
__device__ __forceinline__ void gla_c_item(LAS unsigned char* lds, int id, const bf16* __restrict__ QB, const bf16* __restrict__ KB, const bf16* __restrict__ VB, const bf16* __restrict__ RG, const float* __restrict__ EG,
                                           const float* __restrict__ og, const bf16* __restrict__ SB, bf16* __restrict__ MIX, int tid, int lane, int wid) {
    const int b = id >> 7, h = (id >> 5) & 3, c = id & 31; const size_t row0 = (size_t)b * 2048 + 64 * c;
    const int st_t = tid >> 3, st_d8 = (tid & 7) * 8;
    const v4u kraw = *(const v4u*)(KB + (row0 + st_t) * 256 + h * 64 + st_d8), qraw = *(const v4u*)(QB + (row0 + st_t) * 256 + h * 64 + st_d8);
    const float* eg = EG + ((size_t)id * 64 + st_t) * 64 + st_d8; const f32x4 e0 = *(const f32x4*)eg, e1 = *(const f32x4*)(eg + 4);
    gla_load_v(lds, VB, row0, h, tid);
    const int fr = lane & 15, fq = lane >> 4;
    bf16x8 Bs[2];
    { const bf16* sbp = SB + ((size_t)id * 128 + 16 * wid + fr) * 64 + 8 * fq; Bs[0] = *(const bf16x8*)sbp; Bs[1] = *(const bf16x8*)(sbp + 32); }
    LAS bf16* QA = (LAS bf16*)(lds + QA_OFF); LAS bf16* KR = (LAS bf16*)(lds + KR_OFF); LAS bf16* PM = (LAS bf16*)(lds + PM_OFF); LAS bf16* VR = (LAS bf16*)(lds + VR_OFF);
    LAS float* OT = (LAS float*)(lds + OT_OFF);
    { f32x4 r0, r1;
#pragma unroll
      for (int i = 0; i < 4; ++i) { r0[i] = 0.125f * __builtin_amdgcn_rcpf(e0[i]); r1[i] = 0.125f * __builtin_amdgcn_rcpf(e1[i]); }
      *(LAS v4u*)(KR + st_t * KTP + st_d8) = scale8(kraw, e0, e1); *(LAS v4u*)(QA + st_t * KTP + st_d8) = scale8(qraw, r0, r1); }
    WG_SYNC();
    { const int tt = wid >> 1;
#pragma unroll
      for (int s2 = 0; s2 < 2; ++s2) { const int st = 2 * (wid & 1) + s2; f32x4 acc = (f32x4){0.f, 0.f, 0.f, 0.f};
        if (st <= tt) {
#pragma unroll
            for (int kk = 0; kk < 2; ++kk) { const bf16x8 Af = *(const LAS bf16x8*)(KR + (16 * st + fr) * KTP + 32 * kk + 8 * fq); const bf16x8 Bf = *(const LAS bf16x8*)(QA + (16 * tt + fr) * KTP + 32 * kk + 8 * fq);
                acc = __builtin_amdgcn_mfma_f32_16x16x32_bf16(Af, Bf, acc, 0, 0, 0); } }
        const int t = 16 * tt + fr, s0 = 16 * st + 4 * fq; v2u o;
        o.x = pg8::cvt_pk_bf16((s0 <= t) ? acc[0] : 0.f, (s0 + 1 <= t) ? acc[1] : 0.f); o.y = pg8::cvt_pk_bf16((s0 + 2 <= t) ? acc[2] : 0.f, (s0 + 3 <= t) ? acc[3] : 0.f);
        *(LAS v2u*)(PM + t * KTP + s0) = o; } }
    WG_SYNC();
    bf16x8 Bv[2];
#pragma unroll
    for (int kk = 0; kk < 2; ++kk) Bv[kk] = tr_frag(VR, VRP, 32 * kk, 16 * wid, lane);
#pragma unroll
    for (int tt = 0; tt < 4; ++tt) { f32x4 acc = (f32x4){0.f, 0.f, 0.f, 0.f};
#pragma unroll
        for (int kk = 0; kk < 2; ++kk) { const bf16x8 Ap = *(const LAS bf16x8*)(PM + (16 * tt + fr) * KTP + 32 * kk + 8 * fq); acc = __builtin_amdgcn_mfma_f32_16x16x32_bf16(Ap, Bv[kk], acc, 0, 0, 0);
                                         const bf16x8 Aq = *(const LAS bf16x8*)(QA + (16 * tt + fr) * KTP + 32 * kk + 8 * fq); acc = __builtin_amdgcn_mfma_f32_16x16x32_bf16(Aq, Bs[kk], acc, 0, 0, 0); }
#pragma unroll
        for (int i = 0; i < 4; ++i) OT[(16 * tt + 4 * fq + i) * OTP + 16 * wid + fr] = acc[i]; }
    WG_SYNC();
    { const int t = tid >> 3, v0 = (tid & 7) * 16; f32x4 ov[4]; float ss = 0.f;
#pragma unroll
      for (int k = 0; k < 4; ++k) { ov[k] = *(const LAS f32x4*)(OT + t * OTP + v0 + 4 * k); ss += (ov[k][0] * ov[k][0] + ov[k][1] * ov[k][1]) + (ov[k][2] * ov[k][2] + ov[k][3] * ov[k][3]); }
      ss += DPP_STEP_F(ss, 0xB1); ss += DPP_STEP_F(ss, 0x4E); ss += DPP_STEP_F(ss, 0x141);
      const float rs = __builtin_amdgcn_rsqf(ss * (1.0f / 128.0f) + 1e-6f);
      const bf16* rgp = RG + (row0 + t) * 512 + h * 128 + v0; const v4u ra = *(const v4u*)rgp, rb = *(const v4u*)(rgp + 8);
      const unsigned rw[8] = {ra.x, ra.y, ra.z, ra.w, rb.x, rb.y, rb.z, rb.w}; unsigned ow[8];
#pragma unroll
      for (int k = 0; k < 4; ++k) { const f32x4 g = *(const f32x4*)(og + v0 + 4 * k); float y[4];
#pragma unroll
          for (int i = 0; i < 4; ++i) { const unsigned w = rw[2 * k + (i >> 1)]; const float r = (i & 1) ? bfhi(w) : bflo(w); const float sg = r * __builtin_amdgcn_rcpf(1.0f + __builtin_amdgcn_exp2f(-1.4426950408889634f * r)); y[i] = ov[k][i] * rs * g[i] * sg; }
          ow[2 * k] = pg8::cvt_pk_bf16(y[0], y[1]); ow[2 * k + 1] = pg8::cvt_pk_bf16(y[2], y[3]); }
      bf16* op = MIX + (row0 + t) * 1024 + 512 + h * 128 + v0;
      *(v4u*)op = (v4u){ow[0], ow[1], ow[2], ow[3]}; *(v4u*)(op + 8) = (v4u){ow[4], ow[5], ow[6], ow[7]}; }
    WG_SYNC();
}

constexpr int WRP = 1032;
constexpr int WR_LDS_BYTES = 48 * WRP * 2;
__device__ __forceinline__ void router_tile(LAS unsigned char* lds, int tile, const bf16* __restrict__ XN2, const float* __restrict__ ROWSS, const float* __restrict__ brg, const float* __restrict__ bre,
                                            unsigned* __restrict__ CNT, int* __restrict__ LISTS, float* __restrict__ LSC, int* __restrict__ TOKINFO, int tid, int lane, int wid) {
    LAS bf16* WR = (LAS bf16*)lds; LAS float* PL = (LAS float*)(lds + WR_LDS_BYTES); LAS unsigned* CL = (LAS unsigned*)(lds + WR_LDS_BYTES + 24576); LAS unsigned* BS = CL + 32;
    if (tid < 32) CL[tid] = 0u;
    const int fr = lane & 15, fq = lane >> 4, rt = wid >> 1, kh = wid & 1;
    {   const size_t row = (size_t)tile * 64 + 16 * rt + fr; const bf16* ap = XN2 + row * 1024 + 512 * kh + 8 * fq;
        bf16x8 Af[16];
#pragma unroll
        for (int kk = 0; kk < 16; ++kk) Af[kk] = *(const bf16x8*)(ap + 32 * kk);
        f32x4 acc[3];
#pragma unroll
        for (int nt = 0; nt < 3; ++nt) acc[nt] = (f32x4){0.f, 0.f, 0.f, 0.f};
#pragma unroll
        for (int kk = 0; kk < 16; ++kk)
#pragma unroll
            for (int nt = 0; nt < 3; ++nt) { const bf16x8 Bf = *(const LAS bf16x8*)(WR + (16 * nt + fr) * WRP + 512 * kh + 32 * kk + 8 * fq); acc[nt] = __builtin_amdgcn_mfma_f32_16x16x32_bf16(Af[kk], Bf, acc[nt], 0, 0, 0); }
#pragma unroll
        for (int nt = 0; nt < 3; ++nt)
#pragma unroll
            for (int i = 0; i < 4; ++i) PL[(wid * 16 + 4 * fq + i) * 48 + 16 * nt + fr] = acc[nt][i];
    }
    WG_SYNC();
    int e_[2] = {0, 0}; unsigned lp[2] = {0u, 0u}; float wk[2] = {0.f, 0.f}; float rstd2 = 0.f; const bool act = tid < 64;
    const int token = tile * 64 + tid;
    if (act) {
        const LAS float* l0 = PL + ((2 * (tid >> 4)) * 16 + (tid & 15)) * 48; const LAS float* l1 = l0 + 16 * 48; float ss = 0.f;
        const f32x4* rp = (const f32x4*)(ROWSS + (size_t)token * 16);
#pragma unroll
        for (int j = 0; j < 4; ++j) { const f32x4 v = rp[j]; ss += (v[0] + v[1]) + (v[2] + v[3]); }
        rstd2 = 1.0f / sqrtf(ss * (1.0f / 1024.0f) + 1e-6f);
        float gl[4]; int gs = 0;
#pragma unroll
        for (int j = 0; j < 4; ++j) gl[j] = (l0[j] + l1[j]) * rstd2 + brg[j];
#pragma unroll
        for (int j = 1; j < 4; ++j) if (gl[j] > gl[gs]) gs = j;
        float den = 0.f;
#pragma unroll
        for (int j = 0; j < 4; ++j) den += __expf(gl[j] - gl[gs]);
        const float gw = 1.0f / den;
        float el[8];
#pragma unroll
        for (int j = 0; j < 8; ++j) el[j] = (l0[4 + gs * 8 + j] + l1[4 + gs * 8 + j]) * rstd2 + bre[gs * 8 + j];
        int i0 = 0;
#pragma unroll
        for (int j = 1; j < 8; ++j) if (el[j] > el[i0]) i0 = j;
        int i1 = (i0 == 0) ? 1 : 0;
#pragma unroll
        for (int j = 0; j < 8; ++j) if (j != i0 && j != i1 && el[j] > el[i1]) i1 = j;
        const float ex = __expf(el[i1] - el[i0]); const float w0 = 1.0f / (1.0f + ex);
        wk[0] = w0 * gw; wk[1] = ex * w0 * gw; e_[0] = gs * 8 + i0; e_[1] = gs * 8 + i1;
        lp[0] = __hip_atomic_fetch_add(CL + e_[0], 1u, __ATOMIC_RELAXED, __HIP_MEMORY_SCOPE_WORKGROUP); lp[1] = __hip_atomic_fetch_add(CL + e_[1], 1u, __ATOMIC_RELAXED, __HIP_MEMORY_SCOPE_WORKGROUP);
    }
    WG_SYNC();
    if (tid < 32) { const unsigned n = CL[tid]; BS[tid] = n ? __hip_atomic_fetch_add(CNT + tid, n, __ATOMIC_RELAXED, __HIP_MEMORY_SCOPE_AGENT) : 0u; }
    WG_SYNC();
    if (act) {
#pragma unroll
        for (int k = 0; k < 2; ++k) { const unsigned pos = BS[e_[k]] + lp[k]; LISTS[(size_t)e_[k] * 16384 + pos] = token; *(f32x2*)(LSC + ((size_t)e_[k] * 16384 + pos) * 2) = (f32x2){rstd2, wk[k]}; }
        *(int4*)(TOKINFO + (size_t)token * 4) = make_int4(e_[0], (int)(BS[e_[0]] + lp[0]), e_[1], (int)(BS[e_[1]] + lp[1]));
    }
    WG_SYNC();
}

template <bool GATHER> struct GroupOrder {
    const LAS int* TOFF; const LAS int* BOFF; const LAS int* CNTL; const int* LISTS; int NPN, G, c; unsigned bstride;
    __device__ bool next(int i, pg8::Unit& u) const {
        const int L = i * G + c; const int ntile = BOFF[32]; if (L >= ntile * NPN) return false;
        const int Tb = L / NPN; int e = 0;
#pragma unroll
        for (int s = 16; s >= 1; s >>= 1) if (BOFF[e + s] <= Tb) e += s;
        const int jt = Tb - BOFF[e];
        u.pm = TOFF[e] + jt; u.pn = L - Tb * NPN; u.e = e; u.p0 = jt * 256; const int rem = CNTL[e] - u.p0; u.nv = rem < 256 ? rem : 256; u.bo = (unsigned)e * bstride; return true;
    }
    __device__ __forceinline__ unsigned arow(const pg8::Unit& u, int r) const {
        if (GATHER) return (unsigned)LISTS[(size_t)u.e * 16384 + u.p0 + (r < u.nv ? r : 0)];
        return (unsigned)(u.pm * 256 + r);
    }
};
__device__ __forceinline__ void skinny_gu(LAS unsigned char* lds, int e, int p0, int rem, int rg, int cb, int slot0, const bf16* __restrict__ XN2, const bf16* __restrict__ WGU, const int* __restrict__ LISTS, const float* __restrict__ LSC, bf16* __restrict__ HID, int lane, int wid) {
    const int fr = lane & 15, fq = lane >> 4; const int r = 16 * rg + fr; const int tok = LISTS[(size_t)e * 16384 + p0 + (r < rem ? r : 0)];
    const bf16* ap = XN2 + (size_t)tok * 1024 + 128 * wid + 8 * fq; const bf16* wb = WGU + (size_t)e * 512 * 1024 + 128 * wid + 8 * fq;
    LAS f32x4* PART = (LAS f32x4*)lds;
    bf16x8 Af[4];
#pragma unroll
    for (int k = 0; k < 4; ++k) Af[k] = *(const bf16x8*)(ap + 32 * k);
#pragma unroll
    for (int nt = 0; nt < 4; ++nt) { const int j = 64 * cb + 16 * nt + fr; const bf16* bp = wb + (size_t)((j >> 7) * 256 + (j & 127)) * 1024;
        bf16x8 Bg[4], Bu[4];
#pragma unroll
        for (int k = 0; k < 4; ++k) { Bg[k] = *(const bf16x8*)(bp + 32 * k); Bu[k] = *(const bf16x8*)(bp + 128 * 1024 + 32 * k); }
        f32x4 ag = (f32x4){0.f, 0.f, 0.f, 0.f}, au = (f32x4){0.f, 0.f, 0.f, 0.f};
#pragma unroll
        for (int k = 0; k < 4; ++k) { ag = __builtin_amdgcn_mfma_f32_16x16x32_bf16(Af[k], Bg[k], ag, 0, 0, 0); au = __builtin_amdgcn_mfma_f32_16x16x32_bf16(Af[k], Bu[k], au, 0, 0, 0); }
        PART[(wid * 8 + nt) * 64 + lane] = ag; PART[(wid * 8 + 4 + nt) * 64 + lane] = au; }
    WG_SYNC();
    if (wid < 4) { const int nt = wid; f32x4 g = (f32x4){0.f, 0.f, 0.f, 0.f}, u = (f32x4){0.f, 0.f, 0.f, 0.f};
#pragma unroll
        for (int w = 0; w < 8; ++w) { g += PART[(w * 8 + nt) * 64 + lane]; u += PART[(w * 8 + 4 + nt) * 64 + lane]; }
#pragma unroll
        for (int i = 0; i < 4; ++i) { const int rr = 16 * rg + 4 * fq + i; if (rr < rem) { const f32x2 sw = *(const f32x2*)(LSC + ((size_t)e * 16384 + p0 + rr) * 2);
            const float a = g[i] * sw.x, uu = u[i] * sw.x; HID[(size_t)(slot0 + rr) * 256 + 64 * cb + 16 * nt + fr] = (bf16)f2bf(a * __builtin_amdgcn_rcpf(1.f + __expf(-a)) * uu * sw.y); } } }
    WG_SYNC();
}
__device__ __forceinline__ void skinny_down(int e, int rem, int rg, int cq, int slot0, const bf16* __restrict__ HID, const bf16* __restrict__ WD, bf16* __restrict__ Y, int lane, int wid) {
    const int fr = lane & 15, fq = lane >> 4; const int r = 16 * rg + fr; const int col0 = 256 * cq + 32 * wid;
    const bf16* ap = HID + (size_t)(slot0 + (r < rem ? r : 0)) * 256 + 8 * fq; const bf16* wb = WD + (size_t)e * 1024 * 256 + (size_t)(col0 + fr) * 256 + 8 * fq;
    bf16x8 Af[8], B0[8], B1[8];
#pragma unroll
    for (int k = 0; k < 8; ++k) { Af[k] = *(const bf16x8*)(ap + 32 * k); B0[k] = *(const bf16x8*)(wb + 32 * k); B1[k] = *(const bf16x8*)(wb + (size_t)16 * 256 + 32 * k); }
    f32x4 a0 = (f32x4){0.f, 0.f, 0.f, 0.f}, a1 = (f32x4){0.f, 0.f, 0.f, 0.f};
#pragma unroll
    for (int k = 0; k < 8; ++k) { a0 = __builtin_amdgcn_mfma_f32_16x16x32_bf16(Af[k], B0[k], a0, 0, 0, 0); a1 = __builtin_amdgcn_mfma_f32_16x16x32_bf16(Af[k], B1[k], a1, 0, 0, 0); }
#pragma unroll
    for (int i = 0; i < 4; ++i) { const int rr = 16 * rg + 4 * fq + i; if (rr < rem) { bf16* yp = Y + (size_t)(slot0 + rr) * 1024 + col0 + fr; yp[0] = (bf16)f2bf(a0[i]); yp[16] = (bf16)f2bf(a1[i]); } }
}
struct Args { const float* in[18]; float* out; unsigned char* ws; int ph_lo, ph_hi, li, pad; };
__global__ void __launch_bounds__(NWAVES * 64, 2) hymba_fwd(Args args) {
    extern __shared__ __attribute__((aligned(16))) unsigned char lds[];
    LAS unsigned char* const L = (LAS unsigned char*)lds;
    volatile LAS unsigned* const MISCW = (volatile LAS unsigned*)(L + MISC_OFF);
    LAS int* const TOFF = (LAS int*)(L + TOFF_OFF); LAS int* const CNTL = TOFF + 40; LAS int* const BOFF = TOFF + 80; LAS int* const SMALL = TOFF + 120;
    const int tid = threadIdx.x, lane = tid & 63, wave = __builtin_amdgcn_readfirstlane(tid >> 6);
    const int G = gridDim.x; const int bx = blockIdx.x; const int vcu = (G % 8 == 0) ? (bx % 8) * (G / 8) + bx / 8 : bx;
    unsigned char* const ws = args.ws;
    gu32* const ctl = (gu32*)(ws + WS_CTL);
    const float* x = args.in[0]; const float* norm1_g = args.in[1]; const float* w_in = args.in[2]; const float* q_norm_g = args.in[3]; const float* k_norm_g = args.in[4];
    const float* rel_bias = args.in[5]; const float* gate_w2 = args.in[6]; const float* gate_b = args.in[7]; const float* out_norm_g = args.in[8]; const float* w_out = args.in[9];
    const float* norm2_g = args.in[10]; const float* w_rg = args.in[11]; const float* b_rg = args.in[12]; const float* w_re = args.in[13]; const float* b_re = args.in[14];
    const float* w_eg = args.in[15]; const float* w_eu = args.in[16]; const float* w_ed = args.in[17];
    float* out = args.out;
    float* RSTD1 = (float*)(ws + WS_RSTD1); float* ROWSS = (float*)(ws + WS_ROWSS); bf16* WR_T = (bf16*)(ws + WS_WR); float* BLAST = (float*)(ws + WS_BLAST);
    int* TOKINFO = (int*)(ws + WS_TOKINFO); int* LISTS = (int*)(ws + WS_LISTS); float* LSC = (float*)(ws + WS_LSC);
    bf16* WO_T = (bf16*)(ws + WS_WO); bf16* WGU_T = (bf16*)(ws + WS_WGU); bf16* WD_T = (bf16*)(ws + WS_WD); bf16* XB = (bf16*)(ws + WS_XB); bf16* WIN_T = (bf16*)(ws + WS_WIN);
    unsigned* MASK = (unsigned*)(ws + WS_MASK); bf16* SB = (bf16*)(ws + WS_SB); float* EG = (float*)(ws + WS_EG);
    bf16* QN = (bf16*)(ws + WS_QN); bf16* KN = (bf16*)(ws + WS_KN); bf16* VN = (bf16*)(ws + WS_VN); bf16* XN2 = (bf16*)(ws + WS_XN2);
    bf16* IQ = (bf16*)(ws + WS_IQ); bf16* MISC = (bf16*)(ws + WS_MISC); bf16* QB = (bf16*)(ws + WS_QB); bf16* KB = (bf16*)(ws + WS_KB); bf16* VB = (bf16*)(ws + WS_VB); bf16* RG = (bf16*)(ws + WS_RG);
    bf16* MIX = (bf16*)(ws + WS_MIX); float* U = (float*)(ws + WS_MIX); bf16* HID = (bf16*)(ws + WS_HID); bf16* Y = (bf16*)(ws + WS_Y);
    unsigned* CNT = (unsigned*)(ctl + CW_CNT);

    for (int u = tid; u < (LDS_BYTES - LDSCTL_OFF) / 4; u += NWAVES * 64) ((LAS unsigned*)(L + LDSCTL_OFF))[u] = 0u;
    __syncthreads();
    const int bli = (N_LAUNCHES == PER_PHASE) ? 0 : args.li;
    XcdBarrier bar; bar.bar = (unsigned*)(ctl + CW_BAR) + bli * XCD_BAR_WORDS; bar.x = 0; bar.st = nullptr;
    if (N_LAUNCHES != PER_PHASE) bar = xcd_barrier_post((unsigned*)(ctl + CW_BAR) + bli * XCD_BAR_WORDS, MISCW + 8);
#define GRID_BAR(seam) do { if (N_LAUNCHES == PER_PHASE) { if (tid == 0) __hip_atomic_store(ctl + CW_TMO, 0xBADBA0u | (unsigned)(seam), RLX_AGENT); } else { xcd_barrier(bar); } } while (0)
    const int lo = args.ph_lo, hi = args.ph_hi;
#define IN(k) (lo <= (k) && (k) < hi)
#define BOTH(k) (IN(k) && IN((k) + 1))
    const int gw = vcu * NWAVES + wave, NGW = G * NWAVES;

    constexpr int I_G = 16 * 8, I_D = 4 * 32, PER_E = 2 * I_G + I_D, NE1 = 18, NE2 = 25;
#define expert_weights(lo_, hi_, w0_, nw_) do { LAS float* scr_ = (LAS float*)(L + wave * 16384); \
        for (int it_ = (lo_) + (w0_); it_ < (hi_); it_ += (nw_)) { const int e_ = it_ / PER_E; int r_ = it_ - e_ * PER_E; \
            if (r_ < I_G) { p0_transpose_item<2>(w_eg + (size_t)e_ * 1024 * 256, 1024, 256, norm2_g, WGU_T + (size_t)e_ * 512 * 1024, scr_, r_, lane); continue; } r_ -= I_G; \
            if (r_ < I_G) { p0_transpose_item<3>(w_eu + (size_t)e_ * 1024 * 256, 1024, 256, norm2_g, WGU_T + (size_t)e_ * 512 * 1024, scr_, r_, lane); continue; } r_ -= I_G; \
            p0_transpose_item<1>(w_ed + (size_t)e_ * 256 * 1024, 256, 1024, nullptr, WD_T + (size_t)e_ * 1024 * 256, scr_, r_, lane); } } while (0)
    if (IN(0)) {
        LAS float* scr = (LAS float*)(L + wave * 16384);
        constexpr int I_IN = 16 * 106, I_O = 16 * 32;
        constexpr int NITEMS = I_IN + I_O;
        for (int it = gw; it < NITEMS; it += NGW) {
            int r = it;
            if (r < I_IN) { p0_transpose_item<0>(w_in, 1024, 3384, norm1_g, WIN_T, scr, r, lane); continue; } r -= I_IN;
            p0_transpose_item<1>(w_out, 1024, 1024, nullptr, WO_T, scr, r, lane);
        }
        expert_weights(NE2 * PER_E, 32 * PER_E, gw, NGW);
        for (int i = bx * (NWAVES * 64) + tid; i < 48 * 1024; i += G * NWAVES * 64) { const int n = i >> 10, k = i & 1023;
            const float v = (n < 4) ? w_rg[k * 4 + n] : (n < 36) ? w_re[k * 32 + (n - 4)] : 0.f; WR_T[i] = (bf16)f2bf(v * norm2_g[k]); }
        for (int m0 = 2 * gw; m0 < M; m0 += 2 * NGW) {
            f32x4 v[2][4]; float s[2];
#pragma unroll
            for (int r = 0; r < 2; ++r) { const GAS f32x4* xr = (const GAS f32x4*)(x + (size_t)(m0 + r) * 1024) + lane;
#pragma unroll
                for (int j = 0; j < 4; ++j) v[r][j] = __builtin_nontemporal_load(xr + 64 * j); }
#pragma unroll
            for (int r = 0; r < 2; ++r) { s[r] = 0.f;
#pragma unroll
                for (int j = 0; j < 4; ++j) s[r] += (v[r][j].x * v[r][j].x + v[r][j].y * v[r][j].y) + (v[r][j].z * v[r][j].z + v[r][j].w * v[r][j].w);
                s[r] = wave_fsum(s[r]); if (lane == 0) RSTD1[m0 + r] = 1.0f / sqrtf(s[r] * (1.0f / 1024.0f) + 1e-6f);
                GAS unsigned long long* o8 = (GAS unsigned long long*)(XB + (size_t)(m0 + r) * 1024) + lane;
#pragma unroll
                for (int j = 0; j < 4; ++j) o8[64 * j] = (unsigned long long)pg8::cvt_pk_bf16(v[r][j].x, v[r][j].y) | ((unsigned long long)pg8::cvt_pk_bf16(v[r][j].z, v[r][j].w) << 32); }
        }
        if (BOTH(0)) GRID_BAR(0);
#if defined(EXTRA_BAR)
        for (int eb = 0; eb < EXTRA_BAR; ++eb) GRID_BAR(0);
#endif
    }
    if (IN(1)) {
        pg8::Gemm g{XB, WIN_T, 1024}; pg8::StaticOrder S; S.init(M, 3584, G, bx);
        pg8::EpiProj E{RSTD1, q_norm_g, k_norm_g, QN, KN, VN, IQ, QB, KB, VB, RG, MISC, 0.125f * 1.4426950408889634f, 1e-6f};
        pg8::gemm_phase<pg8::EpiProj, pg8::StaticOrder, true>(L, g, S, E);
        {
            const int nshort = (896 % G == 0) ? G : G - (896 % G), first = G - nshort;
            if (bx >= first) expert_weights(0, NE1 * PER_E, (bx - first) * NWAVES + wave, nshort * NWAVES); }
        if (BOTH(1)) GRID_BAR(1);
    }
    if (IN(2)) {
        for (int rep = 0; rep < REP_IDX; ++rep)
        for (int it = bx; it < 1024; it += G) { const int b = it & 7, t_ = it >> 3, j_ = t_ >> 5, k0_ = t_ & 31;
            const int p = (j_ == 0) ? k0_ : (j_ == 1) ? 63 - k0_ : (j_ == 2) ? 64 + k0_ : 127 - k0_;
            idx_item(L, b, p, IQ, MISC, MASK, lane, wave); }
        for (int rep = 0; rep < REP_GLAA; ++rep)
        for (int it = bx; it < 1024; it += G) gla_a_item(L, it, KB, VB, MISC, gate_w2, gate_b, U, BLAST, EG, tid, lane, wave);
        if (BOTH(2)) GRID_BAR(2);
    }
    if (IN(3)) {
        for (int it = bx; it < 128; it += G) gla_b_item(it, U, BLAST, SB, tid);
        { const int first = (G > 128) ? 128 : 0, nb = G - first;
          if (bx >= first) expert_weights(NE1 * PER_E, NE2 * PER_E, (bx - first) * NWAVES + wave, nb * NWAVES); }
        if (BOTH(3)) GRID_BAR(3);
    }
    if (IN(4)) {
        const attn_body::AttnTensors AT{(const attn_body::bf16*)QN, (const attn_body::bf16*)KN, (const attn_body::bf16*)VN, (attn_body::bf16*)MIX, MASK, rel_bias};
        for (int rep = 0; rep < REP_ATT; ++rep)
        for (int pr = vcu; pr < 256; pr += G) { const int bh = pr >> 2, s = pr & 3;
            for (int k2 = 0; k2 < 2; ++k2) attn_body::attn_unit<8>(bh >> 3, bh & 7, k2 ? s : 7 - s, AT.Q, AT.K, AT.V, AT.O, AT.MASK, AT.relb, (char*)lds); }
        for (int rep = 0; rep < REP_GLAC; ++rep)
        for (int it = bx; it < 1024; it += G) gla_c_item(L, it, QB, KB, VB, RG, EG, out_norm_g, SB, MIX, tid, lane, wave);
        if (BOTH(4)) GRID_BAR(4);
    }
    if (IN(5)) {
        pg8::Gemm g{MIX, WO_T, 1024}; pg8::StaticOrder S; S.init(M, 1024, G, bx);
        pg8::EpiOut E{x, XN2, ROWSS};
        pg8::gemm_phase<pg8::EpiOut, pg8::StaticOrder, false>(L, g, S, E);
        if (BOTH(5)) GRID_BAR(5);
    }
    if (IN(6)) {
        { LAS bf16* WR = (LAS bf16*)L;
          for (int i = tid; i < 48 * 128; i += NWAVES * 64) { const int n = i >> 7, c8 = i & 127; *(LAS v4u*)(WR + n * WRP + c8 * 8) = *(const v4u*)(WR_T + n * 1024 + c8 * 8); } }
        WG_SYNC();
        for (int tile = bx; tile < 256; tile += G) router_tile(L, tile, XN2, ROWSS, b_rg, b_re, CNT, LISTS, LSC, TOKINFO, tid, lane, wave);
        if (BOTH(6)) GRID_BAR(6);
    }
#define LOAD_TOFF() do { if (tid < 32) CNTL[tid] = (int)__hip_atomic_load(CNT + tid, RLX_AGENT); WG_SYNC(); \
        if (tid == 0) { int acc_ = 0, bacc_ = 0, ns_ = 0; for (int e_ = 0; e_ < 32; ++e_) { const int c_ = CNTL[e_]; TOFF[e_] = acc_; BOFF[e_] = bacc_; \
        const int full_ = c_ >> 8, rem_ = c_ & 255; acc_ += (c_ + 255) >> 8; bacc_ += full_ + (rem_ > 128 ? 1 : 0); if (rem_ > 0 && rem_ <= 128) { SMALL[1 + ns_] = e_; ++ns_; } } TOFF[32] = acc_; BOFF[32] = bacc_; SMALL[0] = ns_; } WG_SYNC(); } while (0)
    if (IN(7)) {
        LOAD_TOFF();
        pg8::Gemm g{XN2, WGU_T, 1024}; GroupOrder<true> S{TOFF, BOFF, CNTL, LISTS, 2, G, vcu, 512u * 1024u * 2u};
        pg8::EpiGU E{LSC, HID};
        pg8::gemm_phase<pg8::EpiGU, GroupOrder<true>, false>(L, g, S, E);
        { const int ns = SMALL[0];
          for (int idx = G - 1 - bx; idx < ns * 32; idx += G) { const int e = SMALL[1 + (idx >> 5)], rg = (idx >> 2) & 7, cb = idx & 3; const int cnt = CNTL[e], full = cnt >> 8, rem = cnt & 255;
              if (16 * rg < rem) skinny_gu(L, e, full * 256, rem, rg, cb, (TOFF[e] + full) * 256, XN2, WGU_T, LISTS, LSC, HID, lane, wave); } }
        if (BOTH(7)) GRID_BAR(7);
    }
    if (IN(8)) {
        LOAD_TOFF();
        pg8::Gemm g{HID, WD_T, 256}; GroupOrder<false> S{TOFF, BOFF, CNTL, LISTS, 4, G, vcu, 1024u * 256u * 2u};
        pg8::EpiDown E{Y};
        pg8::gemm_phase<pg8::EpiDown, GroupOrder<false>, false>(L, g, S, E);
        { const int ns = SMALL[0];
          for (int idx = G - 1 - bx; idx < ns * 32; idx += G) { const int e = SMALL[1 + (idx >> 5)], rg = (idx >> 2) & 7, cq = idx & 3; const int cnt = CNTL[e], full = cnt >> 8, rem = cnt & 255;
              if (16 * rg < rem) skinny_down(e, rem, rg, cq, (TOFF[e] + full) * 256, HID, WD_T, Y, lane, wave); } }
        if (BOTH(8)) GRID_BAR(8);
    }
    if (IN(9)) {
        LOAD_TOFF();
        for (int m0 = 4 * gw; m0 < M; m0 += 4 * NGW) {
            int4 ti[4];
#pragma unroll
            for (int r = 0; r < 4; ++r) ti[r] = *(const int4*)(TOKINFO + (size_t)(m0 + r) * 4);
            v4u av[4][2], b0[4][2], b1[4][2];
#pragma unroll
            for (int r = 0; r < 4; ++r) { const size_t s0 = (size_t)TOFF[ti[r].x] * 256 + ti[r].y, s1 = (size_t)TOFF[ti[r].z] * 256 + ti[r].w;
                const GAS v4u* a = (const GAS v4u*)(XN2 + (size_t)(m0 + r) * 1024) + lane; const GAS v4u* y0 = (const GAS v4u*)(Y + s0 * 1024) + lane; const GAS v4u* y1 = (const GAS v4u*)(Y + s1 * 1024) + lane;
#pragma unroll
                for (int j = 0; j < 2; ++j) { av[r][j] = __builtin_nontemporal_load(a + 64 * j); b0[r][j] = __builtin_nontemporal_load(y0 + 64 * j); b1[r][j] = __builtin_nontemporal_load(y1 + 64 * j); } }
#pragma unroll
            for (int r = 0; r < 4; ++r) { GAS f32x4* o = (GAS f32x4*)(out + (size_t)(m0 + r) * 1024) + 2 * lane;
#pragma unroll
                for (int j = 0; j < 2; ++j) { const v4u a_ = av[r][j], c0 = b0[r][j], c1 = b1[r][j]; f32x4 r0, r1;
                    r0[0] = bflo(a_.x) + bflo(c0.x) + bflo(c1.x); r0[1] = bfhi(a_.x) + bfhi(c0.x) + bfhi(c1.x); r0[2] = bflo(a_.y) + bflo(c0.y) + bflo(c1.y); r0[3] = bfhi(a_.y) + bfhi(c0.y) + bfhi(c1.y);
                    r1[0] = bflo(a_.z) + bflo(c0.z) + bflo(c1.z); r1[1] = bfhi(a_.z) + bfhi(c0.z) + bfhi(c1.z); r1[2] = bflo(a_.w) + bflo(c0.w) + bflo(c1.w); r1[3] = bfhi(a_.w) + bfhi(c0.w) + bfhi(c1.w);
                    __builtin_nontemporal_store(r0, o + 128 * j); __builtin_nontemporal_store(r1, o + 128 * j + 1); } }
        }
    }
#undef IN
#undef BOTH
}

extern "C" void kernel_launch(void* const* d_in, const int* in_sizes, int n_in, void* d_out, int out_size, void* d_ws, size_t ws_size, hipStream_t stream) {
    static int grid = 0;
    if (grid == 0) {
        if (n_in != 18 || out_size != M * 1024 || ws_size < WS_END) { fprintf(stderr, "kernel_launch: unexpected problem shape (n_in %d out %d ws %zu)\n", n_in, out_size, ws_size); grid = -1; return; }
        int dev = 0, cus = 0, per_cu = 0;
        if (hipGetDevice(&dev) != hipSuccess || hipDeviceGetAttribute(&cus, hipDeviceAttributeMultiprocessorCount, dev) != hipSuccess) { grid = -1; return; }
        if (hipFuncSetAttribute((const void*)hymba_fwd, hipFuncAttributeMaxDynamicSharedMemorySize, LDS_BYTES) != hipSuccess) { fprintf(stderr, "kernel_launch: hipFuncSetAttribute failed\n"); grid = -1; return; }
        if (hipOccupancyMaxActiveBlocksPerMultiprocessor(&per_cu, (const void*)hymba_fwd, NWAVES * 64, LDS_BYTES) != hipSuccess || per_cu < 1) { fprintf(stderr, "kernel_launch: occupancy query reports %d\n", per_cu); }
        (void)hipGetLastError();
        grid = cus;
    }
    if (grid < 0) return;
    (void)hipMemsetAsync((char*)d_ws + WS_CTL, 0, CTL_ZERO_BYTES, stream);
    Args a{};
    for (int i = 0; i < 18; ++i) a.in[i] = (const float*)d_in[i];
    a.out = (float*)d_out; a.ws = (unsigned char*)d_ws;
#if defined(PROBE_PHASE)
    { const int k = PROBE_PHASE; a.ph_lo = 0; a.ph_hi = k + 1; a.li = 0; hipLaunchKernelGGL(hymba_fwd, dim3(grid), dim3(NWAVES * 64), LDS_BYTES, stream, a);
      for (int r = 1; r < PROBE_REPS; ++r) { a.ph_lo = k; a.ph_hi = k + 1; a.li = 1; hipLaunchKernelGGL(hymba_fwd, dim3(grid), dim3(NWAVES * 64), LDS_BYTES, stream, a); }
      if (k + 1 < PER_PHASE) { a.ph_lo = k + 1; a.ph_hi = PER_PHASE; a.li = 2; hipLaunchKernelGGL(hymba_fwd, dim3(grid), dim3(NWAVES * 64), LDS_BYTES, stream, a); } }
#else
    if (N_LAUNCHES == 1) { a.ph_lo = 0; a.ph_hi = PER_PHASE; a.li = 0; hipLaunchKernelGGL(hymba_fwd, dim3(grid), dim3(NWAVES * 64), LDS_BYTES, stream, a); }
    else for (int li = 0; li < PER_PHASE; ++li) { a.ph_lo = li; a.ph_hi = li + 1; a.li = li; hipLaunchKernelGGL(hymba_fwd, dim3(grid), dim3(NWAVES * 64), LDS_BYTES, stream, a); }
#endif
}
```

```cpp
#include <hip/hip_runtime.h>
#include <hip/hip_bf16.h>
#include <cstdio>
#include <cstdint>
#include <cmath>
namespace pg8 {
#define PG8_LAS __attribute__((address_space(3)))
typedef unsigned short bf16_t;
typedef short bf16x8 __attribute__((ext_vector_type(8)));
typedef float f32x4 __attribute__((ext_vector_type(4)));
typedef float f32x2 __attribute__((ext_vector_type(2)));
typedef unsigned u32x4 __attribute__((ext_vector_type(4)));
constexpr int BM = 256, BK = 64, HALF = 128, HTB = HALF * BK * 2  , STAGE_BYTES = 8 * HTB, NXCD = 8, WGM = 8;

__host__ __device__ __forceinline__ int lds_byte(int r, int c) { const int st = (r >> 4) * 2 + (c >> 5), rr = r & 15, cc = c & 31, ob = rr * 64 + cc * 2; return st * 1024 + (ob ^ (((ob >> 9) & 1) << 5)); }
__host__ __device__ __forceinline__ void stage_rc(int b, int& R, int& C) { const int st = b / 1024, sb = b % 1024, swz = sb ^ (((sb >> 9) & 1) << 5); R = (st >> 1) * 16 + swz / 64; C = (st & 1) * 32 + (swz % 64) / 2; }
__host__ __device__ __forceinline__ int perm32(int rho) { const int n = rho >> 4, i = rho & 15; return 8 * (i >> 2) + 4 * n + (i & 3); }

struct Unit { int pm, pn; unsigned bo; int e, nv, p0; };
struct Gemm { const bf16_t* A; const bf16_t* Bt; int K; };

struct StaticOrder {
    int nM, nN, nwg, G, c;
    __device__ void init(int M, int N, int G_, int c_) { nM = M / BM; nN = N / BM; nwg = nM * nN; G = G_; c = c_; }
    __device__ bool next(int i, Unit& u) const {
        const long L = (long)i * G + c; if (L >= nwg) return false;
        int wgid = (int)L; { const int q = nwg / NXCD, r = nwg % NXCD, xcd = wgid % NXCD, off = wgid / NXCD; wgid = (xcd < r ? xcd * (q + 1) : r * (q + 1) + (xcd - r) * q) + off; }
        const int nig = WGM * nN, gid = wgid / nig, fm = gid * WGM, gsz = (nM - fm) < WGM ? (nM - fm) : WGM;
        u.pm = fm + ((wgid % nig) % gsz); u.pn = (wgid % nig) / gsz; u.bo = 0u; u.e = 0; u.nv = BM; u.p0 = 0; return true;
    }
    __device__ __forceinline__ unsigned arow(const Unit& u, int r) const { return (unsigned)(u.pm * BM + r); }
};

__device__ __forceinline__ unsigned cvt_pk_bf16(float lo, float hi) { unsigned r; asm volatile("v_cvt_pk_bf16_f32 %0, %1, %2" : "=v"(r) : "v"(lo), "v"(hi)); return r; }

template <class Epi, class Sched, bool ALIGN_EPI = false>
__device__ __forceinline__ void gemm_phase(PG8_LAS unsigned char* lds, const Gemm g, const Sched& S, const Epi& E) {
    const int tid = threadIdx.x, wid = __builtin_amdgcn_readfirstlane(tid >> 6), lane = tid & 63, wr = wid >> 2, wc = wid & 3, fr = lane & 15, fq = lane >> 4;
    const int K = g.K, nt = K / BK;
    int RA[2], CA[2]; unsigned voffB[2];
#pragma unroll
    for (int i = 0; i < 2; ++i) { int R, C; stage_rc(tid * 16 + i * 8192, R, C); const int Rb = ((R & ~31) + perm32(R & 31));
        RA[i] = R; CA[i] = C; voffB[i] = (unsigned)(Rb * K + C) * 2u; }
    const size_t kstep = (size_t)(BK * 2);
    const size_t hstep = (size_t)HALF * K * 2;
    const size_t tstep = 2 * hstep;
    const unsigned ldsw = (unsigned)wid * 1024u;
    const int aoff = lds_byte(wr * 64 + fr, fq * 8), boff = lds_byte(wc * 32 + fr, fq * 8);
#define PG8_SA(b, h) (((b) * 2 + (h)) * HTB)
#define PG8_SB(b, h) ((4 + (b) * 2 + (h)) * HTB)
#define PG8_STAGE(bufoff, gbase, voff) do { _Pragma("unroll") for (int _i = 0; _i < 2; ++_i) \
        __builtin_amdgcn_global_load_lds((const unsigned*)((const char*)(gbase) + (voff)[_i]), (PG8_LAS unsigned*)(lds + (bufoff) + ldsw + _i * 8192), 16, 0, 0); } while (0)
#define PG8_LDA(dst, b, h) do { _Pragma("unroll") for (int m = 0; m < 4; ++m) _Pragma("unroll") for (int k = 0; k < 2; ++k) dst[m][k] = *(const PG8_LAS bf16x8*)(lds + PG8_SA(b, h) + aoff + m * 2048 + k * 1024); } while (0)
#define PG8_LDB(dst, b, h) do { _Pragma("unroll") for (int n = 0; n < 2; ++n) _Pragma("unroll") for (int k = 0; k < 2; ++k) dst[n][k] = *(const PG8_LAS bf16x8*)(lds + PG8_SB(b, h) + boff + n * 2048 + k * 1024); } while (0)
#define PG8_MMA(ai, bj, At, Bt) do { __builtin_amdgcn_s_setprio(1); _Pragma("unroll") for (int m = 0; m < 4; ++m) _Pragma("unroll") for (int n = 0; n < 2; ++n) _Pragma("unroll") for (int k = 0; k < 2; ++k) \
        acc[ai][bj][m][n] = __builtin_amdgcn_mfma_f32_16x16x32_bf16(Bt[n][k], At[m][k], acc[ai][bj][m][n], 0, 0, 0); __builtin_amdgcn_s_setprio(0); } while (0)
#define PG8_WAIT_V(n) asm volatile("s_waitcnt vmcnt(" #n ")" ::: "memory")
#define PG8_WAIT_L(n) asm volatile("s_waitcnt lgkmcnt(" #n ")" ::: "memory")
#define PG8_BAR __builtin_amdgcn_s_barrier()
#define PG8_SCHED __builtin_amdgcn_sched_barrier(0)
#define PG8_AOFF(AO, U) do { _Pragma("unroll") for (int _h = 0; _h < 2; ++_h) _Pragma("unroll") for (int _i = 0; _i < 2; ++_i) \
        AO[_h][_i] = (S.arow(U, _h * HALF + RA[_i]) * (unsigned)K + (unsigned)CA[_i]) * 2u; } while (0)
    Unit cur, nxt; int ui = 0;
    if (!S.next(0, cur)) return;
    f32x4 acc[2][2][4][2];
#pragma unroll
    for (int a = 0; a < 2; ++a)
#pragma unroll
        for (int b = 0; b < 2; ++b)
#pragma unroll
            for (int m = 0; m < 4; ++m)
#pragma unroll
                for (int n = 0; n < 2; ++n) acc[a][b][m][n] = (f32x4){0.f, 0.f, 0.f, 0.f};
    bf16x8 At[4][2], B0[2][2], B1[2][2];
    unsigned aoC[2][2], aoN[2][2];
    PG8_AOFF(aoC, cur);
    const char* const gA = (const char*)g.A;
    const char* cB = (const char*)g.Bt + (size_t)cur.bo + (size_t)cur.pn * tstep;
    {
        PG8_STAGE(PG8_SB(0, 0), cB, voffB); PG8_STAGE(PG8_SB(0, 1), cB + hstep, voffB); PG8_STAGE(PG8_SA(0, 0), gA, aoC[0]); PG8_STAGE(PG8_SA(0, 1), gA, aoC[1]);
        if (wr == 1) PG8_BAR;
        PG8_WAIT_V(2); PG8_BAR;
        PG8_STAGE(PG8_SB(1, 0), cB + kstep, voffB); PG8_STAGE(PG8_SA(1, 0), gA + kstep, aoC[0]); PG8_STAGE(PG8_SB(1, 1), cB + hstep + kstep, voffB);
        PG8_WAIT_V(6); PG8_BAR;
    }
    for (;;) {
        const bool has_next = S.next(ui + 1, nxt);
        if (has_next) { PG8_AOFF(aoN, nxt); } else {
#pragma unroll
            for (int _h = 0; _h < 2; ++_h)
#pragma unroll
                for (int _i = 0; _i < 2; ++_i) aoN[_h][_i] = aoC[_h][_i]; }
        const char* nB = has_next ? (const char*)g.Bt + (size_t)nxt.bo + (size_t)nxt.pn * tstep : cB;
        for (int t = 0; t < nt; t += 2) {
            const bool last = (t == nt - 2);
            const char* a1 = gA + (size_t)(t + 1) * kstep;
            const char* a2 = last ? gA : gA + (size_t)(t + 2) * kstep; const char* b2 = last ? nB : cB + (size_t)(t + 2) * kstep;
            const char* a3 = a2 + kstep; const char* b3 = b2 + kstep;
            unsigned ao2[2][2];
#pragma unroll
            for (int _h = 0; _h < 2; ++_h)
#pragma unroll
                for (int _i = 0; _i < 2; ++_i) ao2[_h][_i] = last ? aoN[_h][_i] : aoC[_h][_i];
            PG8_LDB(B0, 0, 0); PG8_LDB(B1, 0, 1); PG8_SCHED; PG8_LDA(At, 0, 0); PG8_STAGE(PG8_SA(1, 1), a1, aoC[1]);
            PG8_WAIT_V(8); PG8_WAIT_L(0); PG8_BAR; PG8_MMA(0, 0, At, B0); PG8_MMA(0, 1, At, B1); PG8_BAR; PG8_SCHED;
            PG8_LDA(At, 0, 1); PG8_STAGE(PG8_SB(0, 0), b2, voffB); PG8_STAGE(PG8_SB(0, 1), b2 + hstep, voffB); PG8_STAGE(PG8_SA(0, 0), a2, ao2[0]);
            PG8_WAIT_V(8); PG8_WAIT_L(0); PG8_BAR; PG8_MMA(1, 0, At, B0); PG8_MMA(1, 1, At, B1); PG8_BAR; PG8_SCHED;
            PG8_LDB(B0, 1, 0); PG8_LDB(B1, 1, 1); PG8_SCHED; PG8_LDA(At, 1, 0); PG8_STAGE(PG8_SA(0, 1), a2, ao2[1]);
            PG8_WAIT_V(8); PG8_WAIT_L(0); PG8_BAR; PG8_MMA(0, 0, At, B0); PG8_MMA(0, 1, At, B1); PG8_BAR; PG8_SCHED;
            PG8_LDA(At, 1, 1); PG8_STAGE(PG8_SB(1, 0), b3, voffB); PG8_STAGE(PG8_SB(1, 1), b3 + hstep, voffB); PG8_STAGE(PG8_SA(1, 0), a3, ao2[0]);
            PG8_WAIT_V(8); PG8_WAIT_L(0); PG8_BAR; PG8_MMA(1, 0, At, B0); PG8_MMA(1, 1, At, B1); PG8_BAR; PG8_SCHED;
        }
        if constexpr (ALIGN_EPI) { if (wr == 0) PG8_BAR; }
        E(acc, cur, wr, wc, fr, fq);
        if (!has_next) break;
#pragma unroll
        for (int a = 0; a < 2; ++a)
#pragma unroll
            for (int b = 0; b < 2; ++b)
#pragma unroll
                for (int m = 0; m < 4; ++m)
#pragma unroll
                    for (int n = 0; n < 2; ++n) acc[a][b][m][n] = (f32x4){0.f, 0.f, 0.f, 0.f};
        cur = nxt; cB = nB; ++ui;
#pragma unroll
        for (int _h = 0; _h < 2; ++_h)
#pragma unroll
            for (int _i = 0; _i < 2; ++_i) aoC[_h][_i] = aoN[_h][_i];
        if constexpr (ALIGN_EPI) { if (wr == 1) PG8_BAR; }
    }
    PG8_WAIT_V(0);
    if constexpr (!ALIGN_EPI) { if (wr == 0) PG8_BAR; }
    PG8_BAR;
#undef PG8_SA
#undef PG8_SB
#undef PG8_STAGE
#undef PG8_LDA
#undef PG8_LDB
#undef PG8_MMA
#undef PG8_WAIT_V
#undef PG8_WAIT_L
#undef PG8_BAR
#undef PG8_SCHED
#undef PG8_AOFF
}
}
namespace pg8 {
__device__ __forceinline__ float row4_sum(float v) {
    { auto r = __builtin_amdgcn_permlane16_swap(__float_as_uint(v), __float_as_uint(v), false, false); v = __uint_as_float(r[0]) + __uint_as_float(r[1]); }
    { auto r = __builtin_amdgcn_permlane32_swap(__float_as_uint(v), __float_as_uint(v), false, false); v = __uint_as_float(r[0]) + __uint_as_float(r[1]); }
    return v;
}
__device__ __forceinline__ u32x4 pack8(const f32x4 v0, const f32x4 v1) { u32x4 w; w.x = cvt_pk_bf16(v0[0], v0[1]); w.y = cvt_pk_bf16(v0[2], v0[3]); w.z = cvt_pk_bf16(v1[0], v1[1]); w.w = cvt_pk_bf16(v1[2], v1[3]); return w; }

struct EpiProj {
    const float* rstd1; const float* qg; const float* kg;
    bf16_t *QN, *KN, *VN, *IQ, *QB, *KB, *VB, *RG, *MISC;
    float qscale, eps;
    __device__ __forceinline__ void operator()(const f32x4 (&acc)[2][2][4][2], const Unit& u, int wr, int wc, int fr, int fq) const {
        const int row0 = u.pm * BM + wr * 64 + fr; const int pn = u.pn;
        float rs1[2][4];
#pragma unroll
        for (int ai = 0; ai < 2; ++ai)
#pragma unroll
            for (int m = 0; m < 4; ++m) rs1[ai][m] = rstd1[row0 + ai * HALF + m * 16];
        if (pn < 4) {
            const bool isq = pn < 2; const float* gp = isq ? qg : kg; bf16_t* O = isq ? QN : KN; const float os = isq ? qscale : 1.f;
            f32x4 gv[2][2];
#pragma unroll
            for (int bj = 0; bj < 2; ++bj)
#pragma unroll
                for (int n = 0; n < 2; ++n) gv[bj][n] = *(const f32x4*)(gp + 32 * bj + 8 * fq + 4 * n) * os;
            const int hcol = (4 * (pn & 1) + wc) * 64 + 8 * fq;
#pragma unroll
            for (int ai = 0; ai < 2; ++ai)
#pragma unroll
                for (int m = 0; m < 4; ++m) { const int row = row0 + ai * HALF + m * 16; const float s = rs1[ai][m];
                    float ss = 0.f;
#pragma unroll
                    for (int bj = 0; bj < 2; ++bj)
#pragma unroll
                        for (int n = 0; n < 2; ++n) { const f32x4 x = acc[ai][bj][m][n]; ss += (x[0] * x[0] + x[1] * x[1]) + (x[2] * x[2] + x[3] * x[3]); }
                    ss = row4_sum(ss);
                    const float r = s * __builtin_amdgcn_rsqf(s * s * ss * (1.f / 64.f) + eps);
                    bf16_t* rowp = O + (size_t)row * 512 + hcol;
#pragma unroll
                    for (int bj = 0; bj < 2; ++bj) *(u32x4*)(rowp + 32 * bj) = pack8(acc[ai][bj][m][0] * r * gv[bj][0], acc[ai][bj][m][1] * r * gv[bj][1]); }
            return;
        }
        bf16_t* O; int pitch, coff, lim = 256;
        if (pn < 6) { O = VN; pitch = 512; coff = (pn - 4) * 256; }
        else if (pn == 6) { O = IQ; pitch = 256; coff = 0; }
        else if (pn == 7) { O = QB; pitch = 256; coff = 0; }
        else if (pn == 8) { O = KB; pitch = 256; coff = 0; }
        else if (pn < 11) { O = VB; pitch = 512; coff = (pn - 9) * 256; }
        else if (pn < 13) { O = RG; pitch = 512; coff = (pn - 11) * 256; }
        else { O = MISC; pitch = 64; coff = 0; lim = 56; }
        const int c0 = wc * 32 + 8 * fq;
#pragma unroll
        for (int ai = 0; ai < 2; ++ai)
#pragma unroll
            for (int m = 0; m < 4; ++m) { const int row = row0 + ai * HALF + m * 16; const float s = rs1[ai][m];
                bf16_t* rowp = O + (size_t)row * pitch + coff + c0;
#pragma unroll
                for (int bj = 0; bj < 2; ++bj) if (c0 + bj * HALF < lim) *(u32x4*)(rowp + bj * HALF) = pack8(acc[ai][bj][m][0] * s, acc[ai][bj][m][1] * s); }
    }
};

struct EpiOut {
    const float* x; bf16_t* XN2; float* ROWSS;
    __device__ __forceinline__ void operator()(const f32x4 (&acc)[2][2][4][2], const Unit& u, int wr, int wc, int fr, int fq) const {
        const int row0 = u.pm * BM + wr * 64 + fr; const int col0 = u.pn * BM + wc * 32 + 8 * fq;
        f32x4 xv[2][4];
#define EPO_LOAD(buf, g) do { const size_t off_ = (size_t)(row0 + ((g) >> 2) * HALF + ((g) & 3) * 16) * 1024 + col0; \
            xv[buf][0] = *(const f32x4*)(x + off_); xv[buf][1] = *(const f32x4*)(x + off_ + 4); xv[buf][2] = *(const f32x4*)(x + off_ + HALF); xv[buf][3] = *(const f32x4*)(x + off_ + HALF + 4); } while (0)
        EPO_LOAD(0, 0);
#pragma unroll
        for (int g = 0; g < 8; ++g) { const int ai = g >> 2, m = g & 3, cur = g & 1;
            if (g + 1 < 8) EPO_LOAD(cur ^ 1, g + 1);
            const int row = row0 + ai * HALF + m * 16; const size_t off = (size_t)row * 1024 + col0; float ss = 0.f;
#pragma unroll
            for (int bj = 0; bj < 2; ++bj) { const f32x4 a = xv[cur][2 * bj] + acc[ai][bj][m][0], b = xv[cur][2 * bj + 1] + acc[ai][bj][m][1];
                ss += (a[0] * a[0] + a[1] * a[1]) + (a[2] * a[2] + a[3] * a[3]) + (b[0] * b[0] + b[1] * b[1]) + (b[2] * b[2] + b[3] * b[3]);
                *(u32x4*)(XN2 + off + bj * HALF) = pack8(a, b); }
            ss = row4_sum(ss);
            if (fq == 0) ROWSS[(size_t)row * 16 + u.pn * 4 + wc] = ss; }
#undef EPO_LOAD
    }
};

struct EpiGU {
    const float* LSC; bf16_t* HID;
    __device__ __forceinline__ void operator()(const f32x4 (&acc)[2][2][4][2], const Unit& u, int wr, int wc, int fr, int fq) const {
        const int r0 = wr * 64 + fr; const int c0 = u.pn * HALF + wc * 32 + 8 * fq;
#pragma unroll
        for (int ai = 0; ai < 2; ++ai)
#pragma unroll
            for (int m = 0; m < 4; ++m) { const int r = r0 + ai * HALF + m * 16;
                f32x2 sw = (f32x2){0.f, 0.f};
                if (r < u.nv) sw = *(const f32x2*)(LSC + ((size_t)u.e * 16384 + (size_t)(u.p0 + r)) * 2);
                f32x4 h0, h1;
#pragma unroll
                for (int j = 0; j < 4; ++j) { const float a = acc[ai][0][m][0][j] * sw.x, uu = acc[ai][1][m][0][j] * sw.x; h0[j] = a * __builtin_amdgcn_rcpf(1.f + __expf(-a)) * uu * sw.y;
                                              const float a2 = acc[ai][0][m][1][j] * sw.x, u2 = acc[ai][1][m][1][j] * sw.x; h1[j] = a2 * __builtin_amdgcn_rcpf(1.f + __expf(-a2)) * u2 * sw.y; }
                *(u32x4*)(HID + (size_t)(u.pm * BM + r) * 256 + c0) = pack8(h0, h1); }
    }
};
struct EpiDown {
    bf16_t* Y;
    __device__ __forceinline__ void operator()(const f32x4 (&acc)[2][2][4][2], const Unit& u, int wr, int wc, int fr, int fq) const {
        const int r0 = u.pm * BM + wr * 64 + fr; const int c0 = u.pn * BM + wc * 32 + 8 * fq;
#pragma unroll
        for (int ai = 0; ai < 2; ++ai)
#pragma unroll
            for (int m = 0; m < 4; ++m) { bf16_t* rowp = Y + (size_t)(r0 + ai * HALF + m * 16) * 1024 + c0;
#pragma unroll
                for (int bj = 0; bj < 2; ++bj) *(u32x4*)(rowp + bj * HALF) = pack8(acc[ai][bj][m][0], acc[ai][bj][m][1]); }
    }
};
}
namespace attn_body {
using bf16=__hip_bfloat16;
using bf16x8=__attribute__((ext_vector_type(8)))short;
using s16x4=__attribute__((ext_vector_type(4)))short;
using f32x16=__attribute__((ext_vector_type(16)))float;
using u32x4=__attribute__((ext_vector_type(4)))unsigned;
constexpr int BATCH=8,NHEAD=8,SEQ=2048,D=64,DM=NHEAD*D,PO=1024;
constexpr int NW=8,QBLK=32,QB=QBLK*NW,KVBLK=64,NQB=SEQ/QB;
constexpr int ATTN_UNIT_ROWS=QB;
__device__ __forceinline__ int crow(int r,int hi){return (r&3)+8*(r>>2)+4*hi;}
#define SBAR() __builtin_amdgcn_sched_barrier(0)
typedef float f32x4a __attribute__((ext_vector_type(4)));
__device__ __forceinline__ void tbias(f32x16&p0,f32x16&p1,int t,int qpos,int hi,__attribute__((address_space(3))) const char* tabr){
  int base=qpos-64*t-4*hi; base=base<-4?-4:(base>200?200:base); const int a=200-base, s=a&3;
  const __attribute__((address_space(3))) f32x4a* tp=(const __attribute__((address_space(3))) f32x4a*)(tabr+s*1088+(a-s)*4);
  #pragma unroll
  for(int g=0;g<4;++g){ const f32x4a v0=tp[2*g], v1=tp[2*g+8];
    p0[4*g]+=v0[0];p0[4*g+1]+=v0[1];p0[4*g+2]+=v0[2];p0[4*g+3]+=v0[3]; p1[4*g]+=v1[0];p1[4*g+1]+=v1[1];p1[4*g+2]+=v1[2];p1[4*g+3]+=v1[3];
    asm volatile("":"+v"(p0),"+v"(p1)); }
}
__device__ __forceinline__ float mkeep(float v,unsigned mw,int bit){ const unsigned t=(unsigned)(((int)(mw<<(31-bit)))>>31); return __uint_as_float(__float_as_uint(v)&t); }
constexpr int NSLOT=3, SLOTB=8192;
constexpr int LDS_K=0, LDS_V=NSLOT*SLOTB, LDS_WS=2*NSLOT*SLOTB, LDS_OST=LDS_WS+NW*64*4, LDS_BYTES=LDS_OST+NW*4096, LDS_MSK=LDS_BYTES, LDS_TAB=LDS_MSK+65536, LDS_TOTAL=LDS_TAB+4352;
constexpr float C2=0.125f*1.4426950408889634f;
__device__ __forceinline__ void glds16(const void*gsrc,unsigned lds_dst){unsigned keep;
  asm volatile("s_mov_b32 %0, m0\n\ts_mov_b32 m0, %2\n\ts_nop 0\n\tglobal_load_lds_dwordx4 %1, off\n\ts_mov_b32 m0, %0":"=&s"(keep):"v"(gsrc),"s"(lds_dst):"memory");}
__device__ __forceinline__ float max3f(float a,float b,float c){float r;asm("v_max3_f32 %0, %1, %2, %3":"=v"(r):"v"(a),"v"(b),"v"(c));return r;}
__device__ __forceinline__ float max2f(float a,float b){float r;asm("v_max_f32_e32 %0, %1, %2":"=v"(r):"v"(a),"v"(b));return r;}
__device__ __forceinline__ float fadd_s(float a,float b){float r;asm("v_add_f32_e32 %0, %1, %2":"=v"(r):"v"(a),"v"(b));return r;}
__device__ __forceinline__ float fsub_s(float a,float b){float r;asm("v_sub_f32_e32 %0, %1, %2":"=v"(r):"v"(a),"v"(b));return r;}
typedef float f32x2_t __attribute__((ext_vector_type(2))); typedef __bf16 bf16x2_t __attribute__((ext_vector_type(2)));
__device__ __forceinline__ unsigned cvtpk_s(float lo,float hi){f32x2_t v={lo,hi};bf16x2_t b=__builtin_convertvector(v,bf16x2_t);return __builtin_bit_cast(unsigned,b);}
#define WAIT_BAR(N) asm volatile("s_waitcnt vmcnt(" #N ") lgkmcnt(0)\n\ts_barrier":::"memory")

__device__ __forceinline__ void qkt(f32x16&p0,f32x16&p1,const char*Kslot,const bf16x8*qr,const f32x16&negm,int r32,int hi){
  const char*kb=Kslot+hi*1024+r32*16;
  #pragma unroll
  for(int d0=0;d0<4;++d0){
    const bf16x8 b0=*reinterpret_cast<const bf16x8*>(kb+d0*2048);
    const bf16x8 b1=*reinterpret_cast<const bf16x8*>(kb+d0*2048+512);
    if(d0==0){p0=__builtin_amdgcn_mfma_f32_32x32x16_bf16(b0,qr[0],negm,0,0,0);p1=__builtin_amdgcn_mfma_f32_32x32x16_bf16(b1,qr[0],negm,0,0,0);}
    else{p0=__builtin_amdgcn_mfma_f32_32x32x16_bf16(b0,qr[d0],p0,0,0,0);p1=__builtin_amdgcn_mfma_f32_32x32x16_bf16(b1,qr[d0],p1,0,0,0);}}
}
typedef __attribute__((address_space(3))) const char* lds_cptr;
typedef short v4i16_t __attribute__((ext_vector_type(4)));
__device__ __forceinline__ void kload8(bf16x8*kf,lds_cptr kp){
  kf[0]=*(const __attribute__((address_space(3))) bf16x8*)(kp);      kf[1]=*(const __attribute__((address_space(3))) bf16x8*)(kp+512);
  kf[2]=*(const __attribute__((address_space(3))) bf16x8*)(kp+2048); kf[3]=*(const __attribute__((address_space(3))) bf16x8*)(kp+2560);
  kf[4]=*(const __attribute__((address_space(3))) bf16x8*)(kp+4096); kf[5]=*(const __attribute__((address_space(3))) bf16x8*)(kp+4608);
  kf[6]=*(const __attribute__((address_space(3))) bf16x8*)(kp+6144); kf[7]=*(const __attribute__((address_space(3))) bf16x8*)(kp+6656);
}
__device__ __forceinline__ void kload2(bf16x8*kf,lds_cptr kp,int j){ kf[2*j]=*(const __attribute__((address_space(3))) bf16x8*)(kp+j*2048); kf[2*j+1]=*(const __attribute__((address_space(3))) bf16x8*)(kp+j*2048+512); }
__device__ __forceinline__ s16x4 vtr(lds_cptr p){ return __builtin_bit_cast(s16x4,__builtin_amdgcn_ds_read_tr16_b64_v4i16((__attribute__((address_space(3))) v4i16_t*)p)); }
__device__ __forceinline__ float rowmax(const f32x16&p0,const f32x16&p1){
  float a=max3f(p0[0],p0[1],p1[0]),b=max3f(p0[2],p0[3],p1[1]);a=max3f(a,p1[2],p1[3]);
  #pragma unroll
  for(int r=4;r<16;r+=4){a=max3f(a,p0[r],p0[r+1]);b=max3f(b,p0[r+2],p0[r+3]);a=max3f(a,p1[r],p1[r+1]);b=max3f(b,p1[r+2],p1[r+3]);}
  const float m=max2f(a,b);
  auto rr=__builtin_amdgcn_permlane32_swap(__float_as_uint(m),__float_as_uint(m),false,false);
  return max2f(__uint_as_float(rr[0]),__uint_as_float(rr[1]));
}
__device__ __forceinline__ void pv(f32x16*o,int vb,bf16x8 pa0,bf16x8 pa1,bf16x8 pa2,bf16x8 pa3){
  #pragma unroll
  for(int d0=0;d0<2;++d0){s16x4 lo[4],hi[4];
    #pragma unroll
    for(int ks=0;ks<4;++ks){
      asm volatile("ds_read_b64_tr_b16 %0,%1 offset:%c2":"=&v"(lo[ks]):"v"(vb),"i"(d0*4096+ks*1024):"memory");
      asm volatile("ds_read_b64_tr_b16 %0,%1 offset:%c2":"=&v"(hi[ks]):"v"(vb),"i"(d0*4096+ks*1024+512):"memory");}
    asm volatile("s_waitcnt lgkmcnt(0)":::"memory");SBAR();
    #define PK(k) (bf16x8){lo[k][0],lo[k][1],lo[k][2],lo[k][3],hi[k][0],hi[k][1],hi[k][2],hi[k][3]}
    o[d0]=__builtin_amdgcn_mfma_f32_32x32x16_bf16(pa0,PK(0),o[d0],0,0,0);
    o[d0]=__builtin_amdgcn_mfma_f32_32x32x16_bf16(pa1,PK(1),o[d0],0,0,0);
    o[d0]=__builtin_amdgcn_mfma_f32_32x32x16_bf16(pa2,PK(2),o[d0],0,0,0);
    o[d0]=__builtin_amdgcn_mfma_f32_32x32x16_bf16(pa3,PK(3),o[d0],0,0,0);
    #undef PK
  }
}

#ifndef ATTN_STORE16
#define ATTN_STORE16(p,v) (*(u32x4*)(p)=(v))
#endif
template<int THRL> __device__ __forceinline__ void attn_unit(int b,int h,int qb,const bf16*Q,const bf16*__restrict__ K,const bf16*__restrict__ V,bf16*O,const unsigned*__restrict__ MASK,const float*__restrict__ relb,char*shm){
  int tid0_=threadIdx.x; asm volatile("":"+v"(tid0_));
  const int tid=tid0_,lane=tid&63,r32=lane&31,hi=lane>>5; const int wid=__builtin_amdgcn_readfirstlane(tid>>6);
  const long rowbase=(long)b*SEQ; const int q0=qb*QB;
  const bf16*Qw=Q+(rowbase+q0+wid*QBLK)*DM+h*D;
  const bf16*Kh=K+rowbase*DM+h*D,*Vh=V+rowbase*DM+h*D;
  const unsigned lds0=(unsigned)(uintptr_t)shm;
  float*wsf=(float*)(shm+LDS_WS)+wid*64;
  const bf16*ksrc=Kh+(long)lane*DM+wid*8;
  const bf16*vsrc=Vh+(long)(16*(wid&3)+(lane>>2))*DM+(wid>>2)*32+(lane&3)*8;
  const unsigned kdst=lds0+LDS_K+wid*1024, vdst=lds0+LDS_V+wid*1024;
  #define DMA_K(t,slot) glds16(ksrc+(long)(t)*KVBLK*DM,(unsigned)__builtin_amdgcn_readfirstlane(kdst+(slot)))
  #define DMA_V(t,slot) glds16(vsrc+(long)(t)*KVBLK*DM,(unsigned)__builtin_amdgcn_readfirstlane(vdst+(slot)))
  const int vb0=(int)(lds0+LDS_V)+((lane>>4)&1)*32+(lane&3)*8+(4*hi+((lane&15)>>2))*64;
  const char*Kbase=shm+LDS_K; bf16x8 kf[8];
  const lds_cptr shm3=(lds_cptr)shm; const lds_cptr kp0=shm3+LDS_K+hi*1024+r32*16; const lds_cptr vp0=shm3+LDS_V+((lane>>4)&1)*32+(lane&3)*8+(4*hi+((lane&15)>>2))*64;
  const int NT=(q0+QB)/KVBLK;
  const unsigned*mskw=(const unsigned*)(shm+LDS_MSK)+(wid*QBLK+r32)*2+hi;
  const int qpos=q0+wid*QBLK+r32;
  DMA_K(0,0);DMA_V(0,0);DMA_K(1,SLOTB);
  bf16x8 qr[4];
  #pragma unroll
  for(int d0=0;d0<4;++d0)qr[d0]=*reinterpret_cast<const bf16x8*>(&Qw[(long)r32*DM+d0*16+hi*8]);
  float mhat=0.f,l_reg=0.f;f32x16 o[2];o[0]=f32x16{};o[1]=f32x16{};f32x16 negm=f32x16{};asm volatile("":"+v"(negm));
  #define CMASK(P0,P1,t) do{ if((t)>=NT-7 && 64*(t)+63+127>=q0+wid*QBLK) tbias(P0,P1,(t),qpos,hi,shm3+LDS_TAB); }while(0)
  bool resc=false;
  #define START(P0,P1) do{ const float rm=rowmax(P0,P1); resc=false; \
    { const float dl=rm; mhat=fadd_s(mhat,dl); \
      _Pragma("unroll") for(int r=0;r<16;++r){P0[r]=fsub_s(P0[r],dl);P1[r]=fsub_s(P1[r],dl);} \
      _Pragma("unroll") for(int r=0;r<16;++r)negm[r]=-mhat; asm volatile("":"+v"(negm)); } \
    _Pragma("unroll") for(int r=0;r<16;++r)P0[r]=__builtin_amdgcn_exp2f(P0[r]); }while(0)
  #define RESC() do{ if(resc){ asm volatile("s_waitcnt lgkmcnt(0)":::"memory"); \
      _Pragma("unroll") for(int d_=0;d_<2;++d_) _Pragma("unroll") for(int r=0;r<16;++r)o[d_][r]*=wsf[crow(r,hi)]; } }while(0)
  f32x16 pA0,pA1,pB0,pB1;
  int sl_prev=0,sl_cur=0,sl_next=SLOTB;
  #define ROT() do{sl_prev=sl_cur;sl_cur=sl_next;sl_next=(sl_next==(NSLOT-1)*SLOTB)?0:sl_next+SLOTB;}while(0)
  DMA_K(2,2*SLOTB);
  { int tid_=tid; asm volatile("":"+v"(tid_));
    const u32x4*msrc=(const u32x4*)(MASK+((size_t)(b*32)*SEQ+q0)*2); u32x4*mdst=(u32x4*)(shm+LDS_MSK);
    u32x4 mv[8]; const int nit=NT>>2;
    _Pragma("unroll") for(int k=0;k<8;++k){ const int i=tid_+k*(NW*64); if(k<nit) mv[k]=msrc[(size_t)(i>>7)*(SEQ*2/4)+(i&127)]; }
    _Pragma("unroll") for(int k=0;k<8;++k){ const int i=tid_+k*(NW*64); if(k<nit) mdst[i]=mv[k]; }
    for(int i=tid_;i<4*272;i+=NW*64){ const int sft=i/272, k=i-sft*272, d=200-(k+sft); float v=0.f;
      if(d>=0&&d<=112){ int bk; if(d<16)bk=d; else { bk=16+(int)(logf((float)d*(1.0f/16.0f))/2.0794415416798357f*16.0f); bk=bk>31?31:bk; } v=(relb[bk*NHEAD+h]-relb[31*NHEAD+h])*1.4426950408889634f; }
      ((float*)(shm+LDS_TAB))[i]=v; } }
  WAIT_BAR(3);
  qkt(pA0,pA1,Kbase,qr,negm,r32,hi);asm volatile("s_nop 15\n\ts_nop 7":"+v"(pA0),"+v"(pA1));CMASK(pA0,pA1,0);
  START(pA0,pA1);
  _Pragma("unroll") for(int r=0;r<16;++r)pA1[r]=__builtin_amdgcn_exp2f(pA1[r]);
  { const unsigned mw0=mskw[0]; _Pragma("unroll") for(int r=0;r<16;++r){pA0[r]=mkeep(pA0[r],mw0,r);pA1[r]=mkeep(pA1[r],mw0,16+r);} }
  WAIT_BAR(0);
  DMA_K(3,0);DMA_V(1,SLOTB);
  ROT();
  kload8(kf,kp0+sl_cur);
  WAIT_BAR(2);
  s16x4 vlo[8],vhi[8]; u32x4 pw0,pw1,pw2,pw3;
  #define PKW(P,B) cvtpk_s(P[B],P[B+1])
  #define PAF(k) __builtin_bit_cast(bf16x8,pw##k)
  #define VFR(i) (bf16x8){vlo[i][0],vlo[i][1],vlo[i][2],vlo[i][3],vhi[i][0],vhi[i][1],vhi[i][2],vhi[i][3]}
  #define PIN(x) asm volatile("":"+v"(x))
  #define MX3(a,b,c) __builtin_fmaxf(__builtin_fmaxf((a),(b)),(c))
  #define GAPA(MF,A0,A1,A2,A3,W0,W1,PW) do{ MF; sacc+=A0; sacc+=A1; sacc+=A2; sacc+=A3; PIN(sacc); W0; W1; PIN(PW); SBAR(); }while(0)
  #define EX(v) __builtin_amdgcn_exp2f(v)
  #define GAPB(MF,X,B,MB) do{ MF; X[B]=mkeep(EX(X[B]),mw_,MB+B); X[B+1]=mkeep(EX(X[B+1]),mw_,MB+B+1); X[B+2]=mkeep(EX(X[B+2]),mw_,MB+B+2); X[B+3]=mkeep(EX(X[B+3]),mw_,MB+B+3); PIN(X); SBAR(); }while(0)
  #define VRD(i) do{ vlo[i]=vtr(vp_+(((i)>>2)*4096+((i)&3)*1024)); vhi[i]=vtr(vp_+(((i)>>2)*4096+((i)&3)*1024+512)); }while(0)
  #define KRD(G,j) do{ if(G){ kload2(kf,kp0+sl_next,j); SBAR(); } }while(0)
  #define STEP(C0,C1,P0,P1,t,GK,GV,GL) do{ SBAR(); \
    const lds_cptr vp_=vp0+sl_prev; const unsigned mw_=mskw[(t)*512]; \
    VRD(0); SBAR(); float sacc=(P0[0]+P0[1]); \
    GAPA(C0=__builtin_amdgcn_mfma_f32_32x32x16_bf16(kf[0],qr[0],negm,0,0,0), P0[2],P0[3],P0[4],P0[5],     pw0[0]=PKW(P0,0), pw0[1]=PKW(P0,2), pw0); \
    VRD(4); SBAR(); GAPA(C1=__builtin_amdgcn_mfma_f32_32x32x16_bf16(kf[1],qr[0],negm,0,0,0), P0[6],P0[7],P0[8],P0[9],     pw0[2]=PKW(P0,4), pw0[3]=PKW(P0,6), pw0); \
    VRD(1); SBAR(); GAPA(C0=__builtin_amdgcn_mfma_f32_32x32x16_bf16(kf[2],qr[1],C0,0,0,0),   P0[10],P0[11],P0[12],P0[13], pw1[0]=PKW(P0,8), pw1[1]=PKW(P0,10), pw1); \
    VRD(5); SBAR(); GAPA(C1=__builtin_amdgcn_mfma_f32_32x32x16_bf16(kf[3],qr[1],C1,0,0,0),   P0[14],P0[15],P1[0],P1[1],   pw1[2]=PKW(P0,12),pw1[3]=PKW(P0,14), pw1); \
    VRD(2); SBAR(); GAPA(C0=__builtin_amdgcn_mfma_f32_32x32x16_bf16(kf[4],qr[2],C0,0,0,0),   P1[2],P1[3],P1[4],P1[5],     pw2[0]=PKW(P1,0), pw2[1]=PKW(P1,2), pw2); \
    VRD(6); SBAR(); GAPA(C1=__builtin_amdgcn_mfma_f32_32x32x16_bf16(kf[5],qr[2],C1,0,0,0),   P1[6],P1[7],P1[8],P1[9],     pw2[2]=PKW(P1,4), pw2[3]=PKW(P1,6), pw2); \
    VRD(3); SBAR(); GAPA(C0=__builtin_amdgcn_mfma_f32_32x32x16_bf16(kf[6],qr[3],C0,0,0,0),   P1[10],P1[11],P1[12],P1[13], pw3[0]=PKW(P1,8), pw3[1]=PKW(P1,10), pw3); \
    VRD(7); SBAR(); GAPA(C1=__builtin_amdgcn_mfma_f32_32x32x16_bf16(kf[7],qr[3],C1,0,0,0),   P1[14],P1[15],0.f,0.f,       pw3[2]=PKW(P1,12),pw3[3]=PKW(P1,14), pw3); \
    l_reg+=sacc; \
    if(GK){DMA_K((t)+3,sl_cur);} if(GV){DMA_V((t)+1,sl_next);} \
    CMASK(C0,C1,t); \
    { float a=MX3(C0[0],C0[1],C1[0]),b=MX3(C0[2],C0[3],C1[1]); a=MX3(a,C1[2],C1[3]); \
      _Pragma("unroll") for(int r=4;r<16;r+=4){a=MX3(a,C0[r],C0[r+1]);b=MX3(b,C0[r+2],C0[r+3]);a=MX3(a,C1[r],C1[r+1]);b=MX3(b,C1[r+2],C1[r+3]);} \
      float rm=__builtin_fmaxf(a,b); { auto rr=__builtin_amdgcn_permlane32_swap(__float_as_uint(rm),__float_as_uint(rm),false,false); rm=__builtin_fmaxf(__uint_as_float(rr[0]),__uint_as_float(rr[1])); } \
      resc=false; \
      if(__builtin_expect(__any(rm>(float)THRL),0)){ const float dl=__builtin_fmaxf(rm,0.f); mhat+=dl; \
        _Pragma("unroll") for(int r=0;r<16;++r){C0[r]-=dl;C1[r]-=dl;} \
        _Pragma("unroll") for(int r=0;r<16;++r)negm[r]=-mhat; asm volatile("":"+v"(negm)); \
        const float f=__builtin_amdgcn_exp2f(-dl); l_reg*=f; if(hi==0)wsf[r32]=f; resc=true; } } \
    SBAR(); \
    GAPB(o[0]=__builtin_amdgcn_mfma_f32_32x32x16_bf16(PAF(0),VFR(0),o[0],0,0,0), C0,0,0); \
    GAPB(o[1]=__builtin_amdgcn_mfma_f32_32x32x16_bf16(PAF(0),VFR(4),o[1],0,0,0), C0,4,0); \
    KRD(GL,0); GAPB(o[0]=__builtin_amdgcn_mfma_f32_32x32x16_bf16(PAF(1),VFR(1),o[0],0,0,0), C0,8,0); \
    KRD(GL,1); GAPB(o[1]=__builtin_amdgcn_mfma_f32_32x32x16_bf16(PAF(1),VFR(5),o[1],0,0,0), C0,12,0); \
    KRD(GL,2); GAPB(o[0]=__builtin_amdgcn_mfma_f32_32x32x16_bf16(PAF(2),VFR(2),o[0],0,0,0), C1,0,16); \
    KRD(GL,3); GAPB(o[1]=__builtin_amdgcn_mfma_f32_32x32x16_bf16(PAF(2),VFR(6),o[1],0,0,0), C1,4,16); \
    GAPB(o[0]=__builtin_amdgcn_mfma_f32_32x32x16_bf16(PAF(3),VFR(3),o[0],0,0,0), C1,8,16); \
    GAPB(o[1]=__builtin_amdgcn_mfma_f32_32x32x16_bf16(PAF(3),VFR(7),o[1],0,0,0), C1,12,16); \
    }while(0)
  int t=1;
  #undef CMASK
  #define CMASK(P0,P1,t) do{}while(0)
  for(;t+7<NT;t+=2){
    STEP(pB0,pB1,pA0,pA1,t,true,true,true);     WAIT_BAR(2); RESC(); ROT();
    STEP(pA0,pA1,pB0,pB1,t+1,true,true,true);   WAIT_BAR(2); RESC(); ROT();
  }
  #undef CMASK
  #define CMASK(P0,P1,t) do{ if(64*(t)+63+127>=q0+wid*QBLK) tbias(P0,P1,(t),qpos,hi,shm3+LDS_TAB); }while(0)
  #define ENDW(tt) do{ if((tt)+3<NT){WAIT_BAR(2);} else if((tt)+2<NT){WAIT_BAR(1);} else {WAIT_BAR(0);} }while(0)
  for(;t+1<NT;t+=2){
    STEP(pB0,pB1,pA0,pA1,t,(t+3<NT),(t+1<NT),(t+1<NT));       ENDW(t);   RESC(); ROT();
    STEP(pA0,pA1,pB0,pB1,t+1,(t+4<NT),(t+2<NT),(t+2<NT));     ENDW(t+1); RESC(); ROT();
  }
  STEP(pB0,pB1,pA0,pA1,NT-1,false,false,false); RESC();
  { float sacc=pB0[0]+pB0[1]; _Pragma("unroll") for(int r=2;r<16;++r)sacc+=pB0[r]; _Pragma("unroll") for(int r=0;r<16;++r)sacc+=pB1[r]; l_reg+=sacc;
    pw0=(u32x4){PKW(pB0,0),PKW(pB0,2),PKW(pB0,4),PKW(pB0,6)};pw1=(u32x4){PKW(pB0,8),PKW(pB0,10),PKW(pB0,12),PKW(pB0,14)};pw2=(u32x4){PKW(pB1,0),PKW(pB1,2),PKW(pB1,4),PKW(pB1,6)};pw3=(u32x4){PKW(pB1,8),PKW(pB1,10),PKW(pB1,12),PKW(pB1,14)};
    SBAR(); pv(o,vb0+sl_cur,PAF(0),PAF(1),PAF(2),PAF(3)); }
  #undef PKW
  #undef PAF
  #undef VFR
  #undef PIN
  #undef MX3
  #undef GAPA
  #undef GAPB
  #undef EX
  #undef VRD
  #undef KRD
  #undef STEP
  #undef ENDW
  {auto rr=__builtin_amdgcn_permlane32_swap(__float_as_uint(l_reg),__float_as_uint(l_reg),false,false);l_reg=__uint_as_float(rr[0])+__uint_as_float(rr[1]);}
  if(hi==0)wsf[32+r32]=l_reg;asm volatile("s_waitcnt lgkmcnt(0)":::"memory");
  float rli[16];
  #pragma unroll
  for(int r=0;r<16;++r)rli[r]=__builtin_amdgcn_rcpf(wsf[32+crow(r,hi)]);
  bf16*Ow=O+(rowbase+q0+wid*QBLK)*PO+h*D;
  { bf16*stg=(bf16*)(shm+LDS_OST)+wid*2048;
    #pragma unroll
    for(int r=0;r<16;++r){const int orow=crow(r,hi);
      #pragma unroll
      for(int d0=0;d0<2;++d0)stg[orow*64+d0*32+r32]=__float2bfloat16(o[d0][r]*rli[r]);}
    asm volatile("s_waitcnt lgkmcnt(0)":::"memory");
    #pragma unroll
    for(int i=0;i<4;++i){const int row=i*8+(lane>>3),ch=lane&7; const u32x4 v=*(const u32x4*)(stg+row*64+ch*8); ATTN_STORE16(Ow+(long)row*PO+ch*8,v);} }
  asm volatile("s_waitcnt lgkmcnt(0)\n\ts_barrier":::"memory");
  #undef DMA_K
  #undef DMA_V
  #undef CMASK
  #undef START
  #undef RESC
  #undef ROT
}
struct AttnTensors { const bf16* Q; const bf16* K; const bf16* V; bf16* O; const unsigned* MASK; const float* relb; };
struct AttnUnit { int bh; int qb; };
constexpr int ATTN_LDS_BYTES=LDS_TOTAL;
#undef SBAR
#undef WAIT_BAR
}
constexpr int NWAVES = 8;
#ifndef MK_N_LAUNCHES
#define MK_N_LAUNCHES 1
#endif
constexpr int PER_PHASE = 10;
constexpr int N_LAUNCHES = (MK_N_LAUNCHES == 1) ? 1 : PER_PHASE;
constexpr int M = 8 * 2048;
constexpr size_t MiB = 1u << 20;
constexpr size_t WS_CTL = 0, CTL_ZERO_BYTES = 65536;
constexpr size_t WS_RSTD1 = 1 * MiB, WS_ROWSS = 2 * MiB, WS_WR = 3 * MiB, WS_BLAST = 3 * MiB + 512 * 1024, WS_TOKINFO = 4 * MiB, WS_LISTS = 5 * MiB, WS_LSC = 7 * MiB;
constexpr size_t WS_WO = 16 * MiB, WS_WGU = 18 * MiB, WS_WD = 50 * MiB, WS_XB = 66 * MiB, WS_MASK = 66 * MiB, WS_SB = 70 * MiB, WS_EG = 86 * MiB  , WS_WIN = 98 * MiB;
constexpr size_t WS_QN = 106 * MiB, WS_KN = 122 * MiB, WS_VN = 138 * MiB, WS_XN2 = 106 * MiB, WS_IQ = 154 * MiB, WS_MISC = 162 * MiB, WS_QB = 164 * MiB, WS_KB = 172 * MiB, WS_VB = 180 * MiB, WS_RG = 196 * MiB;
constexpr size_t WS_MIX = 212 * MiB, WS_HID = 138 * MiB, WS_Y = 158 * MiB, WS_END = 244 * MiB;
constexpr int CW_TMO = 0, CW_CODE = 1, CW_BAR = 4096, CW_CNT = 15360;
constexpr int RING_BYTES = 154624;
constexpr int LDSCTL_OFF = RING_BYTES, MISC_OFF = LDSCTL_OFF, TOFF_OFF = LDSCTL_OFF + 256;
constexpr int LDS_BYTES = RING_BYTES + 1024;
static_assert(attn_body::ATTN_LDS_BYTES <= RING_BYTES, "attention LDS");
#ifndef REP_IDX
#define REP_IDX 1
#endif
#ifndef REP_GLAA
#define REP_GLAA 1
#endif
#ifndef REP_ATT
#define REP_ATT 1
#endif
#ifndef REP_GLAC
#define REP_GLAC 1
#endif
#ifndef REP_IDX_SCORE
#define REP_IDX_SCORE 1
#endif
#ifndef REP_IDX_SEL
#define REP_IDX_SEL 1
#endif
#ifndef REP_SEL_A
#define REP_SEL_A 1
#endif
#ifndef REP_SEL_B
#define REP_SEL_B 1
#endif
#ifndef REP_SEL_C
#define REP_SEL_C 1
#endif
#ifndef REP_SEL_CNT
#define REP_SEL_CNT 1
#endif
#ifndef REP_SEL_ST
#define REP_SEL_ST 1
#endif
#define GAS __attribute__((address_space(1)))
#define LAS __attribute__((address_space(3)))
typedef unsigned short bf16;
typedef unsigned v4u __attribute__((ext_vector_type(4)));
typedef float f32x4 __attribute__((ext_vector_type(4)));
typedef short bf16x8 __attribute__((ext_vector_type(8)));
typedef GAS unsigned gu32;
typedef GAS unsigned long long gu64;
#define RLX_AGENT __ATOMIC_RELAXED, __HIP_MEMORY_SCOPE_AGENT
#define LDS_WAIT() asm volatile("s_waitcnt lgkmcnt(0)" ::: "memory")
#define VM_WAIT() asm volatile("s_waitcnt vmcnt(0)" ::: "memory")
__device__ __forceinline__ unsigned long long rt() { return __builtin_amdgcn_s_memrealtime(); }
__device__ __forceinline__ unsigned f2bf(float f) { unsigned u = __builtin_bit_cast(unsigned, f); return (u + 0x7fffu + ((u >> 16) & 1u)) >> 16; }
__device__ __forceinline__ unsigned pk2(float lo, float hi) { return f2bf(lo) | (f2bf(hi) << 16); }

#define XB_TMO      128
#define XB_XCNT(j)  (256  + 64 * (j))
#define XB_XSUB(j)  (1280 + 64 * (j))
#define XB_XGEN(j)  (2304 + 64 * (j))
#define XB_TOP      3328
#define XB_TOPGEN   3392
#define XCD_BAR_WORDS 3456
#define XB_SPIN_CAP (1u << 18)

__device__ __forceinline__ unsigned xb_ld(unsigned* p)              { return __hip_atomic_load(p, __ATOMIC_RELAXED, __HIP_MEMORY_SCOPE_AGENT); }
__device__ __forceinline__ unsigned xb_add(unsigned* p, unsigned v) { return __hip_atomic_fetch_add(p, v, __ATOMIC_RELAXED, __HIP_MEMORY_SCOPE_AGENT); }
__device__ __forceinline__ unsigned xb_xcc_id() { return (unsigned)__builtin_amdgcn_s_getreg((3 << 11) | 20) & 0xFu; }
#define XB_SPIN(cond, bar) do { unsigned _sp = 0; while (cond) { __builtin_amdgcn_s_sleep(1); \
    if ((++_sp & 255u) == 0u) { if (xb_ld(&(bar)[XB_TMO])) break; if (_sp > XB_SPIN_CAP) { atomicAdd(&(bar)[XB_TMO], 1u); break; } } } } while (0)

struct XcdBarrier {
    unsigned* bar; unsigned x;
    volatile LAS unsigned* st;
};

__device__ __forceinline__ XcdBarrier xcd_barrier_post(unsigned* bar, volatile LAS unsigned* st) {
    XcdBarrier b; b.bar = bar; b.x = xb_xcc_id(); b.st = st;
    if (threadIdx.x == 0) (void)xb_add(&bar[XB_XCNT(b.x)], 1u);
    return b;
}
__device__ __forceinline__ void xcd_barrier_complete(unsigned* bar, unsigned x, unsigned& nloc, unsigned& nx) {
    const unsigned G = gridDim.x * gridDim.y * gridDim.z;
    unsigned sum, cnt, mine, sp = 0u;
    for (;;) {
        sum = 0u; cnt = 0u; mine = 0u;
#pragma unroll
        for (unsigned j = 0; j < 16; ++j) { const unsigned c = xb_ld(&bar[XB_XCNT(j)]); sum += c; cnt += (c > 0u) ? 1u : 0u; mine = (j == x) ? c : mine; }
        if (sum == G) break;
        __builtin_amdgcn_s_sleep(1);
        if ((++sp & 255u) == 0u) { if (xb_ld(&bar[XB_TMO])) break; if (sp > XB_SPIN_CAP) { atomicAdd(&bar[XB_TMO], 1u); break; } }
    }
    nloc = mine > 0u ? mine : 1u; nx = cnt > 0u ? cnt : 1u;
}

__device__ __forceinline__ void xcd_barrier(const XcdBarrier& b) {
    asm volatile("s_waitcnt vmcnt(0)" ::: "memory");
    __syncthreads();
    if (threadIdx.x == 0) {
        unsigned* bar = b.bar;
        __builtin_amdgcn_s_waitcnt(0);
        unsigned nloc = b.st[0], nx = b.st[1];
        if (nloc == 0u) { xcd_barrier_complete(bar, b.x, nloc, nx); b.st[0] = nloc; b.st[1] = nx; }
        const unsigned old = xb_add(&bar[XB_XSUB(b.x)], 1u);
        const unsigned gen = old / nloc;
        if (old + 1u == (gen + 1u) * nloc) {
            __builtin_amdgcn_fence(__ATOMIC_RELEASE, "agent");
            asm volatile("s_waitcnt vmcnt(0)" ::: "memory");
            const unsigned og = xb_add(&bar[XB_TOP], 1u);
            const unsigned tg = og / nx;
            if (og + 1u == (tg + 1u) * nx) xb_add(&bar[XB_TOPGEN], 1u);
            else XB_SPIN(xb_ld(&bar[XB_TOPGEN]) == tg, bar);
            __builtin_amdgcn_fence(__ATOMIC_ACQUIRE, "agent");
            xb_add(&bar[XB_XGEN(b.x)], 1u);
            asm volatile("s_waitcnt vmcnt(0)" ::: "memory");
        } else {
            XB_SPIN(xb_ld(&bar[XB_XGEN(b.x)]) == gen, bar);
            __builtin_amdgcn_fence(__ATOMIC_ACQUIRE, "agent");
            asm volatile("s_waitcnt vmcnt(0)" ::: "memory");
        }
    }
    __syncthreads();
}
typedef float f32x2 __attribute__((ext_vector_type(2)));
typedef unsigned v2u __attribute__((ext_vector_type(2)));
__device__ __forceinline__ float bf2f(unsigned short b) { return __uint_as_float((unsigned)b << 16); }
__device__ __forceinline__ float bflo(unsigned w) { return __uint_as_float(w << 16); }
__device__ __forceinline__ float bfhi(unsigned w) { return __uint_as_float(w & 0xffff0000u); }
__device__ __forceinline__ float wave_sum(float v) {
#pragma unroll
    for (int o = 1; o < 64; o <<= 1) v += __shfl_xor(v, o);
    return v;
}
__device__ __forceinline__ float wave_max(float v) {
#pragma unroll
    for (int o = 1; o < 64; o <<= 1) v = fmaxf(v, __shfl_xor(v, o));
    return v;
}
__device__ __forceinline__ float wave_min(float v) {
#pragma unroll
    for (int o = 1; o < 64; o <<= 1) v = fminf(v, __shfl_xor(v, o));
    return v;
}
#define WG_SYNC() __syncthreads()
#define DPP_STEP_I(v, ctrl) __builtin_amdgcn_update_dpp(0, (v), (ctrl), 0xF, 0xF, false)
__device__ __forceinline__ int wave_isum(int v) {
    v += DPP_STEP_I(v, 0xB1); v += DPP_STEP_I(v, 0x4E); v += DPP_STEP_I(v, 0x141); v += DPP_STEP_I(v, 0x140);
    return __builtin_amdgcn_readlane(v, 0) + __builtin_amdgcn_readlane(v, 16) + __builtin_amdgcn_readlane(v, 32) + __builtin_amdgcn_readlane(v, 48);
}
#define DPP_STEP_F(v, ctrl) __uint_as_float((unsigned)__builtin_amdgcn_update_dpp(0, (int)__float_as_uint(v), (ctrl), 0xF, 0xF, false))
#define RDL_F(v, l) __uint_as_float((unsigned)__builtin_amdgcn_readlane((int)__float_as_uint(v), (l)))
__device__ __forceinline__ float wave_fsum(float v) {
    v += DPP_STEP_F(v, 0xB1); v += DPP_STEP_F(v, 0x4E); v += DPP_STEP_F(v, 0x141); v += DPP_STEP_F(v, 0x140);
    return (RDL_F(v, 0) + RDL_F(v, 16)) + (RDL_F(v, 32) + RDL_F(v, 48));
}
__device__ __forceinline__ float wave_fmax(float v) {
    v = fmaxf(v, DPP_STEP_F(v, 0xB1)); v = fmaxf(v, DPP_STEP_F(v, 0x4E)); v = fmaxf(v, DPP_STEP_F(v, 0x141)); v = fmaxf(v, DPP_STEP_F(v, 0x140));
    return fmaxf(fmaxf(RDL_F(v, 0), RDL_F(v, 16)), fmaxf(RDL_F(v, 32), RDL_F(v, 48)));
}
__device__ __forceinline__ float wave_fmin(float v) {
    v = fminf(v, DPP_STEP_F(v, 0xB1)); v = fminf(v, DPP_STEP_F(v, 0x4E)); v = fminf(v, DPP_STEP_F(v, 0x141)); v = fminf(v, DPP_STEP_F(v, 0x140));
    return fminf(fminf(RDL_F(v, 0), RDL_F(v, 16)), fminf(RDL_F(v, 32), RDL_F(v, 48)));
}

__device__ __forceinline__ int win_vrow(int n) {
    if (n < 1024) { const int base = (n < 512) ? 0 : 512, m = n - base, hh = m >> 6, d = m & 63; return base + 256 * (hh >> 2) + 128 * (d >> 5) + 32 * (hh & 3) + (d & 31); }
    if (n < 1792) return n;
    if (n < 1832) return 3328 + (n - 1792);
    if (n < 2088) return 1792 + (n - 1832);
    if (n < 2344) return 2048 + (n - 2088);
    if (n < 2856) return 2304 + (n - 2344);
    if (n < 2872) return 3328 + 40 + (n - 2856);
    return 2816 + (n - 2872);
}
template <int KIND>
__device__ __forceinline__ void p0_transpose_item(const float* __restrict__ W, int K, int N, const float* __restrict__ gain, bf16* WT, LAS float* scr, int item, int lane) {
    const int nblk = (N + 31) / 32, kb = item / nblk, nb = item % nblk, k0 = 64 * kb, n0 = 32 * nb;
    f32x4 v[8];
#pragma unroll
    for (int j = 0; j < 8; ++j) { const int i = lane + 64 * j, kk = i >> 3, c4 = (i & 7) * 4; v[j] = (n0 + c4 < N) ? *(const f32x4*)(W + (size_t)(k0 + kk) * N + n0 + c4) : (f32x4){0.f, 0.f, 0.f, 0.f}; }
#pragma unroll
    for (int j = 0; j < 8; ++j) { const int i = lane + 64 * j, kk = i >> 3, c4 = (i & 7) * 4; f32x4 x = v[j]; if (gain) x = x * gain[k0 + kk];
        scr[kk * 33 + c4] = x[0]; scr[kk * 33 + c4 + 1] = x[1]; scr[kk * 33 + c4 + 2] = x[2]; scr[kk * 33 + c4 + 3] = x[3]; }
    LDS_WAIT(); asm volatile("" ::: "memory");
    const int c = lane & 7;
#pragma unroll
    for (int j = 0; j < 4; ++j) { const int n = (lane >> 3) + 8 * j; const LAS float* s = scr + (8 * c) * 33 + n;
        v4u o; o.x = pg8::cvt_pk_bf16(s[0 * 33], s[1 * 33]); o.y = pg8::cvt_pk_bf16(s[2 * 33], s[3 * 33]); o.z = pg8::cvt_pk_bf16(s[4 * 33], s[5 * 33]); o.w = pg8::cvt_pk_bf16(s[6 * 33], s[7 * 33]);
        const int gn = n0 + n; int row;
        if (KIND == 0) row = win_vrow(gn); else if (KIND == 1) row = gn; else if (KIND == 2) row = (gn >> 7) * 256 + (gn & 127); else row = (gn >> 7) * 256 + 128 + (gn & 127);
        if (gn < N) *(GAS v4u*)(WT + (size_t)row * K + k0 + 8 * c) = o; }
    LDS_WAIT(); asm volatile("" ::: "memory");
}

constexpr int SCP = 2064;
__device__ __forceinline__ int crow_(int r, int hi) { return (r & 3) + 8 * (r >> 2) + 4 * hi; }
__device__ __forceinline__ void idx_item(LAS unsigned char* lds, int b, int p, const bf16* __restrict__ IQ, const bf16* __restrict__ MISC, unsigned* __restrict__ MASK, int lane, int wid) {
    const int q0 = p * 16, fr = lane & 15, fq = lane >> 4;
    LAS float* SC = (LAS float*)lds;
    const size_t rowq = (size_t)b * 2048 + q0 + fr;
    bf16x8 Bq[8]; float sinf[8];
    {   const v4u wraw = *(const v4u*)(MISC + rowq * 64 + 32);
        const unsigned wr_[4] = {wraw.x, wraw.y, wraw.z, wraw.w};
#pragma unroll
        for (int h = 0; h < 8; ++h) { const float w = ((h & 1) ? bfhi(wr_[h >> 1]) : bflo(wr_[h >> 1])) * 0.0625f;
            const v4u raw = *(const v4u*)(IQ + rowq * 256 + h * 32 + fq * 8);
            v4u o; o.x = pg8::cvt_pk_bf16(bflo(raw.x) * w, bfhi(raw.x) * w); o.y = pg8::cvt_pk_bf16(bflo(raw.y) * w, bfhi(raw.y) * w); o.z = pg8::cvt_pk_bf16(bflo(raw.z) * w, bfhi(raw.z) * w); o.w = pg8::cvt_pk_bf16(bflo(raw.w) * w, bfhi(raw.w) * w);
            Bq[h] = __builtin_bit_cast(bf16x8, o); sinf[h] = (w > 0.f) ? __builtin_inff() : -__builtin_inff(); } }
    const int nkt = p + 1;
    LAS int* const ROWCTR = (LAS int*)(lds + 16 * SCP * 4);
    if (wid == 0 && lane == 0) ROWCTR[0] = 0;
    const bf16* ikb = MISC + ((size_t)b * 2048 + fr) * 64 + fq * 8;
    for (int rep_ = 0; rep_ < REP_IDX_SCORE; ++rep_)
    for (int kt0 = wid; kt0 < nkt; kt0 += 32) {
        f32x4 acc[4]; bf16x8 A[4];
#pragma unroll
        for (int u = 0; u < 4; ++u) { const int kt = kt0 + 8 * u; acc[u] = (f32x4){0.f, 0.f, 0.f, 0.f}; if (kt < nkt) A[u] = *(const bf16x8*)(ikb + (size_t)kt * 16 * 64); else A[u] = (bf16x8){0, 0, 0, 0, 0, 0, 0, 0}; }
#pragma unroll
        for (int h = 0; h < 8; ++h)
#pragma unroll
            for (int u = 0; u < 4; ++u) { const f32x4 t = __builtin_amdgcn_mfma_f32_16x16x32_bf16(A[u], Bq[h], acc[u], 0, 0, 0);
#pragma unroll
                for (int i = 0; i < 4; ++i) acc[u][i] = __builtin_amdgcn_fmed3f(t[i], acc[u][i], sinf[h]); }
#pragma unroll
        for (int u = 0; u < 4; ++u) { const int kt = kt0 + 8 * u;
            if (kt < nkt) { if (kt == nkt - 1) {
#pragma unroll
                    for (int i = 0; i < 4; ++i) if (4 * fq + i > fr) acc[u][i] = -__builtin_inff(); }
                *(LAS f32x4*)(SC + fr * SCP + kt * 16 + 4 * fq) = acc[u]; } }
    }
    WG_SYNC();
    const int kap = 32 * ((lane >> 4) & 1) + crow_(lane & 15, lane >> 5);
#define IDX_COUNT(dst, expr) do { int cl__ = 0; _Pragma("unroll") for (int g__ = 0; g__ < 4; ++g__) if (8 * g__ < ntile) { _Pragma("unroll") for (int jj__ = 0; jj__ < 8; ++jj__) { const int j = 8 * g__ + jj__; cl__ += (expr) ? 1 : 0; } } \
        dst = wave_isum(cl__); } while (0)
#define IDX_UNI(v) __uint_as_float((unsigned)__builtin_amdgcn_readfirstlane((int)__float_as_uint(v)))
    for (;;) {
        int r = 0; if (lane == 0) r = __hip_atomic_fetch_add(ROWCTR, 1, __ATOMIC_RELAXED, __HIP_MEMORY_SCOPE_WORKGROUP);
        r = __builtin_amdgcn_readfirstlane(r); if (r >= 16) break;
        r = 15 - r;
        const int q = q0 + r, n = q + 1, ntile = (q >> 6) + 1, ngrp = (ntile + 7) >> 3;
        const float NINF = -__builtin_inff();
        float x[32]; unsigned vmask = 0u; float s1 = 0.f, s2 = 0.f;
        const int tb = ntile - 1;
#pragma unroll
        for (int g = 0; g < 4; ++g) {
            if (8 * g + 7 < tb) {
#pragma unroll
                for (int jj = 0; jj < 8; ++jj) x[8 * g + jj] = SC[r * SCP + 64 * (8 * g + jj) + kap];
                if (g == 0) {
#pragma unroll
                    for (int jj = 0; jj < 8; ++jj) { s1 += x[jj]; s2 += x[jj] * x[jj]; } }
                vmask |= 0xFFu << (8 * g);
            } else if (8 * g <= tb) {
#pragma unroll
                for (int jj = 0; jj < 8; ++jj) x[8 * g + jj] = SC[r * SCP + 64 * (8 * g + jj) + kap];
#pragma unroll
                for (int jj = 0; jj < 8; ++jj) { const int j = 8 * g + jj; const bool v = (64 * j + kap) <= q; vmask |= v ? (1u << j) : 0u; if (g == 0) { const float xv = v ? x[j] : 0.f; s1 += xv; s2 += xv * xv; } x[j] = v ? x[j] : NINF; }
            } else {
#pragma unroll
                for (int jj = 0; jj < 8; ++jj) x[8 * g + jj] = NINF;
            }
        }
        unsigned selm = vmask;
        for (int rpb = 0; rpb < REP_SEL_B; ++rpb) { asm volatile("" : "+v"(x[0]), "+v"(vmask)); selm = vmask;
        if (n > 256) {
            const float fn = (float)n, rn = __builtin_amdgcn_rcpf(fn), rs = __builtin_amdgcn_rcpf((float)(n < 512 ? n : 512)), mu = wave_fsum(s1) * rs, var = fmaxf(wave_fsum(s2) * rs - mu * mu, 0.f), sd = __builtin_amdgcn_sqrtf(var);
            float zq; { const float pq = 256.0f * rn, pp = pq <= 0.5f ? pq : 1.0f - pq; const float t = __builtin_amdgcn_sqrtf(-1.3862943611f * __builtin_amdgcn_logf(fmaxf(pp, 1e-6f)));
                float z = t - (2.30753f + 0.27061f * t) * __builtin_amdgcn_rcpf(1.0f + t * (0.99229f + 0.04481f * t)); zq = pq <= 0.5f ? z : -z; }
            const float sp = sd * __builtin_amdgcn_rcpf(fmaxf(fn * (__builtin_amdgcn_exp2f(-0.7213475204f * zq * zq) * 0.3989422804f), 1e-3f));
            float lo = NINF;
            const float PINF = __builtin_inff();
            float hi = PINF, grow = 1.5f; int c_lo = n, c_hi = 0, side = 0; unsigned lt_lo = 0u, lt_hi = 0xFFFFFFFFu; bool have_lo = false, have_hi = false;
            bool tie = false, found = false, needfinish = false; float tv = 0.f, thr = 0.f; int need = 256;
#pragma unroll 1
            for (int it = 0; it < 48; ++it) {
                if (have_lo && have_hi && (c_lo - c_hi) <= 64) { needfinish = true; break; }
                float mid;
                if (it == 0) mid = mu + zq * sd;
                else if (have_lo && have_hi) {
                    mid = 0.5f * lo + 0.5f * hi;
                    if (side > -2 && side < 2) { const float fr_ = ((float)(c_lo - 256) + 0.5f) * __builtin_amdgcn_rcpf((float)(c_lo - c_hi)); const float m2 = lo + (hi - lo) * fr_; if (m2 > lo && m2 < hi) mid = m2; } else side = 0;
                } else if (have_lo) { mid = lo + ((float)(c_lo - 256) + 4.0f) * sp * grow; grow *= 2.0f; }
                else { mid = hi - ((float)(256 - c_hi) + 4.0f) * sp * grow; grow *= 2.0f; }
                if (!(mid > lo && mid < hi)) { mid = (hi == PINF) ? lo + fabsf(lo) * 0.5f + sp : (lo == NINF) ? hi - fabsf(hi) * 0.5f - sp : 0.5f * lo + 0.5f * hi; if (!(mid > lo && mid < hi)) break; }
                mid = IDX_UNI(mid);
                unsigned a0 = 0u, a1 = 0u;
#pragma unroll
                for (int g = 1; g >= 0; --g) if (g < ngrp) {
#pragma unroll
                    for (int jj = 7; jj >= 0; --jj) a0 = __builtin_amdgcn_alignbit(a0, __float_as_uint(x[8 * g + jj] - mid), 31); }
#pragma unroll
                for (int g = 3; g >= 2; --g) if (g < ngrp) {
#pragma unroll
                    for (int jj = 7; jj >= 0; --jj) a1 = __builtin_amdgcn_alignbit(a1, __float_as_uint(x[8 * g + jj] - mid), 31); }
                const unsigned ltm = a0 | (a1 << 16);
                const int c = 64 * 8 * ngrp - wave_isum(__builtin_popcount(ltm));
                if (c == 256) { found = true; selm = vmask & ~ltm; thr = mid; break; }
                if (c > 256) { lo = mid; c_lo = c; lt_lo = ltm; have_lo = true; side = side > 0 ? side + 1 : 1; } else { hi = mid; c_hi = c; lt_hi = ltm; have_hi = true; side = side < 0 ? side - 1 : -1; }
            }
            if (needfinish) {
                LAS float* CV = (LAS float*)((LAS unsigned char*)SC + 16 * SCP * 4 + 64) + 128 * wid; LAS int* CI = (LAS int*)(CV + 64);
                unsigned cb = lt_hi & ~lt_lo & vmask; int k = 256 - c_hi, base = 0;
                for (;;) { const bool has = cb != 0u; const unsigned long long bal = __ballot(has); if (bal == 0ull) break;
                    if (has) { const int jb = __builtin_ctz(cb); const int key = 64 * jb + kap; const int pos = base + (int)__builtin_amdgcn_mbcnt_hi((unsigned)(bal >> 32), __builtin_amdgcn_mbcnt_lo((unsigned)bal, 0u));
                        CV[pos] = SC[r * SCP + key]; CI[pos] = key; cb &= cb - 1u; }
                    base += __builtin_popcountll(bal); }
                asm volatile("s_waitcnt lgkmcnt(0)" ::: "memory");
                const int m = base; bool active = lane < m; float v_c = active ? CV[lane] : NINF; int i_c = active ? CI[lane] : 0x7fffffff;
                float Tv = 0.f; int Ti = 0;
                for (int qs = 0; qs < 128; ++qs) { const unsigned long long ab = __ballot(active); const int pl = __builtin_ctzll(ab);
                    const float pv = __uint_as_float((unsigned)__builtin_amdgcn_readlane((int)__float_as_uint(v_c), pl)); const int pi = __builtin_amdgcn_readlane(i_c, pl);
                    const bool before = active && ((v_c > pv) || (v_c == pv && i_c < pi)); const int g = __builtin_popcountll(__ballot(before));
                    if (g == k - 1) { Tv = pv; Ti = pi; break; }
                    if (g >= k) active = before; else { k -= g + 1; active = active && !before && (lane != pl); } }
                { const float TvU = IDX_UNI(Tv); unsigned b0 = 0u, b1 = 0u;
#pragma unroll
                  for (int g = 1; g >= 0; --g) if (g < ngrp) {
#pragma unroll
                      for (int jj = 7; jj >= 0; --jj) b0 = __builtin_amdgcn_alignbit(b0, __float_as_uint(x[8 * g + jj] - TvU), 31); }
#pragma unroll
                  for (int g = 3; g >= 2; --g) if (g < ngrp) {
#pragma unroll
                      for (int jj = 7; jj >= 0; --jj) b1 = __builtin_amdgcn_alignbit(b1, __float_as_uint(x[8 * g + jj] - TvU), 31); }
                  const unsigned ltT = b0 | (b1 << 16); selm = vmask & ~ltT;
                  if (64 * 8 * ngrp - wave_isum(__builtin_popcount(ltT)) != 256) {
#pragma unroll
                      for (int jx = 0; jx < 32; ++jx) if (x[jx] == TvU && (64 * jx + kap) > Ti) selm &= ~(1u << jx); } }
            } else
            if (!found) {
                IDX_COUNT(c_hi, x[j] >= hi);
                if (c_hi >= 256) { if (c_hi == 256) { thr = hi; found = true; } else { tie = true; tv = hi; need = 256; } }
                else for (int it = 0; it < 4096; ++it) {
                    float m = NINF;
#pragma unroll
                    for (int g = 0; g < 4; ++g) if (g < ngrp) {
#pragma unroll
                        for (int jj = 0; jj < 8; ++jj) { const int j = 8 * g + jj; m = fmaxf(m, (x[j] < hi) ? x[j] : NINF); } }
                    const float v1 = IDX_UNI(wave_fmax(m));
                    int c; IDX_COUNT(c, x[j] >= v1);
                    if (c >= 256) { if (c == 256) { thr = v1; found = true; } else { tie = true; tv = v1; need = 256 - c_hi; } break; }
                    hi = v1; c_hi = c;
                }
                if (!tie) { selm = 0u;
#pragma unroll
                    for (int j = 0; j < 32; ++j) selm |= (x[j] >= thr) ? (1u << j) : 0u;
                } else {
                    int cum = 0, jstar = 32, needp = 0; unsigned tiem = 0u; selm = 0u;
#pragma unroll
                    for (int j = 0; j < 32; ++j) { const bool t = (x[j] == tv); tiem |= t ? (1u << j) : 0u; const int cj = __builtin_popcountll(__ballot(t));
                        if (jstar == 32 && cum + cj > need) { jstar = j; needp = need - cum; } cum += cj; }
                    const bool tstar = (jstar < 32) && ((tiem >> (jstar & 31)) & 1u);
                    int kL = 0, kH = 63;
                    if (jstar < 32 && needp > 0) { while (kL < kH) { const int km = (kL + kH) >> 1; const int c = __builtin_popcountll(__ballot(tstar && kap <= km)); if (c >= needp) kH = km; else kL = km + 1; } }
                    else kL = -1;
#pragma unroll
                    for (int j = 0; j < 32; ++j) { const bool t = (tiem >> j) & 1u; const bool ts = t && (j < jstar || (j == jstar && kap <= kL)); selm |= (x[j] > tv || ts) ? (1u << j) : 0u; }
                }
            }
        }
        }
        unsigned wlo = 0u, whi = 0u;
        for (int rpc = 0; rpc < REP_SEL_C; ++rpc) { asm volatile("" : "+v"(selm));
#pragma unroll
        for (int g = 0; g < 4; ++g) if (g < ngrp) {
#pragma unroll
            for (int jj = 0; jj < 8; ++jj) { const int j = 8 * g + jj; const unsigned long long bal = __ballot((selm >> j) & 1u); if (lane == j) { wlo = (unsigned)bal; whi = (unsigned)(bal >> 32); } } }
        if (lane < 32) { v2u o; o.x = wlo; o.y = whi; *(v2u*)(MASK + (((size_t)(b * 32 + lane)) * 2048 + q) * 2) = o; }
        }
    }
#undef IDX_COUNT
#undef IDX_UNI
    WG_SYNC();
}

constexpr int KTP = 72;
constexpr int VRP = 136;
constexpr int EP = 68;
constexpr int OTP = 132;
constexpr int GL_OFF = 0, TOT_OFF = 4096, E_OFF = 6144, QA_OFF = 23552, KR_OFF = 32768, PM_OFF = 41984, VR_OFF = 51200, OT_OFF = 68608;
typedef short v4i16g __attribute__((ext_vector_type(4)));
__device__ __forceinline__ bf16x8 tr_frag(const LAS bf16* T, int pitch, int k0, int n0, int lane) {
    const int g = lane >> 4, q = (lane & 15) >> 2, p = lane & 3;
    const LAS bf16* a = T + (k0 + 8 * g + q) * pitch + n0 + 4 * p;
    const v4i16g lo = __builtin_amdgcn_ds_read_tr16_b64_v4i16((LAS v4i16g*)a), hi = __builtin_amdgcn_ds_read_tr16_b64_v4i16((LAS v4i16g*)(a + 4 * pitch));
    return (bf16x8){lo[0], lo[1], lo[2], lo[3], hi[0], hi[1], hi[2], hi[3]};
}
__device__ __forceinline__ float fexp(float x) { return __builtin_amdgcn_exp2f(x * 1.4426950408889634f); }
__device__ __forceinline__ float gla_decay(LAS unsigned char* lds, const bf16* __restrict__ MISC, const float* __restrict__ w2, const float* __restrict__ gb, size_t row0, int h, int tid) {
    LAS float* GL = (LAS float*)(lds + GL_OFF); LAS float* TOT = (LAS float*)(lds + TOT_OFF); LAS float* E = (LAS float*)(lds + E_OFF);
    const int d = tid & 63, tg = tid >> 6;
    { const int t = tid >> 3, r2 = (tid & 7) * 2; const unsigned w = *(const unsigned*)(MISC + (row0 + t) * 64 + 40 + r2); GL[t * 16 + r2] = bflo(w); GL[t * 16 + r2 + 1] = bfhi(w); }
    float wc[16];
#pragma unroll
    for (int r = 0; r < 16; ++r) wc[r] = w2[r * 256 + h * 64 + d];
    const float bias = gb[h * 64 + d];
    WG_SYNC();
    float bc[8]; float run = 0.f;
#pragma unroll
    for (int i = 0; i < 8; ++i) { const int t = 8 * tg + i; float z = bias;
#pragma unroll
        for (int r4 = 0; r4 < 4; ++r4) { const f32x4 g = *(const LAS f32x4*)(GL + t * 16 + 4 * r4); z += g[0] * wc[4 * r4] + g[1] * wc[4 * r4 + 1] + g[2] * wc[4 * r4 + 2] + g[3] * wc[4 * r4 + 3]; }
        const float ls = fminf(z, 0.f) - 0.6931471805599453f * __builtin_amdgcn_logf(1.0f + __builtin_amdgcn_exp2f(-1.4426950408889634f * fabsf(z)));
        run += ls * (1.0f / 16.0f); bc[i] = run; }
    TOT[tg * 64 + d] = run;
    WG_SYNC();
    float pre = 0.f, tot = 0.f;
#pragma unroll
    for (int g = 0; g < 8; ++g) { const float v = TOT[g * 64 + d]; tot += v; if (g < tg) pre += v; }
#pragma unroll
    for (int i = 0; i < 8; ++i) E[(8 * tg + i) * EP + d] = fexp(tot - (bc[i] + pre));
    return tot;
}
__device__ __forceinline__ void gla_load_v(LAS unsigned char* lds, const bf16* __restrict__ VB, size_t row0, int h, int tid) {
    LAS bf16* VR = (LAS bf16*)(lds + VR_OFF); const int t = tid >> 3, v0 = (tid & 7) * 16; const bf16* src = VB + (row0 + t) * 512 + h * 128 + v0;
    const v4u a = *(const v4u*)src, b = *(const v4u*)(src + 8);
    *(LAS v4u*)(VR + t * VRP + v0) = a; *(LAS v4u*)(VR + t * VRP + v0 + 8) = b;
}
__device__ __forceinline__ v4u scale8(v4u raw, const f32x4 e0, const f32x4 e1) {
    v4u o; o.x = pg8::cvt_pk_bf16(bflo(raw.x) * e0[0], bfhi(raw.x) * e0[1]); o.y = pg8::cvt_pk_bf16(bflo(raw.y) * e0[2], bfhi(raw.y) * e0[3]);
    o.z = pg8::cvt_pk_bf16(bflo(raw.z) * e1[0], bfhi(raw.z) * e1[1]); o.w = pg8::cvt_pk_bf16(bflo(raw.w) * e1[2], bfhi(raw.w) * e1[3]); return o;
}
__device__ __forceinline__ void gla_a_item(LAS unsigned char* lds, int id, const bf16* __restrict__ KB, const bf16* __restrict__ VB, const bf16* __restrict__ MISC, const float* __restrict__ w2, const float* __restrict__ gb,
                                           float* __restrict__ U, float* __restrict__ BLAST, float* __restrict__ EG, int tid, int lane, int wid) {
    const int b = id >> 7, h = (id >> 5) & 3, c = id & 31; const size_t row0 = (size_t)b * 2048 + 64 * c;
    const v4u kraw = *(const v4u*)(KB + (row0 + (tid >> 3)) * 256 + h * 64 + (tid & 7) * 8);
    gla_load_v(lds, VB, row0, h, tid);
    const float blast = gla_decay(lds, MISC, w2, gb, row0, h, tid);
    if (tid < 64) BLAST[(size_t)id * 64 + tid] = blast;
    WG_SYNC();
    LAS bf16* KR = (LAS bf16*)(lds + KR_OFF); LAS bf16* VR = (LAS bf16*)(lds + VR_OFF); const LAS float* E = (const LAS float*)(lds + E_OFF);
    { const int t = tid >> 3, d8 = (tid & 7) * 8; const f32x4 e0 = *(const LAS f32x4*)(E + t * EP + d8), e1 = *(const LAS f32x4*)(E + t * EP + d8 + 4); *(LAS v4u*)(KR + t * KTP + d8) = scale8(kraw, e0, e1);
      float* eg = EG + ((size_t)id * 64 + t) * 64 + d8; *(f32x4*)eg = e0; *(f32x4*)(eg + 4) = e1; }
    WG_SYNC();
    const int fr = lane & 15, fq = lane >> 4;
    bf16x8 Bf[2];
#pragma unroll
    for (int kk = 0; kk < 2; ++kk) Bf[kk] = tr_frag(VR, VRP, 32 * kk, 16 * wid, lane);
#pragma unroll
    for (int dt = 0; dt < 4; ++dt) { f32x4 acc = (f32x4){0.f, 0.f, 0.f, 0.f};
#pragma unroll
        for (int kk = 0; kk < 2; ++kk) { const bf16x8 Af = tr_frag(KR, KTP, 32 * kk, 16 * dt, lane); acc = __builtin_amdgcn_mfma_f32_16x16x32_bf16(Af, Bf[kk], acc, 0, 0, 0); }
        *(f32x4*)(U + ((size_t)id * 128 + 16 * wid + fr) * 64 + 16 * dt + 4 * fq) = acc; }
    WG_SYNC();
}
__device__ __forceinline__ void gla_b_item(int item, const float* __restrict__ U, const float* __restrict__ BLAST, bf16* __restrict__ SB, int tid) {
    const int bh = item >> 3, pc = item & 7; const size_t eoff = (size_t)pc * 1024 + (size_t)tid * 2; const int d0 = (tid * 2) & 63;
    f32x2 S = (f32x2){0.f, 0.f};
#pragma unroll 1
    for (int half = 0; half < 2; ++half) {
        f32x2 u[16], bl[16];
#pragma unroll
        for (int c = 0; c < 16; ++c) { const size_t id = (size_t)bh * 32 + 16 * half + c; u[c] = *(const f32x2*)(U + id * 8192 + eoff); bl[c] = *(const f32x2*)(BLAST + id * 64 + d0); }
#pragma unroll
        for (int c = 0; c < 16; ++c) { const size_t id = (size_t)bh * 32 + 16 * half + c;
            f32x2 e; e[0] = __expf(bl[c][0]); e[1] = __expf(bl[c][1]);
            const f32x2 sd = S * e; *(unsigned*)(SB + id * 8192 + eoff) = pg8::cvt_pk_bf16(sd[0], sd[1]); S = sd + u[c]; }
    }
}
__device__ __forceinline__ void gla_c_item(LAS unsigned char* lds, int id, const bf16* __restrict__ QB, const bf16* __restrict__ KB, const bf16* __restrict__ VB, const bf16* __restrict__ RG, const float* __restrict__ EG,
                                           const float* __restrict__ og, const bf16* __restrict__ SB, bf16* __restrict__ MIX, int tid, int lane, int wid) {
    const int b = id >> 7, h = (id >> 5) & 3, c = id & 31; const size_t row0 = (size_t)b * 2048 + 64 * c;
    const int st_t = tid >> 3, st_d8 = (tid & 7) * 8;
    const v4u kraw = *(const v4u*)(KB + (row0 + st_t) * 256 + h * 64 + st_d8), qraw = *(const v4u*)(QB + (row0 + st_t) * 256 + h * 64 + st_d8);
    const float* eg = EG + ((size_t)id * 64 + st_t) * 64 + st_d8; const f32x4 e0 = *(const f32x4*)eg, e1 = *(const f32x4*)(eg + 4);
    gla_load_v(lds, VB, row0, h, tid);
    const int fr = lane & 15, fq = lane >> 4;
    bf16x8 Bs[2];
    { const bf16* sbp = SB + ((size_t)id * 128 + 16 * wid + fr) * 64 + 8 * fq; Bs[0] = *(const bf16x8*)sbp; Bs[1] = *(const bf16x8*)(sbp + 32); }
    LAS bf16* QA = (LAS bf16*)(lds + QA_OFF); LAS bf16* KR = (LAS bf16*)(lds + KR_OFF); LAS bf16* PM = (LAS bf16*)(lds + PM_OFF); LAS bf16* VR = (LAS bf16*)(lds + VR_OFF);
    LAS float* OT = (LAS float*)(lds + OT_OFF);
    { f32x4 r0, r1;
#pragma unroll
      for (int i = 0; i < 4; ++i) { r0[i] = 0.125f * __builtin_amdgcn_rcpf(e0[i]); r1[i] = 0.125f * __builtin_amdgcn_rcpf(e1[i]); }
      *(LAS v4u*)(KR + st_t * KTP + st_d8) = scale8(kraw, e0, e1); *(LAS v4u*)(QA + st_t * KTP + st_d8) = scale8(qraw, r0, r1); }
    WG_SYNC();
    { const int tt = wid >> 1;
#pragma unroll
      for (int s2 = 0; s2 < 2; ++s2) { const int st = 2 * (wid & 1) + s2; f32x4 acc = (f32x4){0.f, 0.f, 0.f, 0.f};
        if (st <= tt) {
#pragma unroll
            for (int kk = 0; kk < 2; ++kk) { const bf16x8 Af = *(const LAS bf16x8*)(KR + (16 * st + fr) * KTP + 32 * kk + 8 * fq); const bf16x8 Bf = *(const LAS bf16x8*)(QA + (16 * tt + fr) * KTP + 32 * kk + 8 * fq);
                acc = __builtin_amdgcn_mfma_f32_16x16x32_bf16(Af, Bf, acc, 0, 0, 0); } }
        const int t = 16 * tt + fr, s0 = 16 * st + 4 * fq; v2u o;
        o.x = pg8::cvt_pk_bf16((s0 <= t) ? acc[0] : 0.f, (s0 + 1 <= t) ? acc[1] : 0.f); o.y = pg8::cvt_pk_bf16((s0 + 2 <= t) ? acc[2] : 0.f, (s0 + 3 <= t) ? acc[3] : 0.f);
        *(LAS v2u*)(PM + t * KTP + s0) = o; } }
    WG_SYNC();
    bf16x8 Bv[2];
#pragma unroll
    for (int kk = 0; kk < 2; ++kk) Bv[kk] = tr_frag(VR, VRP, 32 * kk, 16 * wid, lane);
#pragma unroll
    for (int tt = 0; tt < 4; ++tt) { f32x4 acc = (f32x4){0.f, 0.f, 0.f, 0.f};
#pragma unroll
        for (int kk = 0; kk < 2; ++kk) { const bf16x8 Ap = *(const LAS bf16x8*)(PM + (16 * tt + fr) * KTP + 32 * kk + 8 * fq); acc = __builtin_amdgcn_mfma_f32_16x16x32_bf16(Ap, Bv[kk], acc, 0, 0, 0);
                                         const bf16x8 Aq = *(const LAS bf16x8*)(QA + (16 * tt + fr) * KTP + 32 * kk + 8 * fq); acc = __builtin_amdgcn_mfma_f32_16x16x32_bf16(Aq, Bs[kk], acc, 0, 0, 0); }
#pragma unroll
        for (int i = 0; i < 4; ++i) OT[(16 * tt + 4 * fq + i) * OTP + 16 * wid + fr] = acc[i]; }
    WG_SYNC();
    { const int t = tid >> 3, v0 = (tid & 7) * 16; f32x4 ov[4]; float ss = 0.f;
#pragma unroll
      for (int k = 0; k < 4; ++k) { ov[k] = *(const LAS f32x4*)(OT + t * OTP + v0 + 4 * k); ss += (ov[k][0] * ov[k][0] + ov[k][1] * ov[k][1]) + (ov[k][2] * ov[k][2] + ov[k][3] * ov[k][3]); }
      ss += DPP_STEP_F(ss, 0xB1); ss += DPP_STEP_F(ss, 0x4E); ss += DPP_STEP_F(ss, 0x141);
      const float rs = __builtin_amdgcn_rsqf(ss * (1.0f / 128.0f) + 1e-6f);
      const bf16* rgp = RG + (row0 + t) * 512 + h * 128 + v0; const v4u ra = *(const v4u*)rgp, rb = *(const v4u*)(rgp + 8);
      const unsigned rw[8] = {ra.x, ra.y, ra.z, ra.w, rb.x, rb.y, rb.z, rb.w}; unsigned ow[8];
#pragma unroll
      for (int k = 0; k < 4; ++k) { const f32x4 g = *(const f32x4*)(og + v0 + 4 * k); float y[4];
#pragma unroll
          for (int i = 0; i < 4; ++i) { const unsigned w = rw[2 * k + (i >> 1)]; const float r = (i & 1) ? bfhi(w) : bflo(w); const float sg = r * __builtin_amdgcn_rcpf(1.0f + __builtin_amdgcn_exp2f(-1.4426950408889634f * r)); y[i] = ov[k][i] * rs * g[i] * sg; }
          ow[2 * k] = pg8::cvt_pk_bf16(y[0], y[1]); ow[2 * k + 1] = pg8::cvt_pk_bf16(y[2], y[3]); }
      bf16* op = MIX + (row0 + t) * 1024 + 512 + h * 128 + v0;
      *(v4u*)op = (v4u){ow[0], ow[1], ow[2], ow[3]}; *(v4u*)(op + 8) = (v4u){ow[4], ow[5], ow[6], ow[7]}; }
    WG_SYNC();
}

constexpr int WRP = 1032;
constexpr int WR_LDS_BYTES = 48 * WRP * 2;
__device__ __forceinline__ void router_tile(LAS unsigned char* lds, int tile, const bf16* __restrict__ XN2, const float* __restrict__ ROWSS, const float* __restrict__ brg, const float* __restrict__ bre,
                                            unsigned* __restrict__ CNT, int* __restrict__ LISTS, float* __restrict__ LSC, int* __restrict__ TOKINFO, int tid, int lane, int wid) {
    LAS bf16* WR = (LAS bf16*)lds; LAS float* PL = (LAS float*)(lds + WR_LDS_BYTES); LAS unsigned* CL = (LAS unsigned*)(lds + WR_LDS_BYTES + 24576); LAS unsigned* BS = CL + 32;
    if (tid < 32) CL[tid] = 0u;
    const int fr = lane & 15, fq = lane >> 4, rt = wid >> 1, kh = wid & 1;
    {   const size_t row = (size_t)tile * 64 + 16 * rt + fr; const bf16* ap = XN2 + row * 1024 + 512 * kh + 8 * fq;
        bf16x8 Af[16];
#pragma unroll
        for (int kk = 0; kk < 16; ++kk) Af[kk] = *(const bf16x8*)(ap + 32 * kk);
        f32x4 acc[3];
#pragma unroll
        for (int nt = 0; nt < 3; ++nt) acc[nt] = (f32x4){0.f, 0.f, 0.f, 0.f};
#pragma unroll
        for (int kk = 0; kk < 16; ++kk)
#pragma unroll
            for (int nt = 0; nt < 3; ++nt) { const bf16x8 Bf = *(const LAS bf16x8*)(WR + (16 * nt + fr) * WRP + 512 * kh + 32 * kk + 8 * fq); acc[nt] = __builtin_amdgcn_mfma_f32_16x16x32_bf16(Af[kk], Bf, acc[nt], 0, 0, 0); }
#pragma unroll
        for (int nt = 0; nt < 3; ++nt)
#pragma unroll
            for (int i = 0; i < 4; ++i) PL[(wid * 16 + 4 * fq + i) * 48 + 16 * nt + fr] = acc[nt][i];
    }
    WG_SYNC();
    int e_[2] = {0, 0}; unsigned lp[2] = {0u, 0u}; float wk[2] = {0.f, 0.f}; float rstd2 = 0.f; const bool act = tid < 64;
    const int token = tile * 64 + tid;
    if (act) {
        const LAS float* l0 = PL + ((2 * (tid >> 4)) * 16 + (tid & 15)) * 48; const LAS float* l1 = l0 + 16 * 48; float ss = 0.f;
        const f32x4* rp = (const f32x4*)(ROWSS + (size_t)token * 16);
#pragma unroll
        for (int j = 0; j < 4; ++j) { const f32x4 v = rp[j]; ss += (v[0] + v[1]) + (v[2] + v[3]); }
        rstd2 = 1.0f / sqrtf(ss * (1.0f / 1024.0f) + 1e-6f);
        float gl[4]; int gs = 0;
#pragma unroll
        for (int j = 0; j < 4; ++j) gl[j] = (l0[j] + l1[j]) * rstd2 + brg[j];
#pragma unroll
        for (int j = 1; j < 4; ++j) if (gl[j] > gl[gs]) gs = j;
        float den = 0.f;
#pragma unroll
        for (int j = 0; j < 4; ++j) den += __expf(gl[j] - gl[gs]);
        const float gw = 1.0f / den;
        float el[8];
#pragma unroll
        for (int j = 0; j < 8; ++j) el[j] = (l0[4 + gs * 8 + j] + l1[4 + gs * 8 + j]) * rstd2 + bre[gs * 8 + j];
        int i0 = 0;
#pragma unroll
        for (int j = 1; j < 8; ++j) if (el[j] > el[i0]) i0 = j;
        int i1 = (i0 == 0) ? 1 : 0;
#pragma unroll
        for (int j = 0; j < 8; ++j) if (j != i0 && j != i1 && el[j] > el[i1]) i1 = j;
        const float ex = __expf(el[i1] - el[i0]); const float w0 = 1.0f / (1.0f + ex);
        wk[0] = w0 * gw; wk[1] = ex * w0 * gw; e_[0] = gs * 8 + i0; e_[1] = gs * 8 + i1;
        lp[0] = __hip_atomic_fetch_add(CL + e_[0], 1u, __ATOMIC_RELAXED, __HIP_MEMORY_SCOPE_WORKGROUP); lp[1] = __hip_atomic_fetch_add(CL + e_[1], 1u, __ATOMIC_RELAXED, __HIP_MEMORY_SCOPE_WORKGROUP);
    }
    WG_SYNC();
    if (tid < 32) { const unsigned n = CL[tid]; BS[tid] = n ? __hip_atomic_fetch_add(CNT + tid, n, __ATOMIC_RELAXED, __HIP_MEMORY_SCOPE_AGENT) : 0u; }
    WG_SYNC();
    if (act) {
#pragma unroll
        for (int k = 0; k < 2; ++k) { const unsigned pos = BS[e_[k]] + lp[k]; LISTS[(size_t)e_[k] * 16384 + pos] = token; *(f32x2*)(LSC + ((size_t)e_[k] * 16384 + pos) * 2) = (f32x2){rstd2, wk[k]}; }
        *(int4*)(TOKINFO + (size_t)token * 4) = make_int4(e_[0], (int)(BS[e_[0]] + lp[0]), e_[1], (int)(BS[e_[1]] + lp[1]));
    }
    WG_SYNC();
}

template <bool GATHER> struct GroupOrder {
    const LAS int* TOFF; const LAS int* BOFF; const LAS int* CNTL; const int* LISTS; int NPN, G, c; unsigned bstride;
    __device__ bool next(int i, pg8::Unit& u) const {
        const int L = i * G + c; const int ntile = BOFF[32]; if (L >= ntile * NPN) return false;
        const int Tb = L / NPN; int e = 0;
#pragma unroll
        for (int s = 16; s >= 1; s >>= 1) if (BOFF[e + s] <= Tb) e += s;
        const int jt = Tb - BOFF[e];
        u.pm = TOFF[e] + jt; u.pn = L - Tb * NPN; u.e = e; u.p0 = jt * 256; const int rem = CNTL[e] - u.p0; u.nv = rem < 256 ? rem : 256; u.bo = (unsigned)e * bstride; return true;
    }
    __device__ __forceinline__ unsigned arow(const pg8::Unit& u, int r) const {
        if (GATHER) return (unsigned)LISTS[(size_t)u.e * 16384 + u.p0 + (r < u.nv ? r : 0)];
        return (unsigned)(u.pm * 256 + r);
    }
};
__device__ __forceinline__ void skinny_gu(LAS unsigned char* lds, int e, int p0, int rem, int rg, int cb, int slot0, const bf16* __restrict__ XN2, const bf16* __restrict__ WGU, const int* __restrict__ LISTS, const float* __restrict__ LSC, bf16* __restrict__ HID, int lane, int wid) {
    const int fr = lane & 15, fq = lane >> 4; const int r = 16 * rg + fr; const int tok = LISTS[(size_t)e * 16384 + p0 + (r < rem ? r : 0)];
    const bf16* ap = XN2 + (size_t)tok * 1024 + 128 * wid + 8 * fq; const bf16* wb = WGU + (size_t)e * 512 * 1024 + 128 * wid + 8 * fq;
    LAS f32x4* PART = (LAS f32x4*)lds;
    bf16x8 Af[4], Bg[4][4], Bu[4][4];
#pragma unroll
    for (int k = 0; k < 4; ++k) Af[k] = *(const bf16x8*)(ap + 32 * k);
#pragma unroll
    for (int nt = 0; nt < 4; ++nt) { const int j = 64 * cb + 16 * nt + fr; const bf16* bp = wb + (size_t)((j >> 7) * 256 + (j & 127)) * 1024;
#pragma unroll
        for (int k = 0; k < 4; ++k) { Bg[nt][k] = *(const bf16x8*)(bp + 32 * k); Bu[nt][k] = *(const bf16x8*)(bp + 128 * 1024 + 32 * k); } }
#pragma unroll
    for (int nt = 0; nt < 4; ++nt) { f32x4 ag = (f32x4){0.f, 0.f, 0.f, 0.f}, au = (f32x4){0.f, 0.f, 0.f, 0.f};
#pragma unroll
        for (int k = 0; k < 4; ++k) { ag = __builtin_amdgcn_mfma_f32_16x16x32_bf16(Af[k], Bg[nt][k], ag, 0, 0, 0); au = __builtin_amdgcn_mfma_f32_16x16x32_bf16(Af[k], Bu[nt][k], au, 0, 0, 0); }
        PART[(wid * 8 + nt) * 64 + lane] = ag; PART[(wid * 8 + 4 + nt) * 64 + lane] = au; }
    WG_SYNC();
    if (wid < 4) { const int nt = wid; f32x4 g = (f32x4){0.f, 0.f, 0.f, 0.f}, u = (f32x4){0.f, 0.f, 0.f, 0.f};
#pragma unroll
        for (int w = 0; w < 8; ++w) { g += PART[(w * 8 + nt) * 64 + lane]; u += PART[(w * 8 + 4 + nt) * 64 + lane]; }
#pragma unroll
        for (int i = 0; i < 4; ++i) { const int rr = 16 * rg + 4 * fq + i; if (rr < rem) { const f32x2 sw = *(const f32x2*)(LSC + ((size_t)e * 16384 + p0 + rr) * 2);
            const float a = g[i] * sw.x, uu = u[i] * sw.x; HID[(size_t)(slot0 + rr) * 256 + 64 * cb + 16 * nt + fr] = (bf16)f2bf(a * __builtin_amdgcn_rcpf(1.f + __expf(-a)) * uu * sw.y); } } }
    WG_SYNC();
}
__device__ __forceinline__ void skinny_down(int e, int rem, int rg, int cq, int slot0, const bf16* __restrict__ HID, const bf16* __restrict__ WD, bf16* __restrict__ Y, int lane, int wid) {
    const int fr = lane & 15, fq = lane >> 4; const int r = 16 * rg + fr; const int col0 = 256 * cq + 32 * wid;
    const bf16* ap = HID + (size_t)(slot0 + (r < rem ? r : 0)) * 256 + 8 * fq; const bf16* wb = WD + (size_t)e * 1024 * 256 + (size_t)(col0 + fr) * 256 + 8 * fq;
    bf16x8 Af[8], B0[8], B1[8];
#pragma unroll
    for (int k = 0; k < 8; ++k) { Af[k] = *(const bf16x8*)(ap + 32 * k); B0[k] = *(const bf16x8*)(wb + 32 * k); B1[k] = *(const bf16x8*)(wb + (size_t)16 * 256 + 32 * k); }
    f32x4 a0 = (f32x4){0.f, 0.f, 0.f, 0.f}, a1 = (f32x4){0.f, 0.f, 0.f, 0.f};
#pragma unroll
    for (int k = 0; k < 8; ++k) { a0 = __builtin_amdgcn_mfma_f32_16x16x32_bf16(Af[k], B0[k], a0, 0, 0, 0); a1 = __builtin_amdgcn_mfma_f32_16x16x32_bf16(Af[k], B1[k], a1, 0, 0, 0); }
#pragma unroll
    for (int i = 0; i < 4; ++i) { const int rr = 16 * rg + 4 * fq + i; if (rr < rem) { bf16* yp = Y + (size_t)(slot0 + rr) * 1024 + col0 + fr; yp[0] = (bf16)f2bf(a0[i]); yp[16] = (bf16)f2bf(a1[i]); } }
}
struct Args { const float* in[18]; float* out; unsigned char* ws; int ph_lo, ph_hi, li, pad; };
__global__ void __launch_bounds__(NWAVES * 64, 2) hymba_fwd(Args args) {
    extern __shared__ __attribute__((aligned(16))) unsigned char lds[];
    LAS unsigned char* const L = (LAS unsigned char*)lds;
    volatile LAS unsigned* const MISCW = (volatile LAS unsigned*)(L + MISC_OFF);
    LAS int* const TOFF = (LAS int*)(L + TOFF_OFF); LAS int* const CNTL = TOFF + 40; LAS int* const BOFF = TOFF + 80; LAS int* const SMALL = TOFF + 120;
    const int tid = threadIdx.x, lane = tid & 63, wave = __builtin_amdgcn_readfirstlane(tid >> 6);
    const int G = gridDim.x; const int bx = blockIdx.x; const int vcu = (G % 8 == 0) ? (bx % 8) * (G / 8) + bx / 8 : bx;
    unsigned char* const ws = args.ws;
    gu32* const ctl = (gu32*)(ws + WS_CTL);
    const float* x = args.in[0]; const float* norm1_g = args.in[1]; const float* w_in = args.in[2]; const float* q_norm_g = args.in[3]; const float* k_norm_g = args.in[4];
    const float* rel_bias = args.in[5]; const float* gate_w2 = args.in[6]; const float* gate_b = args.in[7]; const float* out_norm_g = args.in[8]; const float* w_out = args.in[9];
    const float* norm2_g = args.in[10]; const float* w_rg = args.in[11]; const float* b_rg = args.in[12]; const float* w_re = args.in[13]; const float* b_re = args.in[14];
    const float* w_eg = args.in[15]; const float* w_eu = args.in[16]; const float* w_ed = args.in[17];
    float* out = args.out;
    float* RSTD1 = (float*)(ws + WS_RSTD1); float* ROWSS = (float*)(ws + WS_ROWSS); bf16* WR_T = (bf16*)(ws + WS_WR); float* BLAST = (float*)(ws + WS_BLAST);
    int* TOKINFO = (int*)(ws + WS_TOKINFO); int* LISTS = (int*)(ws + WS_LISTS); float* LSC = (float*)(ws + WS_LSC);
    bf16* WO_T = (bf16*)(ws + WS_WO); bf16* WGU_T = (bf16*)(ws + WS_WGU); bf16* WD_T = (bf16*)(ws + WS_WD); bf16* XB = (bf16*)(ws + WS_XB); bf16* WIN_T = (bf16*)(ws + WS_WIN);
    unsigned* MASK = (unsigned*)(ws + WS_MASK); bf16* SB = (bf16*)(ws + WS_SB); float* EG = (float*)(ws + WS_EG);
    bf16* QN = (bf16*)(ws + WS_QN); bf16* KN = (bf16*)(ws + WS_KN); bf16* VN = (bf16*)(ws + WS_VN); bf16* XN2 = (bf16*)(ws + WS_XN2);
    bf16* IQ = (bf16*)(ws + WS_IQ); bf16* MISC = (bf16*)(ws + WS_MISC); bf16* QB = (bf16*)(ws + WS_QB); bf16* KB = (bf16*)(ws + WS_KB); bf16* VB = (bf16*)(ws + WS_VB); bf16* RG = (bf16*)(ws + WS_RG);
    bf16* MIX = (bf16*)(ws + WS_MIX); float* U = (float*)(ws + WS_MIX); bf16* HID = (bf16*)(ws + WS_HID); bf16* Y = (bf16*)(ws + WS_Y);
    unsigned* CNT = (unsigned*)(ctl + CW_CNT);

    for (int u = tid; u < (LDS_BYTES - LDSCTL_OFF) / 4; u += NWAVES * 64) ((LAS unsigned*)(L + LDSCTL_OFF))[u] = 0u;
    __syncthreads();
    const int bli = (N_LAUNCHES == PER_PHASE) ? 0 : args.li;
    XcdBarrier bar; bar.bar = (unsigned*)(ctl + CW_BAR) + bli * XCD_BAR_WORDS; bar.x = 0; bar.st = nullptr;
    if (N_LAUNCHES != PER_PHASE) bar = xcd_barrier_post((unsigned*)(ctl + CW_BAR) + bli * XCD_BAR_WORDS, MISCW + 8);
#define GRID_BAR(seam) do { if (N_LAUNCHES == PER_PHASE) { if (tid == 0) __hip_atomic_store(ctl + CW_TMO, 0xBADBA0u | (unsigned)(seam), RLX_AGENT); } else { xcd_barrier(bar); } } while (0)
    const int lo = args.ph_lo, hi = args.ph_hi;
#define IN(k) (lo <= (k) && (k) < hi)
#define BOTH(k) (IN(k) && IN((k) + 1))
    const int gw = vcu * NWAVES + wave, NGW = G * NWAVES;

    constexpr int I_G = 16 * 8, I_D = 4 * 32, PER_E = 2 * I_G + I_D, NE1 = 18, NE2 = 25;
#define expert_weights(lo_, hi_, w0_, nw_) do { LAS float* scr_ = (LAS float*)(L + wave * 16384); \
        for (int it_ = (lo_) + (w0_); it_ < (hi_); it_ += (nw_)) { const int e_ = it_ / PER_E; int r_ = it_ - e_ * PER_E; \
            if (r_ < I_G) { p0_transpose_item<2>(w_eg + (size_t)e_ * 1024 * 256, 1024, 256, norm2_g, WGU_T + (size_t)e_ * 512 * 1024, scr_, r_, lane); continue; } r_ -= I_G; \
            if (r_ < I_G) { p0_transpose_item<3>(w_eu + (size_t)e_ * 1024 * 256, 1024, 256, norm2_g, WGU_T + (size_t)e_ * 512 * 1024, scr_, r_, lane); continue; } r_ -= I_G; \
            p0_transpose_item<1>(w_ed + (size_t)e_ * 256 * 1024, 256, 1024, nullptr, WD_T + (size_t)e_ * 1024 * 256, scr_, r_, lane); } } while (0)
    if (IN(0)) {
        LAS float* scr = (LAS float*)(L + wave * 16384);
        constexpr int I_IN = 16 * 106, I_O = 16 * 32;
        constexpr int NITEMS = I_IN + I_O;
        for (int it = gw; it < NITEMS; it += NGW) {
            int r = it;
            if (r < I_IN) { p0_transpose_item<0>(w_in, 1024, 3384, norm1_g, WIN_T, scr, r, lane); continue; } r -= I_IN;
            p0_transpose_item<1>(w_out, 1024, 1024, nullptr, WO_T, scr, r, lane);
        }
        expert_weights(NE2 * PER_E, 32 * PER_E, gw, NGW);
        for (int i = bx * (NWAVES * 64) + tid; i < 48 * 1024; i += G * NWAVES * 64) { const int n = i >> 10, k = i & 1023;
            const float v = (n < 4) ? w_rg[k * 4 + n] : (n < 36) ? w_re[k * 32 + (n - 4)] : 0.f; WR_T[i] = (bf16)f2bf(v * norm2_g[k]); }
        for (int m0 = 2 * gw; m0 < M; m0 += 2 * NGW) {
            f32x4 v[2][4]; float s[2];
#pragma unroll
            for (int r = 0; r < 2; ++r) { const GAS f32x4* xr = (const GAS f32x4*)(x + (size_t)(m0 + r) * 1024) + lane;
#pragma unroll
                for (int j = 0; j < 4; ++j) v[r][j] = __builtin_nontemporal_load(xr + 64 * j); }
#pragma unroll
            for (int r = 0; r < 2; ++r) { s[r] = 0.f;
#pragma unroll
                for (int j = 0; j < 4; ++j) s[r] += (v[r][j].x * v[r][j].x + v[r][j].y * v[r][j].y) + (v[r][j].z * v[r][j].z + v[r][j].w * v[r][j].w);
                s[r] = wave_fsum(s[r]); if (lane == 0) RSTD1[m0 + r] = 1.0f / sqrtf(s[r] * (1.0f / 1024.0f) + 1e-6f);
                GAS unsigned long long* o8 = (GAS unsigned long long*)(XB + (size_t)(m0 + r) * 1024) + lane;
#pragma unroll
                for (int j = 0; j < 4; ++j) o8[64 * j] = (unsigned long long)pg8::cvt_pk_bf16(v[r][j].x, v[r][j].y) | ((unsigned long long)pg8::cvt_pk_bf16(v[r][j].z, v[r][j].w) << 32); }
        }
        if (BOTH(0)) GRID_BAR(0);
#if defined(EXTRA_BAR)
        for (int eb = 0; eb < EXTRA_BAR; ++eb) GRID_BAR(0);
#endif
    }
    if (IN(1)) {
        pg8::Gemm g{XB, WIN_T, 1024}; pg8::StaticOrder S; S.init(M, 3584, G, bx);
        pg8::EpiProj E{RSTD1, q_norm_g, k_norm_g, QN, KN, VN, IQ, QB, KB, VB, RG, MISC, 0.125f * 1.4426950408889634f, 1e-6f};
        pg8::gemm_phase<pg8::EpiProj, pg8::StaticOrder, true>(L, g, S, E);
        {
            const int nshort = (896 % G == 0) ? G : G - (896 % G), first = G - nshort;
            if (bx >= first) expert_weights(0, NE1 * PER_E, (bx - first) * NWAVES + wave, nshort * NWAVES); }
        if (BOTH(1)) GRID_BAR(1);
    }
    if (IN(2)) {
        for (int rep = 0; rep < REP_IDX; ++rep)
        for (int it = bx; it < 1024; it += G) { const int b = it & 7, t_ = it >> 3, j_ = t_ >> 5, k0_ = t_ & 31;
            const int p = (j_ == 0) ? k0_ : (j_ == 1) ? 63 - k0_ : (j_ == 2) ? 64 + k0_ : 127 - k0_;
            idx_item(L, b, p, IQ, MISC, MASK, lane, wave); }
        for (int rep = 0; rep < REP_GLAA; ++rep)
        for (int it = bx; it < 1024; it += G) gla_a_item(L, it, KB, VB, MISC, gate_w2, gate_b, U, BLAST, EG, tid, lane, wave);
        expert_weights(NE1 * PER_E, NE2 * PER_E, gw, NGW);
        if (BOTH(2)) GRID_BAR(2);
    }
    if (IN(3)) {
        for (int it = bx; it < 256; it += G) gla_b_item(it, U, BLAST, SB, tid);
        if (BOTH(3)) GRID_BAR(3);
    }
    if (IN(4)) {
        const attn_body::AttnTensors AT{(const attn_body::bf16*)QN, (const attn_body::bf16*)KN, (const attn_body::bf16*)VN, (attn_body::bf16*)MIX, MASK, rel_bias};
        for (int rep = 0; rep < REP_ATT; ++rep)
        for (int pr = vcu; pr < 256; pr += G) { const int bh = pr >> 2, s = pr & 3;
            for (int k2 = 0; k2 < 2; ++k2) attn_body::attn_unit<8>(bh >> 3, bh & 7, k2 ? s : 7 - s, AT.Q, AT.K, AT.V, AT.O, AT.MASK, AT.relb, (char*)lds); }
        for (int rep = 0; rep < REP_GLAC; ++rep)
        for (int it = bx; it < 1024; it += G) gla_c_item(L, it, QB, KB, VB, RG, EG, out_norm_g, SB, MIX, tid, lane, wave);
        if (BOTH(4)) GRID_BAR(4);
    }
    if (IN(5)) {
        pg8::Gemm g{MIX, WO_T, 1024}; pg8::StaticOrder S; S.init(M, 1024, G, bx);
        pg8::EpiOut E{x, XN2, ROWSS};
        pg8::gemm_phase<pg8::EpiOut, pg8::StaticOrder, false>(L, g, S, E);
        if (BOTH(5)) GRID_BAR(5);
    }
    if (IN(6)) {
        { LAS bf16* WR = (LAS bf16*)L;
          for (int i = tid; i < 48 * 128; i += NWAVES * 64) { const int n = i >> 7, c8 = i & 127; *(LAS v4u*)(WR + n * WRP + c8 * 8) = *(const v4u*)(WR_T + n * 1024 + c8 * 8); } }
        WG_SYNC();
        for (int tile = bx; tile < 256; tile += G) router_tile(L, tile, XN2, ROWSS, b_rg, b_re, CNT, LISTS, LSC, TOKINFO, tid, lane, wave);
        if (BOTH(6)) GRID_BAR(6);
    }
    bool toff_done = false;
#define LOAD_TOFF() do { if (toff_done) break; toff_done = true; if (tid < 32) CNTL[tid] = (int)__hip_atomic_load(CNT + tid, RLX_AGENT); WG_SYNC(); \
        if (tid == 0) { int acc_ = 0, bacc_ = 0, ns_ = 0; for (int e_ = 0; e_ < 32; ++e_) { const int c_ = CNTL[e_]; TOFF[e_] = acc_; BOFF[e_] = bacc_; \
        const int full_ = c_ >> 8, rem_ = c_ & 255; acc_ += (c_ + 255) >> 8; bacc_ += full_ + (rem_ > 128 ? 1 : 0); if (rem_ > 0 && rem_ <= 128) { SMALL[1 + ns_] = e_; ++ns_; } } TOFF[32] = acc_; BOFF[32] = bacc_; SMALL[0] = ns_; } WG_SYNC(); } while (0)
    if (IN(7)) {
        LOAD_TOFF();
        pg8::Gemm g{XN2, WGU_T, 1024}; GroupOrder<true> S{TOFF, BOFF, CNTL, LISTS, 2, G, vcu, 512u * 1024u * 2u};
        pg8::EpiGU E{LSC, HID};
        pg8::gemm_phase<pg8::EpiGU, GroupOrder<true>, false>(L, g, S, E);
        { const int ns = SMALL[0];
          for (int idx = G - 1 - bx; idx < ns * 32; idx += G) { const int e = SMALL[1 + (idx >> 5)], rg = (idx >> 2) & 7, cb = idx & 3; const int cnt = CNTL[e], full = cnt >> 8, rem = cnt & 255;
              if (16 * rg < rem) skinny_gu(L, e, full * 256, rem, rg, cb, (TOFF[e] + full) * 256, XN2, WGU_T, LISTS, LSC, HID, lane, wave); } }
        if (BOTH(7)) GRID_BAR(7);
    }
    if (IN(8)) {
        LOAD_TOFF();
        pg8::Gemm g{HID, WD_T, 256}; GroupOrder<false> S{TOFF, BOFF, CNTL, LISTS, 4, G, vcu, 1024u * 256u * 2u};
        pg8::EpiDown E{Y};
        pg8::gemm_phase<pg8::EpiDown, GroupOrder<false>, false>(L, g, S, E);
        { const int ns = SMALL[0];
          for (int idx = G - 1 - bx; idx < ns * 32; idx += G) { const int e = SMALL[1 + (idx >> 5)], rg = (idx >> 2) & 7, cq = idx & 3; const int cnt = CNTL[e], full = cnt >> 8, rem = cnt & 255;
              if (16 * rg < rem) skinny_down(e, rem, rg, cq, (TOFF[e] + full) * 256, HID, WD_T, Y, lane, wave); } }
        if (BOTH(8)) GRID_BAR(8);
    }
    if (IN(9)) {
        LOAD_TOFF();
        for (int m0 = 4 * gw; m0 < M; m0 += 4 * NGW) {
            int4 ti[4];
#pragma unroll
            for (int r = 0; r < 4; ++r) ti[r] = *(const int4*)(TOKINFO + (size_t)(m0 + r) * 4);
            v4u av[4][2], b0[4][2], b1[4][2];
#pragma unroll
            for (int r = 0; r < 4; ++r) { const size_t s0 = (size_t)TOFF[ti[r].x] * 256 + ti[r].y, s1 = (size_t)TOFF[ti[r].z] * 256 + ti[r].w;
                const GAS v4u* a = (const GAS v4u*)(XN2 + (size_t)(m0 + r) * 1024) + lane; const GAS v4u* y0 = (const GAS v4u*)(Y + s0 * 1024) + lane; const GAS v4u* y1 = (const GAS v4u*)(Y + s1 * 1024) + lane;
#pragma unroll
                for (int j = 0; j < 2; ++j) { av[r][j] = __builtin_nontemporal_load(a + 64 * j); b0[r][j] = __builtin_nontemporal_load(y0 + 64 * j); b1[r][j] = __builtin_nontemporal_load(y1 + 64 * j); } }
#pragma unroll
            for (int r = 0; r < 4; ++r) { GAS f32x4* o = (GAS f32x4*)(out + (size_t)(m0 + r) * 1024) + 2 * lane;
#pragma unroll
                for (int j = 0; j < 2; ++j) { const v4u a_ = av[r][j], c0 = b0[r][j], c1 = b1[r][j]; f32x4 r0, r1;
                    r0[0] = bflo(a_.x) + bflo(c0.x) + bflo(c1.x); r0[1] = bfhi(a_.x) + bfhi(c0.x) + bfhi(c1.x); r0[2] = bflo(a_.y) + bflo(c0.y) + bflo(c1.y); r0[3] = bfhi(a_.y) + bfhi(c0.y) + bfhi(c1.y);
                    r1[0] = bflo(a_.z) + bflo(c0.z) + bflo(c1.z); r1[1] = bfhi(a_.z) + bfhi(c0.z) + bfhi(c1.z); r1[2] = bflo(a_.w) + bflo(c0.w) + bflo(c1.w); r1[3] = bfhi(a_.w) + bfhi(c0.w) + bfhi(c1.w);
                    __builtin_nontemporal_store(r0, o + 128 * j); __builtin_nontemporal_store(r1, o + 128 * j + 1); } }
        }
    }
#undef IN
#undef BOTH
}

extern "C" void kernel_launch(void* const* d_in, const int* in_sizes, int n_in, void* d_out, int out_size, void* d_ws, size_t ws_size, hipStream_t stream) {
    static int grid = 0;
    if (grid == 0) {
        if (n_in != 18 || out_size != M * 1024 || ws_size < WS_END) { fprintf(stderr, "kernel_launch: unexpected problem shape (n_in %d out %d ws %zu)\n", n_in, out_size, ws_size); grid = -1; return; }
        int dev = 0, cus = 0, per_cu = 0;
        if (hipGetDevice(&dev) != hipSuccess || hipDeviceGetAttribute(&cus, hipDeviceAttributeMultiprocessorCount, dev) != hipSuccess) { grid = -1; return; }
        if (hipFuncSetAttribute((const void*)hymba_fwd, hipFuncAttributeMaxDynamicSharedMemorySize, LDS_BYTES) != hipSuccess) { fprintf(stderr, "kernel_launch: hipFuncSetAttribute failed\n"); grid = -1; return; }
        if (hipOccupancyMaxActiveBlocksPerMultiprocessor(&per_cu, (const void*)hymba_fwd, NWAVES * 64, LDS_BYTES) != hipSuccess || per_cu < 1) { fprintf(stderr, "kernel_launch: occupancy query reports %d\n", per_cu); }
        (void)hipGetLastError();
        grid = cus;
    }
    if (grid < 0) return;
    (void)hipMemsetAsync((char*)d_ws + WS_CTL, 0, CTL_ZERO_BYTES, stream);
    Args a{};
    for (int i = 0; i < 18; ++i) a.in[i] = (const float*)d_in[i];
    a.out = (float*)d_out; a.ws = (unsigned char*)d_ws;
#if defined(PROBE_PHASE)
    { const int k = PROBE_PHASE; a.ph_lo = 0; a.ph_hi = k + 1; a.li = 0; hipLaunchKernelGGL(hymba_fwd, dim3(grid), dim3(NWAVES * 64), LDS_BYTES, stream, a);
      for (int r = 1; r < PROBE_REPS; ++r) { a.ph_lo = k; a.ph_hi = k + 1; a.li = 1; hipLaunchKernelGGL(hymba_fwd, dim3(grid), dim3(NWAVES * 64), LDS_BYTES, stream, a); }
      if (k + 1 < PER_PHASE) { a.ph_lo = k + 1; a.ph_hi = PER_PHASE; a.li = 2; hipLaunchKernelGGL(hymba_fwd, dim3(grid), dim3(NWAVES * 64), LDS_BYTES, stream, a); } }
#else
    if (N_LAUNCHES == 1) { a.ph_lo = 0; a.ph_hi = PER_PHASE; a.li = 0; hipLaunchKernelGGL(hymba_fwd, dim3(grid), dim3(NWAVES * 64), LDS_BYTES, stream, a); }
    else for (int li = 0; li < PER_PHASE; ++li) { a.ph_lo = li; a.ph_hi = li + 1; a.li = li; hipLaunchKernelGGL(hymba_fwd, dim3(grid), dim3(NWAVES * 64), LDS_BYTES, stream, a); }
#endif
}
```

```cpp
#include <hip/hip_runtime.h>
#include <hip/hip_bf16.h>
#include <cstdio>
#include <cstdint>
#include <cmath>
namespace pg8 {
#define PG8_LAS __attribute__((address_space(3)))
typedef unsigned short bf16_t;
typedef short bf16x8 __attribute__((ext_vector_type(8)));
typedef float f32x4 __attribute__((ext_vector_type(4)));
typedef float f32x2 __attribute__((ext_vector_type(2)));
typedef unsigned u32x4 __attribute__((ext_vector_type(4)));
constexpr int BM = 256, BK = 64, HALF = 128, HTB = HALF * BK * 2  , STAGE_BYTES = 8 * HTB, NXCD = 8, WGM = 8;

__host__ __device__ __forceinline__ int lds_byte(int r, int c) { const int st = (r >> 4) * 2 + (c >> 5), rr = r & 15, cc = c & 31, ob = rr * 64 + cc * 2; return st * 1024 + (ob ^ (((ob >> 9) & 1) << 5)); }
__host__ __device__ __forceinline__ void stage_rc(int b, int& R, int& C) { const int st = b / 1024, sb = b % 1024, swz = sb ^ (((sb >> 9) & 1) << 5); R = (st >> 1) * 16 + swz / 64; C = (st & 1) * 32 + (swz % 64) / 2; }
__host__ __device__ __forceinline__ int perm32(int rho) { const int n = rho >> 4, i = rho & 15; return 8 * (i >> 2) + 4 * n + (i & 3); }

struct Unit { int pm, pn; unsigned bo; int e, nv, p0; };
struct Gemm { const bf16_t* A; const bf16_t* Bt; int K; };

struct StaticOrder {
    int nM, nN, nwg, G, c;
    __device__ void init(int M, int N, int G_, int c_) { nM = M / BM; nN = N / BM; nwg = nM * nN; G = G_; c = c_; }
    __device__ bool next(int i, Unit& u) const {
        const long L = (long)i * G + c; if (L >= nwg) return false;
        int wgid = (int)L; { const int q = nwg / NXCD, r = nwg % NXCD, xcd = wgid % NXCD, off = wgid / NXCD; wgid = (xcd < r ? xcd * (q + 1) : r * (q + 1) + (xcd - r) * q) + off; }
        const int nig = WGM * nN, gid = wgid / nig, fm = gid * WGM, gsz = (nM - fm) < WGM ? (nM - fm) : WGM;
        u.pm = fm + ((wgid % nig) % gsz); u.pn = (wgid % nig) / gsz; u.bo = 0u; u.e = 0; u.nv = BM; u.p0 = 0; return true;
    }
    __device__ __forceinline__ unsigned arow(const Unit& u, int r) const { return (unsigned)(u.pm * BM + r); }
};

__device__ __forceinline__ unsigned cvt_pk_bf16(float lo, float hi) { unsigned r; asm volatile("v_cvt_pk_bf16_f32 %0, %1, %2" : "=v"(r) : "v"(lo), "v"(hi)); return r; }

template <class Epi, class Sched, bool ALIGN_EPI = false>
__device__ __forceinline__ void gemm_phase(PG8_LAS unsigned char* lds, const Gemm g, const Sched& S, const Epi& E) {
    const int tid = threadIdx.x, wid = __builtin_amdgcn_readfirstlane(tid >> 6), lane = tid & 63, wr = wid >> 2, wc = wid & 3, fr = lane & 15, fq = lane >> 4;
    const int K = g.K, nt = K / BK;
    int RA[2], CA[2]; unsigned voffB[2];
#pragma unroll
    for (int i = 0; i < 2; ++i) { int R, C; stage_rc(tid * 16 + i * 8192, R, C); const int Rb = ((R & ~31) + perm32(R & 31));
        RA[i] = R; CA[i] = C; voffB[i] = (unsigned)(Rb * K + C) * 2u; }
    const size_t kstep = (size_t)(BK * 2);
    const size_t hstep = (size_t)HALF * K * 2;
    const size_t tstep = 2 * hstep;
    const unsigned ldsw = (unsigned)wid * 1024u;
    const int aoff = lds_byte(wr * 64 + fr, fq * 8), boff = lds_byte(wc * 32 + fr, fq * 8);
#define PG8_SA(b, h) (((b) * 2 + (h)) * HTB)
#define PG8_SB(b, h) ((4 + (b) * 2 + (h)) * HTB)
#define PG8_STAGE(bufoff, gbase, voff) do { _Pragma("unroll") for (int _i = 0; _i < 2; ++_i) \
        __builtin_amdgcn_global_load_lds((const unsigned*)((const char*)(gbase) + (voff)[_i]), (PG8_LAS unsigned*)(lds + (bufoff) + ldsw + _i * 8192), 16, 0, 0); } while (0)
#define PG8_LDA(dst, b, h) do { _Pragma("unroll") for (int m = 0; m < 4; ++m) _Pragma("unroll") for (int k = 0; k < 2; ++k) dst[m][k] = *(const PG8_LAS bf16x8*)(lds + PG8_SA(b, h) + aoff + m * 2048 + k * 1024); } while (0)
#define PG8_LDB(dst, b, h) do { _Pragma("unroll") for (int n = 0; n < 2; ++n) _Pragma("unroll") for (int k = 0; k < 2; ++k) dst[n][k] = *(const PG8_LAS bf16x8*)(lds + PG8_SB(b, h) + boff + n * 2048 + k * 1024); } while (0)
#define PG8_MMA(ai, bj, At, Bt) do { __builtin_amdgcn_s_setprio(1); _Pragma("unroll") for (int m = 0; m < 4; ++m) _Pragma("unroll") for (int n = 0; n < 2; ++n) _Pragma("unroll") for (int k = 0; k < 2; ++k) \
        acc[ai][bj][m][n] = __builtin_amdgcn_mfma_f32_16x16x32_bf16(Bt[n][k], At[m][k], acc[ai][bj][m][n], 0, 0, 0); __builtin_amdgcn_s_setprio(0); } while (0)
#define PG8_WAIT_V(n) asm volatile("s_waitcnt vmcnt(" #n ")" ::: "memory")
#define PG8_WAIT_L(n) asm volatile("s_waitcnt lgkmcnt(" #n ")" ::: "memory")
#define PG8_BAR __builtin_amdgcn_s_barrier()
#define PG8_SCHED __builtin_amdgcn_sched_barrier(0)
#define PG8_AOFF(AO, U) do { _Pragma("unroll") for (int _h = 0; _h < 2; ++_h) _Pragma("unroll") for (int _i = 0; _i < 2; ++_i) \
        AO[_h][_i] = (S.arow(U, _h * HALF + RA[_i]) * (unsigned)K + (unsigned)CA[_i]) * 2u; } while (0)
    Unit cur, nxt; int ui = 0;
    if (!S.next(0, cur)) return;
    f32x4 acc[2][2][4][2];
#pragma unroll
    for (int a = 0; a < 2; ++a)
#pragma unroll
        for (int b = 0; b < 2; ++b)
#pragma unroll
            for (int m = 0; m < 4; ++m)
#pragma unroll
                for (int n = 0; n < 2; ++n) acc[a][b][m][n] = (f32x4){0.f, 0.f, 0.f, 0.f};
    bf16x8 At[4][2], B0[2][2], B1[2][2];
    unsigned aoC[2][2], aoN[2][2];
    PG8_AOFF(aoC, cur);
    const char* const gA = (const char*)g.A;
    const char* cB = (const char*)g.Bt + (size_t)cur.bo + (size_t)cur.pn * tstep;
    {
        PG8_STAGE(PG8_SB(0, 0), cB, voffB); PG8_STAGE(PG8_SB(0, 1), cB + hstep, voffB); PG8_STAGE(PG8_SA(0, 0), gA, aoC[0]); PG8_STAGE(PG8_SA(0, 1), gA, aoC[1]);
        if (wr == 1) PG8_BAR;
        PG8_WAIT_V(2); PG8_BAR;
        PG8_STAGE(PG8_SB(1, 0), cB + kstep, voffB); PG8_STAGE(PG8_SA(1, 0), gA + kstep, aoC[0]); PG8_STAGE(PG8_SB(1, 1), cB + hstep + kstep, voffB);
        PG8_WAIT_V(6); PG8_BAR;
    }
    for (;;) {
        const bool has_next = S.next(ui + 1, nxt);
        if (has_next) { PG8_AOFF(aoN, nxt); } else {
#pragma unroll
            for (int _h = 0; _h < 2; ++_h)
#pragma unroll
                for (int _i = 0; _i < 2; ++_i) aoN[_h][_i] = aoC[_h][_i]; }
        const char* nB = has_next ? (const char*)g.Bt + (size_t)nxt.bo + (size_t)nxt.pn * tstep : cB;
        for (int t = 0; t < nt; t += 2) {
            const bool last = (t == nt - 2);
            const char* a1 = gA + (size_t)(t + 1) * kstep;
            const char* a2 = last ? gA : gA + (size_t)(t + 2) * kstep; const char* b2 = last ? nB : cB + (size_t)(t + 2) * kstep;
            const char* a3 = a2 + kstep; const char* b3 = b2 + kstep;
            unsigned ao2[2][2];
#pragma unroll
            for (int _h = 0; _h < 2; ++_h)
#pragma unroll
                for (int _i = 0; _i < 2; ++_i) ao2[_h][_i] = last ? aoN[_h][_i] : aoC[_h][_i];
            PG8_LDB(B0, 0, 0); PG8_LDB(B1, 0, 1); PG8_SCHED; PG8_LDA(At, 0, 0); PG8_STAGE(PG8_SA(1, 1), a1, aoC[1]);
            PG8_WAIT_V(8); PG8_WAIT_L(0); PG8_BAR; PG8_MMA(0, 0, At, B0); PG8_MMA(0, 1, At, B1); PG8_BAR; PG8_SCHED;
            PG8_LDA(At, 0, 1); PG8_STAGE(PG8_SB(0, 0), b2, voffB); PG8_STAGE(PG8_SB(0, 1), b2 + hstep, voffB); PG8_STAGE(PG8_SA(0, 0), a2, ao2[0]);
            PG8_WAIT_V(8); PG8_WAIT_L(0); PG8_BAR; PG8_MMA(1, 0, At, B0); PG8_MMA(1, 1, At, B1); PG8_BAR; PG8_SCHED;
            PG8_LDB(B0, 1, 0); PG8_LDB(B1, 1, 1); PG8_SCHED; PG8_LDA(At, 1, 0); PG8_STAGE(PG8_SA(0, 1), a2, ao2[1]);
            PG8_WAIT_V(8); PG8_WAIT_L(0); PG8_BAR; PG8_MMA(0, 0, At, B0); PG8_MMA(0, 1, At, B1); PG8_BAR; PG8_SCHED;
            PG8_LDA(At, 1, 1); PG8_STAGE(PG8_SB(1, 0), b3, voffB); PG8_STAGE(PG8_SB(1, 1), b3 + hstep, voffB); PG8_STAGE(PG8_SA(1, 0), a3, ao2[0]);
            PG8_WAIT_V(8); PG8_WAIT_L(0); PG8_BAR; PG8_MMA(1, 0, At, B0); PG8_MMA(1, 1, At, B1); PG8_BAR; PG8_SCHED;
        }
        if constexpr (ALIGN_EPI) { if (wr == 0) PG8_BAR; }
        E(acc, cur, wr, wc, fr, fq);
        if (!has_next) break;
#pragma unroll
        for (int a = 0; a < 2; ++a)
#pragma unroll
            for (int b = 0; b < 2; ++b)
#pragma unroll
                for (int m = 0; m < 4; ++m)
#pragma unroll
                    for (int n = 0; n < 2; ++n) acc[a][b][m][n] = (f32x4){0.f, 0.f, 0.f, 0.f};
        cur = nxt; cB = nB; ++ui;
#pragma unroll
        for (int _h = 0; _h < 2; ++_h)
#pragma unroll
            for (int _i = 0; _i < 2; ++_i) aoC[_h][_i] = aoN[_h][_i];
        if constexpr (ALIGN_EPI) { if (wr == 1) PG8_BAR; }
    }
    PG8_WAIT_V(0);
    if constexpr (!ALIGN_EPI) { if (wr == 0) PG8_BAR; }
    PG8_BAR;
#undef PG8_SA
#undef PG8_SB
#undef PG8_STAGE
#undef PG8_LDA
#undef PG8_LDB
#undef PG8_MMA
#undef PG8_WAIT_V
#undef PG8_WAIT_L
#undef PG8_BAR
#undef PG8_SCHED
#undef PG8_AOFF
}
}
namespace pg8 {
__device__ __forceinline__ float row4_sum(float v) {
    { auto r = __builtin_amdgcn_permlane16_swap(__float_as_uint(v), __float_as_uint(v), false, false); v = __uint_as_float(r[0]) + __uint_as_float(r[1]); }
    { auto r = __builtin_amdgcn_permlane32_swap(__float_as_uint(v), __float_as_uint(v), false, false); v = __uint_as_float(r[0]) + __uint_as_float(r[1]); }
    return v;
}
__device__ __forceinline__ u32x4 pack8(const f32x4 v0, const f32x4 v1) { u32x4 w; w.x = cvt_pk_bf16(v0[0], v0[1]); w.y = cvt_pk_bf16(v0[2], v0[3]); w.z = cvt_pk_bf16(v1[0], v1[1]); w.w = cvt_pk_bf16(v1[2], v1[3]); return w; }

struct EpiProj {
    const float* rstd1; const float* qg; const float* kg;
    bf16_t *QN, *KN, *VN, *IQ, *QB, *KB, *VB, *RG, *MISC;
    float qscale, eps;
    __device__ __forceinline__ void operator()(const f32x4 (&acc)[2][2][4][2], const Unit& u, int wr, int wc, int fr, int fq) const {
        const int row0 = u.pm * BM + wr * 64 + fr; const int pn = u.pn;
        float rs1[2][4];
#pragma unroll
        for (int ai = 0; ai < 2; ++ai)
#pragma unroll
            for (int m = 0; m < 4; ++m) rs1[ai][m] = rstd1[row0 + ai * HALF + m * 16];
        if (pn < 4) {
            const bool isq = pn < 2; const float* gp = isq ? qg : kg; bf16_t* O = isq ? QN : KN; const float os = isq ? qscale : 1.f;
            f32x4 gv[2][2];
#pragma unroll
            for (int bj = 0; bj < 2; ++bj)
#pragma unroll
                for (int n = 0; n < 2; ++n) gv[bj][n] = *(const f32x4*)(gp + 32 * bj + 8 * fq + 4 * n) * os;
            const int hcol = (4 * (pn & 1) + wc) * 64 + 8 * fq;
#pragma unroll
            for (int ai = 0; ai < 2; ++ai)
#pragma unroll
                for (int m = 0; m < 4; ++m) { const int row = row0 + ai * HALF + m * 16; const float s = rs1[ai][m];
                    float ss = 0.f;
#pragma unroll
                    for (int bj = 0; bj < 2; ++bj)
#pragma unroll
                        for (int n = 0; n < 2; ++n) { const f32x4 x = acc[ai][bj][m][n]; ss += (x[0] * x[0] + x[1] * x[1]) + (x[2] * x[2] + x[3] * x[3]); }
                    ss = row4_sum(ss);
                    const float r = s * __builtin_amdgcn_rsqf(s * s * ss * (1.f / 64.f) + eps);
                    bf16_t* rowp = O + (size_t)row * 512 + hcol;
#pragma unroll
                    for (int bj = 0; bj < 2; ++bj) *(u32x4*)(rowp + 32 * bj) = pack8(acc[ai][bj][m][0] * r * gv[bj][0], acc[ai][bj][m][1] * r * gv[bj][1]); }
            return;
        }
        bf16_t* O; int pitch, coff, lim = 256;
        if (pn < 6) { O = VN; pitch = 512; coff = (pn - 4) * 256; }
        else if (pn == 6) { O = IQ; pitch = 256; coff = 0; }
        else if (pn == 7) { O = QB; pitch = 256; coff = 0; }
        else if (pn == 8) { O = KB; pitch = 256; coff = 0; }
        else if (pn < 11) { O = VB; pitch = 512; coff = (pn - 9) * 256; }
        else if (pn < 13) { O = RG; pitch = 512; coff = (pn - 11) * 256; }
        else { O = MISC; pitch = 64; coff = 0; lim = 56; }
        const int c0 = wc * 32 + 8 * fq;
#pragma unroll
        for (int ai = 0; ai < 2; ++ai)
#pragma unroll
            for (int m = 0; m < 4; ++m) { const int row = row0 + ai * HALF + m * 16; const float s = rs1[ai][m];
                bf16_t* rowp = O + (size_t)row * pitch + coff + c0;
#pragma unroll
                for (int bj = 0; bj < 2; ++bj) if (c0 + bj * HALF < lim) *(u32x4*)(rowp + bj * HALF) = pack8(acc[ai][bj][m][0] * s, acc[ai][bj][m][1] * s); }
    }
};

struct EpiOut {
    const bf16_t* xb; bf16_t* XN2; float* ROWSS;
    static __device__ __forceinline__ f32x4 lo4(unsigned a, unsigned b) { f32x4 r; r[0] = __uint_as_float(a << 16); r[1] = __uint_as_float(a & 0xffff0000u); r[2] = __uint_as_float(b << 16); r[3] = __uint_as_float(b & 0xffff0000u); return r; }
    __device__ __forceinline__ void operator()(const f32x4 (&acc)[2][2][4][2], const Unit& u, int wr, int wc, int fr, int fq) const {
        const int row0 = u.pm * BM + wr * 64 + fr; const int col0 = u.pn * BM + wc * 32 + 8 * fq;
        u32x4 xv[8][2];
#pragma unroll
        for (int g = 0; g < 8; ++g) { const size_t off_ = (size_t)(row0 + (g >> 2) * HALF + (g & 3) * 16) * 1024 + col0; xv[g][0] = *(const u32x4*)(xb + off_); xv[g][1] = *(const u32x4*)(xb + off_ + HALF); }
#pragma unroll
        for (int g = 0; g < 8; ++g) { const int ai = g >> 2, m = g & 3;
            const int row = row0 + ai * HALF + m * 16; const size_t off = (size_t)row * 1024 + col0; float ss = 0.f;
#pragma unroll
            for (int bj = 0; bj < 2; ++bj) { const u32x4 w = xv[g][bj]; const f32x4 a = lo4(w.x, w.y) + acc[ai][bj][m][0], b = lo4(w.z, w.w) + acc[ai][bj][m][1];
                ss += (a[0] * a[0] + a[1] * a[1]) + (a[2] * a[2] + a[3] * a[3]) + (b[0] * b[0] + b[1] * b[1]) + (b[2] * b[2] + b[3] * b[3]);
                *(u32x4*)(XN2 + off + bj * HALF) = pack8(a, b); }
            ss = row4_sum(ss);
            if (fq == 0) ROWSS[(size_t)row * 16 + u.pn * 4 + wc] = ss; }
    }
};

struct EpiGU {
    const float* LSC; bf16_t* HID;
    __device__ __forceinline__ void operator()(const f32x4 (&acc)[2][2][4][2], const Unit& u, int wr, int wc, int fr, int fq) const {
        const int r0 = wr * 64 + fr; const int c0 = u.pn * HALF + wc * 32 + 8 * fq;
#pragma unroll
        for (int ai = 0; ai < 2; ++ai)
#pragma unroll
            for (int m = 0; m < 4; ++m) { const int r = r0 + ai * HALF + m * 16;
                f32x2 sw = (f32x2){0.f, 0.f};
                if (r < u.nv) sw = *(const f32x2*)(LSC + ((size_t)u.e * 16384 + (size_t)(u.p0 + r)) * 2);
                f32x4 h0, h1;
#pragma unroll
                for (int j = 0; j < 4; ++j) { const float a = acc[ai][0][m][0][j] * sw.x, uu = acc[ai][1][m][0][j] * sw.x; h0[j] = a * __builtin_amdgcn_rcpf(1.f + __expf(-a)) * uu * sw.y;
                                              const float a2 = acc[ai][0][m][1][j] * sw.x, u2 = acc[ai][1][m][1][j] * sw.x; h1[j] = a2 * __builtin_amdgcn_rcpf(1.f + __expf(-a2)) * u2 * sw.y; }
                *(u32x4*)(HID + (size_t)(u.pm * BM + r) * 256 + c0) = pack8(h0, h1); }
    }
};
struct EpiDown {
    bf16_t* Y;
    __device__ __forceinline__ void operator()(const f32x4 (&acc)[2][2][4][2], const Unit& u, int wr, int wc, int fr, int fq) const {
        const int r0 = u.pm * BM + wr * 64 + fr; const int c0 = u.pn * BM + wc * 32 + 8 * fq;
#pragma unroll
        for (int ai = 0; ai < 2; ++ai)
#pragma unroll
            for (int m = 0; m < 4; ++m) { bf16_t* rowp = Y + (size_t)(r0 + ai * HALF + m * 16) * 1024 + c0;
#pragma unroll
                for (int bj = 0; bj < 2; ++bj) *(u32x4*)(rowp + bj * HALF) = pack8(acc[ai][bj][m][0], acc[ai][bj][m][1]); }
    }
};
}
namespace attn_body {
using bf16=__hip_bfloat16;
using bf16x8=__attribute__((ext_vector_type(8)))short;
using s16x4=__attribute__((ext_vector_type(4)))short;
using f32x16=__attribute__((ext_vector_type(16)))float;
using u32x4=__attribute__((ext_vector_type(4)))unsigned;
constexpr int BATCH=8,NHEAD=8,SEQ=2048,D=64,DM=NHEAD*D,PO=1024;
constexpr int NW=8,QBLK=32,QB=QBLK*NW,KVBLK=64,NQB=SEQ/QB;
constexpr int ATTN_UNIT_ROWS=QB;
__device__ __forceinline__ int crow(int r,int hi){return (r&3)+8*(r>>2)+4*hi;}
#define SBAR() __builtin_amdgcn_sched_barrier(0)
typedef float f32x4a __attribute__((ext_vector_type(4)));
__device__ __forceinline__ void tbias(f32x16&p0,f32x16&p1,int t,int qpos,int hi,__attribute__((address_space(3))) const char* tabr){
  int base=qpos-64*t-4*hi; base=base<-4?-4:(base>200?200:base); const int a=200-base, s=a&3;
  const __attribute__((address_space(3))) f32x4a* tp=(const __attribute__((address_space(3))) f32x4a*)(tabr+s*1088+(a-s)*4);
  #pragma unroll
  for(int g=0;g<4;++g){ const f32x4a v0=tp[2*g], v1=tp[2*g+8];
    p0[4*g]+=v0[0];p0[4*g+1]+=v0[1];p0[4*g+2]+=v0[2];p0[4*g+3]+=v0[3]; p1[4*g]+=v1[0];p1[4*g+1]+=v1[1];p1[4*g+2]+=v1[2];p1[4*g+3]+=v1[3];
    asm volatile("":"+v"(p0),"+v"(p1)); }
}
__device__ __forceinline__ float mkeep(float v,unsigned mw,int bit){ const unsigned t=(unsigned)(((int)(mw<<(31-bit)))>>31); return __uint_as_float(__float_as_uint(v)&t); }
constexpr int NSLOT=3, SLOTB=8192;
constexpr int LDS_K=0, LDS_V=NSLOT*SLOTB, LDS_WS=2*NSLOT*SLOTB, LDS_OST=LDS_WS+NW*64*4, LDS_BYTES=LDS_OST+NW*4096, LDS_MSK=LDS_BYTES, LDS_TAB=LDS_MSK+65536, LDS_TOTAL=LDS_TAB+4352;
constexpr float C2=0.125f*1.4426950408889634f;
__device__ __forceinline__ void glds16(const void*gsrc,unsigned lds_dst){unsigned keep;
  asm volatile("s_mov_b32 %0, m0\n\ts_mov_b32 m0, %2\n\ts_nop 0\n\tglobal_load_lds_dwordx4 %1, off\n\ts_mov_b32 m0, %0":"=&s"(keep):"v"(gsrc),"s"(lds_dst):"memory");}
__device__ __forceinline__ float max3f(float a,float b,float c){float r;asm("v_max3_f32 %0, %1, %2, %3":"=v"(r):"v"(a),"v"(b),"v"(c));return r;}
__device__ __forceinline__ float max2f(float a,float b){float r;asm("v_max_f32_e32 %0, %1, %2":"=v"(r):"v"(a),"v"(b));return r;}
__device__ __forceinline__ float fadd_s(float a,float b){float r;asm("v_add_f32_e32 %0, %1, %2":"=v"(r):"v"(a),"v"(b));return r;}
__device__ __forceinline__ float fsub_s(float a,float b){float r;asm("v_sub_f32_e32 %0, %1, %2":"=v"(r):"v"(a),"v"(b));return r;}
typedef float f32x2_t __attribute__((ext_vector_type(2))); typedef __bf16 bf16x2_t __attribute__((ext_vector_type(2)));
__device__ __forceinline__ unsigned cvtpk_s(float lo,float hi){f32x2_t v={lo,hi};bf16x2_t b=__builtin_convertvector(v,bf16x2_t);return __builtin_bit_cast(unsigned,b);}
#define WAIT_BAR(N) asm volatile("s_waitcnt vmcnt(" #N ") lgkmcnt(0)\n\ts_barrier":::"memory")

__device__ __forceinline__ void qkt(f32x16&p0,f32x16&p1,const char*Kslot,const bf16x8*qr,const f32x16&negm,int r32,int hi){
  const char*kb=Kslot+hi*1024+r32*16;
  #pragma unroll
  for(int d0=0;d0<4;++d0){
    const bf16x8 b0=*reinterpret_cast<const bf16x8*>(kb+d0*2048);
    const bf16x8 b1=*reinterpret_cast<const bf16x8*>(kb+d0*2048+512);
    if(d0==0){p0=__builtin_amdgcn_mfma_f32_32x32x16_bf16(b0,qr[0],negm,0,0,0);p1=__builtin_amdgcn_mfma_f32_32x32x16_bf16(b1,qr[0],negm,0,0,0);}
    else{p0=__builtin_amdgcn_mfma_f32_32x32x16_bf16(b0,qr[d0],p0,0,0,0);p1=__builtin_amdgcn_mfma_f32_32x32x16_bf16(b1,qr[d0],p1,0,0,0);}}
}
typedef __attribute__((address_space(3))) const char* lds_cptr;
typedef short v4i16_t __attribute__((ext_vector_type(4)));
__device__ __forceinline__ void kload8(bf16x8*kf,lds_cptr kp){
  kf[0]=*(const __attribute__((address_space(3))) bf16x8*)(kp);      kf[1]=*(const __attribute__((address_space(3))) bf16x8*)(kp+512);
  kf[2]=*(const __attribute__((address_space(3))) bf16x8*)(kp+2048); kf[3]=*(const __attribute__((address_space(3))) bf16x8*)(kp+2560);
  kf[4]=*(const __attribute__((address_space(3))) bf16x8*)(kp+4096); kf[5]=*(const __attribute__((address_space(3))) bf16x8*)(kp+4608);
  kf[6]=*(const __attribute__((address_space(3))) bf16x8*)(kp+6144); kf[7]=*(const __attribute__((address_space(3))) bf16x8*)(kp+6656);
}
__device__ __forceinline__ void kload2(bf16x8*kf,lds_cptr kp,int j){ kf[2*j]=*(const __attribute__((address_space(3))) bf16x8*)(kp+j*2048); kf[2*j+1]=*(const __attribute__((address_space(3))) bf16x8*)(kp+j*2048+512); }
__device__ __forceinline__ s16x4 vtr(lds_cptr p){ return __builtin_bit_cast(s16x4,__builtin_amdgcn_ds_read_tr16_b64_v4i16((__attribute__((address_space(3))) v4i16_t*)p)); }
__device__ __forceinline__ float rowmax(const f32x16&p0,const f32x16&p1){
  float a=max3f(p0[0],p0[1],p1[0]),b=max3f(p0[2],p0[3],p1[1]);a=max3f(a,p1[2],p1[3]);
  #pragma unroll
  for(int r=4;r<16;r+=4){a=max3f(a,p0[r],p0[r+1]);b=max3f(b,p0[r+2],p0[r+3]);a=max3f(a,p1[r],p1[r+1]);b=max3f(b,p1[r+2],p1[r+3]);}
  const float m=max2f(a,b);
  auto rr=__builtin_amdgcn_permlane32_swap(__float_as_uint(m),__float_as_uint(m),false,false);
  return max2f(__uint_as_float(rr[0]),__uint_as_float(rr[1]));
}
__device__ __forceinline__ void pv(f32x16*o,int vb,bf16x8 pa0,bf16x8 pa1,bf16x8 pa2,bf16x8 pa3){
  #pragma unroll
  for(int d0=0;d0<2;++d0){s16x4 lo[4],hi[4];
    #pragma unroll
    for(int ks=0;ks<4;++ks){
      asm volatile("ds_read_b64_tr_b16 %0,%1 offset:%c2":"=&v"(lo[ks]):"v"(vb),"i"(d0*4096+ks*1024):"memory");
      asm volatile("ds_read_b64_tr_b16 %0,%1 offset:%c2":"=&v"(hi[ks]):"v"(vb),"i"(d0*4096+ks*1024+512):"memory");}
    asm volatile("s_waitcnt lgkmcnt(0)":::"memory");SBAR();
    #define PK(k) (bf16x8){lo[k][0],lo[k][1],lo[k][2],lo[k][3],hi[k][0],hi[k][1],hi[k][2],hi[k][3]}
    o[d0]=__builtin_amdgcn_mfma_f32_32x32x16_bf16(pa0,PK(0),o[d0],0,0,0);
    o[d0]=__builtin_amdgcn_mfma_f32_32x32x16_bf16(pa1,PK(1),o[d0],0,0,0);
    o[d0]=__builtin_amdgcn_mfma_f32_32x32x16_bf16(pa2,PK(2),o[d0],0,0,0);
    o[d0]=__builtin_amdgcn_mfma_f32_32x32x16_bf16(pa3,PK(3),o[d0],0,0,0);
    #undef PK
  }
}

#ifndef ATTN_STORE16
#define ATTN_STORE16(p,v) (*(u32x4*)(p)=(v))
#endif
template<int THRL> __device__ __forceinline__ void attn_unit(int b,int h,int qb,const bf16*Q,const bf16*__restrict__ K,const bf16*__restrict__ V,bf16*O,const unsigned*__restrict__ MASK,const float*__restrict__ relb,char*shm){
  int tid0_=threadIdx.x; asm volatile("":"+v"(tid0_));
  const int tid=tid0_,lane=tid&63,r32=lane&31,hi=lane>>5; const int wid=__builtin_amdgcn_readfirstlane(tid>>6);
  const long rowbase=(long)b*SEQ; const int q0=qb*QB;
  const bf16*Qw=Q+(rowbase+q0+wid*QBLK)*DM+h*D;
  const bf16*Kh=K+rowbase*DM+h*D,*Vh=V+rowbase*DM+h*D;
  const unsigned lds0=(unsigned)(uintptr_t)shm;
  float*wsf=(float*)(shm+LDS_WS)+wid*64;
  const bf16*ksrc=Kh+(long)lane*DM+wid*8;
  const bf16*vsrc=Vh+(long)(16*(wid&3)+(lane>>2))*DM+(wid>>2)*32+(lane&3)*8;
  const unsigned kdst=lds0+LDS_K+wid*1024, vdst=lds0+LDS_V+wid*1024;
  #define DMA_K(t,slot) glds16(ksrc+(long)(t)*KVBLK*DM,(unsigned)__builtin_amdgcn_readfirstlane(kdst+(slot)))
  #define DMA_V(t,slot) glds16(vsrc+(long)(t)*KVBLK*DM,(unsigned)__builtin_amdgcn_readfirstlane(vdst+(slot)))
  const int vb0=(int)(lds0+LDS_V)+((lane>>4)&1)*32+(lane&3)*8+(4*hi+((lane&15)>>2))*64;
  const char*Kbase=shm+LDS_K; bf16x8 kf[8];
  const lds_cptr shm3=(lds_cptr)shm; const lds_cptr kp0=shm3+LDS_K+hi*1024+r32*16; const lds_cptr vp0=shm3+LDS_V+((lane>>4)&1)*32+(lane&3)*8+(4*hi+((lane&15)>>2))*64;
  const int NT=(q0+QB)/KVBLK;
  const unsigned*mskw=(const unsigned*)(shm+LDS_MSK)+(wid*QBLK+r32)*2+hi;
  const int qpos=q0+wid*QBLK+r32;
  DMA_K(0,0);DMA_V(0,0);DMA_K(1,SLOTB);
  bf16x8 qr[4];
  #pragma unroll
  for(int d0=0;d0<4;++d0)qr[d0]=*reinterpret_cast<const bf16x8*>(&Qw[(long)r32*DM+d0*16+hi*8]);
  float mhat=0.f,l_reg=0.f;f32x16 o[2];o[0]=f32x16{};o[1]=f32x16{};f32x16 negm=f32x16{};asm volatile("":"+v"(negm));
  #define CMASK(P0,P1,t) do{ if((t)>=NT-7 && 64*(t)+63+127>=q0+wid*QBLK) tbias(P0,P1,(t),qpos,hi,shm3+LDS_TAB); }while(0)
  bool resc=false;
  #define START(P0,P1) do{ const float rm=rowmax(P0,P1); resc=false; \
    { const float dl=rm; mhat=fadd_s(mhat,dl); \
      _Pragma("unroll") for(int r=0;r<16;++r){P0[r]=fsub_s(P0[r],dl);P1[r]=fsub_s(P1[r],dl);} \
      _Pragma("unroll") for(int r=0;r<16;++r)negm[r]=-mhat; asm volatile("":"+v"(negm)); } \
    _Pragma("unroll") for(int r=0;r<16;++r)P0[r]=__builtin_amdgcn_exp2f(P0[r]); }while(0)
  #define RESC() do{ if(resc){ asm volatile("s_waitcnt lgkmcnt(0)":::"memory"); \
      _Pragma("unroll") for(int d_=0;d_<2;++d_) _Pragma("unroll") for(int r=0;r<16;++r)o[d_][r]*=wsf[crow(r,hi)]; } }while(0)
  f32x16 pA0,pA1,pB0,pB1;
  int sl_prev=0,sl_cur=0,sl_next=SLOTB;
  #define ROT() do{sl_prev=sl_cur;sl_cur=sl_next;sl_next=(sl_next==(NSLOT-1)*SLOTB)?0:sl_next+SLOTB;}while(0)
  DMA_K(2,2*SLOTB);
  { int tid_=tid; asm volatile("":"+v"(tid_));
    const u32x4*msrc=(const u32x4*)(MASK+((size_t)(b*32)*SEQ+q0)*2); u32x4*mdst=(u32x4*)(shm+LDS_MSK);
    u32x4 mv[8]; const int nit=NT>>2;
    _Pragma("unroll") for(int k=0;k<8;++k){ const int i=tid_+k*(NW*64); if(k<nit) mv[k]=msrc[(size_t)(i>>7)*(SEQ*2/4)+(i&127)]; }
    _Pragma("unroll") for(int k=0;k<8;++k){ const int i=tid_+k*(NW*64); if(k<nit) mdst[i]=mv[k]; }
    for(int i=tid_;i<4*272;i+=NW*64){ const int sft=i/272, k=i-sft*272, d=200-(k+sft); float v=0.f;
      if(d>=0&&d<=112){ int bk; if(d<16)bk=d; else { bk=16+(int)(logf((float)d*(1.0f/16.0f))/2.0794415416798357f*16.0f); bk=bk>31?31:bk; } v=(relb[bk*NHEAD+h]-relb[31*NHEAD+h])*1.4426950408889634f; }
      ((float*)(shm+LDS_TAB))[i]=v; } }
  WAIT_BAR(3);
  qkt(pA0,pA1,Kbase,qr,negm,r32,hi);asm volatile("s_nop 15\n\ts_nop 7":"+v"(pA0),"+v"(pA1));CMASK(pA0,pA1,0);
  START(pA0,pA1);
  _Pragma("unroll") for(int r=0;r<16;++r)pA1[r]=__builtin_amdgcn_exp2f(pA1[r]);
  { const unsigned mw0=mskw[0]; _Pragma("unroll") for(int r=0;r<16;++r){pA0[r]=mkeep(pA0[r],mw0,r);pA1[r]=mkeep(pA1[r],mw0,16+r);} }
  WAIT_BAR(0);
  DMA_K(3,0);DMA_V(1,SLOTB);
  ROT();
  kload8(kf,kp0+sl_cur);
  WAIT_BAR(2);
  s16x4 vlo[8],vhi[8]; u32x4 pw0,pw1,pw2,pw3;
  #define PKW(P,B) cvtpk_s(P[B],P[B+1])
  #define PAF(k) __builtin_bit_cast(bf16x8,pw##k)
  #define VFR(i) (bf16x8){vlo[i][0],vlo[i][1],vlo[i][2],vlo[i][3],vhi[i][0],vhi[i][1],vhi[i][2],vhi[i][3]}
  #define PIN(x) asm volatile("":"+v"(x))
  #define MX3(a,b,c) __builtin_fmaxf(__builtin_fmaxf((a),(b)),(c))
  #define GAPA(MF,A0,A1,A2,A3,W0,W1,PW) do{ MF; sacc+=A0; sacc+=A1; sacc+=A2; sacc+=A3; PIN(sacc); W0; W1; PIN(PW); SBAR(); }while(0)
  #define EX(v) __builtin_amdgcn_exp2f(v)
  #define GAPB(MF,X,B,MB) do{ MF; X[B]=mkeep(EX(X[B]),mw_,MB+B); X[B+1]=mkeep(EX(X[B+1]),mw_,MB+B+1); X[B+2]=mkeep(EX(X[B+2]),mw_,MB+B+2); X[B+3]=mkeep(EX(X[B+3]),mw_,MB+B+3); PIN(X); SBAR(); }while(0)
  #define VRD(i) do{ vlo[i]=vtr(vp_+(((i)>>2)*4096+((i)&3)*1024)); vhi[i]=vtr(vp_+(((i)>>2)*4096+((i)&3)*1024+512)); }while(0)
  #define KRD(G,j) do{ if(G){ kload2(kf,kp0+sl_next,j); SBAR(); } }while(0)
  #define STEP(C0,C1,P0,P1,t,GK,GV,GL) do{ SBAR(); \
    const lds_cptr vp_=vp0+sl_prev; const unsigned mw_=mskw[(t)*512]; \
    VRD(0); SBAR(); float sacc=(P0[0]+P0[1]); \
    GAPA(C0=__builtin_amdgcn_mfma_f32_32x32x16_bf16(kf[0],qr[0],negm,0,0,0), P0[2],P0[3],P0[4],P0[5],     pw0[0]=PKW(P0,0), pw0[1]=PKW(P0,2), pw0); \
    VRD(4); SBAR(); GAPA(C1=__builtin_amdgcn_mfma_f32_32x32x16_bf16(kf[1],qr[0],negm,0,0,0), P0[6],P0[7],P0[8],P0[9],     pw0[2]=PKW(P0,4), pw0[3]=PKW(P0,6), pw0); \
    VRD(1); SBAR(); GAPA(C0=__builtin_amdgcn_mfma_f32_32x32x16_bf16(kf[2],qr[1],C0,0,0,0),   P0[10],P0[11],P0[12],P0[13], pw1[0]=PKW(P0,8), pw1[1]=PKW(P0,10), pw1); \
    VRD(5); SBAR(); GAPA(C1=__builtin_amdgcn_mfma_f32_32x32x16_bf16(kf[3],qr[1],C1,0,0,0),   P0[14],P0[15],P1[0],P1[1],   pw1[2]=PKW(P0,12),pw1[3]=PKW(P0,14), pw1); \
    VRD(2); SBAR(); GAPA(C0=__builtin_amdgcn_mfma_f32_32x32x16_bf16(kf[4],qr[2],C0,0,0,0),   P1[2],P1[3],P1[4],P1[5],     pw2[0]=PKW(P1,0), pw2[1]=PKW(P1,2), pw2); \
    VRD(6); SBAR(); GAPA(C1=__builtin_amdgcn_mfma_f32_32x32x16_bf16(kf[5],qr[2],C1,0,0,0),   P1[6],P1[7],P1[8],P1[9],     pw2[2]=PKW(P1,4), pw2[3]=PKW(P1,6), pw2); \
    VRD(3); SBAR(); GAPA(C0=__builtin_amdgcn_mfma_f32_32x32x16_bf16(kf[6],qr[3],C0,0,0,0),   P1[10],P1[11],P1[12],P1[13], pw3[0]=PKW(P1,8), pw3[1]=PKW(P1,10), pw3); \
    VRD(7); SBAR(); GAPA(C1=__builtin_amdgcn_mfma_f32_32x32x16_bf16(kf[7],qr[3],C1,0,0,0),   P1[14],P1[15],0.f,0.f,       pw3[2]=PKW(P1,12),pw3[3]=PKW(P1,14), pw3); \
    l_reg+=sacc; \
    if(GK){DMA_K((t)+3,sl_cur);} if(GV){DMA_V((t)+1,sl_next);} \
    CMASK(C0,C1,t); \
    { float a=MX3(C0[0],C0[1],C1[0]),b=MX3(C0[2],C0[3],C1[1]); a=MX3(a,C1[2],C1[3]); \
      _Pragma("unroll") for(int r=4;r<16;r+=4){a=MX3(a,C0[r],C0[r+1]);b=MX3(b,C0[r+2],C0[r+3]);a=MX3(a,C1[r],C1[r+1]);b=MX3(b,C1[r+2],C1[r+3]);} \
      float rm=__builtin_fmaxf(a,b); { auto rr=__builtin_amdgcn_permlane32_swap(__float_as_uint(rm),__float_as_uint(rm),false,false); rm=__builtin_fmaxf(__uint_as_float(rr[0]),__uint_as_float(rr[1])); } \
      resc=false; \
      if(__builtin_expect(__any(rm>(float)THRL),0)){ const float dl=__builtin_fmaxf(rm,0.f); mhat+=dl; \
        _Pragma("unroll") for(int r=0;r<16;++r){C0[r]-=dl;C1[r]-=dl;} \
        _Pragma("unroll") for(int r=0;r<16;++r)negm[r]=-mhat; asm volatile("":"+v"(negm)); \
        const float f=__builtin_amdgcn_exp2f(-dl); l_reg*=f; if(hi==0)wsf[r32]=f; resc=true; } } \
    SBAR(); \
    GAPB(o[0]=__builtin_amdgcn_mfma_f32_32x32x16_bf16(PAF(0),VFR(0),o[0],0,0,0), C0,0,0); \
    GAPB(o[1]=__builtin_amdgcn_mfma_f32_32x32x16_bf16(PAF(0),VFR(4),o[1],0,0,0), C0,4,0); \
    KRD(GL,0); GAPB(o[0]=__builtin_amdgcn_mfma_f32_32x32x16_bf16(PAF(1),VFR(1),o[0],0,0,0), C0,8,0); \
    KRD(GL,1); GAPB(o[1]=__builtin_amdgcn_mfma_f32_32x32x16_bf16(PAF(1),VFR(5),o[1],0,0,0), C0,12,0); \
    KRD(GL,2); GAPB(o[0]=__builtin_amdgcn_mfma_f32_32x32x16_bf16(PAF(2),VFR(2),o[0],0,0,0), C1,0,16); \
    KRD(GL,3); GAPB(o[1]=__builtin_amdgcn_mfma_f32_32x32x16_bf16(PAF(2),VFR(6),o[1],0,0,0), C1,4,16); \
    GAPB(o[0]=__builtin_amdgcn_mfma_f32_32x32x16_bf16(PAF(3),VFR(3),o[0],0,0,0), C1,8,16); \
    GAPB(o[1]=__builtin_amdgcn_mfma_f32_32x32x16_bf16(PAF(3),VFR(7),o[1],0,0,0), C1,12,16); \
    }while(0)
  int t=1;
  #undef CMASK
  #define CMASK(P0,P1,t) do{}while(0)
  for(;t+7<NT;t+=2){
    STEP(pB0,pB1,pA0,pA1,t,true,true,true);     WAIT_BAR(2); RESC(); ROT();
    STEP(pA0,pA1,pB0,pB1,t+1,true,true,true);   WAIT_BAR(2); RESC(); ROT();
  }
  #undef CMASK
  #define CMASK(P0,P1,t) do{ if(64*(t)+63+127>=q0+wid*QBLK) tbias(P0,P1,(t),qpos,hi,shm3+LDS_TAB); }while(0)
  #define ENDW(tt) do{ if((tt)+3<NT){WAIT_BAR(2);} else if((tt)+2<NT){WAIT_BAR(1);} else {WAIT_BAR(0);} }while(0)
  for(;t+1<NT;t+=2){
    STEP(pB0,pB1,pA0,pA1,t,(t+3<NT),(t+1<NT),(t+1<NT));       ENDW(t);   RESC(); ROT();
    STEP(pA0,pA1,pB0,pB1,t+1,(t+4<NT),(t+2<NT),(t+2<NT));     ENDW(t+1); RESC(); ROT();
  }
  STEP(pB0,pB1,pA0,pA1,NT-1,false,false,false); RESC();
  { float sacc=pB0[0]+pB0[1]; _Pragma("unroll") for(int r=2;r<16;++r)sacc+=pB0[r]; _Pragma("unroll") for(int r=0;r<16;++r)sacc+=pB1[r]; l_reg+=sacc;
    pw0=(u32x4){PKW(pB0,0),PKW(pB0,2),PKW(pB0,4),PKW(pB0,6)};pw1=(u32x4){PKW(pB0,8),PKW(pB0,10),PKW(pB0,12),PKW(pB0,14)};pw2=(u32x4){PKW(pB1,0),PKW(pB1,2),PKW(pB1,4),PKW(pB1,6)};pw3=(u32x4){PKW(pB1,8),PKW(pB1,10),PKW(pB1,12),PKW(pB1,14)};
    SBAR(); pv(o,vb0+sl_cur,PAF(0),PAF(1),PAF(2),PAF(3)); }
  #undef PKW
  #undef PAF
  #undef VFR
  #undef PIN
  #undef MX3
  #undef GAPA
  #undef GAPB
  #undef EX
  #undef VRD
  #undef KRD
  #undef STEP
  #undef ENDW
  {auto rr=__builtin_amdgcn_permlane32_swap(__float_as_uint(l_reg),__float_as_uint(l_reg),false,false);l_reg=__uint_as_float(rr[0])+__uint_as_float(rr[1]);}
  if(hi==0)wsf[32+r32]=l_reg;asm volatile("s_waitcnt lgkmcnt(0)":::"memory");
  float rli[16];
  #pragma unroll
  for(int r=0;r<16;++r)rli[r]=__builtin_amdgcn_rcpf(wsf[32+crow(r,hi)]);
  bf16*Ow=O+(rowbase+q0+wid*QBLK)*PO+h*D;
  { bf16*stg=(bf16*)(shm+LDS_OST)+wid*2048;
    #pragma unroll
    for(int r=0;r<16;++r){const int orow=crow(r,hi);
      #pragma unroll
      for(int d0=0;d0<2;++d0)stg[orow*64+d0*32+r32]=__float2bfloat16(o[d0][r]*rli[r]);}
    asm volatile("s_waitcnt lgkmcnt(0)":::"memory");
    #pragma unroll
    for(int i=0;i<4;++i){const int row=i*8+(lane>>3),ch=lane&7; const u32x4 v=*(const u32x4*)(stg+row*64+ch*8); ATTN_STORE16(Ow+(long)row*PO+ch*8,v);} }
  asm volatile("s_waitcnt lgkmcnt(0)\n\ts_barrier":::"memory");
  #undef DMA_K
  #undef DMA_V
  #undef CMASK
  #undef START
  #undef RESC
  #undef ROT
}
struct AttnTensors { const bf16* Q; const bf16* K; const bf16* V; bf16* O; const unsigned* MASK; const float* relb; };
struct AttnUnit { int bh; int qb; };
constexpr int ATTN_LDS_BYTES=LDS_TOTAL;
#undef SBAR
#undef WAIT_BAR
}
constexpr int NWAVES = 8;
#ifndef MK_N_LAUNCHES
#define MK_N_LAUNCHES 1
#endif
constexpr int PER_PHASE = 10;
constexpr int N_LAUNCHES = (MK_N_LAUNCHES == 1) ? 1 : PER_PHASE;
constexpr int M = 8 * 2048;
constexpr size_t MiB = 1u << 20;
constexpr size_t WS_CTL = 0, CTL_ZERO_BYTES = 65536;
constexpr size_t WS_RSTD1 = 1 * MiB, WS_ROWSS = 2 * MiB, WS_WR = 3 * MiB, WS_BLAST = 3 * MiB + 512 * 1024, WS_TOKINFO = 4 * MiB, WS_LISTS = 5 * MiB, WS_LSC = 7 * MiB;
constexpr size_t WS_WO = 16 * MiB, WS_WGU = 18 * MiB, WS_WD = 50 * MiB, WS_XB = 66 * MiB, WS_WIN = 98 * MiB;
constexpr size_t OB_MASK = 0, OB_SB = 4 * MiB, OB_EG = 20 * MiB  ;
constexpr size_t WS_QN = 106 * MiB, WS_KN = 122 * MiB, WS_VN = 138 * MiB, WS_XN2 = 106 * MiB, WS_IQ = 154 * MiB, WS_MISC = 162 * MiB, WS_QB = 164 * MiB, WS_KB = 172 * MiB, WS_VB = 180 * MiB, WS_RG = 196 * MiB;
constexpr size_t WS_MIX = 212 * MiB, WS_HID = 138 * MiB, WS_Y = 158 * MiB, WS_END = 244 * MiB;
constexpr int CW_TMO = 0, CW_CODE = 1, CW_BAR = 4096, CW_CNT = 15360;
constexpr int RING_BYTES = 154624;
constexpr int LDSCTL_OFF = RING_BYTES, MISC_OFF = LDSCTL_OFF, TOFF_OFF = LDSCTL_OFF + 256;
constexpr int LDS_BYTES = RING_BYTES + 1280;
static_assert(attn_body::ATTN_LDS_BYTES <= RING_BYTES, "attention LDS");
#ifndef REP_IDX
#define REP_IDX 1
#endif
#ifndef REP_GLAA
#define REP_GLAA 1
#endif
#ifndef REP_ATT
#define REP_ATT 1
#endif
#ifndef REP_GLAC
#define REP_GLAC 1
#endif
#ifndef REP_IDX_SCORE
#define REP_IDX_SCORE 1
#endif
#ifndef REP_IDX_SEL
#define REP_IDX_SEL 1
#endif
#ifndef REP_SEL_A
#define REP_SEL_A 1
#endif
#ifndef REP_SEL_B
#define REP_SEL_B 1
#endif
#ifndef REP_SEL_C
#define REP_SEL_C 1
#endif
#ifndef REP_SEL_CNT
#define REP_SEL_CNT 1
#endif
#ifndef REP_SEL_ST
#define REP_SEL_ST 1
#endif
#ifndef REP_SKGU
#define REP_SKGU 1
#endif
#ifndef REP_SKDN
#define REP_SKDN 1
#endif
#define GAS __attribute__((address_space(1)))
#define LAS __attribute__((address_space(3)))
typedef unsigned short bf16;
typedef unsigned v4u __attribute__((ext_vector_type(4)));
typedef float f32x4 __attribute__((ext_vector_type(4)));
typedef short bf16x8 __attribute__((ext_vector_type(8)));
typedef GAS unsigned gu32;
typedef GAS unsigned long long gu64;
#define RLX_AGENT __ATOMIC_RELAXED, __HIP_MEMORY_SCOPE_AGENT
#define LDS_WAIT() asm volatile("s_waitcnt lgkmcnt(0)" ::: "memory")
#define VM_WAIT() asm volatile("s_waitcnt vmcnt(0)" ::: "memory")
__device__ __forceinline__ unsigned long long rt() { return __builtin_amdgcn_s_memrealtime(); }
__device__ __forceinline__ unsigned f2bf(float f) { unsigned u = __builtin_bit_cast(unsigned, f); return (u + 0x7fffu + ((u >> 16) & 1u)) >> 16; }
__device__ __forceinline__ unsigned pk2(float lo, float hi) { return f2bf(lo) | (f2bf(hi) << 16); }

#define XB_TMO      128
#define XB_XCNT(j)  (256  + 64 * (j))
#define XB_XSUB(j)  (1280 + 64 * (j))
#define XB_XGEN(j)  (2304 + 64 * (j))
#define XB_TOP      3328
#define XB_TOPGEN   3392
#define XCD_BAR_WORDS 3456
#define XB_SPIN_CAP (1u << 18)

__device__ __forceinline__ unsigned xb_ld(unsigned* p)              { return __hip_atomic_load(p, __ATOMIC_RELAXED, __HIP_MEMORY_SCOPE_AGENT); }
__device__ __forceinline__ unsigned xb_add(unsigned* p, unsigned v) { return __hip_atomic_fetch_add(p, v, __ATOMIC_RELAXED, __HIP_MEMORY_SCOPE_AGENT); }
__device__ __forceinline__ unsigned xb_xcc_id() { return (unsigned)__builtin_amdgcn_s_getreg((3 << 11) | 20) & 0xFu; }
#define XB_SPIN(cond, bar) do { unsigned _sp = 0; while (cond) { __builtin_amdgcn_s_sleep(1); \
    if ((++_sp & 255u) == 0u) { if (xb_ld(&(bar)[XB_TMO])) break; if (_sp > XB_SPIN_CAP) { atomicAdd(&(bar)[XB_TMO], 1u); break; } } } } while (0)

struct XcdBarrier {
    unsigned* bar; unsigned x;
    volatile LAS unsigned* st;
};

__device__ __forceinline__ XcdBarrier xcd_barrier_post(unsigned* bar, volatile LAS unsigned* st) {
    XcdBarrier b; b.bar = bar; b.x = xb_xcc_id(); b.st = st;
    if (threadIdx.x == 0) (void)xb_add(&bar[XB_XCNT(b.x)], 1u);
    return b;
}
__device__ __forceinline__ void xcd_barrier_complete(unsigned* bar, unsigned x, unsigned& nloc, unsigned& nx) {
    const unsigned G = gridDim.x * gridDim.y * gridDim.z;
    unsigned sum, cnt, mine, sp = 0u;
    for (;;) {
        sum = 0u; cnt = 0u; mine = 0u;
#pragma unroll
        for (unsigned j = 0; j < 16; ++j) { const unsigned c = xb_ld(&bar[XB_XCNT(j)]); sum += c; cnt += (c > 0u) ? 1u : 0u; mine = (j == x) ? c : mine; }
        if (sum == G) break;
        __builtin_amdgcn_s_sleep(1);
        if ((++sp & 255u) == 0u) { if (xb_ld(&bar[XB_TMO])) break; if (sp > XB_SPIN_CAP) { atomicAdd(&bar[XB_TMO], 1u); break; } }
    }
    nloc = mine > 0u ? mine : 1u; nx = cnt > 0u ? cnt : 1u;
}

__device__ __forceinline__ void xcd_barrier(const XcdBarrier& b) {
    asm volatile("s_waitcnt vmcnt(0)" ::: "memory");
    __syncthreads();
    if (threadIdx.x == 0) {
        unsigned* bar = b.bar;
        __builtin_amdgcn_s_waitcnt(0);
        unsigned nloc = b.st[0], nx = b.st[1];
        if (nloc == 0u) { xcd_barrier_complete(bar, b.x, nloc, nx); b.st[0] = nloc; b.st[1] = nx; }
        const unsigned old = xb_add(&bar[XB_XSUB(b.x)], 1u);
        const unsigned gen = old / nloc;
        if (old + 1u == (gen + 1u) * nloc) {
            __builtin_amdgcn_fence(__ATOMIC_RELEASE, "agent");
            asm volatile("s_waitcnt vmcnt(0)" ::: "memory");
            const unsigned og = xb_add(&bar[XB_TOP], 1u);
            const unsigned tg = og / nx;
            if (og + 1u == (tg + 1u) * nx) xb_add(&bar[XB_TOPGEN], 1u);
            else XB_SPIN(xb_ld(&bar[XB_TOPGEN]) == tg, bar);
            __builtin_amdgcn_fence(__ATOMIC_ACQUIRE, "agent");
            xb_add(&bar[XB_XGEN(b.x)], 1u);
            asm volatile("s_waitcnt vmcnt(0)" ::: "memory");
        } else {
            XB_SPIN(xb_ld(&bar[XB_XGEN(b.x)]) == gen, bar);
            __builtin_amdgcn_fence(__ATOMIC_ACQUIRE, "agent");
            asm volatile("s_waitcnt vmcnt(0)" ::: "memory");
        }
    }
    __syncthreads();
}
typedef float f32x2 __attribute__((ext_vector_type(2)));
typedef unsigned v2u __attribute__((ext_vector_type(2)));
__device__ __forceinline__ float bf2f(unsigned short b) { return __uint_as_float((unsigned)b << 16); }
__device__ __forceinline__ float bflo(unsigned w) { return __uint_as_float(w << 16); }
__device__ __forceinline__ float bfhi(unsigned w) { return __uint_as_float(w & 0xffff0000u); }
__device__ __forceinline__ float wave_sum(float v) {
#pragma unroll
    for (int o = 1; o < 64; o <<= 1) v += __shfl_xor(v, o);
    return v;
}
__device__ __forceinline__ float wave_max(float v) {
#pragma unroll
    for (int o = 1; o < 64; o <<= 1) v = fmaxf(v, __shfl_xor(v, o));
    return v;
}
__device__ __forceinline__ float wave_min(float v) {
#pragma unroll
    for (int o = 1; o < 64; o <<= 1) v = fminf(v, __shfl_xor(v, o));
    return v;
}
#define WG_SYNC() __syncthreads()
#define DPP_STEP_I(v, ctrl) __builtin_amdgcn_update_dpp(0, (v), (ctrl), 0xF, 0xF, false)
__device__ __forceinline__ int wave_isum(int v) {
    v += DPP_STEP_I(v, 0xB1); v += DPP_STEP_I(v, 0x4E); v += DPP_STEP_I(v, 0x141); v += DPP_STEP_I(v, 0x140);
    return __builtin_amdgcn_readlane(v, 0) + __builtin_amdgcn_readlane(v, 16) + __builtin_amdgcn_readlane(v, 32) + __builtin_amdgcn_readlane(v, 48);
}
#define DPP_STEP_F(v, ctrl) __uint_as_float((unsigned)__builtin_amdgcn_update_dpp(0, (int)__float_as_uint(v), (ctrl), 0xF, 0xF, false))
#define RDL_F(v, l) __uint_as_float((unsigned)__builtin_amdgcn_readlane((int)__float_as_uint(v), (l)))
__device__ __forceinline__ float wave_fsum(float v) {
    v += DPP_STEP_F(v, 0xB1); v += DPP_STEP_F(v, 0x4E); v += DPP_STEP_F(v, 0x141); v += DPP_STEP_F(v, 0x140);
    return (RDL_F(v, 0) + RDL_F(v, 16)) + (RDL_F(v, 32) + RDL_F(v, 48));
}
__device__ __forceinline__ float wave_fmax(float v) {
    v = fmaxf(v, DPP_STEP_F(v, 0xB1)); v = fmaxf(v, DPP_STEP_F(v, 0x4E)); v = fmaxf(v, DPP_STEP_F(v, 0x141)); v = fmaxf(v, DPP_STEP_F(v, 0x140));
    return fmaxf(fmaxf(RDL_F(v, 0), RDL_F(v, 16)), fmaxf(RDL_F(v, 32), RDL_F(v, 48)));
}
__device__ __forceinline__ float wave_fmin(float v) {
    v = fminf(v, DPP_STEP_F(v, 0xB1)); v = fminf(v, DPP_STEP_F(v, 0x4E)); v = fminf(v, DPP_STEP_F(v, 0x141)); v = fminf(v, DPP_STEP_F(v, 0x140));
    return fminf(fminf(RDL_F(v, 0), RDL_F(v, 16)), fminf(RDL_F(v, 32), RDL_F(v, 48)));
}

__device__ __forceinline__ int win_vrow(int n) {
    if (n < 1024) { const int base = (n < 512) ? 0 : 512, m = n - base, hh = m >> 6, d = m & 63; return base + 256 * (hh >> 2) + 128 * (d >> 5) + 32 * (hh & 3) + (d & 31); }
    if (n < 1792) return n;
    if (n < 1832) return 3328 + (n - 1792);
    if (n < 2088) return 1792 + (n - 1832);
    if (n < 2344) return 2048 + (n - 2088);
    if (n < 2856) return 2304 + (n - 2344);
    if (n < 2872) return 3328 + 40 + (n - 2856);
    return 2816 + (n - 2872);
}
template <int KIND>
__device__ __forceinline__ void p0_transpose_item(const float* __restrict__ W, int K, int N, const float* __restrict__ gain, bf16* WT, LAS float* scr, int item, int lane) {
    const int nblk = (N + 31) / 32, kb = item / nblk, nb = item % nblk, k0 = 64 * kb, n0 = 32 * nb;
    f32x4 v[8];
#pragma unroll
    for (int j = 0; j < 8; ++j) { const int i = lane + 64 * j, kk = i >> 3, c4 = (i & 7) * 4; v[j] = (n0 + c4 < N) ? *(const f32x4*)(W + (size_t)(k0 + kk) * N + n0 + c4) : (f32x4){0.f, 0.f, 0.f, 0.f}; }
#pragma unroll
    for (int j = 0; j < 8; ++j) { const int i = lane + 64 * j, kk = i >> 3, c4 = (i & 7) * 4; f32x4 x = v[j]; if (gain) x = x * gain[k0 + kk];
        scr[kk * 33 + c4] = x[0]; scr[kk * 33 + c4 + 1] = x[1]; scr[kk * 33 + c4 + 2] = x[2]; scr[kk * 33 + c4 + 3] = x[3]; }
    LDS_WAIT(); asm volatile("" ::: "memory");
    const int c = lane & 7;
#pragma unroll
    for (int j = 0; j < 4; ++j) { const int n = (lane >> 3) + 8 * j; const LAS float* s = scr + (8 * c) * 33 + n;
        v4u o; o.x = pg8::cvt_pk_bf16(s[0 * 33], s[1 * 33]); o.y = pg8::cvt_pk_bf16(s[2 * 33], s[3 * 33]); o.z = pg8::cvt_pk_bf16(s[4 * 33], s[5 * 33]); o.w = pg8::cvt_pk_bf16(s[6 * 33], s[7 * 33]);
        const int gn = n0 + n; int row;
        if (KIND == 0) row = win_vrow(gn); else if (KIND == 1) row = gn; else if (KIND == 2) row = (gn >> 7) * 256 + (gn & 127); else row = (gn >> 7) * 256 + 128 + (gn & 127);
        if (gn < N) *(GAS v4u*)(WT + (size_t)row * K + k0 + 8 * c) = o; }
    LDS_WAIT(); asm volatile("" ::: "memory");
}

constexpr int SCP = 2064;
__device__ __forceinline__ int crow_(int r, int hi) { return (r & 3) + 8 * (r >> 2) + 4 * hi; }
__device__ __forceinline__ void idx_item(LAS unsigned char* lds, int b, int p, const bf16* __restrict__ IQ, const bf16* __restrict__ MISC, unsigned* __restrict__ MASK, int lane, int wid) {
    const int q0 = p * 16, fr = lane & 15, fq = lane >> 4;
    LAS float* SC = (LAS float*)lds;
    const size_t rowq = (size_t)b * 2048 + q0 + fr;
    bf16x8 Bq[8]; float sinf[8];
    {   const v4u wraw = *(const v4u*)(MISC + rowq * 64 + 32);
        const unsigned wr_[4] = {wraw.x, wraw.y, wraw.z, wraw.w};
#pragma unroll
        for (int h = 0; h < 8; ++h) { const float w = ((h & 1) ? bfhi(wr_[h >> 1]) : bflo(wr_[h >> 1])) * 0.0625f;
            const v4u raw = *(const v4u*)(IQ + rowq * 256 + h * 32 + fq * 8);
            v4u o; o.x = pg8::cvt_pk_bf16(bflo(raw.x) * w, bfhi(raw.x) * w); o.y = pg8::cvt_pk_bf16(bflo(raw.y) * w, bfhi(raw.y) * w); o.z = pg8::cvt_pk_bf16(bflo(raw.z) * w, bfhi(raw.z) * w); o.w = pg8::cvt_pk_bf16(bflo(raw.w) * w, bfhi(raw.w) * w);
            Bq[h] = __builtin_bit_cast(bf16x8, o); sinf[h] = (w > 0.f) ? __builtin_inff() : -__builtin_inff(); } }
    const int nkt = p + 1;
    LAS int* const ROWCTR = (LAS int*)(lds + 16 * SCP * 4);
    if (wid == 0 && lane == 0) ROWCTR[0] = 0;
    const bf16* ikb = MISC + ((size_t)b * 2048 + fr) * 64 + fq * 8;
    for (int rep_ = 0; rep_ < REP_IDX_SCORE; ++rep_)
    for (int kt0 = wid; kt0 < nkt; kt0 += 32) {
        f32x4 acc[4]; bf16x8 A[4];
#pragma unroll
        for (int u = 0; u < 4; ++u) { const int kt = kt0 + 8 * u; acc[u] = (f32x4){0.f, 0.f, 0.f, 0.f}; if (kt < nkt) A[u] = *(const bf16x8*)(ikb + (size_t)kt * 16 * 64); else A[u] = (bf16x8){0, 0, 0, 0, 0, 0, 0, 0}; }
#pragma unroll
        for (int h = 0; h < 8; ++h)
#pragma unroll
            for (int u = 0; u < 4; ++u) { const f32x4 t = __builtin_amdgcn_mfma_f32_16x16x32_bf16(A[u], Bq[h], acc[u], 0, 0, 0);
#pragma unroll
                for (int i = 0; i < 4; ++i) acc[u][i] = __builtin_amdgcn_fmed3f(t[i], acc[u][i], sinf[h]); }
#pragma unroll
        for (int u = 0; u < 4; ++u) { const int kt = kt0 + 8 * u;
            if (kt < nkt) { if (kt == nkt - 1) {
#pragma unroll
                    for (int i = 0; i < 4; ++i) if (4 * fq + i > fr) acc[u][i] = -__builtin_inff(); }
                *(LAS f32x4*)(SC + fr * SCP + kt * 16 + 4 * fq) = acc[u]; } }
    }
    WG_SYNC();
    const int kap = 32 * ((lane >> 4) & 1) + crow_(lane & 15, lane >> 5);
#define IDX_COUNT(dst, expr) do { int cl__ = 0; _Pragma("unroll") for (int g__ = 0; g__ < 4; ++g__) if (8 * g__ < ntile) { _Pragma("unroll") for (int jj__ = 0; jj__ < 8; ++jj__) { const int j = 8 * g__ + jj__; cl__ += (expr) ? 1 : 0; } } \
        dst = wave_isum(cl__); } while (0)
#define IDX_UNI(v) __uint_as_float((unsigned)__builtin_amdgcn_readfirstlane((int)__float_as_uint(v)))
    for (;;) {
        int r = 0; if (lane == 0) r = __hip_atomic_fetch_add(ROWCTR, 1, __ATOMIC_RELAXED, __HIP_MEMORY_SCOPE_WORKGROUP);
        r = __builtin_amdgcn_readfirstlane(r); if (r >= 16) break;
        r = 15 - r;
        const int q = q0 + r, n = q + 1, ntile = (q >> 6) + 1, ngrp = (ntile + 7) >> 3;
        const float NINF = -__builtin_inff();
        float x[32]; unsigned vmask = 0u; float s1 = 0.f, s2 = 0.f;
        const int tb = ntile - 1;
#pragma unroll
        for (int g = 0; g < 4; ++g) {
            if (8 * g + 7 < tb) {
#pragma unroll
                for (int jj = 0; jj < 8; ++jj) x[8 * g + jj] = SC[r * SCP + 64 * (8 * g + jj) + kap];
                if (g == 0) {
#pragma unroll
                    for (int jj = 0; jj < 8; ++jj) { s1 += x[jj]; s2 += x[jj] * x[jj]; } }
                vmask |= 0xFFu << (8 * g);
            } else if (8 * g <= tb) {
#pragma unroll
                for (int jj = 0; jj < 8; ++jj) x[8 * g + jj] = SC[r * SCP + 64 * (8 * g + jj) + kap];
#pragma unroll
                for (int jj = 0; jj < 8; ++jj) { const int j = 8 * g + jj; const bool v = (64 * j + kap) <= q; vmask |= v ? (1u << j) : 0u; if (g == 0) { const float xv = v ? x[j] : 0.f; s1 += xv; s2 += xv * xv; } x[j] = v ? x[j] : NINF; }
            } else {
#pragma unroll
                for (int jj = 0; jj < 8; ++jj) x[8 * g + jj] = NINF;
            }
        }
        unsigned selm = vmask;
        for (int rpb = 0; rpb < REP_SEL_B; ++rpb) { asm volatile("" : "+v"(x[0]), "+v"(vmask)); selm = vmask;
        if (n > 256) {
            const float fn = (float)n, rn = __builtin_amdgcn_rcpf(fn), rs = __builtin_amdgcn_rcpf((float)(n < 512 ? n : 512)), mu = wave_fsum(s1) * rs, var = fmaxf(wave_fsum(s2) * rs - mu * mu, 0.f), sd = __builtin_amdgcn_sqrtf(var);
            float zq; { const float pq = 256.0f * rn, pp = pq <= 0.5f ? pq : 1.0f - pq; const float t = __builtin_amdgcn_sqrtf(-1.3862943611f * __builtin_amdgcn_logf(fmaxf(pp, 1e-6f)));
                float z = t - (2.30753f + 0.27061f * t) * __builtin_amdgcn_rcpf(1.0f + t * (0.99229f + 0.04481f * t)); zq = pq <= 0.5f ? z : -z; }
            const float sp = sd * __builtin_amdgcn_rcpf(fmaxf(fn * (__builtin_amdgcn_exp2f(-0.7213475204f * zq * zq) * 0.3989422804f), 1e-3f));
            float lo = NINF;
            const float PINF = __builtin_inff();
            float hi = PINF, grow = 1.5f; int c_lo = n, c_hi = 0, side = 0; unsigned lt_lo = 0u, lt_hi = 0xFFFFFFFFu; bool have_lo = false, have_hi = false;
            bool tie = false, found = false, needfinish = false; float tv = 0.f, thr = 0.f; int need = 256;
#pragma unroll 1
            for (int it = 0; it < 48; ++it) {
                if (have_lo && have_hi && (c_lo - c_hi) <= 64) { needfinish = true; break; }
                float mid;
                if (it == 0) mid = mu + zq * sd;
                else if (have_lo && have_hi) {
                    mid = 0.5f * lo + 0.5f * hi;
                    if (side > -2 && side < 2) { const float fr_ = ((float)(c_lo - 256) + 0.5f) * __builtin_amdgcn_rcpf((float)(c_lo - c_hi)); const float m2 = lo + (hi - lo) * fr_; if (m2 > lo && m2 < hi) mid = m2; } else side = 0;
                } else if (have_lo) { mid = lo + ((float)(c_lo - 256) + 4.0f) * sp * grow; grow *= 2.0f; }
                else { mid = hi - ((float)(256 - c_hi) + 4.0f) * sp * grow; grow *= 2.0f; }
                if (!(mid > lo && mid < hi)) { mid = (hi == PINF) ? lo + fabsf(lo) * 0.5f + sp : (lo == NINF) ? hi - fabsf(hi) * 0.5f - sp : 0.5f * lo + 0.5f * hi; if (!(mid > lo && mid < hi)) break; }
                mid = IDX_UNI(mid);
                unsigned a0 = 0u, a1 = 0u;
#pragma unroll
                for (int g = 1; g >= 0; --g) if (g < ngrp) {
#pragma unroll
                    for (int jj = 7; jj >= 0; --jj) a0 = __builtin_amdgcn_alignbit(a0, __float_as_uint(x[8 * g + jj] - mid), 31); }
#pragma unroll
                for (int g = 3; g >= 2; --g) if (g < ngrp) {
#pragma unroll
                    for (int jj = 7; jj >= 0; --jj) a1 = __builtin_amdgcn_alignbit(a1, __float_as_uint(x[8 * g + jj] - mid), 31); }
                const unsigned ltm = a0 | (a1 << 16);
                const int c = 64 * 8 * ngrp - wave_isum(__builtin_popcount(ltm));
                if (c == 256) { found = true; selm = vmask & ~ltm; thr = mid; break; }
                if (c > 256) { lo = mid; c_lo = c; lt_lo = ltm; have_lo = true; side = side > 0 ? side + 1 : 1; } else { hi = mid; c_hi = c; lt_hi = ltm; have_hi = true; side = side < 0 ? side - 1 : -1; }
            }
            if (needfinish) {
                LAS float* CV = (LAS float*)((LAS unsigned char*)SC + 16 * SCP * 4 + 64) + 128 * wid; LAS int* CI = (LAS int*)(CV + 64);
                unsigned cb = lt_hi & ~lt_lo & vmask; int k = 256 - c_hi, base = 0;
                for (;;) { const bool has = cb != 0u; const unsigned long long bal = __ballot(has); if (bal == 0ull) break;
                    if (has) { const int jb = __builtin_ctz(cb); const int key = 64 * jb + kap; const int pos = base + (int)__builtin_amdgcn_mbcnt_hi((unsigned)(bal >> 32), __builtin_amdgcn_mbcnt_lo((unsigned)bal, 0u));
                        CV[pos] = SC[r * SCP + key]; CI[pos] = key; cb &= cb - 1u; }
                    base += __builtin_popcountll(bal); }
                asm volatile("s_waitcnt lgkmcnt(0)" ::: "memory");
                const int m = base; bool active = lane < m; float v_c = active ? CV[lane] : NINF; int i_c = active ? CI[lane] : 0x7fffffff;
                float Tv = 0.f; int Ti = 0;
                for (int qs = 0; qs < 128; ++qs) { const unsigned long long ab = __ballot(active); const int pl = __builtin_ctzll(ab);
                    const float pv = __uint_as_float((unsigned)__builtin_amdgcn_readlane((int)__float_as_uint(v_c), pl)); const int pi = __builtin_amdgcn_readlane(i_c, pl);
                    const bool before = active && ((v_c > pv) || (v_c == pv && i_c < pi)); const int g = __builtin_popcountll(__ballot(before));
                    if (g == k - 1) { Tv = pv; Ti = pi; break; }
                    if (g >= k) active = before; else { k -= g + 1; active = active && !before && (lane != pl); } }
                { const float TvU = IDX_UNI(Tv); unsigned b0 = 0u, b1 = 0u;
#pragma unroll
                  for (int g = 1; g >= 0; --g) if (g < ngrp) {
#pragma unroll
                      for (int jj = 7; jj >= 0; --jj) b0 = __builtin_amdgcn_alignbit(b0, __float_as_uint(x[8 * g + jj] - TvU), 31); }
#pragma unroll
                  for (int g = 3; g >= 2; --g) if (g < ngrp) {
#pragma unroll
                      for (int jj = 7; jj >= 0; --jj) b1 = __builtin_amdgcn_alignbit(b1, __float_as_uint(x[8 * g + jj] - TvU), 31); }
                  const unsigned ltT = b0 | (b1 << 16); selm = vmask & ~ltT;
                  if (64 * 8 * ngrp - wave_isum(__builtin_popcount(ltT)) != 256) {
#pragma unroll
                      for (int jx = 0; jx < 32; ++jx) if (x[jx] == TvU && (64 * jx + kap) > Ti) selm &= ~(1u << jx); } }
            } else
            if (!found) {
                IDX_COUNT(c_hi, x[j] >= hi);
                if (c_hi >= 256) { if (c_hi == 256) { thr = hi; found = true; } else { tie = true; tv = hi; need = 256; } }
                else for (int it = 0; it < 4096; ++it) {
                    float m = NINF;
#pragma unroll
                    for (int g = 0; g < 4; ++g) if (g < ngrp) {
#pragma unroll
                        for (int jj = 0; jj < 8; ++jj) { const int j = 8 * g + jj; m = fmaxf(m, (x[j] < hi) ? x[j] : NINF); } }
                    const float v1 = IDX_UNI(wave_fmax(m));
                    int c; IDX_COUNT(c, x[j] >= v1);
                    if (c >= 256) { if (c == 256) { thr = v1; found = true; } else { tie = true; tv = v1; need = 256 - c_hi; } break; }
                    hi = v1; c_hi = c;
                }
                if (!tie) { selm = 0u;
#pragma unroll
                    for (int j = 0; j < 32; ++j) selm |= (x[j] >= thr) ? (1u << j) : 0u;
                } else {
                    int cum = 0, jstar = 32, needp = 0; unsigned tiem = 0u; selm = 0u;
#pragma unroll
                    for (int j = 0; j < 32; ++j) { const bool t = (x[j] == tv); tiem |= t ? (1u << j) : 0u; const int cj = __builtin_popcountll(__ballot(t));
                        if (jstar == 32 && cum + cj > need) { jstar = j; needp = need - cum; } cum += cj; }
                    const bool tstar = (jstar < 32) && ((tiem >> (jstar & 31)) & 1u);
                    int kL = 0, kH = 63;
                    if (jstar < 32 && needp > 0) { while (kL < kH) { const int km = (kL + kH) >> 1; const int c = __builtin_popcountll(__ballot(tstar && kap <= km)); if (c >= needp) kH = km; else kL = km + 1; } }
                    else kL = -1;
#pragma unroll
                    for (int j = 0; j < 32; ++j) { const bool t = (tiem >> j) & 1u; const bool ts = t && (j < jstar || (j == jstar && kap <= kL)); selm |= (x[j] > tv || ts) ? (1u << j) : 0u; }
                }
            }
        }
        }
        unsigned wlo = 0u, whi = 0u;
        for (int rpc = 0; rpc < REP_SEL_C; ++rpc) { asm volatile("" : "+v"(selm));
#pragma unroll
        for (int g = 0; g < 4; ++g) if (g < ngrp) {
#pragma unroll
            for (int jj = 0; jj < 8; ++jj) { const int j = 8 * g + jj; const unsigned long long bal = __ballot((selm >> j) & 1u); if (lane == j) { wlo = (unsigned)bal; whi = (unsigned)(bal >> 32); } } }
        if (lane < 32) { v2u o; o.x = wlo; o.y = whi; *(v2u*)(MASK + (((size_t)(b * 32 + lane)) * 2048 + q) * 2) = o; }
        }
    }
#undef IDX_COUNT
#undef IDX_UNI
    WG_SYNC();
}

constexpr int KTP = 72;
constexpr int VRP = 136;
constexpr int EP = 68;
constexpr int OTP = 132;
constexpr int GL_OFF = 0, TOT_OFF = 4096, E_OFF = 6144, QA_OFF = 23552, KR_OFF = 32768, PM_OFF = 41984, VR_OFF = 51200, OT_OFF = 68608;
typedef short v4i16g __attribute__((ext_vector_type(4)));
__device__ __forceinline__ bf16x8 tr_frag(const LAS bf16* T, int pitch, int k0, int n0, int lane) {
    const int g = lane >> 4, q = (lane & 15) >> 2, p = lane & 3;
    const LAS bf16* a = T + (k0 + 8 * g + q) * pitch + n0 + 4 * p;
    const v4i16g lo = __builtin_amdgcn_ds_read_tr16_b64_v4i16((LAS v4i16g*)a), hi = __builtin_amdgcn_ds_read_tr16_b64_v4i16((LAS v4i16g*)(a + 4 * pitch));
    return (bf16x8){lo[0], lo[1], lo[2], lo[3], hi[0], hi[1], hi[2], hi[3]};
}
__device__ __forceinline__ float fexp(float x) { return __builtin_amdgcn_exp2f(x * 1.4426950408889634f); }
__device__ __forceinline__ float gla_decay(LAS unsigned char* lds, const bf16* __restrict__ MISC, const float* __restrict__ w2, const float* __restrict__ gb, size_t row0, int h, int tid) {
    LAS float* GL = (LAS float*)(lds + GL_OFF); LAS float* TOT = (LAS float*)(lds + TOT_OFF); LAS float* E = (LAS float*)(lds + E_OFF);
    const int d = tid & 63, tg = tid >> 6;
    { const int t = tid >> 3, r2 = (tid & 7) * 2; const unsigned w = *(const unsigned*)(MISC + (row0 + t) * 64 + 40 + r2); GL[t * 16 + r2] = bflo(w); GL[t * 16 + r2 + 1] = bfhi(w); }
    float wc[16];
#pragma unroll
    for (int r = 0; r < 16; ++r) wc[r] = w2[r * 256 + h * 64 + d];
    const float bias = gb[h * 64 + d];
    WG_SYNC();
    float bc[8]; float run = 0.f;
#pragma unroll
    for (int i = 0; i < 8; ++i) { const int t = 8 * tg + i; float z = bias;
#pragma unroll
        for (int r4 = 0; r4 < 4; ++r4) { const f32x4 g = *(const LAS f32x4*)(GL + t * 16 + 4 * r4); z += g[0] * wc[4 * r4] + g[1] * wc[4 * r4 + 1] + g[2] * wc[4 * r4 + 2] + g[3] * wc[4 * r4 + 3]; }
        const float ls = fminf(z, 0.f) - 0.6931471805599453f * __builtin_amdgcn_logf(1.0f + __builtin_amdgcn_exp2f(-1.4426950408889634f * fabsf(z)));
        run += ls * (1.0f / 16.0f); bc[i] = run; }
    TOT[tg * 64 + d] = run;
    WG_SYNC();
    float pre = 0.f, tot = 0.f;
#pragma unroll
    for (int g = 0; g < 8; ++g) { const float v = TOT[g * 64 + d]; tot += v; if (g < tg) pre += v; }
#pragma unroll
    for (int i = 0; i < 8; ++i) E[(8 * tg + i) * EP + d] = fexp(tot - (bc[i] + pre));
    return tot;
}
__device__ __forceinline__ void gla_load_v(LAS unsigned char* lds, const bf16* __restrict__ VB, size_t row0, int h, int tid) {
    LAS bf16* VR = (LAS bf16*)(lds + VR_OFF); const int t = tid >> 3, v0 = (tid & 7) * 16; const bf16* src = VB + (row0 + t) * 512 + h * 128 + v0;
    const v4u a = *(const v4u*)src, b = *(const v4u*)(src + 8);
    *(LAS v4u*)(VR + t * VRP + v0) = a; *(LAS v4u*)(VR + t * VRP + v0 + 8) = b;
}
__device__ __forceinline__ v4u scale8(v4u raw, const f32x4 e0, const f32x4 e1) {
    v4u o; o.x = pg8::cvt_pk_bf16(bflo(raw.x) * e0[0], bfhi(raw.x) * e0[1]); o.y = pg8::cvt_pk_bf16(bflo(raw.y) * e0[2], bfhi(raw.y) * e0[3]);
    o.z = pg8::cvt_pk_bf16(bflo(raw.z) * e1[0], bfhi(raw.z) * e1[1]); o.w = pg8::cvt_pk_bf16(bflo(raw.w) * e1[2], bfhi(raw.w) * e1[3]); return o;
}
__device__ __forceinline__ void gla_a_item(LAS unsigned char* lds, int id, const bf16* __restrict__ KB, const bf16* __restrict__ VB, const bf16* __restrict__ MISC, const float* __restrict__ w2, const float* __restrict__ gb,
                                           float* __restrict__ U, float* __restrict__ BLAST, float* __restrict__ EG, int tid, int lane, int wid) {
    const int b = id >> 7, h = (id >> 5) & 3, c = id & 31; const size_t row0 = (size_t)b * 2048 + 64 * c;
    const v4u kraw = *(const v4u*)(KB + (row0 + (tid >> 3)) * 256 + h * 64 + (tid & 7) * 8);
    gla_load_v(lds, VB, row0, h, tid);
    const float blast = gla_decay(lds, MISC, w2, gb, row0, h, tid);
    if (tid < 64) BLAST[(size_t)id * 64 + tid] = blast;
    WG_SYNC();
    LAS bf16* KR = (LAS bf16*)(lds + KR_OFF); LAS bf16* VR = (LAS bf16*)(lds + VR_OFF); const LAS float* E = (const LAS float*)(lds + E_OFF);
    { const int t = tid >> 3, d8 = (tid & 7) * 8; const f32x4 e0 = *(const LAS f32x4*)(E + t * EP + d8), e1 = *(const LAS f32x4*)(E + t * EP + d8 + 4); *(LAS v4u*)(KR + t * KTP + d8) = scale8(kraw, e0, e1);
      float* eg = EG + ((size_t)id * 64 + t) * 64 + d8; *(f32x4*)eg = e0; *(f32x4*)(eg + 4) = e1; }
    WG_SYNC();
    const int fr = lane & 15, fq = lane >> 4;
    bf16x8 Bf[2];
#pragma unroll
    for (int kk = 0; kk < 2; ++kk) Bf[kk] = tr_frag(VR, VRP, 32 * kk, 16 * wid, lane);
#pragma unroll
    for (int dt = 0; dt < 4; ++dt) { f32x4 acc = (f32x4){0.f, 0.f, 0.f, 0.f};
#pragma unroll
        for (int kk = 0; kk < 2; ++kk) { const bf16x8 Af = tr_frag(KR, KTP, 32 * kk, 16 * dt, lane); acc = __builtin_amdgcn_mfma_f32_16x16x32_bf16(Af, Bf[kk], acc, 0, 0, 0); }
        *(f32x4*)(U + ((size_t)id * 128 + 16 * wid + fr) * 64 + 16 * dt + 4 * fq) = acc; }
    WG_SYNC();
}
__device__ __forceinline__ void gla_b_item(int item, const float* __restrict__ U, const float* __restrict__ BLAST, bf16* __restrict__ SB, int tid) {
    const int bh = item >> 3, pc = item & 7; const size_t eoff = (size_t)pc * 1024 + (size_t)tid * 2; const int d0 = (tid * 2) & 63;
    f32x2 S = (f32x2){0.f, 0.f};
#pragma unroll 1
    for (int half = 0; half < 2; ++half) {
        f32x2 u[16], bl[16];
#pragma unroll
        for (int c = 0; c < 16; ++c) { const size_t id = (size_t)bh * 32 + 16 * half + c; u[c] = *(const f32x2*)(U + id * 8192 + eoff); bl[c] = *(const f32x2*)(BLAST + id * 64 + d0); }
#pragma unroll
        for (int c = 0; c < 16; ++c) { const size_t id = (size_t)bh * 32 + 16 * half + c;
            f32x2 e; e[0] = __expf(bl[c][0]); e[1] = __expf(bl[c][1]);
            const f32x2 sd = S * e; *(unsigned*)(SB + id * 8192 + eoff) = pg8::cvt_pk_bf16(sd[0], sd[1]); S = sd + u[c]; }
    }
}
__device__ __forceinline__ void gla_c_item(LAS unsigned char* lds, int id, const bf16* __restrict__ QB, const bf16* __restrict__ KB, const bf16* __restrict__ VB, const bf16* __restrict__ RG, const float* __restrict__ EG,
                                           const float* __restrict__ og, const bf16* __restrict__ SB, bf16* __restrict__ MIX, int tid, int lane, int wid) {
    const int b = id >> 7, h = (id >> 5) & 3, c = id & 31; const size_t row0 = (size_t)b * 2048 + 64 * c;
    const int st_t = tid >> 3, st_d8 = (tid & 7) * 8;
    const v4u kraw = *(const v4u*)(KB + (row0 + st_t) * 256 + h * 64 + st_d8), qraw = *(const v4u*)(QB + (row0 + st_t) * 256 + h * 64 + st_d8);
    const float* eg = EG + ((size_t)id * 64 + st_t) * 64 + st_d8; const f32x4 e0 = *(const f32x4*)eg, e1 = *(const f32x4*)(eg + 4);
    gla_load_v(lds, VB, row0, h, tid);
    const int fr = lane & 15, fq = lane >> 4;
    bf16x8 Bs[2];
    { const bf16* sbp = SB + ((size_t)id * 128 + 16 * wid + fr) * 64 + 8 * fq; Bs[0] = *(const bf16x8*)sbp; Bs[1] = *(const bf16x8*)(sbp + 32); }
    LAS bf16* QA = (LAS bf16*)(lds + QA_OFF); LAS bf16* KR = (LAS bf16*)(lds + KR_OFF); LAS bf16* PM = (LAS bf16*)(lds + PM_OFF); LAS bf16* VR = (LAS bf16*)(lds + VR_OFF);
    LAS float* OT = (LAS float*)(lds + OT_OFF);
    { f32x4 r0, r1;
#pragma unroll
      for (int i = 0; i < 4; ++i) { r0[i] = 0.125f * __builtin_amdgcn_rcpf(e0[i]); r1[i] = 0.125f * __builtin_amdgcn_rcpf(e1[i]); }
      *(LAS v4u*)(KR + st_t * KTP + st_d8) = scale8(kraw, e0, e1); *(LAS v4u*)(QA + st_t * KTP + st_d8) = scale8(qraw, r0, r1); }
    WG_SYNC();
    { const int tt = wid >> 1;
#pragma unroll
      for (int s2 = 0; s2 < 2; ++s2) { const int st = 2 * (wid & 1) + s2; f32x4 acc = (f32x4){0.f, 0.f, 0.f, 0.f};
        if (st <= tt) {
#pragma unroll
            for (int kk = 0; kk < 2; ++kk) { const bf16x8 Af = *(const LAS bf16x8*)(KR + (16 * st + fr) * KTP + 32 * kk + 8 * fq); const bf16x8 Bf = *(const LAS bf16x8*)(QA + (16 * tt + fr) * KTP + 32 * kk + 8 * fq);
                acc = __builtin_amdgcn_mfma_f32_16x16x32_bf16(Af, Bf, acc, 0, 0, 0); } }
        const int t = 16 * tt + fr, s0 = 16 * st + 4 * fq; v2u o;
        o.x = pg8::cvt_pk_bf16((s0 <= t) ? acc[0] : 0.f, (s0 + 1 <= t) ? acc[1] : 0.f); o.y = pg8::cvt_pk_bf16((s0 + 2 <= t) ? acc[2] : 0.f, (s0 + 3 <= t) ? acc[3] : 0.f);
        *(LAS v2u*)(PM + t * KTP + s0) = o; } }
    WG_SYNC();
    bf16x8 Bv[2];
#pragma unroll
    for (int kk = 0; kk < 2; ++kk) Bv[kk] = tr_frag(VR, VRP, 32 * kk, 16 * wid, lane);
#pragma unroll
    for (int tt = 0; tt < 4; ++tt) { f32x4 acc = (f32x4){0.f, 0.f, 0.f, 0.f};
#pragma unroll
        for (int kk = 0; kk < 2; ++kk) { const bf16x8 Ap = *(const LAS bf16x8*)(PM + (16 * tt + fr) * KTP + 32 * kk + 8 * fq); acc = __builtin_amdgcn_mfma_f32_16x16x32_bf16(Ap, Bv[kk], acc, 0, 0, 0);
                                         const bf16x8 Aq = *(const LAS bf16x8*)(QA + (16 * tt + fr) * KTP + 32 * kk + 8 * fq); acc = __builtin_amdgcn_mfma_f32_16x16x32_bf16(Aq, Bs[kk], acc, 0, 0, 0); }
#pragma unroll
        for (int i = 0; i < 4; ++i) OT[(16 * tt + 4 * fq + i) * OTP + 16 * wid + fr] = acc[i]; }
    WG_SYNC();
    { const int t = tid >> 3, v0 = (tid & 7) * 16; f32x4 ov[4]; float ss = 0.f;
#pragma unroll
      for (int k = 0; k < 4; ++k) { ov[k] = *(const LAS f32x4*)(OT + t * OTP + v0 + 4 * k); ss += (ov[k][0] * ov[k][0] + ov[k][1] * ov[k][1]) + (ov[k][2] * ov[k][2] + ov[k][3] * ov[k][3]); }
      ss += DPP_STEP_F(ss, 0xB1); ss += DPP_STEP_F(ss, 0x4E); ss += DPP_STEP_F(ss, 0x141);
      const float rs = __builtin_amdgcn_rsqf(ss * (1.0f / 128.0f) + 1e-6f);
      const bf16* rgp = RG + (row0 + t) * 512 + h * 128 + v0; const v4u ra = *(const v4u*)rgp, rb = *(const v4u*)(rgp + 8);
      const unsigned rw[8] = {ra.x, ra.y, ra.z, ra.w, rb.x, rb.y, rb.z, rb.w}; unsigned ow[8];
#pragma unroll
      for (int k = 0; k < 4; ++k) { const f32x4 g = *(const f32x4*)(og + v0 + 4 * k); float y[4];
#pragma unroll
          for (int i = 0; i < 4; ++i) { const unsigned w = rw[2 * k + (i >> 1)]; const float r = (i & 1) ? bfhi(w) : bflo(w); const float sg = r * __builtin_amdgcn_rcpf(1.0f + __builtin_amdgcn_exp2f(-1.4426950408889634f * r)); y[i] = ov[k][i] * rs * g[i] * sg; }
          ow[2 * k] = pg8::cvt_pk_bf16(y[0], y[1]); ow[2 * k + 1] = pg8::cvt_pk_bf16(y[2], y[3]); }
      bf16* op = MIX + (row0 + t) * 1024 + 512 + h * 128 + v0;
      *(v4u*)op = (v4u){ow[0], ow[1], ow[2], ow[3]}; *(v4u*)(op + 8) = (v4u){ow[4], ow[5], ow[6], ow[7]}; }
    WG_SYNC();
}

constexpr int WRP = 1032;
typedef int i32x4_t __attribute__((ext_vector_type(4)));
__device__ __forceinline__ bf16x8 frag_fix(const i32x4_t v, const int src4) {
    i32x4_t r; r.x = __builtin_amdgcn_ds_bpermute(src4, v.x); r.y = __builtin_amdgcn_ds_bpermute(src4, v.y); r.z = __builtin_amdgcn_ds_bpermute(src4, v.z); r.w = __builtin_amdgcn_ds_bpermute(src4, v.w);
    return __builtin_bit_cast(bf16x8, r);
}
constexpr int WR_LDS_BYTES = 48 * WRP * 2;
__device__ __forceinline__ void router_tile(LAS unsigned char* lds, int tile, const bf16* __restrict__ XN2, const float* __restrict__ ROWSS, const float* __restrict__ brg, const float* __restrict__ bre,
                                            unsigned* __restrict__ CNT, int* __restrict__ LISTS, float* __restrict__ LSC, int* __restrict__ TOKINFO, int tid, int lane, int wid) {
    LAS bf16* WR = (LAS bf16*)lds; LAS float* PL = (LAS float*)(lds + WR_LDS_BYTES); LAS unsigned* CL = (LAS unsigned*)(lds + WR_LDS_BYTES + 24576); LAS unsigned* BS = CL + 32;
    if (tid < 32) CL[tid] = 0u;
    const int fr = lane & 15, fq = lane >> 4, rt = wid >> 1, kh = wid & 1;
    {   const size_t row = (size_t)tile * 64 + 16 * rt + (lane >> 2); const bf16* ap = XN2 + row * 1024 + 512 * kh + 8 * (lane & 3); const int src4 = 4 * (4 * fr + fq);
        i32x4_t Ar[16]; bf16x8 Af[16];
#pragma unroll
        for (int kk = 0; kk < 16; ++kk) Ar[kk] = *(const i32x4_t*)(ap + 32 * kk);
        __builtin_amdgcn_sched_barrier(0);
#pragma unroll
        for (int kk = 0; kk < 16; ++kk) Af[kk] = frag_fix(Ar[kk], src4);
        f32x4 acc[3];
#pragma unroll
        for (int nt = 0; nt < 3; ++nt) acc[nt] = (f32x4){0.f, 0.f, 0.f, 0.f};
#pragma unroll
        for (int kk = 0; kk < 16; ++kk)
#pragma unroll
            for (int nt = 0; nt < 3; ++nt) { const bf16x8 Bf = *(const LAS bf16x8*)(WR + (16 * nt + fr) * WRP + 512 * kh + 32 * kk + 8 * fq); acc[nt] = __builtin_amdgcn_mfma_f32_16x16x32_bf16(Af[kk], Bf, acc[nt], 0, 0, 0); }
#pragma unroll
        for (int nt = 0; nt < 3; ++nt)
#pragma unroll
            for (int i = 0; i < 4; ++i) PL[(wid * 16 + 4 * fq + i) * 48 + 16 * nt + fr] = acc[nt][i];
    }
    WG_SYNC();
    int e_[2] = {0, 0}; unsigned lp[2] = {0u, 0u}; float wk[2] = {0.f, 0.f}; float rstd2 = 0.f; const bool act = tid < 64;
    const int token = tile * 64 + tid;
    if (act) {
        const LAS float* l0 = PL + ((2 * (tid >> 4)) * 16 + (tid & 15)) * 48; const LAS float* l1 = l0 + 16 * 48; float ss = 0.f;
        const f32x4* rp = (const f32x4*)(ROWSS + (size_t)token * 16);
#pragma unroll
        for (int j = 0; j < 4; ++j) { const f32x4 v = rp[j]; ss += (v[0] + v[1]) + (v[2] + v[3]); }
        rstd2 = 1.0f / sqrtf(ss * (1.0f / 1024.0f) + 1e-6f);
        float gl[4]; int gs = 0;
#pragma unroll
        for (int j = 0; j < 4; ++j) gl[j] = (l0[j] + l1[j]) * rstd2 + brg[j];
#pragma unroll
        for (int j = 1; j < 4; ++j) if (gl[j] > gl[gs]) gs = j;
        float den = 0.f;
#pragma unroll
        for (int j = 0; j < 4; ++j) den += __expf(gl[j] - gl[gs]);
        const float gw = 1.0f / den;
        float el[8];
#pragma unroll
        for (int j = 0; j < 8; ++j) el[j] = (l0[4 + gs * 8 + j] + l1[4 + gs * 8 + j]) * rstd2 + bre[gs * 8 + j];
        int i0 = 0;
#pragma unroll
        for (int j = 1; j < 8; ++j) if (el[j] > el[i0]) i0 = j;
        int i1 = (i0 == 0) ? 1 : 0;
#pragma unroll
        for (int j = 0; j < 8; ++j) if (j != i0 && j != i1 && el[j] > el[i1]) i1 = j;
        const float ex = __expf(el[i1] - el[i0]); const float w0 = 1.0f / (1.0f + ex);
        wk[0] = w0 * gw; wk[1] = ex * w0 * gw; e_[0] = gs * 8 + i0; e_[1] = gs * 8 + i1;
        lp[0] = __hip_atomic_fetch_add(CL + e_[0], 1u, __ATOMIC_RELAXED, __HIP_MEMORY_SCOPE_WORKGROUP); lp[1] = __hip_atomic_fetch_add(CL + e_[1], 1u, __ATOMIC_RELAXED, __HIP_MEMORY_SCOPE_WORKGROUP);
    }
    WG_SYNC();
    if (tid < 32) { const unsigned n = CL[tid]; BS[tid] = n ? __hip_atomic_fetch_add(CNT + tid, n, __ATOMIC_RELAXED, __HIP_MEMORY_SCOPE_AGENT) : 0u; }
    WG_SYNC();
    if (act) {
#pragma unroll
        for (int k = 0; k < 2; ++k) { const unsigned pos = BS[e_[k]] + lp[k]; LISTS[(size_t)e_[k] * 16384 + pos] = token; *(f32x2*)(LSC + ((size_t)e_[k] * 16384 + pos) * 2) = (f32x2){rstd2, wk[k]}; }
        *(int4*)(TOKINFO + (size_t)token * 4) = make_int4(e_[0], (int)(BS[e_[0]] + lp[0]), e_[1], (int)(BS[e_[1]] + lp[1]));
    }
    WG_SYNC();
}

template <bool GATHER> struct GroupOrder {
    const LAS int* TOFF; const LAS int* BOFF; const LAS int* CNTL; const int* LISTS; int NPN, G, c; unsigned bstride;
    __device__ bool next(int i, pg8::Unit& u) const {
        const int L = i * G + c; const int ntile = BOFF[32]; if (L >= ntile * NPN) return false;
        const int Tb = L / NPN; int e = 0;
#pragma unroll
        for (int s = 16; s >= 1; s >>= 1) if (BOFF[e + s] <= Tb) e += s;
        const int jt = Tb - BOFF[e];
        u.pm = TOFF[e] + jt; u.pn = L - Tb * NPN; u.e = e; u.p0 = jt * 256; const int rem = CNTL[e] - u.p0; u.nv = rem < 256 ? rem : 256; u.bo = (unsigned)e * bstride; return true;
    }
    __device__ __forceinline__ unsigned arow(const pg8::Unit& u, int r) const {
        if (GATHER) return (unsigned)LISTS[(size_t)u.e * 16384 + u.p0 + (r < u.nv ? r : 0)];
        return (unsigned)(u.pm * 256 + r);
    }
};
__device__ __forceinline__ void skinny_gu(LAS unsigned char* lds, int e, int p0, int rem, int rg2, int cb, int slot0, const bf16* __restrict__ XN2, const bf16* __restrict__ WGU, const int* __restrict__ LISTS, const float* __restrict__ LSC, bf16* __restrict__ HID, int lane, int wid) {
    const int fr = lane & 15, fq = lane >> 4, lr = lane >> 2, lc = lane & 3; const int rb = 32 * rg2; const int r0 = rb + lr, r1 = rb + 16 + lr; const int src4 = 4 * (4 * fr + fq);
    const int* lp = LISTS + (size_t)e * 16384 + p0; const int tok0 = lp[r0 < rem ? r0 : 0], tok1 = lp[r1 < rem ? r1 : 0];
    const int eh = wid >> 2, ent = wid & 3; f32x2 sw[4];
#pragma unroll
    for (int i = 0; i < 4; ++i) { const int rr = rb + 16 * eh + 4 * fq + i; sw[i] = *(const f32x2*)(LSC + ((size_t)e * 16384 + p0 + (rr < rem ? rr : 0)) * 2); }
    const bf16* wb = WGU + (size_t)e * 512 * 1024 + 128 * wid + 8 * lc;
    LAS f32x4* PART = (LAS f32x4*)lds;
    i32x4_t Ar[2][4], Gr[4][4], Ur[4][4];
#pragma unroll
    for (int nt = 0; nt < 4; ++nt) { const int j = 64 * cb + 16 * nt + lr; const bf16* bp = wb + (size_t)((j >> 7) * 256 + (j & 127)) * 1024;
#pragma unroll
        for (int k = 0; k < 4; ++k) { Gr[nt][k] = *(const i32x4_t*)(bp + 32 * k); Ur[nt][k] = *(const i32x4_t*)(bp + 128 * 1024 + 32 * k); } }
    { const bf16* ap0 = XN2 + (size_t)tok0 * 1024 + 128 * wid + 8 * lc; const bf16* ap1 = XN2 + (size_t)tok1 * 1024 + 128 * wid + 8 * lc;
#pragma unroll
      for (int k = 0; k < 4; ++k) { Ar[0][k] = *(const i32x4_t*)(ap0 + 32 * k); Ar[1][k] = *(const i32x4_t*)(ap1 + 32 * k); } }
    __builtin_amdgcn_sched_barrier(0);
    bf16x8 Af[2][4];
#pragma unroll
    for (int k = 0; k < 4; ++k) { Af[0][k] = frag_fix(Ar[0][k], src4); Af[1][k] = frag_fix(Ar[1][k], src4); }
#pragma unroll
    for (int nt = 0; nt < 4; ++nt) { bf16x8 Bg[4], Bu[4];
#pragma unroll
        for (int k = 0; k < 4; ++k) { Bg[k] = frag_fix(Gr[nt][k], src4); Bu[k] = frag_fix(Ur[nt][k], src4); }
#pragma unroll
        for (int h = 0; h < 2; ++h) { f32x4 ag = (f32x4){0.f, 0.f, 0.f, 0.f}, au = (f32x4){0.f, 0.f, 0.f, 0.f};
#pragma unroll
            for (int k = 0; k < 4; ++k) { ag = __builtin_amdgcn_mfma_f32_16x16x32_bf16(Af[h][k], Bg[k], ag, 0, 0, 0); au = __builtin_amdgcn_mfma_f32_16x16x32_bf16(Af[h][k], Bu[k], au, 0, 0, 0); }
            PART[((wid * 2 + h) * 8 + nt) * 64 + lane] = ag; PART[((wid * 2 + h) * 8 + 4 + nt) * 64 + lane] = au; } }
    WG_SYNC();
    { f32x4 g = (f32x4){0.f, 0.f, 0.f, 0.f}, u = (f32x4){0.f, 0.f, 0.f, 0.f};
#pragma unroll
      for (int w = 0; w < 8; ++w) { g += PART[((w * 2 + eh) * 8 + ent) * 64 + lane]; u += PART[((w * 2 + eh) * 8 + 4 + ent) * 64 + lane]; }
#pragma unroll
      for (int i = 0; i < 4; ++i) { const int rr = rb + 16 * eh + 4 * fq + i; if (rr < rem) {
          const float a = g[i] * sw[i].x, uu = u[i] * sw[i].x; HID[(size_t)(slot0 + rr) * 256 + 64 * cb + 16 * ent + fr] = (bf16)f2bf(a * __builtin_amdgcn_rcpf(1.f + __expf(-a)) * uu * sw[i].y); } } }
    WG_SYNC();
}
__device__ __forceinline__ void skinny_down(int e, int rem, int rg2, int cq, int slot0, const bf16* __restrict__ HID, const bf16* __restrict__ WD, bf16* __restrict__ Y, int lane, int wid) {
    const int fr = lane & 15, fq = lane >> 4, lr = lane >> 2, lc = lane & 3; const int rb = 32 * rg2; const int r0 = rb + lr, r1 = rb + 16 + lr; const int col0 = 256 * cq + 32 * wid; const int src4 = 4 * (4 * fr + fq);
    const bf16* ap0 = HID + (size_t)(slot0 + (r0 < rem ? r0 : 0)) * 256 + 8 * lc; const bf16* ap1 = HID + (size_t)(slot0 + (r1 < rem ? r1 : 0)) * 256 + 8 * lc;
    const bf16* wb = WD + (size_t)e * 1024 * 256 + (size_t)(col0 + lr) * 256 + 8 * lc;
    i32x4_t R0[8], R1[8], S0[8], S1[8];
#pragma unroll
    for (int k = 0; k < 8; ++k) { R0[k] = *(const i32x4_t*)(ap0 + 32 * k); R1[k] = *(const i32x4_t*)(ap1 + 32 * k); S0[k] = *(const i32x4_t*)(wb + 32 * k); S1[k] = *(const i32x4_t*)(wb + (size_t)16 * 256 + 32 * k); }
    __builtin_amdgcn_sched_barrier(0);
    bf16x8 A0[8], A1[8], B0[8], B1[8];
#pragma unroll
    for (int k = 0; k < 8; ++k) { A0[k] = frag_fix(R0[k], src4); A1[k] = frag_fix(R1[k], src4); B0[k] = frag_fix(S0[k], src4); B1[k] = frag_fix(S1[k], src4); }
    f32x4 a00 = (f32x4){0.f, 0.f, 0.f, 0.f}, a01 = a00, a10 = a00, a11 = a00;
#pragma unroll
    for (int k = 0; k < 8; ++k) { a00 = __builtin_amdgcn_mfma_f32_16x16x32_bf16(A0[k], B0[k], a00, 0, 0, 0); a01 = __builtin_amdgcn_mfma_f32_16x16x32_bf16(A0[k], B1[k], a01, 0, 0, 0);
                                  a10 = __builtin_amdgcn_mfma_f32_16x16x32_bf16(A1[k], B0[k], a10, 0, 0, 0); a11 = __builtin_amdgcn_mfma_f32_16x16x32_bf16(A1[k], B1[k], a11, 0, 0, 0); }
#pragma unroll
    for (int i = 0; i < 4; ++i) { const int rr = rb + 4 * fq + i;
        if (rr < rem) { bf16* yp = Y + (size_t)(slot0 + rr) * 1024 + col0 + fr; yp[0] = (bf16)f2bf(a00[i]); yp[16] = (bf16)f2bf(a01[i]); }
        if (rr + 16 < rem) { bf16* yp = Y + (size_t)(slot0 + rr + 16) * 1024 + col0 + fr; yp[0] = (bf16)f2bf(a10[i]); yp[16] = (bf16)f2bf(a11[i]); } }
}
struct Args { const float* in[18]; float* out; unsigned char* ws; int ph_lo, ph_hi, li, pad; };
__global__ void __launch_bounds__(NWAVES * 64, 2) hymba_fwd(Args args) {
    extern __shared__ __attribute__((aligned(16))) unsigned char lds[];
    LAS unsigned char* const L = (LAS unsigned char*)lds;
    volatile LAS unsigned* const MISCW = (volatile LAS unsigned*)(L + MISC_OFF);
    LAS int* const TOFF = (LAS int*)(L + TOFF_OFF); LAS int* const CNTL = TOFF + 40; LAS int* const BOFF = TOFF + 80; LAS int* const SMALL = TOFF + 120;
    LAS int* const SPK = TOFF + 156; LAS int* const NX = TOFF + 188;
    const int tid = threadIdx.x, lane = tid & 63, wave = __builtin_amdgcn_readfirstlane(tid >> 6);
    const int G = gridDim.x; const int bx = blockIdx.x; const int vcu = (G % 8 == 0) ? (bx % 8) * (G / 8) + bx / 8 : bx;
    unsigned char* const ws = args.ws;
    gu32* const ctl = (gu32*)(ws + WS_CTL);
    const float* x = args.in[0]; const float* norm1_g = args.in[1]; const float* w_in = args.in[2]; const float* q_norm_g = args.in[3]; const float* k_norm_g = args.in[4];
    const float* rel_bias = args.in[5]; const float* gate_w2 = args.in[6]; const float* gate_b = args.in[7]; const float* out_norm_g = args.in[8]; const float* w_out = args.in[9];
    const float* norm2_g = args.in[10]; const float* w_rg = args.in[11]; const float* b_rg = args.in[12]; const float* w_re = args.in[13]; const float* b_re = args.in[14];
    const float* w_eg = args.in[15]; const float* w_eu = args.in[16]; const float* w_ed = args.in[17];
    float* out = args.out;
    float* RSTD1 = (float*)(ws + WS_RSTD1); float* ROWSS = (float*)(ws + WS_ROWSS); bf16* WR_T = (bf16*)(ws + WS_WR); float* BLAST = (float*)(ws + WS_BLAST);
    int* TOKINFO = (int*)(ws + WS_TOKINFO); int* LISTS = (int*)(ws + WS_LISTS); float* LSC = (float*)(ws + WS_LSC);
    bf16* WO_T = (bf16*)(ws + WS_WO); bf16* WGU_T = (bf16*)(ws + WS_WGU); bf16* WD_T = (bf16*)(ws + WS_WD); bf16* XB = (bf16*)(ws + WS_XB); bf16* WIN_T = (bf16*)(ws + WS_WIN);
    unsigned char* const ob = (unsigned char*)args.out;
    unsigned* MASK = (unsigned*)(ob + OB_MASK); bf16* SB = (bf16*)(ob + OB_SB); float* EG = (float*)(ob + OB_EG);
    bf16* QN = (bf16*)(ws + WS_QN); bf16* KN = (bf16*)(ws + WS_KN); bf16* VN = (bf16*)(ws + WS_VN); bf16* XN2 = (bf16*)(ws + WS_XN2);
    bf16* IQ = (bf16*)(ws + WS_IQ); bf16* MISC = (bf16*)(ws + WS_MISC); bf16* QB = (bf16*)(ws + WS_QB); bf16* KB = (bf16*)(ws + WS_KB); bf16* VB = (bf16*)(ws + WS_VB); bf16* RG = (bf16*)(ws + WS_RG);
    bf16* MIX = (bf16*)(ws + WS_MIX); float* U = (float*)(ws + WS_MIX); bf16* HID = (bf16*)(ws + WS_HID); bf16* Y = (bf16*)(ws + WS_Y);
    unsigned* CNT = (unsigned*)(ctl + CW_CNT);

    for (int u = tid; u < (LDS_BYTES - LDSCTL_OFF) / 4; u += NWAVES * 64) ((LAS unsigned*)(L + LDSCTL_OFF))[u] = 0u;
    __syncthreads();
    const int bli = (N_LAUNCHES == PER_PHASE) ? 0 : args.li;
    XcdBarrier bar; bar.bar = (unsigned*)(ctl + CW_BAR) + bli * XCD_BAR_WORDS; bar.x = 0; bar.st = nullptr;
    if (N_LAUNCHES != PER_PHASE) bar = xcd_barrier_post((unsigned*)(ctl + CW_BAR) + bli * XCD_BAR_WORDS, MISCW + 8);
#define GRID_BAR(seam) do { if (N_LAUNCHES == PER_PHASE) { if (tid == 0) __hip_atomic_store(ctl + CW_TMO, 0xBADBA0u | (unsigned)(seam), RLX_AGENT); } else { xcd_barrier(bar); } } while (0)
    const int lo = args.ph_lo, hi = args.ph_hi;
#define IN(k) (lo <= (k) && (k) < hi)
#define BOTH(k) (IN(k) && IN((k) + 1))
    const int gw = vcu * NWAVES + wave, NGW = G * NWAVES;

    constexpr int I_G = 16 * 8, I_D = 4 * 32, PER_E = 2 * I_G + I_D, NE1 = 18, NE2 = 25;
#define expert_weights(lo_, hi_, w0_, nw_) do { LAS float* scr_ = (LAS float*)(L + wave * 16384); \
        for (int it_ = (lo_) + (w0_); it_ < (hi_); it_ += (nw_)) { const int e_ = it_ / PER_E; int r_ = it_ - e_ * PER_E; \
            if (r_ < I_G) { p0_transpose_item<2>(w_eg + (size_t)e_ * 1024 * 256, 1024, 256, norm2_g, WGU_T + (size_t)e_ * 512 * 1024, scr_, r_, lane); continue; } r_ -= I_G; \
            if (r_ < I_G) { p0_transpose_item<3>(w_eu + (size_t)e_ * 1024 * 256, 1024, 256, norm2_g, WGU_T + (size_t)e_ * 512 * 1024, scr_, r_, lane); continue; } r_ -= I_G; \
            p0_transpose_item<1>(w_ed + (size_t)e_ * 256 * 1024, 256, 1024, nullptr, WD_T + (size_t)e_ * 1024 * 256, scr_, r_, lane); } } while (0)
    if (IN(0)) {
        LAS float* scr = (LAS float*)(L + wave * 16384);
        constexpr int I_IN = 16 * 106, I_O = 16 * 32;
        constexpr int NITEMS = I_IN + I_O;
        for (int it = gw; it < NITEMS; it += NGW) {
            int r = it;
            if (r < I_IN) { p0_transpose_item<0>(w_in, 1024, 3384, norm1_g, WIN_T, scr, r, lane); continue; } r -= I_IN;
            p0_transpose_item<1>(w_out, 1024, 1024, nullptr, WO_T, scr, r, lane);
        }
        expert_weights(NE2 * PER_E, 32 * PER_E, gw, NGW);
        for (int i = bx * (NWAVES * 64) + tid; i < 48 * 1024; i += G * NWAVES * 64) { const int n = i >> 10, k = i & 1023;
            const float v = (n < 4) ? w_rg[k * 4 + n] : (n < 36) ? w_re[k * 32 + (n - 4)] : 0.f; WR_T[i] = (bf16)f2bf(v * norm2_g[k]); }
        for (int m0 = 2 * gw; m0 < M; m0 += 2 * NGW) {
            f32x4 v[2][4]; float s[2];
#pragma unroll
            for (int r = 0; r < 2; ++r) { const GAS f32x4* xr = (const GAS f32x4*)(x + (size_t)(m0 + r) * 1024) + lane;
#pragma unroll
                for (int j = 0; j < 4; ++j) v[r][j] = __builtin_nontemporal_load(xr + 64 * j); }
#pragma unroll
            for (int r = 0; r < 2; ++r) { s[r] = 0.f;
#pragma unroll
                for (int j = 0; j < 4; ++j) s[r] += (v[r][j].x * v[r][j].x + v[r][j].y * v[r][j].y) + (v[r][j].z * v[r][j].z + v[r][j].w * v[r][j].w);
                s[r] = wave_fsum(s[r]); if (lane == 0) RSTD1[m0 + r] = 1.0f / sqrtf(s[r] * (1.0f / 1024.0f) + 1e-6f);
                GAS unsigned long long* o8 = (GAS unsigned long long*)(XB + (size_t)(m0 + r) * 1024) + lane;
#pragma unroll
                for (int j = 0; j < 4; ++j) o8[64 * j] = (unsigned long long)pg8::cvt_pk_bf16(v[r][j].x, v[r][j].y) | ((unsigned long long)pg8::cvt_pk_bf16(v[r][j].z, v[r][j].w) << 32); }
        }
        if (BOTH(0)) GRID_BAR(0);
#if defined(EXTRA_BAR)
        for (int eb = 0; eb < EXTRA_BAR; ++eb) GRID_BAR(0);
#endif
    }
    if (IN(1)) {
        pg8::Gemm g{XB, WIN_T, 1024}; pg8::StaticOrder S; S.init(M, 3584, G, bx);
        pg8::EpiProj E{RSTD1, q_norm_g, k_norm_g, QN, KN, VN, IQ, QB, KB, VB, RG, MISC, 0.125f * 1.4426950408889634f, 1e-6f};
        pg8::gemm_phase<pg8::EpiProj, pg8::StaticOrder, true>(L, g, S, E);
        {
            const int nshort = (896 % G == 0) ? G : G - (896 % G), first = G - nshort;
            if (bx >= first) expert_weights(0, NE1 * PER_E, (bx - first) * NWAVES + wave, nshort * NWAVES); }
        if (BOTH(1)) GRID_BAR(1);
    }
    if (IN(2)) {
        for (int rep = 0; rep < REP_IDX; ++rep)
        for (int it = bx; it < 1024; it += G) { const int b = it & 7, t_ = it >> 3, j_ = t_ >> 5, k0_ = t_ & 31;
            const int p = (j_ == 0) ? k0_ : (j_ == 1) ? 63 - k0_ : (j_ == 2) ? 64 + k0_ : 127 - k0_;
            idx_item(L, b, p, IQ, MISC, MASK, lane, wave); }
        for (int rep = 0; rep < REP_GLAA; ++rep)
        for (int it = bx; it < 1024; it += G) gla_a_item(L, it, KB, VB, MISC, gate_w2, gate_b, U, BLAST, EG, tid, lane, wave);
        expert_weights(NE1 * PER_E, NE2 * PER_E, gw, NGW);
        if (BOTH(2)) GRID_BAR(2);
    }
    if (IN(3)) {
        for (int it = bx; it < 256; it += G) gla_b_item(it, U, BLAST, SB, tid);
        if (BOTH(3)) GRID_BAR(3);
    }
    if (IN(4)) {
        const attn_body::AttnTensors AT{(const attn_body::bf16*)QN, (const attn_body::bf16*)KN, (const attn_body::bf16*)VN, (attn_body::bf16*)MIX, MASK, rel_bias};
        for (int rep = 0; rep < REP_ATT; ++rep)
        for (int pr = vcu; pr < 256; pr += G) { const int bh = pr >> 2, s = pr & 3;
            for (int k2 = 0; k2 < 2; ++k2) attn_body::attn_unit<8>(bh >> 3, bh & 7, k2 ? s : 7 - s, AT.Q, AT.K, AT.V, AT.O, AT.MASK, AT.relb, (char*)lds); }
        for (int rep = 0; rep < REP_GLAC; ++rep)
        for (int it = bx; it < 1024; it += G) gla_c_item(L, it, QB, KB, VB, RG, EG, out_norm_g, SB, MIX, tid, lane, wave);
        if (BOTH(4)) GRID_BAR(4);
    }
    if (IN(5)) {
        pg8::Gemm g{MIX, WO_T, 1024}; pg8::StaticOrder S; S.init(M, 1024, G, bx);
        pg8::EpiOut E{XB, XN2, ROWSS};
        pg8::gemm_phase<pg8::EpiOut, pg8::StaticOrder, false>(L, g, S, E);
        if (BOTH(5)) GRID_BAR(5);
    }
    if (IN(6)) {
        { LAS bf16* WR = (LAS bf16*)L;
          for (int i = tid; i < 48 * 128; i += NWAVES * 64) { const int n = i >> 7, c8 = i & 127; *(LAS v4u*)(WR + n * WRP + c8 * 8) = *(const v4u*)(WR_T + n * 1024 + c8 * 8); } }
        WG_SYNC();
        for (int tile = bx; tile < 256; tile += G) router_tile(L, tile, XN2, ROWSS, b_rg, b_re, CNT, LISTS, LSC, TOKINFO, tid, lane, wave);
        if (BOTH(6)) GRID_BAR(6);
    }
    bool toff_done = false;
#define LOAD_TOFF() do { if (toff_done) break; toff_done = true; if (tid < 32) CNTL[tid] = (int)__hip_atomic_load(CNT + tid, RLX_AGENT); WG_SYNC(); \
        if (tid == 0) { int acc_ = 0, bacc_ = 0, ns_ = 0; for (int x_ = 0; x_ < 8; ++x_) NX[x_] = 0; for (int e_ = 0; e_ < 32; ++e_) { const int c_ = CNTL[e_]; TOFF[e_] = acc_; BOFF[e_] = bacc_; \
        const int full_ = c_ >> 8, rem_ = c_ & 255; if (rem_ > 0 && rem_ <= 128) { int x_ = (G % 8 == 0) ? (bacc_ * 16) / G : 0; x_ = x_ > 7 ? 7 : x_; SMALL[1 + ns_] = e_; SPK[ns_] = (x_ << 16) | NX[x_]; NX[x_] += 4 * ((rem_ + 31) >> 5); ++ns_; } \
        acc_ += (c_ + 255) >> 8; bacc_ += full_ + (rem_ > 128 ? 1 : 0); } \
        TOFF[32] = acc_; BOFF[32] = bacc_; SMALL[0] = ns_; } WG_SYNC(); } while (0)
#define SKINNY_ITEMS(BODY) do { const int ns = SMALL[0]; const int x_ = (G % 8 == 0) ? bx % 8 : 0, per_ = (G % 8 == 0) ? G / 8 : G, k_ = (G % 8 == 0) ? bx / 8 : bx; \
        for (int slot = per_ - 1 - k_; slot < NX[x_]; slot += per_) { int s = -1; for (int t_ = 0; t_ < ns; ++t_) { const int pk_ = SPK[t_]; if ((pk_ >> 16) == x_ && (pk_ & 0xffff) <= slot) s = t_; } \
            const int j = slot - (SPK[s] & 0xffff), e = SMALL[1 + s], cnt = CNTL[e], full = cnt >> 8, rem = cnt & 255; BODY; } } while (0)
    if (IN(7)) {
        LOAD_TOFF();
        pg8::Gemm g{XN2, WGU_T, 1024}; GroupOrder<true> S{TOFF, BOFF, CNTL, LISTS, 2, G, vcu, 512u * 1024u * 2u};
        pg8::EpiGU E{LSC, HID};
        pg8::gemm_phase<pg8::EpiGU, GroupOrder<true>, false>(L, g, S, E);
        for (int rep = 0; rep < REP_SKGU; ++rep)
            SKINNY_ITEMS(skinny_gu(L, e, full * 256, rem, j >> 2, j & 3, (TOFF[e] + full) * 256, XN2, WGU_T, LISTS, LSC, HID, lane, wave));
        if (BOTH(7)) GRID_BAR(7);
    }
    if (IN(8)) {
        LOAD_TOFF();
        pg8::Gemm g{HID, WD_T, 256}; GroupOrder<false> S{TOFF, BOFF, CNTL, LISTS, 4, G, vcu, 1024u * 256u * 2u};
        pg8::EpiDown E{Y};
        pg8::gemm_phase<pg8::EpiDown, GroupOrder<false>, false>(L, g, S, E);
        for (int rep = 0; rep < REP_SKDN; ++rep)
            SKINNY_ITEMS(skinny_down(e, rem, j >> 2, j & 3, (TOFF[e] + full) * 256, HID, WD_T, Y, lane, wave));
        if (BOTH(8)) GRID_BAR(8);
    }
    if (IN(9)) {
        LOAD_TOFF();
        for (int m0 = 4 * gw; m0 < M; m0 += 4 * NGW) {
            int4 ti[4];
#pragma unroll
            for (int r = 0; r < 4; ++r) ti[r] = *(const int4*)(TOKINFO + (size_t)(m0 + r) * 4);
            v4u av[4][2], b0[4][2], b1[4][2];
#pragma unroll
            for (int r = 0; r < 4; ++r) { const size_t s0 = (size_t)TOFF[ti[r].x] * 256 + ti[r].y, s1 = (size_t)TOFF[ti[r].z] * 256 + ti[r].w;
                const GAS v4u* a = (const GAS v4u*)(XN2 + (size_t)(m0 + r) * 1024) + lane; const GAS v4u* y0 = (const GAS v4u*)(Y + s0 * 1024) + lane; const GAS v4u* y1 = (const GAS v4u*)(Y + s1 * 1024) + lane;
#pragma unroll
                for (int j = 0; j < 2; ++j) { av[r][j] = __builtin_nontemporal_load(a + 64 * j); b0[r][j] = __builtin_nontemporal_load(y0 + 64 * j); b1[r][j] = __builtin_nontemporal_load(y1 + 64 * j); } }
#pragma unroll
            for (int r = 0; r < 4; ++r) { GAS f32x4* o = (GAS f32x4*)(out + (size_t)(m0 + r) * 1024) + 2 * lane;
#pragma unroll
                for (int j = 0; j < 2; ++j) { const v4u a_ = av[r][j], c0 = b0[r][j], c1 = b1[r][j]; f32x4 r0, r1;
                    r0[0] = bflo(a_.x) + bflo(c0.x) + bflo(c1.x); r0[1] = bfhi(a_.x) + bfhi(c0.x) + bfhi(c1.x); r0[2] = bflo(a_.y) + bflo(c0.y) + bflo(c1.y); r0[3] = bfhi(a_.y) + bfhi(c0.y) + bfhi(c1.y);
                    r1[0] = bflo(a_.z) + bflo(c0.z) + bflo(c1.z); r1[1] = bfhi(a_.z) + bfhi(c0.z) + bfhi(c1.z); r1[2] = bflo(a_.w) + bflo(c0.w) + bflo(c1.w); r1[3] = bfhi(a_.w) + bfhi(c0.w) + bfhi(c1.w);
                    __builtin_nontemporal_store(r0, o + 128 * j); __builtin_nontemporal_store(r1, o + 128 * j + 1); } }
        }
    }
#undef IN
#undef BOTH
}

extern "C" void kernel_launch(void* const* d_in, const int* in_sizes, int n_in, void* d_out, int out_size, void* d_ws, size_t ws_size, hipStream_t stream) {
    static int grid = 0;
    if (grid == 0) {
        if (n_in != 18 || out_size != M * 1024 || ws_size < WS_END) { fprintf(stderr, "kernel_launch: unexpected problem shape (n_in %d out %d ws %zu)\n", n_in, out_size, ws_size); grid = -1; return; }
        int dev = 0, cus = 0, per_cu = 0;
        if (hipGetDevice(&dev) != hipSuccess || hipDeviceGetAttribute(&cus, hipDeviceAttributeMultiprocessorCount, dev) != hipSuccess) { grid = -1; return; }
        if (hipFuncSetAttribute((const void*)hymba_fwd, hipFuncAttributeMaxDynamicSharedMemorySize, LDS_BYTES) != hipSuccess) { fprintf(stderr, "kernel_launch: hipFuncSetAttribute failed\n"); grid = -1; return; }
        if (hipOccupancyMaxActiveBlocksPerMultiprocessor(&per_cu, (const void*)hymba_fwd, NWAVES * 64, LDS_BYTES) != hipSuccess || per_cu < 1) { fprintf(stderr, "kernel_launch: occupancy query reports %d\n", per_cu); }
        (void)hipGetLastError();
        grid = cus;
    }
    if (grid < 0) return;
    (void)hipMemsetAsync((char*)d_ws + WS_CTL, 0, CTL_ZERO_BYTES, stream);
    Args a{};
    for (int i = 0; i < 18; ++i) a.in[i] = (const float*)d_in[i];
    a.out = (float*)d_out; a.ws = (unsigned char*)d_ws;
#if defined(PROBE_PHASE)
    { const int k = PROBE_PHASE; a.ph_lo = 0; a.ph_hi = k + 1; a.li = 0; hipLaunchKernelGGL(hymba_fwd, dim3(grid), dim3(NWAVES * 64), LDS_BYTES, stream, a);
      for (int r = 1; r < PROBE_REPS; ++r) { a.ph_lo = k; a.ph_hi = k + 1; a.li = 1; hipLaunchKernelGGL(hymba_fwd, dim3(grid), dim3(NWAVES * 64), LDS_BYTES, stream, a); }
      if (k + 1 < PER_PHASE) { a.ph_lo = k + 1; a.ph_hi = PER_PHASE; a.li = 2; hipLaunchKernelGGL(hymba_fwd, dim3(grid), dim3(NWAVES * 64), LDS_BYTES, stream, a); } }
#else
    if (N_LAUNCHES == 1) { a.ph_lo = 0; a.ph_hi = PER_PHASE; a.li = 0; hipLaunchKernelGGL(hymba_fwd, dim3(grid), dim3(NWAVES * 64), LDS_BYTES, stream, a); }
    else for (int li = 0; li < PER_PHASE; ++li) { a.ph_lo = li; a.ph_hi = li + 1; a.li = li; hipLaunchKernelGGL(hymba_fwd, dim3(grid), dim3(NWAVES * 64), LDS_BYTES, stream, a); }
#endif
}
```
